# Optimizing an MI355X kernel written in HIP

```python
import math
import jax, jax.numpy as jnp
from jax import lax
import numpy as np

D_MODEL = 1024
BATCH = 16
SEQ = 4096
DEPTH = 4

GRID_W = 64
CTX_LEN = 256
N_MIXERS = 3
HEAD_DIM = 64
BLOCK = 128
A_Q_HEADS = D_MODEL // HEAD_DIM
A_KV_HEADS = A_Q_HEADS // 4
A_WINDOW = 128
B_HEADS = D_MODEL // (2 * HEAD_DIM)
C_HEADS = D_MODEL // HEAD_DIM
NA_ROWS = 8
NA_COLS = 16
ROPE_BASE = 10000.0
ROPE_AXIS_DIM = HEAD_DIM // 2
N_EXPERTS = 16
EXPERT_FF = 2 * D_MODEL
CAPACITY_FACTOR = 2
RMS_EPS = 1e-6
NEG_INF = -1e30

kernel_name = "hybrid_interleaved_diffusion_block"


def rmsnorm(x, g):
    xf = x.astype(jnp.float32)
    y = xf * lax.rsqrt(jnp.mean(xf * xf, axis=-1, keepdims=True) + RMS_EPS)
    return (y * g.astype(jnp.float32)).astype(x.dtype)


def modulate(h, shift, scale):
    return h * (1 + scale) + shift


def rope_tables(n_tokens, dtype):
    t = jnp.arange(n_tokens)
    row = (t // GRID_W).astype(jnp.float32)
    col = (t % GRID_W).astype(jnp.float32)
    inv = 1.0 / (ROPE_BASE ** (jnp.arange(0, ROPE_AXIS_DIM, 2, dtype=jnp.float32) / ROPE_AXIS_DIM))
    ang = jnp.stack([row[:, None] * inv, col[:, None] * inv], axis=1)
    return jnp.cos(ang).astype(dtype), jnp.sin(ang).astype(dtype)


def apply_rope(x, cos, sin):
    shp = x.shape
    xr = x.reshape(shp[:-1] + (2, 2, ROPE_AXIS_DIM // 2))
    x1 = xr[..., 0, :]
    x2 = xr[..., 1, :]
    out = jnp.stack([x1 * cos - x2 * sin, x2 * cos + x1 * sin], axis=-2)
    return out.reshape(shp)


def sink_softmax(s, sink_l):
    m = jnp.maximum(jnp.max(s, axis=-1, keepdims=True), sink_l)
    e = jnp.exp(s - m)
    return e / (jnp.sum(e, axis=-1, keepdims=True) + jnp.exp(sink_l - m))


def window_gqa_mixer(hx, hc, w_in, w_out, sink, with_ctx):
    B, T, _ = hx.shape
    L = hc.shape[1]
    G = A_Q_HEADS // A_KV_HEADS
    nq = A_Q_HEADS * HEAD_DIM
    nk = A_KV_HEADS * HEAD_DIM

    def proj(h):
        n = h.shape[1]
        p = h @ w_in
        q = p[..., :nq].reshape(B, n, A_KV_HEADS, G, HEAD_DIM).transpose(0, 2, 3, 1, 4) * HEAD_DIM ** -0.5
        k = p[..., nq:nq + nk].reshape(B, n, A_KV_HEADS, HEAD_DIM).transpose(0, 2, 1, 3)
        v = p[..., nq + nk:].reshape(B, n, A_KV_HEADS, HEAD_DIM).transpose(0, 2, 1, 3)
        return q, k, v

    q, k, v = proj(hx)
    qc, kc, vc = proj(hc)
    cos, sin = rope_tables(T, hx.dtype)
    q = apply_rope(q, cos, sin)
    k = apply_rope(k, cos, sin)
    sink_l = sink.astype(jnp.float32).reshape(1, A_KV_HEADS, G, 1, 1)

    nb = T // BLOCK
    pad = ((0, 0), (0, 0), (BLOCK, BLOCK), (0, 0))
    k_pad = jnp.pad(k, pad)
    v_pad = jnp.pad(v, pad)
    q_blk = q.reshape(B, A_KV_HEADS, G, nb, BLOCK, HEAD_DIM).transpose(3, 0, 1, 2, 4, 5)
    ctx_valid = jnp.ones((BLOCK, L), dtype=bool)

    def block(args):
        j, qb = args
        start = j * BLOCK
        kb = jnp.concatenate([kc, lax.dynamic_slice_in_dim(k_pad, start, 3 * BLOCK, axis=2)], axis=2)
        vb = jnp.concatenate([vc, lax.dynamic_slice_in_dim(v_pad, start, 3 * BLOCK, axis=2)], axis=2)
        qpos = start + jnp.arange(BLOCK)
        kpos = start - BLOCK + jnp.arange(3 * BLOCK)
        band = (jnp.abs(qpos[:, None] - kpos[None, :]) <= A_WINDOW) & (kpos >= 0) & (kpos < T)
        valid = jnp.concatenate([ctx_valid, band], axis=1)
        s = jnp.einsum('bhgqd,bhkd->bhgqk', qb, kb).astype(jnp.float32)
        p = sink_softmax(jnp.where(valid, s, NEG_INF), sink_l)
        return jnp.einsum('bhgqk,bhkd->bhgqd', p.astype(vb.dtype), vb)

    y = lax.map(block, (jnp.arange(nb), q_blk))
    y = y.transpose(1, 0, 4, 2, 3, 5).reshape(B, T, nq)
    out_x = y @ w_out
    out_c = None
    if with_ctx:
        s = jnp.einsum('bhgqd,bhkd->bhgqk', qc, kc).astype(jnp.float32)
        p = sink_softmax(s, sink_l)
        yc = jnp.einsum('bhgqk,bhkd->bhgqd', p.astype(vc.dtype), vc)
        out_c = yc.transpose(0, 3, 1, 2, 4).reshape(B, L, nq) @ w_out
    return out_x, out_c


def diff_attn_mixer(hx, hc, w_in, w_out, lam_params, subln_g, lambda_init, with_ctx):
    B, T, _ = hx.shape
    L = hc.shape[1]
    nqk = 2 * B_HEADS * HEAD_DIM
    dv = 2 * HEAD_DIM

    def proj(h):
        n = h.shape[1]
        p = h @ w_in
        q = p[..., :nqk].reshape(B, n, B_HEADS, 2, HEAD_DIM).transpose(0, 2, 3, 1, 4) * HEAD_DIM ** -0.5
        k = p[..., nqk:2 * nqk].reshape(B, n, B_HEADS, 2, HEAD_DIM).transpose(0, 2, 3, 1, 4)
        v = p[..., 2 * nqk:].reshape(B, n, B_HEADS, dv).transpose(0, 2, 1, 3)
        return q, k, v

    q, k, v = proj(hx)
    qc, kc, vc = proj(hc)
    cos, sin = rope_tables(T, hx.dtype)
    q = apply_rope(q, cos, sin)
    k = apply_rope(k, cos, sin)
    lp = lam_params.astype(jnp.float32)
    lam = jnp.exp(jnp.sum(lp[0] * lp[1])) - jnp.exp(jnp.sum(lp[2] * lp[3])) + lambda_init

    def diff_av(qb, kk, vv):
        p = jax.nn.softmax(jnp.einsum('bhiqd,bhikd->bhiqk', qb, kk).astype(jnp.float32), axis=-1)
        a = p[:, :, 0] - lam * p[:, :, 1]
        return jnp.einsum('bhqk,bhkd->bhqd', a.astype(vv.dtype), vv)

    def finish(y):
        y = rmsnorm(y, subln_g) * (1.0 - lambda_init)
        return y.reshape(B, y.shape[1], B_HEADS * dv) @ w_out

    k_all = jnp.concatenate([kc, k], axis=3)
    v_all = jnp.concatenate([vc, v], axis=2)
    nb = T // BLOCK
    q_blk = q.reshape(B, B_HEADS, 2, nb, BLOCK, HEAD_DIM).transpose(3, 0, 1, 2, 4, 5)
    y = lax.map(lambda qb: diff_av(qb, k_all, v_all), q_blk)
    y = y.transpose(1, 0, 3, 2, 4).reshape(B, T, B_HEADS, dv)
    out_x = finish(y)
    out_c = None
    if with_ctx:
        out_c = finish(diff_av(qc, kc, vc).transpose(0, 2, 1, 3))
    return out_x, out_c


def neighbourhood_mixer(hx, hc, w_in, w_out, rpb, with_ctx):
    B, T, _ = hx.shape
    L = hc.shape[1]
    nh = C_HEADS * HEAD_DIM

    def proj(h):
        n = h.shape[1]
        p = h @ w_in
        q = p[..., :nh].reshape(B, n, C_HEADS, HEAD_DIM).transpose(0, 2, 1, 3) * HEAD_DIM ** -0.5
        k = p[..., nh:2 * nh].reshape(B, n, C_HEADS, HEAD_DIM).transpose(0, 2, 1, 3)
        v = p[..., 2 * nh:].reshape(B, n, C_HEADS, HEAD_DIM).transpose(0, 2, 1, 3)
        return q, k, v

    q, k, v = proj(hx)
    qc, kc, vc = proj(hc)
    rows = T // GRID_W
    wr = min(NA_ROWS, rows)
    wc = min(NA_COLS, GRID_W)
    qg = q.reshape(B, C_HEADS, rows, GRID_W, HEAD_DIM)
    kg = k.reshape(B, C_HEADS, rows, GRID_W, HEAD_DIM)
    vg = v.reshape(B, C_HEADS, rows, GRID_W, HEAD_DIM)
    cols = jnp.arange(GRID_W)
    col_idx = jnp.clip(cols - wc // 2, 0, GRID_W - wc)[:, None] + jnp.arange(wc)[None, :]
    col_bias_idx = col_idx - cols[:, None] + NA_COLS - 1
    rpb_c = rpb[:, :, col_bias_idx]

    def row_block(args):
        r, qr = args
        rs = jnp.clip(r - wr // 2, 0, rows - wr)
        kr = lax.dynamic_slice_in_dim(kg, rs, wr, axis=2)
        vr = lax.dynamic_slice_in_dim(vg, rs, wr, axis=2)
        k_nb = kr[:, :, :, col_idx]
        v_nb = vr[:, :, :, col_idx]
        row_bias_idx = rs + jnp.arange(wr) - r + NA_ROWS - 1
        bias = rpb_c[:, row_bias_idx].transpose(0, 2, 1, 3)
        s_nb = jnp.einsum('bhqd,bhrqcd->bhqrc', qr, k_nb).astype(jnp.float32) + bias.astype(jnp.float32)
        s_ctx = jnp.einsum('bhqd,bhkd->bhqk', qr, kc).astype(jnp.float32)
        logits = jnp.concatenate([s_ctx, s_nb.reshape(B, C_HEADS, GRID_W, wr * wc)], axis=-1)
        p = jax.nn.softmax(logits, axis=-1).astype(vr.dtype)
        p_nb = p[..., L:].reshape(B, C_HEADS, GRID_W, wr, wc)
        return (jnp.einsum('bhqk,bhkd->bhqd', p[..., :L], vc)
                + jnp.einsum('bhqrc,bhrqcd->bhqd', p_nb, v_nb))

    y = lax.map(row_block, (jnp.arange(rows), qg.transpose(2, 0, 1, 3, 4)))
    y = y.transpose(1, 0, 3, 2, 4).reshape(B, T, nh)
    out_x = y @ w_out
    out_c = None
    if with_ctx:
        p = jax.nn.softmax(jnp.einsum('bhqd,bhkd->bhqk', qc, kc).astype(jnp.float32), axis=-1)
        yc = jnp.einsum('bhqk,bhkd->bhqd', p.astype(vc.dtype), vc)
        out_c = yc.transpose(0, 2, 1, 3).reshape(B, L, nh) @ w_out
    return out_x, out_c


def ec_moe(h, router_w, w_gate, w_up, w_down):
    B, N, _ = h.shape
    cap = CAPACITY_FACTOR * N // N_EXPERTS
    aff = jax.nn.softmax(jnp.einsum('bnd,de->bne', h, router_w).astype(jnp.float32), axis=-1)
    gate, idx = lax.top_k(jnp.swapaxes(aff, 1, 2), cap)
    bidx = jnp.arange(B)[:, None, None]
    xin = h[bidx, idx]
    hid = jax.nn.silu(jnp.einsum('becd,edf->becf', xin, w_gate)) * jnp.einsum('becd,edf->becf', xin, w_up)
    y = jnp.einsum('becf,efd->becd', hid, w_down) * gate[..., None].astype(h.dtype)
    return jnp.zeros_like(h).at[bidx, idx].add(y)


def setup_inputs(seed: int = 0) -> dict:
    key = jax.random.key(seed)
    ks = jax.random.split(key, 24)
    D = D_MODEL
    n_win = len(range(0, DEPTH, N_MIXERS))
    n_diff = len(range(1, DEPTH, N_MIXERS))
    n_na = len(range(2, DEPTH, N_MIXERS))
    win_cols = (A_Q_HEADS + 2 * A_KV_HEADS) * HEAD_DIM
    diff_cols = 3 * 2 * B_HEADS * HEAD_DIM
    na_cols = 3 * C_HEADS * HEAD_DIM

    def nrm(k, shape, s):
        return jax.random.normal(k, shape, jnp.float32) * s

    return {
        "x": nrm(ks[0], (BATCH, SEQ, D), 1.0),
        "c": nrm(ks[1], (BATCH, D), 1.0),
        "ctx": nrm(ks[2], (BATCH, CTX_LEN, D), 1.0),
        "c_ctx": nrm(ks[3], (D,), 1.0),
        "ada_w": nrm(ks[4], (DEPTH, D, 6 * D), 0.5 * D ** -0.5),
        "ada_b": nrm(ks[5], (DEPTH, 6 * D), 0.02),
        "norm1_g": 1.0 + nrm(ks[6], (DEPTH, D), 0.02),
        "norm2_g": 1.0 + nrm(ks[7], (DEPTH, D), 0.02),
        "final_g": 1.0 + nrm(ks[8], (D,), 0.02),
        "win_w_in": nrm(ks[9], (n_win, D, win_cols), D ** -0.5),
        "win_w_out": nrm(ks[10], (n_win, A_Q_HEADS * HEAD_DIM, D), (A_Q_HEADS * HEAD_DIM) ** -0.5),
        "win_sink": nrm(ks[11], (n_win, A_Q_HEADS), 0.5),
        "diff_w_in": nrm(ks[12], (n_diff, D, diff_cols), D ** -0.5),
        "diff_w_out": nrm(ks[13], (n_diff, 2 * B_HEADS * HEAD_DIM, D), (2 * B_HEADS * HEAD_DIM) ** -0.5),
        "diff_lambda": nrm(ks[14], (n_diff, 4, HEAD_DIM), 0.1),
        "diff_subln_g": 1.0 + nrm(ks[15], (n_diff, 2 * HEAD_DIM), 0.02),
        "na_w_in": nrm(ks[16], (n_na, D, na_cols), D ** -0.5),
        "na_w_out": nrm(ks[17], (n_na, C_HEADS * HEAD_DIM, D), (C_HEADS * HEAD_DIM) ** -0.5),
        "na_rpb": nrm(ks[18], (n_na, C_HEADS, 2 * NA_ROWS - 1, 2 * NA_COLS - 1), 0.1),
        "router_w": nrm(ks[19], (DEPTH, D, N_EXPERTS), D ** -0.5),
        "w_gate": nrm(ks[20], (DEPTH, N_EXPERTS, D, EXPERT_FF), D ** -0.5),
        "w_up": nrm(ks[21], (DEPTH, N_EXPERTS, D, EXPERT_FF), D ** -0.5),
        "w_down": nrm(ks[22], (DEPTH, N_EXPERTS, EXPERT_FF, D), EXPERT_FF ** -0.5),
    }


def reference(x, c, ctx, c_ctx, ada_w, ada_b, norm1_g, norm2_g, final_g,
              win_w_in, win_w_out, win_sink,
              diff_w_in, diff_w_out, diff_lambda, diff_subln_g,
              na_w_in, na_w_out, na_rpb,
              router_w, w_gate, w_up, w_down):
    for i in range(DEPTH):
        kind = i % N_MIXERS
        slot = i // N_MIXERS
        with_ctx = i < DEPTH - 1
        mod_x = (jax.nn.silu(c) @ ada_w[i] + ada_b[i])[:, None, :]
        mod_c = jax.nn.silu(c_ctx) @ ada_w[i] + ada_b[i]
        sx1, cx1, gx1, sx2, cx2, gx2 = jnp.split(mod_x, 6, axis=-1)
        sc1, cc1, gc1, sc2, cc2, gc2 = jnp.split(mod_c, 6, axis=-1)
        hx = modulate(rmsnorm(x, norm1_g[i]), sx1, cx1)
        hc = modulate(rmsnorm(ctx, norm1_g[i]), sc1, cc1)
        if kind == 0:
            yx, yc = window_gqa_mixer(hx, hc, win_w_in[slot], win_w_out[slot], win_sink[slot], with_ctx)
        elif kind == 1:
            lambda_init = 0.8 - 0.6 * math.exp(-0.3 * i)
            yx, yc = diff_attn_mixer(hx, hc, diff_w_in[slot], diff_w_out[slot], diff_lambda[slot],
                                     diff_subln_g[slot], lambda_init, with_ctx)
        else:
            yx, yc = neighbourhood_mixer(hx, hc, na_w_in[slot], na_w_out[slot], na_rpb[slot], with_ctx)
        x = x + gx1 * yx
        x = x + gx2 * ec_moe(modulate(rmsnorm(x, norm2_g[i]), sx2, cx2),
                             router_w[i], w_gate[i], w_up[i], w_down[i])
        if with_ctx:
            ctx = ctx + gc1 * yc
            ctx = ctx + gc2 * ec_moe(modulate(rmsnorm(ctx, norm2_g[i]), sc2, cc2),
                                     router_w[i], w_gate[i], w_up[i], w_down[i])
    return rmsnorm(x, final_g)
```

```cpp
#include <hip/hip_runtime.h>
#include <cstdio>
#include <cstdint>

#ifndef MK_N_LAUNCHES
#define MK_N_LAUNCHES 1
#endif

#define GAS __attribute__((address_space(1)))
#define LAS __attribute__((address_space(3)))
typedef unsigned short bf16_t;
typedef short bf16x8 __attribute__((ext_vector_type(8)));
typedef short s16x4 __attribute__((ext_vector_type(4)));
typedef float f32x4 __attribute__((ext_vector_type(4)));
typedef float f32x2 __attribute__((ext_vector_type(2)));
typedef float f32x16 __attribute__((ext_vector_type(16)));
typedef unsigned u32x4 __attribute__((ext_vector_type(4)));
typedef unsigned u32x2 __attribute__((ext_vector_type(2)));
typedef __bf16 bf16x2_t __attribute__((ext_vector_type(2)));
typedef GAS unsigned gu32;

constexpr int DM = 1024, NB = 16, SEQ = 4096, DEPTH = 4, CTXL = 256, NE = 16, FF = 2048;
constexpr int MX = NB * SEQ;
constexpr int MC = NB * CTXL;
constexpr int MT = MX + MC;
constexpr int CAPX = 512, CAPC = 32;
constexpr int NME_FULL = 34, NME_LAST = 32;
constexpr float C2 = 0.125f * 1.4426950408889634f;
constexpr float LOG2E = 1.4426950408889634f;
constexpr float RMS_EPS = 1e-6f;
constexpr float NEG_BIG = -1e30f;
constexpr int NWAVES = 8;
constexpr int NPHASES = 2 + 8 * DEPTH;

constexpr size_t MiB = 1u << 20;
constexpr size_t WS_CTL = 0, CTL_ZERO_BYTES = 64 * 1024;
constexpr size_t WS_MOD = 1 * MiB;
constexpr size_t WS_TAB = 3 * MiB;
constexpr size_t WS_AFF = 4 * MiB;
constexpr size_t WS_SLOT = 9 * MiB;
constexpr size_t WS_ROWSRC = 12 * MiB;
constexpr size_t WS_CTXRES = 13 * MiB;
constexpr size_t WS_PW = 29 * MiB;
constexpr size_t PW_WIN_IN = 0, PW_WIN_OUT = 6 * MiB, PW_DIFF_IN = 10 * MiB, PW_DIFF_OUT = 16 * MiB, PW_NA_IN = 18 * MiB, PW_NA_OUT = 24 * MiB;
constexpr size_t WS_H = 56 * MiB;
constexpr size_t WS_QKV = 192 * MiB;
constexpr size_t WS_YBUF = 736 * MiB;
constexpr size_t WS_MOEW = 1008 * MiB;
constexpr size_t MOEW_E = (size_t)(4096 * 1024 + 1024 * 2048);
#ifndef INPROJ_FP8
#define INPROJ_FP8 1
#endif
#ifndef OUTPROJ_FP8
#define OUTPROJ_FP8 0
#endif
constexpr float Y_SCALE = 8.f;
constexpr float H2_SCALE = 4.f, HID_SCALE = 2.f, W8_SCALE = 32.f;
constexpr size_t WS_XB = 1536 * MiB;
constexpr size_t WS_END = 1672 * MiB;
constexpr size_t WS_P = 1400 * MiB;
constexpr int TAB_COS = 0, TAB_SIN = 1024, TAB_LAM = 2048;

constexpr int RING_BYTES = 131072;
constexpr int MISC_OFF = 135168;
constexpr int LDS_BYTES = 147456;

#define LDS_WAIT() asm volatile("s_waitcnt lgkmcnt(0)" ::: "memory")
#define VM_WAIT() asm volatile("s_waitcnt vmcnt(0)" ::: "memory")

__device__ __forceinline__ unsigned cvtpk(float lo, float hi) { f32x2 v = {lo, hi}; bf16x2_t b = __builtin_convertvector(v, bf16x2_t); return __builtin_bit_cast(unsigned, b); }
__device__ __forceinline__ float bf2f(unsigned short u) { return __builtin_bit_cast(float, (unsigned)u << 16); }
__device__ __forceinline__ float wave_sum(float v) {
#pragma unroll
    for (int o = 1; o < 64; o <<= 1) v += __shfl_xor(v, o);
    return v;
}
template <int CTRL> __device__ __forceinline__ float dppf(float v) { return __builtin_bit_cast(float, __builtin_amdgcn_update_dpp(0, __builtin_bit_cast(int, v), CTRL, 0xF, 0xF, true)); }
__device__ __forceinline__ float row16_sum(float v) { v += dppf<0xB1>(v); v += dppf<0x4E>(v); v += dppf<0x141>(v); v += dppf<0x140>(v); return v; }
__device__ __forceinline__ float row16_max(float v) { v = fmaxf(v, dppf<0xB1>(v)); v = fmaxf(v, dppf<0x4E>(v)); v = fmaxf(v, dppf<0x141>(v)); v = fmaxf(v, dppf<0x140>(v)); return v; }
__device__ __forceinline__ float rdlane(float v, int l) { return __builtin_bit_cast(float, __builtin_amdgcn_readlane(__builtin_bit_cast(int, v), l)); }
__device__ __forceinline__ float wave_sum_fast(float v) { v = row16_sum(v); return (rdlane(v, 0) + rdlane(v, 16)) + (rdlane(v, 32) + rdlane(v, 48)); }
__device__ __forceinline__ float siluf(float v) { return v / (1.f + __expf(-v)); }

#define XB_TMO      128
#define XB_XCNT(j)  (256  + 64 * (j))
#define XB_XSUB(j)  (1280 + 64 * (j))
#define XB_XGEN(j)  (2304 + 64 * (j))
#define XB_TOP      3328
#define XB_TOPGEN   3392
#define XCD_BAR_WORDS 3456
#define XB_SPIN_CAP (1u << 18)
__device__ __forceinline__ unsigned xb_ld(unsigned* p)              { return __hip_atomic_load(p, __ATOMIC_RELAXED, __HIP_MEMORY_SCOPE_AGENT); }
__device__ __forceinline__ unsigned xb_add(unsigned* p, unsigned v) { return __hip_atomic_fetch_add(p, v, __ATOMIC_RELAXED, __HIP_MEMORY_SCOPE_AGENT); }
__device__ __forceinline__ unsigned xb_xcc_id() { return (unsigned)__builtin_amdgcn_s_getreg((3 << 11) | 20) & 0xFu; }
#define XB_SPIN(cond, bar) do { unsigned _sp = 0; while (cond) { __builtin_amdgcn_s_sleep(1); \
    if ((++_sp & 255u) == 0u) { if (xb_ld(&(bar)[XB_TMO])) break; if (_sp > XB_SPIN_CAP) { atomicAdd(&(bar)[XB_TMO], 1u); break; } } } } while (0)
struct XcdBarrier { unsigned* bar; unsigned x; volatile LAS unsigned* st; };
__device__ __forceinline__ XcdBarrier xcd_barrier_post(unsigned* bar, volatile LAS unsigned* st) {
    XcdBarrier b; b.bar = bar; b.x = xb_xcc_id(); b.st = st;
    if (threadIdx.x == 0) (void)xb_add(&bar[XB_XCNT(b.x)], 1u);
    return b;
}
__device__ __forceinline__ void xcd_barrier_complete(unsigned* bar, unsigned x, unsigned& nloc, unsigned& nx) {
    const unsigned G = gridDim.x * gridDim.y * gridDim.z;
    unsigned sum, cnt, mine, sp = 0u;
    for (;;) {
        sum = 0u; cnt = 0u; mine = 0u;
#pragma unroll
        for (unsigned j = 0; j < 16; ++j) { const unsigned c = xb_ld(&bar[XB_XCNT(j)]); sum += c; cnt += (c > 0u) ? 1u : 0u; mine = (j == x) ? c : mine; }
        if (sum == G) break;
        __builtin_amdgcn_s_sleep(1);
        if ((++sp & 255u) == 0u) { if (xb_ld(&bar[XB_TMO])) break; if (sp > XB_SPIN_CAP) { atomicAdd(&bar[XB_TMO], 1u); break; } }
    }
    nloc = mine > 0u ? mine : 1u; nx = cnt > 0u ? cnt : 1u;
}
__device__ __forceinline__ void xcd_barrier(const XcdBarrier& b) {
    asm volatile("s_waitcnt vmcnt(0)" ::: "memory");
    __syncthreads();
    if (threadIdx.x == 0) {
        unsigned* bar = b.bar;
        __builtin_amdgcn_s_waitcnt(0);
        unsigned nloc = b.st[0], nx = b.st[1];
        if (nloc == 0u) { xcd_barrier_complete(bar, b.x, nloc, nx); b.st[0] = nloc; b.st[1] = nx; }
        const unsigned old = xb_add(&bar[XB_XSUB(b.x)], 1u);
        const unsigned gen = old / nloc;
        if (old + 1u == (gen + 1u) * nloc) {
            __builtin_amdgcn_fence(__ATOMIC_RELEASE, "agent");
            asm volatile("s_waitcnt vmcnt(0)" ::: "memory");
            const unsigned og = xb_add(&bar[XB_TOP], 1u);
            const unsigned tg = og / nx;
            if (og + 1u == (tg + 1u) * nx) xb_add(&bar[XB_TOPGEN], 1u);
            else XB_SPIN(xb_ld(&bar[XB_TOPGEN]) == tg, bar);
            __builtin_amdgcn_fence(__ATOMIC_ACQUIRE, "agent");
            xb_add(&bar[XB_XGEN(b.x)], 1u);
            asm volatile("s_waitcnt vmcnt(0)" ::: "memory");
        } else {
            XB_SPIN(xb_ld(&bar[XB_XGEN(b.x)]) == gen, bar);
            __builtin_amdgcn_fence(__ATOMIC_ACQUIRE, "agent");
            asm volatile("s_waitcnt vmcnt(0)" ::: "memory");
        }
    }
    __syncthreads();
}

namespace pg8 {
constexpr int BM = 256, BK = 64, HALF = 128, HTB = HALF * BK * 2, NXCD = 8, WGM = 8;
typedef int v4i __attribute__((ext_vector_type(4)));
typedef int v8i __attribute__((ext_vector_type(8)));
__host__ __device__ __forceinline__ int lds_byte(int r, int c) { const int st = (r >> 4) * 2 + (c >> 5), rr = r & 15, cc = c & 31, ob = rr * 64 + cc * 2; return st * 1024 + (ob ^ (((ob >> 9) & 1) << 5)); }
__host__ __device__ __forceinline__ void stage_rc(int b, int& R, int& C) { const int st = b / 1024, sb = b % 1024, swz = sb ^ (((sb >> 9) & 1) << 5); R = (st >> 1) * 16 + swz / 64; C = (st & 1) * 32 + (swz % 64) / 2; }
__host__ __device__ __forceinline__ int perm32(int rho) { const int n = rho >> 4, i = rho & 15; return 8 * (i >> 2) + 4 * n + (i & 3); }

struct Unit { int pm, pn; };
struct Gemm { const char* A; const char* Bt; int Kb; int nMe; size_t b_estride; const unsigned* rowsrc; };

struct StaticOrder {
    int nM, nN, nwg, G, c;
    __device__ void init(int nM_, int nN_, int G_, int c_) { nM = nM_; nN = nN_; nwg = nM * nN; G = G_; c = c_; }
    __device__ bool next(int i, Unit& u) const {
        const long L = (long)i * G + c; if (L >= nwg) return false;
        int wgid = (int)L; { const int q = nwg / NXCD, r = nwg % NXCD, xcd = wgid % NXCD, off = wgid / NXCD; wgid = (xcd < r ? xcd * (q + 1) : r * (q + 1) + (xcd - r) * q) + off; }
        const int nig = WGM * nN, gid = wgid / nig, fm = gid * WGM, gsz = (nM - fm) < WGM ? (nM - fm) : WGM;
        u.pm = fm + ((wgid % nig) % gsz); u.pn = (wgid % nig) / gsz; return true;
    }
};

template <class Epi, bool GATHER, bool ALIGN_EPI, bool FP8 = false, bool ABLK = false>
__device__ __forceinline__ void gemm_phase(LAS unsigned char* lds, const Gemm g, const StaticOrder& S, const Epi& E) {
    int tid = threadIdx.x; asm volatile("" : "+v"(tid));
    const int wid = __builtin_amdgcn_readfirstlane(tid >> 6), lane = tid & 63, wr = wid >> 2, wc = wid & 3, fr = lane & 15, fq = lane >> 4;
    const int Kb = g.Kb, nt = Kb / (BK * 2);
    int Rr[2], Cc[2]; unsigned voffB[2];
#pragma unroll
    for (int i = 0; i < 2; ++i) { int R, C; stage_rc(tid * 16 + i * 8192, R, C); const int Rb = Epi::PERM ? ((R & ~31) + perm32(R & 31)) : R;
        Rr[i] = R; Cc[i] = C; voffB[i] = (unsigned)(Rb * Kb + C * 2); }
    const size_t kstep = (size_t)(BK * 2);
    const size_t kstepA = ABLK ? (size_t)32768 : kstep;
    const size_t hstep = (size_t)HALF * Kb;
    const size_t tstep = 2 * hstep;
    const unsigned ldsw = (unsigned)wid * 1024u;
    const int aoff = lds_byte(wr * 64 + fr, fq * 8), boff = lds_byte(wc * 32 + fr, fq * 8);
#define PG8_SA(b, h) (((b) * 2 + (h)) * HTB)
#define PG8_SB(b, h) ((4 + (b) * 2 + (h)) * HTB)
#define PG8_STAGE(bufoff, gbase, voff) do { _Pragma("unroll") for (int _i = 0; _i < 2; ++_i) \
        __builtin_amdgcn_global_load_lds((const unsigned*)((const char*)(gbase) + (voff)[_i]), (LAS unsigned*)(lds + (bufoff) + ldsw + _i * 8192), 16, 0, 0); } while (0)
#define PG8_LDA(dst, b, h) do { _Pragma("unroll") for (int m = 0; m < 4; ++m) _Pragma("unroll") for (int k = 0; k < 2; ++k) dst[m][k] = *(const LAS bf16x8*)(lds + PG8_SA(b, h) + aoff + m * 2048 + k * 1024); } while (0)
#define PG8_LDB(dst, b, h) do { _Pragma("unroll") for (int n = 0; n < 2; ++n) _Pragma("unroll") for (int k = 0; k < 2; ++k) dst[n][k] = *(const LAS bf16x8*)(lds + PG8_SB(b, h) + boff + n * 2048 + k * 1024); } while (0)
#define PG8_MMA(ai, bj, At, Bt) do { __builtin_amdgcn_s_setprio(1); \
        if constexpr (FP8) { _Pragma("unroll") for (int m = 0; m < 4; ++m) _Pragma("unroll") for (int n = 0; n < 2; ++n) { \
            const v8i b8_ = __builtin_shufflevector(__builtin_bit_cast(v4i, Bt[n][0]), __builtin_bit_cast(v4i, Bt[n][1]), 0, 1, 2, 3, 4, 5, 6, 7); \
            const v8i a8_ = __builtin_shufflevector(__builtin_bit_cast(v4i, At[m][0]), __builtin_bit_cast(v4i, At[m][1]), 0, 1, 2, 3, 4, 5, 6, 7); \
            asm volatile("v_mfma_f32_16x16x128_f8f6f4 %0, %1, %2, %0" : "+v"(acc[ai][bj][m][n]) : "v"(b8_), "v"(a8_)); } } \
        else { _Pragma("unroll") for (int m = 0; m < 4; ++m) _Pragma("unroll") for (int n = 0; n < 2; ++n) _Pragma("unroll") for (int k = 0; k < 2; ++k) \
            acc[ai][bj][m][n] = __builtin_amdgcn_mfma_f32_16x16x32_bf16(Bt[n][k], At[m][k], acc[ai][bj][m][n], 0, 0, 0); } \
        __builtin_amdgcn_s_setprio(0); } while (0)
#define PG8_WAIT_V(n) asm volatile("s_waitcnt vmcnt(" #n ")" ::: "memory")
#define PG8_WAIT_L(n) asm volatile("s_waitcnt lgkmcnt(" #n ")" ::: "memory")
#define PG8_BAR __builtin_amdgcn_s_barrier()
#define PG8_SCHED __builtin_amdgcn_sched_barrier(0)
#define PG8_CALC_VG(VG, U) do { _Pragma("unroll") for (int _h = 0; _h < 2; ++_h) _Pragma("unroll") for (int _i = 0; _i < 2; ++_i) { \
        const unsigned _row = (unsigned)((U).pm * BM + _h * HALF + Rr[_i]); const unsigned _src = GATHER ? g.rowsrc[_row] : _row; \
        if constexpr (ABLK) { const unsigned _r = (unsigned)(_h * HALF + Rr[_i]), _c = (unsigned)Cc[_i] >> 3; \
            VG[_h][_i] = (unsigned)(U).pm * (unsigned)(Kb * BM) + (_r >> 4) * 2048u + (_c >> 1) * 512u + (_r & 15u) * 32u + (_c & 1u) * 16u; } \
        else VG[_h][_i] = _src * (unsigned)Kb + (unsigned)Cc[_i] * 2u; } } while (0)
    Unit cur, nxt; int ui = 0;
    if (!S.next(0, cur)) return;
    f32x4 acc[2][2][4][2];
#pragma unroll
    for (int a = 0; a < 2; ++a)
#pragma unroll
        for (int b = 0; b < 2; ++b)
#pragma unroll
            for (int m = 0; m < 4; ++m)
#pragma unroll
                for (int n = 0; n < 2; ++n) acc[a][b][m][n] = (f32x4){0.f, 0.f, 0.f, 0.f};
    bf16x8 At[4][2], B0[2][2], B1[2][2];
    unsigned vg[2][2], vgn[2][2];
    PG8_CALC_VG(vg, cur);
    const char* const gA = g.A;
    const char* cB = g.Bt + (size_t)(cur.pm / g.nMe) * g.b_estride + (size_t)cur.pn * tstep;
    PG8_STAGE(PG8_SB(0, 0), cB, voffB); PG8_STAGE(PG8_SB(0, 1), cB + hstep, voffB); PG8_STAGE(PG8_SA(0, 0), gA, vg[0]); PG8_STAGE(PG8_SA(0, 1), gA, vg[1]);
    if (wr == 1) PG8_BAR;
    PG8_WAIT_V(2); PG8_BAR;
    PG8_STAGE(PG8_SB(1, 0), cB + kstep, voffB); PG8_STAGE(PG8_SA(1, 0), gA + kstepA, vg[0]); PG8_STAGE(PG8_SB(1, 1), cB + hstep + kstep, voffB);
    PG8_WAIT_V(6); PG8_BAR;
    for (;;) {
        const bool has_next = S.next(ui + 1, nxt);
        LAS unsigned char* const rsb = lds + 131072 + ((ui + 1) & 1) * 1024;
        if (has_next) {
            if constexpr (GATHER) { if (wid == 0) __builtin_amdgcn_global_load_lds((const unsigned*)(g.rowsrc + (size_t)nxt.pm * BM) + lane * 4, (LAS unsigned*)rsb, 16, 0, 0); }
            else { PG8_CALC_VG(vgn, nxt); } }
        else {
#pragma unroll
            for (int _h = 0; _h < 2; ++_h)
#pragma unroll
                for (int _i = 0; _i < 2; ++_i) vgn[_h][_i] = vg[_h][_i]; }
        const char* nB = has_next ? g.Bt + (size_t)(nxt.pm / g.nMe) * g.b_estride + (size_t)nxt.pn * tstep : cB;
        for (int t = 0; t < nt; t += 2) {
            const bool last = (t == nt - 2);
            const char* a1 = gA + (size_t)(t + 1) * kstepA;
            const char* a2 = last ? gA : gA + (size_t)(t + 2) * kstepA; const char* b2 = last ? nB : cB + (size_t)(t + 2) * kstep;
            const char* a3 = a2 + kstepA; const char* b3 = b2 + kstep;
            if constexpr (GATHER) { if (last && has_next) {
#pragma unroll
                for (int _h = 0; _h < 2; ++_h)
#pragma unroll
                    for (int _i = 0; _i < 2; ++_i) vgn[_h][_i] = *(const LAS unsigned*)(rsb + (_h * HALF + Rr[_i]) * 4) * (unsigned)Kb + (unsigned)Cc[_i] * 2u; } }
            unsigned w0[2], w1[2];
#pragma unroll
            for (int _i = 0; _i < 2; ++_i) { w0[_i] = last ? vgn[0][_i] : vg[0][_i]; w1[_i] = last ? vgn[1][_i] : vg[1][_i]; }
            PG8_LDB(B0, 0, 0); PG8_LDB(B1, 0, 1); PG8_SCHED; PG8_LDA(At, 0, 0); PG8_STAGE(PG8_SA(1, 1), a1, vg[1]);
            PG8_WAIT_V(8); PG8_WAIT_L(0); PG8_BAR; PG8_MMA(0, 0, At, B0); PG8_MMA(0, 1, At, B1); PG8_BAR; PG8_SCHED;
            PG8_LDA(At, 0, 1); PG8_STAGE(PG8_SB(0, 0), b2, voffB); PG8_STAGE(PG8_SB(0, 1), b2 + hstep, voffB); PG8_STAGE(PG8_SA(0, 0), a2, w0);
            PG8_WAIT_V(8); PG8_WAIT_L(0); PG8_BAR; PG8_MMA(1, 0, At, B0); PG8_MMA(1, 1, At, B1); PG8_BAR; PG8_SCHED;
            PG8_LDB(B0, 1, 0); PG8_LDB(B1, 1, 1); PG8_SCHED; PG8_LDA(At, 1, 0); PG8_STAGE(PG8_SA(0, 1), a2, w1);
            PG8_WAIT_V(8); PG8_WAIT_L(0); PG8_BAR; PG8_MMA(0, 0, At, B0); PG8_MMA(0, 1, At, B1); PG8_BAR; PG8_SCHED;
            PG8_LDA(At, 1, 1); PG8_STAGE(PG8_SB(1, 0), b3, voffB); PG8_STAGE(PG8_SB(1, 1), b3 + hstep, voffB); PG8_STAGE(PG8_SA(1, 0), a3, w0);
            PG8_WAIT_V(8); PG8_WAIT_L(0); PG8_BAR; PG8_MMA(1, 0, At, B0); PG8_MMA(1, 1, At, B1); PG8_BAR; PG8_SCHED;
        }
        if constexpr (ALIGN_EPI) { if (wr == 0) PG8_BAR; }
        if constexpr (FP8) asm volatile("s_nop 15\n\ts_nop 15" ::: "memory");
        E(acc, cur, wr, wc, fr, fq);
        if (!has_next) break;
#pragma unroll
        for (int a = 0; a < 2; ++a)
#pragma unroll
            for (int b = 0; b < 2; ++b)
#pragma unroll
                for (int m = 0; m < 4; ++m)
#pragma unroll
                    for (int n = 0; n < 2; ++n) acc[a][b][m][n] = (f32x4){0.f, 0.f, 0.f, 0.f};
        cur = nxt; cB = nB; ++ui;
#pragma unroll
        for (int _h = 0; _h < 2; ++_h)
#pragma unroll
            for (int _i = 0; _i < 2; ++_i) vg[_h][_i] = vgn[_h][_i];
        if constexpr (ALIGN_EPI) { if (wr == 1) PG8_BAR; }
    }
    PG8_WAIT_V(0);
    if constexpr (!ALIGN_EPI) { if (wr == 0) PG8_BAR; }
    PG8_BAR;
#undef PG8_SA
#undef PG8_SB
#undef PG8_STAGE
#undef PG8_LDA
#undef PG8_LDB
#undef PG8_MMA
#undef PG8_WAIT_V
#undef PG8_WAIT_L
#undef PG8_BAR
#undef PG8_SCHED
#undef PG8_CALC_VG
}

struct EpiInProj {
    static constexpr bool PERM = false;
    bf16_t* O; int ldc; int q_tiles; int rope_tiles; const float* tab; float osc; int v_tile0;
    __device__ __forceinline__ void operator()(const f32x4 (&acc)[2][2][4][2], const Unit& u, int wr, int wc, int fr, int fq) const {
        const int row0 = u.pm * BM + wr * 64 + fr, col0 = u.pn * BM + wc * 32 + 4 * fq;
        const float sc = ((u.pn < q_tiles) ? C2 : 1.f) * osc;
        const bool rope = (u.pn < rope_tiles) && (u.pm < MX / BM);
        const int axis = wc & 1; const bool isv = u.pn >= v_tile0;
#pragma unroll
        for (int ai = 0; ai < 2; ++ai)
#pragma unroll
            for (int m = 0; m < 4; ++m) {
                const int row = row0 + ai * HALF + m * 16;
                f32x4 cs = {1.f, 1.f, 1.f, 1.f}, sn = {0.f, 0.f, 0.f, 0.f};
                if (rope) { const int t = row & (SEQ - 1); const int pos = axis ? (t & 63) : (t >> 6); cs = *(const f32x4*)(tab + TAB_COS + pos * 16 + 4 * fq); sn = *(const f32x4*)(tab + TAB_SIN + pos * 16 + 4 * fq); }
                bf16_t* rowp = O + (size_t)row * ldc + col0;
                bf16_t* rowq = O + (size_t)row * ldc + u.pn * BM + wc * 32 + 8 * fq;
#pragma unroll
                for (int bj = 0; bj < 2; ++bj) {
                    const f32x4 x1 = acc[ai][bj][m][0] * sc, x2 = acc[ai][bj][m][1] * sc;
                    const f32x4 o1 = x1 * cs - x2 * sn, o2 = x2 * cs + x1 * sn;
                    u32x2 w1, w2; w1.x = cvtpk(o1[0], o1[1]); w1.y = cvtpk(o1[2], o1[3]); w2.x = cvtpk(o2[0], o2[1]); w2.y = cvtpk(o2[2], o2[3]);
                    if (isv) { *(u32x2*)(rowp + bj * HALF) = w1; *(u32x2*)(rowp + bj * HALF + 16) = w2; }
                    else *(u32x4*)(rowq + bj * HALF) = (u32x4){w1.x, w1.y, w2.x, w2.y}; }
            }
    }
};
struct EpiOutProj {
    static constexpr bool PERM = true;
    bf16_t* P; const float* mod; float osc;
    __device__ __forceinline__ void operator()(const f32x4 (&acc)[2][2][4][2], const Unit& u, int wr, int wc, int fr, int fq) const {
        const int b = (u.pm < MX / BM) ? ((u.pm * BM) >> 12) : 16;
        const int row0 = u.pm * BM + wr * 64 + fr, col0 = u.pn * BM + wc * 32 + 8 * fq;
        const float* gp = mod + (size_t)b * 6144 + 2 * DM + col0;
        f32x4 gv[2][2];
#pragma unroll
        for (int bj = 0; bj < 2; ++bj)
#pragma unroll
            for (int n = 0; n < 2; ++n) gv[bj][n] = *(const f32x4*)(gp + bj * HALF + 4 * n) * osc;
#pragma unroll
        for (int ai = 0; ai < 2; ++ai)
#pragma unroll
            for (int m = 0; m < 4; ++m) { bf16_t* rowp = P + (size_t)(row0 + ai * HALF + m * 16) * DM + col0;
                u32x4 xr[2]; xr[0] = *(const u32x4*)rowp; xr[1] = *(const u32x4*)(rowp + HALF);
#pragma unroll
                for (int bj = 0; bj < 2; ++bj) { const f32x4 v0 = acc[ai][bj][m][0] * gv[bj][0], v1 = acc[ai][bj][m][1] * gv[bj][1]; const u32x4 x = xr[bj];
                    u32x4 w; w.x = cvtpk(v0[0] + __builtin_bit_cast(float, x.x << 16), v0[1] + __builtin_bit_cast(float, x.x & 0xffff0000u));
                    w.y = cvtpk(v0[2] + __builtin_bit_cast(float, x.y << 16), v0[3] + __builtin_bit_cast(float, x.y & 0xffff0000u));
                    w.z = cvtpk(v1[0] + __builtin_bit_cast(float, x.z << 16), v1[1] + __builtin_bit_cast(float, x.z & 0xffff0000u));
                    w.w = cvtpk(v1[2] + __builtin_bit_cast(float, x.w << 16), v1[3] + __builtin_bit_cast(float, x.w & 0xffff0000u));
                    *(u32x4*)(rowp + bj * HALF) = w; } }
    }
};
template <bool NOSTORE = false> struct EpiSwiglu {
    static constexpr bool PERM = true;
    unsigned char* O; float in_scale; float out_scale;
    __device__ __forceinline__ void operator()(const f32x4 (&acc)[2][2][4][2], const Unit& u, int wr, int wc, int fr, int fq) const {
        const int row0 = u.pm * BM + wr * 64 + fr, col0 = u.pn * HALF + wc * 32 + 8 * fq;
#pragma unroll
        for (int ai = 0; ai < 2; ++ai)
#pragma unroll
            for (int m = 0; m < 4; ++m) { unsigned char* rowp = O + ((size_t)u.pm * 16 + u.pn) * 32768 + (8 * ai + 4 * wr + m) * 2048 + wc * 512 + fr * 32 + fq * 8;
                float h[8];
                const float c1 = -LOG2E * in_scale, c2 = in_scale * in_scale * out_scale;
#pragma unroll
                for (int n = 0; n < 2; ++n)
#pragma unroll
                    for (int j = 0; j < 4; j += 2) { const f32x2 ag = {acc[ai][0][m][n][j], acc[ai][0][m][n][j + 1]}, au = {acc[ai][1][m][n][j], acc[ai][1][m][n][j + 1]};
                        const f32x2 ea = ag * c1; f32x2 t; t.x = __builtin_amdgcn_exp2f(ea.x); t.y = __builtin_amdgcn_exp2f(ea.y);
                        const f32x2 d = t + 1.0f; f32x2 r; r.x = __builtin_amdgcn_rcpf(d.x); r.y = __builtin_amdgcn_rcpf(d.y);
                        const f32x2 hv = ((ag * au) * c2) * r; h[n * 4 + j] = hv.x; h[n * 4 + j + 1] = hv.y; }
                int w0 = 0, w1 = 0;
                w0 = __builtin_amdgcn_cvt_pk_fp8_f32(h[0], h[1], w0, false); w0 = __builtin_amdgcn_cvt_pk_fp8_f32(h[2], h[3], w0, true);
                w1 = __builtin_amdgcn_cvt_pk_fp8_f32(h[4], h[5], w1, false); w1 = __builtin_amdgcn_cvt_pk_fp8_f32(h[6], h[7], w1, true);
                if (NOSTORE) asm volatile("" :: "v"(w0), "v"(w1)); else *(u32x2*)rowp = (u32x2){(unsigned)w0, (unsigned)w1}; }
    }
};
struct EpiBf16 {
    static constexpr bool PERM = true;
    bf16_t* O; int ldc; float sc;
    __device__ __forceinline__ void operator()(const f32x4 (&acc)[2][2][4][2], const Unit& u, int wr, int wc, int fr, int fq) const {
        const int row0 = u.pm * BM + wr * 64 + fr, col0 = u.pn * BM + wc * 32 + 8 * fq;
#pragma unroll
        for (int ai = 0; ai < 2; ++ai)
#pragma unroll
            for (int m = 0; m < 4; ++m) { bf16_t* rowp = O + (size_t)(row0 + ai * HALF + m * 16) * ldc + col0;
#pragma unroll
                for (int bj = 0; bj < 2; ++bj) { const f32x4 v0 = acc[ai][bj][m][0] * sc, v1 = acc[ai][bj][m][1] * sc;
                    u32x4 w; w.x = cvtpk(v0[0], v0[1]); w.y = cvtpk(v0[2], v0[3]); w.z = cvtpk(v1[0], v1[1]); w.w = cvtpk(v1[2], v1[3]);
                    *(u32x4*)(rowp + bj * HALF) = w; } }
    }
};
}

namespace att {
#define SBAR() __builtin_amdgcn_sched_barrier(0)
__device__ __forceinline__ int crow(int r, int hi) { return (r & 3) + 8 * (r >> 2) + 4 * hi; }
__device__ __forceinline__ void glds16(const void* gsrc, unsigned lds_dst) { unsigned keep;
    asm volatile("s_mov_b32 %0, m0\n\ts_mov_b32 m0, %2\n\ts_nop 0\n\tglobal_load_lds_dwordx4 %1, off\n\ts_mov_b32 m0, %0" : "=&s"(keep) : "v"(gsrc), "s"(lds_dst) : "memory"); }
#define WAIT_BAR0() asm volatile("s_waitcnt vmcnt(0) lgkmcnt(0)\n\ts_barrier" ::: "memory")
typedef LAS const char* lds_cptr;
typedef short v4i16_t __attribute__((ext_vector_type(4)));
__device__ __forceinline__ s16x4 vtr(lds_cptr p) { return __builtin_bit_cast(s16x4, __builtin_amdgcn_ds_read_tr16_b64_v4i16((LAS v4i16_t*)p)); }
__device__ __forceinline__ float hmax(float m) { auto rr = __builtin_amdgcn_permlane32_swap(__float_as_uint(m), __float_as_uint(m), false, false); return fmaxf(__uint_as_float(rr[0]), __uint_as_float(rr[1])); }
__device__ __forceinline__ float hsum(float m) { auto rr = __builtin_amdgcn_permlane32_swap(__float_as_uint(m), __float_as_uint(m), false, false); return __uint_as_float(rr[0]) + __uint_as_float(rr[1]); }

__device__ __forceinline__ void qkt(f32x16& p0, f32x16& p1, lds_cptr kb, const bf16x8 (&qr)[4]) {
    p0 = f32x16{}; p1 = f32x16{};
#pragma unroll
    for (int d0 = 0; d0 < 4; ++d0) {
        const bf16x8 b0 = *(const LAS bf16x8*)(kb + d0 * 2048), b1 = *(const LAS bf16x8*)(kb + d0 * 2048 + 512);
        p0 = __builtin_amdgcn_mfma_f32_32x32x16_bf16(b0, qr[d0], p0, 0, 0, 0);
        p1 = __builtin_amdgcn_mfma_f32_32x32x16_bf16(b1, qr[d0], p1, 0, 0, 0); }
}
template <int ND>
__device__ __forceinline__ void softmax_pv(f32x16& p0, f32x16& p1, f32x16 (&oT)[ND], float& m, float& l, lds_cptr vp) {
    float rm = p0[0];
#pragma unroll
    for (int r = 1; r < 16; ++r) rm = fmaxf(rm, p0[r]);
#pragma unroll
    for (int r = 0; r < 16; ++r) rm = fmaxf(rm, p1[r]);
    rm = hmax(rm);
    const float mn = fmaxf(m, rm);
    const float alpha = __builtin_amdgcn_exp2f(m - mn);
    m = mn;
    float s = 0.f;
#pragma unroll
    for (int r = 0; r < 16; ++r) { p0[r] = __builtin_amdgcn_exp2f(p0[r] - mn); p1[r] = __builtin_amdgcn_exp2f(p1[r] - mn); s += p0[r] + p1[r]; }
    l = l * alpha + s;
#pragma unroll
    for (int d = 0; d < ND; ++d) oT[d] = oT[d] * alpha;
    u32x4 pw[4];
#pragma unroll
    for (int k = 0; k < 2; ++k) {
        pw[k]     = (u32x4){cvtpk(p0[8 * k], p0[8 * k + 1]), cvtpk(p0[8 * k + 2], p0[8 * k + 3]), cvtpk(p0[8 * k + 4], p0[8 * k + 5]), cvtpk(p0[8 * k + 6], p0[8 * k + 7])};
        pw[2 + k] = (u32x4){cvtpk(p1[8 * k], p1[8 * k + 1]), cvtpk(p1[8 * k + 2], p1[8 * k + 3]), cvtpk(p1[8 * k + 4], p1[8 * k + 5]), cvtpk(p1[8 * k + 6], p1[8 * k + 7])}; }
#pragma unroll
    for (int d = 0; d < ND; ++d)
#pragma unroll
        for (int ks = 0; ks < 4; ++ks) {
            const s16x4 lo = vtr(vp + d * 4096 + ks * 1024), hi = vtr(vp + d * 4096 + ks * 1024 + 512);
            const bf16x8 vf = (bf16x8){lo[0], lo[1], lo[2], lo[3], hi[0], hi[1], hi[2], hi[3]};
            oT[d] = __builtin_amdgcn_mfma_f32_32x32x16_bf16(vf, __builtin_bit_cast(bf16x8, pw[ks]), oT[d], 0, 0, 0); }
}
template <int ND>
__device__ __forceinline__ void stg_flush(const LAS unsigned char* stg, bf16_t* ybase, int lane) {
    constexpr int RB = ND * 64 + 16, CPR = ND * 4;
#pragma unroll
    for (int i = 0; i < 32 * CPR / 64; ++i) { const int idx = i * 64 + lane, row = idx / CPR, ch = idx % CPR;
        const u32x4 v = *(const LAS u32x4*)(stg + row * RB + ch * 16); *(u32x4*)(ybase + (size_t)row * DM + ch * 8) = v; }
}
template <int ND>
__device__ __forceinline__ void store_oT(const f32x16 (&oT)[ND], float scale, bf16_t* ybase, size_t elem_off, int hi) {
    if (OUTPROJ_FP8) { unsigned char* orow = (unsigned char*)ybase + elem_off; const float sc8 = scale * Y_SCALE;
#pragma unroll
        for (int d = 0; d < ND; ++d)
#pragma unroll
            for (int g = 0; g < 4; ++g) { int t = 0; t = __builtin_amdgcn_cvt_pk_fp8_f32(oT[d][4 * g] * sc8, oT[d][4 * g + 1] * sc8, t, false); t = __builtin_amdgcn_cvt_pk_fp8_f32(oT[d][4 * g + 2] * sc8, oT[d][4 * g + 3] * sc8, t, true);
                *(unsigned*)(orow + d * 32 + 8 * g + 4 * hi) = (unsigned)t; } }
    else { bf16_t* orow = ybase + elem_off;
#pragma unroll
        for (int d = 0; d < ND; ++d)
#pragma unroll
            for (int g = 0; g < 4; ++g) { u32x2 w; w.x = cvtpk(oT[d][4 * g] * scale, oT[d][4 * g + 1] * scale); w.y = cvtpk(oT[d][4 * g + 2] * scale, oT[d][4 * g + 3] * scale);
                *(u32x2*)(orow + d * 32 + 8 * g + 4 * hi) = w; } }
}
constexpr int NA_BIAS_OFF = 65536;
struct DiffArgs { const bf16_t* qkv; bf16_t* y; const float* subln_g; float lam; float omli; int with_ctx; };

#define DF_THR 8.0f
#define DF_BAR()   asm volatile("s_waitcnt lgkmcnt(0)\n\ts_barrier" ::: "memory")
#define DF_BARV()  asm volatile("s_waitcnt vmcnt(0) lgkmcnt(0)\n\ts_barrier" ::: "memory")
__device__ __forceinline__ void diff_phase2(LAS unsigned char* lds, const DiffArgs A, int vcu, int G) {
    int tid = threadIdx.x; asm volatile("" : "+v"(tid));
    const int lane = tid & 63, r32 = lane & 31, hi = lane >> 5; const int wid = __builtin_amdgcn_readfirstlane(tid >> 6);
    constexpr int P = 3072;
    const unsigned lds0 = (unsigned)(uintptr_t)lds;
    const lds_cptr l3 = (lds_cptr)lds;
    const int mp = wid >> 2, qsub = wid & 3;
    LAS float* xch = (LAS float*)lds + qsub * 4096 + lane;
    const int nmain = NB * 8 * 32, nunits = nmain + (A.with_ctx ? NB * 8 * 2 : 0);
    for (int u = vcu; u < nunits; u += G) {
        int b, h, qrow0, NT; const bool ctxu = u >= nmain;
        if (!ctxu) { const int qb = u & 31; h = (u >> 5) & 7; b = u >> 8; qrow0 = b * SEQ + 128 * qb + 32 * qsub; NT = 4 + 64; }
        else { const int v = u - nmain; const int qb = v & 1; h = (v >> 1) & 7; b = v >> 4; qrow0 = MX + b * CTXL + 128 * qb + 32 * qsub; NT = 4; }
        const bf16_t* Kc = A.qkv + (size_t)(MX + b * CTXL) * P + 1024 + 128 * h;
        const bf16_t* Kx = A.qkv + (size_t)(b * SEQ) * P + 1024 + 128 * h;
        const int krow = 8 * wid + (lane >> 3); const size_t koff = (size_t)krow * P + (((lane & 7) ^ ((krow >> 1) & 7)) * 8);
        const int pv0 = 2 * wid, pv1 = 2 * wid + 1;
        const int vra = 4 * pv0 + (lane >> 4), vrb = 4 * pv1 + (lane >> 4); const int vph = lane & 15;
        const size_t voffa = (size_t)vra * P + 1024 + ((((vph >> 2) ^ (vra & 3)) << 2) | (vph & 3)) * 8;
        const size_t voffb = (size_t)vrb * P + 1024 + ((((vph >> 2) ^ (vrb & 3)) << 2) | (vph & 3)) * 8;
#define DF_DMA(t) do { if ((t) < NT) { const int slot_ = (t) % 3; const bf16_t* base_ = ((t) < 4) ? Kc + (size_t)(t) * 64 * P : Kx + (size_t)((t) - 4) * 64 * P; \
        glds16(base_ + koff,      (unsigned)__builtin_amdgcn_readfirstlane(lds0 + slot_ * 32768 + wid * 1024)); \
        glds16(base_ + koff + 64, (unsigned)__builtin_amdgcn_readfirstlane(lds0 + slot_ * 32768 + 8192 + wid * 1024)); \
        glds16(base_ + voffa,     (unsigned)__builtin_amdgcn_readfirstlane(lds0 + slot_ * 32768 + 16384 + pv0 * 1024)); \
        glds16(base_ + voffb,     (unsigned)__builtin_amdgcn_readfirstlane(lds0 + slot_ * 32768 + 16384 + pv1 * 1024)); } } while (0)
        DF_DMA(0);
        bf16x8 qr[4];
        { const bf16_t* Qw = A.qkv + (size_t)(qrow0 + r32) * P + h * 128 + mp * 64;
#pragma unroll
          for (int d0 = 0; d0 < 4; ++d0) qr[d0] = *(const bf16x8*)(Qw + d0 * 16 + hi * 8); }
        f32x16 oT[4]; oT[0] = f32x16{}; oT[1] = f32x16{}; oT[2] = f32x16{}; oT[3] = f32x16{};
        float m = 0.f, l = 0.f;
        f32x16 p0, p1; u32x4 pw[4];
        const int ksw = (r32 >> 1) & 7; const lds_cptr kp0 = l3 + mp * 8192 + r32 * 128 + ((hi ^ (ksw & 1)) << 4); const int ks2 = ksw >> 1;
        const int vq = (lane & 15) >> 2; const lds_cptr vp0 = l3 + 16384 + (4 * hi + vq) * 256 + ((lane >> 4) & 1) * 32 + (lane & 3) * 8;
#define DF_LOADV(dst, vp_, d) do { const lds_cptr vd_ = (vp_) + (((d) ^ vq) << 6); _Pragma("unroll") for (int ks = 0; ks < 4; ++ks) { const s16x4 lo_ = vtr(vd_ + ks * 4096), hi_ = vtr(vd_ + ks * 4096 + 2048); \
            dst[ks] = (bf16x8){lo_[0], lo_[1], lo_[2], lo_[3], hi_[0], hi_[1], hi_[2], hi_[3]}; } } while (0)
#define DF_PV4(src, d) do { _Pragma("unroll") for (int ks = 0; ks < 4; ++ks) oT[d] = __builtin_amdgcn_mfma_f32_32x32x16_bf16(src[ks], __builtin_bit_cast(bf16x8, pw[ks]), oT[d], 0, 0, 0); } while (0)
#define DF_LOADK(dst, kb_, dd) do { dst[0] = *(const LAS bf16x8*)((kb_) + ((((dd)) ^ ks2) << 5)); dst[1] = *(const LAS bf16x8*)((kb_) + ((((dd)) ^ ks2) << 5) + 4096); \
            dst[2] = *(const LAS bf16x8*)((kb_) + ((((dd) + 1) ^ ks2) << 5)); dst[3] = *(const LAS bf16x8*)((kb_) + ((((dd) + 1) ^ ks2) << 5) + 4096); } while (0)
#define DF_QK4(src, dd) do { p0 = __builtin_amdgcn_mfma_f32_32x32x16_bf16(src[0], qr[dd], p0, 0, 0, 0); p1 = __builtin_amdgcn_mfma_f32_32x32x16_bf16(src[1], qr[dd], p1, 0, 0, 0); \
            p0 = __builtin_amdgcn_mfma_f32_32x32x16_bf16(src[2], qr[(dd) + 1], p0, 0, 0, 0); p1 = __builtin_amdgcn_mfma_f32_32x32x16_bf16(src[3], qr[(dd) + 1], p1, 0, 0, 0); } while (0)
#define DF_PREV(vso) do { const lds_cptr vq_ = vp0 + (vso); DF_LOADV(fa, vq_, 0); DF_LOADV(fb, vq_, 1); SBAR(); } while (0)
#define DF_PINIT() do { _Pragma("unroll") for (int r = 0; r < 16; ++r) { p0[r] = -m; p1[r] = -m; } } while (0)
#define DF_SEGM(DO_PV, DO_QK, vso, kso) do { const lds_cptr vp_ = vp0 + (vso); const lds_cptr kb_ = kp0 + (kso); SBAR(); __builtin_amdgcn_s_setprio(1); \
        if (DO_PV) { DF_PV4(fa, 0); SBAR(); DF_LOADV(fa, vp_, 2); SBAR(); \
            DF_PV4(fb, 1); SBAR(); DF_LOADV(fb, vp_, 3); if (DO_QK) { DF_PINIT(); } SBAR(); \
            DF_PV4(fa, 2); SBAR(); if (DO_QK) { DF_LOADK(fa, kb_, 0); } SBAR(); \
            DF_PV4(fb, 3); SBAR(); if (DO_QK) { DF_LOADK(fb, kb_, 2); } SBAR(); } \
        else if (DO_QK) { DF_LOADK(fa, kb_, 0); DF_LOADK(fb, kb_, 2); DF_PINIT(); SBAR(); } \
        if (DO_QK) { DF_QK4(fa, 0); SBAR(); DF_QK4(fb, 2); SBAR(); } \
        __builtin_amdgcn_s_setprio(0); } while (0)
#define DF_SEGV(t) do { \
        float rm = p0[0]; \
        _Pragma("unroll") for (int r = 1; r < 16; ++r) rm = fmaxf(rm, p0[r]); \
        _Pragma("unroll") for (int r = 0; r < 16; ++r) rm = fmaxf(rm, p1[r]); \
        rm = hmax(rm); \
        if ((t) == 0 || __any(rm > DF_THR)) { const float dl = ((t) == 0) ? rm : fmaxf(rm, 0.f); m += dl; \
            _Pragma("unroll") for (int r = 0; r < 16; ++r) { p0[r] -= dl; p1[r] -= dl; } \
            const float f = __builtin_amdgcn_exp2f(-dl); l *= f; \
            _Pragma("unroll") for (int d = 0; d < 4; ++d) oT[d] = oT[d] * f; } \
        float s_ = 0.f; \
        _Pragma("unroll") for (int r = 0; r < 16; ++r) { p0[r] = __builtin_amdgcn_exp2f(p0[r]); p1[r] = __builtin_amdgcn_exp2f(p1[r]); s_ += p0[r] + p1[r]; } \
        l += s_; \
        _Pragma("unroll") for (int k = 0; k < 2; ++k) { \
            pw[k]     = (u32x4){cvtpk(p0[8 * k], p0[8 * k + 1]), cvtpk(p0[8 * k + 2], p0[8 * k + 3]), cvtpk(p0[8 * k + 4], p0[8 * k + 5]), cvtpk(p0[8 * k + 6], p0[8 * k + 7])}; \
            pw[2 + k] = (u32x4){cvtpk(p1[8 * k], p1[8 * k + 1]), cvtpk(p1[8 * k + 2], p1[8 * k + 3]), cvtpk(p1[8 * k + 4], p1[8 * k + 5]), cvtpk(p1[8 * k + 6], p1[8 * k + 7])}; } \
        } while (0)
        DF_BARV();
        int so_p = 0, so_c = 0;
#define DF_ROT() do { so_p = so_c; so_c = (so_c == 65536) ? 0 : so_c + 32768; } while (0)
        bf16x8 fa[4], fb[4];
        if (mp == 0) {
            DF_DMA(1); DF_SEGM(false, true, 0, so_c); SBAR(); DF_PREV(so_c); DF_SEGV(0); SBAR(); DF_BARV(); SBAR();
            for (int t = 1; t < NT; ++t) { DF_ROT();
                DF_DMA(t + 1); DF_SEGM(true, true, so_p, so_c); SBAR(); DF_PREV(so_c); DF_SEGV(t); SBAR(); DF_BARV(); SBAR(); }
            DF_ROT();
            DF_SEGM(true, false, so_p, 0); SBAR(); DF_BARV(); SBAR();
        } else {
            DF_DMA(1); DF_SEGM(false, true, 0, so_c); SBAR(); DF_BARV(); SBAR();
            for (int t = 1; t < NT; ++t) { DF_ROT();
                DF_DMA(t + 1); DF_PREV(so_p); DF_SEGV(t - 1); SBAR(); DF_SEGM(true, true, so_p, so_c); SBAR(); DF_BARV(); SBAR(); }
            DF_ROT();
            DF_PREV(so_p); DF_SEGV(NT - 1); SBAR(); DF_SEGM(true, false, so_p, 0); SBAR(); DF_BARV(); SBAR();
        }
#undef DF_ROT
        l = hsum(l);
        const float il = 1.f / l;
        if (mp == 1) { const float sc = il * A.lam;
#pragma unroll
            for (int d = 0; d < 4; ++d)
#pragma unroll
                for (int q = 0; q < 16; ++q) xch[(d * 16 + q) * 64] = oT[d][q] * sc; }
        DF_BARV();
        if (mp == 0) {
            float ss = 0.f;
#pragma unroll
            for (int d = 0; d < 4; ++d)
#pragma unroll
                for (int q = 0; q < 16; ++q) { const float v = oT[d][q] * il - xch[(d * 16 + q) * 64]; oT[d][q] = v; ss += v * v; }
            ss = hsum(ss);
            const float rstd = rsqrtf(ss * (1.f / 128.f) + RMS_EPS) * A.omli;
            const size_t eo = (size_t)(qrow0 + r32) * DM + h * 128;
#pragma unroll
            for (int d = 0; d < 4; ++d)
#pragma unroll
                for (int g = 0; g < 4; ++g) { const f32x4 gg = *(const f32x4*)(A.subln_g + d * 32 + 8 * g + 4 * hi);
                    if (OUTPROJ_FP8) { const float r8 = rstd * Y_SCALE; int t = 0; t = __builtin_amdgcn_cvt_pk_fp8_f32(oT[d][4 * g] * r8 * gg[0], oT[d][4 * g + 1] * r8 * gg[1], t, false);
                        t = __builtin_amdgcn_cvt_pk_fp8_f32(oT[d][4 * g + 2] * r8 * gg[2], oT[d][4 * g + 3] * r8 * gg[3], t, true);
                        *(unsigned*)((unsigned char*)A.y + eo + d * 32 + 8 * g + 4 * hi) = (unsigned)t; }
                    else { u32x2 w; w.x = cvtpk(oT[d][4 * g] * rstd * gg[0], oT[d][4 * g + 1] * rstd * gg[1]); w.y = cvtpk(oT[d][4 * g + 2] * rstd * gg[2], oT[d][4 * g + 3] * rstd * gg[3]);
                        *(u32x2*)(A.y + eo + d * 32 + 8 * g + 4 * hi) = w; } }
        }
        DF_BAR();
#undef DF_DMA
#undef DF_SEGM
#undef DF_SEGV
#undef DF_PINIT
#undef DF_PREV
#undef DF_LOADV
#undef DF_PV4
#undef DF_LOADK
#undef DF_QK4
    }
}

#define D3_PIN(x) asm volatile("" : "+v"(x))
#define D3_EX(v) __builtin_amdgcn_exp2f(v)
__device__ __forceinline__ void diff_phase3(LAS unsigned char* lds, const DiffArgs A, int vcu, int G) {
    int tid = threadIdx.x; asm volatile("" : "+v"(tid));
    const int lane = tid & 63, r32 = lane & 31, hi = lane >> 5; const int wid = __builtin_amdgcn_readfirstlane(tid >> 6);
    constexpr int P = 3072;
    const unsigned lds0 = (unsigned)(uintptr_t)lds;
    const lds_cptr l3 = (lds_cptr)lds;
    const int mp = wid >> 2, qsub = wid & 3;
    const int nmain = NB * 8 * 32, nunits = nmain + (A.with_ctx ? NB * 8 * 2 : 0);
    for (int u = vcu; u < nunits; u += G) {
        int b, h, qrow0, NT; const bool ctxu = u >= nmain;
        if (!ctxu) { const int qb = u & 31; h = (u >> 5) & 7; b = u >> 8; qrow0 = b * SEQ + 128 * qb + 32 * qsub; NT = 4 + 64; }
        else { const int v = u - nmain; const int qb = v & 1; h = (v >> 1) & 7; b = v >> 4; qrow0 = MX + b * CTXL + 128 * qb + 32 * qsub; NT = 4; }
        const bf16_t* Kc = A.qkv + (size_t)(MX + b * CTXL) * P + 1024 + 128 * h;
        const bf16_t* Kx = A.qkv + (size_t)(b * SEQ) * P + 1024 + 128 * h;
        const int kra = 16 * qsub + (lane >> 3), krb = kra + 8; const int vr0 = 16 * qsub + (lane >> 4); const int vph = lane & 15;
        const unsigned d0 = mp ? (unsigned)vr0 * P + 1024 + ((((vph >> 2) ^ (vr0 & 3)) << 2) | (vph & 3)) * 8 : (unsigned)kra * P + (((lane & 7) ^ ((kra >> 1) & 7)) * 8);
        const unsigned d1 = mp ? d0 + 4 * P : (unsigned)krb * P + (((lane & 7) ^ ((krb >> 1) & 7)) * 8);
        const unsigned inc2 = mp ? 8 * P : 64;
        const unsigned e0 = lds0 + (mp ? 32768 + qsub * 4096 : qsub * 2048), e2 = e0 + (mp ? 2048 : 8192);
#define D3_DMA(t) do { const int t_ = (t); if (t_ < NT) { const bf16_t* base_ = (t_ < 4) ? Kc + (size_t)t_ * 64 * P : Kx + (size_t)(t_ - 4) * 64 * P; \
        const unsigned so_ = (mp ? (t_ & 3) : (t_ & 1)) * 16384; \
        glds16(base_ + d0,        (unsigned)__builtin_amdgcn_readfirstlane(e0 + so_)); \
        glds16(base_ + d1,        (unsigned)__builtin_amdgcn_readfirstlane(e0 + so_ + 1024)); \
        glds16(base_ + d0 + inc2, (unsigned)__builtin_amdgcn_readfirstlane(e2 + so_)); \
        glds16(base_ + d1 + inc2, (unsigned)__builtin_amdgcn_readfirstlane(e2 + so_ + 1024)); } } while (0)
#define D3_WAITBAR(T) do { if (mp == 0 || (T) + 1 >= NT) DF_BARV(); else asm volatile("s_waitcnt vmcnt(4) lgkmcnt(0)\n\ts_barrier" ::: "memory"); } while (0)
        D3_DMA(0);
        bf16x8 qr[4];
        { const bf16_t* Qw = A.qkv + (size_t)(qrow0 + r32) * P + h * 128 + mp * 64;
#pragma unroll
          for (int d0 = 0; d0 < 4; ++d0) qr[d0] = *(const bf16x8*)(Qw + d0 * 16 + hi * 8); }
        f32x16 oT[4]; oT[0] = f32x16{}; oT[1] = f32x16{}; oT[2] = f32x16{}; oT[3] = f32x16{};
        f32x16 negm;
        float m = 0.f, l = 0.f, rf = 1.f; bool resc = false;
        f32x16 pA0, pA1, pB0, pB1; u32x4 pw0, pw1, pw2, pw3;
        const int ksw = (r32 >> 1) & 7; const lds_cptr kp0 = l3 + mp * 8192 + r32 * 128 + ((hi ^ (ksw & 1)) << 4); const int ks2 = ksw >> 1;
        const int vq = (lane & 15) >> 2; const lds_cptr vp0 = l3 + 32768 + (4 * hi + vq) * 256 + ((lane >> 4) & 1) * 32 + (lane & 3) * 8;
#define D3_KF(kb_, g) (*(const LAS bf16x8*)((kb_) + (((((g) >> 1)) ^ ks2) << 5) + ((g) & 1) * 4096))
#define D3_VF(vp_, g) ({ const lds_cptr vd_ = (vp_) + (((((g) >> 2)) ^ vq) << 6) + ((g) & 3) * 4096; const s16x4 lo_ = vtr(vd_), hi_ = vtr(vd_ + 2048); (bf16x8){lo_[0], lo_[1], lo_[2], lo_[3], hi_[0], hi_[1], hi_[2], hi_[3]}; })
#define D3_PK(P, B) cvtpk(P[B], P[(B) + 1])
#define D3_KSEL(g) (((g) & 1) ? kf1 : kf0)
#define D3_GA(g, C0, C1, Q0, Q1, HASQK, HASVA, FIRST) do { \
        if (HASQK) { \
            if ((g) == 0) { if (FIRST) C0 = __builtin_amdgcn_mfma_f32_32x32x16_bf16(D3_KSEL(g), qr[0], f32x16{}, 0, 0, 0); else C0 = __builtin_amdgcn_mfma_f32_32x32x16_bf16(D3_KSEL(g), qr[0], negm, 0, 0, 0); } \
            else if ((g) == 1) { if (FIRST) C1 = __builtin_amdgcn_mfma_f32_32x32x16_bf16(D3_KSEL(g), qr[0], f32x16{}, 0, 0, 0); else C1 = __builtin_amdgcn_mfma_f32_32x32x16_bf16(D3_KSEL(g), qr[0], negm, 0, 0, 0); } \
            else if ((g) & 1) C1 = __builtin_amdgcn_mfma_f32_32x32x16_bf16(D3_KSEL(g), qr[(g) >> 1], C1, 0, 0, 0); else C0 = __builtin_amdgcn_mfma_f32_32x32x16_bf16(D3_KSEL(g), qr[(g) >> 1], C0, 0, 0, 0); \
            if ((g) + 2 < 8) { if ((g) & 1) kf1 = D3_KF(kb_, (g) + 2); else kf0 = D3_KF(kb_, (g) + 2); } } \
        if (HASVA) { if ((g) == 6) vf0 = D3_VF(vp_, 0); if ((g) == 7) vf1 = D3_VF(vp_, 1); } \
        if (HASVA) { if ((g) < 5) { Q1[5 + 2 * (g)] = D3_EX(Q1[5 + 2 * (g)]); Q1[6 + 2 * (g)] = D3_EX(Q1[6 + 2 * (g)]); } if ((g) == 5) { Q1[15] = D3_EX(Q1[15]); } \
            if ((g) == 0) { pw0[0] = D3_PK(Q0, 0); pw0[1] = D3_PK(Q0, 2); } if ((g) == 1) { pw0[2] = D3_PK(Q0, 4); pw0[3] = D3_PK(Q0, 6); D3_PIN(pw0); } \
            if ((g) == 2) { pw1[0] = D3_PK(Q0, 8); pw1[1] = D3_PK(Q0, 10); } if ((g) == 3) { pw1[2] = D3_PK(Q0, 12); pw1[3] = D3_PK(Q0, 14); D3_PIN(pw1); } \
            if ((g) == 4) { pw2[0] = D3_PK(Q1, 0); pw2[1] = D3_PK(Q1, 2); } if ((g) == 5) { pw2[2] = D3_PK(Q1, 4); pw2[3] = D3_PK(Q1, 6); D3_PIN(pw2); } \
            if ((g) == 6) { pw3[0] = D3_PK(Q1, 8); pw3[1] = D3_PK(Q1, 10); } if ((g) == 7) { pw3[2] = D3_PK(Q1, 12); pw3[3] = D3_PK(Q1, 14); D3_PIN(pw3); } \
            } \
        SBAR(); } while (0)
#define D3_PWSEL(g) (((g) & 3) == 0 ? pw0 : ((g) & 3) == 1 ? pw1 : ((g) & 3) == 2 ? pw2 : pw3)
#define D3_EXI(C0, C1, e) do { if ((e) < 16) C0[(e) & 15] = D3_EX(C0[(e) & 15]); else C1[(e) & 15] = D3_EX(C1[(e) & 15]); } while (0)
#define D3_GB(g, C0, C1, Q0, Q1, HASPV, HASVB, FIRST) do { \
        if (HASPV) { \
            oT[(g) >> 2] = __builtin_amdgcn_mfma_f32_32x32x16_bf16(((g) & 1) ? vf1 : vf0, __builtin_bit_cast(bf16x8, D3_PWSEL(g)), oT[(g) >> 2], 0, 0, 0); \
            if ((g) + 2 < 16) { if ((g) & 1) vf1 = D3_VF(vp_, (g) + 2); else vf0 = D3_VF(vp_, (g) + 2); } } \
        if (HASPV) { if ((g) < 4) { sacc += Q0[4 * ((g) & 3)]; sacc += Q0[4 * ((g) & 3) + 1]; sacc += Q0[4 * ((g) & 3) + 2]; sacc += Q0[4 * ((g) & 3) + 3]; D3_PIN(sacc); } \
            else if ((g) < 8) { sacc += Q1[4 * ((g) & 3)]; sacc += Q1[4 * ((g) & 3) + 1]; sacc += Q1[4 * ((g) & 3) + 2]; sacc += Q1[4 * ((g) & 3) + 3]; D3_PIN(sacc); } \
            else if ((g) == 8) { l += sacc; } } \
        if (HASVB) { if ((g) < 4) { rmx = fmaxf(fmaxf(rmx, C0[4 * ((g) & 3)]), C0[4 * ((g) & 3) + 1]); rmx = fmaxf(fmaxf(rmx, C0[4 * ((g) & 3) + 2]), C0[4 * ((g) & 3) + 3]); D3_PIN(rmx); } \
            else if ((g) < 8) { rmx = fmaxf(fmaxf(rmx, C1[4 * ((g) & 3)]), C1[4 * ((g) & 3) + 1]); rmx = fmaxf(fmaxf(rmx, C1[4 * ((g) & 3) + 2]), C1[4 * ((g) & 3) + 3]); D3_PIN(rmx); } \
            else if ((g) == 8) { rmx = hmax(rmx); resc = false; \
                if (FIRST || __any(rmx > DF_THR)) { const float dl = FIRST ? rmx : fmaxf(rmx, 0.f); m += dl; \
                    _Pragma("unroll") for (int r_ = 0; r_ < 16; ++r_) { C0[r_] -= dl; C1[r_] -= dl; negm[r_] = -m; } D3_PIN(negm); \
                    rf = D3_EX(-dl); l *= rf; resc = true; } } \
            else { const int e0_ = 3 * ((g) - 9);   \
                D3_EXI(C0, C1, e0_); D3_EXI(C0, C1, e0_ + 1); D3_EXI(C0, C1, e0_ + 2); if (e0_ + 2 < 16) D3_PIN(C0); else D3_PIN(C1); } } \
        SBAR(); } while (0)
#define D3_STEP(C0, C1, Q0, Q1, HASQK, HASPREV, FIRST, T) do { \
        const lds_cptr kb_ = kp0 + ((T) & 1) * 16384; const lds_cptr vp_ = vp0 + (((T) - 1) & 3) * 16384; bf16x8 kf0, kf1, vf0, vf1; float sacc = 0.f, rmx = -3.0e38f; \
        if (HASQK) D3_DMA((T) + 1); \
        SBAR(); if (HASQK) { kf0 = D3_KF(kb_, 0); kf1 = D3_KF(kb_, 1); } \
        D3_GA(0, C0, C1, Q0, Q1, HASQK, HASPREV, FIRST); D3_GA(1, C0, C1, Q0, Q1, HASQK, HASPREV, FIRST); D3_GA(2, C0, C1, Q0, Q1, HASQK, HASPREV, FIRST); D3_GA(3, C0, C1, Q0, Q1, HASQK, HASPREV, FIRST); \
        D3_GA(4, C0, C1, Q0, Q1, HASQK, HASPREV, FIRST); D3_GA(5, C0, C1, Q0, Q1, HASQK, HASPREV, FIRST); D3_GA(6, C0, C1, Q0, Q1, HASQK, HASPREV, FIRST); D3_GA(7, C0, C1, Q0, Q1, HASQK, HASPREV, FIRST); \
        if (HASQK) { if (mp == 1) D3_WAITBAR(T); } \
        D3_GB(0, C0, C1, Q0, Q1, HASPREV, HASQK, FIRST); D3_GB(1, C0, C1, Q0, Q1, HASPREV, HASQK, FIRST); D3_GB(2, C0, C1, Q0, Q1, HASPREV, HASQK, FIRST); D3_GB(3, C0, C1, Q0, Q1, HASPREV, HASQK, FIRST); \
        D3_GB(4, C0, C1, Q0, Q1, HASPREV, HASQK, FIRST); D3_GB(5, C0, C1, Q0, Q1, HASPREV, HASQK, FIRST); D3_GB(6, C0, C1, Q0, Q1, HASPREV, HASQK, FIRST); D3_GB(7, C0, C1, Q0, Q1, HASPREV, HASQK, FIRST); \
        D3_GB(8, C0, C1, Q0, Q1, HASPREV, HASQK, FIRST); D3_GB(9, C0, C1, Q0, Q1, HASPREV, HASQK, FIRST); D3_GB(10, C0, C1, Q0, Q1, HASPREV, HASQK, FIRST); D3_GB(11, C0, C1, Q0, Q1, HASPREV, HASQK, FIRST); \
        D3_GB(12, C0, C1, Q0, Q1, HASPREV, HASQK, FIRST); D3_GB(13, C0, C1, Q0, Q1, HASPREV, HASQK, FIRST); D3_GB(14, C0, C1, Q0, Q1, HASPREV, HASQK, FIRST); D3_GB(15, C0, C1, Q0, Q1, HASPREV, HASQK, FIRST); \
        if (HASQK && resc) { _Pragma("unroll") for (int d_ = 0; d_ < 4; ++d_) oT[d_] = oT[d_] * rf; } \
        if (HASQK) { if (mp == 0) D3_WAITBAR(T); } \
        } while (0)
        DF_BARV();
        D3_STEP(pA0, pA1, pB0, pB1, true, false, true, 0);
        int t = 1;
        for (; t + 1 < NT; t += 2) {
            D3_STEP(pB0, pB1, pA0, pA1, true, true, false, t);
            D3_STEP(pA0, pA1, pB0, pB1, true, true, false, t + 1);
        }
        D3_STEP(pB0, pB1, pA0, pA1, true, true, false, t);
        D3_STEP(pA0, pA1, pB0, pB1, false, true, false, NT);
        l = hsum(l);
        const float il = 1.f / l;
        DF_BAR();
        LAS float* xch = (LAS float*)lds + qsub * 4096 + lane;
        if (mp == 1) { const float sc = il * A.lam;
#pragma unroll
            for (int d = 0; d < 4; ++d)
#pragma unroll
                for (int q = 0; q < 16; ++q) xch[(d * 16 + q) * 64] = oT[d][q] * sc; }
        DF_BAR();
        if (mp == 0) {
            float ss = 0.f;
#pragma unroll
            for (int d = 0; d < 4; ++d)
#pragma unroll
                for (int q = 0; q < 16; ++q) { const float v = oT[d][q] * il - xch[(d * 16 + q) * 64]; oT[d][q] = v; ss += v * v; }
            ss = hsum(ss);
            const float rstd = rsqrtf(ss * (1.f / 128.f) + RMS_EPS) * A.omli;
            LAS unsigned char* stg = lds + qsub * 16384;
#pragma unroll
            for (int d = 0; d < 4; ++d)
#pragma unroll
                for (int g = 0; g < 4; ++g) { const f32x4 gg = *(const f32x4*)(A.subln_g + d * 32 + 8 * g + 4 * hi);
                    u32x2 w; w.x = cvtpk(oT[d][4 * g] * rstd * gg[0], oT[d][4 * g + 1] * rstd * gg[1]); w.y = cvtpk(oT[d][4 * g + 2] * rstd * gg[2], oT[d][4 * g + 3] * rstd * gg[3]);
                    *(LAS u32x2*)(stg + r32 * 272 + (d * 32 + 8 * g + 4 * hi) * 2) = w; }
            stg_flush<4>(stg, A.y + (size_t)qrow0 * DM + h * 128, lane);
        }
        DF_BAR();
#undef D3_DMA
#undef D3_KF
#undef D3_KSEL
#undef D3_VF
#undef D3_PK
#undef D3_GA
#undef D3_GB
#undef D3_EXI
#undef D3_PWSEL
#undef D3_STEP
#undef D3_WAITBAR
    }
}

struct A2Args { const bf16_t* qkv; bf16_t* y; const float* aux; int with_ctx; };
template <int MODE  >
__device__ __forceinline__ void att2_phase(LAS unsigned char* lds, const A2Args A, int vcu, int G) {
    int tid = threadIdx.x; asm volatile("" : "+v"(tid));
    const int lane = tid & 63, r32 = lane & 31, hi = lane >> 5; const int wid = __builtin_amdgcn_readfirstlane(tid >> 6);
    constexpr int P = MODE == 0 ? 1536 : 3072; constexpr int VOFF = MODE == 0 ? 256 : 1024;
    const unsigned lds0 = (unsigned)(uintptr_t)lds;
    const lds_cptr l3 = (lds_cptr)lds;
    const int grp = wid >> 2;
    LAS float* btab = (LAS float*)(lds + NA_BIAS_OFF + 1024);
    const int nmain = MODE == 0 ? NB * 4 * 32 * 2 : NB * 16 * 16;
    const int nunits = nmain + (A.with_ctx ? (MODE == 0 ? NB * 4 * 4 : NB * 16) : 0);
    for (int u = vcu; u < nunits; u += G) {
        int b, hk, hq, qrow0, nwin, k0win; const bool ctxu = u >= nmain; int qs = 0, r = 0, c = 0;
        if (MODE == 0) {
            if (!ctxu) { const int hp = u & 1, j = (u >> 1) & 31; hk = (u >> 6) & 3; b = u >> 8; hq = 4 * hk + 2 * hp + (wid >> 2); qs = 128 * j + 32 * (wid & 3); qrow0 = b * SEQ + qs;
                const int ks = max(0, 128 * (j - 1)), ke = min(SEQ, 128 * (j + 2)); k0win = ks; nwin = (ke - ks) / 64; }
            else { const int v = u - nmain; hk = (v >> 2) & 3; hq = 4 * hk + (v & 3); b = v >> 4; qrow0 = MX + b * CTXL + 32 * wid; nwin = 0; k0win = 0; }
        } else {
            if (!ctxu) { const int uu = u & 15; hk = hq = (u >> 4) & 15; b = u >> 8; r = 4 * uu + (wid >> 1); c = 32 * (wid & 1) + r32; qrow0 = b * SEQ + r * 64 + 32 * (wid & 1);
                const int rs_lo = min(max(4 * uu - 4, 0), 56), rs_hi = min(max(4 * uu + 3 - 4, 0), 56); k0win = rs_lo * 64; nwin = rs_hi + 8 - rs_lo; }
            else { const int v = u - nmain; hk = hq = v & 15; b = v >> 4; qrow0 = MX + b * CTXL + 32 * wid; nwin = 0; k0win = 0; }
        }
        const int NT = 4 + nwin;
        const bf16_t* Kc = A.qkv + (size_t)(MX + b * CTXL) * P + 1024 + 64 * hk;
        const bf16_t* Kx = A.qkv + (size_t)(b * SEQ + k0win) * P + 1024 + 64 * hk;
        const int krow = 8 * wid + (lane >> 3); const size_t koff = (size_t)krow * P + (((lane & 7) ^ ((krow >> 1) & 7)) * 8), voff = (size_t)krow * P + VOFF + (((lane & 7) ^ (((krow >> 1) & 1) << 2)) * 8);
#define A2_DMA(t) do { if ((t) < NT) { const int slot_ = (t) % 3; const bf16_t* base_ = ((t) < 4) ? Kc + (size_t)(t) * 64 * P : Kx + (size_t)((t) - 4) * 64 * P; \
        glds16(base_ + koff, (unsigned)__builtin_amdgcn_readfirstlane(lds0 + slot_ * 16384 + wid * 1024)); \
        glds16(base_ + voff, (unsigned)__builtin_amdgcn_readfirstlane(lds0 + slot_ * 16384 + 8192 + wid * 1024)); } } while (0)
        A2_DMA(0);
        if (MODE == 1) { if (!ctxu && tid < 15 * 31) btab[tid] = A.aux[hq * 465 + tid] * LOG2E; }
        bf16x8 qr[4];
        { const bf16_t* Qw = A.qkv + (size_t)(qrow0 + r32) * P + hq * 64;
#pragma unroll
          for (int d0 = 0; d0 < 4; ++d0) qr[d0] = *(const bf16x8*)(Qw + d0 * 16 + hi * 8); }
        f32x16 oT[2]; oT[0] = f32x16{}; oT[1] = f32x16{};
        float m = 0.f, l = 0.f;
        f32x16 p0, p1; u32x4 pw[4];
        const int ksw = (r32 >> 1) & 7; const lds_cptr kp0 = l3 + r32 * 128 + ((hi ^ (ksw & 1)) << 4); const int ks2 = ksw >> 1;
        const int vq = (lane & 15) >> 2, vsq = (vq >> 1) & 1; const lds_cptr vp0 = l3 + 8192 + (4 * hi + vq) * 128 + ((lane >> 4) & 1) * 32 + (lane & 3) * 8;
        const int rs = min(max(r - 4, 0), 56), cs = min(max(c - 8, 0), 48);
#define A2_LOADV(dst, vp_, d) do { const lds_cptr vd_ = (vp_) + (((d) ^ vsq) << 6); _Pragma("unroll") for (int ks = 0; ks < 4; ++ks) { const s16x4 lo_ = vtr(vd_ + ks * 2048), hi_ = vtr(vd_ + ks * 2048 + 1024); \
            dst[ks] = (bf16x8){lo_[0], lo_[1], lo_[2], lo_[3], hi_[0], hi_[1], hi_[2], hi_[3]}; } } while (0)
#define A2_PV4(src, d) do { _Pragma("unroll") for (int ks = 0; ks < 4; ++ks) oT[d] = __builtin_amdgcn_mfma_f32_32x32x16_bf16(src[ks], __builtin_bit_cast(bf16x8, pw[ks]), oT[d], 0, 0, 0); } while (0)
#define A2_LOADK(dst, kb_, dd) do { dst[0] = *(const LAS bf16x8*)((kb_) + ((((dd)) ^ ks2) << 5)); dst[1] = *(const LAS bf16x8*)((kb_) + ((((dd)) ^ ks2) << 5) + 4096); \
            dst[2] = *(const LAS bf16x8*)((kb_) + ((((dd) + 1) ^ ks2) << 5)); dst[3] = *(const LAS bf16x8*)((kb_) + ((((dd) + 1) ^ ks2) << 5) + 4096); } while (0)
#define A2_QK4(src, dd) do { p0 = __builtin_amdgcn_mfma_f32_32x32x16_bf16(src[0], qr[dd], p0, 0, 0, 0); p1 = __builtin_amdgcn_mfma_f32_32x32x16_bf16(src[1], qr[dd], p1, 0, 0, 0); \
            p0 = __builtin_amdgcn_mfma_f32_32x32x16_bf16(src[2], qr[(dd) + 1], p0, 0, 0, 0); p1 = __builtin_amdgcn_mfma_f32_32x32x16_bf16(src[3], qr[(dd) + 1], p1, 0, 0, 0); } while (0)
#define A2_PREV(vso) do { const lds_cptr vq_ = vp0 + (vso); A2_LOADV(fa, vq_, 0); A2_LOADV(fb, vq_, 1); SBAR(); } while (0)
#define A2_PINIT() do { _Pragma("unroll") for (int q_ = 0; q_ < 16; ++q_) { p0[q_] = -m; p1[q_] = -m; } } while (0)
#define A2_SEGM(DO_PV, DO_QK, vso, kso) do { const lds_cptr kb_ = kp0 + (kso); SBAR(); __builtin_amdgcn_s_setprio(1); \
        if (DO_PV) { A2_PV4(fa, 0); if (DO_QK) { A2_PINIT(); } SBAR(); if (DO_QK) { A2_LOADK(fa, kb_, 0); } SBAR(); A2_PV4(fb, 1); SBAR(); if (DO_QK) { A2_LOADK(fb, kb_, 2); } SBAR(); } \
        else if (DO_QK) { A2_LOADK(fa, kb_, 0); A2_LOADK(fb, kb_, 2); A2_PINIT(); SBAR(); } \
        if (DO_QK) { A2_QK4(fa, 0); SBAR(); A2_QK4(fb, 2); SBAR(); } \
        __builtin_amdgcn_s_setprio(0); } while (0)
#define A2_SEGV(t) do { \
        if ((t) >= 4) { \
            if (MODE == 0) { const int kb0_ = k0win + 64 * ((t) - 4); if ((kb0_ + 63 > qs + 128) || (kb0_ < qs + 31 - 128)) { const int dq_ = kb0_ + 4 * hi - (qs + r32) + 128; \
                _Pragma("unroll") for (int q_ = 0; q_ < 16; ++q_) { const int kk_ = (q_ & 3) + 8 * (q_ >> 2); if ((unsigned)(dq_ + kk_) > 256u) p0[q_] = NEG_BIG; if ((unsigned)(dq_ + kk_ + 32) > 256u) p1[q_] = NEG_BIG; } } } \
            else { const int kr_ = (k0win >> 6) + (t) - 4; const bool rowok_ = (kr_ >= rs) && (kr_ < rs + 8); const int rel_ = rowok_ ? 4 * hi - cs : 1000; const LAS float* bp_ = btab + (rowok_ ? kr_ - r + 7 : 0) * 31 + 4 * hi - c + 15; \
                _Pragma("unroll") for (int q_ = 0; q_ < 16; ++q_) { const int kk_ = (q_ & 3) + 8 * (q_ >> 2); const float b0_ = bp_[kk_], b1_ = bp_[kk_ + 32]; \
                    p0[q_] = ((unsigned)(rel_ + kk_) < 16u) ? p0[q_] + b0_ : NEG_BIG; p1[q_] = ((unsigned)(rel_ + kk_ + 32) < 16u) ? p1[q_] + b1_ : NEG_BIG; } } } \
        float rm = p0[0]; \
        _Pragma("unroll") for (int q_ = 1; q_ < 16; ++q_) rm = fmaxf(rm, p0[q_]); \
        _Pragma("unroll") for (int q_ = 0; q_ < 16; ++q_) rm = fmaxf(rm, p1[q_]); \
        rm = hmax(rm); \
        if ((t) == 0 || __any(rm > DF_THR)) { const float dl = ((t) == 0) ? rm : fmaxf(rm, 0.f); m += dl; \
            _Pragma("unroll") for (int q_ = 0; q_ < 16; ++q_) { p0[q_] -= dl; p1[q_] -= dl; } \
            const float f = __builtin_amdgcn_exp2f(-dl); l *= f; oT[0] = oT[0] * f; oT[1] = oT[1] * f; } \
        float s_ = 0.f; \
        _Pragma("unroll") for (int q_ = 0; q_ < 16; ++q_) { p0[q_] = __builtin_amdgcn_exp2f(p0[q_]); p1[q_] = __builtin_amdgcn_exp2f(p1[q_]); s_ += p0[q_] + p1[q_]; } \
        l += s_; \
        _Pragma("unroll") for (int k = 0; k < 2; ++k) { \
            pw[k]     = (u32x4){cvtpk(p0[8 * k], p0[8 * k + 1]), cvtpk(p0[8 * k + 2], p0[8 * k + 3]), cvtpk(p0[8 * k + 4], p0[8 * k + 5]), cvtpk(p0[8 * k + 6], p0[8 * k + 7])}; \
            pw[2 + k] = (u32x4){cvtpk(p1[8 * k], p1[8 * k + 1]), cvtpk(p1[8 * k + 2], p1[8 * k + 3]), cvtpk(p1[8 * k + 4], p1[8 * k + 5]), cvtpk(p1[8 * k + 6], p1[8 * k + 7])}; } \
        } while (0)
        DF_BARV();
        int so_p = 0, so_c = 0;
#define A2_ROT() do { so_p = so_c; so_c = (so_c == 32768) ? 0 : so_c + 16384; } while (0)
        bf16x8 fa[4], fb[4];
        if (grp == 0) {
            A2_DMA(1); A2_SEGM(false, true, 0, so_c); SBAR(); A2_PREV(so_c); A2_SEGV(0); SBAR(); DF_BARV(); SBAR();
            for (int t = 1; t < NT; ++t) { A2_ROT();
                A2_DMA(t + 1); A2_SEGM(true, true, so_p, so_c); SBAR(); A2_PREV(so_c); A2_SEGV(t); SBAR(); DF_BARV(); SBAR(); }
            A2_ROT();
            A2_SEGM(true, false, so_p, 0); SBAR(); DF_BARV(); SBAR();
        } else {
            A2_DMA(1); A2_SEGM(false, true, 0, so_c); SBAR(); DF_BARV(); SBAR();
            for (int t = 1; t < NT; ++t) { A2_ROT();
                A2_DMA(t + 1); A2_PREV(so_p); A2_SEGV(t - 1); SBAR(); A2_SEGM(true, true, so_p, so_c); SBAR(); DF_BARV(); SBAR(); }
            A2_ROT();
            A2_PREV(so_p); A2_SEGV(NT - 1); SBAR(); A2_SEGM(true, false, so_p, 0); SBAR(); DF_BARV(); SBAR();
        }
        l = hsum(l);
        if (MODE == 0) l += __builtin_amdgcn_exp2f(A.aux[hq] * LOG2E - m);
        if (OUTPROJ_FP8) store_oT<2>(oT, 1.f / l, A.y, (size_t)(qrow0 + r32) * DM + hq * 64, hi);
        else { LAS unsigned char* stg = lds + wid * 8192; const float sc_ = 1.f / l;
#pragma unroll
            for (int d = 0; d < 2; ++d)
#pragma unroll
                for (int g = 0; g < 4; ++g) { u32x2 w; w.x = cvtpk(oT[d][4 * g] * sc_, oT[d][4 * g + 1] * sc_); w.y = cvtpk(oT[d][4 * g + 2] * sc_, oT[d][4 * g + 3] * sc_);
                    *(LAS u32x2*)(stg + r32 * 144 + (d * 32 + 8 * g + 4 * hi) * 2) = w; }
            stg_flush<2>(stg, A.y + (size_t)qrow0 * DM + hq * 64, lane); }
        DF_BAR();
#undef A2_DMA
#undef A2_LOADV
#undef A2_PV4
#undef A2_LOADK
#undef A2_QK4
#undef A2_SEGM
#undef A2_SEGV
#undef A2_PREV
#undef A2_PINIT
#undef A2_ROT
    }
}
#undef SBAR
}

struct Frame {
    LAS unsigned char* lds; volatile LAS unsigned* MISC; unsigned* ctl;
    int tid, lane, wave, vcu, G;
};

__device__ __forceinline__ void transpose_item(const float* W, int K, int N, bf16_t* WT, int k0, int n0, int drow0, LAS float* scr, int lane) {
    f32x4 v[16];
    const float* src = W + (size_t)(k0 + (lane >> 4)) * N + n0 + 4 * (lane & 15);
#pragma unroll
    for (int i = 0; i < 16; ++i) v[i] = *(const f32x4*)(src + (size_t)(4 * i) * N);
#pragma unroll
    for (int i = 0; i < 16; ++i) { LAS float* d = scr + (4 * i + (lane >> 4)) * 65 + 4 * (lane & 15); d[0] = v[i].x; d[1] = v[i].y; d[2] = v[i].z; d[3] = v[i].w; }
    LDS_WAIT(); asm volatile("" ::: "memory");
    const int c = lane & 7;
#pragma unroll
    for (int j = 0; j < 8; ++j) { const int n = (lane >> 3) + 8 * j; const LAS float* s = scr + (8 * c) * 65 + n;
        u32x4 o; o.x = cvtpk(s[0 * 65], s[1 * 65]); o.y = cvtpk(s[2 * 65], s[3 * 65]); o.z = cvtpk(s[4 * 65], s[5 * 65]); o.w = cvtpk(s[6 * 65], s[7 * 65]);
        *(u32x4*)(WT + (size_t)(drow0 + n) * K + k0 + 8 * c) = o; }
    LDS_WAIT(); asm volatile("" ::: "memory");
}

enum { KA_x, KA_c, KA_ctx, KA_c_ctx, KA_ada_w, KA_ada_b, KA_norm1_g, KA_norm2_g, KA_final_g, KA_win_w_in, KA_win_w_out, KA_win_sink, KA_diff_w_in, KA_diff_w_out, KA_diff_lambda, KA_diff_subln_g,
       KA_na_w_in, KA_na_w_out, KA_na_rpb, KA_router_w, KA_w_gate, KA_w_up, KA_w_down, KA_OUT, KA_WS };
__device__ __forceinline__ const float* karg(int i) { asm volatile("" : "+s"(i)); return (const float*)(((const unsigned long long __attribute__((address_space(4)))*)__builtin_amdgcn_kernarg_segment_ptr())[i]); }
__device__ __forceinline__ void t8_load(f32x4 (&v)[16], const float* W, int N, int k0, int n0, int lane) {
    const float* src = W + (size_t)(k0 + (lane >> 4)) * N + n0 + 4 * (lane & 15);
#pragma unroll
    for (int i = 0; i < 16; ++i) v[i] = *(const f32x4*)(src + (size_t)(4 * i) * N);
}
__device__ __forceinline__ void t8_finish(const f32x4 (&v)[16], int Kb, unsigned char* WT, int k0, int drow0, LAS float* scr, int lane) {
#pragma unroll
    for (int i = 0; i < 16; ++i) { LAS float* d = scr + (4 * i + (lane >> 4)) * 65 + 4 * (lane & 15); d[0] = v[i].x * W8_SCALE; d[1] = v[i].y * W8_SCALE; d[2] = v[i].z * W8_SCALE; d[3] = v[i].w * W8_SCALE; }
    LDS_WAIT(); asm volatile("" ::: "memory");
    const int c = lane & 3;
#pragma unroll
    for (int j = 0; j < 4; ++j) { const int n = (lane >> 2) + 16 * j; const LAS float* s = scr + (16 * c) * 65 + n;
        int w[4];
#pragma unroll
        for (int q = 0; q < 4; ++q) { int t = 0; t = __builtin_amdgcn_cvt_pk_fp8_f32(s[(4 * q) * 65], s[(4 * q + 1) * 65], t, false); t = __builtin_amdgcn_cvt_pk_fp8_f32(s[(4 * q + 2) * 65], s[(4 * q + 3) * 65], t, true); w[q] = t; }
        *(u32x4*)(WT + (size_t)(drow0 + n) * Kb + k0 + 16 * c) = (u32x4){(unsigned)w[0], (unsigned)w[1], (unsigned)w[2], (unsigned)w[3]}; }
    LDS_WAIT(); asm volatile("" ::: "memory");
}
__device__ __forceinline__ void transpose_item8(const float* W, int Kb, int N, unsigned char* WT, int k0, int n0, int drow0, LAS float* scr, int lane) {
    f32x4 v[16]; t8_load(v, W, N, k0, n0, lane); t8_finish(v, Kb, WT, k0, drow0, scr, lane);
}

struct In {
    const float *x, *c, *ctx, *c_ctx, *ada_w, *ada_b, *norm1_g, *norm2_g, *final_g, *win_w_in, *win_w_out, *win_sink, *diff_w_in, *diff_w_out, *diff_lambda, *diff_subln_g,
        *na_w_in, *na_w_out, *na_rpb, *router_w, *w_gate, *w_up, *w_down;
};

__device__ __forceinline__ void phase_prologue(Frame& F, unsigned char* ws) {
    int tid_ = threadIdx.x; asm volatile("" : "+v"(tid_)); const int lane_ = tid_ & 63; const int wave_ = __builtin_amdgcn_readfirstlane(tid_ >> 6);
    LAS float* scr = (LAS float*)(F.lds + wave_ * 16640);
    const int gw = F.vcu * NWAVES + wave_, NGW = F.G * NWAVES;
    if (F.vcu == 0) {
        float* tab = (float*)(ws + WS_TAB);
        for (int i = tid_; i < 1024; i += 512) { const int pos = i >> 4, f = i & 15; const float inv = 1.0f / powf(10000.0f, (float)(2 * f) / 32.0f); const float ang = (float)pos * inv;
            tab[TAB_COS + i] = cosf(ang); tab[TAB_SIN + i] = sinf(ang); }
        if (wave_ == 0) { const float* lp = karg(KA_diff_lambda); const float a = wave_sum(lp[lane_] * lp[64 + lane_]), b2 = wave_sum(lp[128 + lane_] * lp[192 + lane_]);
            const float li = 0.8f - 0.6f * expf(-0.3f * 1.0f); if (lane_ == 0) { tab[TAB_LAM] = expf(a) - expf(b2) + li; tab[TAB_LAM + 1] = 1.0f - li; } }
    }
    {
        bf16_t* pw = (bf16_t*)(ws + WS_PW);
        constexpr int IT_WI = 16 * 24, IT_O = 16 * 16, IT_3 = 16 * 48;
        constexpr int NIT = 2 * IT_WI + 2 * IT_O + IT_3 + IT_O + IT_3 + IT_O;
        for (int it = gw; it < NIT; it += NGW) {
            int r = it; const float* W; bf16_t* WT; int N;
            if (r < 2 * IT_WI) { const int s = r / IT_WI; r -= s * IT_WI; W = karg(KA_win_w_in) + (size_t)s * 1024 * 1536; WT = pw + (PW_WIN_IN / 2) + (size_t)s * 1536 * 1024; N = 1536; }
            else if ((r -= 2 * IT_WI) < 2 * IT_O) { const int s = r / IT_O; r -= s * IT_O; W = karg(KA_win_w_out) + (size_t)s * 1024 * 1024; WT = pw + (PW_WIN_OUT / 2) + (size_t)s * 1024 * 1024; N = 1024; }
            else if ((r -= 2 * IT_O) < IT_3) { W = karg(KA_diff_w_in); WT = pw + PW_DIFF_IN / 2; N = 3072; }
            else if ((r -= IT_3) < IT_O) { W = karg(KA_diff_w_out); WT = pw + PW_DIFF_OUT / 2; N = 1024; }
            else if ((r -= IT_O) < IT_3) { W = karg(KA_na_w_in); WT = pw + PW_NA_IN / 2; N = 3072; }
            else { r -= IT_3; W = karg(KA_na_w_out); WT = pw + PW_NA_OUT / 2; N = 1024; }
            const int nblk = N / 64, kb = r / nblk, nb = r % nblk;
            if ((INPROJ_FP8 && N != 1024) || (OUTPROJ_FP8 && N == 1024)) transpose_item8(W, 1024, N, (unsigned char*)WT, 64 * kb, 64 * nb, 64 * nb, scr, lane_);
            else transpose_item(W, 1024, N, WT, 64 * kb, 64 * nb, 64 * nb, scr, lane_);
        }
    }
    {
        const int NIT = 64 * 1536;
#define MW_DESC(it_, W_, N_, Kb_, WT_, k0_, n0_, dr_) do { const int le_ = (it_) / 1536; int r_ = (it_) % 1536; \
            unsigned char* W1t_ = ws + WS_MOEW + (size_t)le_ * MOEW_E; \
            if (r_ < 1024) { const bool up_ = r_ >= 512; r_ &= 511; W_ = (up_ ? karg(KA_w_up) : karg(KA_w_gate)) + (size_t)le_ * 1024 * 2048; N_ = 2048; Kb_ = 1024; WT_ = W1t_; \
                k0_ = 64 * (r_ / 32); n0_ = 64 * (r_ % 32); dr_ = (n0_ >> 7) * 256 + (up_ ? 128 : 0) + (n0_ & 127); } \
            else { r_ -= 1024; W_ = karg(KA_w_down) + (size_t)le_ * 2048 * 1024; N_ = 1024; Kb_ = 2048; WT_ = W1t_ + (size_t)4096 * 1024; k0_ = 64 * (r_ / 16); n0_ = 64 * (r_ % 16); dr_ = n0_; } } while (0)
        f32x4 va[16], vb[16];
        const float* Wc = nullptr; int Nc = 0, Kbc = 0, k0c = 0, n0c = 0, drc = 0; unsigned char* WTc = nullptr;
        int it = gw;
        if (it < NIT) { MW_DESC(it, Wc, Nc, Kbc, WTc, k0c, n0c, drc); t8_load(va, Wc, Nc, k0c, n0c, lane_); }
        while (it < NIT) {
            const int itn = it + NGW;
            const float* Wn = Wc; int Nn = Nc, Kbn = Kbc, k0n = k0c, n0n = n0c, drn = drc; unsigned char* WTn = WTc;
            if (itn < NIT) { MW_DESC(itn, Wn, Nn, Kbn, WTn, k0n, n0n, drn); t8_load(vb, Wn, Nn, k0n, n0n, lane_); }
            t8_finish(va, Kbc, WTc, k0c, drc, scr, lane_);
#pragma unroll
            for (int i = 0; i < 16; ++i) va[i] = vb[i];
            Wc = Wn; Nc = Nn; Kbc = Kbn; WTc = WTn; k0c = k0n; n0c = n0n; drc = drn; it = itn;
        }
#undef MW_DESC
    }
    __syncthreads();
    {
        LAS float* sc = (LAS float*)F.lds;
        LAS float* red = (LAS float*)(F.lds + 69632);
        for (int i = tid_; i < 17 * 1024; i += 512) { const float v = (i < 16384) ? karg(KA_c)[i] : karg(KA_c_ctx)[i - 16384]; sc[i] = siluf(v); }
        __syncthreads();
        float* mod = (float*)(ws + WS_MOD);
        for (int task = F.vcu; task < 4 * 192; task += F.G) {
            const int L = task / 192, cg = task % 192, col = cg * 32 + (lane_ & 31), kh = lane_ >> 5;
            const float* wp = karg(KA_ada_w) + (size_t)L * 1024 * 6144 + (size_t)(wave_ * 128 + kh * 64) * 6144 + col;
            const LAS float* scp = sc + wave_ * 128 + kh * 64;
            float acc[17];
#pragma unroll
            for (int r = 0; r < 17; ++r) acc[r] = 0.f;
            for (int k0 = 0; k0 < 64; k0 += 16) { float w[16];
#pragma unroll
                for (int kk = 0; kk < 16; ++kk) w[kk] = wp[(size_t)(k0 + kk) * 6144];
#pragma unroll
                for (int kk = 0; kk < 16; ++kk)
#pragma unroll
                    for (int r = 0; r < 17; ++r) acc[r] += scp[r * 1024 + k0 + kk] * w[kk]; }
#pragma unroll
            for (int r = 0; r < 17; ++r) { acc[r] += __shfl_xor(acc[r], 32); if (lane_ < 32) red[(wave_ * 17 + r) * 32 + lane_] = acc[r]; }
            __syncthreads();
            for (int i = tid_; i < 17 * 32; i += 512) { const int r = i >> 5, ln = i & 31; float sum = 0.f;
#pragma unroll
                for (int w = 0; w < 8; ++w) sum += red[(w * 17 + r) * 32 + ln];
                mod[((size_t)L * 17 + r) * 6144 + cg * 32 + ln] = sum + karg(KA_ada_b)[L * 6144 + cg * 32 + ln]; }
            __syncthreads();
        }
    }
}

__device__ __forceinline__ void load_row(const float* row, int lane, f32x4 (&v)[4]) {
    const f32x4* xr = (const f32x4*)row + lane;
#pragma unroll
    for (int j = 0; j < 4; ++j) v[j] = xr[64 * j];
}
__device__ __forceinline__ void load_row_bf16(const bf16_t* row, int lane, u32x2 (&w)[4]) {
    const u32x2* p = (const u32x2*)row + lane;
#pragma unroll
    for (int j = 0; j < 4; ++j) w[j] = p[64 * j];
}
__device__ __forceinline__ void cvt_row_bf16(f32x4 (&v)[4], const u32x2 (&w)[4]) {
#pragma unroll
    for (int j = 0; j < 4; ++j) { v[j].x = __builtin_bit_cast(float, w[j].x << 16); v[j].y = __builtin_bit_cast(float, w[j].x & 0xffff0000u);
        v[j].z = __builtin_bit_cast(float, w[j].y << 16); v[j].w = __builtin_bit_cast(float, w[j].y & 0xffff0000u); }
}
__device__ __forceinline__ void add_row_bf16(f32x4 (&v)[4], const u32x2 (&w)[4]) {
#pragma unroll
    for (int j = 0; j < 4; ++j) { v[j].x += __builtin_bit_cast(float, w[j].x << 16); v[j].y += __builtin_bit_cast(float, w[j].x & 0xffff0000u);
        v[j].z += __builtin_bit_cast(float, w[j].y << 16); v[j].w += __builtin_bit_cast(float, w[j].y & 0xffff0000u); }
}
__device__ __forceinline__ float row_rstd(const f32x4 (&v)[4]) {
    float s = 0.f;
#pragma unroll
    for (int j = 0; j < 4; ++j) s += (v[j].x * v[j].x + v[j].y * v[j].y) + (v[j].z * v[j].z + v[j].w * v[j].w);
    return rsqrtf(wave_sum_fast(s) * (1.f / DM) + RMS_EPS);
}
__device__ __forceinline__ void store_row_bf16(bf16_t* orow, int lane, const f32x4 (&v)[4]) {
    u32x2* o8 = (u32x2*)orow + lane;
#pragma unroll
    for (int j = 0; j < 4; ++j) { u32x2 w; w.x = cvtpk(v[j].x, v[j].y); w.y = cvtpk(v[j].z, v[j].w); o8[64 * j] = w; }
}
__device__ __forceinline__ void store_row_fp8(unsigned char* orow, int lane, const f32x4 (&v)[4], float scale) {
    unsigned* o4 = (unsigned*)orow + lane;
#pragma unroll
    for (int j = 0; j < 4; ++j) { int t = 0; t = __builtin_amdgcn_cvt_pk_fp8_f32(v[j].x * scale, v[j].y * scale, t, false); t = __builtin_amdgcn_cvt_pk_fp8_f32(v[j].z * scale, v[j].w * scale, t, true); o4[64 * j] = (unsigned)t; }
}
struct ModCache { f32x4 sc[4], sh[4]; int b; };
__device__ __forceinline__ void modcache_load(ModCache& M, int b, const float* g, const float* modL, int shift_chunk, int scale_chunk, int lane) {
    if (M.b == b) return; M.b = b;
    const float* mp = modL + (size_t)b * 6144;
#pragma unroll
    for (int j = 0; j < 4; ++j) { const f32x4 gg = ((const f32x4*)g)[lane + 64 * j], s = ((const f32x4*)(mp + scale_chunk * DM))[lane + 64 * j];
        M.sc[j] = gg * (1.f + s); M.sh[j] = ((const f32x4*)(mp + shift_chunk * DM))[lane + 64 * j]; }
}
__device__ __forceinline__ int row_batch(int m) { return m < MX ? (m >> 12) : 16; }

__device__ __forceinline__ void phase_norm1(Frame& F, const float* x, const float* ctx, const float* g1, const float* modL, bf16_t* H, bf16_t* XB) {
    int tid_ = threadIdx.x; asm volatile("" : "+v"(tid_)); const int lane_ = tid_ & 63; const int wave_ = __builtin_amdgcn_readfirstlane(tid_ >> 6);
    const int gw = F.vcu * NWAVES + wave_, NGW = F.G * NWAVES; const int per = (MT + NGW - 1) / NGW;
    ModCache M; M.b = -1;
    const int m0 = gw * per, m1 = min(MT, m0 + per);
    f32x4 nx[4];
    if (m0 < m1) load_row(m0 < MX ? x + (size_t)m0 * DM : ctx + (size_t)(m0 - MX) * DM, lane_, nx);
    for (int m = m0; m < m1; ++m) {
        f32x4 v[4];
#pragma unroll
        for (int j = 0; j < 4; ++j) v[j] = nx[j];
        if (m + 1 < m1) load_row((m + 1) < MX ? x + (size_t)(m + 1) * DM : ctx + (size_t)(m + 1 - MX) * DM, lane_, nx);
        modcache_load(M, row_batch(m), g1, modL, 0, 1, lane_);
        store_row_bf16(XB + (size_t)m * DM, lane_, v);
        const float rstd = row_rstd(v);
#pragma unroll
        for (int j = 0; j < 4; ++j) v[j] = v[j] * rstd * M.sc[j] + M.sh[j];
        if (INPROJ_FP8) store_row_fp8((unsigned char*)H + (size_t)m * DM, lane_, v, H2_SCALE); else store_row_bf16(H + (size_t)m * DM, lane_, v);
    }
}

__device__ __forceinline__ void phase_norm2_router(Frame& F, const bf16_t* XB, const float* g2, const float* modL, const float* rw, unsigned char* H8, float* aff, int nrows, const bf16_t* P, bool do_router = true) {
    int tid_ = threadIdx.x; asm volatile("" : "+v"(tid_)); const int lane = tid_ & 63; const int wave_ = __builtin_amdgcn_readfirstlane(tid_ >> 6);
    LAS float* rwT = (LAS float*)F.lds;
    for (int i = tid_; i < 16384; i += 512) { const int d = i >> 4, e = i & 15; rwT[e * 1024 + d] = rw[i]; }
    __syncthreads();
    const int gw = F.vcu * NWAVES + wave_, NGW = F.G * NWAVES; constexpr int NR2 = 1; const int ngroups = nrows / NR2; const int per = (ngroups + NGW - 1) / NGW;
    ModCache M; M.b = -1;
    const int g0 = gw * per, g1 = min(ngroups, g0 + per);
    constexpr int ND3 = 3;
    u32x2 nx[ND3][4];
#pragma unroll
    for (int k = 0; k < ND3; ++k) if (g0 + k < g1) { load_row_bf16(XB + (size_t)(g0 + k) * DM, lane, nx[k]); }
    for (int gb = g0; gb < g1; gb += ND3)
#pragma unroll
    for (int k = 0; k < ND3; ++k) {
        const int g = gb + k; if (g >= g1) break;
        const int m = NR2 * g;
        f32x4 v[NR2][4];
        cvt_row_bf16(v[0], nx[k]);
        if (g + ND3 < g1) { load_row_bf16(XB + (size_t)(g + ND3) * DM, lane, nx[k]); }
        modcache_load(M, row_batch(m), g2, modL, 3, 4, lane);
#pragma unroll
        for (int r = 0; r < NR2; ++r) { const float rstd = row_rstd(v[r]);
#pragma unroll
            for (int j = 0; j < 4; ++j) v[r][j] = v[r][j] * rstd * M.sc[j] + M.sh[j];
            store_row_fp8(H8 + (size_t)(m + r) * DM, lane, v[r], H2_SCALE); }
        if (!do_router) continue;
        float pe[NR2][16];
        int lo4 = 4 * lane; asm volatile("" : "+v"(lo4));
#pragma unroll
        for (int eb = 0; eb < 16; eb += 4) {
            f32x4 w[4][4];
#pragma unroll
            for (int e4 = 0; e4 < 4; ++e4)
#pragma unroll
                for (int j = 0; j < 4; ++j) w[e4][j] = *(const LAS f32x4*)(rwT + (eb + e4) * 1024 + lo4 + 256 * j);
            __builtin_amdgcn_sched_barrier(0);
#pragma unroll
            for (int e4 = 0; e4 < 4; ++e4) { f32x2 s2 = {0.f, 0.f};
#pragma unroll
                for (int j = 0; j < 4; ++j) { s2 = __builtin_elementwise_fma((f32x2){v[0][j].x, v[0][j].y}, (f32x2){w[e4][j].x, w[e4][j].y}, s2); s2 = __builtin_elementwise_fma((f32x2){v[0][j].z, v[0][j].w}, (f32x2){w[e4][j].z, w[e4][j].w}, s2); }
                pe[0][eb + e4] = s2.x + s2.y; }
            __builtin_amdgcn_sched_barrier(0);
        }
        {
            LAS float* red = (LAS float*)(F.lds + 65536) + wave_ * 1088;
#pragma unroll
            for (int e = 0; e < 16; ++e) red[lane * 17 + e] = pe[0][e];
            const LAS float* rp = red + (lane >> 4) * 272 + (lane & 15);
            float sacc = 0.f;
#pragma unroll
            for (int i = 0; i < 16; ++i) sacc += rp[i * 17];
            sacc += __shfl_xor(sacc, 16); sacc += __shfl_xor(sacc, 32);
            const float mx = row16_max(sacc);
            const float ex = expf(sacc - mx);
            const float sm = row16_sum(ex);
            if (lane < 16) aff[(size_t)m * 16 + lane] = ex / sm;
        }
    }
    __syncthreads();
}

__device__ __forceinline__ void phase_norm2_router_mfma(Frame& F, const bf16_t* XB, const float* g2, const float* modL, const float* rw, unsigned char* H8, float* aff, int nrows) {
    int tid_ = threadIdx.x; asm volatile("" : "+v"(tid_)); const int lane = tid_ & 63; const int wave_ = __builtin_amdgcn_readfirstlane(tid_ >> 6);
    constexpr int AST = 2064;
    LAS unsigned char* Ahi = F.lds; LAS unsigned char* Alo = F.lds + 16 * AST; LAS float* red = (LAS float*)(F.lds + 2 * 16 * AST);
    const int e_ = lane & 15, kg = lane >> 4;
    bf16x8 Bh[4], Bl[4];
#pragma unroll
    for (int s = 0; s < 4; ++s) { const float* wp = rw + (size_t)(128 * wave_ + 32 * s + 8 * kg) * 16 + e_;
        const float x0 = wp[0], x1 = wp[16], x2 = wp[32], x3 = wp[48], x4 = wp[64], x5 = wp[80], x6 = wp[96], x7 = wp[112];
        u32x4 h, l; h.x = cvtpk(x0, x1); h.y = cvtpk(x2, x3); h.z = cvtpk(x4, x5); h.w = cvtpk(x6, x7);
        l.x = cvtpk(x0 - __builtin_bit_cast(float, h.x << 16), x1 - __builtin_bit_cast(float, h.x & 0xffff0000u)); l.y = cvtpk(x2 - __builtin_bit_cast(float, h.y << 16), x3 - __builtin_bit_cast(float, h.y & 0xffff0000u));
        l.z = cvtpk(x4 - __builtin_bit_cast(float, h.z << 16), x5 - __builtin_bit_cast(float, h.z & 0xffff0000u)); l.w = cvtpk(x6 - __builtin_bit_cast(float, h.w << 16), x7 - __builtin_bit_cast(float, h.w & 0xffff0000u));
        Bh[s] = __builtin_bit_cast(bf16x8, h); Bl[s] = __builtin_bit_cast(bf16x8, l); }
    const int ngroups = nrows >> 4; const int per = (ngroups + F.G - 1) / F.G; const int gg0 = F.vcu * per, gg1 = min(ngroups, gg0 + per);
    ModCache M; M.b = -1;
    u32x2 nx[2][4];
    if (gg0 < gg1) { load_row_bf16(XB + (size_t)(gg0 * 16 + 2 * wave_) * DM, lane, nx[0]); load_row_bf16(XB + (size_t)(gg0 * 16 + 2 * wave_ + 1) * DM, lane, nx[1]); }
    for (int gg = gg0; gg < gg1; ++gg) {
        const int mbase = gg * 16;
        f32x4 v[2][4];
        cvt_row_bf16(v[0], nx[0]); cvt_row_bf16(v[1], nx[1]);
        if (gg + 1 < gg1) { load_row_bf16(XB + (size_t)(mbase + 16 + 2 * wave_) * DM, lane, nx[0]); load_row_bf16(XB + (size_t)(mbase + 16 + 2 * wave_ + 1) * DM, lane, nx[1]); }
#pragma unroll
        for (int r = 0; r < 2; ++r) { const int tok = 2 * wave_ + r, m = mbase + tok;
            modcache_load(M, row_batch(m), g2, modL, 3, 4, lane);
            const float rstd = row_rstd(v[r]);
#pragma unroll
            for (int j = 0; j < 4; ++j) v[r][j] = v[r][j] * rstd * M.sc[j] + M.sh[j];
            store_row_fp8(H8 + (size_t)m * DM, lane, v[r], H2_SCALE);
            LAS unsigned char* ah = Ahi + tok * AST + 8 * lane;
#pragma unroll
            for (int j = 0; j < 4; ++j) { const f32x4 x = v[r][j]; u32x2 h, l; h.x = cvtpk(x.x, x.y); h.y = cvtpk(x.z, x.w);
                l.x = cvtpk(x.x - __builtin_bit_cast(float, h.x << 16), x.y - __builtin_bit_cast(float, h.x & 0xffff0000u)); l.y = cvtpk(x.z - __builtin_bit_cast(float, h.y << 16), x.w - __builtin_bit_cast(float, h.y & 0xffff0000u));
                *(LAS u32x2*)(ah + 512 * j) = h; *(LAS u32x2*)(ah + 16 * AST + 512 * j) = l; } }
        __syncthreads();
        f32x4 acc = {0.f, 0.f, 0.f, 0.f};
#pragma unroll
        for (int s = 0; s < 4; ++s) { const LAS unsigned char* ap = Ahi + e_ * AST + 256 * wave_ + 64 * s + 16 * kg;
            const bf16x8 a_h = *(const LAS bf16x8*)ap, a_l = *(const LAS bf16x8*)(ap + 16 * AST);
            acc = __builtin_amdgcn_mfma_f32_16x16x32_bf16(a_h, Bh[s], acc, 0, 0, 0); acc = __builtin_amdgcn_mfma_f32_16x16x32_bf16(a_h, Bl[s], acc, 0, 0, 0); acc = __builtin_amdgcn_mfma_f32_16x16x32_bf16(a_l, Bh[s], acc, 0, 0, 0); }
#pragma unroll
        for (int r = 0; r < 4; ++r) red[wave_ * 256 + (4 * kg + r) * 16 + e_] = acc[r];
        __syncthreads();
        if (tid_ < 256) { float sacc = 0.f;
#pragma unroll
            for (int w = 0; w < 8; ++w) sacc += red[w * 256 + tid_];
            const float mx = row16_max(sacc);
            const float ex = expf(sacc - mx);
            const float sm = row16_sum(ex);
            aff[(size_t)(mbase + (tid_ >> 4)) * 16 + (tid_ & 15)] = ex / sm; }
    }
    __syncthreads();
}

template <int NPT>
__device__ __forceinline__ void topk_task(Frame& F, const float* aff, int rowbase, int n, int cap, int e, int slot_base, unsigned* rowsrc_e, short* slot) {
    int tid_ = threadIdx.x; asm volatile("" : "+v"(tid_)); const int lane_ = tid_ & 63; const int wave_ = __builtin_amdgcn_readfirstlane(tid_ >> 6);
    LAS unsigned* cnt = (LAS unsigned*)F.lds;
    const int tid = tid_, lane = lane_, wave = wave_;
    const bool act = tid * NPT < n;
    unsigned v[NPT];
#pragma unroll
    for (int j = 0; j < NPT; ++j) v[j] = act ? __float_as_uint(aff[(size_t)(rowbase + tid * NPT + j) * 16 + e]) : 0u;
    unsigned T = 0u;
    for (int bit = 30; bit >= 0; --bit) {
        const unsigned cand = T | (1u << bit);
        unsigned c = 0;
#pragma unroll
        for (int j = 0; j < NPT; ++j) c += (act && v[j] >= cand) ? 1u : 0u;
        c = (unsigned)wave_sum((float)c);
        LAS unsigned* cb = cnt + (bit & 1) * 8;
        if (lane == 0) cb[wave] = c;
        __syncthreads();
        unsigned tot = 0;
#pragma unroll
        for (int w = 0; w < 8; ++w) tot += cb[w];
        if (tot >= (unsigned)cap) T = cand;
    }
    unsigned ngt = 0, neq = 0;
#pragma unroll
    for (int j = 0; j < NPT; ++j) { ngt += (act && v[j] > T) ? 1u : 0u; neq += (act && v[j] == T) ? 1u : 0u; }
    unsigned pk = ngt | (neq << 16), inc = pk;
#pragma unroll
    for (int o = 1; o < 64; o <<= 1) { const unsigned t = __shfl_up(inc, o); if (lane >= o) inc += t; }
    LAS unsigned* wtot = cnt + 32;
    __syncthreads();
    if (lane == 63) wtot[wave] = inc;
    __syncthreads();
    unsigned wpre = 0, total = 0;
#pragma unroll
    for (int w = 0; w < 8; ++w) { const unsigned t = wtot[w]; if (w < wave) wpre += t; total += t; }
    const unsigned exc = wpre + inc - pk;
    const unsigned tot_gt = total & 0xffffu;
    const unsigned need_eq = (unsigned)cap - tot_gt;
    unsigned gt_before = exc & 0xffffu, eq_before = exc >> 16;
    if (act) {
#pragma unroll
        for (int j = 0; j < NPT; ++j) {
            const bool g = v[j] > T, q = v[j] == T;
            const bool sel = g || (q && eq_before < need_eq);
            const int tok = tid * NPT + j;
            short sv = -1;
            if (sel) { const unsigned pos = gt_before + min(eq_before, need_eq); sv = (short)(slot_base + pos); rowsrc_e[slot_base + pos] = (unsigned)(rowbase + tok); }
            slot[(size_t)(rowbase + tok) * 16 + e] = sv;
            gt_before += g ? 1u : 0u; eq_before += q ? 1u : 0u;
        }
    }
    __syncthreads();
}
__device__ __forceinline__ void phase_topk(Frame& F, const float* aff, unsigned* rowsrc, short* slot, int nMe, bool with_ctx) {
    const int ntask = NB * NE * (with_ctx ? 2 : 1);
    for (int t = F.vcu; t < ntask; t += F.G) {
        const bool cx = t >= NB * NE; const int tt = cx ? t - NB * NE : t; const int b = tt >> 4, e = tt & 15;
        unsigned* rs_e = rowsrc + (size_t)e * nMe * 256;
        if (!cx) topk_task<8>(F, aff, b * SEQ, SEQ, CAPX, e, b * CAPX, rs_e, slot);
        else topk_task<1>(F, aff, MX + b * CTXL, CTXL, CAPC, e, NB * CAPX + b * CAPC, rs_e, slot);
    }
}

__device__ __forceinline__ void phase_combine(Frame& F, bf16_t* XB, const bf16_t* P, float* xout, const float* modL, const float* aff, const short* slot, const bf16_t* ybuf, int nMe,
                                              int nrows, bool last, const float* gnext, const float* modN, bf16_t* H, const float* final_g, float* dump = nullptr) {
    int tid_ = threadIdx.x; asm volatile("" : "+v"(tid_)); const int lane = tid_ & 63; const int wave_ = __builtin_amdgcn_readfirstlane(tid_ >> 6);
    const int gw = F.vcu * NWAVES + wave_, NGW = F.G * NWAVES; const int per = (nrows + NGW - 1) / NGW;
    ModCache M; M.b = -1;
    f32x4 g2v[4]; int gb = -1;
    const int m0 = gw * per, m1 = min(nrows, m0 + per);
    const size_t estride = (size_t)nMe * 256 * DM;
#define CB_META(m, sv, av) do { sv = (int)slot[(size_t)(m) * 16 + (lane & 15)]; av = aff[(size_t)(m) * 16 + (lane & 15)]; } while (0)
#define CB_ISSUE(m, sv, av, X, Y, AK, REST) do { load_row_bf16(XB + (size_t)(m) * DM, lane, X); \
        unsigned mk_ = (unsigned)__ballot(sv >= 0) & 0xffffu; \
        _Pragma("unroll") for (int k = 0; k < 4; ++k) { \
            if (mk_) { const int e_ = __builtin_ctz(mk_); mk_ &= mk_ - 1u; const int s_ = __builtin_amdgcn_readlane(sv, e_); AK[k] = __builtin_bit_cast(float, __builtin_amdgcn_readlane(__builtin_bit_cast(int, av), e_)); \
                const u32x2* yr_ = (const u32x2*)(ybuf + (size_t)e_ * estride + (size_t)s_ * DM) + lane; \
                _Pragma("unroll") for (int j = 0; j < 4; ++j) Y[k][j] = yr_[64 * j]; } \
            else { AK[k] = 0.f; _Pragma("unroll") for (int j = 0; j < 4; ++j) Y[k][j] = (u32x2){0u, 0u}; } } \
        REST = mk_; } while (0)
    int sv1 = -1, sv2 = -1; float av1 = 0.f, av2 = 0.f;
    u32x2 X[4], Xn[4]; u32x2 Y[4][4], Yn[4][4]; float AK[4], AKn[4]; unsigned rest = 0, restn = 0; int svc = -1, svn = -1; float avc = 0.f, avn = 0.f;
    if (m0 < m1) { CB_META(m0, sv1, av1); CB_ISSUE(m0, sv1, av1, X, Y, AK, rest); svc = sv1; avc = av1; }
    if (m0 + 1 < m1) CB_META(m0 + 1, sv1, av1);
    for (int m = m0; m < m1; ++m) {
        if (m + 1 < m1) { CB_ISSUE(m + 1, sv1, av1, Xn, Yn, AKn, restn); svn = sv1; avn = av1; }
        if (m + 2 < m1) CB_META(m + 2, sv1, av1);
        const int b = row_batch(m);
        if (gb != b) { gb = b;
#pragma unroll
            for (int j = 0; j < 4; ++j) g2v[j] = ((const f32x4*)(modL + (size_t)b * 6144 + 5 * DM))[lane + 64 * j]; }
        f32x4 acc[4];
#pragma unroll
        for (int j = 0; j < 4; ++j) acc[j] = (f32x4){0.f, 0.f, 0.f, 0.f};
#pragma unroll
        for (int k = 0; k < 4; ++k) { const float a = AK[k];
#pragma unroll
            for (int j = 0; j < 4; ++j) { const u32x2 w = Y[k][j];
                acc[j].x += a * __builtin_bit_cast(float, w.x << 16); acc[j].y += a * __builtin_bit_cast(float, w.x & 0xffff0000u);
                acc[j].z += a * __builtin_bit_cast(float, w.y << 16); acc[j].w += a * __builtin_bit_cast(float, w.y & 0xffff0000u); } }
        while (rest) { const int e_ = __builtin_ctz(rest); rest &= rest - 1u; const int s_ = __builtin_amdgcn_readlane(svc, e_); const float a = __builtin_bit_cast(float, __builtin_amdgcn_readlane(__builtin_bit_cast(int, avc), e_));
            const u32x2* yr = (const u32x2*)(ybuf + (size_t)e_ * estride + (size_t)s_ * DM) + lane;
#pragma unroll
            for (int j = 0; j < 4; ++j) { const u32x2 w = yr[64 * j];
                acc[j].x += a * __builtin_bit_cast(float, w.x << 16); acc[j].y += a * __builtin_bit_cast(float, w.x & 0xffff0000u);
                acc[j].z += a * __builtin_bit_cast(float, w.y << 16); acc[j].w += a * __builtin_bit_cast(float, w.y & 0xffff0000u); } }
        f32x4 v[4];
        cvt_row_bf16(v, X);
#pragma unroll
        for (int j = 0; j < 4; ++j) v[j] = v[j] + g2v[j] * acc[j];
        const float rstd = row_rstd(v);
        if (!last) {
            store_row_bf16((dump ? (bf16_t*)dump : XB) + (size_t)m * DM, lane, v);
            modcache_load(M, b, gnext, modN, 0, 1, lane);
#pragma unroll
            for (int j = 0; j < 4; ++j) v[j] = v[j] * rstd * M.sc[j] + M.sh[j];
            if (INPROJ_FP8) store_row_fp8((unsigned char*)H + (size_t)m * DM, lane, v, H2_SCALE); else store_row_bf16(H + (size_t)m * DM, lane, v);
        } else {
            f32x4* o = (f32x4*)((dump ? dump : xout) + (size_t)m * DM) + lane;
#pragma unroll
            for (int j = 0; j < 4; ++j) o[64 * j] = v[j] * rstd * ((const f32x4*)final_g)[lane + 64 * j];
        }
#pragma unroll
        for (int j = 0; j < 4; ++j) { X[j] = Xn[j];
#pragma unroll
            for (int k = 0; k < 4; ++k) Y[k][j] = Yn[k][j]; }
#pragma unroll
        for (int k = 0; k < 4; ++k) AK[k] = AKn[k];
        rest = restn; svc = svn; avc = avn;
    }
#undef CB_META
#undef CB_ISSUE
}

struct Args { In in; float* out; unsigned char* ws; int ph_lo, ph_hi; };
#define WSP(off) ((unsigned char*)karg(KA_WS) + (off))
__global__ void __launch_bounds__(NWAVES * 64, 2) fwd(Args args) {
    extern __shared__ __attribute__((aligned(16))) unsigned char lds_raw[];
    Frame F;
    F.lds = (LAS unsigned char*)lds_raw;
    F.MISC = (volatile LAS unsigned*)(F.lds + MISC_OFF);
    F.tid = threadIdx.x; F.lane = F.tid & 63; F.wave = __builtin_amdgcn_readfirstlane(F.tid >> 6);
    F.G = gridDim.x; { const int bx = blockIdx.x; F.vcu = (F.G % 8 == 0) ? (bx % 8) * (F.G / 8) + bx / 8 : bx; }
    F.ctl = nullptr;
    if (F.tid < 64) ((LAS unsigned*)(F.lds + MISC_OFF))[F.tid] = 0u;
    __syncthreads();
    const int lo = args.ph_lo, hi = args.ph_hi;
    if (hi - lo > 1) (void)xcd_barrier_post((unsigned*)WSP(WS_CTL) + 1024, F.MISC + 8);
#ifndef DBG_ONLY
#define DBG_ONLY -1
#endif
#define PHEN(k) (DBG_ONLY < 0 || ((k) < 2 ? (k) : 2 + (((k) - 2) & 7)) == DBG_ONLY)
#define IN(k) (PHEN(k) && lo <= (k) && (k) < hi)
#ifndef ROUTER_MFMA
#define ROUTER_MFMA 1
#endif
#ifndef DUP_PH
#define DUP_PH -1
#endif
#ifndef DUP_LMASK
#define DUP_LMASK 0xF
#endif
#define NREP(k, L) ((DUP_PH == (k) && ((DUP_LMASK >> (L)) & 1)) ? 2 : 1)
#define SEAM(k) do { if (IN(k) && IN((k) + 1)) { XcdBarrier bar_; bar_.bar = (unsigned*)WSP(WS_CTL) + 1024; bar_.x = xb_xcc_id(); bar_.st = F.MISC + 8; xcd_barrier(bar_); } } while (0)

    if (IN(0)) { for (int rep_ = 0; rep_ < NREP(0, 0); ++rep_) phase_prologue(F, WSP(0)); } SEAM(0);
    if (IN(1)) { phase_norm1(F, karg(KA_x), karg(KA_ctx), karg(KA_norm1_g), (const float*)WSP(WS_MOD), (bf16_t*)WSP(WS_H), (bf16_t*)WSP(WS_XB)); } SEAM(1);

#pragma unroll 1
    for (int L = 0; L < DEPTH; ++L) {
        const int pb = 2 + 8 * L;
        if (hi <= pb || lo >= pb + 8) continue;
        if (IN(pb + 0)) for (int rep_ = 0; rep_ < NREP(2, L); ++rep_) {
            const int kind = L % 3, slot = L / 3; const int Nin = (kind == 0) ? 1536 : 3072;
            const bf16_t* Wt = (const bf16_t*)WSP(WS_PW) + (kind == 0 ? PW_WIN_IN / 2 + (size_t)slot * 1536 * 1024 : kind == 1 ? PW_DIFF_IN / 2 : PW_NA_IN / 2);
            pg8::Gemm g{(const char*)WSP(WS_H), (const char*)Wt, INPROJ_FP8 ? DM : DM * 2, 1 << 20, 0, nullptr};
            pg8::StaticOrder S; S.init(MT / 256, Nin / 256, F.G, (int)blockIdx.x);
            pg8::EpiInProj E{(bf16_t*)WSP(WS_QKV), Nin, 4, kind == 0 ? 5 : (kind == 1 ? 8 : 0), (const float*)WSP(WS_TAB), INPROJ_FP8 ? 1.f / (H2_SCALE * W8_SCALE) : 1.f, kind == 0 ? 5 : 8};
            pg8::gemm_phase<pg8::EpiInProj, false, true, INPROJ_FP8 != 0>(F.lds, g, S, E);
        }
        SEAM(pb + 0);
        if (IN(pb + 1)) for (int rep_ = 0; rep_ < NREP(3, L); ++rep_) {
            const int kind = L % 3, slot = L / 3; const int with_ctx = L < DEPTH - 1 ? 1 : 0;
            if (kind == 0) { att::A2Args A{(const bf16_t*)WSP(WS_QKV), (bf16_t*)WSP(WS_H), karg(KA_win_sink) + slot * 16, with_ctx}; att::att2_phase<0>(F.lds, A, F.vcu, F.G); }
            else if (kind == 1) { const float* TAB = (const float*)WSP(WS_TAB); att::DiffArgs A{(const bf16_t*)WSP(WS_QKV), (bf16_t*)WSP(WS_H), karg(KA_diff_subln_g), TAB[TAB_LAM], TAB[TAB_LAM + 1], with_ctx}; att::diff_phase3(F.lds, A, F.vcu, F.G); }
            else { att::A2Args A{(const bf16_t*)WSP(WS_QKV), (bf16_t*)WSP(WS_H), karg(KA_na_rpb), with_ctx}; att::att2_phase<1>(F.lds, A, F.vcu, F.G); }
        }
        SEAM(pb + 1);
        if (IN(pb + 2)) {
            const int kind = L % 3, slot = L / 3; const bool with_ctx = L < DEPTH - 1;
            const bf16_t* Wt = (const bf16_t*)WSP(WS_PW) + (kind == 0 ? PW_WIN_OUT / 2 + (size_t)slot * 1024 * 1024 : kind == 1 ? PW_DIFF_OUT / 2 : PW_NA_OUT / 2);
            pg8::Gemm g{(const char*)WSP(WS_H), (const char*)Wt, OUTPROJ_FP8 ? DM : DM * 2, 1 << 20, 0, nullptr};
            pg8::StaticOrder S; S.init((with_ctx ? MT : MX) / 256, 4, F.G, (int)blockIdx.x);
            pg8::EpiOutProj E{(bf16_t*)WSP(WS_XB), (const float*)WSP(WS_MOD) + (size_t)L * 17 * 6144, OUTPROJ_FP8 ? 1.f / (Y_SCALE * W8_SCALE) : 1.f};
            pg8::gemm_phase<pg8::EpiOutProj, false, true, OUTPROJ_FP8 != 0>(F.lds, g, S, E);
        }
        SEAM(pb + 2);
        if (IN(pb + 3)) for (int rep_ = 0; rep_ < NREP(5, L); ++rep_) { const bool with_ctx = L < DEPTH - 1;
            if (ROUTER_MFMA && rep_ == 0) phase_norm2_router_mfma(F, (const bf16_t*)WSP(WS_XB), karg(KA_norm2_g) + L * DM, (const float*)WSP(WS_MOD) + (size_t)L * 17 * 6144, karg(KA_router_w) + (size_t)L * DM * NE,
                               (unsigned char*)WSP(WS_H), (float*)WSP(WS_AFF), with_ctx ? MT : MX);
            else phase_norm2_router(F, (const bf16_t*)WSP(WS_XB), karg(KA_norm2_g) + L * DM, (const float*)WSP(WS_MOD) + (size_t)L * 17 * 6144, karg(KA_router_w) + (size_t)L * DM * NE,
                               (unsigned char*)WSP(WS_H), (float*)WSP(WS_AFF), with_ctx ? MT : MX, (const bf16_t*)WSP(WS_P), rep_ == 0); }
        SEAM(pb + 3);
        if (IN(pb + 4)) for (int rep_ = 0; rep_ < NREP(6, L); ++rep_) { const bool with_ctx = L < DEPTH - 1; phase_topk(F, (const float*)WSP(WS_AFF), (unsigned*)WSP(WS_ROWSRC), (short*)WSP(WS_SLOT), with_ctx ? NME_FULL : NME_LAST, with_ctx); }
        SEAM(pb + 4);
        if (IN(pb + 5)) for (int rep_ = 0; rep_ < NREP(7, L); ++rep_) {
            const int nMe = (L < DEPTH - 1) ? NME_FULL : NME_LAST;
            pg8::Gemm g{(const char*)WSP(WS_H), (const char*)WSP(WS_MOEW + (size_t)L * 16 * MOEW_E), DM, nMe, MOEW_E, (const unsigned*)WSP(WS_ROWSRC)};
            pg8::StaticOrder S; S.init(16 * nMe, 16, F.G, (int)blockIdx.x);
            if (DUP_PH == 7 && rep_ == 1) { pg8::EpiSwiglu<true> E{(unsigned char*)WSP(WS_QKV), 1.f / (H2_SCALE * W8_SCALE), HID_SCALE};
                pg8::gemm_phase<pg8::EpiSwiglu<true>, true, true, true>(F.lds, g, S, E); }
            else { pg8::EpiSwiglu<false> E{(unsigned char*)WSP(WS_QKV), 1.f / (H2_SCALE * W8_SCALE), HID_SCALE};
                pg8::gemm_phase<pg8::EpiSwiglu<false>, true, true, true>(F.lds, g, S, E); }
        }
        SEAM(pb + 5);
        if (IN(pb + 6)) for (int rep_ = 0; rep_ < NREP(8, L); ++rep_) {
            const int nMe = (L < DEPTH - 1) ? NME_FULL : NME_LAST;
            pg8::Gemm g{(const char*)WSP(WS_QKV), (const char*)WSP(WS_MOEW + (size_t)L * 16 * MOEW_E + (size_t)4096 * 1024), FF, nMe, MOEW_E, nullptr};
            pg8::StaticOrder S; S.init(16 * nMe, 4, F.G, (int)blockIdx.x);
            pg8::EpiBf16 E{(bf16_t*)WSP(WS_YBUF), DM, 1.f / (HID_SCALE * W8_SCALE)};
            pg8::gemm_phase<pg8::EpiBf16, false, true, true, true>(F.lds, g, S, E);
        }
        SEAM(pb + 6);
        if (IN(pb + 7)) for (int rep_ = NREP(9, L) - 1; rep_ >= 0; --rep_) {
            const bool last = (L == DEPTH - 1); const bool with_ctx = !last;
            phase_combine(F, (bf16_t*)WSP(WS_XB), (const bf16_t*)WSP(WS_P), (float*)karg(KA_OUT), (const float*)WSP(WS_MOD) + (size_t)L * 17 * 6144, (const float*)WSP(WS_AFF), (const short*)WSP(WS_SLOT), (const bf16_t*)WSP(WS_YBUF),
                          with_ctx ? NME_FULL : NME_LAST, with_ctx ? MT : MX, last, karg(KA_norm1_g) + (last ? 0 : (L + 1) * DM), (const float*)WSP(WS_MOD) + (size_t)(last ? 0 : L + 1) * 17 * 6144,
                          rep_ ? (bf16_t*)WSP(WS_QKV + 300 * MiB) : (bf16_t*)WSP(WS_H), karg(KA_final_g), rep_ ? (float*)WSP(WS_QKV) : nullptr);
        }
        SEAM(pb + 7);
    }
#undef IN
#undef SEAM
}

extern "C" void kernel_launch(void* const* d_in, const int* in_sizes, int n_in, void* d_out, int out_size, void* d_ws, size_t ws_size, hipStream_t stream) {
    static int grid = 0;
    if (grid == 0) {
        if (n_in != 23 || out_size != MX * DM || ws_size < WS_END) { fprintf(stderr, "kernel_launch: unexpected shapes: n_in %d out %d ws %zu (need %zu)\n", n_in, out_size, ws_size, (size_t)WS_END); grid = -1; return; }
        int dev = 0, cus = 0, per_cu = 0;
        if (hipGetDevice(&dev) != hipSuccess || hipDeviceGetAttribute(&cus, hipDeviceAttributeMultiprocessorCount, dev) != hipSuccess) { grid = -1; return; }
        if (hipFuncSetAttribute((const void*)fwd, hipFuncAttributeMaxDynamicSharedMemorySize, LDS_BYTES) != hipSuccess) { fprintf(stderr, "kernel_launch: hipFuncSetAttribute failed\n"); grid = -1; return; }
        if (hipOccupancyMaxActiveBlocksPerMultiprocessor(&per_cu, (const void*)fwd, NWAVES * 64, LDS_BYTES) != hipSuccess || per_cu < 1) fprintf(stderr, "kernel_launch: occupancy query says %d\n", per_cu);
        (void)hipGetLastError();
        grid = cus;
    }
    if (grid < 0) return;
    (void)hipMemsetAsync((char*)d_ws + WS_CTL, 0, CTL_ZERO_BYTES, stream);
    Args a{};
    const float** ip = (const float**)&a.in;
    for (int i = 0; i < 23; ++i) ip[i] = (const float*)d_in[i];
    a.out = (float*)d_out; a.ws = (unsigned char*)d_ws;
    if (MK_N_LAUNCHES == 1) { a.ph_lo = 0; a.ph_hi = NPHASES; hipLaunchKernelGGL(fwd, dim3(grid), dim3(NWAVES * 64), LDS_BYTES, stream, a); }
    else for (int p = 0; p < NPHASES; ++p) { a.ph_lo = p; a.ph_hi = p + 1; hipLaunchKernelGGL(fwd, dim3(grid), dim3(NWAVES * 64), LDS_BYTES, stream, a); }
}
```

```cpp
#include <hip/hip_runtime.h>
#include <cstdio>
#include <cstdint>

#ifndef MK_N_LAUNCHES
#define MK_N_LAUNCHES 1
#endif

#define GAS __attribute__((address_space(1)))
#define LAS __attribute__((address_space(3)))
typedef unsigned short bf16_t;
typedef short bf16x8 __attribute__((ext_vector_type(8)));
typedef short s16x4 __attribute__((ext_vector_type(4)));
typedef float f32x4 __attribute__((ext_vector_type(4)));
typedef float f32x2 __attribute__((ext_vector_type(2)));
typedef float f32x16 __attribute__((ext_vector_type(16)));
typedef unsigned u32x4 __attribute__((ext_vector_type(4)));
typedef unsigned u32x2 __attribute__((ext_vector_type(2)));
typedef __bf16 bf16x2_t __attribute__((ext_vector_type(2)));
typedef GAS unsigned gu32;

constexpr int DM = 1024, NB = 16, SEQ = 4096, DEPTH = 4, CTXL = 256, NE = 16, FF = 2048;
constexpr int MX = NB * SEQ;
constexpr int MC = NB * CTXL;
constexpr int MT = MX + MC;
constexpr int CAPX = 512, CAPC = 32;
constexpr int NME_FULL = 34, NME_LAST = 32;
constexpr float C2 = 0.125f * 1.4426950408889634f;
constexpr float LOG2E = 1.4426950408889634f;
constexpr float RMS_EPS = 1e-6f;
constexpr float NEG_BIG = -1e30f;
constexpr int NWAVES = 8;
constexpr int NPHASES = 2 + 8 * DEPTH;

constexpr size_t MiB = 1u << 20;
constexpr size_t WS_CTL = 0, CTL_ZERO_BYTES = 64 * 1024;
constexpr size_t WS_MOD = 1 * MiB;
constexpr size_t WS_TAB = 3 * MiB;
constexpr size_t WS_AFF = 4 * MiB;
constexpr size_t WS_SLOT = 9 * MiB;
constexpr size_t WS_ROWSRC = 12 * MiB;
constexpr size_t WS_CTXRES = 13 * MiB;
constexpr size_t WS_PW = 29 * MiB;
constexpr size_t PW_WIN_IN = 0, PW_WIN_OUT = 6 * MiB, PW_DIFF_IN = 10 * MiB, PW_DIFF_OUT = 16 * MiB, PW_NA_IN = 18 * MiB, PW_NA_OUT = 24 * MiB;
constexpr size_t WS_H = 56 * MiB;
constexpr size_t WS_QKV = 192 * MiB;
constexpr size_t WS_YBUF = 736 * MiB;
constexpr size_t WS_MOEW = 1008 * MiB;
constexpr size_t MOEW_E = (size_t)(4096 * 1024 + 1024 * 2048);
#ifndef INPROJ_FP8
#define INPROJ_FP8 1
#endif
#ifndef OUTPROJ_FP8
#define OUTPROJ_FP8 0
#endif
constexpr float Y_SCALE = 8.f;
constexpr float H2_SCALE = 4.f, HID_SCALE = 2.f, W8_SCALE = 32.f;
constexpr size_t WS_XB = 1536 * MiB;
constexpr size_t WS_END = 1672 * MiB;
constexpr size_t WS_P = 1400 * MiB;
constexpr int TAB_COS = 0, TAB_SIN = 1024, TAB_LAM = 2048;

constexpr int RING_BYTES = 131072;
constexpr int MISC_OFF = 135168;
constexpr int LDS_BYTES = 147456;

#define LDS_WAIT() asm volatile("s_waitcnt lgkmcnt(0)" ::: "memory")
#define VM_WAIT() asm volatile("s_waitcnt vmcnt(0)" ::: "memory")

__device__ __forceinline__ unsigned cvtpk(float lo, float hi) { f32x2 v = {lo, hi}; bf16x2_t b = __builtin_convertvector(v, bf16x2_t); return __builtin_bit_cast(unsigned, b); }
__device__ __forceinline__ float bf2f(unsigned short u) { return __builtin_bit_cast(float, (unsigned)u << 16); }
__device__ __forceinline__ float wave_sum(float v) {
#pragma unroll
    for (int o = 1; o < 64; o <<= 1) v += __shfl_xor(v, o);
    return v;
}
template <int CTRL> __device__ __forceinline__ float dppf(float v) { return __builtin_bit_cast(float, __builtin_amdgcn_update_dpp(0, __builtin_bit_cast(int, v), CTRL, 0xF, 0xF, true)); }
__device__ __forceinline__ float row16_sum(float v) { v += dppf<0xB1>(v); v += dppf<0x4E>(v); v += dppf<0x141>(v); v += dppf<0x140>(v); return v; }
__device__ __forceinline__ float row16_max(float v) { v = fmaxf(v, dppf<0xB1>(v)); v = fmaxf(v, dppf<0x4E>(v)); v = fmaxf(v, dppf<0x141>(v)); v = fmaxf(v, dppf<0x140>(v)); return v; }
__device__ __forceinline__ float rdlane(float v, int l) { return __builtin_bit_cast(float, __builtin_amdgcn_readlane(__builtin_bit_cast(int, v), l)); }
__device__ __forceinline__ float wave_sum_fast(float v) { v = row16_sum(v); return (rdlane(v, 0) + rdlane(v, 16)) + (rdlane(v, 32) + rdlane(v, 48)); }
__device__ __forceinline__ float siluf(float v) { return v / (1.f + __expf(-v)); }

#define XB_TMO      128
#define XB_XCNT(j)  (256  + 64 * (j))
#define XB_XSUB(j)  (1280 + 64 * (j))
#define XB_XGEN(j)  (2304 + 64 * (j))
#define XB_TOP      3328
#define XB_TOPGEN   3392
#define XCD_BAR_WORDS 3456
#define XB_SPIN_CAP (1u << 18)
__device__ __forceinline__ unsigned xb_ld(unsigned* p)              { return __hip_atomic_load(p, __ATOMIC_RELAXED, __HIP_MEMORY_SCOPE_AGENT); }
__device__ __forceinline__ unsigned xb_add(unsigned* p, unsigned v) { return __hip_atomic_fetch_add(p, v, __ATOMIC_RELAXED, __HIP_MEMORY_SCOPE_AGENT); }
__device__ __forceinline__ unsigned xb_xcc_id() { return (unsigned)__builtin_amdgcn_s_getreg((3 << 11) | 20) & 0xFu; }
#define XB_SPIN(cond, bar) do { unsigned _sp = 0; while (cond) { __builtin_amdgcn_s_sleep(1); \
    if ((++_sp & 255u) == 0u) { if (xb_ld(&(bar)[XB_TMO])) break; if (_sp > XB_SPIN_CAP) { atomicAdd(&(bar)[XB_TMO], 1u); break; } } } } while (0)
struct XcdBarrier { unsigned* bar; unsigned x; volatile LAS unsigned* st; };
__device__ __forceinline__ XcdBarrier xcd_barrier_post(unsigned* bar, volatile LAS unsigned* st) {
    XcdBarrier b; b.bar = bar; b.x = xb_xcc_id(); b.st = st;
    if (threadIdx.x == 0) (void)xb_add(&bar[XB_XCNT(b.x)], 1u);
    return b;
}
__device__ __forceinline__ void xcd_barrier_complete(unsigned* bar, unsigned x, unsigned& nloc, unsigned& nx) {
    const unsigned G = gridDim.x * gridDim.y * gridDim.z;
    unsigned sum, cnt, mine, sp = 0u;
    for (;;) {
        sum = 0u; cnt = 0u; mine = 0u;
#pragma unroll
        for (unsigned j = 0; j < 16; ++j) { const unsigned c = xb_ld(&bar[XB_XCNT(j)]); sum += c; cnt += (c > 0u) ? 1u : 0u; mine = (j == x) ? c : mine; }
        if (sum == G) break;
        __builtin_amdgcn_s_sleep(1);
        if ((++sp & 255u) == 0u) { if (xb_ld(&bar[XB_TMO])) break; if (sp > XB_SPIN_CAP) { atomicAdd(&bar[XB_TMO], 1u); break; } }
    }
    nloc = mine > 0u ? mine : 1u; nx = cnt > 0u ? cnt : 1u;
}
__device__ __forceinline__ void xcd_barrier(const XcdBarrier& b) {
    asm volatile("s_waitcnt vmcnt(0)" ::: "memory");
    __syncthreads();
    if (threadIdx.x == 0) {
        unsigned* bar = b.bar;
        __builtin_amdgcn_s_waitcnt(0);
        unsigned nloc = b.st[0], nx = b.st[1];
        if (nloc == 0u) { xcd_barrier_complete(bar, b.x, nloc, nx); b.st[0] = nloc; b.st[1] = nx; }
        const unsigned old = xb_add(&bar[XB_XSUB(b.x)], 1u);
        const unsigned gen = old / nloc;
        if (old + 1u == (gen + 1u) * nloc) {
            __builtin_amdgcn_fence(__ATOMIC_RELEASE, "agent");
            asm volatile("s_waitcnt vmcnt(0)" ::: "memory");
            const unsigned og = xb_add(&bar[XB_TOP], 1u);
            const unsigned tg = og / nx;
            if (og + 1u == (tg + 1u) * nx) xb_add(&bar[XB_TOPGEN], 1u);
            else XB_SPIN(xb_ld(&bar[XB_TOPGEN]) == tg, bar);
            __builtin_amdgcn_fence(__ATOMIC_ACQUIRE, "agent");
            xb_add(&bar[XB_XGEN(b.x)], 1u);
            asm volatile("s_waitcnt vmcnt(0)" ::: "memory");
        } else {
            XB_SPIN(xb_ld(&bar[XB_XGEN(b.x)]) == gen, bar);
            __builtin_amdgcn_fence(__ATOMIC_ACQUIRE, "agent");
            asm volatile("s_waitcnt vmcnt(0)" ::: "memory");
        }
    }
    __syncthreads();
}

namespace pg8 {
constexpr int BM = 256, BK = 64, HALF = 128, HTB = HALF * BK * 2, NXCD = 8, WGM = 8;
typedef int v4i __attribute__((ext_vector_type(4)));
typedef int v8i __attribute__((ext_vector_type(8)));
__host__ __device__ __forceinline__ int lds_byte(int r, int c) { const int st = (r >> 4) * 2 + (c >> 5), rr = r & 15, cc = c & 31, ob = rr * 64 + cc * 2; return st * 1024 + (ob ^ (((ob >> 9) & 1) << 5)); }
__host__ __device__ __forceinline__ void stage_rc(int b, int& R, int& C) { const int st = b / 1024, sb = b % 1024, swz = sb ^ (((sb >> 9) & 1) << 5); R = (st >> 1) * 16 + swz / 64; C = (st & 1) * 32 + (swz % 64) / 2; }
__host__ __device__ __forceinline__ int perm32(int rho) { const int n = rho >> 4, i = rho & 15; return 8 * (i >> 2) + 4 * n + (i & 3); }

struct Unit { int pm, pn; };
struct Gemm { const char* A; const char* Bt; int Kb; int nMe; size_t b_estride; const unsigned* rowsrc; };

struct StaticOrder {
    int nM, nN, nwg, G, c;
    __device__ void init(int nM_, int nN_, int G_, int c_) { nM = nM_; nN = nN_; nwg = nM * nN; G = G_; c = c_; }
    __device__ bool next(int i, Unit& u) const {
        const long L = (long)i * G + c; if (L >= nwg) return false;
        int wgid = (int)L; { const int q = nwg / NXCD, r = nwg % NXCD, xcd = wgid % NXCD, off = wgid / NXCD; wgid = (xcd < r ? xcd * (q + 1) : r * (q + 1) + (xcd - r) * q) + off; }
        const int nig = WGM * nN, gid = wgid / nig, fm = gid * WGM, gsz = (nM - fm) < WGM ? (nM - fm) : WGM;
        u.pm = fm + ((wgid % nig) % gsz); u.pn = (wgid % nig) / gsz; return true;
    }
};

template <class Epi, bool GATHER, bool ALIGN_EPI, bool FP8 = false, bool ABLK = false>
__device__ __forceinline__ void gemm_phase(LAS unsigned char* lds, const Gemm g, const StaticOrder& S, const Epi& E) {
    int tid = threadIdx.x; asm volatile("" : "+v"(tid));
    const int wid = __builtin_amdgcn_readfirstlane(tid >> 6), lane = tid & 63, wr = wid >> 2, wc = wid & 3, fr = lane & 15, fq = lane >> 4;
    const int Kb = g.Kb, nt = Kb / (BK * 2);
    int Rr[2], Cc[2]; unsigned voffB[2];
#pragma unroll
    for (int i = 0; i < 2; ++i) { int R, C; stage_rc(tid * 16 + i * 8192, R, C); const int Rb = Epi::PERM ? ((R & ~31) + perm32(R & 31)) : R;
        Rr[i] = R; Cc[i] = C; voffB[i] = (unsigned)(Rb * Kb + C * 2); }
    const size_t kstep = (size_t)(BK * 2);
    const size_t kstepA = ABLK ? (size_t)32768 : kstep;
    const size_t hstep = (size_t)HALF * Kb;
    const size_t tstep = 2 * hstep;
    const unsigned ldsw = (unsigned)wid * 1024u;
    const int aoff = lds_byte(wr * 64 + fr, fq * 8), boff = lds_byte(wc * 32 + fr, fq * 8);
#define PG8_SA(b, h) (((b) * 2 + (h)) * HTB)
#define PG8_SB(b, h) ((4 + (b) * 2 + (h)) * HTB)
#define PG8_STAGE(bufoff, gbase, voff) do { _Pragma("unroll") for (int _i = 0; _i < 2; ++_i) \
        __builtin_amdgcn_global_load_lds((const unsigned*)((const char*)(gbase) + (voff)[_i]), (LAS unsigned*)(lds + (bufoff) + ldsw + _i * 8192), 16, 0, 0); } while (0)
#define PG8_LDA(dst, b, h) do { _Pragma("unroll") for (int m = 0; m < 4; ++m) _Pragma("unroll") for (int k = 0; k < 2; ++k) dst[m][k] = *(const LAS bf16x8*)(lds + PG8_SA(b, h) + aoff + m * 2048 + k * 1024); } while (0)
#define PG8_LDB(dst, b, h) do { _Pragma("unroll") for (int n = 0; n < 2; ++n) _Pragma("unroll") for (int k = 0; k < 2; ++k) dst[n][k] = *(const LAS bf16x8*)(lds + PG8_SB(b, h) + boff + n * 2048 + k * 1024); } while (0)
#define PG8_MMA(ai, bj, At, Bt) do { __builtin_amdgcn_s_setprio(1); \
        if constexpr (FP8) { _Pragma("unroll") for (int m = 0; m < 4; ++m) _Pragma("unroll") for (int n = 0; n < 2; ++n) { \
            const v8i b8_ = __builtin_shufflevector(__builtin_bit_cast(v4i, Bt[n][0]), __builtin_bit_cast(v4i, Bt[n][1]), 0, 1, 2, 3, 4, 5, 6, 7); \
            const v8i a8_ = __builtin_shufflevector(__builtin_bit_cast(v4i, At[m][0]), __builtin_bit_cast(v4i, At[m][1]), 0, 1, 2, 3, 4, 5, 6, 7); \
            asm volatile("v_mfma_f32_16x16x128_f8f6f4 %0, %1, %2, %0" : "+v"(acc[ai][bj][m][n]) : "v"(b8_), "v"(a8_)); } } \
        else { _Pragma("unroll") for (int m = 0; m < 4; ++m) _Pragma("unroll") for (int n = 0; n < 2; ++n) _Pragma("unroll") for (int k = 0; k < 2; ++k) \
            acc[ai][bj][m][n] = __builtin_amdgcn_mfma_f32_16x16x32_bf16(Bt[n][k], At[m][k], acc[ai][bj][m][n], 0, 0, 0); } \
        __builtin_amdgcn_s_setprio(0); } while (0)
#define PG8_WAIT_V(n) asm volatile("s_waitcnt vmcnt(" #n ")" ::: "memory")
#define PG8_WAIT_L(n) asm volatile("s_waitcnt lgkmcnt(" #n ")" ::: "memory")
#define PG8_BAR __builtin_amdgcn_s_barrier()
#define PG8_SCHED __builtin_amdgcn_sched_barrier(0)
#define PG8_CALC_VG(VG, U) do { _Pragma("unroll") for (int _h = 0; _h < 2; ++_h) _Pragma("unroll") for (int _i = 0; _i < 2; ++_i) { \
        const unsigned _row = (unsigned)((U).pm * BM + _h * HALF + Rr[_i]); const unsigned _src = GATHER ? g.rowsrc[_row] : _row; \
        if constexpr (ABLK) { const unsigned _r = (unsigned)(_h * HALF + Rr[_i]), _c = (unsigned)Cc[_i] >> 3; \
            VG[_h][_i] = (unsigned)(U).pm * (unsigned)(Kb * BM) + (_r >> 4) * 2048u + (_c >> 1) * 512u + (_r & 15u) * 32u + (_c & 1u) * 16u; } \
        else VG[_h][_i] = _src * (unsigned)Kb + (unsigned)Cc[_i] * 2u; } } while (0)
    Unit cur, nxt; int ui = 0;
    if (!S.next(0, cur)) return;
    f32x4 acc[2][2][4][2];
#pragma unroll
    for (int a = 0; a < 2; ++a)
#pragma unroll
        for (int b = 0; b < 2; ++b)
#pragma unroll
            for (int m = 0; m < 4; ++m)
#pragma unroll
                for (int n = 0; n < 2; ++n) acc[a][b][m][n] = (f32x4){0.f, 0.f, 0.f, 0.f};
    bf16x8 At[4][2], B0[2][2], B1[2][2];
    unsigned vg[2][2], vgn[2][2];
    PG8_CALC_VG(vg, cur);
    const char* const gA = g.A;
    const char* cB = g.Bt + (size_t)(cur.pm / g.nMe) * g.b_estride + (size_t)cur.pn * tstep;
    PG8_STAGE(PG8_SB(0, 0), cB, voffB); PG8_STAGE(PG8_SB(0, 1), cB + hstep, voffB); PG8_STAGE(PG8_SA(0, 0), gA, vg[0]); PG8_STAGE(PG8_SA(0, 1), gA, vg[1]);
    if (wr == 1) PG8_BAR;
    PG8_WAIT_V(2); PG8_BAR;
    PG8_STAGE(PG8_SB(1, 0), cB + kstep, voffB); PG8_STAGE(PG8_SA(1, 0), gA + kstepA, vg[0]); PG8_STAGE(PG8_SB(1, 1), cB + hstep + kstep, voffB);
    PG8_WAIT_V(6); PG8_BAR;
    for (;;) {
        const bool has_next = S.next(ui + 1, nxt);
        LAS unsigned char* const rsb = lds + 131072 + ((ui + 1) & 1) * 1024;
        if (has_next) {
            if constexpr (GATHER) { if (wid == 0) __builtin_amdgcn_global_load_lds((const unsigned*)(g.rowsrc + (size_t)nxt.pm * BM) + lane * 4, (LAS unsigned*)rsb, 16, 0, 0); }
            else { PG8_CALC_VG(vgn, nxt); } }
        else {
#pragma unroll
            for (int _h = 0; _h < 2; ++_h)
#pragma unroll
                for (int _i = 0; _i < 2; ++_i) vgn[_h][_i] = vg[_h][_i]; }
        const char* nB = has_next ? g.Bt + (size_t)(nxt.pm / g.nMe) * g.b_estride + (size_t)nxt.pn * tstep : cB;
        for (int t = 0; t < nt; t += 2) {
            const bool last = (t == nt - 2);
            const char* a1 = gA + (size_t)(t + 1) * kstepA;
            const char* a2 = last ? gA : gA + (size_t)(t + 2) * kstepA; const char* b2 = last ? nB : cB + (size_t)(t + 2) * kstep;
            const char* a3 = a2 + kstepA; const char* b3 = b2 + kstep;
            if constexpr (GATHER) { if (last && has_next) {
#pragma unroll
                for (int _h = 0; _h < 2; ++_h)
#pragma unroll
                    for (int _i = 0; _i < 2; ++_i) vgn[_h][_i] = *(const LAS unsigned*)(rsb + (_h * HALF + Rr[_i]) * 4) * (unsigned)Kb + (unsigned)Cc[_i] * 2u; } }
            unsigned w0[2], w1[2];
#pragma unroll
            for (int _i = 0; _i < 2; ++_i) { w0[_i] = last ? vgn[0][_i] : vg[0][_i]; w1[_i] = last ? vgn[1][_i] : vg[1][_i]; }
            PG8_LDB(B0, 0, 0); PG8_LDB(B1, 0, 1); PG8_SCHED; PG8_LDA(At, 0, 0); PG8_STAGE(PG8_SA(1, 1), a1, vg[1]);
            PG8_WAIT_V(8); PG8_WAIT_L(0); PG8_BAR; PG8_MMA(0, 0, At, B0); PG8_MMA(0, 1, At, B1); PG8_BAR; PG8_SCHED;
            PG8_LDA(At, 0, 1); PG8_STAGE(PG8_SB(0, 0), b2, voffB); PG8_STAGE(PG8_SB(0, 1), b2 + hstep, voffB); PG8_STAGE(PG8_SA(0, 0), a2, w0);
            PG8_WAIT_V(8); PG8_WAIT_L(0); PG8_BAR; PG8_MMA(1, 0, At, B0); PG8_MMA(1, 1, At, B1); PG8_BAR; PG8_SCHED;
            PG8_LDB(B0, 1, 0); PG8_LDB(B1, 1, 1); PG8_SCHED; PG8_LDA(At, 1, 0); PG8_STAGE(PG8_SA(0, 1), a2, w1);
            PG8_WAIT_V(8); PG8_WAIT_L(0); PG8_BAR; PG8_MMA(0, 0, At, B0); PG8_MMA(0, 1, At, B1); PG8_BAR; PG8_SCHED;
            PG8_LDA(At, 1, 1); PG8_STAGE(PG8_SB(1, 0), b3, voffB); PG8_STAGE(PG8_SB(1, 1), b3 + hstep, voffB); PG8_STAGE(PG8_SA(1, 0), a3, w0);
            PG8_WAIT_V(8); PG8_WAIT_L(0); PG8_BAR; PG8_MMA(1, 0, At, B0); PG8_MMA(1, 1, At, B1); PG8_BAR; PG8_SCHED;
        }
        if constexpr (ALIGN_EPI) { if (wr == 0) PG8_BAR; }
        if constexpr (FP8) asm volatile("s_nop 15\n\ts_nop 15" ::: "memory");
        E(acc, cur, wr, wc, fr, fq);
        if (!has_next) break;
#pragma unroll
        for (int a = 0; a < 2; ++a)
#pragma unroll
            for (int b = 0; b < 2; ++b)
#pragma unroll
                for (int m = 0; m < 4; ++m)
#pragma unroll
                    for (int n = 0; n < 2; ++n) acc[a][b][m][n] = (f32x4){0.f, 0.f, 0.f, 0.f};
        cur = nxt; cB = nB; ++ui;
#pragma unroll
        for (int _h = 0; _h < 2; ++_h)
#pragma unroll
            for (int _i = 0; _i < 2; ++_i) vg[_h][_i] = vgn[_h][_i];
        if constexpr (ALIGN_EPI) { if (wr == 1) PG8_BAR; }
    }
    PG8_WAIT_V(0);
    if constexpr (!ALIGN_EPI) { if (wr == 0) PG8_BAR; }
    PG8_BAR;
#undef PG8_SA
#undef PG8_SB
#undef PG8_STAGE
#undef PG8_LDA
#undef PG8_LDB
#undef PG8_MMA
#undef PG8_WAIT_V
#undef PG8_WAIT_L
#undef PG8_BAR
#undef PG8_SCHED
#undef PG8_CALC_VG
}

struct EpiInProj {
    static constexpr bool PERM = false;
    bf16_t* O; int ldc; int q_tiles; int rope_tiles; const float* tab; float osc; int v_tile0; bf16_t* Q;
    __device__ __forceinline__ void operator()(const f32x4 (&acc)[2][2][4][2], const Unit& u, int wr, int wc, int fr, int fq) const {
        const int row0 = u.pm * BM + wr * 64 + fr, col0 = u.pn * BM + wc * 32 + 4 * fq;
        const float sc = ((u.pn < q_tiles) ? C2 : 1.f) * osc;
        const bool rope = (u.pn < rope_tiles) && (u.pm < MX / BM);
        const int axis = wc & 1; const bool isv = u.pn >= v_tile0;
#pragma unroll
        for (int ai = 0; ai < 2; ++ai)
#pragma unroll
            for (int m = 0; m < 4; ++m) {
                const int row = row0 + ai * HALF + m * 16;
                f32x4 cs = {1.f, 1.f, 1.f, 1.f}, sn = {0.f, 0.f, 0.f, 0.f};
                if (rope) { const int t = row & (SEQ - 1); const int pos = axis ? (t & 63) : (t >> 6); cs = *(const f32x4*)(tab + TAB_COS + pos * 16 + 4 * fq); sn = *(const f32x4*)(tab + TAB_SIN + pos * 16 + 4 * fq); }
                bf16_t* rowp = O + (size_t)row * ldc + col0;
                bf16_t* rowq = (u.pn < q_tiles) ? Q + ((size_t)(row >> 5) * 16 + 4 * u.pn + (wc >> 1)) * 2048 + (2 * (wc & 1) + (fq >> 1)) * 512 + (fq & 1) * 256 + (row & 31) * 8
                                                : O + (size_t)row * ldc + u.pn * BM + wc * 32 + 8 * fq;
                const int qstep = (u.pn < q_tiles) ? 2 * 2048 : HALF;
#pragma unroll
                for (int bj = 0; bj < 2; ++bj) {
                    const f32x4 x1 = acc[ai][bj][m][0] * sc, x2 = acc[ai][bj][m][1] * sc;
                    const f32x4 o1 = x1 * cs - x2 * sn, o2 = x2 * cs + x1 * sn;
                    u32x2 w1, w2; w1.x = cvtpk(o1[0], o1[1]); w1.y = cvtpk(o1[2], o1[3]); w2.x = cvtpk(o2[0], o2[1]); w2.y = cvtpk(o2[2], o2[3]);
                    if (isv) { *(u32x2*)(rowp + bj * HALF) = w1; *(u32x2*)(rowp + bj * HALF + 16) = w2; }
                    else *(u32x4*)(rowq + bj * qstep) = (u32x4){w1.x, w1.y, w2.x, w2.y}; }
            }
    }
};
struct EpiOutProj {
    static constexpr bool PERM = true;
    bf16_t* P; const float* mod; float osc;
    __device__ __forceinline__ void operator()(const f32x4 (&acc)[2][2][4][2], const Unit& u, int wr, int wc, int fr, int fq) const {
        const int b = (u.pm < MX / BM) ? ((u.pm * BM) >> 12) : 16;
        const int row0 = u.pm * BM + wr * 64 + fr, col0 = u.pn * BM + wc * 32 + 8 * fq;
        const float* gp = mod + (size_t)b * 6144 + 2 * DM + col0;
        f32x4 gv[2][2];
#pragma unroll
        for (int bj = 0; bj < 2; ++bj)
#pragma unroll
            for (int n = 0; n < 2; ++n) gv[bj][n] = *(const f32x4*)(gp + bj * HALF + 4 * n) * osc;
#pragma unroll
        for (int ai = 0; ai < 2; ++ai)
#pragma unroll
            for (int m = 0; m < 4; ++m) { bf16_t* rowp = P + (size_t)(row0 + ai * HALF + m * 16) * DM + col0;
                u32x4 xr[2]; xr[0] = *(const u32x4*)rowp; xr[1] = *(const u32x4*)(rowp + HALF);
#pragma unroll
                for (int bj = 0; bj < 2; ++bj) { const f32x4 v0 = acc[ai][bj][m][0] * gv[bj][0], v1 = acc[ai][bj][m][1] * gv[bj][1]; const u32x4 x = xr[bj];
                    u32x4 w; w.x = cvtpk(v0[0] + __builtin_bit_cast(float, x.x << 16), v0[1] + __builtin_bit_cast(float, x.x & 0xffff0000u));
                    w.y = cvtpk(v0[2] + __builtin_bit_cast(float, x.y << 16), v0[3] + __builtin_bit_cast(float, x.y & 0xffff0000u));
                    w.z = cvtpk(v1[0] + __builtin_bit_cast(float, x.z << 16), v1[1] + __builtin_bit_cast(float, x.z & 0xffff0000u));
                    w.w = cvtpk(v1[2] + __builtin_bit_cast(float, x.w << 16), v1[3] + __builtin_bit_cast(float, x.w & 0xffff0000u));
                    *(u32x4*)(rowp + bj * HALF) = w; } }
    }
};
template <bool NOSTORE = false> struct EpiSwiglu {
    static constexpr bool PERM = true;
    unsigned char* O; float in_scale; float out_scale;
    __device__ __forceinline__ void operator()(const f32x4 (&acc)[2][2][4][2], const Unit& u, int wr, int wc, int fr, int fq) const {
        const int row0 = u.pm * BM + wr * 64 + fr, col0 = u.pn * HALF + wc * 32 + 8 * fq;
#pragma unroll
        for (int ai = 0; ai < 2; ++ai)
#pragma unroll
            for (int m = 0; m < 4; ++m) { unsigned char* rowp = O + ((size_t)u.pm * 16 + u.pn) * 32768 + (8 * ai + 4 * wr + m) * 2048 + wc * 512 + fr * 32 + fq * 8;
                float h[8];
                const float c1 = -LOG2E * in_scale, c2 = in_scale * in_scale * out_scale;
#pragma unroll
                for (int n = 0; n < 2; ++n)
#pragma unroll
                    for (int j = 0; j < 4; j += 2) { const f32x2 ag = {acc[ai][0][m][n][j], acc[ai][0][m][n][j + 1]}, au = {acc[ai][1][m][n][j], acc[ai][1][m][n][j + 1]};
                        const f32x2 ea = ag * c1; f32x2 t; t.x = __builtin_amdgcn_exp2f(ea.x); t.y = __builtin_amdgcn_exp2f(ea.y);
                        const f32x2 d = t + 1.0f; f32x2 r; r.x = __builtin_amdgcn_rcpf(d.x); r.y = __builtin_amdgcn_rcpf(d.y);
                        const f32x2 hv = ((ag * au) * c2) * r; h[n * 4 + j] = hv.x; h[n * 4 + j + 1] = hv.y; }
                int w0 = 0, w1 = 0;
                w0 = __builtin_amdgcn_cvt_pk_fp8_f32(h[0], h[1], w0, false); w0 = __builtin_amdgcn_cvt_pk_fp8_f32(h[2], h[3], w0, true);
                w1 = __builtin_amdgcn_cvt_pk_fp8_f32(h[4], h[5], w1, false); w1 = __builtin_amdgcn_cvt_pk_fp8_f32(h[6], h[7], w1, true);
                if (NOSTORE) asm volatile("" :: "v"(w0), "v"(w1)); else *(u32x2*)rowp = (u32x2){(unsigned)w0, (unsigned)w1}; }
    }
};
struct EpiBf16 {
    static constexpr bool PERM = true;
    bf16_t* O; int ldc; float sc;
    __device__ __forceinline__ void operator()(const f32x4 (&acc)[2][2][4][2], const Unit& u, int wr, int wc, int fr, int fq) const {
        const int row0 = u.pm * BM + wr * 64 + fr, col0 = u.pn * BM + wc * 32 + 8 * fq;
#pragma unroll
        for (int ai = 0; ai < 2; ++ai)
#pragma unroll
            for (int m = 0; m < 4; ++m) { bf16_t* rowp = O + (size_t)(row0 + ai * HALF + m * 16) * ldc + col0;
#pragma unroll
                for (int bj = 0; bj < 2; ++bj) { const f32x4 v0 = acc[ai][bj][m][0] * sc, v1 = acc[ai][bj][m][1] * sc;
                    u32x4 w; w.x = cvtpk(v0[0], v0[1]); w.y = cvtpk(v0[2], v0[3]); w.z = cvtpk(v1[0], v1[1]); w.w = cvtpk(v1[2], v1[3]);
                    *(u32x4*)(rowp + bj * HALF) = w; } }
    }
};
}

namespace att {
#define SBAR() __builtin_amdgcn_sched_barrier(0)
__device__ __forceinline__ int crow(int r, int hi) { return (r & 3) + 8 * (r >> 2) + 4 * hi; }
__device__ __forceinline__ void glds16(const void* gsrc, unsigned lds_dst) { unsigned keep;
    asm volatile("s_mov_b32 %0, m0\n\ts_mov_b32 m0, %2\n\ts_nop 0\n\tglobal_load_lds_dwordx4 %1, off\n\ts_mov_b32 m0, %0" : "=&s"(keep) : "v"(gsrc), "s"(lds_dst) : "memory"); }
#define WAIT_BAR0() asm volatile("s_waitcnt vmcnt(0) lgkmcnt(0)\n\ts_barrier" ::: "memory")
typedef LAS const char* lds_cptr;
typedef short v4i16_t __attribute__((ext_vector_type(4)));
__device__ __forceinline__ s16x4 vtr(lds_cptr p) { return __builtin_bit_cast(s16x4, __builtin_amdgcn_ds_read_tr16_b64_v4i16((LAS v4i16_t*)p)); }
__device__ __forceinline__ float hmax(float m) { auto rr = __builtin_amdgcn_permlane32_swap(__float_as_uint(m), __float_as_uint(m), false, false); return fmaxf(__uint_as_float(rr[0]), __uint_as_float(rr[1])); }
__device__ __forceinline__ float hsum(float m) { auto rr = __builtin_amdgcn_permlane32_swap(__float_as_uint(m), __float_as_uint(m), false, false); return __uint_as_float(rr[0]) + __uint_as_float(rr[1]); }

__device__ __forceinline__ void qkt(f32x16& p0, f32x16& p1, lds_cptr kb, const bf16x8 (&qr)[4]) {
    p0 = f32x16{}; p1 = f32x16{};
#pragma unroll
    for (int d0 = 0; d0 < 4; ++d0) {
        const bf16x8 b0 = *(const LAS bf16x8*)(kb + d0 * 2048), b1 = *(const LAS bf16x8*)(kb + d0 * 2048 + 512);
        p0 = __builtin_amdgcn_mfma_f32_32x32x16_bf16(b0, qr[d0], p0, 0, 0, 0);
        p1 = __builtin_amdgcn_mfma_f32_32x32x16_bf16(b1, qr[d0], p1, 0, 0, 0); }
}
template <int ND>
__device__ __forceinline__ void softmax_pv(f32x16& p0, f32x16& p1, f32x16 (&oT)[ND], float& m, float& l, lds_cptr vp) {
    float rm = p0[0];
#pragma unroll
    for (int r = 1; r < 16; ++r) rm = fmaxf(rm, p0[r]);
#pragma unroll
    for (int r = 0; r < 16; ++r) rm = fmaxf(rm, p1[r]);
    rm = hmax(rm);
    const float mn = fmaxf(m, rm);
    const float alpha = __builtin_amdgcn_exp2f(m - mn);
    m = mn;
    float s = 0.f;
#pragma unroll
    for (int r = 0; r < 16; ++r) { p0[r] = __builtin_amdgcn_exp2f(p0[r] - mn); p1[r] = __builtin_amdgcn_exp2f(p1[r] - mn); s += p0[r] + p1[r]; }
    l = l * alpha + s;
#pragma unroll
    for (int d = 0; d < ND; ++d) oT[d] = oT[d] * alpha;
    u32x4 pw[4];
#pragma unroll
    for (int k = 0; k < 2; ++k) {
        pw[k]     = (u32x4){cvtpk(p0[8 * k], p0[8 * k + 1]), cvtpk(p0[8 * k + 2], p0[8 * k + 3]), cvtpk(p0[8 * k + 4], p0[8 * k + 5]), cvtpk(p0[8 * k + 6], p0[8 * k + 7])};
        pw[2 + k] = (u32x4){cvtpk(p1[8 * k], p1[8 * k + 1]), cvtpk(p1[8 * k + 2], p1[8 * k + 3]), cvtpk(p1[8 * k + 4], p1[8 * k + 5]), cvtpk(p1[8 * k + 6], p1[8 * k + 7])}; }
#pragma unroll
    for (int d = 0; d < ND; ++d)
#pragma unroll
        for (int ks = 0; ks < 4; ++ks) {
            const s16x4 lo = vtr(vp + d * 4096 + ks * 1024), hi = vtr(vp + d * 4096 + ks * 1024 + 512);
            const bf16x8 vf = (bf16x8){lo[0], lo[1], lo[2], lo[3], hi[0], hi[1], hi[2], hi[3]};
            oT[d] = __builtin_amdgcn_mfma_f32_32x32x16_bf16(vf, __builtin_bit_cast(bf16x8, pw[ks]), oT[d], 0, 0, 0); }
}
template <int ND>
__device__ __forceinline__ void stg_flush(const LAS unsigned char* stg, bf16_t* ybase, int lane) {
    constexpr int RB = ND * 64 + 16, CPR = ND * 4;
#pragma unroll
    for (int i = 0; i < 32 * CPR / 64; ++i) { const int idx = i * 64 + lane, row = idx / CPR, ch = idx % CPR;
        const u32x4 v = *(const LAS u32x4*)(stg + row * RB + ch * 16); *(u32x4*)(ybase + (size_t)row * DM + ch * 8) = v; }
}
template <int ND>
__device__ __forceinline__ void store_oT(const f32x16 (&oT)[ND], float scale, bf16_t* ybase, size_t elem_off, int hi) {
    if (OUTPROJ_FP8) { unsigned char* orow = (unsigned char*)ybase + elem_off; const float sc8 = scale * Y_SCALE;
#pragma unroll
        for (int d = 0; d < ND; ++d)
#pragma unroll
            for (int g = 0; g < 4; ++g) { int t = 0; t = __builtin_amdgcn_cvt_pk_fp8_f32(oT[d][4 * g] * sc8, oT[d][4 * g + 1] * sc8, t, false); t = __builtin_amdgcn_cvt_pk_fp8_f32(oT[d][4 * g + 2] * sc8, oT[d][4 * g + 3] * sc8, t, true);
                *(unsigned*)(orow + d * 32 + 8 * g + 4 * hi) = (unsigned)t; } }
    else { bf16_t* orow = ybase + elem_off;
#pragma unroll
        for (int d = 0; d < ND; ++d)
#pragma unroll
            for (int g = 0; g < 4; ++g) { u32x2 w; w.x = cvtpk(oT[d][4 * g] * scale, oT[d][4 * g + 1] * scale); w.y = cvtpk(oT[d][4 * g + 2] * scale, oT[d][4 * g + 3] * scale);
                *(u32x2*)(orow + d * 32 + 8 * g + 4 * hi) = w; } }
}
constexpr int NA_BIAS_OFF = 65536;
struct DiffArgs { const bf16_t* qkv; bf16_t* y; const float* subln_g; float lam; float omli; int with_ctx; const bf16_t* q; };

#define DF_THR 8.0f
#define DF_BAR()   asm volatile("s_waitcnt lgkmcnt(0)\n\ts_barrier" ::: "memory")
#define DF_BARV()  asm volatile("s_waitcnt vmcnt(0) lgkmcnt(0)\n\ts_barrier" ::: "memory")
__device__ __forceinline__ void diff_phase2(LAS unsigned char* lds, const DiffArgs A, int vcu, int G) {
    int tid = threadIdx.x; asm volatile("" : "+v"(tid));
    const int lane = tid & 63, r32 = lane & 31, hi = lane >> 5; const int wid = __builtin_amdgcn_readfirstlane(tid >> 6);
    constexpr int P = 3072;
    const unsigned lds0 = (unsigned)(uintptr_t)lds;
    const lds_cptr l3 = (lds_cptr)lds;
    const int mp = wid >> 2, qsub = wid & 3;
    LAS float* xch = (LAS float*)lds + qsub * 4096 + lane;
    const int nmain = NB * 8 * 32, nunits = nmain + (A.with_ctx ? NB * 8 * 2 : 0);
    for (int u = vcu; u < nunits; u += G) {
        int b, h, qrow0, NT; const bool ctxu = u >= nmain;
        if (!ctxu) { const int qb = u & 31; h = (u >> 5) & 7; b = u >> 8; qrow0 = b * SEQ + 128 * qb + 32 * qsub; NT = 4 + 64; }
        else { const int v = u - nmain; const int qb = v & 1; h = (v >> 1) & 7; b = v >> 4; qrow0 = MX + b * CTXL + 128 * qb + 32 * qsub; NT = 4; }
        const bf16_t* Kc = A.qkv + (size_t)(MX + b * CTXL) * P + 1024 + 128 * h;
        const bf16_t* Kx = A.qkv + (size_t)(b * SEQ) * P + 1024 + 128 * h;
        const int krow = 8 * wid + (lane >> 3); const size_t koff = (size_t)krow * P + (((lane & 7) ^ ((krow >> 1) & 7)) * 8);
        const int pv0 = 2 * wid, pv1 = 2 * wid + 1;
        const int vra = 4 * pv0 + (lane >> 4), vrb = 4 * pv1 + (lane >> 4); const int vph = lane & 15;
        const size_t voffa = (size_t)vra * P + 1024 + ((((vph >> 2) ^ (vra & 3)) << 2) | (vph & 3)) * 8;
        const size_t voffb = (size_t)vrb * P + 1024 + ((((vph >> 2) ^ (vrb & 3)) << 2) | (vph & 3)) * 8;
#define DF_DMA(t) do { if ((t) < NT) { const int slot_ = (t) % 3; const bf16_t* base_ = ((t) < 4) ? Kc + (size_t)(t) * 64 * P : Kx + (size_t)((t) - 4) * 64 * P; \
        glds16(base_ + koff,      (unsigned)__builtin_amdgcn_readfirstlane(lds0 + slot_ * 32768 + wid * 1024)); \
        glds16(base_ + koff + 64, (unsigned)__builtin_amdgcn_readfirstlane(lds0 + slot_ * 32768 + 8192 + wid * 1024)); \
        glds16(base_ + voffa,     (unsigned)__builtin_amdgcn_readfirstlane(lds0 + slot_ * 32768 + 16384 + pv0 * 1024)); \
        glds16(base_ + voffb,     (unsigned)__builtin_amdgcn_readfirstlane(lds0 + slot_ * 32768 + 16384 + pv1 * 1024)); } } while (0)
        DF_DMA(0);
        bf16x8 qr[4];
        { const bf16_t* Qw = A.qkv + (size_t)(qrow0 + r32) * P + h * 128 + mp * 64;
#pragma unroll
          for (int d0 = 0; d0 < 4; ++d0) qr[d0] = *(const bf16x8*)(Qw + d0 * 16 + hi * 8); }
        f32x16 oT[4]; oT[0] = f32x16{}; oT[1] = f32x16{}; oT[2] = f32x16{}; oT[3] = f32x16{};
        float m = 0.f, l = 0.f;
        f32x16 p0, p1; u32x4 pw[4];
        const int ksw = (r32 >> 1) & 7; const lds_cptr kp0 = l3 + mp * 8192 + r32 * 128 + ((hi ^ (ksw & 1)) << 4); const int ks2 = ksw >> 1;
        const int vq = (lane & 15) >> 2; const lds_cptr vp0 = l3 + 16384 + (4 * hi + vq) * 256 + ((lane >> 4) & 1) * 32 + (lane & 3) * 8;
#define DF_LOADV(dst, vp_, d) do { const lds_cptr vd_ = (vp_) + (((d) ^ vq) << 6); _Pragma("unroll") for (int ks = 0; ks < 4; ++ks) { const s16x4 lo_ = vtr(vd_ + ks * 4096), hi_ = vtr(vd_ + ks * 4096 + 2048); \
            dst[ks] = (bf16x8){lo_[0], lo_[1], lo_[2], lo_[3], hi_[0], hi_[1], hi_[2], hi_[3]}; } } while (0)
#define DF_PV4(src, d) do { _Pragma("unroll") for (int ks = 0; ks < 4; ++ks) oT[d] = __builtin_amdgcn_mfma_f32_32x32x16_bf16(src[ks], __builtin_bit_cast(bf16x8, pw[ks]), oT[d], 0, 0, 0); } while (0)
#define DF_LOADK(dst, kb_, dd) do { dst[0] = *(const LAS bf16x8*)((kb_) + ((((dd)) ^ ks2) << 5)); dst[1] = *(const LAS bf16x8*)((kb_) + ((((dd)) ^ ks2) << 5) + 4096); \
            dst[2] = *(const LAS bf16x8*)((kb_) + ((((dd) + 1) ^ ks2) << 5)); dst[3] = *(const LAS bf16x8*)((kb_) + ((((dd) + 1) ^ ks2) << 5) + 4096); } while (0)
#define DF_QK4(src, dd) do { p0 = __builtin_amdgcn_mfma_f32_32x32x16_bf16(src[0], qr[dd], p0, 0, 0, 0); p1 = __builtin_amdgcn_mfma_f32_32x32x16_bf16(src[1], qr[dd], p1, 0, 0, 0); \
            p0 = __builtin_amdgcn_mfma_f32_32x32x16_bf16(src[2], qr[(dd) + 1], p0, 0, 0, 0); p1 = __builtin_amdgcn_mfma_f32_32x32x16_bf16(src[3], qr[(dd) + 1], p1, 0, 0, 0); } while (0)
#define DF_PREV(vso) do { const lds_cptr vq_ = vp0 + (vso); DF_LOADV(fa, vq_, 0); DF_LOADV(fb, vq_, 1); SBAR(); } while (0)
#define DF_PINIT() do { _Pragma("unroll") for (int r = 0; r < 16; ++r) { p0[r] = -m; p1[r] = -m; } } while (0)
#define DF_SEGM(DO_PV, DO_QK, vso, kso) do { const lds_cptr vp_ = vp0 + (vso); const lds_cptr kb_ = kp0 + (kso); SBAR(); __builtin_amdgcn_s_setprio(1); \
        if (DO_PV) { DF_PV4(fa, 0); SBAR(); DF_LOADV(fa, vp_, 2); SBAR(); \
            DF_PV4(fb, 1); SBAR(); DF_LOADV(fb, vp_, 3); if (DO_QK) { DF_PINIT(); } SBAR(); \
            DF_PV4(fa, 2); SBAR(); if (DO_QK) { DF_LOADK(fa, kb_, 0); } SBAR(); \
            DF_PV4(fb, 3); SBAR(); if (DO_QK) { DF_LOADK(fb, kb_, 2); } SBAR(); } \
        else if (DO_QK) { DF_LOADK(fa, kb_, 0); DF_LOADK(fb, kb_, 2); DF_PINIT(); SBAR(); } \
        if (DO_QK) { DF_QK4(fa, 0); SBAR(); DF_QK4(fb, 2); SBAR(); } \
        __builtin_amdgcn_s_setprio(0); } while (0)
#define DF_SEGV(t) do { \
        float rm = p0[0]; \
        _Pragma("unroll") for (int r = 1; r < 16; ++r) rm = fmaxf(rm, p0[r]); \
        _Pragma("unroll") for (int r = 0; r < 16; ++r) rm = fmaxf(rm, p1[r]); \
        rm = hmax(rm); \
        if ((t) == 0 || __any(rm > DF_THR)) { const float dl = ((t) == 0) ? rm : fmaxf(rm, 0.f); m += dl; \
            _Pragma("unroll") for (int r = 0; r < 16; ++r) { p0[r] -= dl; p1[r] -= dl; } \
            const float f = __builtin_amdgcn_exp2f(-dl); l *= f; \
            _Pragma("unroll") for (int d = 0; d < 4; ++d) oT[d] = oT[d] * f; } \
        float s_ = 0.f; \
        _Pragma("unroll") for (int r = 0; r < 16; ++r) { p0[r] = __builtin_amdgcn_exp2f(p0[r]); p1[r] = __builtin_amdgcn_exp2f(p1[r]); s_ += p0[r] + p1[r]; } \
        l += s_; \
        _Pragma("unroll") for (int k = 0; k < 2; ++k) { \
            pw[k]     = (u32x4){cvtpk(p0[8 * k], p0[8 * k + 1]), cvtpk(p0[8 * k + 2], p0[8 * k + 3]), cvtpk(p0[8 * k + 4], p0[8 * k + 5]), cvtpk(p0[8 * k + 6], p0[8 * k + 7])}; \
            pw[2 + k] = (u32x4){cvtpk(p1[8 * k], p1[8 * k + 1]), cvtpk(p1[8 * k + 2], p1[8 * k + 3]), cvtpk(p1[8 * k + 4], p1[8 * k + 5]), cvtpk(p1[8 * k + 6], p1[8 * k + 7])}; } \
        } while (0)
        DF_BARV();
        int so_p = 0, so_c = 0;
#define DF_ROT() do { so_p = so_c; so_c = (so_c == 65536) ? 0 : so_c + 32768; } while (0)
        bf16x8 fa[4], fb[4];
        if (mp == 0) {
            DF_DMA(1); DF_SEGM(false, true, 0, so_c); SBAR(); DF_PREV(so_c); DF_SEGV(0); SBAR(); DF_BARV(); SBAR();
            for (int t = 1; t < NT; ++t) { DF_ROT();
                DF_DMA(t + 1); DF_SEGM(true, true, so_p, so_c); SBAR(); DF_PREV(so_c); DF_SEGV(t); SBAR(); DF_BARV(); SBAR(); }
            DF_ROT();
            DF_SEGM(true, false, so_p, 0); SBAR(); DF_BARV(); SBAR();
        } else {
            DF_DMA(1); DF_SEGM(false, true, 0, so_c); SBAR(); DF_BARV(); SBAR();
            for (int t = 1; t < NT; ++t) { DF_ROT();
                DF_DMA(t + 1); DF_PREV(so_p); DF_SEGV(t - 1); SBAR(); DF_SEGM(true, true, so_p, so_c); SBAR(); DF_BARV(); SBAR(); }
            DF_ROT();
            DF_PREV(so_p); DF_SEGV(NT - 1); SBAR(); DF_SEGM(true, false, so_p, 0); SBAR(); DF_BARV(); SBAR();
        }
#undef DF_ROT
        l = hsum(l);
        const float il = 1.f / l;
        if (mp == 1) { const float sc = il * A.lam;
#pragma unroll
            for (int d = 0; d < 4; ++d)
#pragma unroll
                for (int q = 0; q < 16; ++q) xch[(d * 16 + q) * 64] = oT[d][q] * sc; }
        DF_BARV();
        if (mp == 0) {
            float ss = 0.f;
#pragma unroll
            for (int d = 0; d < 4; ++d)
#pragma unroll
                for (int q = 0; q < 16; ++q) { const float v = oT[d][q] * il - xch[(d * 16 + q) * 64]; oT[d][q] = v; ss += v * v; }
            ss = hsum(ss);
            const float rstd = rsqrtf(ss * (1.f / 128.f) + RMS_EPS) * A.omli;
            const size_t eo = (size_t)(qrow0 + r32) * DM + h * 128;
#pragma unroll
            for (int d = 0; d < 4; ++d)
#pragma unroll
                for (int g = 0; g < 4; ++g) { const f32x4 gg = *(const f32x4*)(A.subln_g + d * 32 + 8 * g + 4 * hi);
                    if (OUTPROJ_FP8) { const float r8 = rstd * Y_SCALE; int t = 0; t = __builtin_amdgcn_cvt_pk_fp8_f32(oT[d][4 * g] * r8 * gg[0], oT[d][4 * g + 1] * r8 * gg[1], t, false);
                        t = __builtin_amdgcn_cvt_pk_fp8_f32(oT[d][4 * g + 2] * r8 * gg[2], oT[d][4 * g + 3] * r8 * gg[3], t, true);
                        *(unsigned*)((unsigned char*)A.y + eo + d * 32 + 8 * g + 4 * hi) = (unsigned)t; }
                    else { u32x2 w; w.x = cvtpk(oT[d][4 * g] * rstd * gg[0], oT[d][4 * g + 1] * rstd * gg[1]); w.y = cvtpk(oT[d][4 * g + 2] * rstd * gg[2], oT[d][4 * g + 3] * rstd * gg[3]);
                        *(u32x2*)(A.y + eo + d * 32 + 8 * g + 4 * hi) = w; } }
        }
        DF_BAR();
#undef DF_DMA
#undef DF_SEGM
#undef DF_SEGV
#undef DF_PINIT
#undef DF_PREV
#undef DF_LOADV
#undef DF_PV4
#undef DF_LOADK
#undef DF_QK4
    }
}

#define D3_PIN(x) asm volatile("" : "+v"(x))
#define D3_EX(v) __builtin_amdgcn_exp2f(v)
__device__ __forceinline__ void diff_phase3(LAS unsigned char* lds, const DiffArgs A, int vcu, int G) {
    int tid = threadIdx.x; asm volatile("" : "+v"(tid));
    const int lane = tid & 63, r32 = lane & 31, hi = lane >> 5; const int wid = __builtin_amdgcn_readfirstlane(tid >> 6);
    constexpr int P = 3072;
    const unsigned lds0 = (unsigned)(uintptr_t)lds;
    const lds_cptr l3 = (lds_cptr)lds;
    const int mp = wid >> 2, qsub = wid & 3;
    const int nmain = NB * 8 * 32, nunits = nmain + (A.with_ctx ? NB * 8 * 2 : 0);
    for (int u = vcu; u < nunits; u += G) {
        int b, h, qrow0, NT; const bool ctxu = u >= nmain;
        if (!ctxu) { const int qb = u & 31; h = (u >> 5) & 7; b = u >> 8; qrow0 = b * SEQ + 128 * qb + 32 * qsub; NT = 4 + 64; }
        else { const int v = u - nmain; const int qb = v & 1; h = (v >> 1) & 7; b = v >> 4; qrow0 = MX + b * CTXL + 128 * qb + 32 * qsub; NT = 4; }
        const bf16_t* Kc = A.qkv + (size_t)(MX + b * CTXL) * P + 1024 + 128 * h;
        const bf16_t* Kx = A.qkv + (size_t)(b * SEQ) * P + 1024 + 128 * h;
        const int kra = 16 * qsub + (lane >> 3), krb = kra + 8; const int vr0 = 16 * qsub + (lane >> 4); const int vph = lane & 15;
        const unsigned d0 = mp ? (unsigned)vr0 * P + 1024 + ((((vph >> 2) ^ (vr0 & 3)) << 2) | (vph & 3)) * 8 : (unsigned)kra * P + (((lane & 7) ^ ((kra >> 1) & 7)) * 8);
        const unsigned d1 = mp ? d0 + 4 * P : (unsigned)krb * P + (((lane & 7) ^ ((krb >> 1) & 7)) * 8);
        const unsigned inc2 = mp ? 8 * P : 64;
        const unsigned e0 = lds0 + (mp ? 32768 + qsub * 4096 : qsub * 2048), e2 = e0 + (mp ? 2048 : 8192);
#define D3_DMA(t) do { const int t_ = (t); if (t_ < NT) { const bf16_t* base_ = (t_ < 4) ? Kc + (size_t)t_ * 64 * P : Kx + (size_t)(t_ - 4) * 64 * P; \
        const unsigned so_ = (mp ? (t_ & 3) : (t_ & 1)) * 16384; \
        glds16(base_ + d0,        (unsigned)__builtin_amdgcn_readfirstlane(e0 + so_)); \
        glds16(base_ + d1,        (unsigned)__builtin_amdgcn_readfirstlane(e0 + so_ + 1024)); \
        glds16(base_ + d0 + inc2, (unsigned)__builtin_amdgcn_readfirstlane(e2 + so_)); \
        glds16(base_ + d1 + inc2, (unsigned)__builtin_amdgcn_readfirstlane(e2 + so_ + 1024)); } } while (0)
#define D3_WAITBAR(T) do { if (mp == 0 || (T) + 1 >= NT) DF_BARV(); else asm volatile("s_waitcnt vmcnt(4) lgkmcnt(0)\n\ts_barrier" ::: "memory"); } while (0)
        D3_DMA(0);
        bf16x8 qr[4];
        { const bf16_t* Qw = A.q + ((size_t)(qrow0 >> 5) * 16 + 2 * h + mp) * 2048 + hi * 256 + r32 * 8;
#pragma unroll
          for (int d0 = 0; d0 < 4; ++d0) qr[d0] = *(const bf16x8*)(Qw + d0 * 512); }
        f32x16 oT[4]; oT[0] = f32x16{}; oT[1] = f32x16{}; oT[2] = f32x16{}; oT[3] = f32x16{};
        f32x16 negm;
        float m = 0.f, l = 0.f, rf = 1.f; bool resc = false;
        f32x16 pA0, pA1, pB0, pB1; u32x4 pw0, pw1, pw2, pw3;
        const int ksw = (r32 >> 1) & 7; const lds_cptr kp0 = l3 + mp * 8192 + r32 * 128 + ((hi ^ (ksw & 1)) << 4); const int ks2 = ksw >> 1;
        const int vq = (lane & 15) >> 2; const lds_cptr vp0 = l3 + 32768 + (4 * hi + vq) * 256 + ((lane >> 4) & 1) * 32 + (lane & 3) * 8;
#define D3_KF(kb_, g) (*(const LAS bf16x8*)((kb_) + (((((g) >> 1)) ^ ks2) << 5) + ((g) & 1) * 4096))
#define D3_VF(vp_, g) ({ const lds_cptr vd_ = (vp_) + (((((g) >> 2)) ^ vq) << 6) + ((g) & 3) * 4096; const s16x4 lo_ = vtr(vd_), hi_ = vtr(vd_ + 2048); (bf16x8){lo_[0], lo_[1], lo_[2], lo_[3], hi_[0], hi_[1], hi_[2], hi_[3]}; })
#define D3_PK(P, B) cvtpk(P[B], P[(B) + 1])
#define D3_KSEL(g) (((g) & 1) ? kf1 : kf0)
#define D3_GA(g, C0, C1, Q0, Q1, HASQK, HASVA, FIRST) do { \
        if (HASQK) { \
            if ((g) == 0) { if (FIRST) C0 = __builtin_amdgcn_mfma_f32_32x32x16_bf16(D3_KSEL(g), qr[0], f32x16{}, 0, 0, 0); else C0 = __builtin_amdgcn_mfma_f32_32x32x16_bf16(D3_KSEL(g), qr[0], negm, 0, 0, 0); } \
            else if ((g) == 1) { if (FIRST) C1 = __builtin_amdgcn_mfma_f32_32x32x16_bf16(D3_KSEL(g), qr[0], f32x16{}, 0, 0, 0); else C1 = __builtin_amdgcn_mfma_f32_32x32x16_bf16(D3_KSEL(g), qr[0], negm, 0, 0, 0); } \
            else if ((g) & 1) C1 = __builtin_amdgcn_mfma_f32_32x32x16_bf16(D3_KSEL(g), qr[(g) >> 1], C1, 0, 0, 0); else C0 = __builtin_amdgcn_mfma_f32_32x32x16_bf16(D3_KSEL(g), qr[(g) >> 1], C0, 0, 0, 0); \
            if ((g) + 2 < 8) { if ((g) & 1) kf1 = D3_KF(kb_, (g) + 2); else kf0 = D3_KF(kb_, (g) + 2); } } \
        if (HASVA) { if ((g) == 6) vf0 = D3_VF(vp_, 0); if ((g) == 7) vf1 = D3_VF(vp_, 1); } \
        if (HASVA) { if ((g) < 5) { Q1[5 + 2 * (g)] = D3_EX(Q1[5 + 2 * (g)]); Q1[6 + 2 * (g)] = D3_EX(Q1[6 + 2 * (g)]); } if ((g) == 5) { Q1[15] = D3_EX(Q1[15]); } \
            if ((g) == 0) { pw0[0] = D3_PK(Q0, 0); pw0[1] = D3_PK(Q0, 2); } if ((g) == 1) { pw0[2] = D3_PK(Q0, 4); pw0[3] = D3_PK(Q0, 6); D3_PIN(pw0); } \
            if ((g) == 2) { pw1[0] = D3_PK(Q0, 8); pw1[1] = D3_PK(Q0, 10); } if ((g) == 3) { pw1[2] = D3_PK(Q0, 12); pw1[3] = D3_PK(Q0, 14); D3_PIN(pw1); } \
            if ((g) == 4) { pw2[0] = D3_PK(Q1, 0); pw2[1] = D3_PK(Q1, 2); } if ((g) == 5) { pw2[2] = D3_PK(Q1, 4); pw2[3] = D3_PK(Q1, 6); D3_PIN(pw2); } \
            if ((g) == 6) { pw3[0] = D3_PK(Q1, 8); pw3[1] = D3_PK(Q1, 10); } if ((g) == 7) { pw3[2] = D3_PK(Q1, 12); pw3[3] = D3_PK(Q1, 14); D3_PIN(pw3); } \
            } \
        SBAR(); } while (0)
#define D3_PWSEL(g) (((g) & 3) == 0 ? pw0 : ((g) & 3) == 1 ? pw1 : ((g) & 3) == 2 ? pw2 : pw3)
#define D3_EXI(C0, C1, e) do { if ((e) < 16) C0[(e) & 15] = D3_EX(C0[(e) & 15]); else C1[(e) & 15] = D3_EX(C1[(e) & 15]); } while (0)
#define D3_GB(g, C0, C1, Q0, Q1, HASPV, HASVB, FIRST) do { \
        if (HASPV) { \
            oT[(g) >> 2] = __builtin_amdgcn_mfma_f32_32x32x16_bf16(((g) & 1) ? vf1 : vf0, __builtin_bit_cast(bf16x8, D3_PWSEL(g)), oT[(g) >> 2], 0, 0, 0); \
            if ((g) + 2 < 16) { if ((g) & 1) vf1 = D3_VF(vp_, (g) + 2); else vf0 = D3_VF(vp_, (g) + 2); } } \
        if (HASPV) { if ((g) < 4) { sacc += Q0[4 * ((g) & 3)]; sacc += Q0[4 * ((g) & 3) + 1]; sacc += Q0[4 * ((g) & 3) + 2]; sacc += Q0[4 * ((g) & 3) + 3]; D3_PIN(sacc); } \
            else if ((g) < 8) { sacc += Q1[4 * ((g) & 3)]; sacc += Q1[4 * ((g) & 3) + 1]; sacc += Q1[4 * ((g) & 3) + 2]; sacc += Q1[4 * ((g) & 3) + 3]; D3_PIN(sacc); } \
            else if ((g) == 8) { l += sacc; } } \
        if (HASVB) { if ((g) < 4) { rmx = fmaxf(fmaxf(rmx, C0[4 * ((g) & 3)]), C0[4 * ((g) & 3) + 1]); rmx = fmaxf(fmaxf(rmx, C0[4 * ((g) & 3) + 2]), C0[4 * ((g) & 3) + 3]); D3_PIN(rmx); } \
            else if ((g) < 8) { rmx = fmaxf(fmaxf(rmx, C1[4 * ((g) & 3)]), C1[4 * ((g) & 3) + 1]); rmx = fmaxf(fmaxf(rmx, C1[4 * ((g) & 3) + 2]), C1[4 * ((g) & 3) + 3]); D3_PIN(rmx); } \
            else if ((g) == 8) { rmx = hmax(rmx); resc = false; \
                if (FIRST || __any(rmx > DF_THR)) { const float dl = FIRST ? rmx : fmaxf(rmx, 0.f); m += dl; \
                    _Pragma("unroll") for (int r_ = 0; r_ < 16; ++r_) { C0[r_] -= dl; C1[r_] -= dl; negm[r_] = -m; } D3_PIN(negm); \
                    rf = D3_EX(-dl); l *= rf; resc = true; } } \
            else { const int e0_ = 3 * ((g) - 9);   \
                D3_EXI(C0, C1, e0_); D3_EXI(C0, C1, e0_ + 1); D3_EXI(C0, C1, e0_ + 2); if (e0_ + 2 < 16) D3_PIN(C0); else D3_PIN(C1); } } \
        SBAR(); } while (0)
#define D3_STEP(C0, C1, Q0, Q1, HASQK, HASPREV, FIRST, T) do { \
        const lds_cptr kb_ = kp0 + ((T) & 1) * 16384; const lds_cptr vp_ = vp0 + (((T) - 1) & 3) * 16384; bf16x8 kf0, kf1, vf0, vf1; float sacc = 0.f, rmx = -3.0e38f; \
        if (HASQK) D3_DMA((T) + 1); \
        SBAR(); if (HASQK) { kf0 = D3_KF(kb_, 0); kf1 = D3_KF(kb_, 1); } \
        D3_GA(0, C0, C1, Q0, Q1, HASQK, HASPREV, FIRST); D3_GA(1, C0, C1, Q0, Q1, HASQK, HASPREV, FIRST); D3_GA(2, C0, C1, Q0, Q1, HASQK, HASPREV, FIRST); D3_GA(3, C0, C1, Q0, Q1, HASQK, HASPREV, FIRST); \
        D3_GA(4, C0, C1, Q0, Q1, HASQK, HASPREV, FIRST); D3_GA(5, C0, C1, Q0, Q1, HASQK, HASPREV, FIRST); D3_GA(6, C0, C1, Q0, Q1, HASQK, HASPREV, FIRST); D3_GA(7, C0, C1, Q0, Q1, HASQK, HASPREV, FIRST); \
        if (HASQK) { if (mp == 1) D3_WAITBAR(T); } \
        D3_GB(0, C0, C1, Q0, Q1, HASPREV, HASQK, FIRST); D3_GB(1, C0, C1, Q0, Q1, HASPREV, HASQK, FIRST); D3_GB(2, C0, C1, Q0, Q1, HASPREV, HASQK, FIRST); D3_GB(3, C0, C1, Q0, Q1, HASPREV, HASQK, FIRST); \
        D3_GB(4, C0, C1, Q0, Q1, HASPREV, HASQK, FIRST); D3_GB(5, C0, C1, Q0, Q1, HASPREV, HASQK, FIRST); D3_GB(6, C0, C1, Q0, Q1, HASPREV, HASQK, FIRST); D3_GB(7, C0, C1, Q0, Q1, HASPREV, HASQK, FIRST); \
        D3_GB(8, C0, C1, Q0, Q1, HASPREV, HASQK, FIRST); D3_GB(9, C0, C1, Q0, Q1, HASPREV, HASQK, FIRST); D3_GB(10, C0, C1, Q0, Q1, HASPREV, HASQK, FIRST); D3_GB(11, C0, C1, Q0, Q1, HASPREV, HASQK, FIRST); \
        D3_GB(12, C0, C1, Q0, Q1, HASPREV, HASQK, FIRST); D3_GB(13, C0, C1, Q0, Q1, HASPREV, HASQK, FIRST); D3_GB(14, C0, C1, Q0, Q1, HASPREV, HASQK, FIRST); D3_GB(15, C0, C1, Q0, Q1, HASPREV, HASQK, FIRST); \
        if (HASQK && resc) { _Pragma("unroll") for (int d_ = 0; d_ < 4; ++d_) oT[d_] = oT[d_] * rf; } \
        if (HASQK) { if (mp == 0) D3_WAITBAR(T); } \
        } while (0)
        DF_BARV();
        D3_STEP(pA0, pA1, pB0, pB1, true, false, true, 0);
        int t = 1;
        for (; t + 1 < NT; t += 2) {
            D3_STEP(pB0, pB1, pA0, pA1, true, true, false, t);
            D3_STEP(pA0, pA1, pB0, pB1, true, true, false, t + 1);
        }
        D3_STEP(pB0, pB1, pA0, pA1, true, true, false, t);
        D3_STEP(pA0, pA1, pB0, pB1, false, true, false, NT);
        l = hsum(l);
        const float il = 1.f / l;
        DF_BAR();
        LAS float* xch = (LAS float*)lds + qsub * 4096 + lane;
        if (mp == 1) { const float sc = il * A.lam;
#pragma unroll
            for (int d = 0; d < 4; ++d)
#pragma unroll
                for (int q = 0; q < 16; ++q) xch[(d * 16 + q) * 64] = oT[d][q] * sc; }
        DF_BAR();
        if (mp == 0) {
            float ss = 0.f;
#pragma unroll
            for (int d = 0; d < 4; ++d)
#pragma unroll
                for (int q = 0; q < 16; ++q) { const float v = oT[d][q] * il - xch[(d * 16 + q) * 64]; oT[d][q] = v; ss += v * v; }
            ss = hsum(ss);
            const float rstd = rsqrtf(ss * (1.f / 128.f) + RMS_EPS) * A.omli;
            LAS unsigned char* stg = lds + qsub * 16384;
#pragma unroll
            for (int d = 0; d < 4; ++d)
#pragma unroll
                for (int g = 0; g < 4; ++g) { const f32x4 gg = *(const f32x4*)(A.subln_g + d * 32 + 8 * g + 4 * hi);
                    u32x2 w; w.x = cvtpk(oT[d][4 * g] * rstd * gg[0], oT[d][4 * g + 1] * rstd * gg[1]); w.y = cvtpk(oT[d][4 * g + 2] * rstd * gg[2], oT[d][4 * g + 3] * rstd * gg[3]);
                    *(LAS u32x2*)(stg + r32 * 272 + (d * 32 + 8 * g + 4 * hi) * 2) = w; }
            stg_flush<4>(stg, A.y + (size_t)qrow0 * DM + h * 128, lane);
        }
        DF_BAR();
#undef D3_DMA
#undef D3_KF
#undef D3_KSEL
#undef D3_VF
#undef D3_PK
#undef D3_GA
#undef D3_GB
#undef D3_EXI
#undef D3_PWSEL
#undef D3_STEP
#undef D3_WAITBAR
    }
}

struct A2Args { const bf16_t* qkv; bf16_t* y; const float* aux; int with_ctx; const bf16_t* q; };
template <int MODE  >
__device__ __forceinline__ void att2_phase(LAS unsigned char* lds, const A2Args A, int vcu, int G) {
    int tid = threadIdx.x; asm volatile("" : "+v"(tid));
    const int lane = tid & 63, r32 = lane & 31, hi = lane >> 5; const int wid = __builtin_amdgcn_readfirstlane(tid >> 6);
    constexpr int P = MODE == 0 ? 1536 : 3072; constexpr int VOFF = MODE == 0 ? 256 : 1024;
    const unsigned lds0 = (unsigned)(uintptr_t)lds;
    const lds_cptr l3 = (lds_cptr)lds;
    const int grp = wid >> 2;
    LAS float* btab = (LAS float*)(lds + NA_BIAS_OFF + 1024);
    const int nmain = MODE == 0 ? NB * 4 * 32 * 2 : NB * 16 * 16;
    const int nunits = nmain + (A.with_ctx ? (MODE == 0 ? NB * 4 * 4 : NB * 16) : 0);
    for (int u = vcu; u < nunits; u += G) {
        int b, hk, hq, qrow0, nwin, k0win; const bool ctxu = u >= nmain; int qs = 0, r = 0, c = 0;
        if (MODE == 0) {
            if (!ctxu) { const int hp = u & 1, j = (u >> 1) & 31; hk = (u >> 6) & 3; b = u >> 8; hq = 4 * hk + 2 * hp + (wid >> 2); qs = 128 * j + 32 * (wid & 3); qrow0 = b * SEQ + qs;
                const int ks = max(0, 128 * (j - 1)), ke = min(SEQ, 128 * (j + 2)); k0win = ks; nwin = (ke - ks) / 64; }
            else { const int v = u - nmain; hk = (v >> 2) & 3; hq = 4 * hk + (v & 3); b = v >> 4; qrow0 = MX + b * CTXL + 32 * wid; nwin = 0; k0win = 0; }
        } else {
            if (!ctxu) { const int uu = u & 15; hk = hq = (u >> 4) & 15; b = u >> 8; r = 4 * uu + (wid >> 1); c = 32 * (wid & 1) + r32; qrow0 = b * SEQ + r * 64 + 32 * (wid & 1);
                const int rs_lo = min(max(4 * uu - 4, 0), 56), rs_hi = min(max(4 * uu + 3 - 4, 0), 56); k0win = rs_lo * 64; nwin = rs_hi + 8 - rs_lo; }
            else { const int v = u - nmain; hk = hq = v & 15; b = v >> 4; qrow0 = MX + b * CTXL + 32 * wid; nwin = 0; k0win = 0; }
        }
        const int NT = 4 + nwin;
        const bf16_t* Kc = A.qkv + (size_t)(MX + b * CTXL) * P + 1024 + 64 * hk;
        const bf16_t* Kx = A.qkv + (size_t)(b * SEQ + k0win) * P + 1024 + 64 * hk;
        const int krow = 8 * wid + (lane >> 3); const size_t koff = (size_t)krow * P + (((lane & 7) ^ ((krow >> 1) & 7)) * 8), voff = (size_t)krow * P + VOFF + (((lane & 7) ^ (((krow >> 1) & 1) << 2)) * 8);
#define A2_DMA(t) do { if ((t) < NT) { const int slot_ = (t) % 3; const bf16_t* base_ = ((t) < 4) ? Kc + (size_t)(t) * 64 * P : Kx + (size_t)((t) - 4) * 64 * P; \
        glds16(base_ + koff, (unsigned)__builtin_amdgcn_readfirstlane(lds0 + slot_ * 16384 + wid * 1024)); \
        glds16(base_ + voff, (unsigned)__builtin_amdgcn_readfirstlane(lds0 + slot_ * 16384 + 8192 + wid * 1024)); } } while (0)
        A2_DMA(0);
        if (MODE == 1) { if (!ctxu && tid < 15 * 31) btab[tid] = A.aux[hq * 465 + tid] * LOG2E; }
        bf16x8 qr[4];
        { const bf16_t* Qw = A.q + ((size_t)(qrow0 >> 5) * 16 + hq) * 2048 + hi * 256 + r32 * 8;
#pragma unroll
          for (int d0 = 0; d0 < 4; ++d0) qr[d0] = *(const bf16x8*)(Qw + d0 * 512); }
        f32x16 oT[2]; oT[0] = f32x16{}; oT[1] = f32x16{};
        float m = 0.f, l = 0.f;
        f32x16 p0, p1; u32x4 pw[4];
        const int ksw = (r32 >> 1) & 7; const lds_cptr kp0 = l3 + r32 * 128 + ((hi ^ (ksw & 1)) << 4); const int ks2 = ksw >> 1;
        const int vq = (lane & 15) >> 2, vsq = (vq >> 1) & 1; const lds_cptr vp0 = l3 + 8192 + (4 * hi + vq) * 128 + ((lane >> 4) & 1) * 32 + (lane & 3) * 8;
        const int rs = min(max(r - 4, 0), 56), cs = min(max(c - 8, 0), 48);
#define A2_LOADV(dst, vp_, d) do { const lds_cptr vd_ = (vp_) + (((d) ^ vsq) << 6); _Pragma("unroll") for (int ks = 0; ks < 4; ++ks) { const s16x4 lo_ = vtr(vd_ + ks * 2048), hi_ = vtr(vd_ + ks * 2048 + 1024); \
            dst[ks] = (bf16x8){lo_[0], lo_[1], lo_[2], lo_[3], hi_[0], hi_[1], hi_[2], hi_[3]}; } } while (0)
#define A2_PV4(src, d) do { _Pragma("unroll") for (int ks = 0; ks < 4; ++ks) oT[d] = __builtin_amdgcn_mfma_f32_32x32x16_bf16(src[ks], __builtin_bit_cast(bf16x8, pw[ks]), oT[d], 0, 0, 0); } while (0)
#define A2_LOADK(dst, kb_, dd) do { dst[0] = *(const LAS bf16x8*)((kb_) + ((((dd)) ^ ks2) << 5)); dst[1] = *(const LAS bf16x8*)((kb_) + ((((dd)) ^ ks2) << 5) + 4096); \
            dst[2] = *(const LAS bf16x8*)((kb_) + ((((dd) + 1) ^ ks2) << 5)); dst[3] = *(const LAS bf16x8*)((kb_) + ((((dd) + 1) ^ ks2) << 5) + 4096); } while (0)
#define A2_QK4(src, dd) do { p0 = __builtin_amdgcn_mfma_f32_32x32x16_bf16(src[0], qr[dd], p0, 0, 0, 0); p1 = __builtin_amdgcn_mfma_f32_32x32x16_bf16(src[1], qr[dd], p1, 0, 0, 0); \
            p0 = __builtin_amdgcn_mfma_f32_32x32x16_bf16(src[2], qr[(dd) + 1], p0, 0, 0, 0); p1 = __builtin_amdgcn_mfma_f32_32x32x16_bf16(src[3], qr[(dd) + 1], p1, 0, 0, 0); } while (0)
#define A2_PREV(vso) do { const lds_cptr vq_ = vp0 + (vso); A2_LOADV(fa, vq_, 0); A2_LOADV(fb, vq_, 1); SBAR(); } while (0)
#define A2_PINIT() do { _Pragma("unroll") for (int q_ = 0; q_ < 16; ++q_) { p0[q_] = -m; p1[q_] = -m; } } while (0)
#define A2_SEGM(DO_PV, DO_QK, vso, kso) do { const lds_cptr kb_ = kp0 + (kso); SBAR(); __builtin_amdgcn_s_setprio(1); \
        if (DO_PV) { A2_PV4(fa, 0); if (DO_QK) { A2_PINIT(); } SBAR(); if (DO_QK) { A2_LOADK(fa, kb_, 0); } SBAR(); A2_PV4(fb, 1); SBAR(); if (DO_QK) { A2_LOADK(fb, kb_, 2); } SBAR(); } \
        else if (DO_QK) { A2_LOADK(fa, kb_, 0); A2_LOADK(fb, kb_, 2); A2_PINIT(); SBAR(); } \
        if (DO_QK) { A2_QK4(fa, 0); SBAR(); A2_QK4(fb, 2); SBAR(); } \
        __builtin_amdgcn_s_setprio(0); } while (0)
#define A2_SEGV(t) do { \
        if ((t) >= 4) { \
            if (MODE == 0) { const int kb0_ = k0win + 64 * ((t) - 4); if ((kb0_ + 63 > qs + 128) || (kb0_ < qs + 31 - 128)) { const int dq_ = kb0_ + 4 * hi - (qs + r32) + 128; \
                _Pragma("unroll") for (int q_ = 0; q_ < 16; ++q_) { const int kk_ = (q_ & 3) + 8 * (q_ >> 2); if ((unsigned)(dq_ + kk_) > 256u) p0[q_] = NEG_BIG; if ((unsigned)(dq_ + kk_ + 32) > 256u) p1[q_] = NEG_BIG; } } } \
            else { const int kr_ = (k0win >> 6) + (t) - 4; const bool rowok_ = (kr_ >= rs) && (kr_ < rs + 8); const int rel_ = rowok_ ? 4 * hi - cs : 1000; const LAS float* bp_ = btab + (rowok_ ? kr_ - r + 7 : 0) * 31 + 4 * hi - c + 15; \
                _Pragma("unroll") for (int q_ = 0; q_ < 16; ++q_) { const int kk_ = (q_ & 3) + 8 * (q_ >> 2); const float b0_ = bp_[kk_], b1_ = bp_[kk_ + 32]; \
                    p0[q_] = ((unsigned)(rel_ + kk_) < 16u) ? p0[q_] + b0_ : NEG_BIG; p1[q_] = ((unsigned)(rel_ + kk_ + 32) < 16u) ? p1[q_] + b1_ : NEG_BIG; } } } \
        float rm = p0[0]; \
        _Pragma("unroll") for (int q_ = 1; q_ < 16; ++q_) rm = fmaxf(rm, p0[q_]); \
        _Pragma("unroll") for (int q_ = 0; q_ < 16; ++q_) rm = fmaxf(rm, p1[q_]); \
        rm = hmax(rm); \
        if ((t) == 0 || __any(rm > DF_THR)) { const float dl = ((t) == 0) ? rm : fmaxf(rm, 0.f); m += dl; \
            _Pragma("unroll") for (int q_ = 0; q_ < 16; ++q_) { p0[q_] -= dl; p1[q_] -= dl; } \
            const float f = __builtin_amdgcn_exp2f(-dl); l *= f; oT[0] = oT[0] * f; oT[1] = oT[1] * f; } \
        float s_ = 0.f; \
        _Pragma("unroll") for (int q_ = 0; q_ < 16; ++q_) { p0[q_] = __builtin_amdgcn_exp2f(p0[q_]); p1[q_] = __builtin_amdgcn_exp2f(p1[q_]); s_ += p0[q_] + p1[q_]; } \
        l += s_; \
        _Pragma("unroll") for (int k = 0; k < 2; ++k) { \
            pw[k]     = (u32x4){cvtpk(p0[8 * k], p0[8 * k + 1]), cvtpk(p0[8 * k + 2], p0[8 * k + 3]), cvtpk(p0[8 * k + 4], p0[8 * k + 5]), cvtpk(p0[8 * k + 6], p0[8 * k + 7])}; \
            pw[2 + k] = (u32x4){cvtpk(p1[8 * k], p1[8 * k + 1]), cvtpk(p1[8 * k + 2], p1[8 * k + 3]), cvtpk(p1[8 * k + 4], p1[8 * k + 5]), cvtpk(p1[8 * k + 6], p1[8 * k + 7])}; } \
        } while (0)
        DF_BARV();
        int so_p = 0, so_c = 0;
#define A2_ROT() do { so_p = so_c; so_c = (so_c == 32768) ? 0 : so_c + 16384; } while (0)
        bf16x8 fa[4], fb[4];
        if (grp == 0) {
            A2_DMA(1); A2_SEGM(false, true, 0, so_c); SBAR(); A2_PREV(so_c); A2_SEGV(0); SBAR(); DF_BARV(); SBAR();
            for (int t = 1; t < NT; ++t) { A2_ROT();
                A2_DMA(t + 1); A2_SEGM(true, true, so_p, so_c); SBAR(); A2_PREV(so_c); A2_SEGV(t); SBAR(); DF_BARV(); SBAR(); }
            A2_ROT();
            A2_SEGM(true, false, so_p, 0); SBAR(); DF_BARV(); SBAR();
        } else {
            A2_DMA(1); A2_SEGM(false, true, 0, so_c); SBAR(); DF_BARV(); SBAR();
            for (int t = 1; t < NT; ++t) { A2_ROT();
                A2_DMA(t + 1); A2_PREV(so_p); A2_SEGV(t - 1); SBAR(); A2_SEGM(true, true, so_p, so_c); SBAR(); DF_BARV(); SBAR(); }
            A2_ROT();
            A2_PREV(so_p); A2_SEGV(NT - 1); SBAR(); A2_SEGM(true, false, so_p, 0); SBAR(); DF_BARV(); SBAR();
        }
        l = hsum(l);
        if (MODE == 0) l += __builtin_amdgcn_exp2f(A.aux[hq] * LOG2E - m);
        if (OUTPROJ_FP8) store_oT<2>(oT, 1.f / l, A.y, (size_t)(qrow0 + r32) * DM + hq * 64, hi);
        else { LAS unsigned char* stg = lds + wid * 8192; const float sc_ = 1.f / l;
#pragma unroll
            for (int d = 0; d < 2; ++d)
#pragma unroll
                for (int g = 0; g < 4; ++g) { u32x2 w; w.x = cvtpk(oT[d][4 * g] * sc_, oT[d][4 * g + 1] * sc_); w.y = cvtpk(oT[d][4 * g + 2] * sc_, oT[d][4 * g + 3] * sc_);
                    *(LAS u32x2*)(stg + r32 * 144 + (d * 32 + 8 * g + 4 * hi) * 2) = w; }
            stg_flush<2>(stg, A.y + (size_t)qrow0 * DM + hq * 64, lane); }
        DF_BAR();
#undef A2_DMA
#undef A2_LOADV
#undef A2_PV4
#undef A2_LOADK
#undef A2_QK4
#undef A2_SEGM
#undef A2_SEGV
#undef A2_PREV
#undef A2_PINIT
#undef A2_ROT
    }
}
#undef SBAR
}

struct Frame {
    LAS unsigned char* lds; volatile LAS unsigned* MISC; unsigned* ctl;
    int tid, lane, wave, vcu, G;
};

__device__ __forceinline__ void transpose_item(const float* W, int K, int N, bf16_t* WT, int k0, int n0, int drow0, LAS float* scr, int lane) {
    f32x4 v[16];
    const float* src = W + (size_t)(k0 + (lane >> 4)) * N + n0 + 4 * (lane & 15);
#pragma unroll
    for (int i = 0; i < 16; ++i) v[i] = *(const f32x4*)(src + (size_t)(4 * i) * N);
#pragma unroll
    for (int i = 0; i < 16; ++i) { LAS float* d = scr + (4 * i + (lane >> 4)) * 65 + 4 * (lane & 15); d[0] = v[i].x; d[1] = v[i].y; d[2] = v[i].z; d[3] = v[i].w; }
    LDS_WAIT(); asm volatile("" ::: "memory");
    const int c = lane & 7;
#pragma unroll
    for (int j = 0; j < 8; ++j) { const int n = (lane >> 3) + 8 * j; const LAS float* s = scr + (8 * c) * 65 + n;
        u32x4 o; o.x = cvtpk(s[0 * 65], s[1 * 65]); o.y = cvtpk(s[2 * 65], s[3 * 65]); o.z = cvtpk(s[4 * 65], s[5 * 65]); o.w = cvtpk(s[6 * 65], s[7 * 65]);
        *(u32x4*)(WT + (size_t)(drow0 + n) * K + k0 + 8 * c) = o; }
    LDS_WAIT(); asm volatile("" ::: "memory");
}

enum { KA_x, KA_c, KA_ctx, KA_c_ctx, KA_ada_w, KA_ada_b, KA_norm1_g, KA_norm2_g, KA_final_g, KA_win_w_in, KA_win_w_out, KA_win_sink, KA_diff_w_in, KA_diff_w_out, KA_diff_lambda, KA_diff_subln_g,
       KA_na_w_in, KA_na_w_out, KA_na_rpb, KA_router_w, KA_w_gate, KA_w_up, KA_w_down, KA_OUT, KA_WS };
__device__ __forceinline__ const float* karg(int i) { asm volatile("" : "+s"(i)); return (const float*)(((const unsigned long long __attribute__((address_space(4)))*)__builtin_amdgcn_kernarg_segment_ptr())[i]); }
__device__ __forceinline__ void t8_load(f32x4 (&v)[16], const float* W, int N, int k0, int n0, int lane) {
    const float* src = W + (size_t)(k0 + (lane >> 4)) * N + n0 + 4 * (lane & 15);
#pragma unroll
    for (int i = 0; i < 16; ++i) v[i] = *(const f32x4*)(src + (size_t)(4 * i) * N);
}
__device__ __forceinline__ void t8_finish(const f32x4 (&v)[16], int Kb, unsigned char* WT, int k0, int drow0, LAS float* scr, int lane) {
#pragma unroll
    for (int i = 0; i < 16; ++i) { LAS float* d = scr + (4 * i + (lane >> 4)) * 65 + 4 * (lane & 15); d[0] = v[i].x * W8_SCALE; d[1] = v[i].y * W8_SCALE; d[2] = v[i].z * W8_SCALE; d[3] = v[i].w * W8_SCALE; }
    LDS_WAIT(); asm volatile("" ::: "memory");
    const int c = lane & 3;
#pragma unroll
    for (int j = 0; j < 4; ++j) { const int n = (lane >> 2) + 16 * j; const LAS float* s = scr + (16 * c) * 65 + n;
        int w[4];
#pragma unroll
        for (int q = 0; q < 4; ++q) { int t = 0; t = __builtin_amdgcn_cvt_pk_fp8_f32(s[(4 * q) * 65], s[(4 * q + 1) * 65], t, false); t = __builtin_amdgcn_cvt_pk_fp8_f32(s[(4 * q + 2) * 65], s[(4 * q + 3) * 65], t, true); w[q] = t; }
        *(u32x4*)(WT + (size_t)(drow0 + n) * Kb + k0 + 16 * c) = (u32x4){(unsigned)w[0], (unsigned)w[1], (unsigned)w[2], (unsigned)w[3]}; }
    LDS_WAIT(); asm volatile("" ::: "memory");
}
__device__ __forceinline__ void transpose_item8(const float* W, int Kb, int N, unsigned char* WT, int k0, int n0, int drow0, LAS float* scr, int lane) {
    f32x4 v[16]; t8_load(v, W, N, k0, n0, lane); t8_finish(v, Kb, WT, k0, drow0, scr, lane);
}

struct In {
    const float *x, *c, *ctx, *c_ctx, *ada_w, *ada_b, *norm1_g, *norm2_g, *final_g, *win_w_in, *win_w_out, *win_sink, *diff_w_in, *diff_w_out, *diff_lambda, *diff_subln_g,
        *na_w_in, *na_w_out, *na_rpb, *router_w, *w_gate, *w_up, *w_down;
};

__device__ __forceinline__ void phase_prologue(Frame& F, unsigned char* ws) {
    int tid_ = threadIdx.x; asm volatile("" : "+v"(tid_)); const int lane_ = tid_ & 63; const int wave_ = __builtin_amdgcn_readfirstlane(tid_ >> 6);
    LAS float* scr = (LAS float*)(F.lds + wave_ * 16640);
    const int gw = F.vcu * NWAVES + wave_, NGW = F.G * NWAVES;
    if (F.vcu == 0) {
        float* tab = (float*)(ws + WS_TAB);
        for (int i = tid_; i < 1024; i += 512) { const int pos = i >> 4, f = i & 15; const float inv = 1.0f / powf(10000.0f, (float)(2 * f) / 32.0f); const float ang = (float)pos * inv;
            tab[TAB_COS + i] = cosf(ang); tab[TAB_SIN + i] = sinf(ang); }
        if (wave_ == 0) { const float* lp = karg(KA_diff_lambda); const float a = wave_sum(lp[lane_] * lp[64 + lane_]), b2 = wave_sum(lp[128 + lane_] * lp[192 + lane_]);
            const float li = 0.8f - 0.6f * expf(-0.3f * 1.0f); if (lane_ == 0) { tab[TAB_LAM] = expf(a) - expf(b2) + li; tab[TAB_LAM + 1] = 1.0f - li; } }
    }
    {
        bf16_t* pw = (bf16_t*)(ws + WS_PW);
        constexpr int IT_WI = 16 * 24, IT_O = 16 * 16, IT_3 = 16 * 48;
        constexpr int NIT = 2 * IT_WI + 2 * IT_O + IT_3 + IT_O + IT_3 + IT_O;
        for (int it = gw; it < NIT; it += NGW) {
            int r = it; const float* W; bf16_t* WT; int N;
            if (r < 2 * IT_WI) { const int s = r / IT_WI; r -= s * IT_WI; W = karg(KA_win_w_in) + (size_t)s * 1024 * 1536; WT = pw + (PW_WIN_IN / 2) + (size_t)s * 1536 * 1024; N = 1536; }
            else if ((r -= 2 * IT_WI) < 2 * IT_O) { const int s = r / IT_O; r -= s * IT_O; W = karg(KA_win_w_out) + (size_t)s * 1024 * 1024; WT = pw + (PW_WIN_OUT / 2) + (size_t)s * 1024 * 1024; N = 1024; }
            else if ((r -= 2 * IT_O) < IT_3) { W = karg(KA_diff_w_in); WT = pw + PW_DIFF_IN / 2; N = 3072; }
            else if ((r -= IT_3) < IT_O) { W = karg(KA_diff_w_out); WT = pw + PW_DIFF_OUT / 2; N = 1024; }
            else if ((r -= IT_O) < IT_3) { W = karg(KA_na_w_in); WT = pw + PW_NA_IN / 2; N = 3072; }
            else { r -= IT_3; W = karg(KA_na_w_out); WT = pw + PW_NA_OUT / 2; N = 1024; }
            const int nblk = N / 64, kb = r / nblk, nb = r % nblk;
            if ((INPROJ_FP8 && N != 1024) || (OUTPROJ_FP8 && N == 1024)) transpose_item8(W, 1024, N, (unsigned char*)WT, 64 * kb, 64 * nb, 64 * nb, scr, lane_);
            else transpose_item(W, 1024, N, WT, 64 * kb, 64 * nb, 64 * nb, scr, lane_);
        }
    }
    {
        const int NIT = 64 * 1536;
#define MW_DESC(it_, W_, N_, Kb_, WT_, k0_, n0_, dr_) do { const int le_ = (it_) / 1536; int r_ = (it_) % 1536; \
            unsigned char* W1t_ = ws + WS_MOEW + (size_t)le_ * MOEW_E; \
            if (r_ < 1024) { const bool up_ = r_ >= 512; r_ &= 511; W_ = (up_ ? karg(KA_w_up) : karg(KA_w_gate)) + (size_t)le_ * 1024 * 2048; N_ = 2048; Kb_ = 1024; WT_ = W1t_; \
                k0_ = 64 * (r_ / 32); n0_ = 64 * (r_ % 32); dr_ = (n0_ >> 7) * 256 + (up_ ? 128 : 0) + (n0_ & 127); } \
            else { r_ -= 1024; W_ = karg(KA_w_down) + (size_t)le_ * 2048 * 1024; N_ = 1024; Kb_ = 2048; WT_ = W1t_ + (size_t)4096 * 1024; k0_ = 64 * (r_ / 16); n0_ = 64 * (r_ % 16); dr_ = n0_; } } while (0)
        f32x4 va[16], vb[16];
        const float* Wc = nullptr; int Nc = 0, Kbc = 0, k0c = 0, n0c = 0, drc = 0; unsigned char* WTc = nullptr;
        int it = gw;
        if (it < NIT) { MW_DESC(it, Wc, Nc, Kbc, WTc, k0c, n0c, drc); t8_load(va, Wc, Nc, k0c, n0c, lane_); }
        while (it < NIT) {
            const int itn = it + NGW;
            const float* Wn = Wc; int Nn = Nc, Kbn = Kbc, k0n = k0c, n0n = n0c, drn = drc; unsigned char* WTn = WTc;
            if (itn < NIT) { MW_DESC(itn, Wn, Nn, Kbn, WTn, k0n, n0n, drn); t8_load(vb, Wn, Nn, k0n, n0n, lane_); }
            t8_finish(va, Kbc, WTc, k0c, drc, scr, lane_);
#pragma unroll
            for (int i = 0; i < 16; ++i) va[i] = vb[i];
            Wc = Wn; Nc = Nn; Kbc = Kbn; WTc = WTn; k0c = k0n; n0c = n0n; drc = drn; it = itn;
        }
#undef MW_DESC
    }
    __syncthreads();
    {
        LAS float* sc = (LAS float*)F.lds;
        LAS float* red = (LAS float*)(F.lds + 69632);
        for (int i = tid_; i < 17 * 1024; i += 512) { const float v = (i < 16384) ? karg(KA_c)[i] : karg(KA_c_ctx)[i - 16384]; sc[i] = siluf(v); }
        __syncthreads();
        float* mod = (float*)(ws + WS_MOD);
        for (int task = F.vcu; task < 4 * 192; task += F.G) {
            const int L = task / 192, cg = task % 192, col = cg * 32 + (lane_ & 31), kh = lane_ >> 5;
            const float* wp = karg(KA_ada_w) + (size_t)L * 1024 * 6144 + (size_t)(wave_ * 128 + kh * 64) * 6144 + col;
            const LAS float* scp = sc + wave_ * 128 + kh * 64;
            float acc[17];
#pragma unroll
            for (int r = 0; r < 17; ++r) acc[r] = 0.f;
            for (int k0 = 0; k0 < 64; k0 += 16) { float w[16];
#pragma unroll
                for (int kk = 0; kk < 16; ++kk) w[kk] = wp[(size_t)(k0 + kk) * 6144];
#pragma unroll
                for (int kk = 0; kk < 16; ++kk)
#pragma unroll
                    for (int r = 0; r < 17; ++r) acc[r] += scp[r * 1024 + k0 + kk] * w[kk]; }
#pragma unroll
            for (int r = 0; r < 17; ++r) { acc[r] += __shfl_xor(acc[r], 32); if (lane_ < 32) red[(wave_ * 17 + r) * 32 + lane_] = acc[r]; }
            __syncthreads();
            for (int i = tid_; i < 17 * 32; i += 512) { const int r = i >> 5, ln = i & 31; float sum = 0.f;
#pragma unroll
                for (int w = 0; w < 8; ++w) sum += red[(w * 17 + r) * 32 + ln];
                mod[((size_t)L * 17 + r) * 6144 + cg * 32 + ln] = sum + karg(KA_ada_b)[L * 6144 + cg * 32 + ln]; }
            __syncthreads();
        }
    }
}

__device__ __forceinline__ void load_row(const float* row, int lane, f32x4 (&v)[4]) {
    const f32x4* xr = (const f32x4*)row + lane;
#pragma unroll
    for (int j = 0; j < 4; ++j) v[j] = xr[64 * j];
}
__device__ __forceinline__ void load_row_bf16(const bf16_t* row, int lane, u32x2 (&w)[4]) {
    const u32x2* p = (const u32x2*)row + lane;
#pragma unroll
    for (int j = 0; j < 4; ++j) w[j] = p[64 * j];
}
__device__ __forceinline__ void cvt_row_bf16(f32x4 (&v)[4], const u32x2 (&w)[4]) {
#pragma unroll
    for (int j = 0; j < 4; ++j) { v[j].x = __builtin_bit_cast(float, w[j].x << 16); v[j].y = __builtin_bit_cast(float, w[j].x & 0xffff0000u);
        v[j].z = __builtin_bit_cast(float, w[j].y << 16); v[j].w = __builtin_bit_cast(float, w[j].y & 0xffff0000u); }
}
__device__ __forceinline__ void add_row_bf16(f32x4 (&v)[4], const u32x2 (&w)[4]) {
#pragma unroll
    for (int j = 0; j < 4; ++j) { v[j].x += __builtin_bit_cast(float, w[j].x << 16); v[j].y += __builtin_bit_cast(float, w[j].x & 0xffff0000u);
        v[j].z += __builtin_bit_cast(float, w[j].y << 16); v[j].w += __builtin_bit_cast(float, w[j].y & 0xffff0000u); }
}
__device__ __forceinline__ float row_rstd(const f32x4 (&v)[4]) {
    float s = 0.f;
#pragma unroll
    for (int j = 0; j < 4; ++j) s += (v[j].x * v[j].x + v[j].y * v[j].y) + (v[j].z * v[j].z + v[j].w * v[j].w);
    return rsqrtf(wave_sum_fast(s) * (1.f / DM) + RMS_EPS);
}
__device__ __forceinline__ void store_row_bf16(bf16_t* orow, int lane, const f32x4 (&v)[4]) {
    u32x2* o8 = (u32x2*)orow + lane;
#pragma unroll
    for (int j = 0; j < 4; ++j) { u32x2 w; w.x = cvtpk(v[j].x, v[j].y); w.y = cvtpk(v[j].z, v[j].w); o8[64 * j] = w; }
}
__device__ __forceinline__ void store_row_fp8(unsigned char* orow, int lane, const f32x4 (&v)[4], float scale) {
    unsigned* o4 = (unsigned*)orow + lane;
#pragma unroll
    for (int j = 0; j < 4; ++j) { int t = 0; t = __builtin_amdgcn_cvt_pk_fp8_f32(v[j].x * scale, v[j].y * scale, t, false); t = __builtin_amdgcn_cvt_pk_fp8_f32(v[j].z * scale, v[j].w * scale, t, true); o4[64 * j] = (unsigned)t; }
}
struct ModCache { f32x4 sc[4], sh[4]; int b; };
__device__ __forceinline__ void modcache_load(ModCache& M, int b, const float* g, const float* modL, int shift_chunk, int scale_chunk, int lane) {
    if (M.b == b) return; M.b = b;
    const float* mp = modL + (size_t)b * 6144;
#pragma unroll
    for (int j = 0; j < 4; ++j) { const f32x4 gg = ((const f32x4*)g)[lane + 64 * j], s = ((const f32x4*)(mp + scale_chunk * DM))[lane + 64 * j];
        M.sc[j] = gg * (1.f + s); M.sh[j] = ((const f32x4*)(mp + shift_chunk * DM))[lane + 64 * j]; }
}
__device__ __forceinline__ int row_batch(int m) { return m < MX ? (m >> 12) : 16; }

__device__ __forceinline__ void phase_norm1(Frame& F, const float* x, const float* ctx, const float* g1, const float* modL, bf16_t* H, bf16_t* XB) {
    int tid_ = threadIdx.x; asm volatile("" : "+v"(tid_)); const int lane_ = tid_ & 63; const int wave_ = __builtin_amdgcn_readfirstlane(tid_ >> 6);
    const int gw = F.vcu * NWAVES + wave_, NGW = F.G * NWAVES; const int per = (MT + NGW - 1) / NGW;
    ModCache M; M.b = -1;
    const int m0 = gw * per, m1 = min(MT, m0 + per);
    f32x4 nx[4];
    if (m0 < m1) load_row(m0 < MX ? x + (size_t)m0 * DM : ctx + (size_t)(m0 - MX) * DM, lane_, nx);
    for (int m = m0; m < m1; ++m) {
        f32x4 v[4];
#pragma unroll
        for (int j = 0; j < 4; ++j) v[j] = nx[j];
        if (m + 1 < m1) load_row((m + 1) < MX ? x + (size_t)(m + 1) * DM : ctx + (size_t)(m + 1 - MX) * DM, lane_, nx);
        modcache_load(M, row_batch(m), g1, modL, 0, 1, lane_);
        store_row_bf16(XB + (size_t)m * DM, lane_, v);
        const float rstd = row_rstd(v);
#pragma unroll
        for (int j = 0; j < 4; ++j) v[j] = v[j] * rstd * M.sc[j] + M.sh[j];
        if (INPROJ_FP8) store_row_fp8((unsigned char*)H + (size_t)m * DM, lane_, v, H2_SCALE); else store_row_bf16(H + (size_t)m * DM, lane_, v);
    }
}

__device__ __forceinline__ void phase_norm2_router(Frame& F, const bf16_t* XB, const float* g2, const float* modL, const float* rw, unsigned char* H8, float* aff, int nrows, const bf16_t* P, bool do_router = true) {
    int tid_ = threadIdx.x; asm volatile("" : "+v"(tid_)); const int lane = tid_ & 63; const int wave_ = __builtin_amdgcn_readfirstlane(tid_ >> 6);
    LAS float* rwT = (LAS float*)F.lds;
    for (int i = tid_; i < 16384; i += 512) { const int d = i >> 4, e = i & 15; rwT[e * 1024 + d] = rw[i]; }
    __syncthreads();
    const int gw = F.vcu * NWAVES + wave_, NGW = F.G * NWAVES; constexpr int NR2 = 1; const int ngroups = nrows / NR2; const int per = (ngroups + NGW - 1) / NGW;
    ModCache M; M.b = -1;
    const int g0 = gw * per, g1 = min(ngroups, g0 + per);
    constexpr int ND3 = 3;
    u32x2 nx[ND3][4];
#pragma unroll
    for (int k = 0; k < ND3; ++k) if (g0 + k < g1) { load_row_bf16(XB + (size_t)(g0 + k) * DM, lane, nx[k]); }
    for (int gb = g0; gb < g1; gb += ND3)
#pragma unroll
    for (int k = 0; k < ND3; ++k) {
        const int g = gb + k; if (g >= g1) break;
        const int m = NR2 * g;
        f32x4 v[NR2][4];
        cvt_row_bf16(v[0], nx[k]);
        if (g + ND3 < g1) { load_row_bf16(XB + (size_t)(g + ND3) * DM, lane, nx[k]); }
        modcache_load(M, row_batch(m), g2, modL, 3, 4, lane);
#pragma unroll
        for (int r = 0; r < NR2; ++r) { const float rstd = row_rstd(v[r]);
#pragma unroll
            for (int j = 0; j < 4; ++j) v[r][j] = v[r][j] * rstd * M.sc[j] + M.sh[j];
            store_row_fp8(H8 + (size_t)(m + r) * DM, lane, v[r], H2_SCALE); }
        if (!do_router) continue;
        float pe[NR2][16];
        int lo4 = 4 * lane; asm volatile("" : "+v"(lo4));
#pragma unroll
        for (int eb = 0; eb < 16; eb += 4) {
            f32x4 w[4][4];
#pragma unroll
            for (int e4 = 0; e4 < 4; ++e4)
#pragma unroll
                for (int j = 0; j < 4; ++j) w[e4][j] = *(const LAS f32x4*)(rwT + (eb + e4) * 1024 + lo4 + 256 * j);
            __builtin_amdgcn_sched_barrier(0);
#pragma unroll
            for (int e4 = 0; e4 < 4; ++e4) { f32x2 s2 = {0.f, 0.f};
#pragma unroll
                for (int j = 0; j < 4; ++j) { s2 = __builtin_elementwise_fma((f32x2){v[0][j].x, v[0][j].y}, (f32x2){w[e4][j].x, w[e4][j].y}, s2); s2 = __builtin_elementwise_fma((f32x2){v[0][j].z, v[0][j].w}, (f32x2){w[e4][j].z, w[e4][j].w}, s2); }
                pe[0][eb + e4] = s2.x + s2.y; }
            __builtin_amdgcn_sched_barrier(0);
        }
        {
            LAS float* red = (LAS float*)(F.lds + 65536) + wave_ * 1088;
#pragma unroll
            for (int e = 0; e < 16; ++e) red[lane * 17 + e] = pe[0][e];
            const LAS float* rp = red + (lane >> 4) * 272 + (lane & 15);
            float sacc = 0.f;
#pragma unroll
            for (int i = 0; i < 16; ++i) sacc += rp[i * 17];
            sacc += __shfl_xor(sacc, 16); sacc += __shfl_xor(sacc, 32);
            const float mx = row16_max(sacc);
            const float ex = expf(sacc - mx);
            const float sm = row16_sum(ex);
            if (lane < 16) aff[(size_t)m * 16 + lane] = ex / sm;
        }
    }
    __syncthreads();
}

__device__ __forceinline__ void phase_norm2_router_mfma(Frame& F, const bf16_t* XB, const float* g2, const float* modL, const float* rw, unsigned char* H8, float* aff, int nrows) {
    int tid_ = threadIdx.x; asm volatile("" : "+v"(tid_)); const int lane = tid_ & 63; const int wave_ = __builtin_amdgcn_readfirstlane(tid_ >> 6);
    constexpr int AST = 2064;
    LAS unsigned char* Ahi = F.lds; LAS unsigned char* Alo = F.lds + 16 * AST; LAS float* red = (LAS float*)(F.lds + 2 * 16 * AST);
    const int e_ = lane & 15, kg = lane >> 4;
    bf16x8 Bh[4], Bl[4];
#pragma unroll
    for (int s = 0; s < 4; ++s) { const float* wp = rw + (size_t)(128 * wave_ + 32 * s + 8 * kg) * 16 + e_;
        const float x0 = wp[0], x1 = wp[16], x2 = wp[32], x3 = wp[48], x4 = wp[64], x5 = wp[80], x6 = wp[96], x7 = wp[112];
        u32x4 h, l; h.x = cvtpk(x0, x1); h.y = cvtpk(x2, x3); h.z = cvtpk(x4, x5); h.w = cvtpk(x6, x7);
        l.x = cvtpk(x0 - __builtin_bit_cast(float, h.x << 16), x1 - __builtin_bit_cast(float, h.x & 0xffff0000u)); l.y = cvtpk(x2 - __builtin_bit_cast(float, h.y << 16), x3 - __builtin_bit_cast(float, h.y & 0xffff0000u));
        l.z = cvtpk(x4 - __builtin_bit_cast(float, h.z << 16), x5 - __builtin_bit_cast(float, h.z & 0xffff0000u)); l.w = cvtpk(x6 - __builtin_bit_cast(float, h.w << 16), x7 - __builtin_bit_cast(float, h.w & 0xffff0000u));
        Bh[s] = __builtin_bit_cast(bf16x8, h); Bl[s] = __builtin_bit_cast(bf16x8, l); }
    const int ngroups = nrows >> 4; const int per = (ngroups + F.G - 1) / F.G; const int gg0 = F.vcu * per, gg1 = min(ngroups, gg0 + per);
    ModCache M; M.b = -1;
    u32x2 nx[2][4];
    if (gg0 < gg1) { load_row_bf16(XB + (size_t)(gg0 * 16 + 2 * wave_) * DM, lane, nx[0]); load_row_bf16(XB + (size_t)(gg0 * 16 + 2 * wave_ + 1) * DM, lane, nx[1]); }
    for (int gg = gg0; gg < gg1; ++gg) {
        const int mbase = gg * 16;
        f32x4 v[2][4];
        cvt_row_bf16(v[0], nx[0]); cvt_row_bf16(v[1], nx[1]);
        if (gg + 1 < gg1) { load_row_bf16(XB + (size_t)(mbase + 16 + 2 * wave_) * DM, lane, nx[0]); load_row_bf16(XB + (size_t)(mbase + 16 + 2 * wave_ + 1) * DM, lane, nx[1]); }
#pragma unroll
        for (int r = 0; r < 2; ++r) { const int tok = 2 * wave_ + r, m = mbase + tok;
            modcache_load(M, row_batch(m), g2, modL, 3, 4, lane);
            const float rstd = row_rstd(v[r]);
#pragma unroll
            for (int j = 0; j < 4; ++j) v[r][j] = v[r][j] * rstd * M.sc[j] + M.sh[j];
            store_row_fp8(H8 + (size_t)m * DM, lane, v[r], H2_SCALE);
            LAS unsigned char* ah = Ahi + tok * AST + 8 * lane;
#pragma unroll
            for (int j = 0; j < 4; ++j) { const f32x4 x = v[r][j]; u32x2 h, l; h.x = cvtpk(x.x, x.y); h.y = cvtpk(x.z, x.w);
                l.x = cvtpk(x.x - __builtin_bit_cast(float, h.x << 16), x.y - __builtin_bit_cast(float, h.x & 0xffff0000u)); l.y = cvtpk(x.z - __builtin_bit_cast(float, h.y << 16), x.w - __builtin_bit_cast(float, h.y & 0xffff0000u));
                *(LAS u32x2*)(ah + 512 * j) = h; *(LAS u32x2*)(ah + 16 * AST + 512 * j) = l; } }
        __syncthreads();
        f32x4 acc = {0.f, 0.f, 0.f, 0.f};
#pragma unroll
        for (int s = 0; s < 4; ++s) { const LAS unsigned char* ap = Ahi + e_ * AST + 256 * wave_ + 64 * s + 16 * kg;
            const bf16x8 a_h = *(const LAS bf16x8*)ap, a_l = *(const LAS bf16x8*)(ap + 16 * AST);
            acc = __builtin_amdgcn_mfma_f32_16x16x32_bf16(a_h, Bh[s], acc, 0, 0, 0); acc = __builtin_amdgcn_mfma_f32_16x16x32_bf16(a_h, Bl[s], acc, 0, 0, 0); acc = __builtin_amdgcn_mfma_f32_16x16x32_bf16(a_l, Bh[s], acc, 0, 0, 0); }
#pragma unroll
        for (int r = 0; r < 4; ++r) red[wave_ * 256 + (4 * kg + r) * 16 + e_] = acc[r];
        __syncthreads();
        if (tid_ < 256) { float sacc = 0.f;
#pragma unroll
            for (int w = 0; w < 8; ++w) sacc += red[w * 256 + tid_];
            const float mx = row16_max(sacc);
            const float ex = expf(sacc - mx);
            const float sm = row16_sum(ex);
            aff[(size_t)(mbase + (tid_ >> 4)) * 16 + (tid_ & 15)] = ex / sm; }
    }
    __syncthreads();
}

template <int NPT>
__device__ __forceinline__ void topk_task(Frame& F, const float* aff, int rowbase, int n, int cap, int e, int slot_base, unsigned* rowsrc_e, short* slot) {
    int tid_ = threadIdx.x; asm volatile("" : "+v"(tid_)); const int lane_ = tid_ & 63; const int wave_ = __builtin_amdgcn_readfirstlane(tid_ >> 6);
    LAS unsigned* cnt = (LAS unsigned*)F.lds;
    const int tid = tid_, lane = lane_, wave = wave_;
    const bool act = tid * NPT < n;
    unsigned v[NPT];
#pragma unroll
    for (int j = 0; j < NPT; ++j) v[j] = act ? __float_as_uint(aff[(size_t)(rowbase + tid * NPT + j) * 16 + e]) : 0u;
    unsigned T = 0u;
    for (int bit = 30; bit >= 0; --bit) {
        const unsigned cand = T | (1u << bit);
        unsigned c = 0;
#pragma unroll
        for (int j = 0; j < NPT; ++j) c += (act && v[j] >= cand) ? 1u : 0u;
        c = (unsigned)wave_sum((float)c);
        LAS unsigned* cb = cnt + (bit & 1) * 8;
        if (lane == 0) cb[wave] = c;
        __syncthreads();
        unsigned tot = 0;
#pragma unroll
        for (int w = 0; w < 8; ++w) tot += cb[w];
        if (tot >= (unsigned)cap) T = cand;
    }
    unsigned ngt = 0, neq = 0;
#pragma unroll
    for (int j = 0; j < NPT; ++j) { ngt += (act && v[j] > T) ? 1u : 0u; neq += (act && v[j] == T) ? 1u : 0u; }
    unsigned pk = ngt | (neq << 16), inc = pk;
#pragma unroll
    for (int o = 1; o < 64; o <<= 1) { const unsigned t = __shfl_up(inc, o); if (lane >= o) inc += t; }
    LAS unsigned* wtot = cnt + 32;
    __syncthreads();
    if (lane == 63) wtot[wave] = inc;
    __syncthreads();
    unsigned wpre = 0, total = 0;
#pragma unroll
    for (int w = 0; w < 8; ++w) { const unsigned t = wtot[w]; if (w < wave) wpre += t; total += t; }
    const unsigned exc = wpre + inc - pk;
    const unsigned tot_gt = total & 0xffffu;
    const unsigned need_eq = (unsigned)cap - tot_gt;
    unsigned gt_before = exc & 0xffffu, eq_before = exc >> 16;
    if (act) {
#pragma unroll
        for (int j = 0; j < NPT; ++j) {
            const bool g = v[j] > T, q = v[j] == T;
            const bool sel = g || (q && eq_before < need_eq);
            const int tok = tid * NPT + j;
            short sv = -1;
            if (sel) { const unsigned pos = gt_before + min(eq_before, need_eq); sv = (short)(slot_base + pos); rowsrc_e[slot_base + pos] = (unsigned)(rowbase + tok); }
            slot[(size_t)(rowbase + tok) * 16 + e] = sv;
            gt_before += g ? 1u : 0u; eq_before += q ? 1u : 0u;
        }
    }
    __syncthreads();
}
__device__ __forceinline__ void phase_topk(Frame& F, const float* aff, unsigned* rowsrc, short* slot, int nMe, bool with_ctx) {
    const int ntask = NB * NE * (with_ctx ? 2 : 1);
    for (int t = F.vcu; t < ntask; t += F.G) {
        const bool cx = t >= NB * NE; const int tt = cx ? t - NB * NE : t; const int b = tt >> 4, e = tt & 15;
        unsigned* rs_e = rowsrc + (size_t)e * nMe * 256;
        if (!cx) topk_task<8>(F, aff, b * SEQ, SEQ, CAPX, e, b * CAPX, rs_e, slot);
        else topk_task<1>(F, aff, MX + b * CTXL, CTXL, CAPC, e, NB * CAPX + b * CAPC, rs_e, slot);
    }
}

__device__ __forceinline__ void phase_combine(Frame& F, bf16_t* XB, const bf16_t* P, float* xout, const float* modL, const float* aff, const short* slot, const bf16_t* ybuf, int nMe,
                                              int nrows, bool last, const float* gnext, const float* modN, bf16_t* H, const float* final_g, float* dump = nullptr) {
    int tid_ = threadIdx.x; asm volatile("" : "+v"(tid_)); const int lane = tid_ & 63; const int wave_ = __builtin_amdgcn_readfirstlane(tid_ >> 6);
    const int gw = F.vcu * NWAVES + wave_, NGW = F.G * NWAVES; const int per = (nrows + NGW - 1) / NGW;
    ModCache M; M.b = -1;
    f32x4 g2v[4]; int gb = -1;
    const int m0 = gw * per, m1 = min(nrows, m0 + per);
    const size_t estride = (size_t)nMe * 256 * DM;
#define CB_META(m, sv, av) do { sv = (int)slot[(size_t)(m) * 16 + (lane & 15)]; av = aff[(size_t)(m) * 16 + (lane & 15)]; } while (0)
#define CB_ISSUE(m, sv, av, X, Y, AK, REST) do { load_row_bf16(XB + (size_t)(m) * DM, lane, X); \
        unsigned mk_ = (unsigned)__ballot(sv >= 0) & 0xffffu; \
        _Pragma("unroll") for (int k = 0; k < 4; ++k) { \
            if (mk_) { const int e_ = __builtin_ctz(mk_); mk_ &= mk_ - 1u; const int s_ = __builtin_amdgcn_readlane(sv, e_); AK[k] = __builtin_bit_cast(float, __builtin_amdgcn_readlane(__builtin_bit_cast(int, av), e_)); \
                const u32x2* yr_ = (const u32x2*)(ybuf + (size_t)e_ * estride + (size_t)s_ * DM) + lane; \
                _Pragma("unroll") for (int j = 0; j < 4; ++j) Y[k][j] = yr_[64 * j]; } \
            else { AK[k] = 0.f; _Pragma("unroll") for (int j = 0; j < 4; ++j) Y[k][j] = (u32x2){0u, 0u}; } } \
        REST = mk_; } while (0)
    int sv1 = -1, sv2 = -1; float av1 = 0.f, av2 = 0.f;
    u32x2 X[4], Xn[4]; u32x2 Y[4][4], Yn[4][4]; float AK[4], AKn[4]; unsigned rest = 0, restn = 0; int svc = -1, svn = -1; float avc = 0.f, avn = 0.f;
    if (m0 < m1) { CB_META(m0, sv1, av1); CB_ISSUE(m0, sv1, av1, X, Y, AK, rest); svc = sv1; avc = av1; }
    if (m0 + 1 < m1) CB_META(m0 + 1, sv1, av1);
    for (int m = m0; m < m1; ++m) {
        if (m + 1 < m1) { CB_ISSUE(m + 1, sv1, av1, Xn, Yn, AKn, restn); svn = sv1; avn = av1; }
        if (m + 2 < m1) CB_META(m + 2, sv1, av1);
        const int b = row_batch(m);
        if (gb != b) { gb = b;
#pragma unroll
            for (int j = 0; j < 4; ++j) g2v[j] = ((const f32x4*)(modL + (size_t)b * 6144 + 5 * DM))[lane + 64 * j]; }
        f32x4 acc[4];
#pragma unroll
        for (int j = 0; j < 4; ++j) acc[j] = (f32x4){0.f, 0.f, 0.f, 0.f};
#pragma unroll
        for (int k = 0; k < 4; ++k) { const float a = AK[k];
#pragma unroll
            for (int j = 0; j < 4; ++j) { const u32x2 w = Y[k][j];
                acc[j].x += a * __builtin_bit_cast(float, w.x << 16); acc[j].y += a * __builtin_bit_cast(float, w.x & 0xffff0000u);
                acc[j].z += a * __builtin_bit_cast(float, w.y << 16); acc[j].w += a * __builtin_bit_cast(float, w.y & 0xffff0000u); } }
        while (rest) { const int e_ = __builtin_ctz(rest); rest &= rest - 1u; const int s_ = __builtin_amdgcn_readlane(svc, e_); const float a = __builtin_bit_cast(float, __builtin_amdgcn_readlane(__builtin_bit_cast(int, avc), e_));
            const u32x2* yr = (const u32x2*)(ybuf + (size_t)e_ * estride + (size_t)s_ * DM) + lane;
#pragma unroll
            for (int j = 0; j < 4; ++j) { const u32x2 w = yr[64 * j];
                acc[j].x += a * __builtin_bit_cast(float, w.x << 16); acc[j].y += a * __builtin_bit_cast(float, w.x & 0xffff0000u);
                acc[j].z += a * __builtin_bit_cast(float, w.y << 16); acc[j].w += a * __builtin_bit_cast(float, w.y & 0xffff0000u); } }
        f32x4 v[4];
        cvt_row_bf16(v, X);
#pragma unroll
        for (int j = 0; j < 4; ++j) v[j] = v[j] + g2v[j] * acc[j];
        const float rstd = row_rstd(v);
        if (!last) {
            store_row_bf16((dump ? (bf16_t*)dump : XB) + (size_t)m * DM, lane, v);
            modcache_load(M, b, gnext, modN, 0, 1, lane);
#pragma unroll
            for (int j = 0; j < 4; ++j) v[j] = v[j] * rstd * M.sc[j] + M.sh[j];
            if (INPROJ_FP8) store_row_fp8((unsigned char*)H + (size_t)m * DM, lane, v, H2_SCALE); else store_row_bf16(H + (size_t)m * DM, lane, v);
        } else {
            f32x4* o = (f32x4*)((dump ? dump : xout) + (size_t)m * DM) + lane;
#pragma unroll
            for (int j = 0; j < 4; ++j) o[64 * j] = v[j] * rstd * ((const f32x4*)final_g)[lane + 64 * j];
        }
#pragma unroll
        for (int j = 0; j < 4; ++j) { X[j] = Xn[j];
#pragma unroll
            for (int k = 0; k < 4; ++k) Y[k][j] = Yn[k][j]; }
#pragma unroll
        for (int k = 0; k < 4; ++k) AK[k] = AKn[k];
        rest = restn; svc = svn; avc = avn;
    }
#undef CB_META
#undef CB_ISSUE
}

struct Args { In in; float* out; unsigned char* ws; int ph_lo, ph_hi; };
#define WSP(off) ((unsigned char*)karg(KA_WS) + (off))
__global__ void __launch_bounds__(NWAVES * 64, 2) fwd(Args args) {
    extern __shared__ __attribute__((aligned(16))) unsigned char lds_raw[];
    Frame F;
    F.lds = (LAS unsigned char*)lds_raw;
    F.MISC = (volatile LAS unsigned*)(F.lds + MISC_OFF);
    F.tid = threadIdx.x; F.lane = F.tid & 63; F.wave = __builtin_amdgcn_readfirstlane(F.tid >> 6);
    F.G = gridDim.x; { const int bx = blockIdx.x; F.vcu = (F.G % 8 == 0) ? (bx % 8) * (F.G / 8) + bx / 8 : bx; }
    F.ctl = nullptr;
    if (F.tid < 64) ((LAS unsigned*)(F.lds + MISC_OFF))[F.tid] = 0u;
    __syncthreads();
    const int lo = args.ph_lo, hi = args.ph_hi;
    if (hi - lo > 1) (void)xcd_barrier_post((unsigned*)WSP(WS_CTL) + 1024, F.MISC + 8);
#ifndef DBG_ONLY
#define DBG_ONLY -1
#endif
#define PHEN(k) (DBG_ONLY < 0 || ((k) < 2 ? (k) : 2 + (((k) - 2) & 7)) == DBG_ONLY)
#define IN(k) (PHEN(k) && lo <= (k) && (k) < hi)
#ifndef ROUTER_MFMA
#define ROUTER_MFMA 1
#endif
#ifndef DUP_PH
#define DUP_PH -1
#endif
#ifndef DUP_LMASK
#define DUP_LMASK 0xF
#endif
#define NREP(k, L) ((DUP_PH == (k) && ((DUP_LMASK >> (L)) & 1)) ? 2 : 1)
#define SEAM(k) do { if (IN(k) && IN((k) + 1)) { XcdBarrier bar_; bar_.bar = (unsigned*)WSP(WS_CTL) + 1024; bar_.x = xb_xcc_id(); bar_.st = F.MISC + 8; xcd_barrier(bar_); } } while (0)

    if (IN(0)) { for (int rep_ = 0; rep_ < NREP(0, 0); ++rep_) phase_prologue(F, WSP(0)); } SEAM(0);
    if (IN(1)) { phase_norm1(F, karg(KA_x), karg(KA_ctx), karg(KA_norm1_g), (const float*)WSP(WS_MOD), (bf16_t*)WSP(WS_H), (bf16_t*)WSP(WS_XB)); } SEAM(1);

#pragma unroll 1
    for (int L = 0; L < DEPTH; ++L) {
        const int pb = 2 + 8 * L;
        if (hi <= pb || lo >= pb + 8) continue;
        if (IN(pb + 0)) for (int rep_ = 0; rep_ < NREP(2, L); ++rep_) {
            const int kind = L % 3, slot = L / 3; const int Nin = (kind == 0) ? 1536 : 3072;
            const bf16_t* Wt = (const bf16_t*)WSP(WS_PW) + (kind == 0 ? PW_WIN_IN / 2 + (size_t)slot * 1536 * 1024 : kind == 1 ? PW_DIFF_IN / 2 : PW_NA_IN / 2);
            pg8::Gemm g{(const char*)WSP(WS_H), (const char*)Wt, INPROJ_FP8 ? DM : DM * 2, 1 << 20, 0, nullptr};
            pg8::StaticOrder S; S.init(MT / 256, Nin / 256, F.G, (int)blockIdx.x);
            pg8::EpiInProj E{(bf16_t*)WSP(WS_QKV), Nin, 4, kind == 0 ? 5 : (kind == 1 ? 8 : 0), (const float*)WSP(WS_TAB), INPROJ_FP8 ? 1.f / (H2_SCALE * W8_SCALE) : 1.f, kind == 0 ? 5 : 8, (bf16_t*)WSP(WS_P)};
            pg8::gemm_phase<pg8::EpiInProj, false, true, INPROJ_FP8 != 0>(F.lds, g, S, E);
        }
        SEAM(pb + 0);
        if (IN(pb + 1)) for (int rep_ = 0; rep_ < NREP(3, L); ++rep_) {
            const int kind = L % 3, slot = L / 3; const int with_ctx = L < DEPTH - 1 ? 1 : 0;
            if (kind == 0) { att::A2Args A{(const bf16_t*)WSP(WS_QKV), (bf16_t*)WSP(WS_H), karg(KA_win_sink) + slot * 16, with_ctx, (const bf16_t*)WSP(WS_P)}; att::att2_phase<0>(F.lds, A, F.vcu, F.G); }
            else if (kind == 1) { const float* TAB = (const float*)WSP(WS_TAB); att::DiffArgs A{(const bf16_t*)WSP(WS_QKV), (bf16_t*)WSP(WS_H), karg(KA_diff_subln_g), TAB[TAB_LAM], TAB[TAB_LAM + 1], with_ctx, (const bf16_t*)WSP(WS_P)}; att::diff_phase3(F.lds, A, F.vcu, F.G); }
            else { att::A2Args A{(const bf16_t*)WSP(WS_QKV), (bf16_t*)WSP(WS_H), karg(KA_na_rpb), with_ctx, (const bf16_t*)WSP(WS_P)}; att::att2_phase<1>(F.lds, A, F.vcu, F.G); }
        }
        SEAM(pb + 1);
        if (IN(pb + 2)) {
            const int kind = L % 3, slot = L / 3; const bool with_ctx = L < DEPTH - 1;
            const bf16_t* Wt = (const bf16_t*)WSP(WS_PW) + (kind == 0 ? PW_WIN_OUT / 2 + (size_t)slot * 1024 * 1024 : kind == 1 ? PW_DIFF_OUT / 2 : PW_NA_OUT / 2);
            pg8::Gemm g{(const char*)WSP(WS_H), (const char*)Wt, OUTPROJ_FP8 ? DM : DM * 2, 1 << 20, 0, nullptr};
            pg8::StaticOrder S; S.init((with_ctx ? MT : MX) / 256, 4, F.G, (int)blockIdx.x);
            pg8::EpiOutProj E{(bf16_t*)WSP(WS_XB), (const float*)WSP(WS_MOD) + (size_t)L * 17 * 6144, OUTPROJ_FP8 ? 1.f / (Y_SCALE * W8_SCALE) : 1.f};
            pg8::gemm_phase<pg8::EpiOutProj, false, true, OUTPROJ_FP8 != 0>(F.lds, g, S, E);
        }
        SEAM(pb + 2);
        if (IN(pb + 3)) for (int rep_ = 0; rep_ < NREP(5, L); ++rep_) { const bool with_ctx = L < DEPTH - 1;
            if (ROUTER_MFMA && rep_ == 0) phase_norm2_router_mfma(F, (const bf16_t*)WSP(WS_XB), karg(KA_norm2_g) + L * DM, (const float*)WSP(WS_MOD) + (size_t)L * 17 * 6144, karg(KA_router_w) + (size_t)L * DM * NE,
                               (unsigned char*)WSP(WS_H), (float*)WSP(WS_AFF), with_ctx ? MT : MX);
            else phase_norm2_router(F, (const bf16_t*)WSP(WS_XB), karg(KA_norm2_g) + L * DM, (const float*)WSP(WS_MOD) + (size_t)L * 17 * 6144, karg(KA_router_w) + (size_t)L * DM * NE,
                               (unsigned char*)WSP(WS_H), (float*)WSP(WS_AFF), with_ctx ? MT : MX, (const bf16_t*)WSP(WS_P), rep_ == 0); }
        SEAM(pb + 3);
        if (IN(pb + 4)) for (int rep_ = 0; rep_ < NREP(6, L); ++rep_) { const bool with_ctx = L < DEPTH - 1; phase_topk(F, (const float*)WSP(WS_AFF), (unsigned*)WSP(WS_ROWSRC), (short*)WSP(WS_SLOT), with_ctx ? NME_FULL : NME_LAST, with_ctx); }
        SEAM(pb + 4);
        if (IN(pb + 5)) for (int rep_ = 0; rep_ < NREP(7, L); ++rep_) {
            const int nMe = (L < DEPTH - 1) ? NME_FULL : NME_LAST;
            pg8::Gemm g{(const char*)WSP(WS_H), (const char*)WSP(WS_MOEW + (size_t)L * 16 * MOEW_E), DM, nMe, MOEW_E, (const unsigned*)WSP(WS_ROWSRC)};
            pg8::StaticOrder S; S.init(16 * nMe, 16, F.G, (int)blockIdx.x);
            if (DUP_PH == 7 && rep_ == 1) { pg8::EpiSwiglu<true> E{(unsigned char*)WSP(WS_QKV), 1.f / (H2_SCALE * W8_SCALE), HID_SCALE};
                pg8::gemm_phase<pg8::EpiSwiglu<true>, true, true, true>(F.lds, g, S, E); }
            else { pg8::EpiSwiglu<false> E{(unsigned char*)WSP(WS_QKV), 1.f / (H2_SCALE * W8_SCALE), HID_SCALE};
                pg8::gemm_phase<pg8::EpiSwiglu<false>, true, true, true>(F.lds, g, S, E); }
        }
        SEAM(pb + 5);
        if (IN(pb + 6)) for (int rep_ = 0; rep_ < NREP(8, L); ++rep_) {
            const int nMe = (L < DEPTH - 1) ? NME_FULL : NME_LAST;
            pg8::Gemm g{(const char*)WSP(WS_QKV), (const char*)WSP(WS_MOEW + (size_t)L * 16 * MOEW_E + (size_t)4096 * 1024), FF, nMe, MOEW_E, nullptr};
            pg8::StaticOrder S; S.init(16 * nMe, 4, F.G, (int)blockIdx.x);
            pg8::EpiBf16 E{(bf16_t*)WSP(WS_YBUF), DM, 1.f / (HID_SCALE * W8_SCALE)};
            pg8::gemm_phase<pg8::EpiBf16, false, true, true, true>(F.lds, g, S, E);
        }
        SEAM(pb + 6);
        if (IN(pb + 7)) for (int rep_ = NREP(9, L) - 1; rep_ >= 0; --rep_) {
            const bool last = (L == DEPTH - 1); const bool with_ctx = !last;
            phase_combine(F, (bf16_t*)WSP(WS_XB), (const bf16_t*)WSP(WS_P), (float*)karg(KA_OUT), (const float*)WSP(WS_MOD) + (size_t)L * 17 * 6144, (const float*)WSP(WS_AFF), (const short*)WSP(WS_SLOT), (const bf16_t*)WSP(WS_YBUF),
                          with_ctx ? NME_FULL : NME_LAST, with_ctx ? MT : MX, last, karg(KA_norm1_g) + (last ? 0 : (L + 1) * DM), (const float*)WSP(WS_MOD) + (size_t)(last ? 0 : L + 1) * 17 * 6144,
                          rep_ ? (bf16_t*)WSP(WS_QKV + 300 * MiB) : (bf16_t*)WSP(WS_H), karg(KA_final_g), rep_ ? (float*)WSP(WS_QKV) : nullptr);
        }
        SEAM(pb + 7);
    }
#undef IN
#undef SEAM
}

extern "C" void kernel_launch(void* const* d_in, const int* in_sizes, int n_in, void* d_out, int out_size, void* d_ws, size_t ws_size, hipStream_t stream) {
    static int grid = 0;
    if (grid == 0) {
        if (n_in != 23 || out_size != MX * DM || ws_size < WS_END) { fprintf(stderr, "kernel_launch: unexpected shapes: n_in %d out %d ws %zu (need %zu)\n", n_in, out_size, ws_size, (size_t)WS_END); grid = -1; return; }
        int dev = 0, cus = 0, per_cu = 0;
        if (hipGetDevice(&dev) != hipSuccess || hipDeviceGetAttribute(&cus, hipDeviceAttributeMultiprocessorCount, dev) != hipSuccess) { grid = -1; return; }
        if (hipFuncSetAttribute((const void*)fwd, hipFuncAttributeMaxDynamicSharedMemorySize, LDS_BYTES) != hipSuccess) { fprintf(stderr, "kernel_launch: hipFuncSetAttribute failed\n"); grid = -1; return; }
        if (hipOccupancyMaxActiveBlocksPerMultiprocessor(&per_cu, (const void*)fwd, NWAVES * 64, LDS_BYTES) != hipSuccess || per_cu < 1) fprintf(stderr, "kernel_launch: occupancy query says %d\n", per_cu);
        (void)hipGetLastError();
        grid = cus;
    }
    if (grid < 0) return;
    (void)hipMemsetAsync((char*)d_ws + WS_CTL, 0, CTL_ZERO_BYTES, stream);
    Args a{};
    const float** ip = (const float**)&a.in;
    for (int i = 0; i < 23; ++i) ip[i] = (const float*)d_in[i];
    a.out = (float*)d_out; a.ws = (unsigned char*)d_ws;
    if (MK_N_LAUNCHES == 1) { a.ph_lo = 0; a.ph_hi = NPHASES; hipLaunchKernelGGL(fwd, dim3(grid), dim3(NWAVES * 64), LDS_BYTES, stream, a); }
    else for (int p = 0; p < NPHASES; ++p) { a.ph_lo = p; a.ph_hi = p + 1; hipLaunchKernelGGL(fwd, dim3(grid), dim3(NWAVES * 64), LDS_BYTES, stream, a); }
}
```

```cpp
#include <hip/hip_runtime.h>
#include <cstdio>
#include <cstdint>

#ifndef MK_N_LAUNCHES
#define MK_N_LAUNCHES 1
#endif

#define GAS __attribute__((address_space(1)))
#define LAS __attribute__((address_space(3)))
typedef unsigned short bf16_t;
typedef short bf16x8 __attribute__((ext_vector_type(8)));
typedef short s16x4 __attribute__((ext_vector_type(4)));
typedef float f32x4 __attribute__((ext_vector_type(4)));
typedef float f32x2 __attribute__((ext_vector_type(2)));
typedef float f32x16 __attribute__((ext_vector_type(16)));
typedef unsigned u32x4 __attribute__((ext_vector_type(4)));
typedef unsigned u32x2 __attribute__((ext_vector_type(2)));
typedef __bf16 bf16x2_t __attribute__((ext_vector_type(2)));
typedef GAS unsigned gu32;

constexpr int DM = 1024, NB = 16, SEQ = 4096, DEPTH = 4, CTXL = 256, NE = 16, FF = 2048;
constexpr int MX = NB * SEQ;
constexpr int MC = NB * CTXL;
constexpr int MT = MX + MC;
constexpr int CAPX = 512, CAPC = 32;
constexpr int NME_FULL = 34, NME_LAST = 32;
constexpr float C2 = 0.125f * 1.4426950408889634f;
constexpr float LOG2E = 1.4426950408889634f;
constexpr float RMS_EPS = 1e-6f;
constexpr float NEG_BIG = -1e30f;
constexpr int NWAVES = 8;
constexpr int NPHASES = 2 + 8 * DEPTH;

constexpr size_t MiB = 1u << 20;
constexpr size_t WS_CTL = 0, CTL_ZERO_BYTES = 64 * 1024;
constexpr size_t WS_MOD = 1 * MiB;
constexpr size_t WS_TAB = 3 * MiB;
constexpr size_t WS_AFF = 4 * MiB;
constexpr size_t WS_SLOT = 9 * MiB;
constexpr size_t WS_ROWSRC = 12 * MiB;
constexpr size_t WS_CTXRES = 13 * MiB;
constexpr size_t WS_PW = 29 * MiB;
constexpr size_t PW_WIN_IN = 0, PW_WIN_OUT = 6 * MiB, PW_DIFF_IN = 10 * MiB, PW_DIFF_OUT = 16 * MiB, PW_NA_IN = 18 * MiB, PW_NA_OUT = 24 * MiB;
constexpr size_t WS_H = 56 * MiB;
constexpr size_t WS_QKV = 192 * MiB;
constexpr size_t WS_YBUF = 736 * MiB;
constexpr size_t WS_MOEW = 1008 * MiB;
constexpr size_t MOEW_E = (size_t)(4096 * 1024 + 1024 * 2048);
#ifndef INPROJ_FP8
#define INPROJ_FP8 1
#endif
#ifndef OUTPROJ_FP8
#define OUTPROJ_FP8 0
#endif
constexpr float Y_SCALE = 8.f;
constexpr float H2_SCALE = 4.f, HID_SCALE = 2.f, W8_SCALE = 32.f;
constexpr size_t WS_XB = 1536 * MiB;
constexpr size_t WS_END = 1672 * MiB;
constexpr size_t WS_P = 1400 * MiB;
constexpr int TAB_COS = 0, TAB_SIN = 1024, TAB_LAM = 2048;

constexpr int RING_BYTES = 131072;
constexpr int MISC_OFF = 135168;
constexpr int LDS_BYTES = 147456;

#define LDS_WAIT() asm volatile("s_waitcnt lgkmcnt(0)" ::: "memory")
#define VM_WAIT() asm volatile("s_waitcnt vmcnt(0)" ::: "memory")

__device__ __forceinline__ unsigned cvtpk(float lo, float hi) { f32x2 v = {lo, hi}; bf16x2_t b = __builtin_convertvector(v, bf16x2_t); return __builtin_bit_cast(unsigned, b); }
__device__ __forceinline__ float bf2f(unsigned short u) { return __builtin_bit_cast(float, (unsigned)u << 16); }
__device__ __forceinline__ float wave_sum(float v) {
#pragma unroll
    for (int o = 1; o < 64; o <<= 1) v += __shfl_xor(v, o);
    return v;
}
template <int CTRL> __device__ __forceinline__ float dppf(float v) { return __builtin_bit_cast(float, __builtin_amdgcn_update_dpp(0, __builtin_bit_cast(int, v), CTRL, 0xF, 0xF, true)); }
__device__ __forceinline__ float row16_sum(float v) { v += dppf<0xB1>(v); v += dppf<0x4E>(v); v += dppf<0x141>(v); v += dppf<0x140>(v); return v; }
__device__ __forceinline__ float row16_max(float v) { v = fmaxf(v, dppf<0xB1>(v)); v = fmaxf(v, dppf<0x4E>(v)); v = fmaxf(v, dppf<0x141>(v)); v = fmaxf(v, dppf<0x140>(v)); return v; }
__device__ __forceinline__ float rdlane(float v, int l) { return __builtin_bit_cast(float, __builtin_amdgcn_readlane(__builtin_bit_cast(int, v), l)); }
__device__ __forceinline__ float wave_sum_fast(float v) { v = row16_sum(v); return (rdlane(v, 0) + rdlane(v, 16)) + (rdlane(v, 32) + rdlane(v, 48)); }
__device__ __forceinline__ float siluf(float v) { return v / (1.f + __expf(-v)); }

#define XB_TMO      128
#define XB_XCNT(j)  (256  + 64 * (j))
#define XB_XSUB(j)  (1280 + 64 * (j))
#define XB_XGEN(j)  (2304 + 64 * (j))
#define XB_TOP      3328
#define XB_TOPGEN   3392
#define XCD_BAR_WORDS 3456
#define XB_SPIN_CAP (1u << 18)
__device__ __forceinline__ unsigned xb_ld(unsigned* p)              { return __hip_atomic_load(p, __ATOMIC_RELAXED, __HIP_MEMORY_SCOPE_AGENT); }
__device__ __forceinline__ unsigned xb_add(unsigned* p, unsigned v) { return __hip_atomic_fetch_add(p, v, __ATOMIC_RELAXED, __HIP_MEMORY_SCOPE_AGENT); }
__device__ __forceinline__ unsigned xb_xcc_id() { return (unsigned)__builtin_amdgcn_s_getreg((3 << 11) | 20) & 0xFu; }
#define XB_SPIN(cond, bar) do { unsigned _sp = 0; while (cond) { __builtin_amdgcn_s_sleep(1); \
    if ((++_sp & 255u) == 0u) { if (xb_ld(&(bar)[XB_TMO])) break; if (_sp > XB_SPIN_CAP) { atomicAdd(&(bar)[XB_TMO], 1u); break; } } } } while (0)
struct XcdBarrier { unsigned* bar; unsigned x; volatile LAS unsigned* st; };
__device__ __forceinline__ XcdBarrier xcd_barrier_post(unsigned* bar, volatile LAS unsigned* st) {
    XcdBarrier b; b.bar = bar; b.x = xb_xcc_id(); b.st = st;
    if (threadIdx.x == 0) (void)xb_add(&bar[XB_XCNT(b.x)], 1u);
    return b;
}
__device__ __forceinline__ void xcd_barrier_complete(unsigned* bar, unsigned x, unsigned& nloc, unsigned& nx) {
    const unsigned G = gridDim.x * gridDim.y * gridDim.z;
    unsigned sum, cnt, mine, sp = 0u;
    for (;;) {
        sum = 0u; cnt = 0u; mine = 0u;
#pragma unroll
        for (unsigned j = 0; j < 16; ++j) { const unsigned c = xb_ld(&bar[XB_XCNT(j)]); sum += c; cnt += (c > 0u) ? 1u : 0u; mine = (j == x) ? c : mine; }
        if (sum == G) break;
        __builtin_amdgcn_s_sleep(1);
        if ((++sp & 255u) == 0u) { if (xb_ld(&bar[XB_TMO])) break; if (sp > XB_SPIN_CAP) { atomicAdd(&bar[XB_TMO], 1u); break; } }
    }
    nloc = mine > 0u ? mine : 1u; nx = cnt > 0u ? cnt : 1u;
}
__device__ __forceinline__ void xcd_barrier(const XcdBarrier& b) {
    asm volatile("s_waitcnt vmcnt(0)" ::: "memory");
    __syncthreads();
    if (threadIdx.x == 0) {
        unsigned* bar = b.bar;
        __builtin_amdgcn_s_waitcnt(0);
        unsigned nloc = b.st[0], nx = b.st[1];
        if (nloc == 0u) { xcd_barrier_complete(bar, b.x, nloc, nx); b.st[0] = nloc; b.st[1] = nx; }
        const unsigned old = xb_add(&bar[XB_XSUB(b.x)], 1u);
        const unsigned gen = old / nloc;
        if (old + 1u == (gen + 1u) * nloc) {
            __builtin_amdgcn_fence(__ATOMIC_RELEASE, "agent");
            asm volatile("s_waitcnt vmcnt(0)" ::: "memory");
            const unsigned og = xb_add(&bar[XB_TOP], 1u);
            const unsigned tg = og / nx;
            if (og + 1u == (tg + 1u) * nx) xb_add(&bar[XB_TOPGEN], 1u);
            else XB_SPIN(xb_ld(&bar[XB_TOPGEN]) == tg, bar);
            __builtin_amdgcn_fence(__ATOMIC_ACQUIRE, "agent");
            xb_add(&bar[XB_XGEN(b.x)], 1u);
            asm volatile("s_waitcnt vmcnt(0)" ::: "memory");
        } else {
            XB_SPIN(xb_ld(&bar[XB_XGEN(b.x)]) == gen, bar);
            __builtin_amdgcn_fence(__ATOMIC_ACQUIRE, "agent");
            asm volatile("s_waitcnt vmcnt(0)" ::: "memory");
        }
    }
    __syncthreads();
}

namespace pg8 {
constexpr int BM = 256, BK = 64, HALF = 128, HTB = HALF * BK * 2, NXCD = 8, WGM = 4;
typedef int v4i __attribute__((ext_vector_type(4)));
typedef int v8i __attribute__((ext_vector_type(8)));
__host__ __device__ __forceinline__ int lds_byte(int r, int c) { const int st = (r >> 4) * 2 + (c >> 5), rr = r & 15, cc = c & 31, ob = rr * 64 + cc * 2; return st * 1024 + (ob ^ (((ob >> 9) & 1) << 5)); }
__host__ __device__ __forceinline__ void stage_rc(int b, int& R, int& C) { const int st = b / 1024, sb = b % 1024, swz = sb ^ (((sb >> 9) & 1) << 5); R = (st >> 1) * 16 + swz / 64; C = (st & 1) * 32 + (swz % 64) / 2; }
__host__ __device__ __forceinline__ int perm32(int rho) { const int n = rho >> 4, i = rho & 15; return 8 * (i >> 2) + 4 * n + (i & 3); }

struct Unit { int pm, pn; };
struct Gemm { const char* A; const char* Bt; int Kb; int nMe; size_t b_estride; const unsigned* rowsrc; };

struct StaticOrder {
    int nM, nN, nwg, G, c;
    __device__ void init(int nM_, int nN_, int G_, int c_) { nM = nM_; nN = nN_; nwg = nM * nN; G = G_; c = c_; }
    __device__ bool next(int i, Unit& u) const {
        const long L = (long)i * G + c; if (L >= nwg) return false;
        int wgid = (int)L; { const int q = nwg / NXCD, r = nwg % NXCD, xcd = wgid % NXCD, off = wgid / NXCD; wgid = (xcd < r ? xcd * (q + 1) : r * (q + 1) + (xcd - r) * q) + off; }
        const int nig = WGM * nN, gid = wgid / nig, fm = gid * WGM, gsz = (nM - fm) < WGM ? (nM - fm) : WGM;
        u.pm = fm + ((wgid % nig) % gsz); u.pn = (wgid % nig) / gsz; return true;
    }
};

template <class Epi, bool GATHER, bool ALIGN_EPI, bool FP8 = false, bool ABLK = false>
__device__ __forceinline__ void gemm_phase(LAS unsigned char* lds, const Gemm g, const StaticOrder& S, const Epi& E) {
    int tid = threadIdx.x; asm volatile("" : "+v"(tid));
    const int wid = __builtin_amdgcn_readfirstlane(tid >> 6), lane = tid & 63, wr = wid >> 2, wc = wid & 3, fr = lane & 15, fq = lane >> 4;
    const int Kb = g.Kb, nt = Kb / (BK * 2);
    int Rr[2], Cc[2]; unsigned voffB[2];
#pragma unroll
    for (int i = 0; i < 2; ++i) { int R, C; stage_rc(tid * 16 + i * 8192, R, C); const int Rb = Epi::PERM ? ((R & ~31) + perm32(R & 31)) : R;
        Rr[i] = R; Cc[i] = C; voffB[i] = (unsigned)(Rb * Kb + C * 2); }
    const size_t kstep = (size_t)(BK * 2);
    const size_t kstepA = ABLK ? (size_t)32768 : kstep;
    const size_t hstep = (size_t)HALF * Kb;
    const size_t tstep = 2 * hstep;
    const unsigned ldsw = (unsigned)wid * 1024u;
    const int aoff = lds_byte(wr * 64 + fr, fq * 8), boff = lds_byte(wc * 32 + fr, fq * 8);
#define PG8_SA(b, h) (((b) * 2 + (h)) * HTB)
#define PG8_SB(b, h) ((4 + (b) * 2 + (h)) * HTB)
#define PG8_STAGE(bufoff, gbase, voff) do { _Pragma("unroll") for (int _i = 0; _i < 2; ++_i) \
        __builtin_amdgcn_global_load_lds((const unsigned*)((const char*)(gbase) + (voff)[_i]), (LAS unsigned*)(lds + (bufoff) + ldsw + _i * 8192), 16, 0, 0); } while (0)
#define PG8_LDA(dst, b, h) do { _Pragma("unroll") for (int m = 0; m < 4; ++m) _Pragma("unroll") for (int k = 0; k < 2; ++k) dst[m][k] = *(const LAS bf16x8*)(lds + PG8_SA(b, h) + aoff + m * 2048 + k * 1024); } while (0)
#define PG8_LDB(dst, b, h) do { _Pragma("unroll") for (int n = 0; n < 2; ++n) _Pragma("unroll") for (int k = 0; k < 2; ++k) dst[n][k] = *(const LAS bf16x8*)(lds + PG8_SB(b, h) + boff + n * 2048 + k * 1024); } while (0)
#define PG8_MMA(ai, bj, At, Bt) do { __builtin_amdgcn_s_setprio(1); \
        if constexpr (FP8) { _Pragma("unroll") for (int m = 0; m < 4; ++m) _Pragma("unroll") for (int n = 0; n < 2; ++n) { \
            const v8i b8_ = __builtin_shufflevector(__builtin_bit_cast(v4i, Bt[n][0]), __builtin_bit_cast(v4i, Bt[n][1]), 0, 1, 2, 3, 4, 5, 6, 7); \
            const v8i a8_ = __builtin_shufflevector(__builtin_bit_cast(v4i, At[m][0]), __builtin_bit_cast(v4i, At[m][1]), 0, 1, 2, 3, 4, 5, 6, 7); \
            asm volatile("v_mfma_f32_16x16x128_f8f6f4 %0, %1, %2, %0" : "+v"(acc[ai][bj][m][n]) : "v"(b8_), "v"(a8_)); } } \
        else { _Pragma("unroll") for (int m = 0; m < 4; ++m) _Pragma("unroll") for (int n = 0; n < 2; ++n) _Pragma("unroll") for (int k = 0; k < 2; ++k) \
            acc[ai][bj][m][n] = __builtin_amdgcn_mfma_f32_16x16x32_bf16(Bt[n][k], At[m][k], acc[ai][bj][m][n], 0, 0, 0); } \
        __builtin_amdgcn_s_setprio(0); } while (0)
#define PG8_WAIT_V(n) asm volatile("s_waitcnt vmcnt(" #n ")" ::: "memory")
#define PG8_WAIT_L(n) asm volatile("s_waitcnt lgkmcnt(" #n ")" ::: "memory")
#define PG8_BAR __builtin_amdgcn_s_barrier()
#define PG8_SCHED __builtin_amdgcn_sched_barrier(0)
#define PG8_CALC_VG(VG, U) do { _Pragma("unroll") for (int _h = 0; _h < 2; ++_h) _Pragma("unroll") for (int _i = 0; _i < 2; ++_i) { \
        const unsigned _row = (unsigned)((U).pm * BM + _h * HALF + Rr[_i]); const unsigned _src = GATHER ? g.rowsrc[_row] : _row; \
        if constexpr (ABLK) { const unsigned _r = (unsigned)(_h * HALF + Rr[_i]), _c = (unsigned)Cc[_i] >> 3; \
            VG[_h][_i] = (unsigned)(U).pm * (unsigned)(Kb * BM) + (_r >> 4) * 2048u + (_c >> 1) * 512u + (_r & 15u) * 32u + (_c & 1u) * 16u; } \
        else VG[_h][_i] = _src * (unsigned)Kb + (unsigned)Cc[_i] * 2u; } } while (0)
    Unit cur, nxt; int ui = 0;
    if (!S.next(0, cur)) return;
    f32x4 acc[2][2][4][2];
#pragma unroll
    for (int a = 0; a < 2; ++a)
#pragma unroll
        for (int b = 0; b < 2; ++b)
#pragma unroll
            for (int m = 0; m < 4; ++m)
#pragma unroll
                for (int n = 0; n < 2; ++n) acc[a][b][m][n] = (f32x4){0.f, 0.f, 0.f, 0.f};
    bf16x8 At[4][2], B0[2][2], B1[2][2];
    unsigned vg[2][2], vgn[2][2];
    PG8_CALC_VG(vg, cur);
    const char* const gA = g.A;
    const char* cB = g.Bt + (size_t)(cur.pm / g.nMe) * g.b_estride + (size_t)cur.pn * tstep;
    PG8_STAGE(PG8_SB(0, 0), cB, voffB); PG8_STAGE(PG8_SB(0, 1), cB + hstep, voffB); PG8_STAGE(PG8_SA(0, 0), gA, vg[0]); PG8_STAGE(PG8_SA(0, 1), gA, vg[1]);
    if (wr == 1) PG8_BAR;
    PG8_WAIT_V(2); PG8_BAR;
    PG8_STAGE(PG8_SB(1, 0), cB + kstep, voffB); PG8_STAGE(PG8_SA(1, 0), gA + kstepA, vg[0]); PG8_STAGE(PG8_SB(1, 1), cB + hstep + kstep, voffB);
    PG8_WAIT_V(6); PG8_BAR;
    for (;;) {
        const bool has_next = S.next(ui + 1, nxt);
        LAS unsigned char* const rsb = lds + 131072 + ((ui + 1) & 1) * 1024;
        if (has_next) {
            if constexpr (GATHER) { if (wid == 0) __builtin_amdgcn_global_load_lds((const unsigned*)(g.rowsrc + (size_t)nxt.pm * BM) + lane * 4, (LAS unsigned*)rsb, 16, 0, 0); }
            else { PG8_CALC_VG(vgn, nxt); } }
        else {
#pragma unroll
            for (int _h = 0; _h < 2; ++_h)
#pragma unroll
                for (int _i = 0; _i < 2; ++_i) vgn[_h][_i] = vg[_h][_i]; }
        const char* nB = has_next ? g.Bt + (size_t)(nxt.pm / g.nMe) * g.b_estride + (size_t)nxt.pn * tstep : cB;
        for (int t = 0; t < nt; t += 2) {
            const bool last = (t == nt - 2);
            const char* a1 = gA + (size_t)(t + 1) * kstepA;
            const char* a2 = last ? gA : gA + (size_t)(t + 2) * kstepA; const char* b2 = last ? nB : cB + (size_t)(t + 2) * kstep;
            const char* a3 = a2 + kstepA; const char* b3 = b2 + kstep;
            if constexpr (GATHER) { if (last && has_next) {
#pragma unroll
                for (int _h = 0; _h < 2; ++_h)
#pragma unroll
                    for (int _i = 0; _i < 2; ++_i) vgn[_h][_i] = *(const LAS unsigned*)(rsb + (_h * HALF + Rr[_i]) * 4) * (unsigned)Kb + (unsigned)Cc[_i] * 2u; } }
            unsigned w0[2], w1[2];
#pragma unroll
            for (int _i = 0; _i < 2; ++_i) { w0[_i] = last ? vgn[0][_i] : vg[0][_i]; w1[_i] = last ? vgn[1][_i] : vg[1][_i]; }
            PG8_LDB(B0, 0, 0); PG8_LDB(B1, 0, 1); PG8_SCHED; PG8_LDA(At, 0, 0); PG8_STAGE(PG8_SA(1, 1), a1, vg[1]);
            PG8_WAIT_V(8); PG8_WAIT_L(0); PG8_BAR; PG8_MMA(0, 0, At, B0); PG8_MMA(0, 1, At, B1); PG8_BAR; PG8_SCHED;
            PG8_LDA(At, 0, 1); PG8_STAGE(PG8_SB(0, 0), b2, voffB); PG8_STAGE(PG8_SB(0, 1), b2 + hstep, voffB); PG8_STAGE(PG8_SA(0, 0), a2, w0);
            PG8_WAIT_V(8); PG8_WAIT_L(0); PG8_BAR; PG8_MMA(1, 0, At, B0); PG8_MMA(1, 1, At, B1); PG8_BAR; PG8_SCHED;
            PG8_LDB(B0, 1, 0); PG8_LDB(B1, 1, 1); PG8_SCHED; PG8_LDA(At, 1, 0); PG8_STAGE(PG8_SA(0, 1), a2, w1);
            PG8_WAIT_V(8); PG8_WAIT_L(0); PG8_BAR; PG8_MMA(0, 0, At, B0); PG8_MMA(0, 1, At, B1); PG8_BAR; PG8_SCHED;
            PG8_LDA(At, 1, 1); PG8_STAGE(PG8_SB(1, 0), b3, voffB); PG8_STAGE(PG8_SB(1, 1), b3 + hstep, voffB); PG8_STAGE(PG8_SA(1, 0), a3, w0);
            PG8_WAIT_V(8); PG8_WAIT_L(0); PG8_BAR; PG8_MMA(1, 0, At, B0); PG8_MMA(1, 1, At, B1); PG8_BAR; PG8_SCHED;
        }
        if constexpr (ALIGN_EPI) { if (wr == 0) PG8_BAR; }
        if constexpr (FP8) asm volatile("s_nop 15\n\ts_nop 15" ::: "memory");
        E(acc, cur, wr, wc, fr, fq);
        if (!has_next) break;
#pragma unroll
        for (int a = 0; a < 2; ++a)
#pragma unroll
            for (int b = 0; b < 2; ++b)
#pragma unroll
                for (int m = 0; m < 4; ++m)
#pragma unroll
                    for (int n = 0; n < 2; ++n) acc[a][b][m][n] = (f32x4){0.f, 0.f, 0.f, 0.f};
        cur = nxt; cB = nB; ++ui;
#pragma unroll
        for (int _h = 0; _h < 2; ++_h)
#pragma unroll
            for (int _i = 0; _i < 2; ++_i) vg[_h][_i] = vgn[_h][_i];
        if constexpr (ALIGN_EPI) { if (wr == 1) PG8_BAR; }
    }
    PG8_WAIT_V(0);
    if constexpr (!ALIGN_EPI) { if (wr == 0) PG8_BAR; }
    PG8_BAR;
#undef PG8_SA
#undef PG8_SB
#undef PG8_STAGE
#undef PG8_LDA
#undef PG8_LDB
#undef PG8_MMA
#undef PG8_WAIT_V
#undef PG8_WAIT_L
#undef PG8_BAR
#undef PG8_SCHED
#undef PG8_CALC_VG
}

struct EpiInProj {
    static constexpr bool PERM = false;
    bf16_t* O; int ldc; int q_tiles; int rope_tiles; const float* tab; float osc; int v_tile0; bf16_t* Q;
    __device__ __forceinline__ void operator()(const f32x4 (&acc)[2][2][4][2], const Unit& u, int wr, int wc, int fr, int fq) const {
        const int row0 = u.pm * BM + wr * 64 + fr, col0 = u.pn * BM + wc * 32 + 4 * fq;
        const float sc = ((u.pn < q_tiles) ? C2 : 1.f) * osc;
        const bool rope = (u.pn < rope_tiles) && (u.pm < MX / BM);
        const int axis = wc & 1; const bool isv = u.pn >= v_tile0;
#pragma unroll
        for (int ai = 0; ai < 2; ++ai)
#pragma unroll
            for (int m = 0; m < 4; ++m) {
                const int row = row0 + ai * HALF + m * 16;
                f32x4 cs = {1.f, 1.f, 1.f, 1.f}, sn = {0.f, 0.f, 0.f, 0.f};
                if (rope) { const int t = row & (SEQ - 1); const int pos = axis ? (t & 63) : (t >> 6); cs = *(const f32x4*)(tab + TAB_COS + pos * 16 + 4 * fq); sn = *(const f32x4*)(tab + TAB_SIN + pos * 16 + 4 * fq); }
                bf16_t* rowp = O + (size_t)row * ldc + col0;
                bf16_t* rowq = (u.pn < q_tiles) ? Q + ((size_t)(row >> 5) * 16 + 4 * u.pn + (wc >> 1)) * 2048 + (2 * (wc & 1) + (fq >> 1)) * 512 + (fq & 1) * 256 + (row & 31) * 8
                                                : O + (size_t)row * ldc + u.pn * BM + wc * 32 + 8 * fq;
                const int qstep = (u.pn < q_tiles) ? 2 * 2048 : HALF;
#pragma unroll
                for (int bj = 0; bj < 2; ++bj) {
                    const f32x4 x1 = acc[ai][bj][m][0] * sc, x2 = acc[ai][bj][m][1] * sc;
                    const f32x4 o1 = x1 * cs - x2 * sn, o2 = x2 * cs + x1 * sn;
                    u32x2 w1, w2; w1.x = cvtpk(o1[0], o1[1]); w1.y = cvtpk(o1[2], o1[3]); w2.x = cvtpk(o2[0], o2[1]); w2.y = cvtpk(o2[2], o2[3]);
                    if (isv) { *(u32x2*)(rowp + bj * HALF) = w1; *(u32x2*)(rowp + bj * HALF + 16) = w2; }
                    else *(u32x4*)(rowq + bj * qstep) = (u32x4){w1.x, w1.y, w2.x, w2.y}; }
            }
    }
};
struct EpiOutProj {
    static constexpr bool PERM = true;
    bf16_t* P; const float* mod; float osc;
    __device__ __forceinline__ void operator()(const f32x4 (&acc)[2][2][4][2], const Unit& u, int wr, int wc, int fr, int fq) const {
        const int b = (u.pm < MX / BM) ? ((u.pm * BM) >> 12) : 16;
        const int row0 = u.pm * BM + wr * 64 + fr, col0 = u.pn * BM + wc * 32 + 8 * fq;
        const float* gp = mod + (size_t)b * 6144 + 2 * DM + col0;
        f32x4 gv[2][2];
#pragma unroll
        for (int bj = 0; bj < 2; ++bj)
#pragma unroll
            for (int n = 0; n < 2; ++n) gv[bj][n] = *(const f32x4*)(gp + bj * HALF + 4 * n) * osc;
#pragma unroll
        for (int ai = 0; ai < 2; ++ai)
#pragma unroll
            for (int m = 0; m < 4; ++m) { bf16_t* rowp = P + (size_t)(row0 + ai * HALF + m * 16) * DM + col0;
                u32x4 xr[2]; xr[0] = *(const u32x4*)rowp; xr[1] = *(const u32x4*)(rowp + HALF);
#pragma unroll
                for (int bj = 0; bj < 2; ++bj) { const f32x4 v0 = acc[ai][bj][m][0] * gv[bj][0], v1 = acc[ai][bj][m][1] * gv[bj][1]; const u32x4 x = xr[bj];
                    u32x4 w; w.x = cvtpk(v0[0] + __builtin_bit_cast(float, x.x << 16), v0[1] + __builtin_bit_cast(float, x.x & 0xffff0000u));
                    w.y = cvtpk(v0[2] + __builtin_bit_cast(float, x.y << 16), v0[3] + __builtin_bit_cast(float, x.y & 0xffff0000u));
                    w.z = cvtpk(v1[0] + __builtin_bit_cast(float, x.z << 16), v1[1] + __builtin_bit_cast(float, x.z & 0xffff0000u));
                    w.w = cvtpk(v1[2] + __builtin_bit_cast(float, x.w << 16), v1[3] + __builtin_bit_cast(float, x.w & 0xffff0000u));
                    *(u32x4*)(rowp + bj * HALF) = w; } }
    }
};
template <bool NOSTORE = false> struct EpiSwiglu {
    static constexpr bool PERM = true;
    unsigned char* O; float in_scale; float out_scale;
    __device__ __forceinline__ void operator()(const f32x4 (&acc)[2][2][4][2], const Unit& u, int wr, int wc, int fr, int fq) const {
        const int row0 = u.pm * BM + wr * 64 + fr, col0 = u.pn * HALF + wc * 32 + 8 * fq;
#pragma unroll
        for (int ai = 0; ai < 2; ++ai)
#pragma unroll
            for (int m = 0; m < 4; ++m) { unsigned char* rowp = O + ((size_t)u.pm * 16 + u.pn) * 32768 + (8 * ai + 4 * wr + m) * 2048 + wc * 512 + fr * 32 + fq * 8;
                float h[8];
                const float c1 = -LOG2E * in_scale, c2 = in_scale * in_scale * out_scale;
#pragma unroll
                for (int n = 0; n < 2; ++n)
#pragma unroll
                    for (int j = 0; j < 4; j += 2) { const f32x2 ag = {acc[ai][0][m][n][j], acc[ai][0][m][n][j + 1]}, au = {acc[ai][1][m][n][j], acc[ai][1][m][n][j + 1]};
                        const f32x2 ea = ag * c1; f32x2 t; t.x = __builtin_amdgcn_exp2f(ea.x); t.y = __builtin_amdgcn_exp2f(ea.y);
                        const f32x2 d = t + 1.0f; f32x2 r; r.x = __builtin_amdgcn_rcpf(d.x); r.y = __builtin_amdgcn_rcpf(d.y);
                        const f32x2 hv = ((ag * au) * c2) * r; h[n * 4 + j] = hv.x; h[n * 4 + j + 1] = hv.y; }
                int w0 = 0, w1 = 0;
                w0 = __builtin_amdgcn_cvt_pk_fp8_f32(h[0], h[1], w0, false); w0 = __builtin_amdgcn_cvt_pk_fp8_f32(h[2], h[3], w0, true);
                w1 = __builtin_amdgcn_cvt_pk_fp8_f32(h[4], h[5], w1, false); w1 = __builtin_amdgcn_cvt_pk_fp8_f32(h[6], h[7], w1, true);
                if (NOSTORE) asm volatile("" :: "v"(w0), "v"(w1)); else *(u32x2*)rowp = (u32x2){(unsigned)w0, (unsigned)w1}; }
    }
};
struct EpiBf16 {
    static constexpr bool PERM = true;
    bf16_t* O; int ldc; float sc;
    __device__ __forceinline__ void operator()(const f32x4 (&acc)[2][2][4][2], const Unit& u, int wr, int wc, int fr, int fq) const {
        const int row0 = u.pm * BM + wr * 64 + fr, col0 = u.pn * BM + wc * 32 + 8 * fq;
#pragma unroll
        for (int ai = 0; ai < 2; ++ai)
#pragma unroll
            for (int m = 0; m < 4; ++m) { bf16_t* rowp = O + (size_t)(row0 + ai * HALF + m * 16) * ldc + col0;
#pragma unroll
                for (int bj = 0; bj < 2; ++bj) { const f32x4 v0 = acc[ai][bj][m][0] * sc, v1 = acc[ai][bj][m][1] * sc;
                    u32x4 w; w.x = cvtpk(v0[0], v0[1]); w.y = cvtpk(v0[2], v0[3]); w.z = cvtpk(v1[0], v1[1]); w.w = cvtpk(v1[2], v1[3]);
                    *(u32x4*)(rowp + bj * HALF) = w; } }
    }
};
}

namespace att {
#define SBAR() __builtin_amdgcn_sched_barrier(0)
__device__ __forceinline__ int crow(int r, int hi) { return (r & 3) + 8 * (r >> 2) + 4 * hi; }
__device__ __forceinline__ void glds16(const void* gsrc, unsigned lds_dst) { unsigned keep;
    asm volatile("s_mov_b32 %0, m0\n\ts_mov_b32 m0, %2\n\ts_nop 0\n\tglobal_load_lds_dwordx4 %1, off\n\ts_mov_b32 m0, %0" : "=&s"(keep) : "v"(gsrc), "s"(lds_dst) : "memory"); }
#define WAIT_BAR0() asm volatile("s_waitcnt vmcnt(0) lgkmcnt(0)\n\ts_barrier" ::: "memory")
typedef LAS const char* lds_cptr;
typedef short v4i16_t __attribute__((ext_vector_type(4)));
__device__ __forceinline__ s16x4 vtr(lds_cptr p) { return __builtin_bit_cast(s16x4, __builtin_amdgcn_ds_read_tr16_b64_v4i16((LAS v4i16_t*)p)); }
__device__ __forceinline__ float hmax(float m) { auto rr = __builtin_amdgcn_permlane32_swap(__float_as_uint(m), __float_as_uint(m), false, false); return fmaxf(__uint_as_float(rr[0]), __uint_as_float(rr[1])); }
__device__ __forceinline__ float hsum(float m) { auto rr = __builtin_amdgcn_permlane32_swap(__float_as_uint(m), __float_as_uint(m), false, false); return __uint_as_float(rr[0]) + __uint_as_float(rr[1]); }

__device__ __forceinline__ void qkt(f32x16& p0, f32x16& p1, lds_cptr kb, const bf16x8 (&qr)[4]) {
    p0 = f32x16{}; p1 = f32x16{};
#pragma unroll
    for (int d0 = 0; d0 < 4; ++d0) {
        const bf16x8 b0 = *(const LAS bf16x8*)(kb + d0 * 2048), b1 = *(const LAS bf16x8*)(kb + d0 * 2048 + 512);
        p0 = __builtin_amdgcn_mfma_f32_32x32x16_bf16(b0, qr[d0], p0, 0, 0, 0);
        p1 = __builtin_amdgcn_mfma_f32_32x32x16_bf16(b1, qr[d0], p1, 0, 0, 0); }
}
template <int ND>
__device__ __forceinline__ void softmax_pv(f32x16& p0, f32x16& p1, f32x16 (&oT)[ND], float& m, float& l, lds_cptr vp) {
    float rm = p0[0];
#pragma unroll
    for (int r = 1; r < 16; ++r) rm = fmaxf(rm, p0[r]);
#pragma unroll
    for (int r = 0; r < 16; ++r) rm = fmaxf(rm, p1[r]);
    rm = hmax(rm);
    const float mn = fmaxf(m, rm);
    const float alpha = __builtin_amdgcn_exp2f(m - mn);
    m = mn;
    float s = 0.f;
#pragma unroll
    for (int r = 0; r < 16; ++r) { p0[r] = __builtin_amdgcn_exp2f(p0[r] - mn); p1[r] = __builtin_amdgcn_exp2f(p1[r] - mn); s += p0[r] + p1[r]; }
    l = l * alpha + s;
#pragma unroll
    for (int d = 0; d < ND; ++d) oT[d] = oT[d] * alpha;
    u32x4 pw[4];
#pragma unroll
    for (int k = 0; k < 2; ++k) {
        pw[k]     = (u32x4){cvtpk(p0[8 * k], p0[8 * k + 1]), cvtpk(p0[8 * k + 2], p0[8 * k + 3]), cvtpk(p0[8 * k + 4], p0[8 * k + 5]), cvtpk(p0[8 * k + 6], p0[8 * k + 7])};
        pw[2 + k] = (u32x4){cvtpk(p1[8 * k], p1[8 * k + 1]), cvtpk(p1[8 * k + 2], p1[8 * k + 3]), cvtpk(p1[8 * k + 4], p1[8 * k + 5]), cvtpk(p1[8 * k + 6], p1[8 * k + 7])}; }
#pragma unroll
    for (int d = 0; d < ND; ++d)
#pragma unroll
        for (int ks = 0; ks < 4; ++ks) {
            const s16x4 lo = vtr(vp + d * 4096 + ks * 1024), hi = vtr(vp + d * 4096 + ks * 1024 + 512);
            const bf16x8 vf = (bf16x8){lo[0], lo[1], lo[2], lo[3], hi[0], hi[1], hi[2], hi[3]};
            oT[d] = __builtin_amdgcn_mfma_f32_32x32x16_bf16(vf, __builtin_bit_cast(bf16x8, pw[ks]), oT[d], 0, 0, 0); }
}
template <int ND>
__device__ __forceinline__ void stg_flush(const LAS unsigned char* stg, bf16_t* ybase, int lane) {
    constexpr int RB = ND * 64 + 16, CPR = ND * 4;
#pragma unroll
    for (int i = 0; i < 32 * CPR / 64; ++i) { const int idx = i * 64 + lane, row = idx / CPR, ch = idx % CPR;
        const u32x4 v = *(const LAS u32x4*)(stg + row * RB + ch * 16); *(u32x4*)(ybase + (size_t)row * DM + ch * 8) = v; }
}
template <int ND>
__device__ __forceinline__ void store_oT(const f32x16 (&oT)[ND], float scale, bf16_t* ybase, size_t elem_off, int hi) {
    if (OUTPROJ_FP8) { unsigned char* orow = (unsigned char*)ybase + elem_off; const float sc8 = scale * Y_SCALE;
#pragma unroll
        for (int d = 0; d < ND; ++d)
#pragma unroll
            for (int g = 0; g < 4; ++g) { int t = 0; t = __builtin_amdgcn_cvt_pk_fp8_f32(oT[d][4 * g] * sc8, oT[d][4 * g + 1] * sc8, t, false); t = __builtin_amdgcn_cvt_pk_fp8_f32(oT[d][4 * g + 2] * sc8, oT[d][4 * g + 3] * sc8, t, true);
                *(unsigned*)(orow + d * 32 + 8 * g + 4 * hi) = (unsigned)t; } }
    else { bf16_t* orow = ybase + elem_off;
#pragma unroll
        for (int d = 0; d < ND; ++d)
#pragma unroll
            for (int g = 0; g < 4; ++g) { u32x2 w; w.x = cvtpk(oT[d][4 * g] * scale, oT[d][4 * g + 1] * scale); w.y = cvtpk(oT[d][4 * g + 2] * scale, oT[d][4 * g + 3] * scale);
                *(u32x2*)(orow + d * 32 + 8 * g + 4 * hi) = w; } }
}
constexpr int NA_BIAS_OFF = 65536;
struct DiffArgs { const bf16_t* qkv; bf16_t* y; const float* subln_g; float lam; float omli; int with_ctx; const bf16_t* q; };

#define DF_THR 8.0f
#define DF_BAR()   asm volatile("s_waitcnt lgkmcnt(0)\n\ts_barrier" ::: "memory")
#define DF_BARV()  asm volatile("s_waitcnt vmcnt(0) lgkmcnt(0)\n\ts_barrier" ::: "memory")
__device__ __forceinline__ void diff_phase2(LAS unsigned char* lds, const DiffArgs A, int vcu, int G) {
    int tid = threadIdx.x; asm volatile("" : "+v"(tid));
    const int lane = tid & 63, r32 = lane & 31, hi = lane >> 5; const int wid = __builtin_amdgcn_readfirstlane(tid >> 6);
    constexpr int P = 3072;
    const unsigned lds0 = (unsigned)(uintptr_t)lds;
    const lds_cptr l3 = (lds_cptr)lds;
    const int mp = wid >> 2, qsub = wid & 3;
    LAS float* xch = (LAS float*)lds + qsub * 4096 + lane;
    const int nmain = NB * 8 * 32, nunits = nmain + (A.with_ctx ? NB * 8 * 2 : 0);
    for (int u = vcu; u < nunits; u += G) {
        int b, h, qrow0, NT; const bool ctxu = u >= nmain;
        if (!ctxu) { const int qb = u & 31; h = (u >> 5) & 7; b = u >> 8; qrow0 = b * SEQ + 128 * qb + 32 * qsub; NT = 4 + 64; }
        else { const int v = u - nmain; const int qb = v & 1; h = (v >> 1) & 7; b = v >> 4; qrow0 = MX + b * CTXL + 128 * qb + 32 * qsub; NT = 4; }
        const bf16_t* Kc = A.qkv + (size_t)(MX + b * CTXL) * P + 1024 + 128 * h;
        const bf16_t* Kx = A.qkv + (size_t)(b * SEQ) * P + 1024 + 128 * h;
        const int krow = 8 * wid + (lane >> 3); const size_t koff = (size_t)krow * P + (((lane & 7) ^ ((krow >> 1) & 7)) * 8);
        const int pv0 = 2 * wid, pv1 = 2 * wid + 1;
        const int vra = 4 * pv0 + (lane >> 4), vrb = 4 * pv1 + (lane >> 4); const int vph = lane & 15;
        const size_t voffa = (size_t)vra * P + 1024 + ((((vph >> 2) ^ (vra & 3)) << 2) | (vph & 3)) * 8;
        const size_t voffb = (size_t)vrb * P + 1024 + ((((vph >> 2) ^ (vrb & 3)) << 2) | (vph & 3)) * 8;
#define DF_DMA(t) do { if ((t) < NT) { const int slot_ = (t) % 3; const bf16_t* base_ = ((t) < 4) ? Kc + (size_t)(t) * 64 * P : Kx + (size_t)((t) - 4) * 64 * P; \
        glds16(base_ + koff,      (unsigned)__builtin_amdgcn_readfirstlane(lds0 + slot_ * 32768 + wid * 1024)); \
        glds16(base_ + koff + 64, (unsigned)__builtin_amdgcn_readfirstlane(lds0 + slot_ * 32768 + 8192 + wid * 1024)); \
        glds16(base_ + voffa,     (unsigned)__builtin_amdgcn_readfirstlane(lds0 + slot_ * 32768 + 16384 + pv0 * 1024)); \
        glds16(base_ + voffb,     (unsigned)__builtin_amdgcn_readfirstlane(lds0 + slot_ * 32768 + 16384 + pv1 * 1024)); } } while (0)
        DF_DMA(0);
        bf16x8 qr[4];
        { const bf16_t* Qw = A.qkv + (size_t)(qrow0 + r32) * P + h * 128 + mp * 64;
#pragma unroll
          for (int d0 = 0; d0 < 4; ++d0) qr[d0] = *(const bf16x8*)(Qw + d0 * 16 + hi * 8); }
        f32x16 oT[4]; oT[0] = f32x16{}; oT[1] = f32x16{}; oT[2] = f32x16{}; oT[3] = f32x16{};
        float m = 0.f, l = 0.f;
        f32x16 p0, p1; u32x4 pw[4];
        const int ksw = (r32 >> 1) & 7; const lds_cptr kp0 = l3 + mp * 8192 + r32 * 128 + ((hi ^ (ksw & 1)) << 4); const int ks2 = ksw >> 1;
        const int vq = (lane & 15) >> 2; const lds_cptr vp0 = l3 + 16384 + (4 * hi + vq) * 256 + ((lane >> 4) & 1) * 32 + (lane & 3) * 8;
#define DF_LOADV(dst, vp_, d) do { const lds_cptr vd_ = (vp_) + (((d) ^ vq) << 6); _Pragma("unroll") for (int ks = 0; ks < 4; ++ks) { const s16x4 lo_ = vtr(vd_ + ks * 4096), hi_ = vtr(vd_ + ks * 4096 + 2048); \
            dst[ks] = (bf16x8){lo_[0], lo_[1], lo_[2], lo_[3], hi_[0], hi_[1], hi_[2], hi_[3]}; } } while (0)
#define DF_PV4(src, d) do { _Pragma("unroll") for (int ks = 0; ks < 4; ++ks) oT[d] = __builtin_amdgcn_mfma_f32_32x32x16_bf16(src[ks], __builtin_bit_cast(bf16x8, pw[ks]), oT[d], 0, 0, 0); } while (0)
#define DF_LOADK(dst, kb_, dd) do { dst[0] = *(const LAS bf16x8*)((kb_) + ((((dd)) ^ ks2) << 5)); dst[1] = *(const LAS bf16x8*)((kb_) + ((((dd)) ^ ks2) << 5) + 4096); \
            dst[2] = *(const LAS bf16x8*)((kb_) + ((((dd) + 1) ^ ks2) << 5)); dst[3] = *(const LAS bf16x8*)((kb_) + ((((dd) + 1) ^ ks2) << 5) + 4096); } while (0)
#define DF_QK4(src, dd) do { p0 = __builtin_amdgcn_mfma_f32_32x32x16_bf16(src[0], qr[dd], p0, 0, 0, 0); p1 = __builtin_amdgcn_mfma_f32_32x32x16_bf16(src[1], qr[dd], p1, 0, 0, 0); \
            p0 = __builtin_amdgcn_mfma_f32_32x32x16_bf16(src[2], qr[(dd) + 1], p0, 0, 0, 0); p1 = __builtin_amdgcn_mfma_f32_32x32x16_bf16(src[3], qr[(dd) + 1], p1, 0, 0, 0); } while (0)
#define DF_PREV(vso) do { const lds_cptr vq_ = vp0 + (vso); DF_LOADV(fa, vq_, 0); DF_LOADV(fb, vq_, 1); SBAR(); } while (0)
#define DF_PINIT() do { _Pragma("unroll") for (int r = 0; r < 16; ++r) { p0[r] = -m; p1[r] = -m; } } while (0)
#define DF_SEGM(DO_PV, DO_QK, vso, kso) do { const lds_cptr vp_ = vp0 + (vso); const lds_cptr kb_ = kp0 + (kso); SBAR(); __builtin_amdgcn_s_setprio(1); \
        if (DO_PV) { DF_PV4(fa, 0); SBAR(); DF_LOADV(fa, vp_, 2); SBAR(); \
            DF_PV4(fb, 1); SBAR(); DF_LOADV(fb, vp_, 3); if (DO_QK) { DF_PINIT(); } SBAR(); \
            DF_PV4(fa, 2); SBAR(); if (DO_QK) { DF_LOADK(fa, kb_, 0); } SBAR(); \
            DF_PV4(fb, 3); SBAR(); if (DO_QK) { DF_LOADK(fb, kb_, 2); } SBAR(); } \
        else if (DO_QK) { DF_LOADK(fa, kb_, 0); DF_LOADK(fb, kb_, 2); DF_PINIT(); SBAR(); } \
        if (DO_QK) { DF_QK4(fa, 0); SBAR(); DF_QK4(fb, 2); SBAR(); } \
        __builtin_amdgcn_s_setprio(0); } while (0)
#define DF_SEGV(t) do { \
        float rm = p0[0]; \
        _Pragma("unroll") for (int r = 1; r < 16; ++r) rm = fmaxf(rm, p0[r]); \
        _Pragma("unroll") for (int r = 0; r < 16; ++r) rm = fmaxf(rm, p1[r]); \
        rm = hmax(rm); \
        if ((t) == 0 || __any(rm > DF_THR)) { const float dl = ((t) == 0) ? rm : fmaxf(rm, 0.f); m += dl; \
            _Pragma("unroll") for (int r = 0; r < 16; ++r) { p0[r] -= dl; p1[r] -= dl; } \
            const float f = __builtin_amdgcn_exp2f(-dl); l *= f; \
            _Pragma("unroll") for (int d = 0; d < 4; ++d) oT[d] = oT[d] * f; } \
        float s_ = 0.f; \
        _Pragma("unroll") for (int r = 0; r < 16; ++r) { p0[r] = __builtin_amdgcn_exp2f(p0[r]); p1[r] = __builtin_amdgcn_exp2f(p1[r]); s_ += p0[r] + p1[r]; } \
        l += s_; \
        _Pragma("unroll") for (int k = 0; k < 2; ++k) { \
            pw[k]     = (u32x4){cvtpk(p0[8 * k], p0[8 * k + 1]), cvtpk(p0[8 * k + 2], p0[8 * k + 3]), cvtpk(p0[8 * k + 4], p0[8 * k + 5]), cvtpk(p0[8 * k + 6], p0[8 * k + 7])}; \
            pw[2 + k] = (u32x4){cvtpk(p1[8 * k], p1[8 * k + 1]), cvtpk(p1[8 * k + 2], p1[8 * k + 3]), cvtpk(p1[8 * k + 4], p1[8 * k + 5]), cvtpk(p1[8 * k + 6], p1[8 * k + 7])}; } \
        } while (0)
        DF_BARV();
        int so_p = 0, so_c = 0;
#define DF_ROT() do { so_p = so_c; so_c = (so_c == 65536) ? 0 : so_c + 32768; } while (0)
        bf16x8 fa[4], fb[4];
        if (mp == 0) {
            DF_DMA(1); DF_SEGM(false, true, 0, so_c); SBAR(); DF_PREV(so_c); DF_SEGV(0); SBAR(); DF_BARV(); SBAR();
            for (int t = 1; t < NT; ++t) { DF_ROT();
                DF_DMA(t + 1); DF_SEGM(true, true, so_p, so_c); SBAR(); DF_PREV(so_c); DF_SEGV(t); SBAR(); DF_BARV(); SBAR(); }
            DF_ROT();
            DF_SEGM(true, false, so_p, 0); SBAR(); DF_BARV(); SBAR();
        } else {
            DF_DMA(1); DF_SEGM(false, true, 0, so_c); SBAR(); DF_BARV(); SBAR();
            for (int t = 1; t < NT; ++t) { DF_ROT();
                DF_DMA(t + 1); DF_PREV(so_p); DF_SEGV(t - 1); SBAR(); DF_SEGM(true, true, so_p, so_c); SBAR(); DF_BARV(); SBAR(); }
            DF_ROT();
            DF_PREV(so_p); DF_SEGV(NT - 1); SBAR(); DF_SEGM(true, false, so_p, 0); SBAR(); DF_BARV(); SBAR();
        }
#undef DF_ROT
        l = hsum(l);
        const float il = 1.f / l;
        if (mp == 1) { const float sc = il * A.lam;
#pragma unroll
            for (int d = 0; d < 4; ++d)
#pragma unroll
                for (int q = 0; q < 16; ++q) xch[(d * 16 + q) * 64] = oT[d][q] * sc; }
        DF_BARV();
        if (mp == 0) {
            float ss = 0.f;
#pragma unroll
            for (int d = 0; d < 4; ++d)
#pragma unroll
                for (int q = 0; q < 16; ++q) { const float v = oT[d][q] * il - xch[(d * 16 + q) * 64]; oT[d][q] = v; ss += v * v; }
            ss = hsum(ss);
            const float rstd = rsqrtf(ss * (1.f / 128.f) + RMS_EPS) * A.omli;
            const size_t eo = (size_t)(qrow0 + r32) * DM + h * 128;
#pragma unroll
            for (int d = 0; d < 4; ++d)
#pragma unroll
                for (int g = 0; g < 4; ++g) { const f32x4 gg = *(const f32x4*)(A.subln_g + d * 32 + 8 * g + 4 * hi);
                    if (OUTPROJ_FP8) { const float r8 = rstd * Y_SCALE; int t = 0; t = __builtin_amdgcn_cvt_pk_fp8_f32(oT[d][4 * g] * r8 * gg[0], oT[d][4 * g + 1] * r8 * gg[1], t, false);
                        t = __builtin_amdgcn_cvt_pk_fp8_f32(oT[d][4 * g + 2] * r8 * gg[2], oT[d][4 * g + 3] * r8 * gg[3], t, true);
                        *(unsigned*)((unsigned char*)A.y + eo + d * 32 + 8 * g + 4 * hi) = (unsigned)t; }
                    else { u32x2 w; w.x = cvtpk(oT[d][4 * g] * rstd * gg[0], oT[d][4 * g + 1] * rstd * gg[1]); w.y = cvtpk(oT[d][4 * g + 2] * rstd * gg[2], oT[d][4 * g + 3] * rstd * gg[3]);
                        *(u32x2*)(A.y + eo + d * 32 + 8 * g + 4 * hi) = w; } }
        }
        DF_BAR();
#undef DF_DMA
#undef DF_SEGM
#undef DF_SEGV
#undef DF_PINIT
#undef DF_PREV
#undef DF_LOADV
#undef DF_PV4
#undef DF_LOADK
#undef DF_QK4
    }
}

#define D3_PIN(x) asm volatile("" : "+v"(x))
#define D3_EX(v) __builtin_amdgcn_exp2f(v)
__device__ __forceinline__ void diff_phase3(LAS unsigned char* lds, const DiffArgs A, int vcu, int G) {
    int tid = threadIdx.x; asm volatile("" : "+v"(tid));
    const int lane = tid & 63, r32 = lane & 31, hi = lane >> 5; const int wid = __builtin_amdgcn_readfirstlane(tid >> 6);
    constexpr int P = 3072;
    const unsigned lds0 = (unsigned)(uintptr_t)lds;
    const lds_cptr l3 = (lds_cptr)lds;
    const int mp = wid >> 2, qsub = wid & 3;
    const int nmain = NB * 8 * 32, nunits = nmain + (A.with_ctx ? NB * 8 * 2 : 0);
    for (int u = vcu; u < nunits; u += G) {
        int b, h, qrow0, NT; const bool ctxu = u >= nmain;
        if (!ctxu) { const int qb = u & 31; h = (u >> 5) & 7; b = u >> 8; qrow0 = b * SEQ + 128 * qb + 32 * qsub; NT = 4 + 64; }
        else { const int v = u - nmain; const int qb = v & 1; h = (v >> 1) & 7; b = v >> 4; qrow0 = MX + b * CTXL + 128 * qb + 32 * qsub; NT = 4; }
        const bf16_t* Kc = A.qkv + (size_t)(MX + b * CTXL) * P + 1024 + 128 * h;
        const bf16_t* Kx = A.qkv + (size_t)(b * SEQ) * P + 1024 + 128 * h;
        const int kra = 16 * qsub + (lane >> 3), krb = kra + 8; const int vr0 = 16 * qsub + (lane >> 4); const int vph = lane & 15;
        const unsigned d0 = mp ? (unsigned)vr0 * P + 1024 + ((((vph >> 2) ^ (vr0 & 3)) << 2) | (vph & 3)) * 8 : (unsigned)kra * P + (((lane & 7) ^ ((kra >> 1) & 7)) * 8);
        const unsigned d1 = mp ? d0 + 4 * P : (unsigned)krb * P + (((lane & 7) ^ ((krb >> 1) & 7)) * 8);
        const unsigned inc2 = mp ? 8 * P : 64;
        const unsigned e0 = lds0 + (mp ? 32768 + qsub * 4096 : qsub * 2048), e2 = e0 + (mp ? 2048 : 8192);
#define D3_DMA(t) do { const int t_ = (t); if (t_ < NT) { const bf16_t* base_ = (t_ < 4) ? Kc + (size_t)t_ * 64 * P : Kx + (size_t)(t_ - 4) * 64 * P; \
        const unsigned so_ = (mp ? (t_ & 3) : (t_ & 1)) * 16384; \
        glds16(base_ + d0,        (unsigned)__builtin_amdgcn_readfirstlane(e0 + so_)); \
        glds16(base_ + d1,        (unsigned)__builtin_amdgcn_readfirstlane(e0 + so_ + 1024)); \
        glds16(base_ + d0 + inc2, (unsigned)__builtin_amdgcn_readfirstlane(e2 + so_)); \
        glds16(base_ + d1 + inc2, (unsigned)__builtin_amdgcn_readfirstlane(e2 + so_ + 1024)); } } while (0)
#define D3_WAITBAR(T) do { if (mp == 0 || (T) + 1 >= NT) DF_BARV(); else asm volatile("s_waitcnt vmcnt(4) lgkmcnt(0)\n\ts_barrier" ::: "memory"); } while (0)
        D3_DMA(0);
        bf16x8 qr[4];
        { const bf16_t* Qw = A.q + ((size_t)(qrow0 >> 5) * 16 + 2 * h + mp) * 2048 + hi * 256 + r32 * 8;
#pragma unroll
          for (int d0 = 0; d0 < 4; ++d0) qr[d0] = *(const bf16x8*)(Qw + d0 * 512); }
        f32x16 oT[4]; oT[0] = f32x16{}; oT[1] = f32x16{}; oT[2] = f32x16{}; oT[3] = f32x16{};
        f32x16 negm;
        float m = 0.f, l = 0.f, rf = 1.f; bool resc = false;
        f32x16 pA0, pA1, pB0, pB1; u32x4 pw0, pw1, pw2, pw3;
        const int ksw = (r32 >> 1) & 7; const lds_cptr kp0 = l3 + mp * 8192 + r32 * 128 + ((hi ^ (ksw & 1)) << 4); const int ks2 = ksw >> 1;
        const int vq = (lane & 15) >> 2; const lds_cptr vp0 = l3 + 32768 + (4 * hi + vq) * 256 + ((lane >> 4) & 1) * 32 + (lane & 3) * 8;
#define D3_KF(kb_, g) (*(const LAS bf16x8*)((kb_) + (((((g) >> 1)) ^ ks2) << 5) + ((g) & 1) * 4096))
#define D3_VF(vp_, g) ({ const lds_cptr vd_ = (vp_) + (((((g) >> 2)) ^ vq) << 6) + ((g) & 3) * 4096; const s16x4 lo_ = vtr(vd_), hi_ = vtr(vd_ + 2048); (bf16x8){lo_[0], lo_[1], lo_[2], lo_[3], hi_[0], hi_[1], hi_[2], hi_[3]}; })
#define D3_PK(P, B) cvtpk(P[B], P[(B) + 1])
#define D3_KSEL(g) (((g) & 1) ? kf1 : kf0)
#define D3_GA(g, C0, C1, Q0, Q1, HASQK, HASVA, FIRST) do { \
        if (HASQK) { \
            if ((g) == 0) { if (FIRST) C0 = __builtin_amdgcn_mfma_f32_32x32x16_bf16(D3_KSEL(g), qr[0], f32x16{}, 0, 0, 0); else C0 = __builtin_amdgcn_mfma_f32_32x32x16_bf16(D3_KSEL(g), qr[0], negm, 0, 0, 0); } \
            else if ((g) == 1) { if (FIRST) C1 = __builtin_amdgcn_mfma_f32_32x32x16_bf16(D3_KSEL(g), qr[0], f32x16{}, 0, 0, 0); else C1 = __builtin_amdgcn_mfma_f32_32x32x16_bf16(D3_KSEL(g), qr[0], negm, 0, 0, 0); } \
            else if ((g) & 1) C1 = __builtin_amdgcn_mfma_f32_32x32x16_bf16(D3_KSEL(g), qr[(g) >> 1], C1, 0, 0, 0); else C0 = __builtin_amdgcn_mfma_f32_32x32x16_bf16(D3_KSEL(g), qr[(g) >> 1], C0, 0, 0, 0); \
            if ((g) + 2 < 8) { if ((g) & 1) kf1 = D3_KF(kb_, (g) + 2); else kf0 = D3_KF(kb_, (g) + 2); } } \
        if (HASVA) { if ((g) == 6) vf0 = D3_VF(vp_, 0); if ((g) == 7) vf1 = D3_VF(vp_, 1); } \
        if (HASVA) { if ((g) < 5) { Q1[5 + 2 * (g)] = D3_EX(Q1[5 + 2 * (g)]); Q1[6 + 2 * (g)] = D3_EX(Q1[6 + 2 * (g)]); } if ((g) == 5) { Q1[15] = D3_EX(Q1[15]); } \
            if ((g) == 0) { pw0[0] = D3_PK(Q0, 0); pw0[1] = D3_PK(Q0, 2); } if ((g) == 1) { pw0[2] = D3_PK(Q0, 4); pw0[3] = D3_PK(Q0, 6); D3_PIN(pw0); } \
            if ((g) == 2) { pw1[0] = D3_PK(Q0, 8); pw1[1] = D3_PK(Q0, 10); } if ((g) == 3) { pw1[2] = D3_PK(Q0, 12); pw1[3] = D3_PK(Q0, 14); D3_PIN(pw1); } \
            if ((g) == 4) { pw2[0] = D3_PK(Q1, 0); pw2[1] = D3_PK(Q1, 2); } if ((g) == 5) { pw2[2] = D3_PK(Q1, 4); pw2[3] = D3_PK(Q1, 6); D3_PIN(pw2); } \
            if ((g) == 6) { pw3[0] = D3_PK(Q1, 8); pw3[1] = D3_PK(Q1, 10); } if ((g) == 7) { pw3[2] = D3_PK(Q1, 12); pw3[3] = D3_PK(Q1, 14); D3_PIN(pw3); } \
            } \
        SBAR(); } while (0)
#define D3_PWSEL(g) (((g) & 3) == 0 ? pw0 : ((g) & 3) == 1 ? pw1 : ((g) & 3) == 2 ? pw2 : pw3)
#define D3_EXI(C0, C1, e) do { if ((e) < 16) C0[(e) & 15] = D3_EX(C0[(e) & 15]); else C1[(e) & 15] = D3_EX(C1[(e) & 15]); } while (0)
#define D3_GB(g, C0, C1, Q0, Q1, HASPV, HASVB, FIRST) do { \
        if (HASPV) { \
            oT[(g) >> 2] = __builtin_amdgcn_mfma_f32_32x32x16_bf16(((g) & 1) ? vf1 : vf0, __builtin_bit_cast(bf16x8, D3_PWSEL(g)), oT[(g) >> 2], 0, 0, 0); \
            if ((g) + 2 < 16) { if ((g) & 1) vf1 = D3_VF(vp_, (g) + 2); else vf0 = D3_VF(vp_, (g) + 2); } } \
        if (HASPV) { if ((g) < 4) { sacc += Q0[4 * ((g) & 3)]; sacc += Q0[4 * ((g) & 3) + 1]; sacc += Q0[4 * ((g) & 3) + 2]; sacc += Q0[4 * ((g) & 3) + 3]; D3_PIN(sacc); } \
            else if ((g) < 8) { sacc += Q1[4 * ((g) & 3)]; sacc += Q1[4 * ((g) & 3) + 1]; sacc += Q1[4 * ((g) & 3) + 2]; sacc += Q1[4 * ((g) & 3) + 3]; D3_PIN(sacc); } \
            else if ((g) == 8) { l += sacc; } } \
        if (HASVB) { if ((g) < 4) { rmx = fmaxf(fmaxf(rmx, C0[4 * ((g) & 3)]), C0[4 * ((g) & 3) + 1]); rmx = fmaxf(fmaxf(rmx, C0[4 * ((g) & 3) + 2]), C0[4 * ((g) & 3) + 3]); D3_PIN(rmx); } \
            else if ((g) < 8) { rmx = fmaxf(fmaxf(rmx, C1[4 * ((g) & 3)]), C1[4 * ((g) & 3) + 1]); rmx = fmaxf(fmaxf(rmx, C1[4 * ((g) & 3) + 2]), C1[4 * ((g) & 3) + 3]); D3_PIN(rmx); } \
            else if ((g) == 8) { rmx = hmax(rmx); resc = false; \
                if (FIRST || __any(rmx > DF_THR)) { const float dl = FIRST ? rmx : fmaxf(rmx, 0.f); m += dl; \
                    _Pragma("unroll") for (int r_ = 0; r_ < 16; ++r_) { C0[r_] -= dl; C1[r_] -= dl; negm[r_] = -m; } D3_PIN(negm); \
                    rf = D3_EX(-dl); l *= rf; resc = true; } } \
            else { const int e0_ = 3 * ((g) - 9);   \
                D3_EXI(C0, C1, e0_); D3_EXI(C0, C1, e0_ + 1); D3_EXI(C0, C1, e0_ + 2); if (e0_ + 2 < 16) D3_PIN(C0); else D3_PIN(C1); } } \
        SBAR(); } while (0)
#define D3_STEP(C0, C1, Q0, Q1, HASQK, HASPREV, FIRST, T) do { \
        const lds_cptr kb_ = kp0 + ((T) & 1) * 16384; const lds_cptr vp_ = vp0 + (((T) - 1) & 3) * 16384; bf16x8 kf0, kf1, vf0, vf1; float sacc = 0.f, rmx = -3.0e38f; \
        if (HASQK) D3_DMA((T) + 1); \
        SBAR(); if (HASQK) { kf0 = D3_KF(kb_, 0); kf1 = D3_KF(kb_, 1); } \
        D3_GA(0, C0, C1, Q0, Q1, HASQK, HASPREV, FIRST); D3_GA(1, C0, C1, Q0, Q1, HASQK, HASPREV, FIRST); D3_GA(2, C0, C1, Q0, Q1, HASQK, HASPREV, FIRST); D3_GA(3, C0, C1, Q0, Q1, HASQK, HASPREV, FIRST); \
        D3_GA(4, C0, C1, Q0, Q1, HASQK, HASPREV, FIRST); D3_GA(5, C0, C1, Q0, Q1, HASQK, HASPREV, FIRST); D3_GA(6, C0, C1, Q0, Q1, HASQK, HASPREV, FIRST); D3_GA(7, C0, C1, Q0, Q1, HASQK, HASPREV, FIRST); \
        if (HASQK) { if (mp == 1) D3_WAITBAR(T); } \
        D3_GB(0, C0, C1, Q0, Q1, HASPREV, HASQK, FIRST); D3_GB(1, C0, C1, Q0, Q1, HASPREV, HASQK, FIRST); D3_GB(2, C0, C1, Q0, Q1, HASPREV, HASQK, FIRST); D3_GB(3, C0, C1, Q0, Q1, HASPREV, HASQK, FIRST); \
        D3_GB(4, C0, C1, Q0, Q1, HASPREV, HASQK, FIRST); D3_GB(5, C0, C1, Q0, Q1, HASPREV, HASQK, FIRST); D3_GB(6, C0, C1, Q0, Q1, HASPREV, HASQK, FIRST); D3_GB(7, C0, C1, Q0, Q1, HASPREV, HASQK, FIRST); \
        D3_GB(8, C0, C1, Q0, Q1, HASPREV, HASQK, FIRST); D3_GB(9, C0, C1, Q0, Q1, HASPREV, HASQK, FIRST); D3_GB(10, C0, C1, Q0, Q1, HASPREV, HASQK, FIRST); D3_GB(11, C0, C1, Q0, Q1, HASPREV, HASQK, FIRST); \
        D3_GB(12, C0, C1, Q0, Q1, HASPREV, HASQK, FIRST); D3_GB(13, C0, C1, Q0, Q1, HASPREV, HASQK, FIRST); D3_GB(14, C0, C1, Q0, Q1, HASPREV, HASQK, FIRST); D3_GB(15, C0, C1, Q0, Q1, HASPREV, HASQK, FIRST); \
        if (HASQK && resc) { _Pragma("unroll") for (int d_ = 0; d_ < 4; ++d_) oT[d_] = oT[d_] * rf; } \
        if (HASQK) { if (mp == 0) D3_WAITBAR(T); } \
        } while (0)
        DF_BARV();
        D3_STEP(pA0, pA1, pB0, pB1, true, false, true, 0);
        int t = 1;
        for (; t + 1 < NT; t += 2) {
            D3_STEP(pB0, pB1, pA0, pA1, true, true, false, t);
            D3_STEP(pA0, pA1, pB0, pB1, true, true, false, t + 1);
        }
        D3_STEP(pB0, pB1, pA0, pA1, true, true, false, t);
        D3_STEP(pA0, pA1, pB0, pB1, false, true, false, NT);
        l = hsum(l);
        const float il = 1.f / l;
        DF_BAR();
        LAS float* xch = (LAS float*)lds + qsub * 4096 + lane;
        if (mp == 1) { const float sc = il * A.lam;
#pragma unroll
            for (int d = 0; d < 4; ++d)
#pragma unroll
                for (int q = 0; q < 16; ++q) xch[(d * 16 + q) * 64] = oT[d][q] * sc; }
        DF_BAR();
        if (mp == 0) {
            float ss = 0.f;
#pragma unroll
            for (int d = 0; d < 4; ++d)
#pragma unroll
                for (int q = 0; q < 16; ++q) { const float v = oT[d][q] * il - xch[(d * 16 + q) * 64]; oT[d][q] = v; ss += v * v; }
            ss = hsum(ss);
            const float rstd = rsqrtf(ss * (1.f / 128.f) + RMS_EPS) * A.omli;
            LAS unsigned char* stg = lds + qsub * 16384;
#pragma unroll
            for (int d = 0; d < 4; ++d)
#pragma unroll
                for (int g = 0; g < 4; ++g) { const f32x4 gg = *(const f32x4*)(A.subln_g + d * 32 + 8 * g + 4 * hi);
                    u32x2 w; w.x = cvtpk(oT[d][4 * g] * rstd * gg[0], oT[d][4 * g + 1] * rstd * gg[1]); w.y = cvtpk(oT[d][4 * g + 2] * rstd * gg[2], oT[d][4 * g + 3] * rstd * gg[3]);
                    *(LAS u32x2*)(stg + r32 * 272 + (d * 32 + 8 * g + 4 * hi) * 2) = w; }
            stg_flush<4>(stg, A.y + (size_t)qrow0 * DM + h * 128, lane);
        }
        DF_BAR();
#undef D3_DMA
#undef D3_KF
#undef D3_KSEL
#undef D3_VF
#undef D3_PK
#undef D3_GA
#undef D3_GB
#undef D3_EXI
#undef D3_PWSEL
#undef D3_STEP
#undef D3_WAITBAR
    }
}

struct A2Args { const bf16_t* qkv; bf16_t* y; const float* aux; int with_ctx; const bf16_t* q; };
template <int MODE  >
__device__ __forceinline__ void att2_phase(LAS unsigned char* lds, const A2Args A, int vcu, int G) {
    int tid = threadIdx.x; asm volatile("" : "+v"(tid));
    const int lane = tid & 63, r32 = lane & 31, hi = lane >> 5; const int wid = __builtin_amdgcn_readfirstlane(tid >> 6);
    constexpr int P = MODE == 0 ? 1536 : 3072; constexpr int VOFF = MODE == 0 ? 256 : 1024;
    const unsigned lds0 = (unsigned)(uintptr_t)lds;
    const lds_cptr l3 = (lds_cptr)lds;
    const int grp = wid >> 2;
    LAS float* btab = (LAS float*)(lds + NA_BIAS_OFF + 1024);
    const int nmain = MODE == 0 ? NB * 4 * 32 * 2 : NB * 16 * 16;
    const int nunits = nmain + (A.with_ctx ? (MODE == 0 ? NB * 4 * 4 : NB * 16) : 0);
    for (int u = vcu; u < nunits; u += G) {
        int b, hk, hq, qrow0, nwin, k0win; const bool ctxu = u >= nmain; int qs = 0, r = 0, c = 0;
        if (MODE == 0) {
            if (!ctxu) { const int hp = u & 1, j = (u >> 1) & 31; hk = (u >> 6) & 3; b = u >> 8; hq = 4 * hk + 2 * hp + (wid >> 2); qs = 128 * j + 32 * (wid & 3); qrow0 = b * SEQ + qs;
                const int ks = max(0, 128 * (j - 1)), ke = min(SEQ, 128 * (j + 2)); k0win = ks; nwin = (ke - ks) / 64; }
            else { const int v = u - nmain; hk = (v >> 2) & 3; hq = 4 * hk + (v & 3); b = v >> 4; qrow0 = MX + b * CTXL + 32 * wid; nwin = 0; k0win = 0; }
        } else {
            if (!ctxu) { const int uu = u & 15; hk = hq = (u >> 4) & 15; b = u >> 8; r = 4 * uu + (wid >> 1); c = 32 * (wid & 1) + r32; qrow0 = b * SEQ + r * 64 + 32 * (wid & 1);
                const int rs_lo = min(max(4 * uu - 4, 0), 56), rs_hi = min(max(4 * uu + 3 - 4, 0), 56); k0win = rs_lo * 64; nwin = rs_hi + 8 - rs_lo; }
            else { const int v = u - nmain; hk = hq = v & 15; b = v >> 4; qrow0 = MX + b * CTXL + 32 * wid; nwin = 0; k0win = 0; }
        }
        const int NT = 4 + nwin;
        const bf16_t* Kc = A.qkv + (size_t)(MX + b * CTXL) * P + 1024 + 64 * hk;
        const bf16_t* Kx = A.qkv + (size_t)(b * SEQ + k0win) * P + 1024 + 64 * hk;
        const int krow = 8 * wid + (lane >> 3); const size_t koff = (size_t)krow * P + (((lane & 7) ^ ((krow >> 1) & 7)) * 8), voff = (size_t)krow * P + VOFF + (((lane & 7) ^ (((krow >> 1) & 1) << 2)) * 8);
#define A2_DMA(t) do { if ((t) < NT) { const int slot_ = (t) % 3; const bf16_t* base_ = ((t) < 4) ? Kc + (size_t)(t) * 64 * P : Kx + (size_t)((t) - 4) * 64 * P; \
        glds16(base_ + koff, (unsigned)__builtin_amdgcn_readfirstlane(lds0 + slot_ * 16384 + wid * 1024)); \
        glds16(base_ + voff, (unsigned)__builtin_amdgcn_readfirstlane(lds0 + slot_ * 16384 + 8192 + wid * 1024)); } } while (0)
        A2_DMA(0);
        if (MODE == 1) { if (!ctxu && tid < 15 * 31) btab[tid] = A.aux[hq * 465 + tid] * LOG2E; }
        bf16x8 qr[4];
        { const bf16_t* Qw = A.q + ((size_t)(qrow0 >> 5) * 16 + hq) * 2048 + hi * 256 + r32 * 8;
#pragma unroll
          for (int d0 = 0; d0 < 4; ++d0) qr[d0] = *(const bf16x8*)(Qw + d0 * 512); }
        f32x16 oT[2]; oT[0] = f32x16{}; oT[1] = f32x16{};
        float m = 0.f, l = 0.f;
        f32x16 p0, p1; u32x4 pw[4];
        const int ksw = (r32 >> 1) & 7; const lds_cptr kp0 = l3 + r32 * 128 + ((hi ^ (ksw & 1)) << 4); const int ks2 = ksw >> 1;
        const int vq = (lane & 15) >> 2, vsq = (vq >> 1) & 1; const lds_cptr vp0 = l3 + 8192 + (4 * hi + vq) * 128 + ((lane >> 4) & 1) * 32 + (lane & 3) * 8;
        const int rs = min(max(r - 4, 0), 56), cs = min(max(c - 8, 0), 48);
#define A2_LOADV(dst, vp_, d) do { const lds_cptr vd_ = (vp_) + (((d) ^ vsq) << 6); _Pragma("unroll") for (int ks = 0; ks < 4; ++ks) { const s16x4 lo_ = vtr(vd_ + ks * 2048), hi_ = vtr(vd_ + ks * 2048 + 1024); \
            dst[ks] = (bf16x8){lo_[0], lo_[1], lo_[2], lo_[3], hi_[0], hi_[1], hi_[2], hi_[3]}; } } while (0)
#define A2_PV4(src, d) do { _Pragma("unroll") for (int ks = 0; ks < 4; ++ks) oT[d] = __builtin_amdgcn_mfma_f32_32x32x16_bf16(src[ks], __builtin_bit_cast(bf16x8, pw[ks]), oT[d], 0, 0, 0); } while (0)
#define A2_LOADK(dst, kb_, dd) do { dst[0] = *(const LAS bf16x8*)((kb_) + ((((dd)) ^ ks2) << 5)); dst[1] = *(const LAS bf16x8*)((kb_) + ((((dd)) ^ ks2) << 5) + 4096); \
            dst[2] = *(const LAS bf16x8*)((kb_) + ((((dd) + 1) ^ ks2) << 5)); dst[3] = *(const LAS bf16x8*)((kb_) + ((((dd) + 1) ^ ks2) << 5) + 4096); } while (0)
#define A2_QK4(src, dd) do { p0 = __builtin_amdgcn_mfma_f32_32x32x16_bf16(src[0], qr[dd], p0, 0, 0, 0); p1 = __builtin_amdgcn_mfma_f32_32x32x16_bf16(src[1], qr[dd], p1, 0, 0, 0); \
            p0 = __builtin_amdgcn_mfma_f32_32x32x16_bf16(src[2], qr[(dd) + 1], p0, 0, 0, 0); p1 = __builtin_amdgcn_mfma_f32_32x32x16_bf16(src[3], qr[(dd) + 1], p1, 0, 0, 0); } while (0)
#define A2_PREV(vso) do { const lds_cptr vq_ = vp0 + (vso); A2_LOADV(fa, vq_, 0); A2_LOADV(fb, vq_, 1); SBAR(); } while (0)
#define A2_PINIT() do { _Pragma("unroll") for (int q_ = 0; q_ < 16; ++q_) { p0[q_] = -m; p1[q_] = -m; } } while (0)
#define A2_SEGM(DO_PV, DO_QK, vso, kso) do { const lds_cptr kb_ = kp0 + (kso); SBAR(); __builtin_amdgcn_s_setprio(1); \
        if (DO_PV) { A2_PV4(fa, 0); if (DO_QK) { A2_PINIT(); } SBAR(); if (DO_QK) { A2_LOADK(fa, kb_, 0); } SBAR(); A2_PV4(fb, 1); SBAR(); if (DO_QK) { A2_LOADK(fb, kb_, 2); } SBAR(); } \
        else if (DO_QK) { A2_LOADK(fa, kb_, 0); A2_LOADK(fb, kb_, 2); A2_PINIT(); SBAR(); } \
        if (DO_QK) { A2_QK4(fa, 0); SBAR(); A2_QK4(fb, 2); SBAR(); } \
        __builtin_amdgcn_s_setprio(0); } while (0)
#define A2_SEGV(t) do { \
        if ((t) >= 4) { \
            if (MODE == 0) { const int kb0_ = k0win + 64 * ((t) - 4); if ((kb0_ + 63 > qs + 128) || (kb0_ < qs + 31 - 128)) { const int dq_ = kb0_ + 4 * hi - (qs + r32) + 128; \
                _Pragma("unroll") for (int q_ = 0; q_ < 16; ++q_) { const int kk_ = (q_ & 3) + 8 * (q_ >> 2); if ((unsigned)(dq_ + kk_) > 256u) p0[q_] = NEG_BIG; if ((unsigned)(dq_ + kk_ + 32) > 256u) p1[q_] = NEG_BIG; } } } \
            else { const int kr_ = (k0win >> 6) + (t) - 4; const bool rowok_ = (kr_ >= rs) && (kr_ < rs + 8); const int rel_ = rowok_ ? 4 * hi - cs : 1000; const LAS float* bp_ = btab + (rowok_ ? kr_ - r + 7 : 0) * 31 + 4 * hi - c + 15; \
                _Pragma("unroll") for (int q_ = 0; q_ < 16; ++q_) { const int kk_ = (q_ & 3) + 8 * (q_ >> 2); const float b0_ = bp_[kk_], b1_ = bp_[kk_ + 32]; \
                    p0[q_] = ((unsigned)(rel_ + kk_) < 16u) ? p0[q_] + b0_ : NEG_BIG; p1[q_] = ((unsigned)(rel_ + kk_ + 32) < 16u) ? p1[q_] + b1_ : NEG_BIG; } } } \
        float rm = p0[0]; \
        _Pragma("unroll") for (int q_ = 1; q_ < 16; ++q_) rm = fmaxf(rm, p0[q_]); \
        _Pragma("unroll") for (int q_ = 0; q_ < 16; ++q_) rm = fmaxf(rm, p1[q_]); \
        rm = hmax(rm); \
        if ((t) == 0 || __any(rm > DF_THR)) { const float dl = ((t) == 0) ? rm : fmaxf(rm, 0.f); m += dl; \
            _Pragma("unroll") for (int q_ = 0; q_ < 16; ++q_) { p0[q_] -= dl; p1[q_] -= dl; } \
            const float f = __builtin_amdgcn_exp2f(-dl); l *= f; oT[0] = oT[0] * f; oT[1] = oT[1] * f; } \
        float s_ = 0.f; \
        _Pragma("unroll") for (int q_ = 0; q_ < 16; ++q_) { p0[q_] = __builtin_amdgcn_exp2f(p0[q_]); p1[q_] = __builtin_amdgcn_exp2f(p1[q_]); s_ += p0[q_] + p1[q_]; } \
        l += s_; \
        _Pragma("unroll") for (int k = 0; k < 2; ++k) { \
            pw[k]     = (u32x4){cvtpk(p0[8 * k], p0[8 * k + 1]), cvtpk(p0[8 * k + 2], p0[8 * k + 3]), cvtpk(p0[8 * k + 4], p0[8 * k + 5]), cvtpk(p0[8 * k + 6], p0[8 * k + 7])}; \
            pw[2 + k] = (u32x4){cvtpk(p1[8 * k], p1[8 * k + 1]), cvtpk(p1[8 * k + 2], p1[8 * k + 3]), cvtpk(p1[8 * k + 4], p1[8 * k + 5]), cvtpk(p1[8 * k + 6], p1[8 * k + 7])}; } \
        } while (0)
        DF_BARV();
        int so_p = 0, so_c = 0;
#define A2_ROT() do { so_p = so_c; so_c = (so_c == 32768) ? 0 : so_c + 16384; } while (0)
        bf16x8 fa[4], fb[4];
        if (grp == 0) {
            A2_DMA(1); A2_SEGM(false, true, 0, so_c); SBAR(); A2_PREV(so_c); A2_SEGV(0); SBAR(); DF_BARV(); SBAR();
            for (int t = 1; t < NT; ++t) { A2_ROT();
                A2_DMA(t + 1); A2_SEGM(true, true, so_p, so_c); SBAR(); A2_PREV(so_c); A2_SEGV(t); SBAR(); DF_BARV(); SBAR(); }
            A2_ROT();
            A2_SEGM(true, false, so_p, 0); SBAR(); DF_BARV(); SBAR();
        } else {
            A2_DMA(1); A2_SEGM(false, true, 0, so_c); SBAR(); DF_BARV(); SBAR();
            for (int t = 1; t < NT; ++t) { A2_ROT();
                A2_DMA(t + 1); A2_PREV(so_p); A2_SEGV(t - 1); SBAR(); A2_SEGM(true, true, so_p, so_c); SBAR(); DF_BARV(); SBAR(); }
            A2_ROT();
            A2_PREV(so_p); A2_SEGV(NT - 1); SBAR(); A2_SEGM(true, false, so_p, 0); SBAR(); DF_BARV(); SBAR();
        }
        l = hsum(l);
        if (MODE == 0) l += __builtin_amdgcn_exp2f(A.aux[hq] * LOG2E - m);
        if (OUTPROJ_FP8) store_oT<2>(oT, 1.f / l, A.y, (size_t)(qrow0 + r32) * DM + hq * 64, hi);
        else { LAS unsigned char* stg = lds + wid * 8192; const float sc_ = 1.f / l;
#pragma unroll
            for (int d = 0; d < 2; ++d)
#pragma unroll
                for (int g = 0; g < 4; ++g) { u32x2 w; w.x = cvtpk(oT[d][4 * g] * sc_, oT[d][4 * g + 1] * sc_); w.y = cvtpk(oT[d][4 * g + 2] * sc_, oT[d][4 * g + 3] * sc_);
                    *(LAS u32x2*)(stg + r32 * 144 + (d * 32 + 8 * g + 4 * hi) * 2) = w; }
            stg_flush<2>(stg, A.y + (size_t)qrow0 * DM + hq * 64, lane); }
        DF_BAR();
#undef A2_DMA
#undef A2_LOADV
#undef A2_PV4
#undef A2_LOADK
#undef A2_QK4
#undef A2_SEGM
#undef A2_SEGV
#undef A2_PREV
#undef A2_PINIT
#undef A2_ROT
    }
}
#undef SBAR
}

struct Frame {
    LAS unsigned char* lds; volatile LAS unsigned* MISC; unsigned* ctl;
    int tid, lane, wave, vcu, G;
};

__device__ __forceinline__ void transpose_item(const float* W, int K, int N, bf16_t* WT, int k0, int n0, int drow0, LAS float* scr, int lane) {
    f32x4 v[16];
    const float* src = W + (size_t)(k0 + (lane >> 4)) * N + n0 + 4 * (lane & 15);
#pragma unroll
    for (int i = 0; i < 16; ++i) v[i] = *(const f32x4*)(src + (size_t)(4 * i) * N);
#pragma unroll
    for (int i = 0; i < 16; ++i) { LAS float* d = scr + (4 * i + (lane >> 4)) * 65 + 4 * (lane & 15); d[0] = v[i].x; d[1] = v[i].y; d[2] = v[i].z; d[3] = v[i].w; }
    LDS_WAIT(); asm volatile("" ::: "memory");
    const int c = lane & 7;
#pragma unroll
    for (int j = 0; j < 8; ++j) { const int n = (lane >> 3) + 8 * j; const LAS float* s = scr + (8 * c) * 65 + n;
        u32x4 o; o.x = cvtpk(s[0 * 65], s[1 * 65]); o.y = cvtpk(s[2 * 65], s[3 * 65]); o.z = cvtpk(s[4 * 65], s[5 * 65]); o.w = cvtpk(s[6 * 65], s[7 * 65]);
        *(u32x4*)(WT + (size_t)(drow0 + n) * K + k0 + 8 * c) = o; }
    LDS_WAIT(); asm volatile("" ::: "memory");
}

enum { KA_x, KA_c, KA_ctx, KA_c_ctx, KA_ada_w, KA_ada_b, KA_norm1_g, KA_norm2_g, KA_final_g, KA_win_w_in, KA_win_w_out, KA_win_sink, KA_diff_w_in, KA_diff_w_out, KA_diff_lambda, KA_diff_subln_g,
       KA_na_w_in, KA_na_w_out, KA_na_rpb, KA_router_w, KA_w_gate, KA_w_up, KA_w_down, KA_OUT, KA_WS };
__device__ __forceinline__ const float* karg(int i) { asm volatile("" : "+s"(i)); return (const float*)(((const unsigned long long __attribute__((address_space(4)))*)__builtin_amdgcn_kernarg_segment_ptr())[i]); }
__device__ __forceinline__ void t8_load(f32x4 (&v)[16], const float* W, int N, int k0, int n0, int lane) {
    const float* src = W + (size_t)(k0 + (lane >> 4)) * N + n0 + 4 * (lane & 15);
#pragma unroll
    for (int i = 0; i < 16; ++i) v[i] = *(const f32x4*)(src + (size_t)(4 * i) * N);
}
__device__ __forceinline__ void t8_finish(const f32x4 (&v)[16], int Kb, unsigned char* WT, int k0, int drow0, LAS float* scr, int lane) {
#pragma unroll
    for (int i = 0; i < 16; ++i) { LAS float* d = scr + (4 * i + (lane >> 4)) * 65 + 4 * (lane & 15); d[0] = v[i].x * W8_SCALE; d[1] = v[i].y * W8_SCALE; d[2] = v[i].z * W8_SCALE; d[3] = v[i].w * W8_SCALE; }
    LDS_WAIT(); asm volatile("" ::: "memory");
    const int c = lane & 3;
#pragma unroll
    for (int j = 0; j < 4; ++j) { const int n = (lane >> 2) + 16 * j; const LAS float* s = scr + (16 * c) * 65 + n;
        int w[4];
#pragma unroll
        for (int q = 0; q < 4; ++q) { int t = 0; t = __builtin_amdgcn_cvt_pk_fp8_f32(s[(4 * q) * 65], s[(4 * q + 1) * 65], t, false); t = __builtin_amdgcn_cvt_pk_fp8_f32(s[(4 * q + 2) * 65], s[(4 * q + 3) * 65], t, true); w[q] = t; }
        *(u32x4*)(WT + (size_t)(drow0 + n) * Kb + k0 + 16 * c) = (u32x4){(unsigned)w[0], (unsigned)w[1], (unsigned)w[2], (unsigned)w[3]}; }
    LDS_WAIT(); asm volatile("" ::: "memory");
}
__device__ __forceinline__ void transpose_item8(const float* W, int Kb, int N, unsigned char* WT, int k0, int n0, int drow0, LAS float* scr, int lane) {
    f32x4 v[16]; t8_load(v, W, N, k0, n0, lane); t8_finish(v, Kb, WT, k0, drow0, scr, lane);
}

struct In {
    const float *x, *c, *ctx, *c_ctx, *ada_w, *ada_b, *norm1_g, *norm2_g, *final_g, *win_w_in, *win_w_out, *win_sink, *diff_w_in, *diff_w_out, *diff_lambda, *diff_subln_g,
        *na_w_in, *na_w_out, *na_rpb, *router_w, *w_gate, *w_up, *w_down;
};

__device__ __forceinline__ void phase_prologue(Frame& F, unsigned char* ws) {
    int tid_ = threadIdx.x; asm volatile("" : "+v"(tid_)); const int lane_ = tid_ & 63; const int wave_ = __builtin_amdgcn_readfirstlane(tid_ >> 6);
    LAS float* scr = (LAS float*)(F.lds + wave_ * 16640);
    const int gw = F.vcu * NWAVES + wave_, NGW = F.G * NWAVES;
    if (F.vcu == 0) {
        float* tab = (float*)(ws + WS_TAB);
        for (int i = tid_; i < 1024; i += 512) { const int pos = i >> 4, f = i & 15; const float inv = 1.0f / powf(10000.0f, (float)(2 * f) / 32.0f); const float ang = (float)pos * inv;
            tab[TAB_COS + i] = cosf(ang); tab[TAB_SIN + i] = sinf(ang); }
        if (wave_ == 0) { const float* lp = karg(KA_diff_lambda); const float a = wave_sum(lp[lane_] * lp[64 + lane_]), b2 = wave_sum(lp[128 + lane_] * lp[192 + lane_]);
            const float li = 0.8f - 0.6f * expf(-0.3f * 1.0f); if (lane_ == 0) { tab[TAB_LAM] = expf(a) - expf(b2) + li; tab[TAB_LAM + 1] = 1.0f - li; } }
    }
    {
        bf16_t* pw = (bf16_t*)(ws + WS_PW);
        constexpr int IT_WI = 16 * 24, IT_O = 16 * 16, IT_3 = 16 * 48;
        constexpr int NIT = 2 * IT_WI + 2 * IT_O + IT_3 + IT_O + IT_3 + IT_O;
        for (int it = gw; it < NIT; it += NGW) {
            int r = it; const float* W; bf16_t* WT; int N;
            if (r < 2 * IT_WI) { const int s = r / IT_WI; r -= s * IT_WI; W = karg(KA_win_w_in) + (size_t)s * 1024 * 1536; WT = pw + (PW_WIN_IN / 2) + (size_t)s * 1536 * 1024; N = 1536; }
            else if ((r -= 2 * IT_WI) < 2 * IT_O) { const int s = r / IT_O; r -= s * IT_O; W = karg(KA_win_w_out) + (size_t)s * 1024 * 1024; WT = pw + (PW_WIN_OUT / 2) + (size_t)s * 1024 * 1024; N = 1024; }
            else if ((r -= 2 * IT_O) < IT_3) { W = karg(KA_diff_w_in); WT = pw + PW_DIFF_IN / 2; N = 3072; }
            else if ((r -= IT_3) < IT_O) { W = karg(KA_diff_w_out); WT = pw + PW_DIFF_OUT / 2; N = 1024; }
            else if ((r -= IT_O) < IT_3) { W = karg(KA_na_w_in); WT = pw + PW_NA_IN / 2; N = 3072; }
            else { r -= IT_3; W = karg(KA_na_w_out); WT = pw + PW_NA_OUT / 2; N = 1024; }
            const int nblk = N / 64, kb = r / nblk, nb = r % nblk;
            if ((INPROJ_FP8 && N != 1024) || (OUTPROJ_FP8 && N == 1024)) transpose_item8(W, 1024, N, (unsigned char*)WT, 64 * kb, 64 * nb, 64 * nb, scr, lane_);
            else transpose_item(W, 1024, N, WT, 64 * kb, 64 * nb, 64 * nb, scr, lane_);
        }
    }
    {
        const int NIT = 64 * 1536;
#define MW_DESC(it_, W_, N_, Kb_, WT_, k0_, n0_, dr_) do { const int le_ = (it_) / 1536; int r_ = (it_) % 1536; \
            unsigned char* W1t_ = ws + WS_MOEW + (size_t)le_ * MOEW_E; \
            if (r_ < 1024) { const bool up_ = r_ >= 512; r_ &= 511; W_ = (up_ ? karg(KA_w_up) : karg(KA_w_gate)) + (size_t)le_ * 1024 * 2048; N_ = 2048; Kb_ = 1024; WT_ = W1t_; \
                k0_ = 64 * (r_ / 32); n0_ = 64 * (r_ % 32); dr_ = (n0_ >> 7) * 256 + (up_ ? 128 : 0) + (n0_ & 127); } \
            else { r_ -= 1024; W_ = karg(KA_w_down) + (size_t)le_ * 2048 * 1024; N_ = 1024; Kb_ = 2048; WT_ = W1t_ + (size_t)4096 * 1024; k0_ = 64 * (r_ / 16); n0_ = 64 * (r_ % 16); dr_ = n0_; } } while (0)
        f32x4 va[16], vb[16];
        const float* Wc = nullptr; int Nc = 0, Kbc = 0, k0c = 0, n0c = 0, drc = 0; unsigned char* WTc = nullptr;
        int it = gw;
        if (it < NIT) { MW_DESC(it, Wc, Nc, Kbc, WTc, k0c, n0c, drc); t8_load(va, Wc, Nc, k0c, n0c, lane_); }
        while (it < NIT) {
            const int itn = it + NGW;
            const float* Wn = Wc; int Nn = Nc, Kbn = Kbc, k0n = k0c, n0n = n0c, drn = drc; unsigned char* WTn = WTc;
            if (itn < NIT) { MW_DESC(itn, Wn, Nn, Kbn, WTn, k0n, n0n, drn); t8_load(vb, Wn, Nn, k0n, n0n, lane_); }
            t8_finish(va, Kbc, WTc, k0c, drc, scr, lane_);
#pragma unroll
            for (int i = 0; i < 16; ++i) va[i] = vb[i];
            Wc = Wn; Nc = Nn; Kbc = Kbn; WTc = WTn; k0c = k0n; n0c = n0n; drc = drn; it = itn;
        }
#undef MW_DESC
    }
    __syncthreads();
    {
        LAS float* sc = (LAS float*)F.lds;
        LAS float* red = (LAS float*)(F.lds + 69632);
        for (int i = tid_; i < 17 * 1024; i += 512) { const float v = (i < 16384) ? karg(KA_c)[i] : karg(KA_c_ctx)[i - 16384]; sc[i] = siluf(v); }
        __syncthreads();
        float* mod = (float*)(ws + WS_MOD);
        for (int task = F.vcu; task < 4 * 192; task += F.G) {
            const int L = task / 192, cg = task % 192, col = cg * 32 + (lane_ & 31), kh = lane_ >> 5;
            const float* wp = karg(KA_ada_w) + (size_t)L * 1024 * 6144 + (size_t)(wave_ * 128 + kh * 64) * 6144 + col;
            const LAS float* scp = sc + wave_ * 128 + kh * 64;
            float acc[17];
#pragma unroll
            for (int r = 0; r < 17; ++r) acc[r] = 0.f;
            for (int k0 = 0; k0 < 64; k0 += 16) { float w[16];
#pragma unroll
                for (int kk = 0; kk < 16; ++kk) w[kk] = wp[(size_t)(k0 + kk) * 6144];
#pragma unroll
                for (int kk = 0; kk < 16; ++kk)
#pragma unroll
                    for (int r = 0; r < 17; ++r) acc[r] += scp[r * 1024 + k0 + kk] * w[kk]; }
#pragma unroll
            for (int r = 0; r < 17; ++r) { acc[r] += __shfl_xor(acc[r], 32); if (lane_ < 32) red[(wave_ * 17 + r) * 32 + lane_] = acc[r]; }
            __syncthreads();
            for (int i = tid_; i < 17 * 32; i += 512) { const int r = i >> 5, ln = i & 31; float sum = 0.f;
#pragma unroll
                for (int w = 0; w < 8; ++w) sum += red[(w * 17 + r) * 32 + ln];
                mod[((size_t)L * 17 + r) * 6144 + cg * 32 + ln] = sum + karg(KA_ada_b)[L * 6144 + cg * 32 + ln]; }
            __syncthreads();
        }
    }
}

__device__ __forceinline__ void load_row(const float* row, int lane, f32x4 (&v)[4]) {
    const f32x4* xr = (const f32x4*)row + lane;
#pragma unroll
    for (int j = 0; j < 4; ++j) v[j] = xr[64 * j];
}
__device__ __forceinline__ void load_row_bf16(const bf16_t* row, int lane, u32x2 (&w)[4]) {
    const u32x2* p = (const u32x2*)row + lane;
#pragma unroll
    for (int j = 0; j < 4; ++j) w[j] = p[64 * j];
}
__device__ __forceinline__ void cvt_row_bf16(f32x4 (&v)[4], const u32x2 (&w)[4]) {
#pragma unroll
    for (int j = 0; j < 4; ++j) { v[j].x = __builtin_bit_cast(float, w[j].x << 16); v[j].y = __builtin_bit_cast(float, w[j].x & 0xffff0000u);
        v[j].z = __builtin_bit_cast(float, w[j].y << 16); v[j].w = __builtin_bit_cast(float, w[j].y & 0xffff0000u); }
}
__device__ __forceinline__ void add_row_bf16(f32x4 (&v)[4], const u32x2 (&w)[4]) {
#pragma unroll
    for (int j = 0; j < 4; ++j) { v[j].x += __builtin_bit_cast(float, w[j].x << 16); v[j].y += __builtin_bit_cast(float, w[j].x & 0xffff0000u);
        v[j].z += __builtin_bit_cast(float, w[j].y << 16); v[j].w += __builtin_bit_cast(float, w[j].y & 0xffff0000u); }
}
__device__ __forceinline__ float row_rstd(const f32x4 (&v)[4]) {
    float s = 0.f;
#pragma unroll
    for (int j = 0; j < 4; ++j) s += (v[j].x * v[j].x + v[j].y * v[j].y) + (v[j].z * v[j].z + v[j].w * v[j].w);
    return rsqrtf(wave_sum_fast(s) * (1.f / DM) + RMS_EPS);
}
__device__ __forceinline__ void store_row_bf16(bf16_t* orow, int lane, const f32x4 (&v)[4]) {
    u32x2* o8 = (u32x2*)orow + lane;
#pragma unroll
    for (int j = 0; j < 4; ++j) { u32x2 w; w.x = cvtpk(v[j].x, v[j].y); w.y = cvtpk(v[j].z, v[j].w); o8[64 * j] = w; }
}
__device__ __forceinline__ void store_row_fp8(unsigned char* orow, int lane, const f32x4 (&v)[4], float scale) {
    unsigned* o4 = (unsigned*)orow + lane;
#pragma unroll
    for (int j = 0; j < 4; ++j) { int t = 0; t = __builtin_amdgcn_cvt_pk_fp8_f32(v[j].x * scale, v[j].y * scale, t, false); t = __builtin_amdgcn_cvt_pk_fp8_f32(v[j].z * scale, v[j].w * scale, t, true); o4[64 * j] = (unsigned)t; }
}
struct ModCache { f32x4 sc[4], sh[4]; int b; };
__device__ __forceinline__ void modcache_load(ModCache& M, int b, const float* g, const float* modL, int shift_chunk, int scale_chunk, int lane) {
    if (M.b == b) return; M.b = b;
    const float* mp = modL + (size_t)b * 6144;
#pragma unroll
    for (int j = 0; j < 4; ++j) { const f32x4 gg = ((const f32x4*)g)[lane + 64 * j], s = ((const f32x4*)(mp + scale_chunk * DM))[lane + 64 * j];
        M.sc[j] = gg * (1.f + s); M.sh[j] = ((const f32x4*)(mp + shift_chunk * DM))[lane + 64 * j]; }
}
__device__ __forceinline__ int row_batch(int m) { return m < MX ? (m >> 12) : 16; }

__device__ __forceinline__ void phase_norm1(Frame& F, const float* x, const float* ctx, const float* g1, const float* modL, bf16_t* H, bf16_t* XB) {
    int tid_ = threadIdx.x; asm volatile("" : "+v"(tid_)); const int lane_ = tid_ & 63; const int wave_ = __builtin_amdgcn_readfirstlane(tid_ >> 6);
    const int gw = F.vcu * NWAVES + wave_, NGW = F.G * NWAVES; const int per = (MT + NGW - 1) / NGW;
    ModCache M; M.b = -1;
    const int m0 = gw * per, m1 = min(MT, m0 + per);
    f32x4 nx[4];
    if (m0 < m1) load_row(m0 < MX ? x + (size_t)m0 * DM : ctx + (size_t)(m0 - MX) * DM, lane_, nx);
    for (int m = m0; m < m1; ++m) {
        f32x4 v[4];
#pragma unroll
        for (int j = 0; j < 4; ++j) v[j] = nx[j];
        if (m + 1 < m1) load_row((m + 1) < MX ? x + (size_t)(m + 1) * DM : ctx + (size_t)(m + 1 - MX) * DM, lane_, nx);
        modcache_load(M, row_batch(m), g1, modL, 0, 1, lane_);
        store_row_bf16(XB + (size_t)m * DM, lane_, v);
        const float rstd = row_rstd(v);
#pragma unroll
        for (int j = 0; j < 4; ++j) v[j] = v[j] * rstd * M.sc[j] + M.sh[j];
        if (INPROJ_FP8) store_row_fp8((unsigned char*)H + (size_t)m * DM, lane_, v, H2_SCALE); else store_row_bf16(H + (size_t)m * DM, lane_, v);
    }
}

__device__ __forceinline__ void phase_norm2_router(Frame& F, const bf16_t* XB, const float* g2, const float* modL, const float* rw, unsigned char* H8, float* aff, int nrows, const bf16_t* P, bool do_router = true) {
    int tid_ = threadIdx.x; asm volatile("" : "+v"(tid_)); const int lane = tid_ & 63; const int wave_ = __builtin_amdgcn_readfirstlane(tid_ >> 6);
    LAS float* rwT = (LAS float*)F.lds;
    for (int i = tid_; i < 16384; i += 512) { const int d = i >> 4, e = i & 15; rwT[e * 1024 + d] = rw[i]; }
    __syncthreads();
    const int gw = F.vcu * NWAVES + wave_, NGW = F.G * NWAVES; constexpr int NR2 = 1; const int ngroups = nrows / NR2; const int per = (ngroups + NGW - 1) / NGW;
    ModCache M; M.b = -1;
    const int g0 = gw * per, g1 = min(ngroups, g0 + per);
    constexpr int ND3 = 3;
    u32x2 nx[ND3][4];
#pragma unroll
    for (int k = 0; k < ND3; ++k) if (g0 + k < g1) { load_row_bf16(XB + (size_t)(g0 + k) * DM, lane, nx[k]); }
    for (int gb = g0; gb < g1; gb += ND3)
#pragma unroll
    for (int k = 0; k < ND3; ++k) {
        const int g = gb + k; if (g >= g1) break;
        const int m = NR2 * g;
        f32x4 v[NR2][4];
        cvt_row_bf16(v[0], nx[k]);
        if (g + ND3 < g1) { load_row_bf16(XB + (size_t)(g + ND3) * DM, lane, nx[k]); }
        modcache_load(M, row_batch(m), g2, modL, 3, 4, lane);
#pragma unroll
        for (int r = 0; r < NR2; ++r) { const float rstd = row_rstd(v[r]);
#pragma unroll
            for (int j = 0; j < 4; ++j) v[r][j] = v[r][j] * rstd * M.sc[j] + M.sh[j];
            store_row_fp8(H8 + (size_t)(m + r) * DM, lane, v[r], H2_SCALE); }
        if (!do_router) continue;
        float pe[NR2][16];
        int lo4 = 4 * lane; asm volatile("" : "+v"(lo4));
#pragma unroll
        for (int eb = 0; eb < 16; eb += 4) {
            f32x4 w[4][4];
#pragma unroll
            for (int e4 = 0; e4 < 4; ++e4)
#pragma unroll
                for (int j = 0; j < 4; ++j) w[e4][j] = *(const LAS f32x4*)(rwT + (eb + e4) * 1024 + lo4 + 256 * j);
            __builtin_amdgcn_sched_barrier(0);
#pragma unroll
            for (int e4 = 0; e4 < 4; ++e4) { f32x2 s2 = {0.f, 0.f};
#pragma unroll
                for (int j = 0; j < 4; ++j) { s2 = __builtin_elementwise_fma((f32x2){v[0][j].x, v[0][j].y}, (f32x2){w[e4][j].x, w[e4][j].y}, s2); s2 = __builtin_elementwise_fma((f32x2){v[0][j].z, v[0][j].w}, (f32x2){w[e4][j].z, w[e4][j].w}, s2); }
                pe[0][eb + e4] = s2.x + s2.y; }
            __builtin_amdgcn_sched_barrier(0);
        }
        {
            LAS float* red = (LAS float*)(F.lds + 65536) + wave_ * 1088;
#pragma unroll
            for (int e = 0; e < 16; ++e) red[lane * 17 + e] = pe[0][e];
            const LAS float* rp = red + (lane >> 4) * 272 + (lane & 15);
            float sacc = 0.f;
#pragma unroll
            for (int i = 0; i < 16; ++i) sacc += rp[i * 17];
            sacc += __shfl_xor(sacc, 16); sacc += __shfl_xor(sacc, 32);
            const float mx = row16_max(sacc);
            const float ex = expf(sacc - mx);
            const float sm = row16_sum(ex);
            if (lane < 16) aff[(size_t)m * 16 + lane] = ex / sm;
        }
    }
    __syncthreads();
}

__device__ __forceinline__ void phase_norm2_router_mfma(Frame& F, const bf16_t* XB, const float* g2, const float* modL, const float* rw, unsigned char* H8, float* aff, int nrows) {
    int tid_ = threadIdx.x; asm volatile("" : "+v"(tid_)); const int lane = tid_ & 63; const int wave_ = __builtin_amdgcn_readfirstlane(tid_ >> 6);
    constexpr int AST = 2064;
    LAS unsigned char* Ahi = F.lds; LAS unsigned char* Alo = F.lds + 16 * AST; LAS float* red = (LAS float*)(F.lds + 2 * 16 * AST);
    const int e_ = lane & 15, kg = lane >> 4;
    bf16x8 Bh[4], Bl[4];
#pragma unroll
    for (int s = 0; s < 4; ++s) { const float* wp = rw + (size_t)(128 * wave_ + 32 * s + 8 * kg) * 16 + e_;
        const float x0 = wp[0], x1 = wp[16], x2 = wp[32], x3 = wp[48], x4 = wp[64], x5 = wp[80], x6 = wp[96], x7 = wp[112];
        u32x4 h, l; h.x = cvtpk(x0, x1); h.y = cvtpk(x2, x3); h.z = cvtpk(x4, x5); h.w = cvtpk(x6, x7);
        l.x = cvtpk(x0 - __builtin_bit_cast(float, h.x << 16), x1 - __builtin_bit_cast(float, h.x & 0xffff0000u)); l.y = cvtpk(x2 - __builtin_bit_cast(float, h.y << 16), x3 - __builtin_bit_cast(float, h.y & 0xffff0000u));
        l.z = cvtpk(x4 - __builtin_bit_cast(float, h.z << 16), x5 - __builtin_bit_cast(float, h.z & 0xffff0000u)); l.w = cvtpk(x6 - __builtin_bit_cast(float, h.w << 16), x7 - __builtin_bit_cast(float, h.w & 0xffff0000u));
        Bh[s] = __builtin_bit_cast(bf16x8, h); Bl[s] = __builtin_bit_cast(bf16x8, l); }
    const int ngroups = nrows >> 4; const int per = (ngroups + F.G - 1) / F.G; const int gg0 = F.vcu * per, gg1 = min(ngroups, gg0 + per);
    ModCache M; M.b = -1;
    u32x2 nx[2][4];
    if (gg0 < gg1) { load_row_bf16(XB + (size_t)(gg0 * 16 + 2 * wave_) * DM, lane, nx[0]); load_row_bf16(XB + (size_t)(gg0 * 16 + 2 * wave_ + 1) * DM, lane, nx[1]); }
    for (int gg = gg0; gg < gg1; ++gg) {
        const int mbase = gg * 16;
        f32x4 v[2][4];
        cvt_row_bf16(v[0], nx[0]); cvt_row_bf16(v[1], nx[1]);
        if (gg + 1 < gg1) { load_row_bf16(XB + (size_t)(mbase + 16 + 2 * wave_) * DM, lane, nx[0]); load_row_bf16(XB + (size_t)(mbase + 16 + 2 * wave_ + 1) * DM, lane, nx[1]); }
#pragma unroll
        for (int r = 0; r < 2; ++r) { const int tok = 2 * wave_ + r, m = mbase + tok;
            modcache_load(M, row_batch(m), g2, modL, 3, 4, lane);
            const float rstd = row_rstd(v[r]);
#pragma unroll
            for (int j = 0; j < 4; ++j) v[r][j] = v[r][j] * rstd * M.sc[j] + M.sh[j];
            store_row_fp8(H8 + (size_t)m * DM, lane, v[r], H2_SCALE);
            LAS unsigned char* ah = Ahi + tok * AST + 8 * lane;
#pragma unroll
            for (int j = 0; j < 4; ++j) { const f32x4 x = v[r][j]; u32x2 h, l; h.x = cvtpk(x.x, x.y); h.y = cvtpk(x.z, x.w);
                l.x = cvtpk(x.x - __builtin_bit_cast(float, h.x << 16), x.y - __builtin_bit_cast(float, h.x & 0xffff0000u)); l.y = cvtpk(x.z - __builtin_bit_cast(float, h.y << 16), x.w - __builtin_bit_cast(float, h.y & 0xffff0000u));
                *(LAS u32x2*)(ah + 512 * j) = h; *(LAS u32x2*)(ah + 16 * AST + 512 * j) = l; } }
        __syncthreads();
        f32x4 acc = {0.f, 0.f, 0.f, 0.f};
#pragma unroll
        for (int s = 0; s < 4; ++s) { const LAS unsigned char* ap = Ahi + e_ * AST + 256 * wave_ + 64 * s + 16 * kg;
            const bf16x8 a_h = *(const LAS bf16x8*)ap, a_l = *(const LAS bf16x8*)(ap + 16 * AST);
            acc = __builtin_amdgcn_mfma_f32_16x16x32_bf16(a_h, Bh[s], acc, 0, 0, 0); acc = __builtin_amdgcn_mfma_f32_16x16x32_bf16(a_h, Bl[s], acc, 0, 0, 0); acc = __builtin_amdgcn_mfma_f32_16x16x32_bf16(a_l, Bh[s], acc, 0, 0, 0); }
#pragma unroll
        for (int r = 0; r < 4; ++r) red[wave_ * 256 + (4 * kg + r) * 16 + e_] = acc[r];
        __syncthreads();
        if (tid_ < 256) { float sacc = 0.f;
#pragma unroll
            for (int w = 0; w < 8; ++w) sacc += red[w * 256 + tid_];
            const float mx = row16_max(sacc);
            const float ex = expf(sacc - mx);
            const float sm = row16_sum(ex);
            aff[(size_t)(mbase + (tid_ >> 4)) * 16 + (tid_ & 15)] = ex / sm; }
    }
    __syncthreads();
}

template <int NPT>
__device__ __forceinline__ void topk_task(Frame& F, const float* aff, int rowbase, int n, int cap, int e, int slot_base, unsigned* rowsrc_e, short* slot) {
    int tid_ = threadIdx.x; asm volatile("" : "+v"(tid_)); const int lane_ = tid_ & 63; const int wave_ = __builtin_amdgcn_readfirstlane(tid_ >> 6);
    LAS unsigned* cnt = (LAS unsigned*)F.lds;
    const int tid = tid_, lane = lane_, wave = wave_;
    const bool act = tid * NPT < n;
    unsigned v[NPT];
#pragma unroll
    for (int j = 0; j < NPT; ++j) v[j] = act ? __float_as_uint(aff[(size_t)(rowbase + tid * NPT + j) * 16 + e]) : 0u;
    unsigned T = 0u;
    for (int bit = 30; bit >= 0; --bit) {
        const unsigned cand = T | (1u << bit);
        unsigned c = 0;
#pragma unroll
        for (int j = 0; j < NPT; ++j) c += (act && v[j] >= cand) ? 1u : 0u;
        c = (unsigned)wave_sum((float)c);
        LAS unsigned* cb = cnt + (bit & 1) * 8;
        if (lane == 0) cb[wave] = c;
        __syncthreads();
        unsigned tot = 0;
#pragma unroll
        for (int w = 0; w < 8; ++w) tot += cb[w];
        if (tot >= (unsigned)cap) T = cand;
    }
    unsigned ngt = 0, neq = 0;
#pragma unroll
    for (int j = 0; j < NPT; ++j) { ngt += (act && v[j] > T) ? 1u : 0u; neq += (act && v[j] == T) ? 1u : 0u; }
    unsigned pk = ngt | (neq << 16), inc = pk;
#pragma unroll
    for (int o = 1; o < 64; o <<= 1) { const unsigned t = __shfl_up(inc, o); if (lane >= o) inc += t; }
    LAS unsigned* wtot = cnt + 32;
    __syncthreads();
    if (lane == 63) wtot[wave] = inc;
    __syncthreads();
    unsigned wpre = 0, total = 0;
#pragma unroll
    for (int w = 0; w < 8; ++w) { const unsigned t = wtot[w]; if (w < wave) wpre += t; total += t; }
    const unsigned exc = wpre + inc - pk;
    const unsigned tot_gt = total & 0xffffu;
    const unsigned need_eq = (unsigned)cap - tot_gt;
    unsigned gt_before = exc & 0xffffu, eq_before = exc >> 16;
    if (act) {
#pragma unroll
        for (int j = 0; j < NPT; ++j) {
            const bool g = v[j] > T, q = v[j] == T;
            const bool sel = g || (q && eq_before < need_eq);
            const int tok = tid * NPT + j;
            short sv = -1;
            if (sel) { const unsigned pos = gt_before + min(eq_before, need_eq); sv = (short)(slot_base + pos); rowsrc_e[slot_base + pos] = (unsigned)(rowbase + tok); }
            slot[(size_t)(rowbase + tok) * 16 + e] = sv;
            gt_before += g ? 1u : 0u; eq_before += q ? 1u : 0u;
        }
    }
    __syncthreads();
}
__device__ __forceinline__ void phase_topk(Frame& F, const float* aff, unsigned* rowsrc, short* slot, int nMe, bool with_ctx) {
    const int ntask = NB * NE * (with_ctx ? 2 : 1);
    for (int t = F.vcu; t < ntask; t += F.G) {
        const bool cx = t >= NB * NE; const int tt = cx ? t - NB * NE : t; const int b = tt >> 4, e = tt & 15;
        unsigned* rs_e = rowsrc + (size_t)e * nMe * 256;
        if (!cx) topk_task<8>(F, aff, b * SEQ, SEQ, CAPX, e, b * CAPX, rs_e, slot);
        else topk_task<1>(F, aff, MX + b * CTXL, CTXL, CAPC, e, NB * CAPX + b * CAPC, rs_e, slot);
    }
}

__device__ __forceinline__ void phase_combine(Frame& F, bf16_t* XB, const bf16_t* P, float* xout, const float* modL, const float* aff, const short* slot, const bf16_t* ybuf, int nMe,
                                              int nrows, bool last, const float* gnext, const float* modN, bf16_t* H, const float* final_g, float* dump = nullptr) {
    int tid_ = threadIdx.x; asm volatile("" : "+v"(tid_)); const int lane = tid_ & 63; const int wave_ = __builtin_amdgcn_readfirstlane(tid_ >> 6);
    const int gw = F.vcu * NWAVES + wave_, NGW = F.G * NWAVES; const int per = (nrows + NGW - 1) / NGW;
    ModCache M; M.b = -1;
    f32x4 g2v[4]; int gb = -1;
    const int m0 = gw * per, m1 = min(nrows, m0 + per);
    const size_t estride = (size_t)nMe * 256 * DM;
#define CB_META(m, sv, av) do { sv = (int)slot[(size_t)(m) * 16 + (lane & 15)]; av = aff[(size_t)(m) * 16 + (lane & 15)]; } while (0)
#define CB_ISSUE(m, sv, av, X, Y, AK, REST) do { load_row_bf16(XB + (size_t)(m) * DM, lane, X); \
        unsigned mk_ = (unsigned)__ballot(sv >= 0) & 0xffffu; \
        _Pragma("unroll") for (int k = 0; k < 4; ++k) { \
            if (mk_) { const int e_ = __builtin_ctz(mk_); mk_ &= mk_ - 1u; const int s_ = __builtin_amdgcn_readlane(sv, e_); AK[k] = __builtin_bit_cast(float, __builtin_amdgcn_readlane(__builtin_bit_cast(int, av), e_)); \
                const u32x2* yr_ = (const u32x2*)(ybuf + (size_t)e_ * estride + (size_t)s_ * DM) + lane; \
                _Pragma("unroll") for (int j = 0; j < 4; ++j) Y[k][j] = yr_[64 * j]; } \
            else { AK[k] = 0.f; _Pragma("unroll") for (int j = 0; j < 4; ++j) Y[k][j] = (u32x2){0u, 0u}; } } \
        REST = mk_; } while (0)
    int sv1 = -1, sv2 = -1; float av1 = 0.f, av2 = 0.f;
    u32x2 X[4], Xn[4]; u32x2 Y[4][4], Yn[4][4]; float AK[4], AKn[4]; unsigned rest = 0, restn = 0; int svc = -1, svn = -1; float avc = 0.f, avn = 0.f;
    if (m0 < m1) { CB_META(m0, sv1, av1); CB_ISSUE(m0, sv1, av1, X, Y, AK, rest); svc = sv1; avc = av1; }
    if (m0 + 1 < m1) CB_META(m0 + 1, sv1, av1);
    for (int m = m0; m < m1; ++m) {
        if (m + 1 < m1) { CB_ISSUE(m + 1, sv1, av1, Xn, Yn, AKn, restn); svn = sv1; avn = av1; }
        if (m + 2 < m1) CB_META(m + 2, sv1, av1);
        const int b = row_batch(m);
        if (gb != b) { gb = b;
#pragma unroll
            for (int j = 0; j < 4; ++j) g2v[j] = ((const f32x4*)(modL + (size_t)b * 6144 + 5 * DM))[lane + 64 * j]; }
        f32x4 acc[4];
#pragma unroll
        for (int j = 0; j < 4; ++j) acc[j] = (f32x4){0.f, 0.f, 0.f, 0.f};
#pragma unroll
        for (int k = 0; k < 4; ++k) { const float a = AK[k];
#pragma unroll
            for (int j = 0; j < 4; ++j) { const u32x2 w = Y[k][j];
                acc[j].x += a * __builtin_bit_cast(float, w.x << 16); acc[j].y += a * __builtin_bit_cast(float, w.x & 0xffff0000u);
                acc[j].z += a * __builtin_bit_cast(float, w.y << 16); acc[j].w += a * __builtin_bit_cast(float, w.y & 0xffff0000u); } }
        while (rest) { const int e_ = __builtin_ctz(rest); rest &= rest - 1u; const int s_ = __builtin_amdgcn_readlane(svc, e_); const float a = __builtin_bit_cast(float, __builtin_amdgcn_readlane(__builtin_bit_cast(int, avc), e_));
            const u32x2* yr = (const u32x2*)(ybuf + (size_t)e_ * estride + (size_t)s_ * DM) + lane;
#pragma unroll
            for (int j = 0; j < 4; ++j) { const u32x2 w = yr[64 * j];
                acc[j].x += a * __builtin_bit_cast(float, w.x << 16); acc[j].y += a * __builtin_bit_cast(float, w.x & 0xffff0000u);
                acc[j].z += a * __builtin_bit_cast(float, w.y << 16); acc[j].w += a * __builtin_bit_cast(float, w.y & 0xffff0000u); } }
        f32x4 v[4];
        cvt_row_bf16(v, X);
#pragma unroll
        for (int j = 0; j < 4; ++j) v[j] = v[j] + g2v[j] * acc[j];
        const float rstd = row_rstd(v);
        if (!last) {
            store_row_bf16((dump ? (bf16_t*)dump : XB) + (size_t)m * DM, lane, v);
            modcache_load(M, b, gnext, modN, 0, 1, lane);
#pragma unroll
            for (int j = 0; j < 4; ++j) v[j] = v[j] * rstd * M.sc[j] + M.sh[j];
            if (INPROJ_FP8) store_row_fp8((unsigned char*)H + (size_t)m * DM, lane, v, H2_SCALE); else store_row_bf16(H + (size_t)m * DM, lane, v);
        } else {
            f32x4* o = (f32x4*)((dump ? dump : xout) + (size_t)m * DM) + lane;
#pragma unroll
            for (int j = 0; j < 4; ++j) o[64 * j] = v[j] * rstd * ((const f32x4*)final_g)[lane + 64 * j];
        }
#pragma unroll
        for (int j = 0; j < 4; ++j) { X[j] = Xn[j];
#pragma unroll
            for (int k = 0; k < 4; ++k) Y[k][j] = Yn[k][j]; }
#pragma unroll
        for (int k = 0; k < 4; ++k) AK[k] = AKn[k];
        rest = restn; svc = svn; avc = avn;
    }
#undef CB_META
#undef CB_ISSUE
}

struct Args { In in; float* out; unsigned char* ws; int ph_lo, ph_hi; };
#define WSP(off) ((unsigned char*)karg(KA_WS) + (off))
__global__ void __launch_bounds__(NWAVES * 64, 2) fwd(Args args) {
    extern __shared__ __attribute__((aligned(16))) unsigned char lds_raw[];
    Frame F;
    F.lds = (LAS unsigned char*)lds_raw;
    F.MISC = (volatile LAS unsigned*)(F.lds + MISC_OFF);
    F.tid = threadIdx.x; F.lane = F.tid & 63; F.wave = __builtin_amdgcn_readfirstlane(F.tid >> 6);
    F.G = gridDim.x; { const int bx = blockIdx.x; F.vcu = (F.G % 8 == 0) ? (bx % 8) * (F.G / 8) + bx / 8 : bx; }
    F.ctl = nullptr;
    if (F.tid < 64) ((LAS unsigned*)(F.lds + MISC_OFF))[F.tid] = 0u;
    __syncthreads();
    const int lo = args.ph_lo, hi = args.ph_hi;
    if (hi - lo > 1) (void)xcd_barrier_post((unsigned*)WSP(WS_CTL) + 1024, F.MISC + 8);
#ifndef DBG_ONLY
#define DBG_ONLY -1
#endif
#define PHEN(k) (DBG_ONLY < 0 || ((k) < 2 ? (k) : 2 + (((k) - 2) & 7)) == DBG_ONLY)
#define IN(k) (PHEN(k) && lo <= (k) && (k) < hi)
#ifndef ROUTER_MFMA
#define ROUTER_MFMA 1
#endif
#ifndef DUP_PH
#define DUP_PH -1
#endif
#ifndef DUP_LMASK
#define DUP_LMASK 0xF
#endif
#define NREP(k, L) ((DUP_PH == (k) && ((DUP_LMASK >> (L)) & 1)) ? 2 : 1)
#define SEAM(k) do { if (IN(k) && IN((k) + 1)) { XcdBarrier bar_; bar_.bar = (unsigned*)WSP(WS_CTL) + 1024; bar_.x = xb_xcc_id(); bar_.st = F.MISC + 8; xcd_barrier(bar_); } } while (0)

    if (IN(0)) { for (int rep_ = 0; rep_ < NREP(0, 0); ++rep_) phase_prologue(F, WSP(0)); } SEAM(0);
    if (IN(1)) { phase_norm1(F, karg(KA_x), karg(KA_ctx), karg(KA_norm1_g), (const float*)WSP(WS_MOD), (bf16_t*)WSP(WS_H), (bf16_t*)WSP(WS_XB)); } SEAM(1);

#pragma unroll 1
    for (int L = 0; L < DEPTH; ++L) {
        const int pb = 2 + 8 * L;
        if (hi <= pb || lo >= pb + 8) continue;
        if (IN(pb + 0)) for (int rep_ = 0; rep_ < NREP(2, L); ++rep_) {
            const int kind = L % 3, slot = L / 3; const int Nin = (kind == 0) ? 1536 : 3072;
            const bf16_t* Wt = (const bf16_t*)WSP(WS_PW) + (kind == 0 ? PW_WIN_IN / 2 + (size_t)slot * 1536 * 1024 : kind == 1 ? PW_DIFF_IN / 2 : PW_NA_IN / 2);
            pg8::Gemm g{(const char*)WSP(WS_H), (const char*)Wt, INPROJ_FP8 ? DM : DM * 2, 1 << 20, 0, nullptr};
            pg8::StaticOrder S; S.init(MT / 256, Nin / 256, F.G, (int)blockIdx.x);
            pg8::EpiInProj E{(bf16_t*)WSP(WS_QKV), Nin, 4, kind == 0 ? 5 : (kind == 1 ? 8 : 0), (const float*)WSP(WS_TAB), INPROJ_FP8 ? 1.f / (H2_SCALE * W8_SCALE) : 1.f, kind == 0 ? 5 : 8, (bf16_t*)WSP(WS_P)};
            pg8::gemm_phase<pg8::EpiInProj, false, true, INPROJ_FP8 != 0>(F.lds, g, S, E);
        }
        SEAM(pb + 0);
        if (IN(pb + 1)) for (int rep_ = 0; rep_ < NREP(3, L); ++rep_) {
            const int kind = L % 3, slot = L / 3; const int with_ctx = L < DEPTH - 1 ? 1 : 0;
            if (kind == 0) { att::A2Args A{(const bf16_t*)WSP(WS_QKV), (bf16_t*)WSP(WS_H), karg(KA_win_sink) + slot * 16, with_ctx, (const bf16_t*)WSP(WS_P)}; att::att2_phase<0>(F.lds, A, F.vcu, F.G); }
            else if (kind == 1) { const float* TAB = (const float*)WSP(WS_TAB); att::DiffArgs A{(const bf16_t*)WSP(WS_QKV), (bf16_t*)WSP(WS_H), karg(KA_diff_subln_g), TAB[TAB_LAM], TAB[TAB_LAM + 1], with_ctx, (const bf16_t*)WSP(WS_P)}; att::diff_phase3(F.lds, A, F.vcu, F.G); }
            else { att::A2Args A{(const bf16_t*)WSP(WS_QKV), (bf16_t*)WSP(WS_H), karg(KA_na_rpb), with_ctx, (const bf16_t*)WSP(WS_P)}; att::att2_phase<1>(F.lds, A, F.vcu, F.G); }
        }
        SEAM(pb + 1);
        if (IN(pb + 2)) {
            const int kind = L % 3, slot = L / 3; const bool with_ctx = L < DEPTH - 1;
            const bf16_t* Wt = (const bf16_t*)WSP(WS_PW) + (kind == 0 ? PW_WIN_OUT / 2 + (size_t)slot * 1024 * 1024 : kind == 1 ? PW_DIFF_OUT / 2 : PW_NA_OUT / 2);
            pg8::Gemm g{(const char*)WSP(WS_H), (const char*)Wt, OUTPROJ_FP8 ? DM : DM * 2, 1 << 20, 0, nullptr};
            pg8::StaticOrder S; S.init((with_ctx ? MT : MX) / 256, 4, F.G, (int)blockIdx.x);
            pg8::EpiOutProj E{(bf16_t*)WSP(WS_XB), (const float*)WSP(WS_MOD) + (size_t)L * 17 * 6144, OUTPROJ_FP8 ? 1.f / (Y_SCALE * W8_SCALE) : 1.f};
            pg8::gemm_phase<pg8::EpiOutProj, false, true, OUTPROJ_FP8 != 0>(F.lds, g, S, E);
        }
        SEAM(pb + 2);
        if (IN(pb + 3)) for (int rep_ = 0; rep_ < NREP(5, L); ++rep_) { const bool with_ctx = L < DEPTH - 1;
            if (ROUTER_MFMA && rep_ == 0) phase_norm2_router_mfma(F, (const bf16_t*)WSP(WS_XB), karg(KA_norm2_g) + L * DM, (const float*)WSP(WS_MOD) + (size_t)L * 17 * 6144, karg(KA_router_w) + (size_t)L * DM * NE,
                               (unsigned char*)WSP(WS_H), (float*)WSP(WS_AFF), with_ctx ? MT : MX);
            else phase_norm2_router(F, (const bf16_t*)WSP(WS_XB), karg(KA_norm2_g) + L * DM, (const float*)WSP(WS_MOD) + (size_t)L * 17 * 6144, karg(KA_router_w) + (size_t)L * DM * NE,
                               (unsigned char*)WSP(WS_H), (float*)WSP(WS_AFF), with_ctx ? MT : MX, (const bf16_t*)WSP(WS_P), rep_ == 0); }
        SEAM(pb + 3);
        if (IN(pb + 4)) for (int rep_ = 0; rep_ < NREP(6, L); ++rep_) { const bool with_ctx = L < DEPTH - 1; phase_topk(F, (const float*)WSP(WS_AFF), (unsigned*)WSP(WS_ROWSRC), (short*)WSP(WS_SLOT), with_ctx ? NME_FULL : NME_LAST, with_ctx); }
        SEAM(pb + 4);
        if (IN(pb + 5)) for (int rep_ = 0; rep_ < NREP(7, L); ++rep_) {
            const int nMe = (L < DEPTH - 1) ? NME_FULL : NME_LAST;
            pg8::Gemm g{(const char*)WSP(WS_H), (const char*)WSP(WS_MOEW + (size_t)L * 16 * MOEW_E), DM, nMe, MOEW_E, (const unsigned*)WSP(WS_ROWSRC)};
            pg8::StaticOrder S; S.init(16 * nMe, 16, F.G, (int)blockIdx.x);
            if (DUP_PH == 7 && rep_ == 1) { pg8::EpiSwiglu<true> E{(unsigned char*)WSP(WS_QKV), 1.f / (H2_SCALE * W8_SCALE), HID_SCALE};
                pg8::gemm_phase<pg8::EpiSwiglu<true>, true, true, true>(F.lds, g, S, E); }
            else { pg8::EpiSwiglu<false> E{(unsigned char*)WSP(WS_QKV), 1.f / (H2_SCALE * W8_SCALE), HID_SCALE};
                pg8::gemm_phase<pg8::EpiSwiglu<false>, true, true, true>(F.lds, g, S, E); }
        }
        SEAM(pb + 5);
        if (IN(pb + 6)) for (int rep_ = 0; rep_ < NREP(8, L); ++rep_) {
            const int nMe = (L < DEPTH - 1) ? NME_FULL : NME_LAST;
            pg8::Gemm g{(const char*)WSP(WS_QKV), (const char*)WSP(WS_MOEW + (size_t)L * 16 * MOEW_E + (size_t)4096 * 1024), FF, nMe, MOEW_E, nullptr};
            pg8::StaticOrder S; S.init(16 * nMe, 4, F.G, (int)blockIdx.x);
            pg8::EpiBf16 E{(bf16_t*)WSP(WS_YBUF), DM, 1.f / (HID_SCALE * W8_SCALE)};
            pg8::gemm_phase<pg8::EpiBf16, false, true, true, true>(F.lds, g, S, E);
        }
        SEAM(pb + 6);
        if (IN(pb + 7)) for (int rep_ = NREP(9, L) - 1; rep_ >= 0; --rep_) {
            const bool last = (L == DEPTH - 1); const bool with_ctx = !last;
            phase_combine(F, (bf16_t*)WSP(WS_XB), (const bf16_t*)WSP(WS_P), (float*)karg(KA_OUT), (const float*)WSP(WS_MOD) + (size_t)L * 17 * 6144, (const float*)WSP(WS_AFF), (const short*)WSP(WS_SLOT), (const bf16_t*)WSP(WS_YBUF),
                          with_ctx ? NME_FULL : NME_LAST, with_ctx ? MT : MX, last, karg(KA_norm1_g) + (last ? 0 : (L + 1) * DM), (const float*)WSP(WS_MOD) + (size_t)(last ? 0 : L + 1) * 17 * 6144,
                          rep_ ? (bf16_t*)WSP(WS_QKV + 300 * MiB) : (bf16_t*)WSP(WS_H), karg(KA_final_g), rep_ ? (float*)WSP(WS_QKV) : nullptr);
        }
        SEAM(pb + 7);
    }
#undef IN
#undef SEAM
}

extern "C" void kernel_launch(void* const* d_in, const int* in_sizes, int n_in, void* d_out, int out_size, void* d_ws, size_t ws_size, hipStream_t stream) {
    static int grid = 0;
    if (grid == 0) {
        if (n_in != 23 || out_size != MX * DM || ws_size < WS_END) { fprintf(stderr, "kernel_launch: unexpected shapes: n_in %d out %d ws %zu (need %zu)\n", n_in, out_size, ws_size, (size_t)WS_END); grid = -1; return; }
        int dev = 0, cus = 0, per_cu = 0;
        if (hipGetDevice(&dev) != hipSuccess || hipDeviceGetAttribute(&cus, hipDeviceAttributeMultiprocessorCount, dev) != hipSuccess) { grid = -1; return; }
        if (hipFuncSetAttribute((const void*)fwd, hipFuncAttributeMaxDynamicSharedMemorySize, LDS_BYTES) != hipSuccess) { fprintf(stderr, "kernel_launch: hipFuncSetAttribute failed\n"); grid = -1; return; }
        if (hipOccupancyMaxActiveBlocksPerMultiprocessor(&per_cu, (const void*)fwd, NWAVES * 64, LDS_BYTES) != hipSuccess || per_cu < 1) fprintf(stderr, "kernel_launch: occupancy query says %d\n", per_cu);
        (void)hipGetLastError();
        grid = cus;
    }
    if (grid < 0) return;
    (void)hipMemsetAsync((char*)d_ws + WS_CTL, 0, CTL_ZERO_BYTES, stream);
    Args a{};
    const float** ip = (const float**)&a.in;
    for (int i = 0; i < 23; ++i) ip[i] = (const float*)d_in[i];
    a.out = (float*)d_out; a.ws = (unsigned char*)d_ws;
    if (MK_N_LAUNCHES == 1) { a.ph_lo = 0; a.ph_hi = NPHASES; hipLaunchKernelGGL(fwd, dim3(grid), dim3(NWAVES * 64), LDS_BYTES, stream, a); }
    else for (int p = 0; p < NPHASES; ++p) { a.ph_lo = p; a.ph_hi = p + 1; hipLaunchKernelGGL(fwd, dim3(grid), dim3(NWAVES * 64), LDS_BYTES, stream, a); }
}
```

```cpp
#include <hip/hip_runtime.h>
#include <cstdio>
#include <cstdint>

#ifndef MK_N_LAUNCHES
#define MK_N_LAUNCHES 1
#endif

#define GAS __attribute__((address_space(1)))
#define LAS __attribute__((address_space(3)))
typedef unsigned short bf16_t;
typedef short bf16x8 __attribute__((ext_vector_type(8)));
typedef short s16x4 __attribute__((ext_vector_type(4)));
typedef float f32x4 __attribute__((ext_vector_type(4)));
typedef float f32x2 __attribute__((ext_vector_type(2)));
typedef float f32x16 __attribute__((ext_vector_type(16)));
typedef unsigned u32x4 __attribute__((ext_vector_type(4)));
typedef unsigned u32x2 __attribute__((ext_vector_type(2)));
typedef __bf16 bf16x2_t __attribute__((ext_vector_type(2)));
typedef GAS unsigned gu32;

constexpr int DM = 1024, NB = 16, SEQ = 4096, DEPTH = 4, CTXL = 256, NE = 16, FF = 2048;
constexpr int MX = NB * SEQ;
constexpr int MC = NB * CTXL;
constexpr int MT = MX + MC;
constexpr int CAPX = 512, CAPC = 32;
constexpr int NME_FULL = 34, NME_LAST = 32;
constexpr float C2 = 0.125f * 1.4426950408889634f;
constexpr float LOG2E = 1.4426950408889634f;
constexpr float RMS_EPS = 1e-6f;
constexpr float NEG_BIG = -1e30f;
constexpr int NWAVES = 8;
constexpr int NPHASES = 2 + 8 * DEPTH;

constexpr size_t MiB = 1u << 20;
constexpr size_t WS_CTL = 0, CTL_ZERO_BYTES = 64 * 1024;
constexpr size_t WS_MOD = 1 * MiB;
constexpr size_t WS_TAB = 3 * MiB;
constexpr size_t WS_AFF = 4 * MiB;
constexpr size_t WS_SLOT = 9 * MiB;
constexpr size_t WS_ROWSRC = 12 * MiB;
constexpr size_t WS_CTXRES = 13 * MiB;
constexpr size_t WS_PW = 29 * MiB;
constexpr size_t PW_WIN_IN = 0, PW_WIN_OUT = 6 * MiB, PW_DIFF_IN = 10 * MiB, PW_DIFF_OUT = 16 * MiB, PW_NA_IN = 18 * MiB, PW_NA_OUT = 24 * MiB;
constexpr size_t WS_H = 56 * MiB;
constexpr size_t WS_QKV = 192 * MiB;
constexpr size_t WS_YBUF = 736 * MiB;
constexpr size_t WS_MOEW = 1008 * MiB;
constexpr size_t MOEW_E = (size_t)(4096 * 1024 + 1024 * 2048);
#ifndef INPROJ_FP8
#define INPROJ_FP8 1
#endif
#ifndef OUTPROJ_FP8
#define OUTPROJ_FP8 0
#endif
constexpr float Y_SCALE = 8.f;
constexpr float H2_SCALE = 4.f, HID_SCALE = 2.f, W8_SCALE = 32.f;
constexpr size_t WS_XB = 1536 * MiB;
constexpr size_t WS_END = 1672 * MiB;
constexpr size_t WS_P = 1400 * MiB;
constexpr int TAB_COS = 0, TAB_SIN = 1024, TAB_LAM = 2048;

constexpr int RING_BYTES = 131072;
constexpr int MISC_OFF = 135168;
constexpr int LDS_BYTES = 147456;

#define LDS_WAIT() asm volatile("s_waitcnt lgkmcnt(0)" ::: "memory")
#define VM_WAIT() asm volatile("s_waitcnt vmcnt(0)" ::: "memory")

__device__ __forceinline__ unsigned cvtpk(float lo, float hi) { f32x2 v = {lo, hi}; bf16x2_t b = __builtin_convertvector(v, bf16x2_t); return __builtin_bit_cast(unsigned, b); }
__device__ __forceinline__ float bf2f(unsigned short u) { return __builtin_bit_cast(float, (unsigned)u << 16); }
__device__ __forceinline__ float wave_sum(float v) {
#pragma unroll
    for (int o = 1; o < 64; o <<= 1) v += __shfl_xor(v, o);
    return v;
}
template <int CTRL> __device__ __forceinline__ float dppf(float v) { return __builtin_bit_cast(float, __builtin_amdgcn_update_dpp(0, __builtin_bit_cast(int, v), CTRL, 0xF, 0xF, true)); }
__device__ __forceinline__ float row16_sum(float v) { v += dppf<0xB1>(v); v += dppf<0x4E>(v); v += dppf<0x141>(v); v += dppf<0x140>(v); return v; }
__device__ __forceinline__ float row16_max(float v) { v = fmaxf(v, dppf<0xB1>(v)); v = fmaxf(v, dppf<0x4E>(v)); v = fmaxf(v, dppf<0x141>(v)); v = fmaxf(v, dppf<0x140>(v)); return v; }
__device__ __forceinline__ float rdlane(float v, int l) { return __builtin_bit_cast(float, __builtin_amdgcn_readlane(__builtin_bit_cast(int, v), l)); }
__device__ __forceinline__ float wave_sum_fast(float v) { v = row16_sum(v); return (rdlane(v, 0) + rdlane(v, 16)) + (rdlane(v, 32) + rdlane(v, 48)); }
__device__ __forceinline__ float siluf(float v) { return v / (1.f + __expf(-v)); }

#define XB_TMO      128
#define XB_XCNT(j)  (256  + 64 * (j))
#define XB_XSUB(j)  (1280 + 64 * (j))
#define XB_XGEN(j)  (2304 + 64 * (j))
#define XB_TOP      3328
#define XB_TOPGEN   3392
#define XCD_BAR_WORDS 3456
#define XB_SPIN_CAP (1u << 18)
__device__ __forceinline__ unsigned xb_ld(unsigned* p)              { return __hip_atomic_load(p, __ATOMIC_RELAXED, __HIP_MEMORY_SCOPE_AGENT); }
__device__ __forceinline__ unsigned xb_add(unsigned* p, unsigned v) { return __hip_atomic_fetch_add(p, v, __ATOMIC_RELAXED, __HIP_MEMORY_SCOPE_AGENT); }
__device__ __forceinline__ unsigned xb_xcc_id() { return (unsigned)__builtin_amdgcn_s_getreg((3 << 11) | 20) & 0xFu; }
#define XB_SPIN(cond, bar) do { unsigned _sp = 0; while (cond) { __builtin_amdgcn_s_sleep(1); \
    if ((++_sp & 255u) == 0u) { if (xb_ld(&(bar)[XB_TMO])) break; if (_sp > XB_SPIN_CAP) { atomicAdd(&(bar)[XB_TMO], 1u); break; } } } } while (0)
struct XcdBarrier { unsigned* bar; unsigned x; volatile LAS unsigned* st; };
__device__ __forceinline__ XcdBarrier xcd_barrier_post(unsigned* bar, volatile LAS unsigned* st) {
    XcdBarrier b; b.bar = bar; b.x = xb_xcc_id(); b.st = st;
    if (threadIdx.x == 0) (void)xb_add(&bar[XB_XCNT(b.x)], 1u);
    return b;
}
__device__ __forceinline__ void xcd_barrier_complete(unsigned* bar, unsigned x, unsigned& nloc, unsigned& nx) {
    const unsigned G = gridDim.x * gridDim.y * gridDim.z;
    unsigned sum, cnt, mine, sp = 0u;
    for (;;) {
        sum = 0u; cnt = 0u; mine = 0u;
#pragma unroll
        for (unsigned j = 0; j < 16; ++j) { const unsigned c = xb_ld(&bar[XB_XCNT(j)]); sum += c; cnt += (c > 0u) ? 1u : 0u; mine = (j == x) ? c : mine; }
        if (sum == G) break;
        __builtin_amdgcn_s_sleep(1);
        if ((++sp & 255u) == 0u) { if (xb_ld(&bar[XB_TMO])) break; if (sp > XB_SPIN_CAP) { atomicAdd(&bar[XB_TMO], 1u); break; } }
    }
    nloc = mine > 0u ? mine : 1u; nx = cnt > 0u ? cnt : 1u;
}
__device__ __forceinline__ void xcd_barrier(const XcdBarrier& b) {
    asm volatile("s_waitcnt vmcnt(0)" ::: "memory");
    __syncthreads();
    if (threadIdx.x == 0) {
        unsigned* bar = b.bar;
        __builtin_amdgcn_s_waitcnt(0);
        unsigned nloc = b.st[0], nx = b.st[1];
        if (nloc == 0u) { xcd_barrier_complete(bar, b.x, nloc, nx); b.st[0] = nloc; b.st[1] = nx; }
        const unsigned old = xb_add(&bar[XB_XSUB(b.x)], 1u);
        const unsigned gen = old / nloc;
        if (old + 1u == (gen + 1u) * nloc) {
            __builtin_amdgcn_fence(__ATOMIC_RELEASE, "agent");
            asm volatile("s_waitcnt vmcnt(0)" ::: "memory");
            const unsigned og = xb_add(&bar[XB_TOP], 1u);
            const unsigned tg = og / nx;
            if (og + 1u == (tg + 1u) * nx) xb_add(&bar[XB_TOPGEN], 1u);
            else XB_SPIN(xb_ld(&bar[XB_TOPGEN]) == tg, bar);
            __builtin_amdgcn_fence(__ATOMIC_ACQUIRE, "agent");
            xb_add(&bar[XB_XGEN(b.x)], 1u);
            asm volatile("s_waitcnt vmcnt(0)" ::: "memory");
        } else {
            XB_SPIN(xb_ld(&bar[XB_XGEN(b.x)]) == gen, bar);
            __builtin_amdgcn_fence(__ATOMIC_ACQUIRE, "agent");
            asm volatile("s_waitcnt vmcnt(0)" ::: "memory");
        }
    }
    __syncthreads();
}

namespace pg8 {
constexpr int BM = 256, BK = 64, HALF = 128, HTB = HALF * BK * 2, NXCD = 8, WGM = 4;
typedef int v4i __attribute__((ext_vector_type(4)));
typedef int v8i __attribute__((ext_vector_type(8)));
__host__ __device__ __forceinline__ int lds_byte(int r, int c) { const int st = (r >> 4) * 2 + (c >> 5), rr = r & 15, cc = c & 31, ob = rr * 64 + cc * 2; return st * 1024 + (ob ^ (((ob >> 9) & 1) << 5)); }
__host__ __device__ __forceinline__ void stage_rc(int b, int& R, int& C) { const int st = b / 1024, sb = b % 1024, swz = sb ^ (((sb >> 9) & 1) << 5); R = (st >> 1) * 16 + swz / 64; C = (st & 1) * 32 + (swz % 64) / 2; }
__host__ __device__ __forceinline__ int perm32(int rho) { const int n = rho >> 4, i = rho & 15; return 8 * (i >> 2) + 4 * n + (i & 3); }

struct Unit { int pm, pn; };
struct Gemm { const char* A; const char* Bt; int Kb; int nMe; size_t b_estride; const unsigned* rowsrc; };

struct StaticOrder {
    int nM, nN, nwg, G, c;
    __device__ void init(int nM_, int nN_, int G_, int c_) { nM = nM_; nN = nN_; nwg = nM * nN; G = G_; c = c_; }
    __device__ bool next(int i, Unit& u) const {
        const long L = (long)i * G + c; if (L >= nwg) return false;
        int wgid = (int)L; { const int q = nwg / NXCD, r = nwg % NXCD, xcd = wgid % NXCD, off = wgid / NXCD; wgid = (xcd < r ? xcd * (q + 1) : r * (q + 1) + (xcd - r) * q) + off; }
        const int nig = WGM * nN, gid = wgid / nig, fm = gid * WGM, gsz = (nM - fm) < WGM ? (nM - fm) : WGM;
        u.pm = fm + ((wgid % nig) % gsz); u.pn = (wgid % nig) / gsz; return true;
    }
};

template <class Epi, bool GATHER, bool ALIGN_EPI, bool FP8 = false, bool ABLK = false>
__device__ __forceinline__ void gemm_phase(LAS unsigned char* lds, const Gemm g, const StaticOrder& S, const Epi& E) {
    int tid = threadIdx.x; asm volatile("" : "+v"(tid));
    const int wid = __builtin_amdgcn_readfirstlane(tid >> 6), lane = tid & 63, wr = wid >> 2, wc = wid & 3, fr = lane & 15, fq = lane >> 4;
    const int Kb = g.Kb, nt = Kb / (BK * 2);
    int Rr[2], Cc[2]; unsigned voffB[2];
#pragma unroll
    for (int i = 0; i < 2; ++i) { int R, C; stage_rc(tid * 16 + i * 8192, R, C); const int Rb = Epi::PERM ? ((R & ~31) + perm32(R & 31)) : R;
        Rr[i] = R; Cc[i] = C; voffB[i] = (unsigned)(Rb * Kb + C * 2); }
    const size_t kstep = (size_t)(BK * 2);
    const size_t kstepA = ABLK ? (size_t)32768 : kstep;
    const size_t hstep = (size_t)HALF * Kb;
    const size_t tstep = 2 * hstep;
    const unsigned ldsw = (unsigned)wid * 1024u;
    const int aoff = lds_byte(wr * 64 + fr, fq * 8), boff = lds_byte(wc * 32 + fr, fq * 8);
#define PG8_SA(b, h) (((b) * 2 + (h)) * HTB)
#define PG8_SB(b, h) ((4 + (b) * 2 + (h)) * HTB)
#define PG8_STAGE(bufoff, gbase, voff) do { _Pragma("unroll") for (int _i = 0; _i < 2; ++_i) \
        __builtin_amdgcn_global_load_lds((const unsigned*)((const char*)(gbase) + (voff)[_i]), (LAS unsigned*)(lds + (bufoff) + ldsw + _i * 8192), 16, 0, 0); } while (0)
#define PG8_LDA(dst, b, h) do { _Pragma("unroll") for (int m = 0; m < 4; ++m) _Pragma("unroll") for (int k = 0; k < 2; ++k) dst[m][k] = *(const LAS bf16x8*)(lds + PG8_SA(b, h) + aoff + m * 2048 + k * 1024); } while (0)
#define PG8_LDB(dst, b, h) do { _Pragma("unroll") for (int n = 0; n < 2; ++n) _Pragma("unroll") for (int k = 0; k < 2; ++k) dst[n][k] = *(const LAS bf16x8*)(lds + PG8_SB(b, h) + boff + n * 2048 + k * 1024); } while (0)
#define PG8_MMA(ai, bj, At, Bt, Z) do { __builtin_amdgcn_s_setprio(1); \
        if constexpr (FP8) { if (Epi::ZEROC && (Z)) { _Pragma("unroll") for (int m = 0; m < 4; ++m) _Pragma("unroll") for (int n = 0; n < 2; ++n) { \
            const v8i b8_ = __builtin_shufflevector(__builtin_bit_cast(v4i, Bt[n][0]), __builtin_bit_cast(v4i, Bt[n][1]), 0, 1, 2, 3, 4, 5, 6, 7); \
            const v8i a8_ = __builtin_shufflevector(__builtin_bit_cast(v4i, At[m][0]), __builtin_bit_cast(v4i, At[m][1]), 0, 1, 2, 3, 4, 5, 6, 7); \
            asm volatile("v_mfma_f32_16x16x128_f8f6f4 %0, %1, %2, 0" : "+v"(acc[ai][bj][m][n]) : "v"(b8_), "v"(a8_)); } }   \
          else { _Pragma("unroll") for (int m = 0; m < 4; ++m) _Pragma("unroll") for (int n = 0; n < 2; ++n) { \
            const v8i b8_ = __builtin_shufflevector(__builtin_bit_cast(v4i, Bt[n][0]), __builtin_bit_cast(v4i, Bt[n][1]), 0, 1, 2, 3, 4, 5, 6, 7); \
            const v8i a8_ = __builtin_shufflevector(__builtin_bit_cast(v4i, At[m][0]), __builtin_bit_cast(v4i, At[m][1]), 0, 1, 2, 3, 4, 5, 6, 7); \
            asm volatile("v_mfma_f32_16x16x128_f8f6f4 %0, %1, %2, %0" : "+v"(acc[ai][bj][m][n]) : "v"(b8_), "v"(a8_)); } } } \
        else { _Pragma("unroll") for (int m = 0; m < 4; ++m) _Pragma("unroll") for (int n = 0; n < 2; ++n) _Pragma("unroll") for (int k = 0; k < 2; ++k) \
            acc[ai][bj][m][n] = __builtin_amdgcn_mfma_f32_16x16x32_bf16(Bt[n][k], At[m][k], acc[ai][bj][m][n], 0, 0, 0); } \
        __builtin_amdgcn_s_setprio(0); } while (0)
#define PG8_WAIT_V(n) asm volatile("s_waitcnt vmcnt(" #n ")" ::: "memory")
#define PG8_WAIT_L(n) asm volatile("s_waitcnt lgkmcnt(" #n ")" ::: "memory")
#define PG8_BAR __builtin_amdgcn_s_barrier()
#define PG8_SCHED __builtin_amdgcn_sched_barrier(0)
#define PG8_CALC_VG(VG, U) do { _Pragma("unroll") for (int _h = 0; _h < 2; ++_h) _Pragma("unroll") for (int _i = 0; _i < 2; ++_i) { \
        const unsigned _row = (unsigned)((U).pm * BM + _h * HALF + Rr[_i]); const unsigned _src = GATHER ? g.rowsrc[_row] : _row; \
        if constexpr (ABLK) { const unsigned _r = (unsigned)(_h * HALF + Rr[_i]), _c = (unsigned)Cc[_i] >> 3; \
            VG[_h][_i] = (unsigned)(U).pm * (unsigned)(Kb * BM) + (_r >> 4) * 2048u + (_c >> 1) * 512u + (_r & 15u) * 32u + (_c & 1u) * 16u; } \
        else VG[_h][_i] = _src * (unsigned)Kb + (unsigned)Cc[_i] * 2u; } } while (0)
    Unit cur, nxt; int ui = 0;
    if (!S.next(0, cur)) return;
    f32x4 acc[2][2][4][2];
    if constexpr (!(FP8 && Epi::ZEROC)) {
#pragma unroll
    for (int a = 0; a < 2; ++a)
#pragma unroll
        for (int b = 0; b < 2; ++b)
#pragma unroll
            for (int m = 0; m < 4; ++m)
#pragma unroll
                for (int n = 0; n < 2; ++n) acc[a][b][m][n] = (f32x4){0.f, 0.f, 0.f, 0.f};
    }
    bf16x8 At[4][2], B0[2][2], B1[2][2];
    unsigned vg[2][2], vgn[2][2];
    PG8_CALC_VG(vg, cur);
    const char* const gA = g.A;
    const char* cB = g.Bt + (size_t)(cur.pm / g.nMe) * g.b_estride + (size_t)cur.pn * tstep;
    PG8_STAGE(PG8_SB(0, 0), cB, voffB); PG8_STAGE(PG8_SB(0, 1), cB + hstep, voffB); PG8_STAGE(PG8_SA(0, 0), gA, vg[0]); PG8_STAGE(PG8_SA(0, 1), gA, vg[1]);
    if (wr == 1) PG8_BAR;
    PG8_WAIT_V(2); PG8_BAR;
    PG8_STAGE(PG8_SB(1, 0), cB + kstep, voffB); PG8_STAGE(PG8_SA(1, 0), gA + kstepA, vg[0]); PG8_STAGE(PG8_SB(1, 1), cB + hstep + kstep, voffB);
    PG8_WAIT_V(6); PG8_BAR;
    for (;;) {
        const bool has_next = S.next(ui + 1, nxt);
        LAS unsigned char* const rsb = lds + 131072 + ((ui + 1) & 1) * 1024;
        if (has_next) {
            if constexpr (GATHER) { if (wid == 0) __builtin_amdgcn_global_load_lds((const unsigned*)(g.rowsrc + (size_t)nxt.pm * BM) + lane * 4, (LAS unsigned*)rsb, 16, 0, 0); }
            else { PG8_CALC_VG(vgn, nxt); } }
        else {
#pragma unroll
            for (int _h = 0; _h < 2; ++_h)
#pragma unroll
                for (int _i = 0; _i < 2; ++_i) vgn[_h][_i] = vg[_h][_i]; }
        const char* nB = has_next ? g.Bt + (size_t)(nxt.pm / g.nMe) * g.b_estride + (size_t)nxt.pn * tstep : cB;
        for (int t = 0; t < nt; t += 2) {
            const bool last = (t == nt - 2);
            const char* a1 = gA + (size_t)(t + 1) * kstepA;
            const char* a2 = last ? gA : gA + (size_t)(t + 2) * kstepA; const char* b2 = last ? nB : cB + (size_t)(t + 2) * kstep;
            const char* a3 = a2 + kstepA; const char* b3 = b2 + kstep;
            if constexpr (GATHER) { if (last && has_next) {
#pragma unroll
                for (int _h = 0; _h < 2; ++_h)
#pragma unroll
                    for (int _i = 0; _i < 2; ++_i) vgn[_h][_i] = *(const LAS unsigned*)(rsb + (_h * HALF + Rr[_i]) * 4) * (unsigned)Kb + (unsigned)Cc[_i] * 2u; } }
            unsigned w0[2], w1[2];
#pragma unroll
            for (int _i = 0; _i < 2; ++_i) { w0[_i] = last ? vgn[0][_i] : vg[0][_i]; w1[_i] = last ? vgn[1][_i] : vg[1][_i]; }
            PG8_LDB(B0, 0, 0); PG8_LDB(B1, 0, 1); PG8_SCHED; PG8_LDA(At, 0, 0); PG8_STAGE(PG8_SA(1, 1), a1, vg[1]);
            PG8_WAIT_V(8); PG8_WAIT_L(0); PG8_BAR; PG8_MMA(0, 0, At, B0, t == 0); PG8_MMA(0, 1, At, B1, t == 0); PG8_BAR; PG8_SCHED;
            PG8_LDA(At, 0, 1); PG8_STAGE(PG8_SB(0, 0), b2, voffB); PG8_STAGE(PG8_SB(0, 1), b2 + hstep, voffB); PG8_STAGE(PG8_SA(0, 0), a2, w0);
            PG8_WAIT_V(8); PG8_WAIT_L(0); PG8_BAR; PG8_MMA(1, 0, At, B0, t == 0); PG8_MMA(1, 1, At, B1, t == 0); PG8_BAR; PG8_SCHED;
            PG8_LDB(B0, 1, 0); PG8_LDB(B1, 1, 1); PG8_SCHED; PG8_LDA(At, 1, 0); PG8_STAGE(PG8_SA(0, 1), a2, w1);
            PG8_WAIT_V(8); PG8_WAIT_L(0); PG8_BAR; PG8_MMA(0, 0, At, B0, false); PG8_MMA(0, 1, At, B1, false); PG8_BAR; PG8_SCHED;
            PG8_LDA(At, 1, 1); PG8_STAGE(PG8_SB(1, 0), b3, voffB); PG8_STAGE(PG8_SB(1, 1), b3 + hstep, voffB); PG8_STAGE(PG8_SA(1, 0), a3, w0);
            PG8_WAIT_V(8); PG8_WAIT_L(0); PG8_BAR; PG8_MMA(1, 0, At, B0, false); PG8_MMA(1, 1, At, B1, false); PG8_BAR; PG8_SCHED;
        }
        if constexpr (ALIGN_EPI) { if (wr == 0) PG8_BAR; }
        if constexpr (FP8) asm volatile("s_nop 15\n\ts_nop 15" ::: "memory");
        E(acc, cur, wr, wc, fr, fq);
        if (!has_next) break;
        if constexpr (!(FP8 && Epi::ZEROC)) {
#pragma unroll
        for (int a = 0; a < 2; ++a)
#pragma unroll
            for (int b = 0; b < 2; ++b)
#pragma unroll
                for (int m = 0; m < 4; ++m)
#pragma unroll
                    for (int n = 0; n < 2; ++n) acc[a][b][m][n] = (f32x4){0.f, 0.f, 0.f, 0.f};
        }
        cur = nxt; cB = nB; ++ui;
#pragma unroll
        for (int _h = 0; _h < 2; ++_h)
#pragma unroll
            for (int _i = 0; _i < 2; ++_i) vg[_h][_i] = vgn[_h][_i];
        if constexpr (ALIGN_EPI) { if (wr == 1) PG8_BAR; }
    }
    PG8_WAIT_V(0);
    if constexpr (!ALIGN_EPI) { if (wr == 0) PG8_BAR; }
    PG8_BAR;
#undef PG8_SA
#undef PG8_SB
#undef PG8_STAGE
#undef PG8_LDA
#undef PG8_LDB
#undef PG8_MMA
#undef PG8_WAIT_V
#undef PG8_WAIT_L
#undef PG8_BAR
#undef PG8_SCHED
#undef PG8_CALC_VG
}

struct EpiInProj {
    static constexpr bool PERM = false; static constexpr bool ZEROC = false;
    bf16_t* O; int ldc; int q_tiles; int rope_tiles; const float* tab; float osc; int v_tile0; bf16_t* Q;
    __device__ __forceinline__ void operator()(const f32x4 (&acc)[2][2][4][2], const Unit& u, int wr, int wc, int fr, int fq) const {
        const int row0 = u.pm * BM + wr * 64 + fr, col0 = u.pn * BM + wc * 32 + 4 * fq;
        const float sc = ((u.pn < q_tiles) ? C2 : 1.f) * osc;
        const bool rope = (u.pn < rope_tiles) && (u.pm < MX / BM);
        const int axis = wc & 1; const bool isv = u.pn >= v_tile0;
#pragma unroll
        for (int ai = 0; ai < 2; ++ai)
#pragma unroll
            for (int m = 0; m < 4; ++m) {
                const int row = row0 + ai * HALF + m * 16;
                f32x4 cs = {1.f, 1.f, 1.f, 1.f}, sn = {0.f, 0.f, 0.f, 0.f};
                if (rope) { const int t = row & (SEQ - 1); const int pos = axis ? (t & 63) : (t >> 6); cs = *(const f32x4*)(tab + TAB_COS + pos * 16 + 4 * fq); sn = *(const f32x4*)(tab + TAB_SIN + pos * 16 + 4 * fq); }
                bf16_t* rowp = O + (size_t)row * ldc + col0;
                bf16_t* rowq = (u.pn < q_tiles) ? Q + ((size_t)(row >> 5) * 16 + 4 * u.pn + (wc >> 1)) * 2048 + (2 * (wc & 1) + (fq >> 1)) * 512 + (fq & 1) * 256 + (row & 31) * 8
                                                : O + (size_t)row * ldc + u.pn * BM + wc * 32 + 8 * fq;
                const int qstep = (u.pn < q_tiles) ? 2 * 2048 : HALF;
#pragma unroll
                for (int bj = 0; bj < 2; ++bj) {
                    const f32x4 x1 = acc[ai][bj][m][0] * sc, x2 = acc[ai][bj][m][1] * sc;
                    const f32x4 o1 = x1 * cs - x2 * sn, o2 = x2 * cs + x1 * sn;
                    u32x2 w1, w2; w1.x = cvtpk(o1[0], o1[1]); w1.y = cvtpk(o1[2], o1[3]); w2.x = cvtpk(o2[0], o2[1]); w2.y = cvtpk(o2[2], o2[3]);
                    if (isv) { *(u32x2*)(rowp + bj * HALF) = w1; *(u32x2*)(rowp + bj * HALF + 16) = w2; }
                    else *(u32x4*)(rowq + bj * qstep) = (u32x4){w1.x, w1.y, w2.x, w2.y}; }
            }
    }
};
struct EpiOutProj {
    static constexpr bool PERM = true; static constexpr bool ZEROC = false;
    bf16_t* P; const float* mod; float osc;
    __device__ __forceinline__ void operator()(const f32x4 (&acc)[2][2][4][2], const Unit& u, int wr, int wc, int fr, int fq) const {
        const int b = (u.pm < MX / BM) ? ((u.pm * BM) >> 12) : 16;
        const int row0 = u.pm * BM + wr * 64 + fr, col0 = u.pn * BM + wc * 32 + 8 * fq;
        const float* gp = mod + (size_t)b * 6144 + 2 * DM + col0;
        f32x4 gv[2][2];
#pragma unroll
        for (int bj = 0; bj < 2; ++bj)
#pragma unroll
            for (int n = 0; n < 2; ++n) gv[bj][n] = *(const f32x4*)(gp + bj * HALF + 4 * n) * osc;
#pragma unroll
        for (int ai = 0; ai < 2; ++ai)
#pragma unroll
            for (int m = 0; m < 4; ++m) { bf16_t* rowp = P + (size_t)(row0 + ai * HALF + m * 16) * DM + col0;
                u32x4 xr[2]; xr[0] = *(const u32x4*)rowp; xr[1] = *(const u32x4*)(rowp + HALF);
#pragma unroll
                for (int bj = 0; bj < 2; ++bj) { const f32x4 v0 = acc[ai][bj][m][0] * gv[bj][0], v1 = acc[ai][bj][m][1] * gv[bj][1]; const u32x4 x = xr[bj];
                    u32x4 w; w.x = cvtpk(v0[0] + __builtin_bit_cast(float, x.x << 16), v0[1] + __builtin_bit_cast(float, x.x & 0xffff0000u));
                    w.y = cvtpk(v0[2] + __builtin_bit_cast(float, x.y << 16), v0[3] + __builtin_bit_cast(float, x.y & 0xffff0000u));
                    w.z = cvtpk(v1[0] + __builtin_bit_cast(float, x.z << 16), v1[1] + __builtin_bit_cast(float, x.z & 0xffff0000u));
                    w.w = cvtpk(v1[2] + __builtin_bit_cast(float, x.w << 16), v1[3] + __builtin_bit_cast(float, x.w & 0xffff0000u));
                    *(u32x4*)(rowp + bj * HALF) = w; } }
    }
};
template <bool NOSTORE = false> struct EpiSwiglu {
    static constexpr bool PERM = true; static constexpr bool ZEROC = true;
    unsigned char* O; float in_scale; float out_scale;
    __device__ __forceinline__ void operator()(const f32x4 (&acc)[2][2][4][2], const Unit& u, int wr, int wc, int fr, int fq) const {
        const int row0 = u.pm * BM + wr * 64 + fr, col0 = u.pn * HALF + wc * 32 + 8 * fq;
#pragma unroll
        for (int ai = 0; ai < 2; ++ai)
#pragma unroll
            for (int m = 0; m < 4; ++m) { unsigned char* rowp = O + ((size_t)u.pm * 16 + u.pn) * 32768 + (8 * ai + 4 * wr + m) * 2048 + wc * 512 + fr * 32 + fq * 8;
                float h[8];
                const float c1 = -LOG2E * in_scale, c2 = in_scale * in_scale * out_scale;
#pragma unroll
                for (int n = 0; n < 2; ++n)
#pragma unroll
                    for (int j = 0; j < 4; j += 2) { const f32x2 ag = {acc[ai][0][m][n][j], acc[ai][0][m][n][j + 1]}, au = {acc[ai][1][m][n][j], acc[ai][1][m][n][j + 1]};
                        const f32x2 ea = ag * c1; f32x2 t; t.x = __builtin_amdgcn_exp2f(ea.x); t.y = __builtin_amdgcn_exp2f(ea.y);
                        const f32x2 d = t + 1.0f; f32x2 r; r.x = __builtin_amdgcn_rcpf(d.x); r.y = __builtin_amdgcn_rcpf(d.y);
                        const f32x2 hv = ((ag * au) * c2) * r; h[n * 4 + j] = hv.x; h[n * 4 + j + 1] = hv.y; }
                int w0 = 0, w1 = 0;
                w0 = __builtin_amdgcn_cvt_pk_fp8_f32(h[0], h[1], w0, false); w0 = __builtin_amdgcn_cvt_pk_fp8_f32(h[2], h[3], w0, true);
                w1 = __builtin_amdgcn_cvt_pk_fp8_f32(h[4], h[5], w1, false); w1 = __builtin_amdgcn_cvt_pk_fp8_f32(h[6], h[7], w1, true);
                if (NOSTORE) asm volatile("" :: "v"(w0), "v"(w1)); else *(u32x2*)rowp = (u32x2){(unsigned)w0, (unsigned)w1}; }
    }
};
struct EpiBf16 {
    static constexpr bool PERM = true; static constexpr bool ZEROC = true;
    bf16_t* O; int ldc; float sc;
    __device__ __forceinline__ void operator()(const f32x4 (&acc)[2][2][4][2], const Unit& u, int wr, int wc, int fr, int fq) const {
        const int row0 = u.pm * BM + wr * 64 + fr, col0 = u.pn * BM + wc * 32 + 8 * fq;
#pragma unroll
        for (int ai = 0; ai < 2; ++ai)
#pragma unroll
            for (int m = 0; m < 4; ++m) { bf16_t* rowp = O + (size_t)(row0 + ai * HALF + m * 16) * ldc + col0;
#pragma unroll
                for (int bj = 0; bj < 2; ++bj) { const f32x4 v0 = acc[ai][bj][m][0] * sc, v1 = acc[ai][bj][m][1] * sc;
                    u32x4 w; w.x = cvtpk(v0[0], v0[1]); w.y = cvtpk(v0[2], v0[3]); w.z = cvtpk(v1[0], v1[1]); w.w = cvtpk(v1[2], v1[3]);
                    *(u32x4*)(rowp + bj * HALF) = w; } }
    }
};
}

namespace att {
#define SBAR() __builtin_amdgcn_sched_barrier(0)
__device__ __forceinline__ int crow(int r, int hi) { return (r & 3) + 8 * (r >> 2) + 4 * hi; }
__device__ __forceinline__ void glds16(const void* gsrc, unsigned lds_dst) { unsigned keep;
    asm volatile("s_mov_b32 %0, m0\n\ts_mov_b32 m0, %2\n\ts_nop 0\n\tglobal_load_lds_dwordx4 %1, off\n\ts_mov_b32 m0, %0" : "=&s"(keep) : "v"(gsrc), "s"(lds_dst) : "memory"); }
#define WAIT_BAR0() asm volatile("s_waitcnt vmcnt(0) lgkmcnt(0)\n\ts_barrier" ::: "memory")
typedef LAS const char* lds_cptr;
typedef short v4i16_t __attribute__((ext_vector_type(4)));
__device__ __forceinline__ s16x4 vtr(lds_cptr p) { return __builtin_bit_cast(s16x4, __builtin_amdgcn_ds_read_tr16_b64_v4i16((LAS v4i16_t*)p)); }
__device__ __forceinline__ float hmax(float m) { auto rr = __builtin_amdgcn_permlane32_swap(__float_as_uint(m), __float_as_uint(m), false, false); return fmaxf(__uint_as_float(rr[0]), __uint_as_float(rr[1])); }
__device__ __forceinline__ float hsum(float m) { auto rr = __builtin_amdgcn_permlane32_swap(__float_as_uint(m), __float_as_uint(m), false, false); return __uint_as_float(rr[0]) + __uint_as_float(rr[1]); }

__device__ __forceinline__ void qkt(f32x16& p0, f32x16& p1, lds_cptr kb, const bf16x8 (&qr)[4]) {
    p0 = f32x16{}; p1 = f32x16{};
#pragma unroll
    for (int d0 = 0; d0 < 4; ++d0) {
        const bf16x8 b0 = *(const LAS bf16x8*)(kb + d0 * 2048), b1 = *(const LAS bf16x8*)(kb + d0 * 2048 + 512);
        p0 = __builtin_amdgcn_mfma_f32_32x32x16_bf16(b0, qr[d0], p0, 0, 0, 0);
        p1 = __builtin_amdgcn_mfma_f32_32x32x16_bf16(b1, qr[d0], p1, 0, 0, 0); }
}
template <int ND>
__device__ __forceinline__ void softmax_pv(f32x16& p0, f32x16& p1, f32x16 (&oT)[ND], float& m, float& l, lds_cptr vp) {
    float rm = p0[0];
#pragma unroll
    for (int r = 1; r < 16; ++r) rm = fmaxf(rm, p0[r]);
#pragma unroll
    for (int r = 0; r < 16; ++r) rm = fmaxf(rm, p1[r]);
    rm = hmax(rm);
    const float mn = fmaxf(m, rm);
    const float alpha = __builtin_amdgcn_exp2f(m - mn);
    m = mn;
    float s = 0.f;
#pragma unroll
    for (int r = 0; r < 16; ++r) { p0[r] = __builtin_amdgcn_exp2f(p0[r] - mn); p1[r] = __builtin_amdgcn_exp2f(p1[r] - mn); s += p0[r] + p1[r]; }
    l = l * alpha + s;
#pragma unroll
    for (int d = 0; d < ND; ++d) oT[d] = oT[d] * alpha;
    u32x4 pw[4];
#pragma unroll
    for (int k = 0; k < 2; ++k) {
        pw[k]     = (u32x4){cvtpk(p0[8 * k], p0[8 * k + 1]), cvtpk(p0[8 * k + 2], p0[8 * k + 3]), cvtpk(p0[8 * k + 4], p0[8 * k + 5]), cvtpk(p0[8 * k + 6], p0[8 * k + 7])};
        pw[2 + k] = (u32x4){cvtpk(p1[8 * k], p1[8 * k + 1]), cvtpk(p1[8 * k + 2], p1[8 * k + 3]), cvtpk(p1[8 * k + 4], p1[8 * k + 5]), cvtpk(p1[8 * k + 6], p1[8 * k + 7])}; }
#pragma unroll
    for (int d = 0; d < ND; ++d)
#pragma unroll
        for (int ks = 0; ks < 4; ++ks) {
            const s16x4 lo = vtr(vp + d * 4096 + ks * 1024), hi = vtr(vp + d * 4096 + ks * 1024 + 512);
            const bf16x8 vf = (bf16x8){lo[0], lo[1], lo[2], lo[3], hi[0], hi[1], hi[2], hi[3]};
            oT[d] = __builtin_amdgcn_mfma_f32_32x32x16_bf16(vf, __builtin_bit_cast(bf16x8, pw[ks]), oT[d], 0, 0, 0); }
}
template <int ND>
__device__ __forceinline__ void stg_flush(const LAS unsigned char* stg, bf16_t* ybase, int lane) {
    constexpr int RB = ND * 64 + 16, CPR = ND * 4;
#pragma unroll
    for (int i = 0; i < 32 * CPR / 64; ++i) { const int idx = i * 64 + lane, row = idx / CPR, ch = idx % CPR;
        const u32x4 v = *(const LAS u32x4*)(stg + row * RB + ch * 16); *(u32x4*)(ybase + (size_t)row * DM + ch * 8) = v; }
}
template <int ND>
__device__ __forceinline__ void store_oT(const f32x16 (&oT)[ND], float scale, bf16_t* ybase, size_t elem_off, int hi) {
    if (OUTPROJ_FP8) { unsigned char* orow = (unsigned char*)ybase + elem_off; const float sc8 = scale * Y_SCALE;
#pragma unroll
        for (int d = 0; d < ND; ++d)
#pragma unroll
            for (int g = 0; g < 4; ++g) { int t = 0; t = __builtin_amdgcn_cvt_pk_fp8_f32(oT[d][4 * g] * sc8, oT[d][4 * g + 1] * sc8, t, false); t = __builtin_amdgcn_cvt_pk_fp8_f32(oT[d][4 * g + 2] * sc8, oT[d][4 * g + 3] * sc8, t, true);
                *(unsigned*)(orow + d * 32 + 8 * g + 4 * hi) = (unsigned)t; } }
    else { bf16_t* orow = ybase + elem_off;
#pragma unroll
        for (int d = 0; d < ND; ++d)
#pragma unroll
            for (int g = 0; g < 4; ++g) { u32x2 w; w.x = cvtpk(oT[d][4 * g] * scale, oT[d][4 * g + 1] * scale); w.y = cvtpk(oT[d][4 * g + 2] * scale, oT[d][4 * g + 3] * scale);
                *(u32x2*)(orow + d * 32 + 8 * g + 4 * hi) = w; } }
}
constexpr int NA_BIAS_OFF = 65536;
struct DiffArgs { const bf16_t* qkv; bf16_t* y; const float* subln_g; float lam; float omli; int with_ctx; const bf16_t* q; };

#define DF_THR 8.0f
#define DF_BAR()   asm volatile("s_waitcnt lgkmcnt(0)\n\ts_barrier" ::: "memory")
#define DF_BARV()  asm volatile("s_waitcnt vmcnt(0) lgkmcnt(0)\n\ts_barrier" ::: "memory")
__device__ __forceinline__ void diff_phase2(LAS unsigned char* lds, const DiffArgs A, int vcu, int G) {
    int tid = threadIdx.x; asm volatile("" : "+v"(tid));
    const int lane = tid & 63, r32 = lane & 31, hi = lane >> 5; const int wid = __builtin_amdgcn_readfirstlane(tid >> 6);
    constexpr int P = 3072;
    const unsigned lds0 = (unsigned)(uintptr_t)lds;
    const lds_cptr l3 = (lds_cptr)lds;
    const int mp = wid >> 2, qsub = wid & 3;
    LAS float* xch = (LAS float*)lds + qsub * 4096 + lane;
    const int nmain = NB * 8 * 32, nunits = nmain + (A.with_ctx ? NB * 8 * 2 : 0);
    for (int u = vcu; u < nunits; u += G) {
        int b, h, qrow0, NT; const bool ctxu = u >= nmain;
        if (!ctxu) { const int qb = u & 31; h = (u >> 5) & 7; b = u >> 8; qrow0 = b * SEQ + 128 * qb + 32 * qsub; NT = 4 + 64; }
        else { const int v = u - nmain; const int qb = v & 1; h = (v >> 1) & 7; b = v >> 4; qrow0 = MX + b * CTXL + 128 * qb + 32 * qsub; NT = 4; }
        const bf16_t* Kc = A.qkv + (size_t)(MX + b * CTXL) * P + 1024 + 128 * h;
        const bf16_t* Kx = A.qkv + (size_t)(b * SEQ) * P + 1024 + 128 * h;
        const int krow = 8 * wid + (lane >> 3); const size_t koff = (size_t)krow * P + (((lane & 7) ^ ((krow >> 1) & 7)) * 8);
        const int pv0 = 2 * wid, pv1 = 2 * wid + 1;
        const int vra = 4 * pv0 + (lane >> 4), vrb = 4 * pv1 + (lane >> 4); const int vph = lane & 15;
        const size_t voffa = (size_t)vra * P + 1024 + ((((vph >> 2) ^ (vra & 3)) << 2) | (vph & 3)) * 8;
        const size_t voffb = (size_t)vrb * P + 1024 + ((((vph >> 2) ^ (vrb & 3)) << 2) | (vph & 3)) * 8;
#define DF_DMA(t) do { if ((t) < NT) { const int slot_ = (t) % 3; const bf16_t* base_ = ((t) < 4) ? Kc + (size_t)(t) * 64 * P : Kx + (size_t)((t) - 4) * 64 * P; \
        glds16(base_ + koff,      (unsigned)__builtin_amdgcn_readfirstlane(lds0 + slot_ * 32768 + wid * 1024)); \
        glds16(base_ + koff + 64, (unsigned)__builtin_amdgcn_readfirstlane(lds0 + slot_ * 32768 + 8192 + wid * 1024)); \
        glds16(base_ + voffa,     (unsigned)__builtin_amdgcn_readfirstlane(lds0 + slot_ * 32768 + 16384 + pv0 * 1024)); \
        glds16(base_ + voffb,     (unsigned)__builtin_amdgcn_readfirstlane(lds0 + slot_ * 32768 + 16384 + pv1 * 1024)); } } while (0)
        DF_DMA(0);
        bf16x8 qr[4];
        { const bf16_t* Qw = A.qkv + (size_t)(qrow0 + r32) * P + h * 128 + mp * 64;
#pragma unroll
          for (int d0 = 0; d0 < 4; ++d0) qr[d0] = *(const bf16x8*)(Qw + d0 * 16 + hi * 8); }
        f32x16 oT[4]; oT[0] = f32x16{}; oT[1] = f32x16{}; oT[2] = f32x16{}; oT[3] = f32x16{};
        float m = 0.f, l = 0.f;
        f32x16 p0, p1; u32x4 pw[4];
        const int ksw = (r32 >> 1) & 7; const lds_cptr kp0 = l3 + mp * 8192 + r32 * 128 + ((hi ^ (ksw & 1)) << 4); const int ks2 = ksw >> 1;
        const int vq = (lane & 15) >> 2; const lds_cptr vp0 = l3 + 16384 + (4 * hi + vq) * 256 + ((lane >> 4) & 1) * 32 + (lane & 3) * 8;
#define DF_LOADV(dst, vp_, d) do { const lds_cptr vd_ = (vp_) + (((d) ^ vq) << 6); _Pragma("unroll") for (int ks = 0; ks < 4; ++ks) { const s16x4 lo_ = vtr(vd_ + ks * 4096), hi_ = vtr(vd_ + ks * 4096 + 2048); \
            dst[ks] = (bf16x8){lo_[0], lo_[1], lo_[2], lo_[3], hi_[0], hi_[1], hi_[2], hi_[3]}; } } while (0)
#define DF_PV4(src, d) do { _Pragma("unroll") for (int ks = 0; ks < 4; ++ks) oT[d] = __builtin_amdgcn_mfma_f32_32x32x16_bf16(src[ks], __builtin_bit_cast(bf16x8, pw[ks]), oT[d], 0, 0, 0); } while (0)
#define DF_LOADK(dst, kb_, dd) do { dst[0] = *(const LAS bf16x8*)((kb_) + ((((dd)) ^ ks2) << 5)); dst[1] = *(const LAS bf16x8*)((kb_) + ((((dd)) ^ ks2) << 5) + 4096); \
            dst[2] = *(const LAS bf16x8*)((kb_) + ((((dd) + 1) ^ ks2) << 5)); dst[3] = *(const LAS bf16x8*)((kb_) + ((((dd) + 1) ^ ks2) << 5) + 4096); } while (0)
#define DF_QK4(src, dd) do { p0 = __builtin_amdgcn_mfma_f32_32x32x16_bf16(src[0], qr[dd], p0, 0, 0, 0); p1 = __builtin_amdgcn_mfma_f32_32x32x16_bf16(src[1], qr[dd], p1, 0, 0, 0); \
            p0 = __builtin_amdgcn_mfma_f32_32x32x16_bf16(src[2], qr[(dd) + 1], p0, 0, 0, 0); p1 = __builtin_amdgcn_mfma_f32_32x32x16_bf16(src[3], qr[(dd) + 1], p1, 0, 0, 0); } while (0)
#define DF_PREV(vso) do { const lds_cptr vq_ = vp0 + (vso); DF_LOADV(fa, vq_, 0); DF_LOADV(fb, vq_, 1); SBAR(); } while (0)
#define DF_PINIT() do { _Pragma("unroll") for (int r = 0; r < 16; ++r) { p0[r] = -m; p1[r] = -m; } } while (0)
#define DF_SEGM(DO_PV, DO_QK, vso, kso) do { const lds_cptr vp_ = vp0 + (vso); const lds_cptr kb_ = kp0 + (kso); SBAR(); __builtin_amdgcn_s_setprio(1); \
        if (DO_PV) { DF_PV4(fa, 0); SBAR(); DF_LOADV(fa, vp_, 2); SBAR(); \
            DF_PV4(fb, 1); SBAR(); DF_LOADV(fb, vp_, 3); if (DO_QK) { DF_PINIT(); } SBAR(); \
            DF_PV4(fa, 2); SBAR(); if (DO_QK) { DF_LOADK(fa, kb_, 0); } SBAR(); \
            DF_PV4(fb, 3); SBAR(); if (DO_QK) { DF_LOADK(fb, kb_, 2); } SBAR(); } \
        else if (DO_QK) { DF_LOADK(fa, kb_, 0); DF_LOADK(fb, kb_, 2); DF_PINIT(); SBAR(); } \
        if (DO_QK) { DF_QK4(fa, 0); SBAR(); DF_QK4(fb, 2); SBAR(); } \
        __builtin_amdgcn_s_setprio(0); } while (0)
#define DF_SEGV(t) do { \
        float rm = p0[0]; \
        _Pragma("unroll") for (int r = 1; r < 16; ++r) rm = fmaxf(rm, p0[r]); \
        _Pragma("unroll") for (int r = 0; r < 16; ++r) rm = fmaxf(rm, p1[r]); \
        rm = hmax(rm); \
        if ((t) == 0 || __any(rm > DF_THR)) { const float dl = ((t) == 0) ? rm : fmaxf(rm, 0.f); m += dl; \
            _Pragma("unroll") for (int r = 0; r < 16; ++r) { p0[r] -= dl; p1[r] -= dl; } \
            const float f = __builtin_amdgcn_exp2f(-dl); l *= f; \
            _Pragma("unroll") for (int d = 0; d < 4; ++d) oT[d] = oT[d] * f; } \
        float s_ = 0.f; \
        _Pragma("unroll") for (int r = 0; r < 16; ++r) { p0[r] = __builtin_amdgcn_exp2f(p0[r]); p1[r] = __builtin_amdgcn_exp2f(p1[r]); s_ += p0[r] + p1[r]; } \
        l += s_; \
        _Pragma("unroll") for (int k = 0; k < 2; ++k) { \
            pw[k]     = (u32x4){cvtpk(p0[8 * k], p0[8 * k + 1]), cvtpk(p0[8 * k + 2], p0[8 * k + 3]), cvtpk(p0[8 * k + 4], p0[8 * k + 5]), cvtpk(p0[8 * k + 6], p0[8 * k + 7])}; \
            pw[2 + k] = (u32x4){cvtpk(p1[8 * k], p1[8 * k + 1]), cvtpk(p1[8 * k + 2], p1[8 * k + 3]), cvtpk(p1[8 * k + 4], p1[8 * k + 5]), cvtpk(p1[8 * k + 6], p1[8 * k + 7])}; } \
        } while (0)
        DF_BARV();
        int so_p = 0, so_c = 0;
#define DF_ROT() do { so_p = so_c; so_c = (so_c == 65536) ? 0 : so_c + 32768; } while (0)
        bf16x8 fa[4], fb[4];
        if (mp == 0) {
            DF_DMA(1); DF_SEGM(false, true, 0, so_c); SBAR(); DF_PREV(so_c); DF_SEGV(0); SBAR(); DF_BARV(); SBAR();
            for (int t = 1; t < NT; ++t) { DF_ROT();
                DF_DMA(t + 1); DF_SEGM(true, true, so_p, so_c); SBAR(); DF_PREV(so_c); DF_SEGV(t); SBAR(); DF_BARV(); SBAR(); }
            DF_ROT();
            DF_SEGM(true, false, so_p, 0); SBAR(); DF_BARV(); SBAR();
        } else {
            DF_DMA(1); DF_SEGM(false, true, 0, so_c); SBAR(); DF_BARV(); SBAR();
            for (int t = 1; t < NT; ++t) { DF_ROT();
                DF_DMA(t + 1); DF_PREV(so_p); DF_SEGV(t - 1); SBAR(); DF_SEGM(true, true, so_p, so_c); SBAR(); DF_BARV(); SBAR(); }
            DF_ROT();
            DF_PREV(so_p); DF_SEGV(NT - 1); SBAR(); DF_SEGM(true, false, so_p, 0); SBAR(); DF_BARV(); SBAR();
        }
#undef DF_ROT
        l = hsum(l);
        const float il = 1.f / l;
        if (mp == 1) { const float sc = il * A.lam;
#pragma unroll
            for (int d = 0; d < 4; ++d)
#pragma unroll
                for (int q = 0; q < 16; ++q) xch[(d * 16 + q) * 64] = oT[d][q] * sc; }
        DF_BARV();
        if (mp == 0) {
            float ss = 0.f;
#pragma unroll
            for (int d = 0; d < 4; ++d)
#pragma unroll
                for (int q = 0; q < 16; ++q) { const float v = oT[d][q] * il - xch[(d * 16 + q) * 64]; oT[d][q] = v; ss += v * v; }
            ss = hsum(ss);
            const float rstd = rsqrtf(ss * (1.f / 128.f) + RMS_EPS) * A.omli;
            const size_t eo = (size_t)(qrow0 + r32) * DM + h * 128;
#pragma unroll
            for (int d = 0; d < 4; ++d)
#pragma unroll
                for (int g = 0; g < 4; ++g) { const f32x4 gg = *(const f32x4*)(A.subln_g + d * 32 + 8 * g + 4 * hi);
                    if (OUTPROJ_FP8) { const float r8 = rstd * Y_SCALE; int t = 0; t = __builtin_amdgcn_cvt_pk_fp8_f32(oT[d][4 * g] * r8 * gg[0], oT[d][4 * g + 1] * r8 * gg[1], t, false);
                        t = __builtin_amdgcn_cvt_pk_fp8_f32(oT[d][4 * g + 2] * r8 * gg[2], oT[d][4 * g + 3] * r8 * gg[3], t, true);
                        *(unsigned*)((unsigned char*)A.y + eo + d * 32 + 8 * g + 4 * hi) = (unsigned)t; }
                    else { u32x2 w; w.x = cvtpk(oT[d][4 * g] * rstd * gg[0], oT[d][4 * g + 1] * rstd * gg[1]); w.y = cvtpk(oT[d][4 * g + 2] * rstd * gg[2], oT[d][4 * g + 3] * rstd * gg[3]);
                        *(u32x2*)(A.y + eo + d * 32 + 8 * g + 4 * hi) = w; } }
        }
        DF_BAR();
#undef DF_DMA
#undef DF_SEGM
#undef DF_SEGV
#undef DF_PINIT
#undef DF_PREV
#undef DF_LOADV
#undef DF_PV4
#undef DF_LOADK
#undef DF_QK4
    }
}

#define D3_PIN(x) asm volatile("" : "+v"(x))
#define D3_EX(v) __builtin_amdgcn_exp2f(v)
__device__ __forceinline__ void diff_phase3(LAS unsigned char* lds, const DiffArgs A, int vcu, int G) {
    int tid = threadIdx.x; asm volatile("" : "+v"(tid));
    const int lane = tid & 63, r32 = lane & 31, hi = lane >> 5; const int wid = __builtin_amdgcn_readfirstlane(tid >> 6);
    constexpr int P = 3072;
    const unsigned lds0 = (unsigned)(uintptr_t)lds;
    const lds_cptr l3 = (lds_cptr)lds;
    const int mp = wid >> 2, qsub = wid & 3;
    const int nmain = NB * 8 * 32, nunits = nmain + (A.with_ctx ? NB * 8 * 2 : 0);
    for (int u = vcu; u < nunits; u += G) {
        int b, h, qrow0, NT; const bool ctxu = u >= nmain;
        if (!ctxu) { const int qb = u & 31; h = (u >> 5) & 7; b = u >> 8; qrow0 = b * SEQ + 128 * qb + 32 * qsub; NT = 4 + 64; }
        else { const int v = u - nmain; const int qb = v & 1; h = (v >> 1) & 7; b = v >> 4; qrow0 = MX + b * CTXL + 128 * qb + 32 * qsub; NT = 4; }
        const bf16_t* Kc = A.qkv + (size_t)(MX + b * CTXL) * P + 1024 + 128 * h;
        const bf16_t* Kx = A.qkv + (size_t)(b * SEQ) * P + 1024 + 128 * h;
        const int kra = 16 * qsub + (lane >> 3), krb = kra + 8; const int vr0 = 16 * qsub + (lane >> 4); const int vph = lane & 15;
        const unsigned d0 = mp ? (unsigned)vr0 * P + 1024 + ((((vph >> 2) ^ (vr0 & 3)) << 2) | (vph & 3)) * 8 : (unsigned)kra * P + (((lane & 7) ^ ((kra >> 1) & 7)) * 8);
        const unsigned d1 = mp ? d0 + 4 * P : (unsigned)krb * P + (((lane & 7) ^ ((krb >> 1) & 7)) * 8);
        const unsigned inc2 = mp ? 8 * P : 64;
        const unsigned e0 = lds0 + (mp ? 32768 + qsub * 4096 : qsub * 2048), e2 = e0 + (mp ? 2048 : 8192);
#define D3_DMA(t) do { const int t_ = (t); if (t_ < NT) { const bf16_t* base_ = (t_ < 4) ? Kc + (size_t)t_ * 64 * P : Kx + (size_t)(t_ - 4) * 64 * P; \
        const unsigned so_ = (mp ? (t_ & 3) : (t_ & 1)) * 16384; \
        glds16(base_ + d0,        (unsigned)__builtin_amdgcn_readfirstlane(e0 + so_)); \
        glds16(base_ + d1,        (unsigned)__builtin_amdgcn_readfirstlane(e0 + so_ + 1024)); \
        glds16(base_ + d0 + inc2, (unsigned)__builtin_amdgcn_readfirstlane(e2 + so_)); \
        glds16(base_ + d1 + inc2, (unsigned)__builtin_amdgcn_readfirstlane(e2 + so_ + 1024)); } } while (0)
#define D3_WAITBAR(T) do { if (mp == 0 || (T) + 1 >= NT) DF_BARV(); else asm volatile("s_waitcnt vmcnt(4) lgkmcnt(0)\n\ts_barrier" ::: "memory"); } while (0)
        D3_DMA(0);
        bf16x8 qr[4];
        { const bf16_t* Qw = A.q + ((size_t)(qrow0 >> 5) * 16 + 2 * h + mp) * 2048 + hi * 256 + r32 * 8;
#pragma unroll
          for (int d0 = 0; d0 < 4; ++d0) qr[d0] = *(const bf16x8*)(Qw + d0 * 512); }
        f32x16 oT[4]; oT[0] = f32x16{}; oT[1] = f32x16{}; oT[2] = f32x16{}; oT[3] = f32x16{};
        f32x16 negm;
        float m = 0.f, l = 0.f, rf = 1.f; bool resc = false;
        f32x16 pA0, pA1, pB0, pB1; u32x4 pw0, pw1, pw2, pw3;
        const int ksw = (r32 >> 1) & 7; const lds_cptr kp0 = l3 + mp * 8192 + r32 * 128 + ((hi ^ (ksw & 1)) << 4); const int ks2 = ksw >> 1;
        const int vq = (lane & 15) >> 2; const lds_cptr vp0 = l3 + 32768 + (4 * hi + vq) * 256 + ((lane >> 4) & 1) * 32 + (lane & 3) * 8;
#define D3_KF(kb_, g) (*(const LAS bf16x8*)((kb_) + (((((g) >> 1)) ^ ks2) << 5) + ((g) & 1) * 4096))
#define D3_VF(vp_, g) ({ const lds_cptr vd_ = (vp_) + (((((g) >> 2)) ^ vq) << 6) + ((g) & 3) * 4096; const s16x4 lo_ = vtr(vd_), hi_ = vtr(vd_ + 2048); (bf16x8){lo_[0], lo_[1], lo_[2], lo_[3], hi_[0], hi_[1], hi_[2], hi_[3]}; })
#define D3_PK(P, B) cvtpk(P[B], P[(B) + 1])
#define D3_KSEL(g) (((g) & 1) ? kf1 : kf0)
#define D3_GA(g, C0, C1, Q0, Q1, HASQK, HASVA, FIRST) do { \
        if (HASQK) { \
            if ((g) == 0) { if (FIRST) C0 = __builtin_amdgcn_mfma_f32_32x32x16_bf16(D3_KSEL(g), qr[0], f32x16{}, 0, 0, 0); else C0 = __builtin_amdgcn_mfma_f32_32x32x16_bf16(D3_KSEL(g), qr[0], negm, 0, 0, 0); } \
            else if ((g) == 1) { if (FIRST) C1 = __builtin_amdgcn_mfma_f32_32x32x16_bf16(D3_KSEL(g), qr[0], f32x16{}, 0, 0, 0); else C1 = __builtin_amdgcn_mfma_f32_32x32x16_bf16(D3_KSEL(g), qr[0], negm, 0, 0, 0); } \
            else if ((g) & 1) C1 = __builtin_amdgcn_mfma_f32_32x32x16_bf16(D3_KSEL(g), qr[(g) >> 1], C1, 0, 0, 0); else C0 = __builtin_amdgcn_mfma_f32_32x32x16_bf16(D3_KSEL(g), qr[(g) >> 1], C0, 0, 0, 0); \
            if ((g) + 2 < 8) { if ((g) & 1) kf1 = D3_KF(kb_, (g) + 2); else kf0 = D3_KF(kb_, (g) + 2); } } \
        if (HASVA) { if ((g) == 6) vf0 = D3_VF(vp_, 0); if ((g) == 7) vf1 = D3_VF(vp_, 1); } \
        if (HASVA) { if ((g) < 5) { Q1[5 + 2 * (g)] = D3_EX(Q1[5 + 2 * (g)]); Q1[6 + 2 * (g)] = D3_EX(Q1[6 + 2 * (g)]); } if ((g) == 5) { Q1[15] = D3_EX(Q1[15]); } \
            if ((g) == 0) { pw0[0] = D3_PK(Q0, 0); pw0[1] = D3_PK(Q0, 2); } if ((g) == 1) { pw0[2] = D3_PK(Q0, 4); pw0[3] = D3_PK(Q0, 6); D3_PIN(pw0); } \
            if ((g) == 2) { pw1[0] = D3_PK(Q0, 8); pw1[1] = D3_PK(Q0, 10); } if ((g) == 3) { pw1[2] = D3_PK(Q0, 12); pw1[3] = D3_PK(Q0, 14); D3_PIN(pw1); } \
            if ((g) == 4) { pw2[0] = D3_PK(Q1, 0); pw2[1] = D3_PK(Q1, 2); } if ((g) == 5) { pw2[2] = D3_PK(Q1, 4); pw2[3] = D3_PK(Q1, 6); D3_PIN(pw2); } \
            if ((g) == 6) { pw3[0] = D3_PK(Q1, 8); pw3[1] = D3_PK(Q1, 10); } if ((g) == 7) { pw3[2] = D3_PK(Q1, 12); pw3[3] = D3_PK(Q1, 14); D3_PIN(pw3); } \
            } \
        SBAR(); } while (0)
#define D3_PWSEL(g) (((g) & 3) == 0 ? pw0 : ((g) & 3) == 1 ? pw1 : ((g) & 3) == 2 ? pw2 : pw3)
#define D3_EXI(C0, C1, e) do { if ((e) < 16) C0[(e) & 15] = D3_EX(C0[(e) & 15]); else C1[(e) & 15] = D3_EX(C1[(e) & 15]); } while (0)
#define D3_GB(g, C0, C1, Q0, Q1, HASPV, HASVB, FIRST) do { \
        if (HASPV) { \
            oT[(g) >> 2] = __builtin_amdgcn_mfma_f32_32x32x16_bf16(((g) & 1) ? vf1 : vf0, __builtin_bit_cast(bf16x8, D3_PWSEL(g)), oT[(g) >> 2], 0, 0, 0); \
            if ((g) + 2 < 16) { if ((g) & 1) vf1 = D3_VF(vp_, (g) + 2); else vf0 = D3_VF(vp_, (g) + 2); } } \
        if (HASPV) { if ((g) < 4) { sacc += Q0[4 * ((g) & 3)]; sacc += Q0[4 * ((g) & 3) + 1]; sacc += Q0[4 * ((g) & 3) + 2]; sacc += Q0[4 * ((g) & 3) + 3]; D3_PIN(sacc); } \
            else if ((g) < 8) { sacc += Q1[4 * ((g) & 3)]; sacc += Q1[4 * ((g) & 3) + 1]; sacc += Q1[4 * ((g) & 3) + 2]; sacc += Q1[4 * ((g) & 3) + 3]; D3_PIN(sacc); } \
            else if ((g) == 8) { l += sacc; } } \
        if (HASVB) { if ((g) < 4) { rmx = fmaxf(fmaxf(rmx, C0[4 * ((g) & 3)]), C0[4 * ((g) & 3) + 1]); rmx = fmaxf(fmaxf(rmx, C0[4 * ((g) & 3) + 2]), C0[4 * ((g) & 3) + 3]); D3_PIN(rmx); } \
            else if ((g) < 8) { rmx = fmaxf(fmaxf(rmx, C1[4 * ((g) & 3)]), C1[4 * ((g) & 3) + 1]); rmx = fmaxf(fmaxf(rmx, C1[4 * ((g) & 3) + 2]), C1[4 * ((g) & 3) + 3]); D3_PIN(rmx); } \
            else if ((g) == 8) { rmx = hmax(rmx); resc = false; \
                if (FIRST || __any(rmx > DF_THR)) { const float dl = FIRST ? rmx : fmaxf(rmx, 0.f); m += dl; \
                    _Pragma("unroll") for (int r_ = 0; r_ < 16; ++r_) { C0[r_] -= dl; C1[r_] -= dl; negm[r_] = -m; } D3_PIN(negm); \
                    rf = D3_EX(-dl); l *= rf; resc = true; } } \
            else { const int e0_ = 3 * ((g) - 9);   \
                D3_EXI(C0, C1, e0_); D3_EXI(C0, C1, e0_ + 1); D3_EXI(C0, C1, e0_ + 2); if (e0_ + 2 < 16) D3_PIN(C0); else D3_PIN(C1); } } \
        SBAR(); } while (0)
#define D3_STEP(C0, C1, Q0, Q1, HASQK, HASPREV, FIRST, T) do { \
        const lds_cptr kb_ = kp0 + ((T) & 1) * 16384; const lds_cptr vp_ = vp0 + (((T) - 1) & 3) * 16384; bf16x8 kf0, kf1, vf0, vf1; float sacc = 0.f, rmx = -3.0e38f; \
        if (HASQK) D3_DMA((T) + 1); \
        SBAR(); if (HASQK) { kf0 = D3_KF(kb_, 0); kf1 = D3_KF(kb_, 1); } \
        D3_GA(0, C0, C1, Q0, Q1, HASQK, HASPREV, FIRST); D3_GA(1, C0, C1, Q0, Q1, HASQK, HASPREV, FIRST); D3_GA(2, C0, C1, Q0, Q1, HASQK, HASPREV, FIRST); D3_GA(3, C0, C1, Q0, Q1, HASQK, HASPREV, FIRST); \
        D3_GA(4, C0, C1, Q0, Q1, HASQK, HASPREV, FIRST); D3_GA(5, C0, C1, Q0, Q1, HASQK, HASPREV, FIRST); D3_GA(6, C0, C1, Q0, Q1, HASQK, HASPREV, FIRST); D3_GA(7, C0, C1, Q0, Q1, HASQK, HASPREV, FIRST); \
        if (HASQK) { if (mp == 1) D3_WAITBAR(T); } \
        D3_GB(0, C0, C1, Q0, Q1, HASPREV, HASQK, FIRST); D3_GB(1, C0, C1, Q0, Q1, HASPREV, HASQK, FIRST); D3_GB(2, C0, C1, Q0, Q1, HASPREV, HASQK, FIRST); D3_GB(3, C0, C1, Q0, Q1, HASPREV, HASQK, FIRST); \
        D3_GB(4, C0, C1, Q0, Q1, HASPREV, HASQK, FIRST); D3_GB(5, C0, C1, Q0, Q1, HASPREV, HASQK, FIRST); D3_GB(6, C0, C1, Q0, Q1, HASPREV, HASQK, FIRST); D3_GB(7, C0, C1, Q0, Q1, HASPREV, HASQK, FIRST); \
        D3_GB(8, C0, C1, Q0, Q1, HASPREV, HASQK, FIRST); D3_GB(9, C0, C1, Q0, Q1, HASPREV, HASQK, FIRST); D3_GB(10, C0, C1, Q0, Q1, HASPREV, HASQK, FIRST); D3_GB(11, C0, C1, Q0, Q1, HASPREV, HASQK, FIRST); \
        D3_GB(12, C0, C1, Q0, Q1, HASPREV, HASQK, FIRST); D3_GB(13, C0, C1, Q0, Q1, HASPREV, HASQK, FIRST); D3_GB(14, C0, C1, Q0, Q1, HASPREV, HASQK, FIRST); D3_GB(15, C0, C1, Q0, Q1, HASPREV, HASQK, FIRST); \
        if (HASQK && resc) { _Pragma("unroll") for (int d_ = 0; d_ < 4; ++d_) oT[d_] = oT[d_] * rf; } \
        if (HASQK) { if (mp == 0) D3_WAITBAR(T); } \
        } while (0)
        DF_BARV();
        D3_STEP(pA0, pA1, pB0, pB1, true, false, true, 0);
        int t = 1;
        for (; t + 1 < NT; t += 2) {
            D3_STEP(pB0, pB1, pA0, pA1, true, true, false, t);
            D3_STEP(pA0, pA1, pB0, pB1, true, true, false, t + 1);
        }
        D3_STEP(pB0, pB1, pA0, pA1, true, true, false, t);
        D3_STEP(pA0, pA1, pB0, pB1, false, true, false, NT);
        l = hsum(l);
        const float il = 1.f / l;
        DF_BAR();
        LAS float* xch = (LAS float*)lds + qsub * 4096 + lane;
        if (mp == 1) { const float sc = il * A.lam;
#pragma unroll
            for (int d = 0; d < 4; ++d)
#pragma unroll
                for (int q = 0; q < 16; ++q) xch[(d * 16 + q) * 64] = oT[d][q] * sc; }
        DF_BAR();
        if (mp == 0) {
            float ss = 0.f;
#pragma unroll
            for (int d = 0; d < 4; ++d)
#pragma unroll
                for (int q = 0; q < 16; ++q) { const float v = oT[d][q] * il - xch[(d * 16 + q) * 64]; oT[d][q] = v; ss += v * v; }
            ss = hsum(ss);
            const float rstd = rsqrtf(ss * (1.f / 128.f) + RMS_EPS) * A.omli;
            LAS unsigned char* stg = lds + qsub * 16384;
#pragma unroll
            for (int d = 0; d < 4; ++d)
#pragma unroll
                for (int g = 0; g < 4; ++g) { const f32x4 gg = *(const f32x4*)(A.subln_g + d * 32 + 8 * g + 4 * hi);
                    u32x2 w; w.x = cvtpk(oT[d][4 * g] * rstd * gg[0], oT[d][4 * g + 1] * rstd * gg[1]); w.y = cvtpk(oT[d][4 * g + 2] * rstd * gg[2], oT[d][4 * g + 3] * rstd * gg[3]);
                    *(LAS u32x2*)(stg + r32 * 272 + (d * 32 + 8 * g + 4 * hi) * 2) = w; }
            stg_flush<4>(stg, A.y + (size_t)qrow0 * DM + h * 128, lane);
        }
        DF_BAR();
#undef D3_DMA
#undef D3_KF
#undef D3_KSEL
#undef D3_VF
#undef D3_PK
#undef D3_GA
#undef D3_GB
#undef D3_EXI
#undef D3_PWSEL
#undef D3_STEP
#undef D3_WAITBAR
    }
}

struct A2Args { const bf16_t* qkv; bf16_t* y; const float* aux; int with_ctx; const bf16_t* q; };
template <int MODE  >
__device__ __forceinline__ void att2_phase(LAS unsigned char* lds, const A2Args A, int vcu, int G) {
    int tid = threadIdx.x; asm volatile("" : "+v"(tid));
    const int lane = tid & 63, r32 = lane & 31, hi = lane >> 5; const int wid = __builtin_amdgcn_readfirstlane(tid >> 6);
    constexpr int P = MODE == 0 ? 1536 : 3072; constexpr int VOFF = MODE == 0 ? 256 : 1024;
    const unsigned lds0 = (unsigned)(uintptr_t)lds;
    const lds_cptr l3 = (lds_cptr)lds;
    const int grp = wid >> 2;
    LAS float* btab = (LAS float*)(lds + NA_BIAS_OFF + 1024);
    const int nmain = MODE == 0 ? NB * 4 * 32 * 2 : NB * 16 * 16;
    const int nunits = nmain + (A.with_ctx ? (MODE == 0 ? NB * 4 * 4 : NB * 16) : 0);
    for (int u = vcu; u < nunits; u += G) {
        int b, hk, hq, qrow0, nwin, k0win; const bool ctxu = u >= nmain; int qs = 0, r = 0, c = 0;
        if (MODE == 0) {
            if (!ctxu) { const int hp = u & 1, j = (u >> 1) & 31; hk = (u >> 6) & 3; b = u >> 8; hq = 4 * hk + 2 * hp + (wid >> 2); qs = 128 * j + 32 * (wid & 3); qrow0 = b * SEQ + qs;
                const int ks = max(0, 128 * (j - 1)), ke = min(SEQ, 128 * (j + 2)); k0win = ks; nwin = (ke - ks) / 64; }
            else { const int v = u - nmain; hk = (v >> 2) & 3; hq = 4 * hk + (v & 3); b = v >> 4; qrow0 = MX + b * CTXL + 32 * wid; nwin = 0; k0win = 0; }
        } else {
            if (!ctxu) { const int uu = u & 15; hk = hq = (u >> 4) & 15; b = u >> 8; r = 4 * uu + (wid >> 1); c = 32 * (wid & 1) + r32; qrow0 = b * SEQ + r * 64 + 32 * (wid & 1);
                const int rs_lo = min(max(4 * uu - 4, 0), 56), rs_hi = min(max(4 * uu + 3 - 4, 0), 56); k0win = rs_lo * 64; nwin = rs_hi + 8 - rs_lo; }
            else { const int v = u - nmain; hk = hq = v & 15; b = v >> 4; qrow0 = MX + b * CTXL + 32 * wid; nwin = 0; k0win = 0; }
        }
        const int NT = 4 + nwin;
        const bf16_t* Kc = A.qkv + (size_t)(MX + b * CTXL) * P + 1024 + 64 * hk;
        const bf16_t* Kx = A.qkv + (size_t)(b * SEQ + k0win) * P + 1024 + 64 * hk;
        const int krow = 8 * wid + (lane >> 3); const size_t koff = (size_t)krow * P + (((lane & 7) ^ ((krow >> 1) & 7)) * 8), voff = (size_t)krow * P + VOFF + (((lane & 7) ^ (((krow >> 1) & 1) << 2)) * 8);
#define A2_DMA(t) do { if ((t) < NT) { const int slot_ = (t) % 3; const bf16_t* base_ = ((t) < 4) ? Kc + (size_t)(t) * 64 * P : Kx + (size_t)((t) - 4) * 64 * P; \
        glds16(base_ + koff, (unsigned)__builtin_amdgcn_readfirstlane(lds0 + slot_ * 16384 + wid * 1024)); \
        glds16(base_ + voff, (unsigned)__builtin_amdgcn_readfirstlane(lds0 + slot_ * 16384 + 8192 + wid * 1024)); } } while (0)
        A2_DMA(0);
        if (MODE == 1) { if (!ctxu && tid < 15 * 31) btab[tid] = A.aux[hq * 465 + tid] * LOG2E; }
        bf16x8 qr[4];
        { const bf16_t* Qw = A.q + ((size_t)(qrow0 >> 5) * 16 + hq) * 2048 + hi * 256 + r32 * 8;
#pragma unroll
          for (int d0 = 0; d0 < 4; ++d0) qr[d0] = *(const bf16x8*)(Qw + d0 * 512); }
        f32x16 oT[2]; oT[0] = f32x16{}; oT[1] = f32x16{};
        float m = 0.f, l = 0.f;
        f32x16 p0, p1; u32x4 pw[4];
        const int ksw = (r32 >> 1) & 7; const lds_cptr kp0 = l3 + r32 * 128 + ((hi ^ (ksw & 1)) << 4); const int ks2 = ksw >> 1;
        const int vq = (lane & 15) >> 2, vsq = (vq >> 1) & 1; const lds_cptr vp0 = l3 + 8192 + (4 * hi + vq) * 128 + ((lane >> 4) & 1) * 32 + (lane & 3) * 8;
        const int rs = min(max(r - 4, 0), 56), cs = min(max(c - 8, 0), 48);
#define A2_LOADV(dst, vp_, d) do { const lds_cptr vd_ = (vp_) + (((d) ^ vsq) << 6); _Pragma("unroll") for (int ks = 0; ks < 4; ++ks) { const s16x4 lo_ = vtr(vd_ + ks * 2048), hi_ = vtr(vd_ + ks * 2048 + 1024); \
            dst[ks] = (bf16x8){lo_[0], lo_[1], lo_[2], lo_[3], hi_[0], hi_[1], hi_[2], hi_[3]}; } } while (0)
#define A2_PV4(src, d) do { _Pragma("unroll") for (int ks = 0; ks < 4; ++ks) oT[d] = __builtin_amdgcn_mfma_f32_32x32x16_bf16(src[ks], __builtin_bit_cast(bf16x8, pw[ks]), oT[d], 0, 0, 0); } while (0)
#define A2_LOADK(dst, kb_, dd) do { dst[0] = *(const LAS bf16x8*)((kb_) + ((((dd)) ^ ks2) << 5)); dst[1] = *(const LAS bf16x8*)((kb_) + ((((dd)) ^ ks2) << 5) + 4096); \
            dst[2] = *(const LAS bf16x8*)((kb_) + ((((dd) + 1) ^ ks2) << 5)); dst[3] = *(const LAS bf16x8*)((kb_) + ((((dd) + 1) ^ ks2) << 5) + 4096); } while (0)
#define A2_QK4(src, dd) do { p0 = __builtin_amdgcn_mfma_f32_32x32x16_bf16(src[0], qr[dd], p0, 0, 0, 0); p1 = __builtin_amdgcn_mfma_f32_32x32x16_bf16(src[1], qr[dd], p1, 0, 0, 0); \
            p0 = __builtin_amdgcn_mfma_f32_32x32x16_bf16(src[2], qr[(dd) + 1], p0, 0, 0, 0); p1 = __builtin_amdgcn_mfma_f32_32x32x16_bf16(src[3], qr[(dd) + 1], p1, 0, 0, 0); } while (0)
#define A2_PREV(vso) do { const lds_cptr vq_ = vp0 + (vso); A2_LOADV(fa, vq_, 0); A2_LOADV(fb, vq_, 1); SBAR(); } while (0)
#define A2_PINIT() do { _Pragma("unroll") for (int q_ = 0; q_ < 16; ++q_) { p0[q_] = -m; p1[q_] = -m; } } while (0)
#define A2_SEGM(DO_PV, DO_QK, vso, kso) do { const lds_cptr kb_ = kp0 + (kso); SBAR(); __builtin_amdgcn_s_setprio(1); \
        if (DO_PV) { A2_PV4(fa, 0); if (DO_QK) { A2_PINIT(); } SBAR(); if (DO_QK) { A2_LOADK(fa, kb_, 0); } SBAR(); A2_PV4(fb, 1); SBAR(); if (DO_QK) { A2_LOADK(fb, kb_, 2); } SBAR(); } \
        else if (DO_QK) { A2_LOADK(fa, kb_, 0); A2_LOADK(fb, kb_, 2); A2_PINIT(); SBAR(); } \
        if (DO_QK) { A2_QK4(fa, 0); SBAR(); A2_QK4(fb, 2); SBAR(); } \
        __builtin_amdgcn_s_setprio(0); } while (0)
#define A2_SEGV(t) do { \
        if ((t) >= 4) { \
            if (MODE == 0) { const int kb0_ = k0win + 64 * ((t) - 4); if ((kb0_ + 63 > qs + 128) || (kb0_ < qs + 31 - 128)) { const int dq_ = kb0_ + 4 * hi - (qs + r32) + 128; \
                _Pragma("unroll") for (int q_ = 0; q_ < 16; ++q_) { const int kk_ = (q_ & 3) + 8 * (q_ >> 2); if ((unsigned)(dq_ + kk_) > 256u) p0[q_] = NEG_BIG; if ((unsigned)(dq_ + kk_ + 32) > 256u) p1[q_] = NEG_BIG; } } } \
            else { const int kr_ = (k0win >> 6) + (t) - 4; const bool rowok_ = (kr_ >= rs) && (kr_ < rs + 8); const int rel_ = rowok_ ? 4 * hi - cs : 1000; const LAS float* bp_ = btab + (rowok_ ? kr_ - r + 7 : 0) * 31 + 4 * hi - c + 15; \
                _Pragma("unroll") for (int q_ = 0; q_ < 16; ++q_) { const int kk_ = (q_ & 3) + 8 * (q_ >> 2); const float b0_ = bp_[kk_], b1_ = bp_[kk_ + 32]; \
                    p0[q_] = ((unsigned)(rel_ + kk_) < 16u) ? p0[q_] + b0_ : NEG_BIG; p1[q_] = ((unsigned)(rel_ + kk_ + 32) < 16u) ? p1[q_] + b1_ : NEG_BIG; } } } \
        float rm = p0[0]; \
        _Pragma("unroll") for (int q_ = 1; q_ < 16; ++q_) rm = fmaxf(rm, p0[q_]); \
        _Pragma("unroll") for (int q_ = 0; q_ < 16; ++q_) rm = fmaxf(rm, p1[q_]); \
        rm = hmax(rm); \
        if ((t) == 0 || __any(rm > DF_THR)) { const float dl = ((t) == 0) ? rm : fmaxf(rm, 0.f); m += dl; \
            _Pragma("unroll") for (int q_ = 0; q_ < 16; ++q_) { p0[q_] -= dl; p1[q_] -= dl; } \
            const float f = __builtin_amdgcn_exp2f(-dl); l *= f; oT[0] = oT[0] * f; oT[1] = oT[1] * f; } \
        float s_ = 0.f; \
        _Pragma("unroll") for (int q_ = 0; q_ < 16; ++q_) { p0[q_] = __builtin_amdgcn_exp2f(p0[q_]); p1[q_] = __builtin_amdgcn_exp2f(p1[q_]); s_ += p0[q_] + p1[q_]; } \
        l += s_; \
        _Pragma("unroll") for (int k = 0; k < 2; ++k) { \
            pw[k]     = (u32x4){cvtpk(p0[8 * k], p0[8 * k + 1]), cvtpk(p0[8 * k + 2], p0[8 * k + 3]), cvtpk(p0[8 * k + 4], p0[8 * k + 5]), cvtpk(p0[8 * k + 6], p0[8 * k + 7])}; \
            pw[2 + k] = (u32x4){cvtpk(p1[8 * k], p1[8 * k + 1]), cvtpk(p1[8 * k + 2], p1[8 * k + 3]), cvtpk(p1[8 * k + 4], p1[8 * k + 5]), cvtpk(p1[8 * k + 6], p1[8 * k + 7])}; } \
        } while (0)
        DF_BARV();
        int so_p = 0, so_c = 0;
#define A2_ROT() do { so_p = so_c; so_c = (so_c == 32768) ? 0 : so_c + 16384; } while (0)
        bf16x8 fa[4], fb[4];
        if (grp == 0) {
            A2_DMA(1); A2_SEGM(false, true, 0, so_c); SBAR(); A2_PREV(so_c); A2_SEGV(0); SBAR(); DF_BARV(); SBAR();
            for (int t = 1; t < NT; ++t) { A2_ROT();
                A2_DMA(t + 1); A2_SEGM(true, true, so_p, so_c); SBAR(); A2_PREV(so_c); A2_SEGV(t); SBAR(); DF_BARV(); SBAR(); }
            A2_ROT();
            A2_SEGM(true, false, so_p, 0); SBAR(); DF_BARV(); SBAR();
        } else {
            A2_DMA(1); A2_SEGM(false, true, 0, so_c); SBAR(); DF_BARV(); SBAR();
            for (int t = 1; t < NT; ++t) { A2_ROT();
                A2_DMA(t + 1); A2_PREV(so_p); A2_SEGV(t - 1); SBAR(); A2_SEGM(true, true, so_p, so_c); SBAR(); DF_BARV(); SBAR(); }
            A2_ROT();
            A2_PREV(so_p); A2_SEGV(NT - 1); SBAR(); A2_SEGM(true, false, so_p, 0); SBAR(); DF_BARV(); SBAR();
        }
        l = hsum(l);
        if (MODE == 0) l += __builtin_amdgcn_exp2f(A.aux[hq] * LOG2E - m);
        if (OUTPROJ_FP8) store_oT<2>(oT, 1.f / l, A.y, (size_t)(qrow0 + r32) * DM + hq * 64, hi);
        else { LAS unsigned char* stg = lds + wid * 8192; const float sc_ = 1.f / l;
#pragma unroll
            for (int d = 0; d < 2; ++d)
#pragma unroll
                for (int g = 0; g < 4; ++g) { u32x2 w; w.x = cvtpk(oT[d][4 * g] * sc_, oT[d][4 * g + 1] * sc_); w.y = cvtpk(oT[d][4 * g + 2] * sc_, oT[d][4 * g + 3] * sc_);
                    *(LAS u32x2*)(stg + r32 * 144 + (d * 32 + 8 * g + 4 * hi) * 2) = w; }
            stg_flush<2>(stg, A.y + (size_t)qrow0 * DM + hq * 64, lane); }
        DF_BAR();
#undef A2_DMA
#undef A2_LOADV
#undef A2_PV4
#undef A2_LOADK
#undef A2_QK4
#undef A2_SEGM
#undef A2_SEGV
#undef A2_PREV
#undef A2_PINIT
#undef A2_ROT
    }
}
#undef SBAR
}

struct Frame {
    LAS unsigned char* lds; volatile LAS unsigned* MISC; unsigned* ctl;
    int tid, lane, wave, vcu, G;
};

__device__ __forceinline__ void transpose_item(const float* W, int K, int N, bf16_t* WT, int k0, int n0, int drow0, LAS float* scr, int lane) {
    f32x4 v[16];
    const float* src = W + (size_t)(k0 + (lane >> 4)) * N + n0 + 4 * (lane & 15);
#pragma unroll
    for (int i = 0; i < 16; ++i) v[i] = *(const f32x4*)(src + (size_t)(4 * i) * N);
#pragma unroll
    for (int i = 0; i < 16; ++i) { LAS float* d = scr + (4 * i + (lane >> 4)) * 65 + 4 * (lane & 15); d[0] = v[i].x; d[1] = v[i].y; d[2] = v[i].z; d[3] = v[i].w; }
    LDS_WAIT(); asm volatile("" ::: "memory");
    const int c = lane & 7;
#pragma unroll
    for (int j = 0; j < 8; ++j) { const int n = (lane >> 3) + 8 * j; const LAS float* s = scr + (8 * c) * 65 + n;
        u32x4 o; o.x = cvtpk(s[0 * 65], s[1 * 65]); o.y = cvtpk(s[2 * 65], s[3 * 65]); o.z = cvtpk(s[4 * 65], s[5 * 65]); o.w = cvtpk(s[6 * 65], s[7 * 65]);
        *(u32x4*)(WT + (size_t)(drow0 + n) * K + k0 + 8 * c) = o; }
    LDS_WAIT(); asm volatile("" ::: "memory");
}

enum { KA_x, KA_c, KA_ctx, KA_c_ctx, KA_ada_w, KA_ada_b, KA_norm1_g, KA_norm2_g, KA_final_g, KA_win_w_in, KA_win_w_out, KA_win_sink, KA_diff_w_in, KA_diff_w_out, KA_diff_lambda, KA_diff_subln_g,
       KA_na_w_in, KA_na_w_out, KA_na_rpb, KA_router_w, KA_w_gate, KA_w_up, KA_w_down, KA_OUT, KA_WS };
__device__ __forceinline__ const float* karg(int i) { asm volatile("" : "+s"(i)); return (const float*)(((const unsigned long long __attribute__((address_space(4)))*)__builtin_amdgcn_kernarg_segment_ptr())[i]); }
__device__ __forceinline__ void t8_load(f32x4 (&v)[16], const float* W, int N, int k0, int n0, int lane) {
    const float* src = W + (size_t)(k0 + (lane >> 4)) * N + n0 + 4 * (lane & 15);
#pragma unroll
    for (int i = 0; i < 16; ++i) v[i] = *(const f32x4*)(src + (size_t)(4 * i) * N);
}
__device__ __forceinline__ void t8_finish(const f32x4 (&v)[16], int Kb, unsigned char* WT, int k0, int drow0, LAS float* scr, int lane) {
#pragma unroll
    for (int i = 0; i < 16; ++i) { LAS float* d = scr + (4 * i + (lane >> 4)) * 65 + 4 * (lane & 15); d[0] = v[i].x * W8_SCALE; d[1] = v[i].y * W8_SCALE; d[2] = v[i].z * W8_SCALE; d[3] = v[i].w * W8_SCALE; }
    LDS_WAIT(); asm volatile("" ::: "memory");
    const int c = lane & 3;
#pragma unroll
    for (int j = 0; j < 4; ++j) { const int n = (lane >> 2) + 16 * j; const LAS float* s = scr + (16 * c) * 65 + n;
        int w[4];
#pragma unroll
        for (int q = 0; q < 4; ++q) { int t = 0; t = __builtin_amdgcn_cvt_pk_fp8_f32(s[(4 * q) * 65], s[(4 * q + 1) * 65], t, false); t = __builtin_amdgcn_cvt_pk_fp8_f32(s[(4 * q + 2) * 65], s[(4 * q + 3) * 65], t, true); w[q] = t; }
        *(u32x4*)(WT + (size_t)(drow0 + n) * Kb + k0 + 16 * c) = (u32x4){(unsigned)w[0], (unsigned)w[1], (unsigned)w[2], (unsigned)w[3]}; }
    LDS_WAIT(); asm volatile("" ::: "memory");
}
__device__ __forceinline__ void transpose_item8(const float* W, int Kb, int N, unsigned char* WT, int k0, int n0, int drow0, LAS float* scr, int lane) {
    f32x4 v[16]; t8_load(v, W, N, k0, n0, lane); t8_finish(v, Kb, WT, k0, drow0, scr, lane);
}

struct In {
    const float *x, *c, *ctx, *c_ctx, *ada_w, *ada_b, *norm1_g, *norm2_g, *final_g, *win_w_in, *win_w_out, *win_sink, *diff_w_in, *diff_w_out, *diff_lambda, *diff_subln_g,
        *na_w_in, *na_w_out, *na_rpb, *router_w, *w_gate, *w_up, *w_down;
};

__device__ __forceinline__ void phase_prologue(Frame& F, unsigned char* ws) {
    int tid_ = threadIdx.x; asm volatile("" : "+v"(tid_)); const int lane_ = tid_ & 63; const int wave_ = __builtin_amdgcn_readfirstlane(tid_ >> 6);
    LAS float* scr = (LAS float*)(F.lds + wave_ * 16640);
    const int gw = F.vcu * NWAVES + wave_, NGW = F.G * NWAVES;
    if (F.vcu == 0) {
        float* tab = (float*)(ws + WS_TAB);
        for (int i = tid_; i < 1024; i += 512) { const int pos = i >> 4, f = i & 15; const float inv = 1.0f / powf(10000.0f, (float)(2 * f) / 32.0f); const float ang = (float)pos * inv;
            tab[TAB_COS + i] = cosf(ang); tab[TAB_SIN + i] = sinf(ang); }
        if (wave_ == 0) { const float* lp = karg(KA_diff_lambda); const float a = wave_sum(lp[lane_] * lp[64 + lane_]), b2 = wave_sum(lp[128 + lane_] * lp[192 + lane_]);
            const float li = 0.8f - 0.6f * expf(-0.3f * 1.0f); if (lane_ == 0) { tab[TAB_LAM] = expf(a) - expf(b2) + li; tab[TAB_LAM + 1] = 1.0f - li; } }
    }
    {
        bf16_t* pw = (bf16_t*)(ws + WS_PW);
        constexpr int IT_WI = 16 * 24, IT_O = 16 * 16, IT_3 = 16 * 48;
        constexpr int NIT = 2 * IT_WI + 2 * IT_O + IT_3 + IT_O + IT_3 + IT_O;
        for (int it = gw; it < NIT; it += NGW) {
            int r = it; const float* W; bf16_t* WT; int N;
            if (r < 2 * IT_WI) { const int s = r / IT_WI; r -= s * IT_WI; W = karg(KA_win_w_in) + (size_t)s * 1024 * 1536; WT = pw + (PW_WIN_IN / 2) + (size_t)s * 1536 * 1024; N = 1536; }
            else if ((r -= 2 * IT_WI) < 2 * IT_O) { const int s = r / IT_O; r -= s * IT_O; W = karg(KA_win_w_out) + (size_t)s * 1024 * 1024; WT = pw + (PW_WIN_OUT / 2) + (size_t)s * 1024 * 1024; N = 1024; }
            else if ((r -= 2 * IT_O) < IT_3) { W = karg(KA_diff_w_in); WT = pw + PW_DIFF_IN / 2; N = 3072; }
            else if ((r -= IT_3) < IT_O) { W = karg(KA_diff_w_out); WT = pw + PW_DIFF_OUT / 2; N = 1024; }
            else if ((r -= IT_O) < IT_3) { W = karg(KA_na_w_in); WT = pw + PW_NA_IN / 2; N = 3072; }
            else { r -= IT_3; W = karg(KA_na_w_out); WT = pw + PW_NA_OUT / 2; N = 1024; }
            const int nblk = N / 64, kb = r / nblk, nb = r % nblk;
            if ((INPROJ_FP8 && N != 1024) || (OUTPROJ_FP8 && N == 1024)) transpose_item8(W, 1024, N, (unsigned char*)WT, 64 * kb, 64 * nb, 64 * nb, scr, lane_);
            else transpose_item(W, 1024, N, WT, 64 * kb, 64 * nb, 64 * nb, scr, lane_);
        }
    }
    {
        const int NIT = 64 * 1536;
#define MW_DESC(it_, W_, N_, Kb_, WT_, k0_, n0_, dr_) do { const int le_ = (it_) / 1536; int r_ = (it_) % 1536; \
            unsigned char* W1t_ = ws + WS_MOEW + (size_t)le_ * MOEW_E; \
            if (r_ < 1024) { const bool up_ = r_ >= 512; r_ &= 511; W_ = (up_ ? karg(KA_w_up) : karg(KA_w_gate)) + (size_t)le_ * 1024 * 2048; N_ = 2048; Kb_ = 1024; WT_ = W1t_; \
                k0_ = 64 * (r_ / 32); n0_ = 64 * (r_ % 32); dr_ = (n0_ >> 7) * 256 + (up_ ? 128 : 0) + (n0_ & 127); } \
            else { r_ -= 1024; W_ = karg(KA_w_down) + (size_t)le_ * 2048 * 1024; N_ = 1024; Kb_ = 2048; WT_ = W1t_ + (size_t)4096 * 1024; k0_ = 64 * (r_ / 16); n0_ = 64 * (r_ % 16); dr_ = n0_; } } while (0)
        f32x4 va[16], vb[16];
        const float* Wc = nullptr; int Nc = 0, Kbc = 0, k0c = 0, n0c = 0, drc = 0; unsigned char* WTc = nullptr;
        int it = gw;
        if (it < NIT) { MW_DESC(it, Wc, Nc, Kbc, WTc, k0c, n0c, drc); t8_load(va, Wc, Nc, k0c, n0c, lane_); }
        while (it < NIT) {
            const int itn = it + NGW;
            const float* Wn = Wc; int Nn = Nc, Kbn = Kbc, k0n = k0c, n0n = n0c, drn = drc; unsigned char* WTn = WTc;
            if (itn < NIT) { MW_DESC(itn, Wn, Nn, Kbn, WTn, k0n, n0n, drn); t8_load(vb, Wn, Nn, k0n, n0n, lane_); }
            t8_finish(va, Kbc, WTc, k0c, drc, scr, lane_);
#pragma unroll
            for (int i = 0; i < 16; ++i) va[i] = vb[i];
            Wc = Wn; Nc = Nn; Kbc = Kbn; WTc = WTn; k0c = k0n; n0c = n0n; drc = drn; it = itn;
        }
#undef MW_DESC
    }
    __syncthreads();
    {
        LAS float* sc = (LAS float*)F.lds;
        LAS float* red = (LAS float*)(F.lds + 69632);
        for (int i = tid_; i < 17 * 1024; i += 512) { const float v = (i < 16384) ? karg(KA_c)[i] : karg(KA_c_ctx)[i - 16384]; sc[i] = siluf(v); }
        __syncthreads();
        float* mod = (float*)(ws + WS_MOD);
        for (int task = F.vcu; task < 4 * 192; task += F.G) {
            const int L = task / 192, cg = task % 192, col = cg * 32 + (lane_ & 31), kh = lane_ >> 5;
            const float* wp = karg(KA_ada_w) + (size_t)L * 1024 * 6144 + (size_t)(wave_ * 128 + kh * 64) * 6144 + col;
            const LAS float* scp = sc + wave_ * 128 + kh * 64;
            float acc[17];
#pragma unroll
            for (int r = 0; r < 17; ++r) acc[r] = 0.f;
            for (int k0 = 0; k0 < 64; k0 += 16) { float w[16];
#pragma unroll
                for (int kk = 0; kk < 16; ++kk) w[kk] = wp[(size_t)(k0 + kk) * 6144];
#pragma unroll
                for (int kk = 0; kk < 16; ++kk)
#pragma unroll
                    for (int r = 0; r < 17; ++r) acc[r] += scp[r * 1024 + k0 + kk] * w[kk]; }
#pragma unroll
            for (int r = 0; r < 17; ++r) { acc[r] += __shfl_xor(acc[r], 32); if (lane_ < 32) red[(wave_ * 17 + r) * 32 + lane_] = acc[r]; }
            __syncthreads();
            for (int i = tid_; i < 17 * 32; i += 512) { const int r = i >> 5, ln = i & 31; float sum = 0.f;
#pragma unroll
                for (int w = 0; w < 8; ++w) sum += red[(w * 17 + r) * 32 + ln];
                mod[((size_t)L * 17 + r) * 6144 + cg * 32 + ln] = sum + karg(KA_ada_b)[L * 6144 + cg * 32 + ln]; }
            __syncthreads();
        }
    }
}

__device__ __forceinline__ void load_row(const float* row, int lane, f32x4 (&v)[4]) {
    const f32x4* xr = (const f32x4*)row + lane;
#pragma unroll
    for (int j = 0; j < 4; ++j) v[j] = xr[64 * j];
}
__device__ __forceinline__ void load_row_bf16(const bf16_t* row, int lane, u32x2 (&w)[4]) {
    const u32x2* p = (const u32x2*)row + lane;
#pragma unroll
    for (int j = 0; j < 4; ++j) w[j] = p[64 * j];
}
__device__ __forceinline__ void cvt_row_bf16(f32x4 (&v)[4], const u32x2 (&w)[4]) {
#pragma unroll
    for (int j = 0; j < 4; ++j) { v[j].x = __builtin_bit_cast(float, w[j].x << 16); v[j].y = __builtin_bit_cast(float, w[j].x & 0xffff0000u);
        v[j].z = __builtin_bit_cast(float, w[j].y << 16); v[j].w = __builtin_bit_cast(float, w[j].y & 0xffff0000u); }
}
__device__ __forceinline__ void add_row_bf16(f32x4 (&v)[4], const u32x2 (&w)[4]) {
#pragma unroll
    for (int j = 0; j < 4; ++j) { v[j].x += __builtin_bit_cast(float, w[j].x << 16); v[j].y += __builtin_bit_cast(float, w[j].x & 0xffff0000u);
        v[j].z += __builtin_bit_cast(float, w[j].y << 16); v[j].w += __builtin_bit_cast(float, w[j].y & 0xffff0000u); }
}
__device__ __forceinline__ float row_rstd(const f32x4 (&v)[4]) {
    float s = 0.f;
#pragma unroll
    for (int j = 0; j < 4; ++j) s += (v[j].x * v[j].x + v[j].y * v[j].y) + (v[j].z * v[j].z + v[j].w * v[j].w);
    return rsqrtf(wave_sum_fast(s) * (1.f / DM) + RMS_EPS);
}
__device__ __forceinline__ void store_row_bf16(bf16_t* orow, int lane, const f32x4 (&v)[4]) {
    u32x2* o8 = (u32x2*)orow + lane;
#pragma unroll
    for (int j = 0; j < 4; ++j) { u32x2 w; w.x = cvtpk(v[j].x, v[j].y); w.y = cvtpk(v[j].z, v[j].w); o8[64 * j] = w; }
}
__device__ __forceinline__ void store_row_fp8(unsigned char* orow, int lane, const f32x4 (&v)[4], float scale) {
    unsigned* o4 = (unsigned*)orow + lane;
#pragma unroll
    for (int j = 0; j < 4; ++j) { int t = 0; t = __builtin_amdgcn_cvt_pk_fp8_f32(v[j].x * scale, v[j].y * scale, t, false); t = __builtin_amdgcn_cvt_pk_fp8_f32(v[j].z * scale, v[j].w * scale, t, true); o4[64 * j] = (unsigned)t; }
}
struct ModCache { f32x4 sc[4], sh[4]; int b; };
__device__ __forceinline__ void modcache_load(ModCache& M, int b, const float* g, const float* modL, int shift_chunk, int scale_chunk, int lane) {
    if (M.b == b) return; M.b = b;
    const float* mp = modL + (size_t)b * 6144;
#pragma unroll
    for (int j = 0; j < 4; ++j) { const f32x4 gg = ((const f32x4*)g)[lane + 64 * j], s = ((const f32x4*)(mp + scale_chunk * DM))[lane + 64 * j];
        M.sc[j] = gg * (1.f + s); M.sh[j] = ((const f32x4*)(mp + shift_chunk * DM))[lane + 64 * j]; }
}
__device__ __forceinline__ int row_batch(int m) { return m < MX ? (m >> 12) : 16; }

__device__ __forceinline__ void phase_norm1(Frame& F, const float* x, const float* ctx, const float* g1, const float* modL, bf16_t* H, bf16_t* XB) {
    int tid_ = threadIdx.x; asm volatile("" : "+v"(tid_)); const int lane_ = tid_ & 63; const int wave_ = __builtin_amdgcn_readfirstlane(tid_ >> 6);
    const int gw = F.vcu * NWAVES + wave_, NGW = F.G * NWAVES; const int per = (MT + NGW - 1) / NGW;
    ModCache M; M.b = -1;
    const int m0 = gw * per, m1 = min(MT, m0 + per);
    f32x4 nx[4];
    if (m0 < m1) load_row(m0 < MX ? x + (size_t)m0 * DM : ctx + (size_t)(m0 - MX) * DM, lane_, nx);
    for (int m = m0; m < m1; ++m) {
        f32x4 v[4];
#pragma unroll
        for (int j = 0; j < 4; ++j) v[j] = nx[j];
        if (m + 1 < m1) load_row((m + 1) < MX ? x + (size_t)(m + 1) * DM : ctx + (size_t)(m + 1 - MX) * DM, lane_, nx);
        modcache_load(M, row_batch(m), g1, modL, 0, 1, lane_);
        store_row_bf16(XB + (size_t)m * DM, lane_, v);
        const float rstd = row_rstd(v);
#pragma unroll
        for (int j = 0; j < 4; ++j) v[j] = v[j] * rstd * M.sc[j] + M.sh[j];
        if (INPROJ_FP8) store_row_fp8((unsigned char*)H + (size_t)m * DM, lane_, v, H2_SCALE); else store_row_bf16(H + (size_t)m * DM, lane_, v);
    }
}

__device__ __forceinline__ void phase_norm2_router(Frame& F, const bf16_t* XB, const float* g2, const float* modL, const float* rw, unsigned char* H8, float* aff, int nrows, const bf16_t* P, bool do_router = true) {
    int tid_ = threadIdx.x; asm volatile("" : "+v"(tid_)); const int lane = tid_ & 63; const int wave_ = __builtin_amdgcn_readfirstlane(tid_ >> 6);
    LAS float* rwT = (LAS float*)F.lds;
    for (int i = tid_; i < 16384; i += 512) { const int d = i >> 4, e = i & 15; rwT[e * 1024 + d] = rw[i]; }
    __syncthreads();
    const int gw = F.vcu * NWAVES + wave_, NGW = F.G * NWAVES; constexpr int NR2 = 1; const int ngroups = nrows / NR2; const int per = (ngroups + NGW - 1) / NGW;
    ModCache M; M.b = -1;
    const int g0 = gw * per, g1 = min(ngroups, g0 + per);
    constexpr int ND3 = 3;
    u32x2 nx[ND3][4];
#pragma unroll
    for (int k = 0; k < ND3; ++k) if (g0 + k < g1) { load_row_bf16(XB + (size_t)(g0 + k) * DM, lane, nx[k]); }
    for (int gb = g0; gb < g1; gb += ND3)
#pragma unroll
    for (int k = 0; k < ND3; ++k) {
        const int g = gb + k; if (g >= g1) break;
        const int m = NR2 * g;
        f32x4 v[NR2][4];
        cvt_row_bf16(v[0], nx[k]);
        if (g + ND3 < g1) { load_row_bf16(XB + (size_t)(g + ND3) * DM, lane, nx[k]); }
        modcache_load(M, row_batch(m), g2, modL, 3, 4, lane);
#pragma unroll
        for (int r = 0; r < NR2; ++r) { const float rstd = row_rstd(v[r]);
#pragma unroll
            for (int j = 0; j < 4; ++j) v[r][j] = v[r][j] * rstd * M.sc[j] + M.sh[j];
            store_row_fp8(H8 + (size_t)(m + r) * DM, lane, v[r], H2_SCALE); }
        if (!do_router) continue;
        float pe[NR2][16];
        int lo4 = 4 * lane; asm volatile("" : "+v"(lo4));
#pragma unroll
        for (int eb = 0; eb < 16; eb += 4) {
            f32x4 w[4][4];
#pragma unroll
            for (int e4 = 0; e4 < 4; ++e4)
#pragma unroll
                for (int j = 0; j < 4; ++j) w[e4][j] = *(const LAS f32x4*)(rwT + (eb + e4) * 1024 + lo4 + 256 * j);
            __builtin_amdgcn_sched_barrier(0);
#pragma unroll
            for (int e4 = 0; e4 < 4; ++e4) { f32x2 s2 = {0.f, 0.f};
#pragma unroll
                for (int j = 0; j < 4; ++j) { s2 = __builtin_elementwise_fma((f32x2){v[0][j].x, v[0][j].y}, (f32x2){w[e4][j].x, w[e4][j].y}, s2); s2 = __builtin_elementwise_fma((f32x2){v[0][j].z, v[0][j].w}, (f32x2){w[e4][j].z, w[e4][j].w}, s2); }
                pe[0][eb + e4] = s2.x + s2.y; }
            __builtin_amdgcn_sched_barrier(0);
        }
        {
            LAS float* red = (LAS float*)(F.lds + 65536) + wave_ * 1088;
#pragma unroll
            for (int e = 0; e < 16; ++e) red[lane * 17 + e] = pe[0][e];
            const LAS float* rp = red + (lane >> 4) * 272 + (lane & 15);
            float sacc = 0.f;
#pragma unroll
            for (int i = 0; i < 16; ++i) sacc += rp[i * 17];
            sacc += __shfl_xor(sacc, 16); sacc += __shfl_xor(sacc, 32);
            const float mx = row16_max(sacc);
            const float ex = expf(sacc - mx);
            const float sm = row16_sum(ex);
            if (lane < 16) aff[(size_t)m * 16 + lane] = ex / sm;
        }
    }
    __syncthreads();
}

__device__ __forceinline__ void phase_norm2_router_mfma(Frame& F, const bf16_t* XB, const float* g2, const float* modL, const float* rw, unsigned char* H8, float* aff, int nrows) {
    int tid_ = threadIdx.x; asm volatile("" : "+v"(tid_)); const int lane = tid_ & 63; const int wave_ = __builtin_amdgcn_readfirstlane(tid_ >> 6);
    constexpr int AST = 2064;
    LAS unsigned char* Ahi = F.lds; LAS unsigned char* Alo = F.lds + 16 * AST; LAS float* red = (LAS float*)(F.lds + 2 * 16 * AST);
    const int e_ = lane & 15, kg = lane >> 4;
    bf16x8 Bh[4], Bl[4];
#pragma unroll
    for (int s = 0; s < 4; ++s) { const float* wp = rw + (size_t)(128 * wave_ + 32 * s + 8 * kg) * 16 + e_;
        const float x0 = wp[0], x1 = wp[16], x2 = wp[32], x3 = wp[48], x4 = wp[64], x5 = wp[80], x6 = wp[96], x7 = wp[112];
        u32x4 h, l; h.x = cvtpk(x0, x1); h.y = cvtpk(x2, x3); h.z = cvtpk(x4, x5); h.w = cvtpk(x6, x7);
        l.x = cvtpk(x0 - __builtin_bit_cast(float, h.x << 16), x1 - __builtin_bit_cast(float, h.x & 0xffff0000u)); l.y = cvtpk(x2 - __builtin_bit_cast(float, h.y << 16), x3 - __builtin_bit_cast(float, h.y & 0xffff0000u));
        l.z = cvtpk(x4 - __builtin_bit_cast(float, h.z << 16), x5 - __builtin_bit_cast(float, h.z & 0xffff0000u)); l.w = cvtpk(x6 - __builtin_bit_cast(float, h.w << 16), x7 - __builtin_bit_cast(float, h.w & 0xffff0000u));
        Bh[s] = __builtin_bit_cast(bf16x8, h); Bl[s] = __builtin_bit_cast(bf16x8, l); }
    const int ngroups = nrows >> 4; const int per = (ngroups + F.G - 1) / F.G; const int gg0 = F.vcu * per, gg1 = min(ngroups, gg0 + per);
    ModCache M; M.b = -1;
    u32x2 nx[2][4];
    if (gg0 < gg1) { load_row_bf16(XB + (size_t)(gg0 * 16 + 2 * wave_) * DM, lane, nx[0]); load_row_bf16(XB + (size_t)(gg0 * 16 + 2 * wave_ + 1) * DM, lane, nx[1]); }
    for (int gg = gg0; gg < gg1; ++gg) {
        const int mbase = gg * 16;
        f32x4 v[2][4];
        cvt_row_bf16(v[0], nx[0]); cvt_row_bf16(v[1], nx[1]);
        if (gg + 1 < gg1) { load_row_bf16(XB + (size_t)(mbase + 16 + 2 * wave_) * DM, lane, nx[0]); load_row_bf16(XB + (size_t)(mbase + 16 + 2 * wave_ + 1) * DM, lane, nx[1]); }
#pragma unroll
        for (int r = 0; r < 2; ++r) { const int tok = 2 * wave_ + r, m = mbase + tok;
            modcache_load(M, row_batch(m), g2, modL, 3, 4, lane);
            const float rstd = row_rstd(v[r]);
#pragma unroll
            for (int j = 0; j < 4; ++j) v[r][j] = v[r][j] * rstd * M.sc[j] + M.sh[j];
            store_row_fp8(H8 + (size_t)m * DM, lane, v[r], H2_SCALE);
            LAS unsigned char* ah = Ahi + tok * AST + 8 * lane;
#pragma unroll
            for (int j = 0; j < 4; ++j) { const f32x4 x = v[r][j]; u32x2 h, l; h.x = cvtpk(x.x, x.y); h.y = cvtpk(x.z, x.w);
                l.x = cvtpk(x.x - __builtin_bit_cast(float, h.x << 16), x.y - __builtin_bit_cast(float, h.x & 0xffff0000u)); l.y = cvtpk(x.z - __builtin_bit_cast(float, h.y << 16), x.w - __builtin_bit_cast(float, h.y & 0xffff0000u));
                *(LAS u32x2*)(ah + 512 * j) = h; *(LAS u32x2*)(ah + 16 * AST + 512 * j) = l; } }
        __syncthreads();
        f32x4 acc = {0.f, 0.f, 0.f, 0.f};
#pragma unroll
        for (int s = 0; s < 4; ++s) { const LAS unsigned char* ap = Ahi + e_ * AST + 256 * wave_ + 64 * s + 16 * kg;
            const bf16x8 a_h = *(const LAS bf16x8*)ap, a_l = *(const LAS bf16x8*)(ap + 16 * AST);
            acc = __builtin_amdgcn_mfma_f32_16x16x32_bf16(a_h, Bh[s], acc, 0, 0, 0); acc = __builtin_amdgcn_mfma_f32_16x16x32_bf16(a_h, Bl[s], acc, 0, 0, 0); acc = __builtin_amdgcn_mfma_f32_16x16x32_bf16(a_l, Bh[s], acc, 0, 0, 0); }
#pragma unroll
        for (int r = 0; r < 4; ++r) red[wave_ * 256 + (4 * kg + r) * 16 + e_] = acc[r];
        __syncthreads();
        if (tid_ < 256) { float sacc = 0.f;
#pragma unroll
            for (int w = 0; w < 8; ++w) sacc += red[w * 256 + tid_];
            const float mx = row16_max(sacc);
            const float ex = expf(sacc - mx);
            const float sm = row16_sum(ex);
            aff[(size_t)(mbase + (tid_ >> 4)) * 16 + (tid_ & 15)] = ex / sm; }
    }
    __syncthreads();
}

template <int NPT>
__device__ __forceinline__ void topk_task(Frame& F, const float* aff, int rowbase, int n, int cap, int e, int slot_base, unsigned* rowsrc_e, short* slot) {
    int tid_ = threadIdx.x; asm volatile("" : "+v"(tid_)); const int lane_ = tid_ & 63; const int wave_ = __builtin_amdgcn_readfirstlane(tid_ >> 6);
    LAS unsigned* cnt = (LAS unsigned*)F.lds;
    const int tid = tid_, lane = lane_, wave = wave_;
    const bool act = tid * NPT < n;
    unsigned v[NPT];
#pragma unroll
    for (int j = 0; j < NPT; ++j) v[j] = act ? __float_as_uint(aff[(size_t)(rowbase + tid * NPT + j) * 16 + e]) : 0u;
    unsigned T = 0u;
    for (int bit = 30; bit >= 0; --bit) {
        const unsigned cand = T | (1u << bit);
        unsigned c = 0;
#pragma unroll
        for (int j = 0; j < NPT; ++j) c += (act && v[j] >= cand) ? 1u : 0u;
        c = (unsigned)wave_sum((float)c);
        LAS unsigned* cb = cnt + (bit & 1) * 8;
        if (lane == 0) cb[wave] = c;
        __syncthreads();
        unsigned tot = 0;
#pragma unroll
        for (int w = 0; w < 8; ++w) tot += cb[w];
        if (tot >= (unsigned)cap) T = cand;
    }
    unsigned ngt = 0, neq = 0;
#pragma unroll
    for (int j = 0; j < NPT; ++j) { ngt += (act && v[j] > T) ? 1u : 0u; neq += (act && v[j] == T) ? 1u : 0u; }
    unsigned pk = ngt | (neq << 16), inc = pk;
#pragma unroll
    for (int o = 1; o < 64; o <<= 1) { const unsigned t = __shfl_up(inc, o); if (lane >= o) inc += t; }
    LAS unsigned* wtot = cnt + 32;
    __syncthreads();
    if (lane == 63) wtot[wave] = inc;
    __syncthreads();
    unsigned wpre = 0, total = 0;
#pragma unroll
    for (int w = 0; w < 8; ++w) { const unsigned t = wtot[w]; if (w < wave) wpre += t; total += t; }
    const unsigned exc = wpre + inc - pk;
    const unsigned tot_gt = total & 0xffffu;
    const unsigned need_eq = (unsigned)cap - tot_gt;
    unsigned gt_before = exc & 0xffffu, eq_before = exc >> 16;
    if (act) {
#pragma unroll
        for (int j = 0; j < NPT; ++j) {
            const bool g = v[j] > T, q = v[j] == T;
            const bool sel = g || (q && eq_before < need_eq);
            const int tok = tid * NPT + j;
            short sv = -1;
            if (sel) { const unsigned pos = gt_before + min(eq_before, need_eq); sv = (short)(slot_base + pos); rowsrc_e[slot_base + pos] = (unsigned)(rowbase + tok); }
            slot[(size_t)(rowbase + tok) * 16 + e] = sv;
            gt_before += g ? 1u : 0u; eq_before += q ? 1u : 0u;
        }
    }
    __syncthreads();
}
__device__ __forceinline__ void phase_topk(Frame& F, const float* aff, unsigned* rowsrc, short* slot, int nMe, bool with_ctx) {
    const int ntask = NB * NE * (with_ctx ? 2 : 1);
    for (int t = F.vcu; t < ntask; t += F.G) {
        const bool cx = t >= NB * NE; const int tt = cx ? t - NB * NE : t; const int b = tt >> 4, e = tt & 15;
        unsigned* rs_e = rowsrc + (size_t)e * nMe * 256;
        if (!cx) topk_task<8>(F, aff, b * SEQ, SEQ, CAPX, e, b * CAPX, rs_e, slot);
        else topk_task<1>(F, aff, MX + b * CTXL, CTXL, CAPC, e, NB * CAPX + b * CAPC, rs_e, slot);
    }
}

__device__ __forceinline__ void phase_combine(Frame& F, bf16_t* XB, const bf16_t* P, float* xout, const float* modL, const float* aff, const short* slot, const bf16_t* ybuf, int nMe,
                                              int nrows, bool last, const float* gnext, const float* modN, bf16_t* H, const float* final_g, float* dump = nullptr) {
    int tid_ = threadIdx.x; asm volatile("" : "+v"(tid_)); const int lane = tid_ & 63; const int wave_ = __builtin_amdgcn_readfirstlane(tid_ >> 6);
    const int gw = F.vcu * NWAVES + wave_, NGW = F.G * NWAVES; const int per = (nrows + NGW - 1) / NGW;
    ModCache M; M.b = -1;
    f32x4 g2v[4]; int gb = -1;
    const int m0 = gw * per, m1 = min(nrows, m0 + per);
    const size_t estride = (size_t)nMe * 256 * DM;
#define CB_META(m, sv, av) do { sv = (int)slot[(size_t)(m) * 16 + (lane & 15)]; av = aff[(size_t)(m) * 16 + (lane & 15)]; } while (0)
#define CB_ISSUE(m, sv, av, X, Y, AK, REST) do { load_row_bf16(XB + (size_t)(m) * DM, lane, X); \
        unsigned mk_ = (unsigned)__ballot(sv >= 0) & 0xffffu; \
        _Pragma("unroll") for (int k = 0; k < 4; ++k) { \
            if (mk_) { const int e_ = __builtin_ctz(mk_); mk_ &= mk_ - 1u; const int s_ = __builtin_amdgcn_readlane(sv, e_); AK[k] = __builtin_bit_cast(float, __builtin_amdgcn_readlane(__builtin_bit_cast(int, av), e_)); \
                const u32x2* yr_ = (const u32x2*)(ybuf + (size_t)e_ * estride + (size_t)s_ * DM) + lane; \
                _Pragma("unroll") for (int j = 0; j < 4; ++j) Y[k][j] = yr_[64 * j]; } \
            else { AK[k] = 0.f; _Pragma("unroll") for (int j = 0; j < 4; ++j) Y[k][j] = (u32x2){0u, 0u}; } } \
        REST = mk_; } while (0)
    int sv1 = -1, sv2 = -1; float av1 = 0.f, av2 = 0.f;
    u32x2 X[4], Xn[4]; u32x2 Y[4][4], Yn[4][4]; float AK[4], AKn[4]; unsigned rest = 0, restn = 0; int svc = -1, svn = -1; float avc = 0.f, avn = 0.f;
    if (m0 < m1) { CB_META(m0, sv1, av1); CB_ISSUE(m0, sv1, av1, X, Y, AK, rest); svc = sv1; avc = av1; }
    if (m0 + 1 < m1) CB_META(m0 + 1, sv1, av1);
    for (int m = m0; m < m1; ++m) {
        if (m + 1 < m1) { CB_ISSUE(m + 1, sv1, av1, Xn, Yn, AKn, restn); svn = sv1; avn = av1; }
        if (m + 2 < m1) CB_META(m + 2, sv1, av1);
        const int b = row_batch(m);
        if (gb != b) { gb = b;
#pragma unroll
            for (int j = 0; j < 4; ++j) g2v[j] = ((const f32x4*)(modL + (size_t)b * 6144 + 5 * DM))[lane + 64 * j]; }
        f32x4 acc[4];
#pragma unroll
        for (int j = 0; j < 4; ++j) acc[j] = (f32x4){0.f, 0.f, 0.f, 0.f};
#pragma unroll
        for (int k = 0; k < 4; ++k) { const float a = AK[k];
#pragma unroll
            for (int j = 0; j < 4; ++j) { const u32x2 w = Y[k][j];
                acc[j].x += a * __builtin_bit_cast(float, w.x << 16); acc[j].y += a * __builtin_bit_cast(float, w.x & 0xffff0000u);
                acc[j].z += a * __builtin_bit_cast(float, w.y << 16); acc[j].w += a * __builtin_bit_cast(float, w.y & 0xffff0000u); } }
        while (rest) { const int e_ = __builtin_ctz(rest); rest &= rest - 1u; const int s_ = __builtin_amdgcn_readlane(svc, e_); const float a = __builtin_bit_cast(float, __builtin_amdgcn_readlane(__builtin_bit_cast(int, avc), e_));
            const u32x2* yr = (const u32x2*)(ybuf + (size_t)e_ * estride + (size_t)s_ * DM) + lane;
#pragma unroll
            for (int j = 0; j < 4; ++j) { const u32x2 w = yr[64 * j];
                acc[j].x += a * __builtin_bit_cast(float, w.x << 16); acc[j].y += a * __builtin_bit_cast(float, w.x & 0xffff0000u);
                acc[j].z += a * __builtin_bit_cast(float, w.y << 16); acc[j].w += a * __builtin_bit_cast(float, w.y & 0xffff0000u); } }
        f32x4 v[4];
        cvt_row_bf16(v, X);
#pragma unroll
        for (int j = 0; j < 4; ++j) v[j] = v[j] + g2v[j] * acc[j];
        const float rstd = row_rstd(v);
        if (!last) {
            store_row_bf16((dump ? (bf16_t*)dump : XB) + (size_t)m * DM, lane, v);
            modcache_load(M, b, gnext, modN, 0, 1, lane);
#pragma unroll
            for (int j = 0; j < 4; ++j) v[j] = v[j] * rstd * M.sc[j] + M.sh[j];
            if (INPROJ_FP8) store_row_fp8((unsigned char*)H + (size_t)m * DM, lane, v, H2_SCALE); else store_row_bf16(H + (size_t)m * DM, lane, v);
        } else {
            f32x4* o = (f32x4*)((dump ? dump : xout) + (size_t)m * DM) + lane;
#pragma unroll
            for (int j = 0; j < 4; ++j) o[64 * j] = v[j] * rstd * ((const f32x4*)final_g)[lane + 64 * j];
        }
#pragma unroll
        for (int j = 0; j < 4; ++j) { X[j] = Xn[j];
#pragma unroll
            for (int k = 0; k < 4; ++k) Y[k][j] = Yn[k][j]; }
#pragma unroll
        for (int k = 0; k < 4; ++k) AK[k] = AKn[k];
        rest = restn; svc = svn; avc = avn;
    }
#undef CB_META
#undef CB_ISSUE
}

struct Args { In in; float* out; unsigned char* ws; int ph_lo, ph_hi; };
#define WSP(off) ((unsigned char*)karg(KA_WS) + (off))
__global__ void __launch_bounds__(NWAVES * 64, 2) fwd(Args args) {
    extern __shared__ __attribute__((aligned(16))) unsigned char lds_raw[];
    Frame F;
    F.lds = (LAS unsigned char*)lds_raw;
    F.MISC = (volatile LAS unsigned*)(F.lds + MISC_OFF);
    F.tid = threadIdx.x; F.lane = F.tid & 63; F.wave = __builtin_amdgcn_readfirstlane(F.tid >> 6);
    F.G = gridDim.x; { const int bx = blockIdx.x; F.vcu = (F.G % 8 == 0) ? (bx % 8) * (F.G / 8) + bx / 8 : bx; }
    F.ctl = nullptr;
    if (F.tid < 64) ((LAS unsigned*)(F.lds + MISC_OFF))[F.tid] = 0u;
    __syncthreads();
    const int lo = args.ph_lo, hi = args.ph_hi;
    if (hi - lo > 1) (void)xcd_barrier_post((unsigned*)WSP(WS_CTL) + 1024, F.MISC + 8);
#ifndef DBG_ONLY
#define DBG_ONLY -1
#endif
#define PHEN(k) (DBG_ONLY < 0 || ((k) < 2 ? (k) : 2 + (((k) - 2) & 7)) == DBG_ONLY)
#define IN(k) (PHEN(k) && lo <= (k) && (k) < hi)
#ifndef ROUTER_MFMA
#define ROUTER_MFMA 1
#endif
#ifndef DUP_PH
#define DUP_PH -1
#endif
#ifndef DUP_LMASK
#define DUP_LMASK 0xF
#endif
#define NREP(k, L) ((DUP_PH == (k) && ((DUP_LMASK >> (L)) & 1)) ? 2 : 1)
#define SEAM(k) do { if (IN(k) && IN((k) + 1)) { XcdBarrier bar_; bar_.bar = (unsigned*)WSP(WS_CTL) + 1024; bar_.x = xb_xcc_id(); bar_.st = F.MISC + 8; xcd_barrier(bar_); } } while (0)

    if (IN(0)) { for (int rep_ = 0; rep_ < NREP(0, 0); ++rep_) phase_prologue(F, WSP(0)); } SEAM(0);
    if (IN(1)) { phase_norm1(F, karg(KA_x), karg(KA_ctx), karg(KA_norm1_g), (const float*)WSP(WS_MOD), (bf16_t*)WSP(WS_H), (bf16_t*)WSP(WS_XB)); } SEAM(1);

#pragma unroll 1
    for (int L = 0; L < DEPTH; ++L) {
        const int pb = 2 + 8 * L;
        if (hi <= pb || lo >= pb + 8) continue;
        if (IN(pb + 0)) for (int rep_ = 0; rep_ < NREP(2, L); ++rep_) {
            const int kind = L % 3, slot = L / 3; const int Nin = (kind == 0) ? 1536 : 3072;
            const bf16_t* Wt = (const bf16_t*)WSP(WS_PW) + (kind == 0 ? PW_WIN_IN / 2 + (size_t)slot * 1536 * 1024 : kind == 1 ? PW_DIFF_IN / 2 : PW_NA_IN / 2);
            pg8::Gemm g{(const char*)WSP(WS_H), (const char*)Wt, INPROJ_FP8 ? DM : DM * 2, 1 << 20, 0, nullptr};
            pg8::StaticOrder S; S.init(MT / 256, Nin / 256, F.G, (int)blockIdx.x);
            pg8::EpiInProj E{(bf16_t*)WSP(WS_QKV), Nin, 4, kind == 0 ? 5 : (kind == 1 ? 8 : 0), (const float*)WSP(WS_TAB), INPROJ_FP8 ? 1.f / (H2_SCALE * W8_SCALE) : 1.f, kind == 0 ? 5 : 8, (bf16_t*)WSP(WS_P)};
            pg8::gemm_phase<pg8::EpiInProj, false, true, INPROJ_FP8 != 0>(F.lds, g, S, E);
        }
        SEAM(pb + 0);
        if (IN(pb + 1)) for (int rep_ = 0; rep_ < NREP(3, L); ++rep_) {
            const int kind = L % 3, slot = L / 3; const int with_ctx = L < DEPTH - 1 ? 1 : 0;
            if (kind == 0) { att::A2Args A{(const bf16_t*)WSP(WS_QKV), (bf16_t*)WSP(WS_H), karg(KA_win_sink) + slot * 16, with_ctx, (const bf16_t*)WSP(WS_P)}; att::att2_phase<0>(F.lds, A, F.vcu, F.G); }
            else if (kind == 1) { const float* TAB = (const float*)WSP(WS_TAB); att::DiffArgs A{(const bf16_t*)WSP(WS_QKV), (bf16_t*)WSP(WS_H), karg(KA_diff_subln_g), TAB[TAB_LAM], TAB[TAB_LAM + 1], with_ctx, (const bf16_t*)WSP(WS_P)}; att::diff_phase3(F.lds, A, F.vcu, F.G); }
            else { att::A2Args A{(const bf16_t*)WSP(WS_QKV), (bf16_t*)WSP(WS_H), karg(KA_na_rpb), with_ctx, (const bf16_t*)WSP(WS_P)}; att::att2_phase<1>(F.lds, A, F.vcu, F.G); }
        }
        SEAM(pb + 1);
        if (IN(pb + 2)) {
            const int kind = L % 3, slot = L / 3; const bool with_ctx = L < DEPTH - 1;
            const bf16_t* Wt = (const bf16_t*)WSP(WS_PW) + (kind == 0 ? PW_WIN_OUT / 2 + (size_t)slot * 1024 * 1024 : kind == 1 ? PW_DIFF_OUT / 2 : PW_NA_OUT / 2);
            pg8::Gemm g{(const char*)WSP(WS_H), (const char*)Wt, OUTPROJ_FP8 ? DM : DM * 2, 1 << 20, 0, nullptr};
            pg8::StaticOrder S; S.init((with_ctx ? MT : MX) / 256, 4, F.G, (int)blockIdx.x);
            pg8::EpiOutProj E{(bf16_t*)WSP(WS_XB), (const float*)WSP(WS_MOD) + (size_t)L * 17 * 6144, OUTPROJ_FP8 ? 1.f / (Y_SCALE * W8_SCALE) : 1.f};
            pg8::gemm_phase<pg8::EpiOutProj, false, true, OUTPROJ_FP8 != 0>(F.lds, g, S, E);
        }
        SEAM(pb + 2);
        if (IN(pb + 3)) for (int rep_ = 0; rep_ < NREP(5, L); ++rep_) { const bool with_ctx = L < DEPTH - 1;
            if (ROUTER_MFMA && rep_ == 0) phase_norm2_router_mfma(F, (const bf16_t*)WSP(WS_XB), karg(KA_norm2_g) + L * DM, (const float*)WSP(WS_MOD) + (size_t)L * 17 * 6144, karg(KA_router_w) + (size_t)L * DM * NE,
                               (unsigned char*)WSP(WS_H), (float*)WSP(WS_AFF), with_ctx ? MT : MX);
            else phase_norm2_router(F, (const bf16_t*)WSP(WS_XB), karg(KA_norm2_g) + L * DM, (const float*)WSP(WS_MOD) + (size_t)L * 17 * 6144, karg(KA_router_w) + (size_t)L * DM * NE,
                               (unsigned char*)WSP(WS_H), (float*)WSP(WS_AFF), with_ctx ? MT : MX, (const bf16_t*)WSP(WS_P), rep_ == 0); }
        SEAM(pb + 3);
        if (IN(pb + 4)) for (int rep_ = 0; rep_ < NREP(6, L); ++rep_) { const bool with_ctx = L < DEPTH - 1; phase_topk(F, (const float*)WSP(WS_AFF), (unsigned*)WSP(WS_ROWSRC), (short*)WSP(WS_SLOT), with_ctx ? NME_FULL : NME_LAST, with_ctx); }
        SEAM(pb + 4);
        if (IN(pb + 5)) for (int rep_ = 0; rep_ < NREP(7, L); ++rep_) {
            const int nMe = (L < DEPTH - 1) ? NME_FULL : NME_LAST;
            pg8::Gemm g{(const char*)WSP(WS_H), (const char*)WSP(WS_MOEW + (size_t)L * 16 * MOEW_E), DM, nMe, MOEW_E, (const unsigned*)WSP(WS_ROWSRC)};
            pg8::StaticOrder S; S.init(16 * nMe, 16, F.G, (int)blockIdx.x);
            if (DUP_PH == 7 && rep_ == 1) { pg8::EpiSwiglu<true> E{(unsigned char*)WSP(WS_QKV), 1.f / (H2_SCALE * W8_SCALE), HID_SCALE};
                pg8::gemm_phase<pg8::EpiSwiglu<true>, true, true, true>(F.lds, g, S, E); }
            else { pg8::EpiSwiglu<false> E{(unsigned char*)WSP(WS_QKV), 1.f / (H2_SCALE * W8_SCALE), HID_SCALE};
                pg8::gemm_phase<pg8::EpiSwiglu<false>, true, true, true>(F.lds, g, S, E); }
        }
        SEAM(pb + 5);
        if (IN(pb + 6)) for (int rep_ = 0; rep_ < NREP(8, L); ++rep_) {
            const int nMe = (L < DEPTH - 1) ? NME_FULL : NME_LAST;
            pg8::Gemm g{(const char*)WSP(WS_QKV), (const char*)WSP(WS_MOEW + (size_t)L * 16 * MOEW_E + (size_t)4096 * 1024), FF, nMe, MOEW_E, nullptr};
            pg8::StaticOrder S; S.init(16 * nMe, 4, F.G, (int)blockIdx.x);
            pg8::EpiBf16 E{(bf16_t*)WSP(WS_YBUF), DM, 1.f / (HID_SCALE * W8_SCALE)};
            pg8::gemm_phase<pg8::EpiBf16, false, true, true, true>(F.lds, g, S, E);
        }
        SEAM(pb + 6);
        if (IN(pb + 7)) for (int rep_ = NREP(9, L) - 1; rep_ >= 0; --rep_) {
            const bool last = (L == DEPTH - 1); const bool with_ctx = !last;
            phase_combine(F, (bf16_t*)WSP(WS_XB), (const bf16_t*)WSP(WS_P), (float*)karg(KA_OUT), (const float*)WSP(WS_MOD) + (size_t)L * 17 * 6144, (const float*)WSP(WS_AFF), (const short*)WSP(WS_SLOT), (const bf16_t*)WSP(WS_YBUF),
                          with_ctx ? NME_FULL : NME_LAST, with_ctx ? MT : MX, last, karg(KA_norm1_g) + (last ? 0 : (L + 1) * DM), (const float*)WSP(WS_MOD) + (size_t)(last ? 0 : L + 1) * 17 * 6144,
                          rep_ ? (bf16_t*)WSP(WS_QKV + 300 * MiB) : (bf16_t*)WSP(WS_H), karg(KA_final_g), rep_ ? (float*)WSP(WS_QKV) : nullptr);
        }
        SEAM(pb + 7);
    }
#undef IN
#undef SEAM
}

extern "C" void kernel_launch(void* const* d_in, const int* in_sizes, int n_in, void* d_out, int out_size, void* d_ws, size_t ws_size, hipStream_t stream) {
    static int grid = 0;
    if (grid == 0) {
        if (n_in != 23 || out_size != MX * DM || ws_size < WS_END) { fprintf(stderr, "kernel_launch: unexpected shapes: n_in %d out %d ws %zu (need %zu)\n", n_in, out_size, ws_size, (size_t)WS_END); grid = -1; return; }
        int dev = 0, cus = 0, per_cu = 0;
        if (hipGetDevice(&dev) != hipSuccess || hipDeviceGetAttribute(&cus, hipDeviceAttributeMultiprocessorCount, dev) != hipSuccess) { grid = -1; return; }
        if (hipFuncSetAttribute((const void*)fwd, hipFuncAttributeMaxDynamicSharedMemorySize, LDS_BYTES) != hipSuccess) { fprintf(stderr, "kernel_launch: hipFuncSetAttribute failed\n"); grid = -1; return; }
        if (hipOccupancyMaxActiveBlocksPerMultiprocessor(&per_cu, (const void*)fwd, NWAVES * 64, LDS_BYTES) != hipSuccess || per_cu < 1) fprintf(stderr, "kernel_launch: occupancy query says %d\n", per_cu);
        (void)hipGetLastError();
        grid = cus;
    }
    if (grid < 0) return;
    (void)hipMemsetAsync((char*)d_ws + WS_CTL, 0, CTL_ZERO_BYTES, stream);
    Args a{};
    const float** ip = (const float**)&a.in;
    for (int i = 0; i < 23; ++i) ip[i] = (const float*)d_in[i];
    a.out = (float*)d_out; a.ws = (unsigned char*)d_ws;
    if (MK_N_LAUNCHES == 1) { a.ph_lo = 0; a.ph_hi = NPHASES; hipLaunchKernelGGL(fwd, dim3(grid), dim3(NWAVES * 64), LDS_BYTES, stream, a); }
    else for (int p = 0; p < NPHASES; ++p) { a.ph_lo = p; a.ph_hi = p + 1; hipLaunchKernelGGL(fwd, dim3(grid), dim3(NWAVES * 64), LDS_BYTES, stream, a); }
}
```

```cpp
#include <hip/hip_runtime.h>
#include <cstdio>
#include <cstdint>

#ifndef MK_N_LAUNCHES
#define MK_N_LAUNCHES 1
#endif

#define GAS __attribute__((address_space(1)))
#define LAS __attribute__((address_space(3)))
typedef unsigned short bf16_t;
typedef short bf16x8 __attribute__((ext_vector_type(8)));
typedef short s16x4 __attribute__((ext_vector_type(4)));
typedef float f32x4 __attribute__((ext_vector_type(4)));
typedef float f32x2 __attribute__((ext_vector_type(2)));
typedef float f32x16 __attribute__((ext_vector_type(16)));
typedef unsigned u32x4 __attribute__((ext_vector_type(4)));
typedef unsigned u32x2 __attribute__((ext_vector_type(2)));
typedef __bf16 bf16x2_t __attribute__((ext_vector_type(2)));
typedef GAS unsigned gu32;

constexpr int DM = 1024, NB = 16, SEQ = 4096, DEPTH = 4, CTXL = 256, NE = 16, FF = 2048;
constexpr int MX = NB * SEQ;
constexpr int MC = NB * CTXL;
constexpr int MT = MX + MC;
constexpr int CAPX = 512, CAPC = 32;
constexpr int NME_FULL = 34, NME_LAST = 32;
constexpr float C2 = 0.125f * 1.4426950408889634f;
constexpr float LOG2E = 1.4426950408889634f;
constexpr float RMS_EPS = 1e-6f;
constexpr float NEG_BIG = -1e30f;
constexpr int NWAVES = 8;
constexpr int NPHASES = 2 + 8 * DEPTH;

constexpr size_t MiB = 1u << 20;
constexpr size_t WS_CTL = 0, CTL_ZERO_BYTES = 64 * 1024;
constexpr size_t WS_MOD = 1 * MiB;
constexpr size_t WS_TAB = 3 * MiB;
constexpr size_t WS_AFF = 4 * MiB;
constexpr size_t WS_SLOT = 9 * MiB;
constexpr size_t WS_ROWSRC = 12 * MiB;
constexpr size_t WS_CTXRES = 13 * MiB;
constexpr size_t WS_PW = 29 * MiB;
constexpr size_t PW_WIN_IN = 0, PW_WIN_OUT = 6 * MiB, PW_DIFF_IN = 10 * MiB, PW_DIFF_OUT = 16 * MiB, PW_NA_IN = 18 * MiB, PW_NA_OUT = 24 * MiB;
constexpr size_t WS_H = 56 * MiB;
constexpr size_t WS_QKV = 192 * MiB;
constexpr size_t WS_YBUF = 736 * MiB;
constexpr size_t WS_MOEW = 1008 * MiB;
constexpr size_t MOEW_E = (size_t)(4096 * 1024 + 1024 * 2048);
#ifndef INPROJ_FP8
#define INPROJ_FP8 1
#endif
#ifndef OUTPROJ_FP8
#define OUTPROJ_FP8 0
#endif
constexpr float Y_SCALE = 8.f;
constexpr float H2_SCALE = 4.f, HID_SCALE = 2.f, W8_SCALE = 32.f;
constexpr size_t WS_XB = 1536 * MiB;
constexpr size_t WS_END = 1672 * MiB;
constexpr size_t WS_P = 1400 * MiB;
constexpr int TAB_COS = 0, TAB_SIN = 1024, TAB_LAM = 2048;

constexpr int RING_BYTES = 131072;
constexpr int MISC_OFF = 135168;
constexpr int LDS_BYTES = 147456;

#define LDS_WAIT() asm volatile("s_waitcnt lgkmcnt(0)" ::: "memory")
#define VM_WAIT() asm volatile("s_waitcnt vmcnt(0)" ::: "memory")

__device__ __forceinline__ unsigned cvtpk(float lo, float hi) { f32x2 v = {lo, hi}; bf16x2_t b = __builtin_convertvector(v, bf16x2_t); return __builtin_bit_cast(unsigned, b); }
__device__ __forceinline__ float bf2f(unsigned short u) { return __builtin_bit_cast(float, (unsigned)u << 16); }
__device__ __forceinline__ float wave_sum(float v) {
#pragma unroll
    for (int o = 1; o < 64; o <<= 1) v += __shfl_xor(v, o);
    return v;
}
template <int CTRL> __device__ __forceinline__ float dppf(float v) { return __builtin_bit_cast(float, __builtin_amdgcn_update_dpp(0, __builtin_bit_cast(int, v), CTRL, 0xF, 0xF, true)); }
__device__ __forceinline__ float row16_sum(float v) { v += dppf<0xB1>(v); v += dppf<0x4E>(v); v += dppf<0x141>(v); v += dppf<0x140>(v); return v; }
__device__ __forceinline__ float row16_max(float v) { v = fmaxf(v, dppf<0xB1>(v)); v = fmaxf(v, dppf<0x4E>(v)); v = fmaxf(v, dppf<0x141>(v)); v = fmaxf(v, dppf<0x140>(v)); return v; }
__device__ __forceinline__ float rdlane(float v, int l) { return __builtin_bit_cast(float, __builtin_amdgcn_readlane(__builtin_bit_cast(int, v), l)); }
__device__ __forceinline__ float wave_sum_fast(float v) { v = row16_sum(v); return (rdlane(v, 0) + rdlane(v, 16)) + (rdlane(v, 32) + rdlane(v, 48)); }
__device__ __forceinline__ float siluf(float v) { return v / (1.f + __expf(-v)); }

#define XB_TMO      128
#define XB_XCNT(j)  (256  + 64 * (j))
#define XB_XSUB(j)  (1280 + 64 * (j))
#define XB_XGEN(j)  (2304 + 64 * (j))
#define XB_TOP      3328
#define XB_TOPGEN   3392
#define XCD_BAR_WORDS 3456
#define XB_SPIN_CAP (1u << 18)
__device__ __forceinline__ unsigned xb_ld(unsigned* p)              { return __hip_atomic_load(p, __ATOMIC_RELAXED, __HIP_MEMORY_SCOPE_AGENT); }
__device__ __forceinline__ unsigned xb_add(unsigned* p, unsigned v) { return __hip_atomic_fetch_add(p, v, __ATOMIC_RELAXED, __HIP_MEMORY_SCOPE_AGENT); }
__device__ __forceinline__ unsigned xb_xcc_id() { return (unsigned)__builtin_amdgcn_s_getreg((3 << 11) | 20) & 0xFu; }
#define XB_SPIN(cond, bar) do { unsigned _sp = 0; while (cond) { __builtin_amdgcn_s_sleep(1); \
    if ((++_sp & 255u) == 0u) { if (xb_ld(&(bar)[XB_TMO])) break; if (_sp > XB_SPIN_CAP) { atomicAdd(&(bar)[XB_TMO], 1u); break; } } } } while (0)
struct XcdBarrier { unsigned* bar; unsigned x; volatile LAS unsigned* st; };
__device__ __forceinline__ XcdBarrier xcd_barrier_post(unsigned* bar, volatile LAS unsigned* st) {
    XcdBarrier b; b.bar = bar; b.x = xb_xcc_id(); b.st = st;
    if (threadIdx.x == 0) (void)xb_add(&bar[XB_XCNT(b.x)], 1u);
    return b;
}
__device__ __forceinline__ void xcd_barrier_complete(unsigned* bar, unsigned x, unsigned& nloc, unsigned& nx) {
    const unsigned G = gridDim.x * gridDim.y * gridDim.z;
    unsigned sum, cnt, mine, sp = 0u;
    for (;;) {
        sum = 0u; cnt = 0u; mine = 0u;
#pragma unroll
        for (unsigned j = 0; j < 16; ++j) { const unsigned c = xb_ld(&bar[XB_XCNT(j)]); sum += c; cnt += (c > 0u) ? 1u : 0u; mine = (j == x) ? c : mine; }
        if (sum == G) break;
        __builtin_amdgcn_s_sleep(1);
        if ((++sp & 255u) == 0u) { if (xb_ld(&bar[XB_TMO])) break; if (sp > XB_SPIN_CAP) { atomicAdd(&bar[XB_TMO], 1u); break; } }
    }
    nloc = mine > 0u ? mine : 1u; nx = cnt > 0u ? cnt : 1u;
}
__device__ __forceinline__ void xcd_barrier(const XcdBarrier& b) {
    asm volatile("s_waitcnt vmcnt(0)" ::: "memory");
    __syncthreads();
    if (threadIdx.x == 0) {
        unsigned* bar = b.bar;
        __builtin_amdgcn_s_waitcnt(0);
        unsigned nloc = b.st[0], nx = b.st[1];
        if (nloc == 0u) { xcd_barrier_complete(bar, b.x, nloc, nx); b.st[0] = nloc; b.st[1] = nx; }
        const unsigned old = xb_add(&bar[XB_XSUB(b.x)], 1u);
        const unsigned gen = old / nloc;
        if (old + 1u == (gen + 1u) * nloc) {
            __builtin_amdgcn_fence(__ATOMIC_RELEASE, "agent");
            asm volatile("s_waitcnt vmcnt(0)" ::: "memory");
            const unsigned og = xb_add(&bar[XB_TOP], 1u);
            const unsigned tg = og / nx;
            if (og + 1u == (tg + 1u) * nx) xb_add(&bar[XB_TOPGEN], 1u);
            else XB_SPIN(xb_ld(&bar[XB_TOPGEN]) == tg, bar);
            __builtin_amdgcn_fence(__ATOMIC_ACQUIRE, "agent");
            xb_add(&bar[XB_XGEN(b.x)], 1u);
            asm volatile("s_waitcnt vmcnt(0)" ::: "memory");
        } else {
            XB_SPIN(xb_ld(&bar[XB_XGEN(b.x)]) == gen, bar);
            __builtin_amdgcn_fence(__ATOMIC_ACQUIRE, "agent");
            asm volatile("s_waitcnt vmcnt(0)" ::: "memory");
        }
    }
    __syncthreads();
}

namespace pg8 {
constexpr int BM = 256, BK = 64, HALF = 128, HTB = HALF * BK * 2, NXCD = 8, WGM = 4;
typedef int v4i __attribute__((ext_vector_type(4)));
typedef int v8i __attribute__((ext_vector_type(8)));
__host__ __device__ __forceinline__ int lds_byte(int r, int c) { const int st = (r >> 4) * 2 + (c >> 5), rr = r & 15, cc = c & 31, ob = rr * 64 + cc * 2; return st * 1024 + (ob ^ (((ob >> 9) & 1) << 5)); }
__host__ __device__ __forceinline__ void stage_rc(int b, int& R, int& C) { const int st = b / 1024, sb = b % 1024, swz = sb ^ (((sb >> 9) & 1) << 5); R = (st >> 1) * 16 + swz / 64; C = (st & 1) * 32 + (swz % 64) / 2; }
__host__ __device__ __forceinline__ int perm32(int rho) { const int n = rho >> 4, i = rho & 15; return 8 * (i >> 2) + 4 * n + (i & 3); }

struct Unit { int pm, pn; };
struct Gemm { const char* A; const char* Bt; int Kb; int nMe; size_t b_estride; const unsigned* rowsrc; };

struct StaticOrder {
    int nM, nN, nwg, G, c;
    __device__ void init(int nM_, int nN_, int G_, int c_) { nM = nM_; nN = nN_; nwg = nM * nN; G = G_; c = c_; }
    __device__ bool next(int i, Unit& u) const {
        const long L = (long)i * G + c; if (L >= nwg) return false;
        int wgid = (int)L; { const int q = nwg / NXCD, r = nwg % NXCD, xcd = wgid % NXCD, off = wgid / NXCD; wgid = (xcd < r ? xcd * (q + 1) : r * (q + 1) + (xcd - r) * q) + off; }
        const int nig = WGM * nN, gid = wgid / nig, fm = gid * WGM, gsz = (nM - fm) < WGM ? (nM - fm) : WGM;
        u.pm = fm + ((wgid % nig) % gsz); u.pn = (wgid % nig) / gsz; return true;
    }
};

template <class Epi, bool GATHER, bool ALIGN_EPI, bool FP8 = false, bool ABLK = false>
__device__ __forceinline__ void gemm_phase(LAS unsigned char* lds, const Gemm g, const StaticOrder& S, const Epi& E) {
    int tid = threadIdx.x; asm volatile("" : "+v"(tid));
    const int wid = __builtin_amdgcn_readfirstlane(tid >> 6), lane = tid & 63, wr = wid >> 2, wc = wid & 3, fr = lane & 15, fq = lane >> 4;
    const int Kb = g.Kb, nt = Kb / (BK * 2);
    int Rr[2], Cc[2]; unsigned voffB[2];
#pragma unroll
    for (int i = 0; i < 2; ++i) { int R, C; stage_rc(tid * 16 + i * 8192, R, C); const int Rb = Epi::PERM ? ((R & ~31) + perm32(R & 31)) : R;
        Rr[i] = R; Cc[i] = C; voffB[i] = (unsigned)(Rb * Kb + C * 2); }
    const size_t kstep = (size_t)(BK * 2);
    const size_t kstepA = ABLK ? (size_t)32768 : kstep;
    const size_t hstep = (size_t)HALF * Kb;
    const size_t tstep = 2 * hstep;
    const unsigned ldsw = (unsigned)wid * 1024u;
    const int aoff = lds_byte(wr * 64 + fr, fq * 8), boff = lds_byte(wc * 32 + fr, fq * 8);
#define PG8_SA(b, h) (((b) * 2 + (h)) * HTB)
#define PG8_SB(b, h) ((4 + (b) * 2 + (h)) * HTB)
#define PG8_STAGE(bufoff, gbase, voff) do { _Pragma("unroll") for (int _i = 0; _i < 2; ++_i) \
        __builtin_amdgcn_global_load_lds((const unsigned*)((const char*)(gbase) + (voff)[_i]), (LAS unsigned*)(lds + (bufoff) + ldsw + _i * 8192), 16, 0, 0); } while (0)
#define PG8_LDA(dst, b, h) do { _Pragma("unroll") for (int m = 0; m < 4; ++m) _Pragma("unroll") for (int k = 0; k < 2; ++k) dst[m][k] = *(const LAS bf16x8*)(lds + PG8_SA(b, h) + aoff + m * 2048 + k * 1024); } while (0)
#define PG8_LDB(dst, b, h) do { _Pragma("unroll") for (int n = 0; n < 2; ++n) _Pragma("unroll") for (int k = 0; k < 2; ++k) dst[n][k] = *(const LAS bf16x8*)(lds + PG8_SB(b, h) + boff + n * 2048 + k * 1024); } while (0)
#define PG8_MMA(ai, bj, At, Bt, Z) do { __builtin_amdgcn_s_setprio(1); \
        if constexpr (FP8) { if (Epi::ZEROC && (Z)) { _Pragma("unroll") for (int m = 0; m < 4; ++m) _Pragma("unroll") for (int n = 0; n < 2; ++n) { \
            const v8i b8_ = __builtin_shufflevector(__builtin_bit_cast(v4i, Bt[n][0]), __builtin_bit_cast(v4i, Bt[n][1]), 0, 1, 2, 3, 4, 5, 6, 7); \
            const v8i a8_ = __builtin_shufflevector(__builtin_bit_cast(v4i, At[m][0]), __builtin_bit_cast(v4i, At[m][1]), 0, 1, 2, 3, 4, 5, 6, 7); \
            asm volatile("v_mfma_f32_16x16x128_f8f6f4 %0, %1, %2, 0" : "+v"(acc[ai][bj][m][n]) : "v"(b8_), "v"(a8_)); } }   \
          else { _Pragma("unroll") for (int m = 0; m < 4; ++m) _Pragma("unroll") for (int n = 0; n < 2; ++n) { \
            const v8i b8_ = __builtin_shufflevector(__builtin_bit_cast(v4i, Bt[n][0]), __builtin_bit_cast(v4i, Bt[n][1]), 0, 1, 2, 3, 4, 5, 6, 7); \
            const v8i a8_ = __builtin_shufflevector(__builtin_bit_cast(v4i, At[m][0]), __builtin_bit_cast(v4i, At[m][1]), 0, 1, 2, 3, 4, 5, 6, 7); \
            asm volatile("v_mfma_f32_16x16x128_f8f6f4 %0, %1, %2, %0" : "+v"(acc[ai][bj][m][n]) : "v"(b8_), "v"(a8_)); } } } \
        else { _Pragma("unroll") for (int m = 0; m < 4; ++m) _Pragma("unroll") for (int n = 0; n < 2; ++n) _Pragma("unroll") for (int k = 0; k < 2; ++k) \
            acc[ai][bj][m][n] = __builtin_amdgcn_mfma_f32_16x16x32_bf16(Bt[n][k], At[m][k], acc[ai][bj][m][n], 0, 0, 0); } \
        __builtin_amdgcn_s_setprio(0); } while (0)
#define PG8_WAIT_V(n) asm volatile("s_waitcnt vmcnt(" #n ")" ::: "memory")
#define PG8_WAIT_L(n) asm volatile("s_waitcnt lgkmcnt(" #n ")" ::: "memory")
#define PG8_BAR __builtin_amdgcn_s_barrier()
#define PG8_SCHED __builtin_amdgcn_sched_barrier(0)
#define PG8_CALC_VG(VG, U) do { _Pragma("unroll") for (int _h = 0; _h < 2; ++_h) _Pragma("unroll") for (int _i = 0; _i < 2; ++_i) { \
        const unsigned _row = (unsigned)((U).pm * BM + _h * HALF + Rr[_i]); const unsigned _src = GATHER ? g.rowsrc[_row] : _row; \
        if constexpr (ABLK) { const unsigned _r = (unsigned)(_h * HALF + Rr[_i]), _c = (unsigned)Cc[_i] >> 3; \
            VG[_h][_i] = (unsigned)(U).pm * (unsigned)(Kb * BM) + (_r >> 4) * 2048u + (_c >> 1) * 512u + (_r & 15u) * 32u + (_c & 1u) * 16u; } \
        else VG[_h][_i] = _src * (unsigned)Kb + (unsigned)Cc[_i] * 2u; } } while (0)
    Unit cur, nxt; int ui = 0;
    if (!S.next(0, cur)) return;
    f32x4 acc[2][2][4][2];
    if constexpr (!(FP8 && Epi::ZEROC)) {
#pragma unroll
    for (int a = 0; a < 2; ++a)
#pragma unroll
        for (int b = 0; b < 2; ++b)
#pragma unroll
            for (int m = 0; m < 4; ++m)
#pragma unroll
                for (int n = 0; n < 2; ++n) acc[a][b][m][n] = (f32x4){0.f, 0.f, 0.f, 0.f};
    }
    bf16x8 At[4][2], B0[2][2], B1[2][2];
    unsigned vg[2][2], vgn[2][2];
    PG8_CALC_VG(vg, cur);
    const char* const gA = g.A;
    const char* cB = g.Bt + (size_t)(cur.pm / g.nMe) * g.b_estride + (size_t)cur.pn * tstep;
    PG8_STAGE(PG8_SB(0, 0), cB, voffB); PG8_STAGE(PG8_SB(0, 1), cB + hstep, voffB); PG8_STAGE(PG8_SA(0, 0), gA, vg[0]); PG8_STAGE(PG8_SA(0, 1), gA, vg[1]);
    if (wr == 1) PG8_BAR;
    PG8_WAIT_V(2); PG8_BAR;
    PG8_STAGE(PG8_SB(1, 0), cB + kstep, voffB); PG8_STAGE(PG8_SA(1, 0), gA + kstepA, vg[0]); PG8_STAGE(PG8_SB(1, 1), cB + hstep + kstep, voffB);
    PG8_WAIT_V(6); PG8_BAR;
    for (;;) {
        const bool has_next = S.next(ui + 1, nxt);
        LAS unsigned char* const rsb = lds + 131072 + ((ui + 1) & 1) * 1024;
        if (has_next) {
            if constexpr (GATHER) { if (wid == 0) __builtin_amdgcn_global_load_lds((const unsigned*)(g.rowsrc + (size_t)nxt.pm * BM) + lane * 4, (LAS unsigned*)rsb, 16, 0, 0); }
            else { PG8_CALC_VG(vgn, nxt); } }
        else {
#pragma unroll
            for (int _h = 0; _h < 2; ++_h)
#pragma unroll
                for (int _i = 0; _i < 2; ++_i) vgn[_h][_i] = vg[_h][_i]; }
        const char* nB = has_next ? g.Bt + (size_t)(nxt.pm / g.nMe) * g.b_estride + (size_t)nxt.pn * tstep : cB;
        for (int t = 0; t < nt; t += 2) {
            const bool last = (t == nt - 2);
            const char* a1 = gA + (size_t)(t + 1) * kstepA;
            const char* a2 = last ? gA : gA + (size_t)(t + 2) * kstepA; const char* b2 = last ? nB : cB + (size_t)(t + 2) * kstep;
            const char* a3 = a2 + kstepA; const char* b3 = b2 + kstep;
            if constexpr (GATHER) { if (last && has_next) {
#pragma unroll
                for (int _h = 0; _h < 2; ++_h)
#pragma unroll
                    for (int _i = 0; _i < 2; ++_i) vgn[_h][_i] = *(const LAS unsigned*)(rsb + (_h * HALF + Rr[_i]) * 4) * (unsigned)Kb + (unsigned)Cc[_i] * 2u; } }
            unsigned w0[2], w1[2];
#pragma unroll
            for (int _i = 0; _i < 2; ++_i) { w0[_i] = last ? vgn[0][_i] : vg[0][_i]; w1[_i] = last ? vgn[1][_i] : vg[1][_i]; }
            PG8_LDB(B0, 0, 0); PG8_LDB(B1, 0, 1); PG8_SCHED; PG8_LDA(At, 0, 0); PG8_STAGE(PG8_SA(1, 1), a1, vg[1]);
            PG8_WAIT_V(8); PG8_WAIT_L(0); PG8_BAR; PG8_MMA(0, 0, At, B0, t == 0); PG8_MMA(0, 1, At, B1, t == 0); PG8_BAR; PG8_SCHED;
            PG8_LDA(At, 0, 1); PG8_STAGE(PG8_SB(0, 0), b2, voffB); PG8_STAGE(PG8_SB(0, 1), b2 + hstep, voffB); PG8_STAGE(PG8_SA(0, 0), a2, w0);
            PG8_WAIT_V(8); PG8_WAIT_L(0); PG8_BAR; PG8_MMA(1, 0, At, B0, t == 0); PG8_MMA(1, 1, At, B1, t == 0); PG8_BAR; PG8_SCHED;
            PG8_LDB(B0, 1, 0); PG8_LDB(B1, 1, 1); PG8_SCHED; PG8_LDA(At, 1, 0); PG8_STAGE(PG8_SA(0, 1), a2, w1);
            PG8_WAIT_V(8); PG8_WAIT_L(0); PG8_BAR; PG8_MMA(0, 0, At, B0, false); PG8_MMA(0, 1, At, B1, false); PG8_BAR; PG8_SCHED;
            PG8_LDA(At, 1, 1); PG8_STAGE(PG8_SB(1, 0), b3, voffB); PG8_STAGE(PG8_SB(1, 1), b3 + hstep, voffB); PG8_STAGE(PG8_SA(1, 0), a3, w0);
            PG8_WAIT_V(8); PG8_WAIT_L(0); PG8_BAR; PG8_MMA(1, 0, At, B0, false); PG8_MMA(1, 1, At, B1, false); PG8_BAR; PG8_SCHED;
        }
        if constexpr (ALIGN_EPI) { if (wr == 0) PG8_BAR; }
        if constexpr (FP8) asm volatile("s_nop 15\n\ts_nop 15" ::: "memory");
        E(acc, cur, wr, wc, fr, fq);
        if (!has_next) break;
        if constexpr (!(FP8 && Epi::ZEROC)) {
#pragma unroll
        for (int a = 0; a < 2; ++a)
#pragma unroll
            for (int b = 0; b < 2; ++b)
#pragma unroll
                for (int m = 0; m < 4; ++m)
#pragma unroll
                    for (int n = 0; n < 2; ++n) acc[a][b][m][n] = (f32x4){0.f, 0.f, 0.f, 0.f};
        }
        cur = nxt; cB = nB; ++ui;
#pragma unroll
        for (int _h = 0; _h < 2; ++_h)
#pragma unroll
            for (int _i = 0; _i < 2; ++_i) vg[_h][_i] = vgn[_h][_i];
        if constexpr (ALIGN_EPI) { if (wr == 1) PG8_BAR; }
    }
    PG8_WAIT_V(0);
    if constexpr (!ALIGN_EPI) { if (wr == 0) PG8_BAR; }
    PG8_BAR;
#undef PG8_SA
#undef PG8_SB
#undef PG8_STAGE
#undef PG8_LDA
#undef PG8_LDB
#undef PG8_MMA
#undef PG8_WAIT_V
#undef PG8_WAIT_L
#undef PG8_BAR
#undef PG8_SCHED
#undef PG8_CALC_VG
}

struct EpiInProj {
    static constexpr bool PERM = false; static constexpr bool ZEROC = false;
    bf16_t* O; int ldc; int q_tiles; int rope_tiles; const float* tab; float osc; int v_tile0; bf16_t* Q;
    __device__ __forceinline__ void operator()(const f32x4 (&acc)[2][2][4][2], const Unit& u, int wr, int wc, int fr, int fq) const {
        const int row0 = u.pm * BM + wr * 64 + fr, col0 = u.pn * BM + wc * 32 + 4 * fq;
        const float sc = ((u.pn < q_tiles) ? C2 : 1.f) * osc;
        const bool rope = (u.pn < rope_tiles) && (u.pm < MX / BM);
        const int axis = wc & 1; const bool isv = u.pn >= v_tile0;
#pragma unroll
        for (int ai = 0; ai < 2; ++ai)
#pragma unroll
            for (int m = 0; m < 4; ++m) {
                const int row = row0 + ai * HALF + m * 16;
                f32x4 cs = {1.f, 1.f, 1.f, 1.f}, sn = {0.f, 0.f, 0.f, 0.f};
                if (rope) { const int t = row & (SEQ - 1); const int pos = axis ? (t & 63) : (t >> 6); cs = *(const f32x4*)(tab + TAB_COS + pos * 16 + 4 * fq); sn = *(const f32x4*)(tab + TAB_SIN + pos * 16 + 4 * fq); }
                bf16_t* rowp = O + (size_t)row * ldc + col0;
                bf16_t* rowq = (u.pn < q_tiles) ? Q + ((size_t)(row >> 5) * 16 + 4 * u.pn + (wc >> 1)) * 2048 + (2 * (wc & 1) + (fq >> 1)) * 512 + (fq & 1) * 256 + (row & 31) * 8
                                                : O + (size_t)row * ldc + u.pn * BM + wc * 32 + 8 * fq;
                const int qstep = (u.pn < q_tiles) ? 2 * 2048 : HALF;
#pragma unroll
                for (int bj = 0; bj < 2; ++bj) {
                    const f32x4 x1 = acc[ai][bj][m][0] * sc, x2 = acc[ai][bj][m][1] * sc;
                    const f32x4 o1 = x1 * cs - x2 * sn, o2 = x2 * cs + x1 * sn;
                    u32x2 w1, w2; w1.x = cvtpk(o1[0], o1[1]); w1.y = cvtpk(o1[2], o1[3]); w2.x = cvtpk(o2[0], o2[1]); w2.y = cvtpk(o2[2], o2[3]);
                    if (isv) { *(u32x2*)(rowp + bj * HALF) = w1; *(u32x2*)(rowp + bj * HALF + 16) = w2; }
                    else *(u32x4*)(rowq + bj * qstep) = (u32x4){w1.x, w1.y, w2.x, w2.y}; }
            }
    }
};
struct EpiOutProj {
    static constexpr bool PERM = true; static constexpr bool ZEROC = false;
    bf16_t* P; const float* mod; float osc;
    __device__ __forceinline__ void operator()(const f32x4 (&acc)[2][2][4][2], const Unit& u, int wr, int wc, int fr, int fq) const {
        const int b = (u.pm < MX / BM) ? ((u.pm * BM) >> 12) : 16;
        const int row0 = u.pm * BM + wr * 64 + fr, col0 = u.pn * BM + wc * 32 + 8 * fq;
        const float* gp = mod + (size_t)b * 6144 + 2 * DM + col0;
        f32x4 gv[2][2];
#pragma unroll
        for (int bj = 0; bj < 2; ++bj)
#pragma unroll
            for (int n = 0; n < 2; ++n) gv[bj][n] = *(const f32x4*)(gp + bj * HALF + 4 * n) * osc;
#pragma unroll
        for (int ai = 0; ai < 2; ++ai)
#pragma unroll
            for (int m = 0; m < 4; ++m) { bf16_t* rowp = P + (size_t)(row0 + ai * HALF + m * 16) * DM + col0;
                u32x4 xr[2]; xr[0] = *(const u32x4*)rowp; xr[1] = *(const u32x4*)(rowp + HALF);
#pragma unroll
                for (int bj = 0; bj < 2; ++bj) { const f32x4 v0 = acc[ai][bj][m][0] * gv[bj][0], v1 = acc[ai][bj][m][1] * gv[bj][1]; const u32x4 x = xr[bj];
                    u32x4 w; w.x = cvtpk(v0[0] + __builtin_bit_cast(float, x.x << 16), v0[1] + __builtin_bit_cast(float, x.x & 0xffff0000u));
                    w.y = cvtpk(v0[2] + __builtin_bit_cast(float, x.y << 16), v0[3] + __builtin_bit_cast(float, x.y & 0xffff0000u));
                    w.z = cvtpk(v1[0] + __builtin_bit_cast(float, x.z << 16), v1[1] + __builtin_bit_cast(float, x.z & 0xffff0000u));
                    w.w = cvtpk(v1[2] + __builtin_bit_cast(float, x.w << 16), v1[3] + __builtin_bit_cast(float, x.w & 0xffff0000u));
                    *(u32x4*)(rowp + bj * HALF) = w; } }
    }
};
template <bool NOSTORE = false> struct EpiSwiglu {
    static constexpr bool PERM = true; static constexpr bool ZEROC = true;
    unsigned char* O; float in_scale; float out_scale;
    __device__ __forceinline__ void operator()(const f32x4 (&acc)[2][2][4][2], const Unit& u, int wr, int wc, int fr, int fq) const {
        const int row0 = u.pm * BM + wr * 64 + fr, col0 = u.pn * HALF + wc * 32 + 8 * fq;
#pragma unroll
        for (int ai = 0; ai < 2; ++ai)
#pragma unroll
            for (int m = 0; m < 4; ++m) { unsigned char* rowp = O + ((size_t)u.pm * 16 + u.pn) * 32768 + (8 * ai + 4 * wr + m) * 2048 + wc * 512 + fr * 32 + fq * 8;
                float h[8];
                const float c1 = -LOG2E * in_scale, c2i = 1.f / (in_scale * in_scale * out_scale);
#pragma unroll
                for (int n = 0; n < 2; ++n)
#pragma unroll
                    for (int j = 0; j < 4; j += 2) { const f32x2 ag = {acc[ai][0][m][n][j], acc[ai][0][m][n][j + 1]}, au = {acc[ai][1][m][n][j], acc[ai][1][m][n][j + 1]};
                        const f32x2 ea = ag * c1; f32x2 t; t.x = __builtin_amdgcn_exp2f(ea.x); t.y = __builtin_amdgcn_exp2f(ea.y);
                        const f32x2 d = __builtin_elementwise_fma(t, (f32x2){c2i, c2i}, (f32x2){c2i, c2i}); f32x2 r; r.x = __builtin_amdgcn_rcpf(d.x); r.y = __builtin_amdgcn_rcpf(d.y);
                        const f32x2 hv = (ag * au) * r; h[n * 4 + j] = hv.x; h[n * 4 + j + 1] = hv.y; }
                int w0 = 0, w1 = 0;
                w0 = __builtin_amdgcn_cvt_pk_fp8_f32(h[0], h[1], w0, false); w0 = __builtin_amdgcn_cvt_pk_fp8_f32(h[2], h[3], w0, true);
                w1 = __builtin_amdgcn_cvt_pk_fp8_f32(h[4], h[5], w1, false); w1 = __builtin_amdgcn_cvt_pk_fp8_f32(h[6], h[7], w1, true);
                if (NOSTORE) asm volatile("" :: "v"(w0), "v"(w1)); else *(u32x2*)rowp = (u32x2){(unsigned)w0, (unsigned)w1}; }
    }
};
struct EpiBf16 {
    static constexpr bool PERM = true; static constexpr bool ZEROC = true;
    bf16_t* O; int ldc; float sc;
    __device__ __forceinline__ void operator()(const f32x4 (&acc)[2][2][4][2], const Unit& u, int wr, int wc, int fr, int fq) const {
        const int row0 = u.pm * BM + wr * 64 + fr, col0 = u.pn * BM + wc * 32 + 8 * fq;
#pragma unroll
        for (int ai = 0; ai < 2; ++ai)
#pragma unroll
            for (int m = 0; m < 4; ++m) { bf16_t* rowp = O + (size_t)(row0 + ai * HALF + m * 16) * ldc + col0;
#pragma unroll
                for (int bj = 0; bj < 2; ++bj) { const f32x4 v0 = acc[ai][bj][m][0] * sc, v1 = acc[ai][bj][m][1] * sc;
                    u32x4 w; w.x = cvtpk(v0[0], v0[1]); w.y = cvtpk(v0[2], v0[3]); w.z = cvtpk(v1[0], v1[1]); w.w = cvtpk(v1[2], v1[3]);
                    *(u32x4*)(rowp + bj * HALF) = w; } }
    }
};
}

namespace att {
#define SBAR() __builtin_amdgcn_sched_barrier(0)
__device__ __forceinline__ int crow(int r, int hi) { return (r & 3) + 8 * (r >> 2) + 4 * hi; }
__device__ __forceinline__ void glds16(const void* gsrc, unsigned lds_dst) { unsigned keep;
    asm volatile("s_mov_b32 %0, m0\n\ts_mov_b32 m0, %2\n\ts_nop 0\n\tglobal_load_lds_dwordx4 %1, off\n\ts_mov_b32 m0, %0" : "=&s"(keep) : "v"(gsrc), "s"(lds_dst) : "memory"); }
#define WAIT_BAR0() asm volatile("s_waitcnt vmcnt(0) lgkmcnt(0)\n\ts_barrier" ::: "memory")
typedef LAS const char* lds_cptr;
typedef short v4i16_t __attribute__((ext_vector_type(4)));
__device__ __forceinline__ s16x4 vtr(lds_cptr p) { return __builtin_bit_cast(s16x4, __builtin_amdgcn_ds_read_tr16_b64_v4i16((LAS v4i16_t*)p)); }
__device__ __forceinline__ float hmax(float m) { auto rr = __builtin_amdgcn_permlane32_swap(__float_as_uint(m), __float_as_uint(m), false, false); return fmaxf(__uint_as_float(rr[0]), __uint_as_float(rr[1])); }
__device__ __forceinline__ float hsum(float m) { auto rr = __builtin_amdgcn_permlane32_swap(__float_as_uint(m), __float_as_uint(m), false, false); return __uint_as_float(rr[0]) + __uint_as_float(rr[1]); }

__device__ __forceinline__ void qkt(f32x16& p0, f32x16& p1, lds_cptr kb, const bf16x8 (&qr)[4]) {
    p0 = f32x16{}; p1 = f32x16{};
#pragma unroll
    for (int d0 = 0; d0 < 4; ++d0) {
        const bf16x8 b0 = *(const LAS bf16x8*)(kb + d0 * 2048), b1 = *(const LAS bf16x8*)(kb + d0 * 2048 + 512);
        p0 = __builtin_amdgcn_mfma_f32_32x32x16_bf16(b0, qr[d0], p0, 0, 0, 0);
        p1 = __builtin_amdgcn_mfma_f32_32x32x16_bf16(b1, qr[d0], p1, 0, 0, 0); }
}
template <int ND>
__device__ __forceinline__ void softmax_pv(f32x16& p0, f32x16& p1, f32x16 (&oT)[ND], float& m, float& l, lds_cptr vp) {
    float rm = p0[0];
#pragma unroll
    for (int r = 1; r < 16; ++r) rm = fmaxf(rm, p0[r]);
#pragma unroll
    for (int r = 0; r < 16; ++r) rm = fmaxf(rm, p1[r]);
    rm = hmax(rm);
    const float mn = fmaxf(m, rm);
    const float alpha = __builtin_amdgcn_exp2f(m - mn);
    m = mn;
    float s = 0.f;
#pragma unroll
    for (int r = 0; r < 16; ++r) { p0[r] = __builtin_amdgcn_exp2f(p0[r] - mn); p1[r] = __builtin_amdgcn_exp2f(p1[r] - mn); s += p0[r] + p1[r]; }
    l = l * alpha + s;
#pragma unroll
    for (int d = 0; d < ND; ++d) oT[d] = oT[d] * alpha;
    u32x4 pw[4];
#pragma unroll
    for (int k = 0; k < 2; ++k) {
        pw[k]     = (u32x4){cvtpk(p0[8 * k], p0[8 * k + 1]), cvtpk(p0[8 * k + 2], p0[8 * k + 3]), cvtpk(p0[8 * k + 4], p0[8 * k + 5]), cvtpk(p0[8 * k + 6], p0[8 * k + 7])};
        pw[2 + k] = (u32x4){cvtpk(p1[8 * k], p1[8 * k + 1]), cvtpk(p1[8 * k + 2], p1[8 * k + 3]), cvtpk(p1[8 * k + 4], p1[8 * k + 5]), cvtpk(p1[8 * k + 6], p1[8 * k + 7])}; }
#pragma unroll
    for (int d = 0; d < ND; ++d)
#pragma unroll
        for (int ks = 0; ks < 4; ++ks) {
            const s16x4 lo = vtr(vp + d * 4096 + ks * 1024), hi = vtr(vp + d * 4096 + ks * 1024 + 512);
            const bf16x8 vf = (bf16x8){lo[0], lo[1], lo[2], lo[3], hi[0], hi[1], hi[2], hi[3]};
            oT[d] = __builtin_amdgcn_mfma_f32_32x32x16_bf16(vf, __builtin_bit_cast(bf16x8, pw[ks]), oT[d], 0, 0, 0); }
}
template <int ND>
__device__ __forceinline__ void stg_flush(const LAS unsigned char* stg, bf16_t* ybase, int lane) {
    constexpr int RB = ND * 64 + 16, CPR = ND * 4;
#pragma unroll
    for (int i = 0; i < 32 * CPR / 64; ++i) { const int idx = i * 64 + lane, row = idx / CPR, ch = idx % CPR;
        const u32x4 v = *(const LAS u32x4*)(stg + row * RB + ch * 16); *(u32x4*)(ybase + (size_t)row * DM + ch * 8) = v; }
}
template <int ND>
__device__ __forceinline__ void store_oT(const f32x16 (&oT)[ND], float scale, bf16_t* ybase, size_t elem_off, int hi) {
    if (OUTPROJ_FP8) { unsigned char* orow = (unsigned char*)ybase + elem_off; const float sc8 = scale * Y_SCALE;
#pragma unroll
        for (int d = 0; d < ND; ++d)
#pragma unroll
            for (int g = 0; g < 4; ++g) { int t = 0; t = __builtin_amdgcn_cvt_pk_fp8_f32(oT[d][4 * g] * sc8, oT[d][4 * g + 1] * sc8, t, false); t = __builtin_amdgcn_cvt_pk_fp8_f32(oT[d][4 * g + 2] * sc8, oT[d][4 * g + 3] * sc8, t, true);
                *(unsigned*)(orow + d * 32 + 8 * g + 4 * hi) = (unsigned)t; } }
    else { bf16_t* orow = ybase + elem_off;
#pragma unroll
        for (int d = 0; d < ND; ++d)
#pragma unroll
            for (int g = 0; g < 4; ++g) { u32x2 w; w.x = cvtpk(oT[d][4 * g] * scale, oT[d][4 * g + 1] * scale); w.y = cvtpk(oT[d][4 * g + 2] * scale, oT[d][4 * g + 3] * scale);
                *(u32x2*)(orow + d * 32 + 8 * g + 4 * hi) = w; } }
}
constexpr int NA_BIAS_OFF = 65536;
struct DiffArgs { const bf16_t* qkv; bf16_t* y; const float* subln_g; float lam; float omli; int with_ctx; const bf16_t* q; };

#define DF_THR 8.0f
#define DF_BAR()   asm volatile("s_waitcnt lgkmcnt(0)\n\ts_barrier" ::: "memory")
#define DF_BARV()  asm volatile("s_waitcnt vmcnt(0) lgkmcnt(0)\n\ts_barrier" ::: "memory")
__device__ __forceinline__ void diff_phase2(LAS unsigned char* lds, const DiffArgs A, int vcu, int G) {
    int tid = threadIdx.x; asm volatile("" : "+v"(tid));
    const int lane = tid & 63, r32 = lane & 31, hi = lane >> 5; const int wid = __builtin_amdgcn_readfirstlane(tid >> 6);
    constexpr int P = 3072;
    const unsigned lds0 = (unsigned)(uintptr_t)lds;
    const lds_cptr l3 = (lds_cptr)lds;
    const int mp = wid >> 2, qsub = wid & 3;
    LAS float* xch = (LAS float*)lds + qsub * 4096 + lane;
    const int nmain = NB * 8 * 32, nunits = nmain + (A.with_ctx ? NB * 8 * 2 : 0);
    for (int u = vcu; u < nunits; u += G) {
        int b, h, qrow0, NT; const bool ctxu = u >= nmain;
        if (!ctxu) { const int qb = u & 31; h = (u >> 5) & 7; b = u >> 8; qrow0 = b * SEQ + 128 * qb + 32 * qsub; NT = 4 + 64; }
        else { const int v = u - nmain; const int qb = v & 1; h = (v >> 1) & 7; b = v >> 4; qrow0 = MX + b * CTXL + 128 * qb + 32 * qsub; NT = 4; }
        const bf16_t* Kc = A.qkv + (size_t)(MX + b * CTXL) * P + 1024 + 128 * h;
        const bf16_t* Kx = A.qkv + (size_t)(b * SEQ) * P + 1024 + 128 * h;
        const int krow = 8 * wid + (lane >> 3); const size_t koff = (size_t)krow * P + (((lane & 7) ^ ((krow >> 1) & 7)) * 8);
        const int pv0 = 2 * wid, pv1 = 2 * wid + 1;
        const int vra = 4 * pv0 + (lane >> 4), vrb = 4 * pv1 + (lane >> 4); const int vph = lane & 15;
        const size_t voffa = (size_t)vra * P + 1024 + ((((vph >> 2) ^ (vra & 3)) << 2) | (vph & 3)) * 8;
        const size_t voffb = (size_t)vrb * P + 1024 + ((((vph >> 2) ^ (vrb & 3)) << 2) | (vph & 3)) * 8;
#define DF_DMA(t) do { if ((t) < NT) { const int slot_ = (t) % 3; const bf16_t* base_ = ((t) < 4) ? Kc + (size_t)(t) * 64 * P : Kx + (size_t)((t) - 4) * 64 * P; \
        glds16(base_ + koff,      (unsigned)__builtin_amdgcn_readfirstlane(lds0 + slot_ * 32768 + wid * 1024)); \
        glds16(base_ + koff + 64, (unsigned)__builtin_amdgcn_readfirstlane(lds0 + slot_ * 32768 + 8192 + wid * 1024)); \
        glds16(base_ + voffa,     (unsigned)__builtin_amdgcn_readfirstlane(lds0 + slot_ * 32768 + 16384 + pv0 * 1024)); \
        glds16(base_ + voffb,     (unsigned)__builtin_amdgcn_readfirstlane(lds0 + slot_ * 32768 + 16384 + pv1 * 1024)); } } while (0)
        DF_DMA(0);
        bf16x8 qr[4];
        { const bf16_t* Qw = A.qkv + (size_t)(qrow0 + r32) * P + h * 128 + mp * 64;
#pragma unroll
          for (int d0 = 0; d0 < 4; ++d0) qr[d0] = *(const bf16x8*)(Qw + d0 * 16 + hi * 8); }
        f32x16 oT[4]; oT[0] = f32x16{}; oT[1] = f32x16{}; oT[2] = f32x16{}; oT[3] = f32x16{};
        float m = 0.f, l = 0.f;
        f32x16 p0, p1; u32x4 pw[4];
        const int ksw = (r32 >> 1) & 7; const lds_cptr kp0 = l3 + mp * 8192 + r32 * 128 + ((hi ^ (ksw & 1)) << 4); const int ks2 = ksw >> 1;
        const int vq = (lane & 15) >> 2; const lds_cptr vp0 = l3 + 16384 + (4 * hi + vq) * 256 + ((lane >> 4) & 1) * 32 + (lane & 3) * 8;
#define DF_LOADV(dst, vp_, d) do { const lds_cptr vd_ = (vp_) + (((d) ^ vq) << 6); _Pragma("unroll") for (int ks = 0; ks < 4; ++ks) { const s16x4 lo_ = vtr(vd_ + ks * 4096), hi_ = vtr(vd_ + ks * 4096 + 2048); \
            dst[ks] = (bf16x8){lo_[0], lo_[1], lo_[2], lo_[3], hi_[0], hi_[1], hi_[2], hi_[3]}; } } while (0)
#define DF_PV4(src, d) do { _Pragma("unroll") for (int ks = 0; ks < 4; ++ks) oT[d] = __builtin_amdgcn_mfma_f32_32x32x16_bf16(src[ks], __builtin_bit_cast(bf16x8, pw[ks]), oT[d], 0, 0, 0); } while (0)
#define DF_LOADK(dst, kb_, dd) do { dst[0] = *(const LAS bf16x8*)((kb_) + ((((dd)) ^ ks2) << 5)); dst[1] = *(const LAS bf16x8*)((kb_) + ((((dd)) ^ ks2) << 5) + 4096); \
            dst[2] = *(const LAS bf16x8*)((kb_) + ((((dd) + 1) ^ ks2) << 5)); dst[3] = *(const LAS bf16x8*)((kb_) + ((((dd) + 1) ^ ks2) << 5) + 4096); } while (0)
#define DF_QK4(src, dd) do { p0 = __builtin_amdgcn_mfma_f32_32x32x16_bf16(src[0], qr[dd], p0, 0, 0, 0); p1 = __builtin_amdgcn_mfma_f32_32x32x16_bf16(src[1], qr[dd], p1, 0, 0, 0); \
            p0 = __builtin_amdgcn_mfma_f32_32x32x16_bf16(src[2], qr[(dd) + 1], p0, 0, 0, 0); p1 = __builtin_amdgcn_mfma_f32_32x32x16_bf16(src[3], qr[(dd) + 1], p1, 0, 0, 0); } while (0)
#define DF_PREV(vso) do { const lds_cptr vq_ = vp0 + (vso); DF_LOADV(fa, vq_, 0); DF_LOADV(fb, vq_, 1); SBAR(); } while (0)
#define DF_PINIT() do { _Pragma("unroll") for (int r = 0; r < 16; ++r) { p0[r] = -m; p1[r] = -m; } } while (0)
#define DF_SEGM(DO_PV, DO_QK, vso, kso) do { const lds_cptr vp_ = vp0 + (vso); const lds_cptr kb_ = kp0 + (kso); SBAR(); __builtin_amdgcn_s_setprio(1); \
        if (DO_PV) { DF_PV4(fa, 0); SBAR(); DF_LOADV(fa, vp_, 2); SBAR(); \
            DF_PV4(fb, 1); SBAR(); DF_LOADV(fb, vp_, 3); if (DO_QK) { DF_PINIT(); } SBAR(); \
            DF_PV4(fa, 2); SBAR(); if (DO_QK) { DF_LOADK(fa, kb_, 0); } SBAR(); \
            DF_PV4(fb, 3); SBAR(); if (DO_QK) { DF_LOADK(fb, kb_, 2); } SBAR(); } \
        else if (DO_QK) { DF_LOADK(fa, kb_, 0); DF_LOADK(fb, kb_, 2); DF_PINIT(); SBAR(); } \
        if (DO_QK) { DF_QK4(fa, 0); SBAR(); DF_QK4(fb, 2); SBAR(); } \
        __builtin_amdgcn_s_setprio(0); } while (0)
#define DF_SEGV(t) do { \
        float rm = p0[0]; \
        _Pragma("unroll") for (int r = 1; r < 16; ++r) rm = fmaxf(rm, p0[r]); \
        _Pragma("unroll") for (int r = 0; r < 16; ++r) rm = fmaxf(rm, p1[r]); \
        rm = hmax(rm); \
        if ((t) == 0 || __any(rm > DF_THR)) { const float dl = ((t) == 0) ? rm : fmaxf(rm, 0.f); m += dl; \
            _Pragma("unroll") for (int r = 0; r < 16; ++r) { p0[r] -= dl; p1[r] -= dl; } \
            const float f = __builtin_amdgcn_exp2f(-dl); l *= f; \
            _Pragma("unroll") for (int d = 0; d < 4; ++d) oT[d] = oT[d] * f; } \
        float s_ = 0.f; \
        _Pragma("unroll") for (int r = 0; r < 16; ++r) { p0[r] = __builtin_amdgcn_exp2f(p0[r]); p1[r] = __builtin_amdgcn_exp2f(p1[r]); s_ += p0[r] + p1[r]; } \
        l += s_; \
        _Pragma("unroll") for (int k = 0; k < 2; ++k) { \
            pw[k]     = (u32x4){cvtpk(p0[8 * k], p0[8 * k + 1]), cvtpk(p0[8 * k + 2], p0[8 * k + 3]), cvtpk(p0[8 * k + 4], p0[8 * k + 5]), cvtpk(p0[8 * k + 6], p0[8 * k + 7])}; \
            pw[2 + k] = (u32x4){cvtpk(p1[8 * k], p1[8 * k + 1]), cvtpk(p1[8 * k + 2], p1[8 * k + 3]), cvtpk(p1[8 * k + 4], p1[8 * k + 5]), cvtpk(p1[8 * k + 6], p1[8 * k + 7])}; } \
        } while (0)
        DF_BARV();
        int so_p = 0, so_c = 0;
#define DF_ROT() do { so_p = so_c; so_c = (so_c == 65536) ? 0 : so_c + 32768; } while (0)
        bf16x8 fa[4], fb[4];
        if (mp == 0) {
            DF_DMA(1); DF_SEGM(false, true, 0, so_c); SBAR(); DF_PREV(so_c); DF_SEGV(0); SBAR(); DF_BARV(); SBAR();
            for (int t = 1; t < NT; ++t) { DF_ROT();
                DF_DMA(t + 1); DF_SEGM(true, true, so_p, so_c); SBAR(); DF_PREV(so_c); DF_SEGV(t); SBAR(); DF_BARV(); SBAR(); }
            DF_ROT();
            DF_SEGM(true, false, so_p, 0); SBAR(); DF_BARV(); SBAR();
        } else {
            DF_DMA(1); DF_SEGM(false, true, 0, so_c); SBAR(); DF_BARV(); SBAR();
            for (int t = 1; t < NT; ++t) { DF_ROT();
                DF_DMA(t + 1); DF_PREV(so_p); DF_SEGV(t - 1); SBAR(); DF_SEGM(true, true, so_p, so_c); SBAR(); DF_BARV(); SBAR(); }
            DF_ROT();
            DF_PREV(so_p); DF_SEGV(NT - 1); SBAR(); DF_SEGM(true, false, so_p, 0); SBAR(); DF_BARV(); SBAR();
        }
#undef DF_ROT
        l = hsum(l);
        const float il = 1.f / l;
        if (mp == 1) { const float sc = il * A.lam;
#pragma unroll
            for (int d = 0; d < 4; ++d)
#pragma unroll
                for (int q = 0; q < 16; ++q) xch[(d * 16 + q) * 64] = oT[d][q] * sc; }
        DF_BARV();
        if (mp == 0) {
            float ss = 0.f;
#pragma unroll
            for (int d = 0; d < 4; ++d)
#pragma unroll
                for (int q = 0; q < 16; ++q) { const float v = oT[d][q] * il - xch[(d * 16 + q) * 64]; oT[d][q] = v; ss += v * v; }
            ss = hsum(ss);
            const float rstd = rsqrtf(ss * (1.f / 128.f) + RMS_EPS) * A.omli;
            const size_t eo = (size_t)(qrow0 + r32) * DM + h * 128;
#pragma unroll
            for (int d = 0; d < 4; ++d)
#pragma unroll
                for (int g = 0; g < 4; ++g) { const f32x4 gg = *(const f32x4*)(A.subln_g + d * 32 + 8 * g + 4 * hi);
                    if (OUTPROJ_FP8) { const float r8 = rstd * Y_SCALE; int t = 0; t = __builtin_amdgcn_cvt_pk_fp8_f32(oT[d][4 * g] * r8 * gg[0], oT[d][4 * g + 1] * r8 * gg[1], t, false);
                        t = __builtin_amdgcn_cvt_pk_fp8_f32(oT[d][4 * g + 2] * r8 * gg[2], oT[d][4 * g + 3] * r8 * gg[3], t, true);
                        *(unsigned*)((unsigned char*)A.y + eo + d * 32 + 8 * g + 4 * hi) = (unsigned)t; }
                    else { u32x2 w; w.x = cvtpk(oT[d][4 * g] * rstd * gg[0], oT[d][4 * g + 1] * rstd * gg[1]); w.y = cvtpk(oT[d][4 * g + 2] * rstd * gg[2], oT[d][4 * g + 3] * rstd * gg[3]);
                        *(u32x2*)(A.y + eo + d * 32 + 8 * g + 4 * hi) = w; } }
        }
        DF_BAR();
#undef DF_DMA
#undef DF_SEGM
#undef DF_SEGV
#undef DF_PINIT
#undef DF_PREV
#undef DF_LOADV
#undef DF_PV4
#undef DF_LOADK
#undef DF_QK4
    }
}

#define D3_PIN(x) asm volatile("" : "+v"(x))
#define D3_EX(v) __builtin_amdgcn_exp2f(v)
__device__ __forceinline__ void diff_phase3(LAS unsigned char* lds, const DiffArgs A, int vcu, int G) {
    int tid = threadIdx.x; asm volatile("" : "+v"(tid));
    const int lane = tid & 63, r32 = lane & 31, hi = lane >> 5; const int wid = __builtin_amdgcn_readfirstlane(tid >> 6);
    constexpr int P = 3072;
    const unsigned lds0 = (unsigned)(uintptr_t)lds;
    const lds_cptr l3 = (lds_cptr)lds;
    const int mp = wid >> 2, qsub = wid & 3;
    const int nmain = NB * 8 * 32, nunits = nmain + (A.with_ctx ? NB * 8 * 2 : 0);
    for (int u = vcu; u < nunits; u += G) {
        int b, h, qrow0, NT; const bool ctxu = u >= nmain;
        if (!ctxu) { const int qb = u & 31; h = (u >> 5) & 7; b = u >> 8; qrow0 = b * SEQ + 128 * qb + 32 * qsub; NT = 4 + 64; }
        else { const int v = u - nmain; const int qb = v & 1; h = (v >> 1) & 7; b = v >> 4; qrow0 = MX + b * CTXL + 128 * qb + 32 * qsub; NT = 4; }
        const bf16_t* Kc = A.qkv + (size_t)(MX + b * CTXL) * P + 1024 + 128 * h;
        const bf16_t* Kx = A.qkv + (size_t)(b * SEQ) * P + 1024 + 128 * h;
        const int kra = 16 * qsub + (lane >> 3), krb = kra + 8; const int vr0 = 16 * qsub + (lane >> 4); const int vph = lane & 15;
        const unsigned d0 = mp ? (unsigned)vr0 * P + 1024 + ((((vph >> 2) ^ (vr0 & 3)) << 2) | (vph & 3)) * 8 : (unsigned)kra * P + (((lane & 7) ^ ((kra >> 1) & 7)) * 8);
        const unsigned d1 = mp ? d0 + 4 * P : (unsigned)krb * P + (((lane & 7) ^ ((krb >> 1) & 7)) * 8);
        const unsigned inc2 = mp ? 8 * P : 64;
        const unsigned e0 = lds0 + (mp ? 32768 + qsub * 4096 : qsub * 2048), e2 = e0 + (mp ? 2048 : 8192);
#define D3_DMA(t) do { const int t_ = (t); if (t_ < NT) { const bf16_t* base_ = (t_ < 4) ? Kc + (size_t)t_ * 64 * P : Kx + (size_t)(t_ - 4) * 64 * P; \
        const unsigned so_ = (mp ? (t_ & 3) : (t_ & 1)) * 16384; \
        glds16(base_ + d0,        (unsigned)__builtin_amdgcn_readfirstlane(e0 + so_)); \
        glds16(base_ + d1,        (unsigned)__builtin_amdgcn_readfirstlane(e0 + so_ + 1024)); \
        glds16(base_ + d0 + inc2, (unsigned)__builtin_amdgcn_readfirstlane(e2 + so_)); \
        glds16(base_ + d1 + inc2, (unsigned)__builtin_amdgcn_readfirstlane(e2 + so_ + 1024)); } } while (0)
#define D3_WAITBAR(T) do { if (mp == 0 || (T) + 1 >= NT) DF_BARV(); else asm volatile("s_waitcnt vmcnt(4) lgkmcnt(0)\n\ts_barrier" ::: "memory"); } while (0)
        D3_DMA(0);
        bf16x8 qr[4];
        { const bf16_t* Qw = A.q + ((size_t)(qrow0 >> 5) * 16 + 2 * h + mp) * 2048 + hi * 256 + r32 * 8;
#pragma unroll
          for (int d0 = 0; d0 < 4; ++d0) qr[d0] = *(const bf16x8*)(Qw + d0 * 512); }
        f32x16 oT[4]; oT[0] = f32x16{}; oT[1] = f32x16{}; oT[2] = f32x16{}; oT[3] = f32x16{};
        f32x16 negm;
        float m = 0.f, l = 0.f, rf = 1.f; bool resc = false;
        f32x16 pA0, pA1, pB0, pB1; u32x4 pw0, pw1, pw2, pw3;
        const int ksw = (r32 >> 1) & 7; const lds_cptr kp0 = l3 + mp * 8192 + r32 * 128 + ((hi ^ (ksw & 1)) << 4); const int ks2 = ksw >> 1;
        const int vq = (lane & 15) >> 2; const lds_cptr vp0 = l3 + 32768 + (4 * hi + vq) * 256 + ((lane >> 4) & 1) * 32 + (lane & 3) * 8;
#define D3_KF(kb_, g) (*(const LAS bf16x8*)((kb_) + (((((g) >> 1)) ^ ks2) << 5) + ((g) & 1) * 4096))
#define D3_VF(vp_, g) ({ const lds_cptr vd_ = (vp_) + (((((g) >> 2)) ^ vq) << 6) + ((g) & 3) * 4096; const s16x4 lo_ = vtr(vd_), hi_ = vtr(vd_ + 2048); (bf16x8){lo_[0], lo_[1], lo_[2], lo_[3], hi_[0], hi_[1], hi_[2], hi_[3]}; })
#define D3_PK(P, B) cvtpk(P[B], P[(B) + 1])
#define D3_KSEL(g) (((g) & 1) ? kf1 : kf0)
#define D3_GA(g, C0, C1, Q0, Q1, HASQK, HASVA, FIRST) do { \
        if (HASQK) { \
            if ((g) == 0) { if (FIRST) C0 = __builtin_amdgcn_mfma_f32_32x32x16_bf16(D3_KSEL(g), qr[0], f32x16{}, 0, 0, 0); else C0 = __builtin_amdgcn_mfma_f32_32x32x16_bf16(D3_KSEL(g), qr[0], negm, 0, 0, 0); } \
            else if ((g) == 1) { if (FIRST) C1 = __builtin_amdgcn_mfma_f32_32x32x16_bf16(D3_KSEL(g), qr[0], f32x16{}, 0, 0, 0); else C1 = __builtin_amdgcn_mfma_f32_32x32x16_bf16(D3_KSEL(g), qr[0], negm, 0, 0, 0); } \
            else if ((g) & 1) C1 = __builtin_amdgcn_mfma_f32_32x32x16_bf16(D3_KSEL(g), qr[(g) >> 1], C1, 0, 0, 0); else C0 = __builtin_amdgcn_mfma_f32_32x32x16_bf16(D3_KSEL(g), qr[(g) >> 1], C0, 0, 0, 0); \
            if ((g) + 2 < 8) { if ((g) & 1) kf1 = D3_KF(kb_, (g) + 2); else kf0 = D3_KF(kb_, (g) + 2); } } \
        if (HASVA) { if ((g) == 6) vf0 = D3_VF(vp_, 0); if ((g) == 7) vf1 = D3_VF(vp_, 1); } \
        if (HASVA) { if ((g) < 5) { Q1[5 + 2 * (g)] = D3_EX(Q1[5 + 2 * (g)]); Q1[6 + 2 * (g)] = D3_EX(Q1[6 + 2 * (g)]); } if ((g) == 5) { Q1[15] = D3_EX(Q1[15]); } \
            if ((g) == 0) { pw0[0] = D3_PK(Q0, 0); pw0[1] = D3_PK(Q0, 2); } if ((g) == 1) { pw0[2] = D3_PK(Q0, 4); pw0[3] = D3_PK(Q0, 6); D3_PIN(pw0); } \
            if ((g) == 2) { pw1[0] = D3_PK(Q0, 8); pw1[1] = D3_PK(Q0, 10); } if ((g) == 3) { pw1[2] = D3_PK(Q0, 12); pw1[3] = D3_PK(Q0, 14); D3_PIN(pw1); } \
            if ((g) == 4) { pw2[0] = D3_PK(Q1, 0); pw2[1] = D3_PK(Q1, 2); } if ((g) == 5) { pw2[2] = D3_PK(Q1, 4); pw2[3] = D3_PK(Q1, 6); D3_PIN(pw2); } \
            if ((g) == 6) { pw3[0] = D3_PK(Q1, 8); pw3[1] = D3_PK(Q1, 10); } if ((g) == 7) { pw3[2] = D3_PK(Q1, 12); pw3[3] = D3_PK(Q1, 14); D3_PIN(pw3); } \
            } \
        SBAR(); } while (0)
#define D3_PWSEL(g) (((g) & 3) == 0 ? pw0 : ((g) & 3) == 1 ? pw1 : ((g) & 3) == 2 ? pw2 : pw3)
#define D3_EXI(C0, C1, e) do { if ((e) < 16) C0[(e) & 15] = D3_EX(C0[(e) & 15]); else C1[(e) & 15] = D3_EX(C1[(e) & 15]); } while (0)
#define D3_GB(g, C0, C1, Q0, Q1, HASPV, HASVB, FIRST) do { \
        if (HASPV) { \
            oT[(g) >> 2] = __builtin_amdgcn_mfma_f32_32x32x16_bf16(((g) & 1) ? vf1 : vf0, __builtin_bit_cast(bf16x8, D3_PWSEL(g)), oT[(g) >> 2], 0, 0, 0); \
            if ((g) + 2 < 16) { if ((g) & 1) vf1 = D3_VF(vp_, (g) + 2); else vf0 = D3_VF(vp_, (g) + 2); } } \
        if (HASPV) { if ((g) < 4) { sacc += Q0[4 * ((g) & 3)]; sacc += Q0[4 * ((g) & 3) + 1]; sacc += Q0[4 * ((g) & 3) + 2]; sacc += Q0[4 * ((g) & 3) + 3]; D3_PIN(sacc); } \
            else if ((g) < 8) { sacc += Q1[4 * ((g) & 3)]; sacc += Q1[4 * ((g) & 3) + 1]; sacc += Q1[4 * ((g) & 3) + 2]; sacc += Q1[4 * ((g) & 3) + 3]; D3_PIN(sacc); } \
            else if ((g) == 8) { l += sacc; } } \
        if (HASVB) { if ((g) < 4) { rmx = fmaxf(fmaxf(rmx, C0[4 * ((g) & 3)]), C0[4 * ((g) & 3) + 1]); rmx = fmaxf(fmaxf(rmx, C0[4 * ((g) & 3) + 2]), C0[4 * ((g) & 3) + 3]); D3_PIN(rmx); } \
            else if ((g) < 8) { rmx = fmaxf(fmaxf(rmx, C1[4 * ((g) & 3)]), C1[4 * ((g) & 3) + 1]); rmx = fmaxf(fmaxf(rmx, C1[4 * ((g) & 3) + 2]), C1[4 * ((g) & 3) + 3]); D3_PIN(rmx); } \
            else if ((g) == 8) { rmx = hmax(rmx); resc = false; \
                if (FIRST || __any(rmx > DF_THR)) { const float dl = FIRST ? rmx : fmaxf(rmx, 0.f); m += dl; \
                    _Pragma("unroll") for (int r_ = 0; r_ < 16; ++r_) { C0[r_] -= dl; C1[r_] -= dl; negm[r_] = -m; } D3_PIN(negm); \
                    rf = D3_EX(-dl); l *= rf; resc = true; } } \
            else { const int e0_ = 3 * ((g) - 9);   \
                D3_EXI(C0, C1, e0_); D3_EXI(C0, C1, e0_ + 1); D3_EXI(C0, C1, e0_ + 2); if (e0_ + 2 < 16) D3_PIN(C0); else D3_PIN(C1); } } \
        SBAR(); } while (0)
#define D3_STEP(C0, C1, Q0, Q1, HASQK, HASPREV, FIRST, T) do { \
        const lds_cptr kb_ = kp0 + ((T) & 1) * 16384; const lds_cptr vp_ = vp0 + (((T) - 1) & 3) * 16384; bf16x8 kf0, kf1, vf0, vf1; float sacc = 0.f, rmx = -3.0e38f; \
        if (HASQK) D3_DMA((T) + 1); \
        SBAR(); if (HASQK) { kf0 = D3_KF(kb_, 0); kf1 = D3_KF(kb_, 1); } \
        D3_GA(0, C0, C1, Q0, Q1, HASQK, HASPREV, FIRST); D3_GA(1, C0, C1, Q0, Q1, HASQK, HASPREV, FIRST); D3_GA(2, C0, C1, Q0, Q1, HASQK, HASPREV, FIRST); D3_GA(3, C0, C1, Q0, Q1, HASQK, HASPREV, FIRST); \
        D3_GA(4, C0, C1, Q0, Q1, HASQK, HASPREV, FIRST); D3_GA(5, C0, C1, Q0, Q1, HASQK, HASPREV, FIRST); D3_GA(6, C0, C1, Q0, Q1, HASQK, HASPREV, FIRST); D3_GA(7, C0, C1, Q0, Q1, HASQK, HASPREV, FIRST); \
        if (HASQK) { if (mp == 1) D3_WAITBAR(T); } \
        D3_GB(0, C0, C1, Q0, Q1, HASPREV, HASQK, FIRST); D3_GB(1, C0, C1, Q0, Q1, HASPREV, HASQK, FIRST); D3_GB(2, C0, C1, Q0, Q1, HASPREV, HASQK, FIRST); D3_GB(3, C0, C1, Q0, Q1, HASPREV, HASQK, FIRST); \
        D3_GB(4, C0, C1, Q0, Q1, HASPREV, HASQK, FIRST); D3_GB(5, C0, C1, Q0, Q1, HASPREV, HASQK, FIRST); D3_GB(6, C0, C1, Q0, Q1, HASPREV, HASQK, FIRST); D3_GB(7, C0, C1, Q0, Q1, HASPREV, HASQK, FIRST); \
        D3_GB(8, C0, C1, Q0, Q1, HASPREV, HASQK, FIRST); D3_GB(9, C0, C1, Q0, Q1, HASPREV, HASQK, FIRST); D3_GB(10, C0, C1, Q0, Q1, HASPREV, HASQK, FIRST); D3_GB(11, C0, C1, Q0, Q1, HASPREV, HASQK, FIRST); \
        D3_GB(12, C0, C1, Q0, Q1, HASPREV, HASQK, FIRST); D3_GB(13, C0, C1, Q0, Q1, HASPREV, HASQK, FIRST); D3_GB(14, C0, C1, Q0, Q1, HASPREV, HASQK, FIRST); D3_GB(15, C0, C1, Q0, Q1, HASPREV, HASQK, FIRST); \
        if (HASQK && resc) { _Pragma("unroll") for (int d_ = 0; d_ < 4; ++d_) oT[d_] = oT[d_] * rf; } \
        if (HASQK) { if (mp == 0) D3_WAITBAR(T); } \
        } while (0)
        DF_BARV();
        D3_STEP(pA0, pA1, pB0, pB1, true, false, true, 0);
        int t = 1;
        for (; t + 1 < NT; t += 2) {
            D3_STEP(pB0, pB1, pA0, pA1, true, true, false, t);
            D3_STEP(pA0, pA1, pB0, pB1, true, true, false, t + 1);
        }
        D3_STEP(pB0, pB1, pA0, pA1, true, true, false, t);
        D3_STEP(pA0, pA1, pB0, pB1, false, true, false, NT);
        l = hsum(l);
        const float il = 1.f / l;
        DF_BAR();
        LAS float* xch = (LAS float*)lds + qsub * 4096 + lane;
        if (mp == 1) { const float sc = il * A.lam;
#pragma unroll
            for (int d = 0; d < 4; ++d)
#pragma unroll
                for (int q = 0; q < 16; ++q) xch[(d * 16 + q) * 64] = oT[d][q] * sc; }
        DF_BAR();
        if (mp == 0) {
            float ss = 0.f;
#pragma unroll
            for (int d = 0; d < 4; ++d)
#pragma unroll
                for (int q = 0; q < 16; ++q) { const float v = oT[d][q] * il - xch[(d * 16 + q) * 64]; oT[d][q] = v; ss += v * v; }
            ss = hsum(ss);
            const float rstd = rsqrtf(ss * (1.f / 128.f) + RMS_EPS) * A.omli;
            LAS unsigned char* stg = lds + qsub * 16384;
#pragma unroll
            for (int d = 0; d < 4; ++d)
#pragma unroll
                for (int g = 0; g < 4; ++g) { const f32x4 gg = *(const f32x4*)(A.subln_g + d * 32 + 8 * g + 4 * hi);
                    u32x2 w; w.x = cvtpk(oT[d][4 * g] * rstd * gg[0], oT[d][4 * g + 1] * rstd * gg[1]); w.y = cvtpk(oT[d][4 * g + 2] * rstd * gg[2], oT[d][4 * g + 3] * rstd * gg[3]);
                    *(LAS u32x2*)(stg + r32 * 272 + (d * 32 + 8 * g + 4 * hi) * 2) = w; }
            stg_flush<4>(stg, A.y + (size_t)qrow0 * DM + h * 128, lane);
        }
        DF_BAR();
#undef D3_DMA
#undef D3_KF
#undef D3_KSEL
#undef D3_VF
#undef D3_PK
#undef D3_GA
#undef D3_GB
#undef D3_EXI
#undef D3_PWSEL
#undef D3_STEP
#undef D3_WAITBAR
    }
}

struct A2Args { const bf16_t* qkv; bf16_t* y; const float* aux; int with_ctx; const bf16_t* q; };
template <int MODE  >
__device__ __forceinline__ void att2_phase(LAS unsigned char* lds, const A2Args A, int vcu, int G) {
    int tid = threadIdx.x; asm volatile("" : "+v"(tid));
    const int lane = tid & 63, r32 = lane & 31, hi = lane >> 5; const int wid = __builtin_amdgcn_readfirstlane(tid >> 6);
    constexpr int P = MODE == 0 ? 1536 : 3072; constexpr int VOFF = MODE == 0 ? 256 : 1024;
    const unsigned lds0 = (unsigned)(uintptr_t)lds;
    const lds_cptr l3 = (lds_cptr)lds;
    const int grp = wid >> 2;
    LAS float* btab = (LAS float*)(lds + NA_BIAS_OFF + 1024);
    const int nmain = MODE == 0 ? NB * 4 * 32 * 2 : NB * 16 * 16;
    const int nunits = nmain + (A.with_ctx ? (MODE == 0 ? NB * 4 * 4 : NB * 16) : 0);
    for (int u = vcu; u < nunits; u += G) {
        int b, hk, hq, qrow0, nwin, k0win; const bool ctxu = u >= nmain; int qs = 0, r = 0, c = 0;
        if (MODE == 0) {
            if (!ctxu) { const int hp = u & 1, j = (u >> 1) & 31; hk = (u >> 6) & 3; b = u >> 8; hq = 4 * hk + 2 * hp + (wid >> 2); qs = 128 * j + 32 * (wid & 3); qrow0 = b * SEQ + qs;
                const int ks = max(0, 128 * (j - 1)), ke = min(SEQ, 128 * (j + 2)); k0win = ks; nwin = (ke - ks) / 64; }
            else { const int v = u - nmain; hk = (v >> 2) & 3; hq = 4 * hk + (v & 3); b = v >> 4; qrow0 = MX + b * CTXL + 32 * wid; nwin = 0; k0win = 0; }
        } else {
            if (!ctxu) { const int uu = u & 15; hk = hq = (u >> 4) & 15; b = u >> 8; r = 4 * uu + (wid >> 1); c = 32 * (wid & 1) + r32; qrow0 = b * SEQ + r * 64 + 32 * (wid & 1);
                const int rs_lo = min(max(4 * uu - 4, 0), 56), rs_hi = min(max(4 * uu + 3 - 4, 0), 56); k0win = rs_lo * 64; nwin = rs_hi + 8 - rs_lo; }
            else { const int v = u - nmain; hk = hq = v & 15; b = v >> 4; qrow0 = MX + b * CTXL + 32 * wid; nwin = 0; k0win = 0; }
        }
        const int NT = 4 + nwin;
        const bf16_t* Kc = A.qkv + (size_t)(MX + b * CTXL) * P + 1024 + 64 * hk;
        const bf16_t* Kx = A.qkv + (size_t)(b * SEQ + k0win) * P + 1024 + 64 * hk;
        const int krow = 8 * wid + (lane >> 3); const size_t koff = (size_t)krow * P + (((lane & 7) ^ ((krow >> 1) & 7)) * 8), voff = (size_t)krow * P + VOFF + (((lane & 7) ^ (((krow >> 1) & 1) << 2)) * 8);
#define A2_DMA(t) do { if ((t) < NT) { const int slot_ = (t) % 3; const bf16_t* base_ = ((t) < 4) ? Kc + (size_t)(t) * 64 * P : Kx + (size_t)((t) - 4) * 64 * P; \
        glds16(base_ + koff, (unsigned)__builtin_amdgcn_readfirstlane(lds0 + slot_ * 16384 + wid * 1024)); \
        glds16(base_ + voff, (unsigned)__builtin_amdgcn_readfirstlane(lds0 + slot_ * 16384 + 8192 + wid * 1024)); } } while (0)
        A2_DMA(0);
        if (MODE == 1) { if (!ctxu && tid < 15 * 31) btab[tid] = A.aux[hq * 465 + tid] * LOG2E; }
        bf16x8 qr[4];
        { const bf16_t* Qw = A.q + ((size_t)(qrow0 >> 5) * 16 + hq) * 2048 + hi * 256 + r32 * 8;
#pragma unroll
          for (int d0 = 0; d0 < 4; ++d0) qr[d0] = *(const bf16x8*)(Qw + d0 * 512); }
        f32x16 oT[2]; oT[0] = f32x16{}; oT[1] = f32x16{};
        float m = 0.f, l = 0.f;
        f32x16 p0, p1; u32x4 pw[4];
        const int ksw = (r32 >> 1) & 7; const lds_cptr kp0 = l3 + r32 * 128 + ((hi ^ (ksw & 1)) << 4); const int ks2 = ksw >> 1;
        const int vq = (lane & 15) >> 2, vsq = (vq >> 1) & 1; const lds_cptr vp0 = l3 + 8192 + (4 * hi + vq) * 128 + ((lane >> 4) & 1) * 32 + (lane & 3) * 8;
        const int rs = min(max(r - 4, 0), 56), cs = min(max(c - 8, 0), 48);
#define A2_LOADV(dst, vp_, d) do { const lds_cptr vd_ = (vp_) + (((d) ^ vsq) << 6); _Pragma("unroll") for (int ks = 0; ks < 4; ++ks) { const s16x4 lo_ = vtr(vd_ + ks * 2048), hi_ = vtr(vd_ + ks * 2048 + 1024); \
            dst[ks] = (bf16x8){lo_[0], lo_[1], lo_[2], lo_[3], hi_[0], hi_[1], hi_[2], hi_[3]}; } } while (0)
#define A2_PV4(src, d) do { _Pragma("unroll") for (int ks = 0; ks < 4; ++ks) oT[d] = __builtin_amdgcn_mfma_f32_32x32x16_bf16(src[ks], __builtin_bit_cast(bf16x8, pw[ks]), oT[d], 0, 0, 0); } while (0)
#define A2_LOADK(dst, kb_, dd) do { dst[0] = *(const LAS bf16x8*)((kb_) + ((((dd)) ^ ks2) << 5)); dst[1] = *(const LAS bf16x8*)((kb_) + ((((dd)) ^ ks2) << 5) + 4096); \
            dst[2] = *(const LAS bf16x8*)((kb_) + ((((dd) + 1) ^ ks2) << 5)); dst[3] = *(const LAS bf16x8*)((kb_) + ((((dd) + 1) ^ ks2) << 5) + 4096); } while (0)
#define A2_QK4(src, dd) do { p0 = __builtin_amdgcn_mfma_f32_32x32x16_bf16(src[0], qr[dd], p0, 0, 0, 0); p1 = __builtin_amdgcn_mfma_f32_32x32x16_bf16(src[1], qr[dd], p1, 0, 0, 0); \
            p0 = __builtin_amdgcn_mfma_f32_32x32x16_bf16(src[2], qr[(dd) + 1], p0, 0, 0, 0); p1 = __builtin_amdgcn_mfma_f32_32x32x16_bf16(src[3], qr[(dd) + 1], p1, 0, 0, 0); } while (0)
#define A2_PREV(vso) do { const lds_cptr vq_ = vp0 + (vso); A2_LOADV(fa, vq_, 0); A2_LOADV(fb, vq_, 1); SBAR(); } while (0)
#define A2_PINIT() do { _Pragma("unroll") for (int q_ = 0; q_ < 16; ++q_) { p0[q_] = -m; p1[q_] = -m; } } while (0)
#define A2_SEGM(DO_PV, DO_QK, vso, kso) do { const lds_cptr kb_ = kp0 + (kso); SBAR(); __builtin_amdgcn_s_setprio(1); \
        if (DO_PV) { A2_PV4(fa, 0); if (DO_QK) { A2_PINIT(); } SBAR(); if (DO_QK) { A2_LOADK(fa, kb_, 0); } SBAR(); A2_PV4(fb, 1); SBAR(); if (DO_QK) { A2_LOADK(fb, kb_, 2); } SBAR(); } \
        else if (DO_QK) { A2_LOADK(fa, kb_, 0); A2_LOADK(fb, kb_, 2); A2_PINIT(); SBAR(); } \
        if (DO_QK) { A2_QK4(fa, 0); SBAR(); A2_QK4(fb, 2); SBAR(); } \
        __builtin_amdgcn_s_setprio(0); } while (0)
#define A2_SEGV(t) do { \
        if ((t) >= 4) { \
            if (MODE == 0) { const int kb0_ = k0win + 64 * ((t) - 4); if ((kb0_ + 63 > qs + 128) || (kb0_ < qs + 31 - 128)) { const int dq_ = kb0_ + 4 * hi - (qs + r32) + 128; \
                _Pragma("unroll") for (int q_ = 0; q_ < 16; ++q_) { const int kk_ = (q_ & 3) + 8 * (q_ >> 2); if ((unsigned)(dq_ + kk_) > 256u) p0[q_] = NEG_BIG; if ((unsigned)(dq_ + kk_ + 32) > 256u) p1[q_] = NEG_BIG; } } } \
            else { const int kr_ = (k0win >> 6) + (t) - 4; const bool rowok_ = (kr_ >= rs) && (kr_ < rs + 8); const int rel_ = rowok_ ? 4 * hi - cs : 1000; const LAS float* bp_ = btab + (rowok_ ? kr_ - r + 7 : 0) * 31 + 4 * hi - c + 15; \
                _Pragma("unroll") for (int q_ = 0; q_ < 16; ++q_) { const int kk_ = (q_ & 3) + 8 * (q_ >> 2); const float b0_ = bp_[kk_], b1_ = bp_[kk_ + 32]; \
                    p0[q_] = ((unsigned)(rel_ + kk_) < 16u) ? p0[q_] + b0_ : NEG_BIG; p1[q_] = ((unsigned)(rel_ + kk_ + 32) < 16u) ? p1[q_] + b1_ : NEG_BIG; } } } \
        float rm = p0[0]; \
        _Pragma("unroll") for (int q_ = 1; q_ < 16; ++q_) rm = fmaxf(rm, p0[q_]); \
        _Pragma("unroll") for (int q_ = 0; q_ < 16; ++q_) rm = fmaxf(rm, p1[q_]); \
        rm = hmax(rm); \
        if ((t) == 0 || __any(rm > DF_THR)) { const float dl = ((t) == 0) ? rm : fmaxf(rm, 0.f); m += dl; \
            _Pragma("unroll") for (int q_ = 0; q_ < 16; ++q_) { p0[q_] -= dl; p1[q_] -= dl; } \
            const float f = __builtin_amdgcn_exp2f(-dl); l *= f; oT[0] = oT[0] * f; oT[1] = oT[1] * f; } \
        float s_ = 0.f; \
        _Pragma("unroll") for (int q_ = 0; q_ < 16; ++q_) { p0[q_] = __builtin_amdgcn_exp2f(p0[q_]); p1[q_] = __builtin_amdgcn_exp2f(p1[q_]); s_ += p0[q_] + p1[q_]; } \
        l += s_; \
        _Pragma("unroll") for (int k = 0; k < 2; ++k) { \
            pw[k]     = (u32x4){cvtpk(p0[8 * k], p0[8 * k + 1]), cvtpk(p0[8 * k + 2], p0[8 * k + 3]), cvtpk(p0[8 * k + 4], p0[8 * k + 5]), cvtpk(p0[8 * k + 6], p0[8 * k + 7])}; \
            pw[2 + k] = (u32x4){cvtpk(p1[8 * k], p1[8 * k + 1]), cvtpk(p1[8 * k + 2], p1[8 * k + 3]), cvtpk(p1[8 * k + 4], p1[8 * k + 5]), cvtpk(p1[8 * k + 6], p1[8 * k + 7])}; } \
        } while (0)
        DF_BARV();
        int so_p = 0, so_c = 0;
#define A2_ROT() do { so_p = so_c; so_c = (so_c == 32768) ? 0 : so_c + 16384; } while (0)
        bf16x8 fa[4], fb[4];
        if (grp == 0) {
            A2_DMA(1); A2_SEGM(false, true, 0, so_c); SBAR(); A2_PREV(so_c); A2_SEGV(0); SBAR(); DF_BARV(); SBAR();
            for (int t = 1; t < NT; ++t) { A2_ROT();
                A2_DMA(t + 1); A2_SEGM(true, true, so_p, so_c); SBAR(); A2_PREV(so_c); A2_SEGV(t); SBAR(); DF_BARV(); SBAR(); }
            A2_ROT();
            A2_SEGM(true, false, so_p, 0); SBAR(); DF_BARV(); SBAR();
        } else {
            A2_DMA(1); A2_SEGM(false, true, 0, so_c); SBAR(); DF_BARV(); SBAR();
            for (int t = 1; t < NT; ++t) { A2_ROT();
                A2_DMA(t + 1); A2_PREV(so_p); A2_SEGV(t - 1); SBAR(); A2_SEGM(true, true, so_p, so_c); SBAR(); DF_BARV(); SBAR(); }
            A2_ROT();
            A2_PREV(so_p); A2_SEGV(NT - 1); SBAR(); A2_SEGM(true, false, so_p, 0); SBAR(); DF_BARV(); SBAR();
        }
        l = hsum(l);
        if (MODE == 0) l += __builtin_amdgcn_exp2f(A.aux[hq] * LOG2E - m);
        if (OUTPROJ_FP8) store_oT<2>(oT, 1.f / l, A.y, (size_t)(qrow0 + r32) * DM + hq * 64, hi);
        else { LAS unsigned char* stg = lds + wid * 8192; const float sc_ = 1.f / l;
#pragma unroll
            for (int d = 0; d < 2; ++d)
#pragma unroll
                for (int g = 0; g < 4; ++g) { u32x2 w; w.x = cvtpk(oT[d][4 * g] * sc_, oT[d][4 * g + 1] * sc_); w.y = cvtpk(oT[d][4 * g + 2] * sc_, oT[d][4 * g + 3] * sc_);
                    *(LAS u32x2*)(stg + r32 * 144 + (d * 32 + 8 * g + 4 * hi) * 2) = w; }
            stg_flush<2>(stg, A.y + (size_t)qrow0 * DM + hq * 64, lane); }
        DF_BAR();
#undef A2_DMA
#undef A2_LOADV
#undef A2_PV4
#undef A2_LOADK
#undef A2_QK4
#undef A2_SEGM
#undef A2_SEGV
#undef A2_PREV
#undef A2_PINIT
#undef A2_ROT
    }
}
#undef SBAR
}

struct Frame {
    LAS unsigned char* lds; volatile LAS unsigned* MISC; unsigned* ctl;
    int tid, lane, wave, vcu, G;
};

__device__ __forceinline__ void transpose_item(const float* W, int K, int N, bf16_t* WT, int k0, int n0, int drow0, LAS float* scr, int lane) {
    f32x4 v[16];
    const float* src = W + (size_t)(k0 + (lane >> 4)) * N + n0 + 4 * (lane & 15);
#pragma unroll
    for (int i = 0; i < 16; ++i) v[i] = *(const f32x4*)(src + (size_t)(4 * i) * N);
#pragma unroll
    for (int i = 0; i < 16; ++i) { LAS float* d = scr + (4 * i + (lane >> 4)) * 65 + 4 * (lane & 15); d[0] = v[i].x; d[1] = v[i].y; d[2] = v[i].z; d[3] = v[i].w; }
    LDS_WAIT(); asm volatile("" ::: "memory");
    const int c = lane & 7;
#pragma unroll
    for (int j = 0; j < 8; ++j) { const int n = (lane >> 3) + 8 * j; const LAS float* s = scr + (8 * c) * 65 + n;
        u32x4 o; o.x = cvtpk(s[0 * 65], s[1 * 65]); o.y = cvtpk(s[2 * 65], s[3 * 65]); o.z = cvtpk(s[4 * 65], s[5 * 65]); o.w = cvtpk(s[6 * 65], s[7 * 65]);
        *(u32x4*)(WT + (size_t)(drow0 + n) * K + k0 + 8 * c) = o; }
    LDS_WAIT(); asm volatile("" ::: "memory");
}

enum { KA_x, KA_c, KA_ctx, KA_c_ctx, KA_ada_w, KA_ada_b, KA_norm1_g, KA_norm2_g, KA_final_g, KA_win_w_in, KA_win_w_out, KA_win_sink, KA_diff_w_in, KA_diff_w_out, KA_diff_lambda, KA_diff_subln_g,
       KA_na_w_in, KA_na_w_out, KA_na_rpb, KA_router_w, KA_w_gate, KA_w_up, KA_w_down, KA_OUT, KA_WS };
__device__ __forceinline__ const float* karg(int i) { asm volatile("" : "+s"(i)); return (const float*)(((const unsigned long long __attribute__((address_space(4)))*)__builtin_amdgcn_kernarg_segment_ptr())[i]); }
__device__ __forceinline__ void t8_load(f32x4 (&v)[16], const float* W, int N, int k0, int n0, int lane) {
    const float* src = W + (size_t)(k0 + (lane >> 4)) * N + n0 + 4 * (lane & 15);
#pragma unroll
    for (int i = 0; i < 16; ++i) v[i] = *(const f32x4*)(src + (size_t)(4 * i) * N);
}
__device__ __forceinline__ void t8_finish(const f32x4 (&v)[16], int Kb, unsigned char* WT, int k0, int drow0, LAS float* scr, int lane) {
#pragma unroll
    for (int i = 0; i < 16; ++i) { LAS float* d = scr + (4 * i + (lane >> 4)) * 65 + 4 * (lane & 15); d[0] = v[i].x * W8_SCALE; d[1] = v[i].y * W8_SCALE; d[2] = v[i].z * W8_SCALE; d[3] = v[i].w * W8_SCALE; }
    LDS_WAIT(); asm volatile("" ::: "memory");
    const int c = lane & 3;
#pragma unroll
    for (int j = 0; j < 4; ++j) { const int n = (lane >> 2) + 16 * j; const LAS float* s = scr + (16 * c) * 65 + n;
        int w[4];
#pragma unroll
        for (int q = 0; q < 4; ++q) { int t = 0; t = __builtin_amdgcn_cvt_pk_fp8_f32(s[(4 * q) * 65], s[(4 * q + 1) * 65], t, false); t = __builtin_amdgcn_cvt_pk_fp8_f32(s[(4 * q + 2) * 65], s[(4 * q + 3) * 65], t, true); w[q] = t; }
        *(u32x4*)(WT + (size_t)(drow0 + n) * Kb + k0 + 16 * c) = (u32x4){(unsigned)w[0], (unsigned)w[1], (unsigned)w[2], (unsigned)w[3]}; }
    LDS_WAIT(); asm volatile("" ::: "memory");
}
__device__ __forceinline__ void transpose_item8(const float* W, int Kb, int N, unsigned char* WT, int k0, int n0, int drow0, LAS float* scr, int lane) {
    f32x4 v[16]; t8_load(v, W, N, k0, n0, lane); t8_finish(v, Kb, WT, k0, drow0, scr, lane);
}

struct In {
    const float *x, *c, *ctx, *c_ctx, *ada_w, *ada_b, *norm1_g, *norm2_g, *final_g, *win_w_in, *win_w_out, *win_sink, *diff_w_in, *diff_w_out, *diff_lambda, *diff_subln_g,
        *na_w_in, *na_w_out, *na_rpb, *router_w, *w_gate, *w_up, *w_down;
};

__device__ __forceinline__ void phase_prologue(Frame& F, unsigned char* ws) {
    int tid_ = threadIdx.x; asm volatile("" : "+v"(tid_)); const int lane_ = tid_ & 63; const int wave_ = __builtin_amdgcn_readfirstlane(tid_ >> 6);
    LAS float* scr = (LAS float*)(F.lds + wave_ * 16640);
    const int gw = F.vcu * NWAVES + wave_, NGW = F.G * NWAVES;
    if (F.vcu == 0) {
        float* tab = (float*)(ws + WS_TAB);
        for (int i = tid_; i < 1024; i += 512) { const int pos = i >> 4, f = i & 15; const float inv = 1.0f / powf(10000.0f, (float)(2 * f) / 32.0f); const float ang = (float)pos * inv;
            tab[TAB_COS + i] = cosf(ang); tab[TAB_SIN + i] = sinf(ang); }
        if (wave_ == 0) { const float* lp = karg(KA_diff_lambda); const float a = wave_sum(lp[lane_] * lp[64 + lane_]), b2 = wave_sum(lp[128 + lane_] * lp[192 + lane_]);
            const float li = 0.8f - 0.6f * expf(-0.3f * 1.0f); if (lane_ == 0) { tab[TAB_LAM] = expf(a) - expf(b2) + li; tab[TAB_LAM + 1] = 1.0f - li; } }
    }
    {
        bf16_t* pw = (bf16_t*)(ws + WS_PW);
        constexpr int IT_WI = 16 * 24, IT_O = 16 * 16, IT_3 = 16 * 48;
        constexpr int NIT = 2 * IT_WI + 2 * IT_O + IT_3 + IT_O + IT_3 + IT_O;
        for (int it = gw; it < NIT; it += NGW) {
            int r = it; const float* W; bf16_t* WT; int N;
            if (r < 2 * IT_WI) { const int s = r / IT_WI; r -= s * IT_WI; W = karg(KA_win_w_in) + (size_t)s * 1024 * 1536; WT = pw + (PW_WIN_IN / 2) + (size_t)s * 1536 * 1024; N = 1536; }
            else if ((r -= 2 * IT_WI) < 2 * IT_O) { const int s = r / IT_O; r -= s * IT_O; W = karg(KA_win_w_out) + (size_t)s * 1024 * 1024; WT = pw + (PW_WIN_OUT / 2) + (size_t)s * 1024 * 1024; N = 1024; }
            else if ((r -= 2 * IT_O) < IT_3) { W = karg(KA_diff_w_in); WT = pw + PW_DIFF_IN / 2; N = 3072; }
            else if ((r -= IT_3) < IT_O) { W = karg(KA_diff_w_out); WT = pw + PW_DIFF_OUT / 2; N = 1024; }
            else if ((r -= IT_O) < IT_3) { W = karg(KA_na_w_in); WT = pw + PW_NA_IN / 2; N = 3072; }
            else { r -= IT_3; W = karg(KA_na_w_out); WT = pw + PW_NA_OUT / 2; N = 1024; }
            const int nblk = N / 64, kb = r / nblk, nb = r % nblk;
            if ((INPROJ_FP8 && N != 1024) || (OUTPROJ_FP8 && N == 1024)) transpose_item8(W, 1024, N, (unsigned char*)WT, 64 * kb, 64 * nb, 64 * nb, scr, lane_);
            else transpose_item(W, 1024, N, WT, 64 * kb, 64 * nb, 64 * nb, scr, lane_);
        }
    }
    {
        const int NIT = 64 * 1536;
#define MW_DESC(it_, W_, N_, Kb_, WT_, k0_, n0_, dr_) do { const int le_ = (it_) / 1536; int r_ = (it_) % 1536; \
            unsigned char* W1t_ = ws + WS_MOEW + (size_t)le_ * MOEW_E; \
            if (r_ < 1024) { const bool up_ = r_ >= 512; r_ &= 511; W_ = (up_ ? karg(KA_w_up) : karg(KA_w_gate)) + (size_t)le_ * 1024 * 2048; N_ = 2048; Kb_ = 1024; WT_ = W1t_; \
                k0_ = 64 * (r_ / 32); n0_ = 64 * (r_ % 32); dr_ = (n0_ >> 7) * 256 + (up_ ? 128 : 0) + (n0_ & 127); } \
            else { r_ -= 1024; W_ = karg(KA_w_down) + (size_t)le_ * 2048 * 1024; N_ = 1024; Kb_ = 2048; WT_ = W1t_ + (size_t)4096 * 1024; k0_ = 64 * (r_ / 16); n0_ = 64 * (r_ % 16); dr_ = n0_; } } while (0)
        f32x4 va[16], vb[16];
        const float* Wc = nullptr; int Nc = 0, Kbc = 0, k0c = 0, n0c = 0, drc = 0; unsigned char* WTc = nullptr;
        int it = gw;
        if (it < NIT) { MW_DESC(it, Wc, Nc, Kbc, WTc, k0c, n0c, drc); t8_load(va, Wc, Nc, k0c, n0c, lane_); }
        while (it < NIT) {
            const int itn = it + NGW;
            const float* Wn = Wc; int Nn = Nc, Kbn = Kbc, k0n = k0c, n0n = n0c, drn = drc; unsigned char* WTn = WTc;
            if (itn < NIT) { MW_DESC(itn, Wn, Nn, Kbn, WTn, k0n, n0n, drn); t8_load(vb, Wn, Nn, k0n, n0n, lane_); }
            t8_finish(va, Kbc, WTc, k0c, drc, scr, lane_);
#pragma unroll
            for (int i = 0; i < 16; ++i) va[i] = vb[i];
            Wc = Wn; Nc = Nn; Kbc = Kbn; WTc = WTn; k0c = k0n; n0c = n0n; drc = drn; it = itn;
        }
#undef MW_DESC
    }
    __syncthreads();
    {
        LAS float* sc = (LAS float*)F.lds;
        LAS float* red = (LAS float*)(F.lds + 69632);
        for (int i = tid_; i < 17 * 1024; i += 512) { const float v = (i < 16384) ? karg(KA_c)[i] : karg(KA_c_ctx)[i - 16384]; sc[i] = siluf(v); }
        __syncthreads();
        float* mod = (float*)(ws + WS_MOD);
        for (int task = F.vcu; task < 4 * 192; task += F.G) {
            const int L = task / 192, cg = task % 192, col = cg * 32 + (lane_ & 31), kh = lane_ >> 5;
            const float* wp = karg(KA_ada_w) + (size_t)L * 1024 * 6144 + (size_t)(wave_ * 128 + kh * 64) * 6144 + col;
            const LAS float* scp = sc + wave_ * 128 + kh * 64;
            float acc[17];
#pragma unroll
            for (int r = 0; r < 17; ++r) acc[r] = 0.f;
            for (int k0 = 0; k0 < 64; k0 += 16) { float w[16];
#pragma unroll
                for (int kk = 0; kk < 16; ++kk) w[kk] = wp[(size_t)(k0 + kk) * 6144];
#pragma unroll
                for (int kk = 0; kk < 16; ++kk)
#pragma unroll
                    for (int r = 0; r < 17; ++r) acc[r] += scp[r * 1024 + k0 + kk] * w[kk]; }
#pragma unroll
            for (int r = 0; r < 17; ++r) { acc[r] += __shfl_xor(acc[r], 32); if (lane_ < 32) red[(wave_ * 17 + r) * 32 + lane_] = acc[r]; }
            __syncthreads();
            for (int i = tid_; i < 17 * 32; i += 512) { const int r = i >> 5, ln = i & 31; float sum = 0.f;
#pragma unroll
                for (int w = 0; w < 8; ++w) sum += red[(w * 17 + r) * 32 + ln];
                mod[((size_t)L * 17 + r) * 6144 + cg * 32 + ln] = sum + karg(KA_ada_b)[L * 6144 + cg * 32 + ln]; }
            __syncthreads();
        }
    }
}

__device__ __forceinline__ void load_row(const float* row, int lane, f32x4 (&v)[4]) {
    const f32x4* xr = (const f32x4*)row + lane;
#pragma unroll
    for (int j = 0; j < 4; ++j) v[j] = xr[64 * j];
}
__device__ __forceinline__ void load_row_bf16(const bf16_t* row, int lane, u32x2 (&w)[4]) {
    const u32x2* p = (const u32x2*)row + lane;
#pragma unroll
    for (int j = 0; j < 4; ++j) w[j] = p[64 * j];
}
__device__ __forceinline__ void cvt_row_bf16(f32x4 (&v)[4], const u32x2 (&w)[4]) {
#pragma unroll
    for (int j = 0; j < 4; ++j) { v[j].x = __builtin_bit_cast(float, w[j].x << 16); v[j].y = __builtin_bit_cast(float, w[j].x & 0xffff0000u);
        v[j].z = __builtin_bit_cast(float, w[j].y << 16); v[j].w = __builtin_bit_cast(float, w[j].y & 0xffff0000u); }
}
__device__ __forceinline__ void add_row_bf16(f32x4 (&v)[4], const u32x2 (&w)[4]) {
#pragma unroll
    for (int j = 0; j < 4; ++j) { v[j].x += __builtin_bit_cast(float, w[j].x << 16); v[j].y += __builtin_bit_cast(float, w[j].x & 0xffff0000u);
        v[j].z += __builtin_bit_cast(float, w[j].y << 16); v[j].w += __builtin_bit_cast(float, w[j].y & 0xffff0000u); }
}
__device__ __forceinline__ float row_rstd(const f32x4 (&v)[4]) {
    float s = 0.f;
#pragma unroll
    for (int j = 0; j < 4; ++j) s += (v[j].x * v[j].x + v[j].y * v[j].y) + (v[j].z * v[j].z + v[j].w * v[j].w);
    return rsqrtf(wave_sum_fast(s) * (1.f / DM) + RMS_EPS);
}
__device__ __forceinline__ void store_row_bf16(bf16_t* orow, int lane, const f32x4 (&v)[4]) {
    u32x2* o8 = (u32x2*)orow + lane;
#pragma unroll
    for (int j = 0; j < 4; ++j) { u32x2 w; w.x = cvtpk(v[j].x, v[j].y); w.y = cvtpk(v[j].z, v[j].w); o8[64 * j] = w; }
}
__device__ __forceinline__ void store_row_fp8(unsigned char* orow, int lane, const f32x4 (&v)[4], float scale) {
    unsigned* o4 = (unsigned*)orow + lane;
#pragma unroll
    for (int j = 0; j < 4; ++j) { int t = 0; t = __builtin_amdgcn_cvt_pk_fp8_f32(v[j].x * scale, v[j].y * scale, t, false); t = __builtin_amdgcn_cvt_pk_fp8_f32(v[j].z * scale, v[j].w * scale, t, true); o4[64 * j] = (unsigned)t; }
}
struct ModCache { f32x4 sc[4], sh[4]; int b; };
__device__ __forceinline__ void modcache_load(ModCache& M, int b, const float* g, const float* modL, int shift_chunk, int scale_chunk, int lane) {
    if (M.b == b) return; M.b = b;
    const float* mp = modL + (size_t)b * 6144;
#pragma unroll
    for (int j = 0; j < 4; ++j) { const f32x4 gg = ((const f32x4*)g)[lane + 64 * j], s = ((const f32x4*)(mp + scale_chunk * DM))[lane + 64 * j];
        M.sc[j] = gg * (1.f + s); M.sh[j] = ((const f32x4*)(mp + shift_chunk * DM))[lane + 64 * j]; }
}
__device__ __forceinline__ int row_batch(int m) { return m < MX ? (m >> 12) : 16; }

__device__ __forceinline__ void phase_norm1(Frame& F, const float* x, const float* ctx, const float* g1, const float* modL, bf16_t* H, bf16_t* XB) {
    int tid_ = threadIdx.x; asm volatile("" : "+v"(tid_)); const int lane_ = tid_ & 63; const int wave_ = __builtin_amdgcn_readfirstlane(tid_ >> 6);
    const int gw = F.vcu * NWAVES + wave_, NGW = F.G * NWAVES; const int per = (MT + NGW - 1) / NGW;
    ModCache M; M.b = -1;
    const int m0 = gw * per, m1 = min(MT, m0 + per);
    f32x4 nx[4];
    if (m0 < m1) load_row(m0 < MX ? x + (size_t)m0 * DM : ctx + (size_t)(m0 - MX) * DM, lane_, nx);
    for (int m = m0; m < m1; ++m) {
        f32x4 v[4];
#pragma unroll
        for (int j = 0; j < 4; ++j) v[j] = nx[j];
        if (m + 1 < m1) load_row((m + 1) < MX ? x + (size_t)(m + 1) * DM : ctx + (size_t)(m + 1 - MX) * DM, lane_, nx);
        modcache_load(M, row_batch(m), g1, modL, 0, 1, lane_);
        store_row_bf16(XB + (size_t)m * DM, lane_, v);
        const float rstd = row_rstd(v);
#pragma unroll
        for (int j = 0; j < 4; ++j) v[j] = v[j] * rstd * M.sc[j] + M.sh[j];
        if (INPROJ_FP8) store_row_fp8((unsigned char*)H + (size_t)m * DM, lane_, v, H2_SCALE); else store_row_bf16(H + (size_t)m * DM, lane_, v);
    }
}

__device__ __forceinline__ void phase_norm2_router(Frame& F, const bf16_t* XB, const float* g2, const float* modL, const float* rw, unsigned char* H8, float* aff, int nrows, const bf16_t* P, bool do_router = true) {
    int tid_ = threadIdx.x; asm volatile("" : "+v"(tid_)); const int lane = tid_ & 63; const int wave_ = __builtin_amdgcn_readfirstlane(tid_ >> 6);
    LAS float* rwT = (LAS float*)F.lds;
    for (int i = tid_; i < 16384; i += 512) { const int d = i >> 4, e = i & 15; rwT[e * 1024 + d] = rw[i]; }
    __syncthreads();
    const int gw = F.vcu * NWAVES + wave_, NGW = F.G * NWAVES; constexpr int NR2 = 1; const int ngroups = nrows / NR2; const int per = (ngroups + NGW - 1) / NGW;
    ModCache M; M.b = -1;
    const int g0 = gw * per, g1 = min(ngroups, g0 + per);
    constexpr int ND3 = 3;
    u32x2 nx[ND3][4];
#pragma unroll
    for (int k = 0; k < ND3; ++k) if (g0 + k < g1) { load_row_bf16(XB + (size_t)(g0 + k) * DM, lane, nx[k]); }
    for (int gb = g0; gb < g1; gb += ND3)
#pragma unroll
    for (int k = 0; k < ND3; ++k) {
        const int g = gb + k; if (g >= g1) break;
        const int m = NR2 * g;
        f32x4 v[NR2][4];
        cvt_row_bf16(v[0], nx[k]);
        if (g + ND3 < g1) { load_row_bf16(XB + (size_t)(g + ND3) * DM, lane, nx[k]); }
        modcache_load(M, row_batch(m), g2, modL, 3, 4, lane);
#pragma unroll
        for (int r = 0; r < NR2; ++r) { const float rstd = row_rstd(v[r]);
#pragma unroll
            for (int j = 0; j < 4; ++j) v[r][j] = v[r][j] * rstd * M.sc[j] + M.sh[j];
            store_row_fp8(H8 + (size_t)(m + r) * DM, lane, v[r], H2_SCALE); }
        if (!do_router) continue;
        float pe[NR2][16];
        int lo4 = 4 * lane; asm volatile("" : "+v"(lo4));
#pragma unroll
        for (int eb = 0; eb < 16; eb += 4) {
            f32x4 w[4][4];
#pragma unroll
            for (int e4 = 0; e4 < 4; ++e4)
#pragma unroll
                for (int j = 0; j < 4; ++j) w[e4][j] = *(const LAS f32x4*)(rwT + (eb + e4) * 1024 + lo4 + 256 * j);
            __builtin_amdgcn_sched_barrier(0);
#pragma unroll
            for (int e4 = 0; e4 < 4; ++e4) { f32x2 s2 = {0.f, 0.f};
#pragma unroll
                for (int j = 0; j < 4; ++j) { s2 = __builtin_elementwise_fma((f32x2){v[0][j].x, v[0][j].y}, (f32x2){w[e4][j].x, w[e4][j].y}, s2); s2 = __builtin_elementwise_fma((f32x2){v[0][j].z, v[0][j].w}, (f32x2){w[e4][j].z, w[e4][j].w}, s2); }
                pe[0][eb + e4] = s2.x + s2.y; }
            __builtin_amdgcn_sched_barrier(0);
        }
        {
            LAS float* red = (LAS float*)(F.lds + 65536) + wave_ * 1088;
#pragma unroll
            for (int e = 0; e < 16; ++e) red[lane * 17 + e] = pe[0][e];
            const LAS float* rp = red + (lane >> 4) * 272 + (lane & 15);
            float sacc = 0.f;
#pragma unroll
            for (int i = 0; i < 16; ++i) sacc += rp[i * 17];
            sacc += __shfl_xor(sacc, 16); sacc += __shfl_xor(sacc, 32);
            const float mx = row16_max(sacc);
            const float ex = expf(sacc - mx);
            const float sm = row16_sum(ex);
            if (lane < 16) aff[(size_t)m * 16 + lane] = ex / sm;
        }
    }
    __syncthreads();
}

__device__ __forceinline__ void phase_norm2_router_mfma(Frame& F, const bf16_t* XB, const float* g2, const float* modL, const float* rw, unsigned char* H8, float* aff, int nrows) {
    int tid_ = threadIdx.x; asm volatile("" : "+v"(tid_)); const int lane = tid_ & 63; const int wave_ = __builtin_amdgcn_readfirstlane(tid_ >> 6);
    constexpr int AST = 2064;
    LAS unsigned char* Ahi = F.lds; LAS unsigned char* Alo = F.lds + 16 * AST; LAS float* red = (LAS float*)(F.lds + 2 * 16 * AST);
    const int e_ = lane & 15, kg = lane >> 4;
    bf16x8 Bh[4], Bl[4];
#pragma unroll
    for (int s = 0; s < 4; ++s) { const float* wp = rw + (size_t)(128 * wave_ + 32 * s + 8 * kg) * 16 + e_;
        const float x0 = wp[0], x1 = wp[16], x2 = wp[32], x3 = wp[48], x4 = wp[64], x5 = wp[80], x6 = wp[96], x7 = wp[112];
        u32x4 h, l; h.x = cvtpk(x0, x1); h.y = cvtpk(x2, x3); h.z = cvtpk(x4, x5); h.w = cvtpk(x6, x7);
        l.x = cvtpk(x0 - __builtin_bit_cast(float, h.x << 16), x1 - __builtin_bit_cast(float, h.x & 0xffff0000u)); l.y = cvtpk(x2 - __builtin_bit_cast(float, h.y << 16), x3 - __builtin_bit_cast(float, h.y & 0xffff0000u));
        l.z = cvtpk(x4 - __builtin_bit_cast(float, h.z << 16), x5 - __builtin_bit_cast(float, h.z & 0xffff0000u)); l.w = cvtpk(x6 - __builtin_bit_cast(float, h.w << 16), x7 - __builtin_bit_cast(float, h.w & 0xffff0000u));
        Bh[s] = __builtin_bit_cast(bf16x8, h); Bl[s] = __builtin_bit_cast(bf16x8, l); }
    const int ngroups = nrows >> 4; const int per = (ngroups + F.G - 1) / F.G; const int gg0 = F.vcu * per, gg1 = min(ngroups, gg0 + per);
    ModCache M; M.b = -1;
    u32x2 nx[2][4];
    if (gg0 < gg1) { load_row_bf16(XB + (size_t)(gg0 * 16 + 2 * wave_) * DM, lane, nx[0]); load_row_bf16(XB + (size_t)(gg0 * 16 + 2 * wave_ + 1) * DM, lane, nx[1]); }
    for (int gg = gg0; gg < gg1; ++gg) {
        const int mbase = gg * 16;
        f32x4 v[2][4];
        cvt_row_bf16(v[0], nx[0]); cvt_row_bf16(v[1], nx[1]);
        if (gg + 1 < gg1) { load_row_bf16(XB + (size_t)(mbase + 16 + 2 * wave_) * DM, lane, nx[0]); load_row_bf16(XB + (size_t)(mbase + 16 + 2 * wave_ + 1) * DM, lane, nx[1]); }
#pragma unroll
        for (int r = 0; r < 2; ++r) { const int tok = 2 * wave_ + r, m = mbase + tok;
            modcache_load(M, row_batch(m), g2, modL, 3, 4, lane);
            const float rstd = row_rstd(v[r]);
#pragma unroll
            for (int j = 0; j < 4; ++j) v[r][j] = v[r][j] * rstd * M.sc[j] + M.sh[j];
            store_row_fp8(H8 + (size_t)m * DM, lane, v[r], H2_SCALE);
            LAS unsigned char* ah = Ahi + tok * AST + 8 * lane;
#pragma unroll
            for (int j = 0; j < 4; ++j) { const f32x4 x = v[r][j]; u32x2 h, l; h.x = cvtpk(x.x, x.y); h.y = cvtpk(x.z, x.w);
                l.x = cvtpk(x.x - __builtin_bit_cast(float, h.x << 16), x.y - __builtin_bit_cast(float, h.x & 0xffff0000u)); l.y = cvtpk(x.z - __builtin_bit_cast(float, h.y << 16), x.w - __builtin_bit_cast(float, h.y & 0xffff0000u));
                *(LAS u32x2*)(ah + 512 * j) = h; *(LAS u32x2*)(ah + 16 * AST + 512 * j) = l; } }
        __syncthreads();
        f32x4 acc = {0.f, 0.f, 0.f, 0.f};
#pragma unroll
        for (int s = 0; s < 4; ++s) { const LAS unsigned char* ap = Ahi + e_ * AST + 256 * wave_ + 64 * s + 16 * kg;
            const bf16x8 a_h = *(const LAS bf16x8*)ap, a_l = *(const LAS bf16x8*)(ap + 16 * AST);
            acc = __builtin_amdgcn_mfma_f32_16x16x32_bf16(a_h, Bh[s], acc, 0, 0, 0); acc = __builtin_amdgcn_mfma_f32_16x16x32_bf16(a_h, Bl[s], acc, 0, 0, 0); acc = __builtin_amdgcn_mfma_f32_16x16x32_bf16(a_l, Bh[s], acc, 0, 0, 0); }
#pragma unroll
        for (int r = 0; r < 4; ++r) red[wave_ * 256 + (4 * kg + r) * 16 + e_] = acc[r];
        __syncthreads();
        if (tid_ < 256) { float sacc = 0.f;
#pragma unroll
            for (int w = 0; w < 8; ++w) sacc += red[w * 256 + tid_];
            const float mx = row16_max(sacc);
            const float ex = expf(sacc - mx);
            const float sm = row16_sum(ex);
            aff[(size_t)(mbase + (tid_ >> 4)) * 16 + (tid_ & 15)] = ex / sm; }
    }
    __syncthreads();
}

template <int NPT>
__device__ __forceinline__ void topk_task(Frame& F, const float* aff, int rowbase, int n, int cap, int e, int slot_base, unsigned* rowsrc_e, short* slot) {
    int tid_ = threadIdx.x; asm volatile("" : "+v"(tid_)); const int lane_ = tid_ & 63; const int wave_ = __builtin_amdgcn_readfirstlane(tid_ >> 6);
    LAS unsigned* cnt = (LAS unsigned*)F.lds;
    const int tid = tid_, lane = lane_, wave = wave_;
    const bool act = tid * NPT < n;
    unsigned v[NPT];
#pragma unroll
    for (int j = 0; j < NPT; ++j) v[j] = act ? __float_as_uint(aff[(size_t)(rowbase + tid * NPT + j) * 16 + e]) : 0u;
    unsigned T = 0u;
    for (int bit = 30; bit >= 0; --bit) {
        const unsigned cand = T | (1u << bit);
        unsigned c = 0;
#pragma unroll
        for (int j = 0; j < NPT; ++j) c += (act && v[j] >= cand) ? 1u : 0u;
        c = (unsigned)wave_sum((float)c);
        LAS unsigned* cb = cnt + (bit & 1) * 8;
        if (lane == 0) cb[wave] = c;
        __syncthreads();
        unsigned tot = 0;
#pragma unroll
        for (int w = 0; w < 8; ++w) tot += cb[w];
        if (tot >= (unsigned)cap) T = cand;
    }
    unsigned ngt = 0, neq = 0;
#pragma unroll
    for (int j = 0; j < NPT; ++j) { ngt += (act && v[j] > T) ? 1u : 0u; neq += (act && v[j] == T) ? 1u : 0u; }
    unsigned pk = ngt | (neq << 16), inc = pk;
#pragma unroll
    for (int o = 1; o < 64; o <<= 1) { const unsigned t = __shfl_up(inc, o); if (lane >= o) inc += t; }
    LAS unsigned* wtot = cnt + 32;
    __syncthreads();
    if (lane == 63) wtot[wave] = inc;
    __syncthreads();
    unsigned wpre = 0, total = 0;
#pragma unroll
    for (int w = 0; w < 8; ++w) { const unsigned t = wtot[w]; if (w < wave) wpre += t; total += t; }
    const unsigned exc = wpre + inc - pk;
    const unsigned tot_gt = total & 0xffffu;
    const unsigned need_eq = (unsigned)cap - tot_gt;
    unsigned gt_before = exc & 0xffffu, eq_before = exc >> 16;
    if (act) {
#pragma unroll
        for (int j = 0; j < NPT; ++j) {
            const bool g = v[j] > T, q = v[j] == T;
            const bool sel = g || (q && eq_before < need_eq);
            const int tok = tid * NPT + j;
            short sv = -1;
            if (sel) { const unsigned pos = gt_before + min(eq_before, need_eq); sv = (short)(slot_base + pos); rowsrc_e[slot_base + pos] = (unsigned)(rowbase + tok); }
            slot[(size_t)(rowbase + tok) * 16 + e] = sv;
            gt_before += g ? 1u : 0u; eq_before += q ? 1u : 0u;
        }
    }
    __syncthreads();
}
__device__ __forceinline__ void phase_topk(Frame& F, const float* aff, unsigned* rowsrc, short* slot, int nMe, bool with_ctx) {
    const int ntask = NB * NE * (with_ctx ? 2 : 1);
    for (int t = F.vcu; t < ntask; t += F.G) {
        const bool cx = t >= NB * NE; const int tt = cx ? t - NB * NE : t; const int b = tt >> 4, e = tt & 15;
        unsigned* rs_e = rowsrc + (size_t)e * nMe * 256;
        if (!cx) topk_task<8>(F, aff, b * SEQ, SEQ, CAPX, e, b * CAPX, rs_e, slot);
        else topk_task<1>(F, aff, MX + b * CTXL, CTXL, CAPC, e, NB * CAPX + b * CAPC, rs_e, slot);
    }
}

__device__ __forceinline__ void phase_combine(Frame& F, bf16_t* XB, const bf16_t* P, float* xout, const float* modL, const float* aff, const short* slot, const bf16_t* ybuf, int nMe,
                                              int nrows, bool last, const float* gnext, const float* modN, bf16_t* H, const float* final_g, float* dump = nullptr) {
    int tid_ = threadIdx.x; asm volatile("" : "+v"(tid_)); const int lane = tid_ & 63; const int wave_ = __builtin_amdgcn_readfirstlane(tid_ >> 6);
    const int gw = F.vcu * NWAVES + wave_, NGW = F.G * NWAVES; const int per = (nrows + NGW - 1) / NGW;
    ModCache M; M.b = -1;
    f32x4 g2v[4]; int gb = -1;
    const int m0 = gw * per, m1 = min(nrows, m0 + per);
    const size_t estride = (size_t)nMe * 256 * DM;
#define CB_META(m, sv, av) do { sv = (int)slot[(size_t)(m) * 16 + (lane & 15)]; av = aff[(size_t)(m) * 16 + (lane & 15)]; } while (0)
#define CB_ISSUE(m, sv, av, X, Y, AK, REST) do { load_row_bf16(XB + (size_t)(m) * DM, lane, X); \
        unsigned mk_ = (unsigned)__ballot(sv >= 0) & 0xffffu; \
        _Pragma("unroll") for (int k = 0; k < 4; ++k) { \
            if (mk_) { const int e_ = __builtin_ctz(mk_); mk_ &= mk_ - 1u; const int s_ = __builtin_amdgcn_readlane(sv, e_); AK[k] = __builtin_bit_cast(float, __builtin_amdgcn_readlane(__builtin_bit_cast(int, av), e_)); \
                const u32x2* yr_ = (const u32x2*)(ybuf + (size_t)e_ * estride + (size_t)s_ * DM) + lane; \
                _Pragma("unroll") for (int j = 0; j < 4; ++j) Y[k][j] = yr_[64 * j]; } \
            else { AK[k] = 0.f; _Pragma("unroll") for (int j = 0; j < 4; ++j) Y[k][j] = (u32x2){0u, 0u}; } } \
        REST = mk_; } while (0)
    int sv1 = -1, sv2 = -1; float av1 = 0.f, av2 = 0.f;
    u32x2 X[4], Xn[4]; u32x2 Y[4][4], Yn[4][4]; float AK[4], AKn[4]; unsigned rest = 0, restn = 0; int svc = -1, svn = -1; float avc = 0.f, avn = 0.f;
    if (m0 < m1) { CB_META(m0, sv1, av1); CB_ISSUE(m0, sv1, av1, X, Y, AK, rest); svc = sv1; avc = av1; }
    if (m0 + 1 < m1) CB_META(m0 + 1, sv1, av1);
    for (int m = m0; m < m1; ++m) {
        if (m + 1 < m1) { CB_ISSUE(m + 1, sv1, av1, Xn, Yn, AKn, restn); svn = sv1; avn = av1; }
        if (m + 2 < m1) CB_META(m + 2, sv1, av1);
        const int b = row_batch(m);
        if (gb != b) { gb = b;
#pragma unroll
            for (int j = 0; j < 4; ++j) g2v[j] = ((const f32x4*)(modL + (size_t)b * 6144 + 5 * DM))[lane + 64 * j]; }
        f32x4 acc[4];
#pragma unroll
        for (int j = 0; j < 4; ++j) acc[j] = (f32x4){0.f, 0.f, 0.f, 0.f};
#pragma unroll
        for (int k = 0; k < 4; ++k) { const float a = AK[k];
#pragma unroll
            for (int j = 0; j < 4; ++j) { const u32x2 w = Y[k][j];
                acc[j].x += a * __builtin_bit_cast(float, w.x << 16); acc[j].y += a * __builtin_bit_cast(float, w.x & 0xffff0000u);
                acc[j].z += a * __builtin_bit_cast(float, w.y << 16); acc[j].w += a * __builtin_bit_cast(float, w.y & 0xffff0000u); } }
        while (rest) { const int e_ = __builtin_ctz(rest); rest &= rest - 1u; const int s_ = __builtin_amdgcn_readlane(svc, e_); const float a = __builtin_bit_cast(float, __builtin_amdgcn_readlane(__builtin_bit_cast(int, avc), e_));
            const u32x2* yr = (const u32x2*)(ybuf + (size_t)e_ * estride + (size_t)s_ * DM) + lane;
#pragma unroll
            for (int j = 0; j < 4; ++j) { const u32x2 w = yr[64 * j];
                acc[j].x += a * __builtin_bit_cast(float, w.x << 16); acc[j].y += a * __builtin_bit_cast(float, w.x & 0xffff0000u);
                acc[j].z += a * __builtin_bit_cast(float, w.y << 16); acc[j].w += a * __builtin_bit_cast(float, w.y & 0xffff0000u); } }
        f32x4 v[4];
        cvt_row_bf16(v, X);
#pragma unroll
        for (int j = 0; j < 4; ++j) v[j] = v[j] + g2v[j] * acc[j];
        const float rstd = row_rstd(v);
        if (!last) {
            store_row_bf16((dump ? (bf16_t*)dump : XB) + (size_t)m * DM, lane, v);
            modcache_load(M, b, gnext, modN, 0, 1, lane);
#pragma unroll
            for (int j = 0; j < 4; ++j) v[j] = v[j] * rstd * M.sc[j] + M.sh[j];
            if (INPROJ_FP8) store_row_fp8((unsigned char*)H + (size_t)m * DM, lane, v, H2_SCALE); else store_row_bf16(H + (size_t)m * DM, lane, v);
        } else {
            f32x4* o = (f32x4*)((dump ? dump : xout) + (size_t)m * DM) + lane;
#pragma unroll
            for (int j = 0; j < 4; ++j) o[64 * j] = v[j] * rstd * ((const f32x4*)final_g)[lane + 64 * j];
        }
#pragma unroll
        for (int j = 0; j < 4; ++j) { X[j] = Xn[j];
#pragma unroll
            for (int k = 0; k < 4; ++k) Y[k][j] = Yn[k][j]; }
#pragma unroll
        for (int k = 0; k < 4; ++k) AK[k] = AKn[k];
        rest = restn; svc = svn; avc = avn;
    }
#undef CB_META
#undef CB_ISSUE
}

struct Args { In in; float* out; unsigned char* ws; int ph_lo, ph_hi; };
#define WSP(off) ((unsigned char*)karg(KA_WS) + (off))
__global__ void __launch_bounds__(NWAVES * 64, 2) fwd(Args args) {
    extern __shared__ __attribute__((aligned(16))) unsigned char lds_raw[];
    Frame F;
    F.lds = (LAS unsigned char*)lds_raw;
    F.MISC = (volatile LAS unsigned*)(F.lds + MISC_OFF);
    F.tid = threadIdx.x; F.lane = F.tid & 63; F.wave = __builtin_amdgcn_readfirstlane(F.tid >> 6);
    F.G = gridDim.x; { const int bx = blockIdx.x; F.vcu = (F.G % 8 == 0) ? (bx % 8) * (F.G / 8) + bx / 8 : bx; }
    F.ctl = nullptr;
    if (F.tid < 64) ((LAS unsigned*)(F.lds + MISC_OFF))[F.tid] = 0u;
    __syncthreads();
    const int lo = args.ph_lo, hi = args.ph_hi;
    if (hi - lo > 1) (void)xcd_barrier_post((unsigned*)WSP(WS_CTL) + 1024, F.MISC + 8);
#ifndef DBG_ONLY
#define DBG_ONLY -1
#endif
#define PHEN(k) (DBG_ONLY < 0 || ((k) < 2 ? (k) : 2 + (((k) - 2) & 7)) == DBG_ONLY)
#define IN(k) (PHEN(k) && lo <= (k) && (k) < hi)
#ifndef ROUTER_MFMA
#define ROUTER_MFMA 1
#endif
#ifndef DUP_PH
#define DUP_PH -1
#endif
#ifndef DUP_LMASK
#define DUP_LMASK 0xF
#endif
#define NREP(k, L) ((DUP_PH == (k) && ((DUP_LMASK >> (L)) & 1)) ? 2 : 1)
#define SEAM(k) do { if (IN(k) && IN((k) + 1)) { XcdBarrier bar_; bar_.bar = (unsigned*)WSP(WS_CTL) + 1024; bar_.x = xb_xcc_id(); bar_.st = F.MISC + 8; xcd_barrier(bar_); } } while (0)

    if (IN(0)) { for (int rep_ = 0; rep_ < NREP(0, 0); ++rep_) phase_prologue(F, WSP(0)); } SEAM(0);
    if (IN(1)) { phase_norm1(F, karg(KA_x), karg(KA_ctx), karg(KA_norm1_g), (const float*)WSP(WS_MOD), (bf16_t*)WSP(WS_H), (bf16_t*)WSP(WS_XB)); } SEAM(1);

#pragma unroll 1
    for (int L = 0; L < DEPTH; ++L) {
        const int pb = 2 + 8 * L;
        if (hi <= pb || lo >= pb + 8) continue;
        if (IN(pb + 0)) for (int rep_ = 0; rep_ < NREP(2, L); ++rep_) {
            const int kind = L % 3, slot = L / 3; const int Nin = (kind == 0) ? 1536 : 3072;
            const bf16_t* Wt = (const bf16_t*)WSP(WS_PW) + (kind == 0 ? PW_WIN_IN / 2 + (size_t)slot * 1536 * 1024 : kind == 1 ? PW_DIFF_IN / 2 : PW_NA_IN / 2);
            pg8::Gemm g{(const char*)WSP(WS_H), (const char*)Wt, INPROJ_FP8 ? DM : DM * 2, 1 << 20, 0, nullptr};
            pg8::StaticOrder S; S.init(MT / 256, Nin / 256, F.G, (int)blockIdx.x);
            pg8::EpiInProj E{(bf16_t*)WSP(WS_QKV), Nin, 4, kind == 0 ? 5 : (kind == 1 ? 8 : 0), (const float*)WSP(WS_TAB), INPROJ_FP8 ? 1.f / (H2_SCALE * W8_SCALE) : 1.f, kind == 0 ? 5 : 8, (bf16_t*)WSP(WS_P)};
            pg8::gemm_phase<pg8::EpiInProj, false, true, INPROJ_FP8 != 0>(F.lds, g, S, E);
        }
        SEAM(pb + 0);
        if (IN(pb + 1)) for (int rep_ = 0; rep_ < NREP(3, L); ++rep_) {
            const int kind = L % 3, slot = L / 3; const int with_ctx = L < DEPTH - 1 ? 1 : 0;
            if (kind == 0) { att::A2Args A{(const bf16_t*)WSP(WS_QKV), (bf16_t*)WSP(WS_H), karg(KA_win_sink) + slot * 16, with_ctx, (const bf16_t*)WSP(WS_P)}; att::att2_phase<0>(F.lds, A, F.vcu, F.G); }
            else if (kind == 1) { const float* TAB = (const float*)WSP(WS_TAB); att::DiffArgs A{(const bf16_t*)WSP(WS_QKV), (bf16_t*)WSP(WS_H), karg(KA_diff_subln_g), TAB[TAB_LAM], TAB[TAB_LAM + 1], with_ctx, (const bf16_t*)WSP(WS_P)}; att::diff_phase3(F.lds, A, F.vcu, F.G); }
            else { att::A2Args A{(const bf16_t*)WSP(WS_QKV), (bf16_t*)WSP(WS_H), karg(KA_na_rpb), with_ctx, (const bf16_t*)WSP(WS_P)}; att::att2_phase<1>(F.lds, A, F.vcu, F.G); }
        }
        SEAM(pb + 1);
        if (IN(pb + 2)) {
            const int kind = L % 3, slot = L / 3; const bool with_ctx = L < DEPTH - 1;
            const bf16_t* Wt = (const bf16_t*)WSP(WS_PW) + (kind == 0 ? PW_WIN_OUT / 2 + (size_t)slot * 1024 * 1024 : kind == 1 ? PW_DIFF_OUT / 2 : PW_NA_OUT / 2);
            pg8::Gemm g{(const char*)WSP(WS_H), (const char*)Wt, OUTPROJ_FP8 ? DM : DM * 2, 1 << 20, 0, nullptr};
            pg8::StaticOrder S; S.init((with_ctx ? MT : MX) / 256, 4, F.G, (int)blockIdx.x);
            pg8::EpiOutProj E{(bf16_t*)WSP(WS_XB), (const float*)WSP(WS_MOD) + (size_t)L * 17 * 6144, OUTPROJ_FP8 ? 1.f / (Y_SCALE * W8_SCALE) : 1.f};
            pg8::gemm_phase<pg8::EpiOutProj, false, true, OUTPROJ_FP8 != 0>(F.lds, g, S, E);
        }
        SEAM(pb + 2);
        if (IN(pb + 3)) for (int rep_ = 0; rep_ < NREP(5, L); ++rep_) { const bool with_ctx = L < DEPTH - 1;
            if (ROUTER_MFMA && rep_ == 0) phase_norm2_router_mfma(F, (const bf16_t*)WSP(WS_XB), karg(KA_norm2_g) + L * DM, (const float*)WSP(WS_MOD) + (size_t)L * 17 * 6144, karg(KA_router_w) + (size_t)L * DM * NE,
                               (unsigned char*)WSP(WS_H), (float*)WSP(WS_AFF), with_ctx ? MT : MX);
            else phase_norm2_router(F, (const bf16_t*)WSP(WS_XB), karg(KA_norm2_g) + L * DM, (const float*)WSP(WS_MOD) + (size_t)L * 17 * 6144, karg(KA_router_w) + (size_t)L * DM * NE,
                               (unsigned char*)WSP(WS_H), (float*)WSP(WS_AFF), with_ctx ? MT : MX, (const bf16_t*)WSP(WS_P), rep_ == 0); }
        SEAM(pb + 3);
        if (IN(pb + 4)) for (int rep_ = 0; rep_ < NREP(6, L); ++rep_) { const bool with_ctx = L < DEPTH - 1; phase_topk(F, (const float*)WSP(WS_AFF), (unsigned*)WSP(WS_ROWSRC), (short*)WSP(WS_SLOT), with_ctx ? NME_FULL : NME_LAST, with_ctx); }
        SEAM(pb + 4);
        if (IN(pb + 5)) for (int rep_ = 0; rep_ < NREP(7, L); ++rep_) {
            const int nMe = (L < DEPTH - 1) ? NME_FULL : NME_LAST;
            pg8::Gemm g{(const char*)WSP(WS_H), (const char*)WSP(WS_MOEW + (size_t)L * 16 * MOEW_E), DM, nMe, MOEW_E, (const unsigned*)WSP(WS_ROWSRC)};
            pg8::StaticOrder S; S.init(16 * nMe, 16, F.G, (int)blockIdx.x);
            if (DUP_PH == 7 && rep_ == 1) { pg8::EpiSwiglu<true> E{(unsigned char*)WSP(WS_QKV), 1.f / (H2_SCALE * W8_SCALE), HID_SCALE};
                pg8::gemm_phase<pg8::EpiSwiglu<true>, true, true, true>(F.lds, g, S, E); }
            else { pg8::EpiSwiglu<false> E{(unsigned char*)WSP(WS_QKV), 1.f / (H2_SCALE * W8_SCALE), HID_SCALE};
                pg8::gemm_phase<pg8::EpiSwiglu<false>, true, true, true>(F.lds, g, S, E); }
        }
        SEAM(pb + 5);
        if (IN(pb + 6)) for (int rep_ = 0; rep_ < NREP(8, L); ++rep_) {
            const int nMe = (L < DEPTH - 1) ? NME_FULL : NME_LAST;
            pg8::Gemm g{(const char*)WSP(WS_QKV), (const char*)WSP(WS_MOEW + (size_t)L * 16 * MOEW_E + (size_t)4096 * 1024), FF, nMe, MOEW_E, nullptr};
            pg8::StaticOrder S; S.init(16 * nMe, 4, F.G, (int)blockIdx.x);
            pg8::EpiBf16 E{(bf16_t*)WSP(WS_YBUF), DM, 1.f / (HID_SCALE * W8_SCALE)};
            pg8::gemm_phase<pg8::EpiBf16, false, true, true, true>(F.lds, g, S, E);
        }
        SEAM(pb + 6);
        if (IN(pb + 7)) for (int rep_ = NREP(9, L) - 1; rep_ >= 0; --rep_) {
            const bool last = (L == DEPTH - 1); const bool with_ctx = !last;
            phase_combine(F, (bf16_t*)WSP(WS_XB), (const bf16_t*)WSP(WS_P), (float*)karg(KA_OUT), (const float*)WSP(WS_MOD) + (size_t)L * 17 * 6144, (const float*)WSP(WS_AFF), (const short*)WSP(WS_SLOT), (const bf16_t*)WSP(WS_YBUF),
                          with_ctx ? NME_FULL : NME_LAST, with_ctx ? MT : MX, last, karg(KA_norm1_g) + (last ? 0 : (L + 1) * DM), (const float*)WSP(WS_MOD) + (size_t)(last ? 0 : L + 1) * 17 * 6144,
                          rep_ ? (bf16_t*)WSP(WS_QKV + 300 * MiB) : (bf16_t*)WSP(WS_H), karg(KA_final_g), rep_ ? (float*)WSP(WS_QKV) : nullptr);
        }
        SEAM(pb + 7);
    }
#undef IN
#undef SEAM
}

extern "C" void kernel_launch(void* const* d_in, const int* in_sizes, int n_in, void* d_out, int out_size, void* d_ws, size_t ws_size, hipStream_t stream) {
    static int grid = 0;
    if (grid == 0) {
        if (n_in != 23 || out_size != MX * DM || ws_size < WS_END) { fprintf(stderr, "kernel_launch: unexpected shapes: n_in %d out %d ws %zu (need %zu)\n", n_in, out_size, ws_size, (size_t)WS_END); grid = -1; return; }
        int dev = 0, cus = 0, per_cu = 0;
        if (hipGetDevice(&dev) != hipSuccess || hipDeviceGetAttribute(&cus, hipDeviceAttributeMultiprocessorCount, dev) != hipSuccess) { grid = -1; return; }
        if (hipFuncSetAttribute((const void*)fwd, hipFuncAttributeMaxDynamicSharedMemorySize, LDS_BYTES) != hipSuccess) { fprintf(stderr, "kernel_launch: hipFuncSetAttribute failed\n"); grid = -1; return; }
        if (hipOccupancyMaxActiveBlocksPerMultiprocessor(&per_cu, (const void*)fwd, NWAVES * 64, LDS_BYTES) != hipSuccess || per_cu < 1) fprintf(stderr, "kernel_launch: occupancy query says %d\n", per_cu);
        (void)hipGetLastError();
        grid = cus;
    }
    if (grid < 0) return;
    (void)hipMemsetAsync((char*)d_ws + WS_CTL, 0, CTL_ZERO_BYTES, stream);
    Args a{};
    const float** ip = (const float**)&a.in;
    for (int i = 0; i < 23; ++i) ip[i] = (const float*)d_in[i];
    a.out = (float*)d_out; a.ws = (unsigned char*)d_ws;
    if (MK_N_LAUNCHES == 1) { a.ph_lo = 0; a.ph_hi = NPHASES; hipLaunchKernelGGL(fwd, dim3(grid), dim3(NWAVES * 64), LDS_BYTES, stream, a); }
    else for (int p = 0; p < NPHASES; ++p) { a.ph_lo = p; a.ph_hi = p + 1; hipLaunchKernelGGL(fwd, dim3(grid), dim3(NWAVES * 64), LDS_BYTES, stream, a); }
}
```

```cpp
#include <hip/hip_runtime.h>
#include <cstdio>
#include <cstdint>

#ifndef MK_N_LAUNCHES
#define MK_N_LAUNCHES 1
#endif

#define GAS __attribute__((address_space(1)))
#define LAS __attribute__((address_space(3)))
typedef unsigned short bf16_t;
typedef short bf16x8 __attribute__((ext_vector_type(8)));
typedef short s16x4 __attribute__((ext_vector_type(4)));
typedef float f32x4 __attribute__((ext_vector_type(4)));
typedef float f32x2 __attribute__((ext_vector_type(2)));
typedef float f32x16 __attribute__((ext_vector_type(16)));
typedef unsigned u32x4 __attribute__((ext_vector_type(4)));
typedef unsigned u32x2 __attribute__((ext_vector_type(2)));
typedef __bf16 bf16x2_t __attribute__((ext_vector_type(2)));
typedef GAS unsigned gu32;

constexpr int DM = 1024, NB = 16, SEQ = 4096, DEPTH = 4, CTXL = 256, NE = 16, FF = 2048;
constexpr int MX = NB * SEQ;
constexpr int MC = NB * CTXL;
constexpr int MT = MX + MC;
constexpr int CAPX = 512, CAPC = 32;
constexpr int NME_FULL = 34, NME_LAST = 32;
constexpr float C2 = 0.125f * 1.4426950408889634f;
constexpr float LOG2E = 1.4426950408889634f;
constexpr float RMS_EPS = 1e-6f;
constexpr float NEG_BIG = -1e30f;
constexpr int NWAVES = 8;
constexpr int NPHASES = 2 + 8 * DEPTH;

constexpr size_t MiB = 1u << 20;
constexpr size_t WS_CTL = 0, CTL_ZERO_BYTES = 64 * 1024;
constexpr size_t WS_MOD = 1 * MiB;
constexpr size_t WS_TAB = 3 * MiB;
constexpr size_t WS_AFF = 4 * MiB;
constexpr size_t WS_SLOT = 9 * MiB;
constexpr size_t WS_ROWSRC = 12 * MiB;
constexpr size_t WS_CTXRES = 13 * MiB;
constexpr size_t WS_PW = 29 * MiB;
constexpr size_t PW_WIN_IN = 0, PW_WIN_OUT = 6 * MiB, PW_DIFF_IN = 10 * MiB, PW_DIFF_OUT = 16 * MiB, PW_NA_IN = 18 * MiB, PW_NA_OUT = 24 * MiB;
constexpr size_t WS_H = 56 * MiB;
constexpr size_t WS_QKV = 192 * MiB;
constexpr size_t WS_YBUF = 736 * MiB;
constexpr size_t WS_MOEW = 1008 * MiB;
constexpr size_t MOEW_E = (size_t)(4096 * 1024 + 1024 * 2048);
#ifndef INPROJ_FP8
#define INPROJ_FP8 1
#endif
#ifndef OUTPROJ_FP8
#define OUTPROJ_FP8 0
#endif
constexpr float Y_SCALE = 8.f;
constexpr float H2_SCALE = 4.f, HID_SCALE = 2.f, W8_SCALE = 32.f;
constexpr size_t WS_XB = 1536 * MiB;
constexpr size_t WS_END = 1672 * MiB;
constexpr size_t WS_P = 1400 * MiB;
constexpr int TAB_COS = 0, TAB_SIN = 1024, TAB_LAM = 2048;

constexpr int RING_BYTES = 131072;
constexpr int MISC_OFF = 135168;
constexpr int LDS_BYTES = 147456;

#define LDS_WAIT() asm volatile("s_waitcnt lgkmcnt(0)" ::: "memory")
#define VM_WAIT() asm volatile("s_waitcnt vmcnt(0)" ::: "memory")

__device__ __forceinline__ unsigned cvtpk(float lo, float hi) { f32x2 v = {lo, hi}; bf16x2_t b = __builtin_convertvector(v, bf16x2_t); return __builtin_bit_cast(unsigned, b); }
__device__ __forceinline__ float bf2f(unsigned short u) { return __builtin_bit_cast(float, (unsigned)u << 16); }
__device__ __forceinline__ float wave_sum(float v) {
#pragma unroll
    for (int o = 1; o < 64; o <<= 1) v += __shfl_xor(v, o);
    return v;
}
template <int CTRL> __device__ __forceinline__ float dppf(float v) { return __builtin_bit_cast(float, __builtin_amdgcn_update_dpp(0, __builtin_bit_cast(int, v), CTRL, 0xF, 0xF, true)); }
__device__ __forceinline__ float row16_sum(float v) { v += dppf<0xB1>(v); v += dppf<0x4E>(v); v += dppf<0x141>(v); v += dppf<0x140>(v); return v; }
__device__ __forceinline__ float row16_max(float v) { v = fmaxf(v, dppf<0xB1>(v)); v = fmaxf(v, dppf<0x4E>(v)); v = fmaxf(v, dppf<0x141>(v)); v = fmaxf(v, dppf<0x140>(v)); return v; }
__device__ __forceinline__ float rdlane(float v, int l) { return __builtin_bit_cast(float, __builtin_amdgcn_readlane(__builtin_bit_cast(int, v), l)); }
__device__ __forceinline__ float wave_sum_fast(float v) { v = row16_sum(v); return (rdlane(v, 0) + rdlane(v, 16)) + (rdlane(v, 32) + rdlane(v, 48)); }
__device__ __forceinline__ float siluf(float v) { return v / (1.f + __expf(-v)); }

#define XB_TMO      128
#define XB_XCNT(j)  (256  + 64 * (j))
#define XB_XSUB(j)  (1280 + 64 * (j))
#define XB_XGEN(j)  (2304 + 64 * (j))
#define XB_TOP      3328
#define XB_TOPGEN   3392
#define XCD_BAR_WORDS 3456
#define XB_SPIN_CAP (1u << 18)
__device__ __forceinline__ unsigned xb_ld(unsigned* p)              { return __hip_atomic_load(p, __ATOMIC_RELAXED, __HIP_MEMORY_SCOPE_AGENT); }
__device__ __forceinline__ unsigned xb_add(unsigned* p, unsigned v) { return __hip_atomic_fetch_add(p, v, __ATOMIC_RELAXED, __HIP_MEMORY_SCOPE_AGENT); }
__device__ __forceinline__ unsigned xb_xcc_id() { return (unsigned)__builtin_amdgcn_s_getreg((3 << 11) | 20) & 0xFu; }
#define XB_SPIN(cond, bar) do { unsigned _sp = 0; while (cond) { __builtin_amdgcn_s_sleep(1); \
    if ((++_sp & 255u) == 0u) { if (xb_ld(&(bar)[XB_TMO])) break; if (_sp > XB_SPIN_CAP) { atomicAdd(&(bar)[XB_TMO], 1u); break; } } } } while (0)
struct XcdBarrier { unsigned* bar; unsigned x; volatile LAS unsigned* st; };
__device__ __forceinline__ XcdBarrier xcd_barrier_post(unsigned* bar, volatile LAS unsigned* st) {
    XcdBarrier b; b.bar = bar; b.x = xb_xcc_id(); b.st = st;
    if (threadIdx.x == 0) (void)xb_add(&bar[XB_XCNT(b.x)], 1u);
    return b;
}
__device__ __forceinline__ void xcd_barrier_complete(unsigned* bar, unsigned x, unsigned& nloc, unsigned& nx) {
    const unsigned G = gridDim.x * gridDim.y * gridDim.z;
    unsigned sum, cnt, mine, sp = 0u;
    for (;;) {
        sum = 0u; cnt = 0u; mine = 0u;
#pragma unroll
        for (unsigned j = 0; j < 16; ++j) { const unsigned c = xb_ld(&bar[XB_XCNT(j)]); sum += c; cnt += (c > 0u) ? 1u : 0u; mine = (j == x) ? c : mine; }
        if (sum == G) break;
        __builtin_amdgcn_s_sleep(1);
        if ((++sp & 255u) == 0u) { if (xb_ld(&bar[XB_TMO])) break; if (sp > XB_SPIN_CAP) { atomicAdd(&bar[XB_TMO], 1u); break; } }
    }
    nloc = mine > 0u ? mine : 1u; nx = cnt > 0u ? cnt : 1u;
}
__device__ __forceinline__ void xcd_barrier(const XcdBarrier& b) {
    asm volatile("s_waitcnt vmcnt(0)" ::: "memory");
    __syncthreads();
    if (threadIdx.x == 0) {
        unsigned* bar = b.bar;
        __builtin_amdgcn_s_waitcnt(0);
        unsigned nloc = b.st[0], nx = b.st[1];
        if (nloc == 0u) { xcd_barrier_complete(bar, b.x, nloc, nx); b.st[0] = nloc; b.st[1] = nx; }
        const unsigned old = xb_add(&bar[XB_XSUB(b.x)], 1u);
        const unsigned gen = old / nloc;
        if (old + 1u == (gen + 1u) * nloc) {
            __builtin_amdgcn_fence(__ATOMIC_RELEASE, "agent");
            asm volatile("s_waitcnt vmcnt(0)" ::: "memory");
            const unsigned og = xb_add(&bar[XB_TOP], 1u);
            const unsigned tg = og / nx;
            if (og + 1u == (tg + 1u) * nx) xb_add(&bar[XB_TOPGEN], 1u);
            else XB_SPIN(xb_ld(&bar[XB_TOPGEN]) == tg, bar);
            __builtin_amdgcn_fence(__ATOMIC_ACQUIRE, "agent");
            xb_add(&bar[XB_XGEN(b.x)], 1u);
            asm volatile("s_waitcnt vmcnt(0)" ::: "memory");
        } else {
            XB_SPIN(xb_ld(&bar[XB_XGEN(b.x)]) == gen, bar);
            __builtin_amdgcn_fence(__ATOMIC_ACQUIRE, "agent");
            asm volatile("s_waitcnt vmcnt(0)" ::: "memory");
        }
    }
    __syncthreads();
}

namespace pg8 {
constexpr int BM = 256, BK = 64, HALF = 128, HTB = HALF * BK * 2, NXCD = 8, WGM = 4;
typedef int v4i __attribute__((ext_vector_type(4)));
typedef int v8i __attribute__((ext_vector_type(8)));
__host__ __device__ __forceinline__ int lds_byte(int r, int c) { const int st = (r >> 4) * 2 + (c >> 5), rr = r & 15, cc = c & 31, ob = rr * 64 + cc * 2; return st * 1024 + (ob ^ (((ob >> 9) & 1) << 5)); }
__host__ __device__ __forceinline__ void stage_rc(int b, int& R, int& C) { const int st = b / 1024, sb = b % 1024, swz = sb ^ (((sb >> 9) & 1) << 5); R = (st >> 1) * 16 + swz / 64; C = (st & 1) * 32 + (swz % 64) / 2; }
__host__ __device__ __forceinline__ int perm32(int rho) { const int n = rho >> 4, i = rho & 15; return 8 * (i >> 2) + 4 * n + (i & 3); }

struct Unit { int pm, pn; };
struct Gemm { const char* A; const char* Bt; int Kb; int nMe; size_t b_estride; const unsigned* rowsrc; };

struct StaticOrder {
    int nM, nN, nwg, G, c;
    __device__ void init(int nM_, int nN_, int G_, int c_) { nM = nM_; nN = nN_; nwg = nM * nN; G = G_; c = c_; }
    __device__ bool next(int i, Unit& u) const {
        const long L = (long)i * G + c; if (L >= nwg) return false;
        int wgid = (int)L; { const int q = nwg / NXCD, r = nwg % NXCD, xcd = wgid % NXCD, off = wgid / NXCD; wgid = (xcd < r ? xcd * (q + 1) : r * (q + 1) + (xcd - r) * q) + off; }
        const int nig = WGM * nN, gid = wgid / nig, fm = gid * WGM, gsz = (nM - fm) < WGM ? (nM - fm) : WGM;
        u.pm = fm + ((wgid % nig) % gsz); u.pn = (wgid % nig) / gsz; return true;
    }
};

template <class Epi, bool GATHER, bool ALIGN_EPI, bool FP8 = false, bool ABLK = false>
__device__ __forceinline__ void gemm_phase(LAS unsigned char* lds, const Gemm g, const StaticOrder& S, const Epi& E) {
    int tid = threadIdx.x; asm volatile("" : "+v"(tid));
    const int wid = __builtin_amdgcn_readfirstlane(tid >> 6), lane = tid & 63, wr = wid >> 2, wc = wid & 3, fr = lane & 15, fq = lane >> 4;
    const int Kb = g.Kb, nt = Kb / (BK * 2);
    int Rr[2], Cc[2]; unsigned voffB[2];
#pragma unroll
    for (int i = 0; i < 2; ++i) { int R, C; stage_rc(tid * 16 + i * 8192, R, C); const int Rb = Epi::PERM ? ((R & ~31) + perm32(R & 31)) : R;
        Rr[i] = R; Cc[i] = C; voffB[i] = (unsigned)(Rb * Kb + C * 2); }
    const size_t kstep = (size_t)(BK * 2);
    const size_t kstepA = ABLK ? (size_t)32768 : kstep;
    const size_t hstep = (size_t)HALF * Kb;
    const size_t tstep = 2 * hstep;
    const unsigned ldsw = (unsigned)wid * 1024u;
    const int aoff = lds_byte(wr * 64 + fr, fq * 8), boff = lds_byte(wc * 32 + fr, fq * 8);
#define PG8_SA(b, h) (((b) * 2 + (h)) * HTB)
#define PG8_SB(b, h) ((4 + (b) * 2 + (h)) * HTB)
#define PG8_STAGE(bufoff, gbase, voff) do { _Pragma("unroll") for (int _i = 0; _i < 2; ++_i) \
        __builtin_amdgcn_global_load_lds((const unsigned*)((const char*)(gbase) + (voff)[_i]), (LAS unsigned*)(lds + (bufoff) + ldsw + _i * 8192), 16, 0, 0); } while (0)
#define PG8_LDA(dst, b, h) do { _Pragma("unroll") for (int m = 0; m < 4; ++m) _Pragma("unroll") for (int k = 0; k < 2; ++k) dst[m][k] = *(const LAS bf16x8*)(lds + PG8_SA(b, h) + aoff + m * 2048 + k * 1024); } while (0)
#define PG8_LDB(dst, b, h) do { _Pragma("unroll") for (int n = 0; n < 2; ++n) _Pragma("unroll") for (int k = 0; k < 2; ++k) dst[n][k] = *(const LAS bf16x8*)(lds + PG8_SB(b, h) + boff + n * 2048 + k * 1024); } while (0)
#define PG8_MMA(ai, bj, At, Bt, Z) do { __builtin_amdgcn_s_setprio(1); \
        if constexpr (FP8) { if (Epi::ZEROC && (Z)) { _Pragma("unroll") for (int m = 0; m < 4; ++m) _Pragma("unroll") for (int n = 0; n < 2; ++n) { \
            const v8i b8_ = __builtin_shufflevector(__builtin_bit_cast(v4i, Bt[n][0]), __builtin_bit_cast(v4i, Bt[n][1]), 0, 1, 2, 3, 4, 5, 6, 7); \
            const v8i a8_ = __builtin_shufflevector(__builtin_bit_cast(v4i, At[m][0]), __builtin_bit_cast(v4i, At[m][1]), 0, 1, 2, 3, 4, 5, 6, 7); \
            asm volatile("v_mfma_f32_16x16x128_f8f6f4 %0, %1, %2, 0" : "+v"(acc[ai][bj][m][n]) : "v"(b8_), "v"(a8_)); } }   \
          else { _Pragma("unroll") for (int m = 0; m < 4; ++m) _Pragma("unroll") for (int n = 0; n < 2; ++n) { \
            const v8i b8_ = __builtin_shufflevector(__builtin_bit_cast(v4i, Bt[n][0]), __builtin_bit_cast(v4i, Bt[n][1]), 0, 1, 2, 3, 4, 5, 6, 7); \
            const v8i a8_ = __builtin_shufflevector(__builtin_bit_cast(v4i, At[m][0]), __builtin_bit_cast(v4i, At[m][1]), 0, 1, 2, 3, 4, 5, 6, 7); \
            asm volatile("v_mfma_f32_16x16x128_f8f6f4 %0, %1, %2, %0" : "+v"(acc[ai][bj][m][n]) : "v"(b8_), "v"(a8_)); } } } \
        else { _Pragma("unroll") for (int m = 0; m < 4; ++m) _Pragma("unroll") for (int n = 0; n < 2; ++n) _Pragma("unroll") for (int k = 0; k < 2; ++k) \
            acc[ai][bj][m][n] = __builtin_amdgcn_mfma_f32_16x16x32_bf16(Bt[n][k], At[m][k], acc[ai][bj][m][n], 0, 0, 0); } \
        __builtin_amdgcn_s_setprio(0); } while (0)
#define PG8_WAIT_V(n) asm volatile("s_waitcnt vmcnt(" #n ")" ::: "memory")
#define PG8_WAIT_L(n) asm volatile("s_waitcnt lgkmcnt(" #n ")" ::: "memory")
#define PG8_BAR __builtin_amdgcn_s_barrier()
#define PG8_SCHED __builtin_amdgcn_sched_barrier(0)
#define PG8_CALC_VG(VG, U) do { _Pragma("unroll") for (int _h = 0; _h < 2; ++_h) _Pragma("unroll") for (int _i = 0; _i < 2; ++_i) { \
        const unsigned _row = (unsigned)((U).pm * BM + _h * HALF + Rr[_i]); const unsigned _src = GATHER ? g.rowsrc[_row] : _row; \
        if constexpr (ABLK) { const unsigned _r = (unsigned)(_h * HALF + Rr[_i]), _c = (unsigned)Cc[_i] >> 3; \
            VG[_h][_i] = (unsigned)(U).pm * (unsigned)(Kb * BM) + (_r >> 4) * 2048u + (_c >> 1) * 512u + (_r & 15u) * 32u + (_c & 1u) * 16u; } \
        else VG[_h][_i] = _src * (unsigned)Kb + (unsigned)Cc[_i] * 2u; } } while (0)
    Unit cur, nxt; int ui = 0;
    if (!S.next(0, cur)) return;
    f32x4 acc[2][2][4][2];
    if constexpr (!(FP8 && Epi::ZEROC)) {
#pragma unroll
    for (int a = 0; a < 2; ++a)
#pragma unroll
        for (int b = 0; b < 2; ++b)
#pragma unroll
            for (int m = 0; m < 4; ++m)
#pragma unroll
                for (int n = 0; n < 2; ++n) acc[a][b][m][n] = (f32x4){0.f, 0.f, 0.f, 0.f};
    }
    bf16x8 At[4][2], B0[2][2], B1[2][2];
    unsigned vg[2][2], vgn[2][2];
    PG8_CALC_VG(vg, cur);
    const char* const gA = g.A;
    const char* cB = g.Bt + (size_t)(cur.pm / g.nMe) * g.b_estride + (size_t)cur.pn * tstep;
    PG8_STAGE(PG8_SB(0, 0), cB, voffB); PG8_STAGE(PG8_SB(0, 1), cB + hstep, voffB); PG8_STAGE(PG8_SA(0, 0), gA, vg[0]); PG8_STAGE(PG8_SA(0, 1), gA, vg[1]);
    if (wr == 1) PG8_BAR;
    PG8_WAIT_V(2); PG8_BAR;
    PG8_STAGE(PG8_SB(1, 0), cB + kstep, voffB); PG8_STAGE(PG8_SA(1, 0), gA + kstepA, vg[0]); PG8_STAGE(PG8_SB(1, 1), cB + hstep + kstep, voffB);
    PG8_WAIT_V(6); PG8_BAR;
    for (;;) {
        const bool has_next = S.next(ui + 1, nxt);
        LAS unsigned char* const rsb = lds + 131072 + ((ui + 1) & 1) * 1024;
        if (has_next) {
            if constexpr (GATHER) { if (wid == 0) __builtin_amdgcn_global_load_lds((const unsigned*)(g.rowsrc + (size_t)nxt.pm * BM) + lane * 4, (LAS unsigned*)rsb, 16, 0, 0); }
            else { PG8_CALC_VG(vgn, nxt); } }
        else {
#pragma unroll
            for (int _h = 0; _h < 2; ++_h)
#pragma unroll
                for (int _i = 0; _i < 2; ++_i) vgn[_h][_i] = vg[_h][_i]; }
        const char* nB = has_next ? g.Bt + (size_t)(nxt.pm / g.nMe) * g.b_estride + (size_t)nxt.pn * tstep : cB;
        for (int t = 0; t < nt; t += 2) {
            const bool last = (t == nt - 2);
            const char* a1 = gA + (size_t)(t + 1) * kstepA;
            const char* a2 = last ? gA : gA + (size_t)(t + 2) * kstepA; const char* b2 = last ? nB : cB + (size_t)(t + 2) * kstep;
            const char* a3 = a2 + kstepA; const char* b3 = b2 + kstep;
            if constexpr (GATHER) { if (last && has_next) {
#pragma unroll
                for (int _h = 0; _h < 2; ++_h)
#pragma unroll
                    for (int _i = 0; _i < 2; ++_i) vgn[_h][_i] = *(const LAS unsigned*)(rsb + (_h * HALF + Rr[_i]) * 4) * (unsigned)Kb + (unsigned)Cc[_i] * 2u; } }
            unsigned w0[2], w1[2];
#pragma unroll
            for (int _i = 0; _i < 2; ++_i) { w0[_i] = last ? vgn[0][_i] : vg[0][_i]; w1[_i] = last ? vgn[1][_i] : vg[1][_i]; }
            PG8_LDB(B0, 0, 0); PG8_LDB(B1, 0, 1); PG8_SCHED; PG8_LDA(At, 0, 0); PG8_STAGE(PG8_SA(1, 1), a1, vg[1]);
            PG8_WAIT_V(8); PG8_WAIT_L(0); PG8_BAR; PG8_MMA(0, 0, At, B0, t == 0); PG8_MMA(0, 1, At, B1, t == 0); PG8_BAR; PG8_SCHED;
            PG8_LDA(At, 0, 1); PG8_STAGE(PG8_SB(0, 0), b2, voffB); PG8_STAGE(PG8_SB(0, 1), b2 + hstep, voffB); PG8_STAGE(PG8_SA(0, 0), a2, w0);
            PG8_WAIT_V(8); PG8_WAIT_L(0); PG8_BAR; PG8_MMA(1, 0, At, B0, t == 0); PG8_MMA(1, 1, At, B1, t == 0); PG8_BAR; PG8_SCHED;
            PG8_LDB(B0, 1, 0); PG8_LDB(B1, 1, 1); PG8_SCHED; PG8_LDA(At, 1, 0); PG8_STAGE(PG8_SA(0, 1), a2, w1);
            PG8_WAIT_V(8); PG8_WAIT_L(0); PG8_BAR; PG8_MMA(0, 0, At, B0, false); PG8_MMA(0, 1, At, B1, false); PG8_BAR; PG8_SCHED;
            PG8_LDA(At, 1, 1); PG8_STAGE(PG8_SB(1, 0), b3, voffB); PG8_STAGE(PG8_SB(1, 1), b3 + hstep, voffB); PG8_STAGE(PG8_SA(1, 0), a3, w0);
            PG8_WAIT_V(8); PG8_WAIT_L(0); PG8_BAR; PG8_MMA(1, 0, At, B0, false); PG8_MMA(1, 1, At, B1, false); PG8_BAR; PG8_SCHED;
        }
        if constexpr (ALIGN_EPI) { if (wr == 0) PG8_BAR; }
        if constexpr (FP8) asm volatile("s_nop 15\n\ts_nop 15" ::: "memory");
        E(acc, cur, wr, wc, fr, fq);
        if (!has_next) break;
        if constexpr (!(FP8 && Epi::ZEROC)) {
#pragma unroll
        for (int a = 0; a < 2; ++a)
#pragma unroll
            for (int b = 0; b < 2; ++b)
#pragma unroll
                for (int m = 0; m < 4; ++m)
#pragma unroll
                    for (int n = 0; n < 2; ++n) acc[a][b][m][n] = (f32x4){0.f, 0.f, 0.f, 0.f};
        }
        cur = nxt; cB = nB; ++ui;
#pragma unroll
        for (int _h = 0; _h < 2; ++_h)
#pragma unroll
            for (int _i = 0; _i < 2; ++_i) vg[_h][_i] = vgn[_h][_i];
        if constexpr (ALIGN_EPI) { if (wr == 1) PG8_BAR; }
    }
    PG8_WAIT_V(0);
    if constexpr (!ALIGN_EPI) { if (wr == 0) PG8_BAR; }
    PG8_BAR;
#undef PG8_SA
#undef PG8_SB
#undef PG8_STAGE
#undef PG8_LDA
#undef PG8_LDB
#undef PG8_MMA
#undef PG8_WAIT_V
#undef PG8_WAIT_L
#undef PG8_BAR
#undef PG8_SCHED
#undef PG8_CALC_VG
}

struct EpiInProj {
    static constexpr bool PERM = false; static constexpr bool ZEROC = false;
    bf16_t* O; int ldc; int q_tiles; int rope_tiles; const float* tab; float osc; int v_tile0; bf16_t* Q;
    __device__ __forceinline__ void operator()(const f32x4 (&acc)[2][2][4][2], const Unit& u, int wr, int wc, int fr, int fq) const {
        const int row0 = u.pm * BM + wr * 64 + fr, col0 = u.pn * BM + wc * 32 + 4 * fq;
        const float sc = ((u.pn < q_tiles) ? C2 : 1.f) * osc;
        const bool rope = (u.pn < rope_tiles) && (u.pm < MX / BM);
        const int axis = wc & 1; const bool isv = u.pn >= v_tile0;
#pragma unroll
        for (int ai = 0; ai < 2; ++ai)
#pragma unroll
            for (int m = 0; m < 4; ++m) {
                const int row = row0 + ai * HALF + m * 16;
                f32x4 cs = {1.f, 1.f, 1.f, 1.f}, sn = {0.f, 0.f, 0.f, 0.f};
                if (rope) { const int t = row & (SEQ - 1); const int pos = axis ? (t & 63) : (t >> 6); cs = *(const f32x4*)(tab + TAB_COS + pos * 16 + 4 * fq); sn = *(const f32x4*)(tab + TAB_SIN + pos * 16 + 4 * fq); }
                bf16_t* rowp = O + (size_t)row * ldc + col0;
                bf16_t* rowq = (u.pn < q_tiles) ? Q + ((size_t)(row >> 5) * 16 + 4 * u.pn + (wc >> 1)) * 2048 + (2 * (wc & 1) + (fq >> 1)) * 512 + (fq & 1) * 256 + (row & 31) * 8
                                                : O + (size_t)row * ldc + u.pn * BM + wc * 32 + 8 * fq;
                const int qstep = (u.pn < q_tiles) ? 2 * 2048 : HALF;
#pragma unroll
                for (int bj = 0; bj < 2; ++bj) {
                    const f32x4 x1 = acc[ai][bj][m][0] * sc, x2 = acc[ai][bj][m][1] * sc;
                    const f32x4 o1 = x1 * cs - x2 * sn, o2 = x2 * cs + x1 * sn;
                    u32x2 w1, w2; w1.x = cvtpk(o1[0], o1[1]); w1.y = cvtpk(o1[2], o1[3]); w2.x = cvtpk(o2[0], o2[1]); w2.y = cvtpk(o2[2], o2[3]);
                    if (isv) { *(u32x2*)(rowp + bj * HALF) = w1; *(u32x2*)(rowp + bj * HALF + 16) = w2; }
                    else *(u32x4*)(rowq + bj * qstep) = (u32x4){w1.x, w1.y, w2.x, w2.y}; }
            }
    }
};
struct EpiOutProj {
    static constexpr bool PERM = true; static constexpr bool ZEROC = false;
    bf16_t* P; const float* mod; float osc;
    __device__ __forceinline__ void operator()(const f32x4 (&acc)[2][2][4][2], const Unit& u, int wr, int wc, int fr, int fq) const {
        const int b = (u.pm < MX / BM) ? ((u.pm * BM) >> 12) : 16;
        const int row0 = u.pm * BM + wr * 64 + fr, col0 = u.pn * BM + wc * 32 + 8 * fq;
        const float* gp = mod + (size_t)b * 6144 + 2 * DM + col0;
        f32x4 gv[2][2];
#pragma unroll
        for (int bj = 0; bj < 2; ++bj)
#pragma unroll
            for (int n = 0; n < 2; ++n) gv[bj][n] = *(const f32x4*)(gp + bj * HALF + 4 * n) * osc;
#pragma unroll
        for (int ai = 0; ai < 2; ++ai)
#pragma unroll
            for (int m = 0; m < 4; ++m) { bf16_t* rowp = P + (size_t)(row0 + ai * HALF + m * 16) * DM + col0;
                u32x4 xr[2]; xr[0] = *(const u32x4*)rowp; xr[1] = *(const u32x4*)(rowp + HALF);
#pragma unroll
                for (int bj = 0; bj < 2; ++bj) { const f32x4 v0 = acc[ai][bj][m][0] * gv[bj][0], v1 = acc[ai][bj][m][1] * gv[bj][1]; const u32x4 x = xr[bj];
                    u32x4 w; w.x = cvtpk(v0[0] + __builtin_bit_cast(float, x.x << 16), v0[1] + __builtin_bit_cast(float, x.x & 0xffff0000u));
                    w.y = cvtpk(v0[2] + __builtin_bit_cast(float, x.y << 16), v0[3] + __builtin_bit_cast(float, x.y & 0xffff0000u));
                    w.z = cvtpk(v1[0] + __builtin_bit_cast(float, x.z << 16), v1[1] + __builtin_bit_cast(float, x.z & 0xffff0000u));
                    w.w = cvtpk(v1[2] + __builtin_bit_cast(float, x.w << 16), v1[3] + __builtin_bit_cast(float, x.w & 0xffff0000u));
                    *(u32x4*)(rowp + bj * HALF) = w; } }
    }
};
template <bool NOSTORE = false> struct EpiSwiglu {
    static constexpr bool PERM = true; static constexpr bool ZEROC = true;
    unsigned char* O; float in_scale; float out_scale;
    __device__ __forceinline__ void operator()(const f32x4 (&acc)[2][2][4][2], const Unit& u, int wr, int wc, int fr, int fq) const {
        const int row0 = u.pm * BM + wr * 64 + fr, col0 = u.pn * HALF + wc * 32 + 8 * fq;
#pragma unroll
        for (int ai = 0; ai < 2; ++ai)
#pragma unroll
            for (int m = 0; m < 4; ++m) { unsigned char* rowp = O + ((size_t)u.pm * 16 + u.pn) * 32768 + (8 * ai + 4 * wr + m) * 2048 + wc * 512 + fr * 32 + fq * 8;
                float h[8];
                const float c1 = -LOG2E * in_scale, c2i = 1.f / (in_scale * in_scale * out_scale);
#pragma unroll
                for (int n = 0; n < 2; ++n)
#pragma unroll
                    for (int j = 0; j < 4; j += 2) { const f32x2 ag = {acc[ai][0][m][n][j], acc[ai][0][m][n][j + 1]}, au = {acc[ai][1][m][n][j], acc[ai][1][m][n][j + 1]};
                        const f32x2 ea = ag * c1; f32x2 t; t.x = __builtin_amdgcn_exp2f(ea.x); t.y = __builtin_amdgcn_exp2f(ea.y);
                        const f32x2 d = __builtin_elementwise_fma(t, (f32x2){c2i, c2i}, (f32x2){c2i, c2i}); f32x2 r; r.x = __builtin_amdgcn_rcpf(d.x); r.y = __builtin_amdgcn_rcpf(d.y);
                        const f32x2 hv = (ag * au) * r; h[n * 4 + j] = hv.x; h[n * 4 + j + 1] = hv.y; }
                int w0 = 0, w1 = 0;
                w0 = __builtin_amdgcn_cvt_pk_fp8_f32(h[0], h[1], w0, false); w0 = __builtin_amdgcn_cvt_pk_fp8_f32(h[2], h[3], w0, true);
                w1 = __builtin_amdgcn_cvt_pk_fp8_f32(h[4], h[5], w1, false); w1 = __builtin_amdgcn_cvt_pk_fp8_f32(h[6], h[7], w1, true);
                if (NOSTORE) asm volatile("" :: "v"(w0), "v"(w1)); else *(u32x2*)rowp = (u32x2){(unsigned)w0, (unsigned)w1}; }
    }
};
struct EpiBf16 {
    static constexpr bool PERM = true; static constexpr bool ZEROC = true;
    bf16_t* O; int ldc; float sc;
    __device__ __forceinline__ void operator()(const f32x4 (&acc)[2][2][4][2], const Unit& u, int wr, int wc, int fr, int fq) const {
        const int row0 = u.pm * BM + wr * 64 + fr, col0 = u.pn * BM + wc * 32 + 8 * fq;
#pragma unroll
        for (int ai = 0; ai < 2; ++ai)
#pragma unroll
            for (int m = 0; m < 4; ++m) { bf16_t* rowp = O + (size_t)(row0 + ai * HALF + m * 16) * ldc + col0;
#pragma unroll
                for (int bj = 0; bj < 2; ++bj) { const f32x4 v0 = acc[ai][bj][m][0] * sc, v1 = acc[ai][bj][m][1] * sc;
                    u32x4 w; w.x = cvtpk(v0[0], v0[1]); w.y = cvtpk(v0[2], v0[3]); w.z = cvtpk(v1[0], v1[1]); w.w = cvtpk(v1[2], v1[3]);
                    *(u32x4*)(rowp + bj * HALF) = w; } }
    }
};
}

namespace att {
#define SBAR() __builtin_amdgcn_sched_barrier(0)
__device__ __forceinline__ int crow(int r, int hi) { return (r & 3) + 8 * (r >> 2) + 4 * hi; }
__device__ __forceinline__ void glds16(const void* gsrc, unsigned lds_dst) { unsigned keep;
    asm volatile("s_mov_b32 %0, m0\n\ts_mov_b32 m0, %2\n\ts_nop 0\n\tglobal_load_lds_dwordx4 %1, off\n\ts_mov_b32 m0, %0" : "=&s"(keep) : "v"(gsrc), "s"(lds_dst) : "memory"); }
#define WAIT_BAR0() asm volatile("s_waitcnt vmcnt(0) lgkmcnt(0)\n\ts_barrier" ::: "memory")
typedef LAS const char* lds_cptr;
typedef short v4i16_t __attribute__((ext_vector_type(4)));
__device__ __forceinline__ s16x4 vtr(lds_cptr p) { return __builtin_bit_cast(s16x4, __builtin_amdgcn_ds_read_tr16_b64_v4i16((LAS v4i16_t*)p)); }
__device__ __forceinline__ float hmax(float m) { auto rr = __builtin_amdgcn_permlane32_swap(__float_as_uint(m), __float_as_uint(m), false, false); return fmaxf(__uint_as_float(rr[0]), __uint_as_float(rr[1])); }
__device__ __forceinline__ float hsum(float m) { auto rr = __builtin_amdgcn_permlane32_swap(__float_as_uint(m), __float_as_uint(m), false, false); return __uint_as_float(rr[0]) + __uint_as_float(rr[1]); }

__device__ __forceinline__ void qkt(f32x16& p0, f32x16& p1, lds_cptr kb, const bf16x8 (&qr)[4]) {
    p0 = f32x16{}; p1 = f32x16{};
#pragma unroll
    for (int d0 = 0; d0 < 4; ++d0) {
        const bf16x8 b0 = *(const LAS bf16x8*)(kb + d0 * 2048), b1 = *(const LAS bf16x8*)(kb + d0 * 2048 + 512);
        p0 = __builtin_amdgcn_mfma_f32_32x32x16_bf16(b0, qr[d0], p0, 0, 0, 0);
        p1 = __builtin_amdgcn_mfma_f32_32x32x16_bf16(b1, qr[d0], p1, 0, 0, 0); }
}
template <int ND>
__device__ __forceinline__ void softmax_pv(f32x16& p0, f32x16& p1, f32x16 (&oT)[ND], float& m, float& l, lds_cptr vp) {
    float rm = p0[0];
#pragma unroll
    for (int r = 1; r < 16; ++r) rm = fmaxf(rm, p0[r]);
#pragma unroll
    for (int r = 0; r < 16; ++r) rm = fmaxf(rm, p1[r]);
    rm = hmax(rm);
    const float mn = fmaxf(m, rm);
    const float alpha = __builtin_amdgcn_exp2f(m - mn);
    m = mn;
    float s = 0.f;
#pragma unroll
    for (int r = 0; r < 16; ++r) { p0[r] = __builtin_amdgcn_exp2f(p0[r] - mn); p1[r] = __builtin_amdgcn_exp2f(p1[r] - mn); s += p0[r] + p1[r]; }
    l = l * alpha + s;
#pragma unroll
    for (int d = 0; d < ND; ++d) oT[d] = oT[d] * alpha;
    u32x4 pw[4];
#pragma unroll
    for (int k = 0; k < 2; ++k) {
        pw[k]     = (u32x4){cvtpk(p0[8 * k], p0[8 * k + 1]), cvtpk(p0[8 * k + 2], p0[8 * k + 3]), cvtpk(p0[8 * k + 4], p0[8 * k + 5]), cvtpk(p0[8 * k + 6], p0[8 * k + 7])};
        pw[2 + k] = (u32x4){cvtpk(p1[8 * k], p1[8 * k + 1]), cvtpk(p1[8 * k + 2], p1[8 * k + 3]), cvtpk(p1[8 * k + 4], p1[8 * k + 5]), cvtpk(p1[8 * k + 6], p1[8 * k + 7])}; }
#pragma unroll
    for (int d = 0; d < ND; ++d)
#pragma unroll
        for (int ks = 0; ks < 4; ++ks) {
            const s16x4 lo = vtr(vp + d * 4096 + ks * 1024), hi = vtr(vp + d * 4096 + ks * 1024 + 512);
            const bf16x8 vf = (bf16x8){lo[0], lo[1], lo[2], lo[3], hi[0], hi[1], hi[2], hi[3]};
            oT[d] = __builtin_amdgcn_mfma_f32_32x32x16_bf16(vf, __builtin_bit_cast(bf16x8, pw[ks]), oT[d], 0, 0, 0); }
}
template <int ND>
__device__ __forceinline__ void stg_flush(const LAS unsigned char* stg, bf16_t* ybase, int lane) {
    constexpr int RB = ND * 64 + 16, CPR = ND * 4;
#pragma unroll
    for (int i = 0; i < 32 * CPR / 64; ++i) { const int idx = i * 64 + lane, row = idx / CPR, ch = idx % CPR;
        const u32x4 v = *(const LAS u32x4*)(stg + row * RB + ch * 16); *(u32x4*)(ybase + (size_t)row * DM + ch * 8) = v; }
}
template <int ND>
__device__ __forceinline__ void store_oT(const f32x16 (&oT)[ND], float scale, bf16_t* ybase, size_t elem_off, int hi) {
    if (OUTPROJ_FP8) { unsigned char* orow = (unsigned char*)ybase + elem_off; const float sc8 = scale * Y_SCALE;
#pragma unroll
        for (int d = 0; d < ND; ++d)
#pragma unroll
            for (int g = 0; g < 4; ++g) { int t = 0; t = __builtin_amdgcn_cvt_pk_fp8_f32(oT[d][4 * g] * sc8, oT[d][4 * g + 1] * sc8, t, false); t = __builtin_amdgcn_cvt_pk_fp8_f32(oT[d][4 * g + 2] * sc8, oT[d][4 * g + 3] * sc8, t, true);
                *(unsigned*)(orow + d * 32 + 8 * g + 4 * hi) = (unsigned)t; } }
    else { bf16_t* orow = ybase + elem_off;
#pragma unroll
        for (int d = 0; d < ND; ++d)
#pragma unroll
            for (int g = 0; g < 4; ++g) { u32x2 w; w.x = cvtpk(oT[d][4 * g] * scale, oT[d][4 * g + 1] * scale); w.y = cvtpk(oT[d][4 * g + 2] * scale, oT[d][4 * g + 3] * scale);
                *(u32x2*)(orow + d * 32 + 8 * g + 4 * hi) = w; } }
}
constexpr int NA_BIAS_OFF = 65536;
struct DiffArgs { const bf16_t* qkv; bf16_t* y; const float* subln_g; float lam; float omli; int with_ctx; const bf16_t* q; };

#define DF_THR 8.0f
#define DF_BAR()   asm volatile("s_waitcnt lgkmcnt(0)\n\ts_barrier" ::: "memory")
#define DF_BARV()  asm volatile("s_waitcnt vmcnt(0) lgkmcnt(0)\n\ts_barrier" ::: "memory")
__device__ __forceinline__ void diff_phase2(LAS unsigned char* lds, const DiffArgs A, int vcu, int G) {
    int tid = threadIdx.x; asm volatile("" : "+v"(tid));
    const int lane = tid & 63, r32 = lane & 31, hi = lane >> 5; const int wid = __builtin_amdgcn_readfirstlane(tid >> 6);
    constexpr int P = 3072;
    const unsigned lds0 = (unsigned)(uintptr_t)lds;
    const lds_cptr l3 = (lds_cptr)lds;
    const int mp = wid >> 2, qsub = wid & 3;
    LAS float* xch = (LAS float*)lds + qsub * 4096 + lane;
    const int nmain = NB * 8 * 32, nunits = nmain + (A.with_ctx ? NB * 8 * 2 : 0);
    for (int u = vcu; u < nunits; u += G) {
        int b, h, qrow0, NT; const bool ctxu = u >= nmain;
        if (!ctxu) { const int qb = u & 31; h = (u >> 5) & 7; b = u >> 8; qrow0 = b * SEQ + 128 * qb + 32 * qsub; NT = 4 + 64; }
        else { const int v = u - nmain; const int qb = v & 1; h = (v >> 1) & 7; b = v >> 4; qrow0 = MX + b * CTXL + 128 * qb + 32 * qsub; NT = 4; }
        const bf16_t* Kc = A.qkv + (size_t)(MX + b * CTXL) * P + 1024 + 128 * h;
        const bf16_t* Kx = A.qkv + (size_t)(b * SEQ) * P + 1024 + 128 * h;
        const int krow = 8 * wid + (lane >> 3); const size_t koff = (size_t)krow * P + (((lane & 7) ^ ((krow >> 1) & 7)) * 8);
        const int pv0 = 2 * wid, pv1 = 2 * wid + 1;
        const int vra = 4 * pv0 + (lane >> 4), vrb = 4 * pv1 + (lane >> 4); const int vph = lane & 15;
        const size_t voffa = (size_t)vra * P + 1024 + ((((vph >> 2) ^ (vra & 3)) << 2) | (vph & 3)) * 8;
        const size_t voffb = (size_t)vrb * P + 1024 + ((((vph >> 2) ^ (vrb & 3)) << 2) | (vph & 3)) * 8;
#define DF_DMA(t) do { if ((t) < NT) { const int slot_ = (t) % 3; const bf16_t* base_ = ((t) < 4) ? Kc + (size_t)(t) * 64 * P : Kx + (size_t)((t) - 4) * 64 * P; \
        glds16(base_ + koff,      (unsigned)__builtin_amdgcn_readfirstlane(lds0 + slot_ * 32768 + wid * 1024)); \
        glds16(base_ + koff + 64, (unsigned)__builtin_amdgcn_readfirstlane(lds0 + slot_ * 32768 + 8192 + wid * 1024)); \
        glds16(base_ + voffa,     (unsigned)__builtin_amdgcn_readfirstlane(lds0 + slot_ * 32768 + 16384 + pv0 * 1024)); \
        glds16(base_ + voffb,     (unsigned)__builtin_amdgcn_readfirstlane(lds0 + slot_ * 32768 + 16384 + pv1 * 1024)); } } while (0)
        DF_DMA(0);
        bf16x8 qr[4];
        { const bf16_t* Qw = A.qkv + (size_t)(qrow0 + r32) * P + h * 128 + mp * 64;
#pragma unroll
          for (int d0 = 0; d0 < 4; ++d0) qr[d0] = *(const bf16x8*)(Qw + d0 * 16 + hi * 8); }
        f32x16 oT[4]; oT[0] = f32x16{}; oT[1] = f32x16{}; oT[2] = f32x16{}; oT[3] = f32x16{};
        float m = 0.f, l = 0.f;
        f32x16 p0, p1; u32x4 pw[4];
        const int ksw = (r32 >> 1) & 7; const lds_cptr kp0 = l3 + mp * 8192 + r32 * 128 + ((hi ^ (ksw & 1)) << 4); const int ks2 = ksw >> 1;
        const int vq = (lane & 15) >> 2; const lds_cptr vp0 = l3 + 16384 + (4 * hi + vq) * 256 + ((lane >> 4) & 1) * 32 + (lane & 3) * 8;
#define DF_LOADV(dst, vp_, d) do { const lds_cptr vd_ = (vp_) + (((d) ^ vq) << 6); _Pragma("unroll") for (int ks = 0; ks < 4; ++ks) { const s16x4 lo_ = vtr(vd_ + ks * 4096), hi_ = vtr(vd_ + ks * 4096 + 2048); \
            dst[ks] = (bf16x8){lo_[0], lo_[1], lo_[2], lo_[3], hi_[0], hi_[1], hi_[2], hi_[3]}; } } while (0)
#define DF_PV4(src, d) do { _Pragma("unroll") for (int ks = 0; ks < 4; ++ks) oT[d] = __builtin_amdgcn_mfma_f32_32x32x16_bf16(src[ks], __builtin_bit_cast(bf16x8, pw[ks]), oT[d], 0, 0, 0); } while (0)
#define DF_LOADK(dst, kb_, dd) do { dst[0] = *(const LAS bf16x8*)((kb_) + ((((dd)) ^ ks2) << 5)); dst[1] = *(const LAS bf16x8*)((kb_) + ((((dd)) ^ ks2) << 5) + 4096); \
            dst[2] = *(const LAS bf16x8*)((kb_) + ((((dd) + 1) ^ ks2) << 5)); dst[3] = *(const LAS bf16x8*)((kb_) + ((((dd) + 1) ^ ks2) << 5) + 4096); } while (0)
#define DF_QK4(src, dd) do { p0 = __builtin_amdgcn_mfma_f32_32x32x16_bf16(src[0], qr[dd], p0, 0, 0, 0); p1 = __builtin_amdgcn_mfma_f32_32x32x16_bf16(src[1], qr[dd], p1, 0, 0, 0); \
            p0 = __builtin_amdgcn_mfma_f32_32x32x16_bf16(src[2], qr[(dd) + 1], p0, 0, 0, 0); p1 = __builtin_amdgcn_mfma_f32_32x32x16_bf16(src[3], qr[(dd) + 1], p1, 0, 0, 0); } while (0)
#define DF_PREV(vso) do { const lds_cptr vq_ = vp0 + (vso); DF_LOADV(fa, vq_, 0); DF_LOADV(fb, vq_, 1); SBAR(); } while (0)
#define DF_PINIT() do { _Pragma("unroll") for (int r = 0; r < 16; ++r) { p0[r] = -m; p1[r] = -m; } } while (0)
#define DF_SEGM(DO_PV, DO_QK, vso, kso) do { const lds_cptr vp_ = vp0 + (vso); const lds_cptr kb_ = kp0 + (kso); SBAR(); __builtin_amdgcn_s_setprio(1); \
        if (DO_PV) { DF_PV4(fa, 0); SBAR(); DF_LOADV(fa, vp_, 2); SBAR(); \
            DF_PV4(fb, 1); SBAR(); DF_LOADV(fb, vp_, 3); if (DO_QK) { DF_PINIT(); } SBAR(); \
            DF_PV4(fa, 2); SBAR(); if (DO_QK) { DF_LOADK(fa, kb_, 0); } SBAR(); \
            DF_PV4(fb, 3); SBAR(); if (DO_QK) { DF_LOADK(fb, kb_, 2); } SBAR(); } \
        else if (DO_QK) { DF_LOADK(fa, kb_, 0); DF_LOADK(fb, kb_, 2); DF_PINIT(); SBAR(); } \
        if (DO_QK) { DF_QK4(fa, 0); SBAR(); DF_QK4(fb, 2); SBAR(); } \
        __builtin_amdgcn_s_setprio(0); } while (0)
#define DF_SEGV(t) do { \
        float rm = p0[0]; \
        _Pragma("unroll") for (int r = 1; r < 16; ++r) rm = fmaxf(rm, p0[r]); \
        _Pragma("unroll") for (int r = 0; r < 16; ++r) rm = fmaxf(rm, p1[r]); \
        rm = hmax(rm); \
        if ((t) == 0 || __any(rm > DF_THR)) { const float dl = ((t) == 0) ? rm : fmaxf(rm, 0.f); m += dl; \
            _Pragma("unroll") for (int r = 0; r < 16; ++r) { p0[r] -= dl; p1[r] -= dl; } \
            const float f = __builtin_amdgcn_exp2f(-dl); l *= f; \
            _Pragma("unroll") for (int d = 0; d < 4; ++d) oT[d] = oT[d] * f; } \
        float s_ = 0.f; \
        _Pragma("unroll") for (int r = 0; r < 16; ++r) { p0[r] = __builtin_amdgcn_exp2f(p0[r]); p1[r] = __builtin_amdgcn_exp2f(p1[r]); s_ += p0[r] + p1[r]; } \
        l += s_; \
        _Pragma("unroll") for (int k = 0; k < 2; ++k) { \
            pw[k]     = (u32x4){cvtpk(p0[8 * k], p0[8 * k + 1]), cvtpk(p0[8 * k + 2], p0[8 * k + 3]), cvtpk(p0[8 * k + 4], p0[8 * k + 5]), cvtpk(p0[8 * k + 6], p0[8 * k + 7])}; \
            pw[2 + k] = (u32x4){cvtpk(p1[8 * k], p1[8 * k + 1]), cvtpk(p1[8 * k + 2], p1[8 * k + 3]), cvtpk(p1[8 * k + 4], p1[8 * k + 5]), cvtpk(p1[8 * k + 6], p1[8 * k + 7])}; } \
        } while (0)
        DF_BARV();
        int so_p = 0, so_c = 0;
#define DF_ROT() do { so_p = so_c; so_c = (so_c == 65536) ? 0 : so_c + 32768; } while (0)
        bf16x8 fa[4], fb[4];
        if (mp == 0) {
            DF_DMA(1); DF_SEGM(false, true, 0, so_c); SBAR(); DF_PREV(so_c); DF_SEGV(0); SBAR(); DF_BARV(); SBAR();
            for (int t = 1; t < NT; ++t) { DF_ROT();
                DF_DMA(t + 1); DF_SEGM(true, true, so_p, so_c); SBAR(); DF_PREV(so_c); DF_SEGV(t); SBAR(); DF_BARV(); SBAR(); }
            DF_ROT();
            DF_SEGM(true, false, so_p, 0); SBAR(); DF_BARV(); SBAR();
        } else {
            DF_DMA(1); DF_SEGM(false, true, 0, so_c); SBAR(); DF_BARV(); SBAR();
            for (int t = 1; t < NT; ++t) { DF_ROT();
                DF_DMA(t + 1); DF_PREV(so_p); DF_SEGV(t - 1); SBAR(); DF_SEGM(true, true, so_p, so_c); SBAR(); DF_BARV(); SBAR(); }
            DF_ROT();
            DF_PREV(so_p); DF_SEGV(NT - 1); SBAR(); DF_SEGM(true, false, so_p, 0); SBAR(); DF_BARV(); SBAR();
        }
#undef DF_ROT
        l = hsum(l);
        const float il = 1.f / l;
        if (mp == 1) { const float sc = il * A.lam;
#pragma unroll
            for (int d = 0; d < 4; ++d)
#pragma unroll
                for (int q = 0; q < 16; ++q) xch[(d * 16 + q) * 64] = oT[d][q] * sc; }
        DF_BARV();
        if (mp == 0) {
            float ss = 0.f;
#pragma unroll
            for (int d = 0; d < 4; ++d)
#pragma unroll
                for (int q = 0; q < 16; ++q) { const float v = oT[d][q] * il - xch[(d * 16 + q) * 64]; oT[d][q] = v; ss += v * v; }
            ss = hsum(ss);
            const float rstd = rsqrtf(ss * (1.f / 128.f) + RMS_EPS) * A.omli;
            const size_t eo = (size_t)(qrow0 + r32) * DM + h * 128;
#pragma unroll
            for (int d = 0; d < 4; ++d)
#pragma unroll
                for (int g = 0; g < 4; ++g) { const f32x4 gg = *(const f32x4*)(A.subln_g + d * 32 + 8 * g + 4 * hi);
                    if (OUTPROJ_FP8) { const float r8 = rstd * Y_SCALE; int t = 0; t = __builtin_amdgcn_cvt_pk_fp8_f32(oT[d][4 * g] * r8 * gg[0], oT[d][4 * g + 1] * r8 * gg[1], t, false);
                        t = __builtin_amdgcn_cvt_pk_fp8_f32(oT[d][4 * g + 2] * r8 * gg[2], oT[d][4 * g + 3] * r8 * gg[3], t, true);
                        *(unsigned*)((unsigned char*)A.y + eo + d * 32 + 8 * g + 4 * hi) = (unsigned)t; }
                    else { u32x2 w; w.x = cvtpk(oT[d][4 * g] * rstd * gg[0], oT[d][4 * g + 1] * rstd * gg[1]); w.y = cvtpk(oT[d][4 * g + 2] * rstd * gg[2], oT[d][4 * g + 3] * rstd * gg[3]);
                        *(u32x2*)(A.y + eo + d * 32 + 8 * g + 4 * hi) = w; } }
        }
        DF_BAR();
#undef DF_DMA
#undef DF_SEGM
#undef DF_SEGV
#undef DF_PINIT
#undef DF_PREV
#undef DF_LOADV
#undef DF_PV4
#undef DF_LOADK
#undef DF_QK4
    }
}

#define D3_PIN(x) asm volatile("" : "+v"(x))
#define D3_EX(v) __builtin_amdgcn_exp2f(v)
__device__ __forceinline__ void diff_phase3(LAS unsigned char* lds, const DiffArgs A, int vcu, int G) {
    int tid = threadIdx.x; asm volatile("" : "+v"(tid));
    const int lane = tid & 63, r32 = lane & 31, hi = lane >> 5; const int wid = __builtin_amdgcn_readfirstlane(tid >> 6);
    constexpr int P = 3072;
    const unsigned lds0 = (unsigned)(uintptr_t)lds;
    const lds_cptr l3 = (lds_cptr)lds;
    const int mp = wid >> 2, qsub = wid & 3;
    const int nmain = NB * 8 * 32, nunits = nmain + (A.with_ctx ? NB * 8 * 2 : 0);
    for (int u = vcu; u < nunits; u += G) {
        int b, h, qrow0, NT; const bool ctxu = u >= nmain;
        if (!ctxu) { const int qb = u & 31; h = (u >> 5) & 7; b = u >> 8; qrow0 = b * SEQ + 128 * qb + 32 * qsub; NT = 4 + 64; }
        else { const int v = u - nmain; const int qb = v & 1; h = (v >> 1) & 7; b = v >> 4; qrow0 = MX + b * CTXL + 128 * qb + 32 * qsub; NT = 4; }
        const bf16_t* Kc = A.qkv + (size_t)(MX + b * CTXL) * P + 1024 + 128 * h;
        const bf16_t* Kx = A.qkv + (size_t)(b * SEQ) * P + 1024 + 128 * h;
        const int kra = 16 * qsub + (lane >> 3), krb = kra + 8; const int vr0 = 16 * qsub + (lane >> 4); const int vph = lane & 15;
        const unsigned d0 = mp ? (unsigned)vr0 * P + 1024 + ((((vph >> 2) ^ (vr0 & 3)) << 2) | (vph & 3)) * 8 : (unsigned)kra * P + (((lane & 7) ^ ((kra >> 1) & 7)) * 8);
        const unsigned d1 = mp ? d0 + 4 * P : (unsigned)krb * P + (((lane & 7) ^ ((krb >> 1) & 7)) * 8);
        const unsigned inc2 = mp ? 8 * P : 64;
        const unsigned e0 = lds0 + (mp ? 32768 + qsub * 4096 : qsub * 2048), e2 = e0 + (mp ? 2048 : 8192);
#define D3_DMA(t) do { const int t_ = (t); if (t_ < NT) { const bf16_t* base_ = (t_ < 4) ? Kc + (size_t)t_ * 64 * P : Kx + (size_t)(t_ - 4) * 64 * P; \
        const unsigned so_ = (mp ? (t_ & 3) : (t_ & 1)) * 16384; \
        glds16(base_ + d0,        (unsigned)__builtin_amdgcn_readfirstlane(e0 + so_)); \
        glds16(base_ + d1,        (unsigned)__builtin_amdgcn_readfirstlane(e0 + so_ + 1024)); \
        glds16(base_ + d0 + inc2, (unsigned)__builtin_amdgcn_readfirstlane(e2 + so_)); \
        glds16(base_ + d1 + inc2, (unsigned)__builtin_amdgcn_readfirstlane(e2 + so_ + 1024)); } } while (0)
#define D3_WAITBAR(T) do { if (mp == 0 || (T) + 1 >= NT) DF_BARV(); else asm volatile("s_waitcnt vmcnt(4) lgkmcnt(0)\n\ts_barrier" ::: "memory"); } while (0)
        D3_DMA(0);
        bf16x8 qr[4];
        { const bf16_t* Qw = A.q + ((size_t)(qrow0 >> 5) * 16 + 2 * h + mp) * 2048 + hi * 256 + r32 * 8;
#pragma unroll
          for (int d0 = 0; d0 < 4; ++d0) qr[d0] = *(const bf16x8*)(Qw + d0 * 512); }
        f32x16 oT[4]; oT[0] = f32x16{}; oT[1] = f32x16{}; oT[2] = f32x16{}; oT[3] = f32x16{};
        f32x16 negm;
        float m = 0.f, l = 0.f, rf = 1.f; bool resc = false;
        f32x16 pA0, pA1, pB0, pB1; u32x4 pw0, pw1, pw2, pw3;
        const int ksw = (r32 >> 1) & 7; const lds_cptr kp0 = l3 + mp * 8192 + r32 * 128 + ((hi ^ (ksw & 1)) << 4); const int ks2 = ksw >> 1;
        const int vq = (lane & 15) >> 2; const lds_cptr vp0 = l3 + 32768 + (4 * hi + vq) * 256 + ((lane >> 4) & 1) * 32 + (lane & 3) * 8;
#define D3_KF(kb_, g) (*(const LAS bf16x8*)((kb_) + (((((g) >> 1)) ^ ks2) << 5) + ((g) & 1) * 4096))
#define D3_VF(vp_, g) ({ const lds_cptr vd_ = (vp_) + (((((g) >> 2)) ^ vq) << 6) + ((g) & 3) * 4096; const s16x4 lo_ = vtr(vd_), hi_ = vtr(vd_ + 2048); (bf16x8){lo_[0], lo_[1], lo_[2], lo_[3], hi_[0], hi_[1], hi_[2], hi_[3]}; })
#define D3_PK(P, B) cvtpk(P[B], P[(B) + 1])
#define D3_KSEL(g) (((g) & 1) ? kf1 : kf0)
#define D3_GA(g, C0, C1, Q0, Q1, HASQK, HASVA, FIRST) do { \
        if (HASQK) { \
            if ((g) == 0) { if (FIRST) C0 = __builtin_amdgcn_mfma_f32_32x32x16_bf16(D3_KSEL(g), qr[0], f32x16{}, 0, 0, 0); else C0 = __builtin_amdgcn_mfma_f32_32x32x16_bf16(D3_KSEL(g), qr[0], negm, 0, 0, 0); } \
            else if ((g) == 1) { if (FIRST) C1 = __builtin_amdgcn_mfma_f32_32x32x16_bf16(D3_KSEL(g), qr[0], f32x16{}, 0, 0, 0); else C1 = __builtin_amdgcn_mfma_f32_32x32x16_bf16(D3_KSEL(g), qr[0], negm, 0, 0, 0); } \
            else if ((g) & 1) C1 = __builtin_amdgcn_mfma_f32_32x32x16_bf16(D3_KSEL(g), qr[(g) >> 1], C1, 0, 0, 0); else C0 = __builtin_amdgcn_mfma_f32_32x32x16_bf16(D3_KSEL(g), qr[(g) >> 1], C0, 0, 0, 0); \
            if ((g) + 2 < 8) { if ((g) & 1) kf1 = D3_KF(kb_, (g) + 2); else kf0 = D3_KF(kb_, (g) + 2); } } \
        if (HASVA) { if ((g) == 6) vf0 = D3_VF(vp_, 0); if ((g) == 7) vf1 = D3_VF(vp_, 1); } \
        if (HASVA) { if ((g) < 5) { Q1[5 + 2 * (g)] = D3_EX(Q1[5 + 2 * (g)]); Q1[6 + 2 * (g)] = D3_EX(Q1[6 + 2 * (g)]); } if ((g) == 5) { Q1[15] = D3_EX(Q1[15]); } \
            if ((g) == 0) { pw0[0] = D3_PK(Q0, 0); pw0[1] = D3_PK(Q0, 2); } if ((g) == 1) { pw0[2] = D3_PK(Q0, 4); pw0[3] = D3_PK(Q0, 6); D3_PIN(pw0); } \
            if ((g) == 2) { pw1[0] = D3_PK(Q0, 8); pw1[1] = D3_PK(Q0, 10); } if ((g) == 3) { pw1[2] = D3_PK(Q0, 12); pw1[3] = D3_PK(Q0, 14); D3_PIN(pw1); } \
            if ((g) == 4) { pw2[0] = D3_PK(Q1, 0); pw2[1] = D3_PK(Q1, 2); } if ((g) == 5) { pw2[2] = D3_PK(Q1, 4); pw2[3] = D3_PK(Q1, 6); D3_PIN(pw2); } \
            if ((g) == 6) { pw3[0] = D3_PK(Q1, 8); pw3[1] = D3_PK(Q1, 10); } if ((g) == 7) { pw3[2] = D3_PK(Q1, 12); pw3[3] = D3_PK(Q1, 14); D3_PIN(pw3); } \
            } \
        SBAR(); } while (0)
#define D3_PWSEL(g) (((g) & 3) == 0 ? pw0 : ((g) & 3) == 1 ? pw1 : ((g) & 3) == 2 ? pw2 : pw3)
#define D3_EXI(C0, C1, e) do { if ((e) < 16) C0[(e) & 15] = D3_EX(C0[(e) & 15]); else C1[(e) & 15] = D3_EX(C1[(e) & 15]); } while (0)
#define D3_GB(g, C0, C1, Q0, Q1, HASPV, HASVB, FIRST) do { \
        if (HASPV) { \
            oT[(g) >> 2] = __builtin_amdgcn_mfma_f32_32x32x16_bf16(((g) & 1) ? vf1 : vf0, __builtin_bit_cast(bf16x8, D3_PWSEL(g)), oT[(g) >> 2], 0, 0, 0); \
            if ((g) + 2 < 16) { if ((g) & 1) vf1 = D3_VF(vp_, (g) + 2); else vf0 = D3_VF(vp_, (g) + 2); } } \
        if (HASPV) { if ((g) < 4) { sacc += Q0[4 * ((g) & 3)]; sacc += Q0[4 * ((g) & 3) + 1]; sacc += Q0[4 * ((g) & 3) + 2]; sacc += Q0[4 * ((g) & 3) + 3]; D3_PIN(sacc); } \
            else if ((g) < 8) { sacc += Q1[4 * ((g) & 3)]; sacc += Q1[4 * ((g) & 3) + 1]; sacc += Q1[4 * ((g) & 3) + 2]; sacc += Q1[4 * ((g) & 3) + 3]; D3_PIN(sacc); } \
            else if ((g) == 8) { l += sacc; } } \
        if (HASVB) { if ((g) < 4) { rmx = fmaxf(fmaxf(rmx, C0[4 * ((g) & 3)]), C0[4 * ((g) & 3) + 1]); rmx = fmaxf(fmaxf(rmx, C0[4 * ((g) & 3) + 2]), C0[4 * ((g) & 3) + 3]); D3_PIN(rmx); } \
            else if ((g) < 8) { rmx = fmaxf(fmaxf(rmx, C1[4 * ((g) & 3)]), C1[4 * ((g) & 3) + 1]); rmx = fmaxf(fmaxf(rmx, C1[4 * ((g) & 3) + 2]), C1[4 * ((g) & 3) + 3]); D3_PIN(rmx); } \
            else if ((g) == 8) { rmx = hmax(rmx); resc = false; \
                if (FIRST || __any(rmx > DF_THR)) { const float dl = FIRST ? rmx : fmaxf(rmx, 0.f); m += dl; \
                    _Pragma("unroll") for (int r_ = 0; r_ < 16; ++r_) { C0[r_] -= dl; C1[r_] -= dl; negm[r_] = -m; } D3_PIN(negm); \
                    rf = D3_EX(-dl); l *= rf; resc = true; } } \
            else { const int e0_ = 3 * ((g) - 9);   \
                D3_EXI(C0, C1, e0_); D3_EXI(C0, C1, e0_ + 1); D3_EXI(C0, C1, e0_ + 2); if (e0_ + 2 < 16) D3_PIN(C0); else D3_PIN(C1); } } \
        SBAR(); } while (0)
#define D3_STEP(C0, C1, Q0, Q1, HASQK, HASPREV, FIRST, T) do { \
        const lds_cptr kb_ = kp0 + ((T) & 1) * 16384; const lds_cptr vp_ = vp0 + (((T) - 1) & 3) * 16384; bf16x8 kf0, kf1, vf0, vf1; float sacc = 0.f, rmx = -3.0e38f; \
        if (HASQK) D3_DMA((T) + 1); \
        SBAR(); if (HASQK) { kf0 = D3_KF(kb_, 0); kf1 = D3_KF(kb_, 1); } \
        D3_GA(0, C0, C1, Q0, Q1, HASQK, HASPREV, FIRST); D3_GA(1, C0, C1, Q0, Q1, HASQK, HASPREV, FIRST); D3_GA(2, C0, C1, Q0, Q1, HASQK, HASPREV, FIRST); D3_GA(3, C0, C1, Q0, Q1, HASQK, HASPREV, FIRST); \
        D3_GA(4, C0, C1, Q0, Q1, HASQK, HASPREV, FIRST); D3_GA(5, C0, C1, Q0, Q1, HASQK, HASPREV, FIRST); D3_GA(6, C0, C1, Q0, Q1, HASQK, HASPREV, FIRST); D3_GA(7, C0, C1, Q0, Q1, HASQK, HASPREV, FIRST); \
        if (HASQK) { if (mp == 1) D3_WAITBAR(T); } \
        D3_GB(0, C0, C1, Q0, Q1, HASPREV, HASQK, FIRST); D3_GB(1, C0, C1, Q0, Q1, HASPREV, HASQK, FIRST); D3_GB(2, C0, C1, Q0, Q1, HASPREV, HASQK, FIRST); D3_GB(3, C0, C1, Q0, Q1, HASPREV, HASQK, FIRST); \
        D3_GB(4, C0, C1, Q0, Q1, HASPREV, HASQK, FIRST); D3_GB(5, C0, C1, Q0, Q1, HASPREV, HASQK, FIRST); D3_GB(6, C0, C1, Q0, Q1, HASPREV, HASQK, FIRST); D3_GB(7, C0, C1, Q0, Q1, HASPREV, HASQK, FIRST); \
        D3_GB(8, C0, C1, Q0, Q1, HASPREV, HASQK, FIRST); D3_GB(9, C0, C1, Q0, Q1, HASPREV, HASQK, FIRST); D3_GB(10, C0, C1, Q0, Q1, HASPREV, HASQK, FIRST); D3_GB(11, C0, C1, Q0, Q1, HASPREV, HASQK, FIRST); \
        D3_GB(12, C0, C1, Q0, Q1, HASPREV, HASQK, FIRST); D3_GB(13, C0, C1, Q0, Q1, HASPREV, HASQK, FIRST); D3_GB(14, C0, C1, Q0, Q1, HASPREV, HASQK, FIRST); D3_GB(15, C0, C1, Q0, Q1, HASPREV, HASQK, FIRST); \
        if (HASQK && resc) { _Pragma("unroll") for (int d_ = 0; d_ < 4; ++d_) oT[d_] = oT[d_] * rf; } \
        if (HASQK) { if (mp == 0) D3_WAITBAR(T); } \
        } while (0)
        DF_BARV();
        D3_STEP(pA0, pA1, pB0, pB1, true, false, true, 0);
        int t = 1;
        for (; t + 1 < NT; t += 2) {
            D3_STEP(pB0, pB1, pA0, pA1, true, true, false, t);
            D3_STEP(pA0, pA1, pB0, pB1, true, true, false, t + 1);
        }
        D3_STEP(pB0, pB1, pA0, pA1, true, true, false, t);
        D3_STEP(pA0, pA1, pB0, pB1, false, true, false, NT);
        l = hsum(l);
        const float il = 1.f / l;
        DF_BAR();
        LAS float* xch = (LAS float*)lds + qsub * 4096 + lane;
        if (mp == 1) { const float sc = il * A.lam;
#pragma unroll
            for (int d = 0; d < 4; ++d)
#pragma unroll
                for (int q = 0; q < 16; ++q) xch[(d * 16 + q) * 64] = oT[d][q] * sc; }
        DF_BAR();
        if (mp == 0) {
            float ss = 0.f;
#pragma unroll
            for (int d = 0; d < 4; ++d)
#pragma unroll
                for (int q = 0; q < 16; ++q) { const float v = oT[d][q] * il - xch[(d * 16 + q) * 64]; oT[d][q] = v; ss += v * v; }
            ss = hsum(ss);
            const float rstd = rsqrtf(ss * (1.f / 128.f) + RMS_EPS) * A.omli;
            LAS unsigned char* stg = lds + qsub * 16384;
#pragma unroll
            for (int d = 0; d < 4; ++d)
#pragma unroll
                for (int g = 0; g < 4; ++g) { const f32x4 gg = *(const f32x4*)(A.subln_g + d * 32 + 8 * g + 4 * hi);
                    u32x2 w; w.x = cvtpk(oT[d][4 * g] * rstd * gg[0], oT[d][4 * g + 1] * rstd * gg[1]); w.y = cvtpk(oT[d][4 * g + 2] * rstd * gg[2], oT[d][4 * g + 3] * rstd * gg[3]);
                    *(LAS u32x2*)(stg + r32 * 272 + (d * 32 + 8 * g + 4 * hi) * 2) = w; }
            stg_flush<4>(stg, A.y + (size_t)qrow0 * DM + h * 128, lane);
        }
        DF_BAR();
#undef D3_DMA
#undef D3_KF
#undef D3_KSEL
#undef D3_VF
#undef D3_PK
#undef D3_GA
#undef D3_GB
#undef D3_EXI
#undef D3_PWSEL
#undef D3_STEP
#undef D3_WAITBAR
    }
}

struct A2Args { const bf16_t* qkv; bf16_t* y; const float* aux; int with_ctx; const bf16_t* q; };
template <int MODE  >
__device__ __forceinline__ void att2_phase(LAS unsigned char* lds, const A2Args A, int vcu, int G) {
    int tid = threadIdx.x; asm volatile("" : "+v"(tid));
    const int lane = tid & 63, r32 = lane & 31, hi = lane >> 5; const int wid = __builtin_amdgcn_readfirstlane(tid >> 6);
    constexpr int P = MODE == 0 ? 1536 : 3072; constexpr int VOFF = MODE == 0 ? 256 : 1024;
    const unsigned lds0 = (unsigned)(uintptr_t)lds;
    const lds_cptr l3 = (lds_cptr)lds;
    const int grp = wid >> 2;
    LAS float* btab = (LAS float*)(lds + NA_BIAS_OFF + 1024);
    const int nmain = MODE == 0 ? NB * 4 * 32 * 2 : NB * 16 * 16;
    const int nunits = nmain + (A.with_ctx ? (MODE == 0 ? NB * 4 * 4 : NB * 16) : 0);
    for (int u = vcu; u < nunits; u += G) {
        int b, hk, hq, qrow0, nwin, k0win; const bool ctxu = u >= nmain; int qs = 0, r = 0, c = 0;
        if (MODE == 0) {
            if (!ctxu) { const int jj = u & 63; hk = (u >> 6) & 3; b = u >> 8; hq = 4 * hk + (wid >> 1); qs = 64 * jj + 32 * (wid & 1); qrow0 = b * SEQ + qs;
                const int ks = max(0, 64 * jj - 128), ke = min(SEQ, 64 * jj + 192); k0win = ks; nwin = (ke - ks) / 64; }
            else { const int v = u - nmain; hk = (v >> 2) & 3; hq = 4 * hk + (v & 3); b = v >> 4; qrow0 = MX + b * CTXL + 32 * wid; nwin = 0; k0win = 0; }
        } else {
            if (!ctxu) { const int uu = u & 15; hk = hq = (u >> 4) & 15; b = u >> 8; r = 4 * uu + (wid >> 1); c = 32 * (wid & 1) + r32; qrow0 = b * SEQ + r * 64 + 32 * (wid & 1);
                const int rs_lo = min(max(4 * uu - 4, 0), 56), rs_hi = min(max(4 * uu + 3 - 4, 0), 56); k0win = rs_lo * 64; nwin = rs_hi + 8 - rs_lo; }
            else { const int v = u - nmain; hk = hq = v & 15; b = v >> 4; qrow0 = MX + b * CTXL + 32 * wid; nwin = 0; k0win = 0; }
        }
        const int NT = 4 + nwin;
        const bf16_t* Kc = A.qkv + (size_t)(MX + b * CTXL) * P + 1024 + 64 * hk;
        const bf16_t* Kx = A.qkv + (size_t)(b * SEQ + k0win) * P + 1024 + 64 * hk;
        const int krow = 8 * wid + (lane >> 3); const size_t koff = (size_t)krow * P + (((lane & 7) ^ ((krow >> 1) & 7)) * 8), voff = (size_t)krow * P + VOFF + (((lane & 7) ^ (((krow >> 1) & 1) << 2)) * 8);
#define A2_DMA(t) do { if ((t) < NT) { const int slot_ = (t) % 3; const bf16_t* base_ = ((t) < 4) ? Kc + (size_t)(t) * 64 * P : Kx + (size_t)((t) - 4) * 64 * P; \
        glds16(base_ + koff, (unsigned)__builtin_amdgcn_readfirstlane(lds0 + slot_ * 16384 + wid * 1024)); \
        glds16(base_ + voff, (unsigned)__builtin_amdgcn_readfirstlane(lds0 + slot_ * 16384 + 8192 + wid * 1024)); } } while (0)
        A2_DMA(0);
        if (MODE == 1) { if (!ctxu && tid < 15 * 31) btab[tid] = A.aux[hq * 465 + tid] * LOG2E; }
        bf16x8 qr[4];
        { const bf16_t* Qw = A.q + ((size_t)(qrow0 >> 5) * 16 + hq) * 2048 + hi * 256 + r32 * 8;
#pragma unroll
          for (int d0 = 0; d0 < 4; ++d0) qr[d0] = *(const bf16x8*)(Qw + d0 * 512); }
        f32x16 oT[2]; oT[0] = f32x16{}; oT[1] = f32x16{};
        float m = 0.f, l = 0.f;
        f32x16 p0, p1; u32x4 pw[4];
        const int ksw = (r32 >> 1) & 7; const lds_cptr kp0 = l3 + r32 * 128 + ((hi ^ (ksw & 1)) << 4); const int ks2 = ksw >> 1;
        const int vq = (lane & 15) >> 2, vsq = (vq >> 1) & 1; const lds_cptr vp0 = l3 + 8192 + (4 * hi + vq) * 128 + ((lane >> 4) & 1) * 32 + (lane & 3) * 8;
        const int rs = min(max(r - 4, 0), 56), cs = min(max(c - 8, 0), 48);
#define A2_LOADV(dst, vp_, d) do { const lds_cptr vd_ = (vp_) + (((d) ^ vsq) << 6); _Pragma("unroll") for (int ks = 0; ks < 4; ++ks) { const s16x4 lo_ = vtr(vd_ + ks * 2048), hi_ = vtr(vd_ + ks * 2048 + 1024); \
            dst[ks] = (bf16x8){lo_[0], lo_[1], lo_[2], lo_[3], hi_[0], hi_[1], hi_[2], hi_[3]}; } } while (0)
#define A2_PV4(src, d) do { _Pragma("unroll") for (int ks = 0; ks < 4; ++ks) oT[d] = __builtin_amdgcn_mfma_f32_32x32x16_bf16(src[ks], __builtin_bit_cast(bf16x8, pw[ks]), oT[d], 0, 0, 0); } while (0)
#define A2_LOADK(dst, kb_, dd) do { dst[0] = *(const LAS bf16x8*)((kb_) + ((((dd)) ^ ks2) << 5)); dst[1] = *(const LAS bf16x8*)((kb_) + ((((dd)) ^ ks2) << 5) + 4096); \
            dst[2] = *(const LAS bf16x8*)((kb_) + ((((dd) + 1) ^ ks2) << 5)); dst[3] = *(const LAS bf16x8*)((kb_) + ((((dd) + 1) ^ ks2) << 5) + 4096); } while (0)
#define A2_QK4(src, dd) do { p0 = __builtin_amdgcn_mfma_f32_32x32x16_bf16(src[0], qr[dd], p0, 0, 0, 0); p1 = __builtin_amdgcn_mfma_f32_32x32x16_bf16(src[1], qr[dd], p1, 0, 0, 0); \
            p0 = __builtin_amdgcn_mfma_f32_32x32x16_bf16(src[2], qr[(dd) + 1], p0, 0, 0, 0); p1 = __builtin_amdgcn_mfma_f32_32x32x16_bf16(src[3], qr[(dd) + 1], p1, 0, 0, 0); } while (0)
#define A2_PREV(vso) do { const lds_cptr vq_ = vp0 + (vso); A2_LOADV(fa, vq_, 0); A2_LOADV(fb, vq_, 1); SBAR(); } while (0)
#define A2_PINIT() do { _Pragma("unroll") for (int q_ = 0; q_ < 16; ++q_) { p0[q_] = -m; p1[q_] = -m; } } while (0)
#define A2_SEGM(DO_PV, DO_QK, vso, kso) do { const lds_cptr kb_ = kp0 + (kso); SBAR(); __builtin_amdgcn_s_setprio(1); \
        if (DO_PV) { A2_PV4(fa, 0); if (DO_QK) { A2_PINIT(); } SBAR(); if (DO_QK) { A2_LOADK(fa, kb_, 0); } SBAR(); A2_PV4(fb, 1); SBAR(); if (DO_QK) { A2_LOADK(fb, kb_, 2); } SBAR(); } \
        else if (DO_QK) { A2_LOADK(fa, kb_, 0); A2_LOADK(fb, kb_, 2); A2_PINIT(); SBAR(); } \
        if (DO_QK) { A2_QK4(fa, 0); SBAR(); A2_QK4(fb, 2); SBAR(); } \
        __builtin_amdgcn_s_setprio(0); } while (0)
#define A2_SEGV(t) do { \
        if ((t) >= 4) { \
            if (MODE == 0) { const int kb0_ = k0win + 64 * ((t) - 4); if ((kb0_ + 63 > qs + 128) || (kb0_ < qs + 31 - 128)) { const int dq_ = kb0_ + 4 * hi - (qs + r32) + 128; \
                _Pragma("unroll") for (int q_ = 0; q_ < 16; ++q_) { const int kk_ = (q_ & 3) + 8 * (q_ >> 2); if ((unsigned)(dq_ + kk_) > 256u) p0[q_] = NEG_BIG; if ((unsigned)(dq_ + kk_ + 32) > 256u) p1[q_] = NEG_BIG; } } } \
            else { const int kr_ = (k0win >> 6) + (t) - 4; const bool rowok_ = (kr_ >= rs) && (kr_ < rs + 8); const int rel_ = rowok_ ? 4 * hi - cs : 1000; const LAS float* bp_ = btab + (rowok_ ? kr_ - r + 7 : 0) * 31 + 4 * hi - c + 15; \
                _Pragma("unroll") for (int q_ = 0; q_ < 16; ++q_) { const int kk_ = (q_ & 3) + 8 * (q_ >> 2); const float b0_ = bp_[kk_], b1_ = bp_[kk_ + 32]; \
                    p0[q_] = ((unsigned)(rel_ + kk_) < 16u) ? p0[q_] + b0_ : NEG_BIG; p1[q_] = ((unsigned)(rel_ + kk_ + 32) < 16u) ? p1[q_] + b1_ : NEG_BIG; } } } \
        float rm = p0[0]; \
        _Pragma("unroll") for (int q_ = 1; q_ < 16; ++q_) rm = fmaxf(rm, p0[q_]); \
        _Pragma("unroll") for (int q_ = 0; q_ < 16; ++q_) rm = fmaxf(rm, p1[q_]); \
        rm = hmax(rm); \
        if ((t) == 0 || __any(rm > DF_THR)) { const float dl = ((t) == 0) ? rm : fmaxf(rm, 0.f); m += dl; \
            _Pragma("unroll") for (int q_ = 0; q_ < 16; ++q_) { p0[q_] -= dl; p1[q_] -= dl; } \
            const float f = __builtin_amdgcn_exp2f(-dl); l *= f; oT[0] = oT[0] * f; oT[1] = oT[1] * f; } \
        float s_ = 0.f; \
        _Pragma("unroll") for (int q_ = 0; q_ < 16; ++q_) { p0[q_] = __builtin_amdgcn_exp2f(p0[q_]); p1[q_] = __builtin_amdgcn_exp2f(p1[q_]); s_ += p0[q_] + p1[q_]; } \
        l += s_; \
        _Pragma("unroll") for (int k = 0; k < 2; ++k) { \
            pw[k]     = (u32x4){cvtpk(p0[8 * k], p0[8 * k + 1]), cvtpk(p0[8 * k + 2], p0[8 * k + 3]), cvtpk(p0[8 * k + 4], p0[8 * k + 5]), cvtpk(p0[8 * k + 6], p0[8 * k + 7])}; \
            pw[2 + k] = (u32x4){cvtpk(p1[8 * k], p1[8 * k + 1]), cvtpk(p1[8 * k + 2], p1[8 * k + 3]), cvtpk(p1[8 * k + 4], p1[8 * k + 5]), cvtpk(p1[8 * k + 6], p1[8 * k + 7])}; } \
        } while (0)
        DF_BARV();
        int so_p = 0, so_c = 0;
#define A2_ROT() do { so_p = so_c; so_c = (so_c == 32768) ? 0 : so_c + 16384; } while (0)
        bf16x8 fa[4], fb[4];
        if (grp == 0) {
            A2_DMA(1); A2_SEGM(false, true, 0, so_c); SBAR(); A2_PREV(so_c); A2_SEGV(0); SBAR(); DF_BARV(); SBAR();
            for (int t = 1; t < NT; ++t) { A2_ROT();
                A2_DMA(t + 1); A2_SEGM(true, true, so_p, so_c); SBAR(); A2_PREV(so_c); A2_SEGV(t); SBAR(); DF_BARV(); SBAR(); }
            A2_ROT();
            A2_SEGM(true, false, so_p, 0); SBAR(); DF_BARV(); SBAR();
        } else {
            A2_DMA(1); A2_SEGM(false, true, 0, so_c); SBAR(); DF_BARV(); SBAR();
            for (int t = 1; t < NT; ++t) { A2_ROT();
                A2_DMA(t + 1); A2_PREV(so_p); A2_SEGV(t - 1); SBAR(); A2_SEGM(true, true, so_p, so_c); SBAR(); DF_BARV(); SBAR(); }
            A2_ROT();
            A2_PREV(so_p); A2_SEGV(NT - 1); SBAR(); A2_SEGM(true, false, so_p, 0); SBAR(); DF_BARV(); SBAR();
        }
        l = hsum(l);
        if (MODE == 0) l += __builtin_amdgcn_exp2f(A.aux[hq] * LOG2E - m);
        if (OUTPROJ_FP8) store_oT<2>(oT, 1.f / l, A.y, (size_t)(qrow0 + r32) * DM + hq * 64, hi);
        else { LAS unsigned char* stg = lds + wid * 8192; const float sc_ = 1.f / l;
#pragma unroll
            for (int d = 0; d < 2; ++d)
#pragma unroll
                for (int g = 0; g < 4; ++g) { u32x2 w; w.x = cvtpk(oT[d][4 * g] * sc_, oT[d][4 * g + 1] * sc_); w.y = cvtpk(oT[d][4 * g + 2] * sc_, oT[d][4 * g + 3] * sc_);
                    *(LAS u32x2*)(stg + r32 * 144 + (d * 32 + 8 * g + 4 * hi) * 2) = w; }
            stg_flush<2>(stg, A.y + (size_t)qrow0 * DM + hq * 64, lane); }
        DF_BAR();
#undef A2_DMA
#undef A2_LOADV
#undef A2_PV4
#undef A2_LOADK
#undef A2_QK4
#undef A2_SEGM
#undef A2_SEGV
#undef A2_PREV
#undef A2_PINIT
#undef A2_ROT
    }
}
#undef SBAR
}

struct Frame {
    LAS unsigned char* lds; volatile LAS unsigned* MISC; unsigned* ctl;
    int tid, lane, wave, vcu, G;
};

__device__ __forceinline__ void transpose_item(const float* W, int K, int N, bf16_t* WT, int k0, int n0, int drow0, LAS float* scr, int lane) {
    f32x4 v[16];
    const float* src = W + (size_t)(k0 + (lane >> 4)) * N + n0 + 4 * (lane & 15);
#pragma unroll
    for (int i = 0; i < 16; ++i) v[i] = *(const f32x4*)(src + (size_t)(4 * i) * N);
#pragma unroll
    for (int i = 0; i < 16; ++i) { LAS float* d = scr + (4 * i + (lane >> 4)) * 65 + 4 * (lane & 15); d[0] = v[i].x; d[1] = v[i].y; d[2] = v[i].z; d[3] = v[i].w; }
    LDS_WAIT(); asm volatile("" ::: "memory");
    const int c = lane & 7;
#pragma unroll
    for (int j = 0; j < 8; ++j) { const int n = (lane >> 3) + 8 * j; const LAS float* s = scr + (8 * c) * 65 + n;
        u32x4 o; o.x = cvtpk(s[0 * 65], s[1 * 65]); o.y = cvtpk(s[2 * 65], s[3 * 65]); o.z = cvtpk(s[4 * 65], s[5 * 65]); o.w = cvtpk(s[6 * 65], s[7 * 65]);
        *(u32x4*)(WT + (size_t)(drow0 + n) * K + k0 + 8 * c) = o; }
    LDS_WAIT(); asm volatile("" ::: "memory");
}

enum { KA_x, KA_c, KA_ctx, KA_c_ctx, KA_ada_w, KA_ada_b, KA_norm1_g, KA_norm2_g, KA_final_g, KA_win_w_in, KA_win_w_out, KA_win_sink, KA_diff_w_in, KA_diff_w_out, KA_diff_lambda, KA_diff_subln_g,
       KA_na_w_in, KA_na_w_out, KA_na_rpb, KA_router_w, KA_w_gate, KA_w_up, KA_w_down, KA_OUT, KA_WS };
__device__ __forceinline__ const float* karg(int i) { asm volatile("" : "+s"(i)); return (const float*)(((const unsigned long long __attribute__((address_space(4)))*)__builtin_amdgcn_kernarg_segment_ptr())[i]); }
__device__ __forceinline__ void t8_load(f32x4 (&v)[16], const float* W, int N, int k0, int n0, int lane) {
    const float* src = W + (size_t)(k0 + (lane >> 4)) * N + n0 + 4 * (lane & 15);
#pragma unroll
    for (int i = 0; i < 16; ++i) v[i] = *(const f32x4*)(src + (size_t)(4 * i) * N);
}
__device__ __forceinline__ void t8_finish(const f32x4 (&v)[16], int Kb, unsigned char* WT, int k0, int drow0, LAS float* scr, int lane) {
#pragma unroll
    for (int i = 0; i < 16; ++i) { LAS float* d = scr + (4 * i + (lane >> 4)) * 65 + 4 * (lane & 15); d[0] = v[i].x * W8_SCALE; d[1] = v[i].y * W8_SCALE; d[2] = v[i].z * W8_SCALE; d[3] = v[i].w * W8_SCALE; }
    LDS_WAIT(); asm volatile("" ::: "memory");
    const int c = lane & 3;
#pragma unroll
    for (int j = 0; j < 4; ++j) { const int n = (lane >> 2) + 16 * j; const LAS float* s = scr + (16 * c) * 65 + n;
        int w[4];
#pragma unroll
        for (int q = 0; q < 4; ++q) { int t = 0; t = __builtin_amdgcn_cvt_pk_fp8_f32(s[(4 * q) * 65], s[(4 * q + 1) * 65], t, false); t = __builtin_amdgcn_cvt_pk_fp8_f32(s[(4 * q + 2) * 65], s[(4 * q + 3) * 65], t, true); w[q] = t; }
        *(u32x4*)(WT + (size_t)(drow0 + n) * Kb + k0 + 16 * c) = (u32x4){(unsigned)w[0], (unsigned)w[1], (unsigned)w[2], (unsigned)w[3]}; }
    LDS_WAIT(); asm volatile("" ::: "memory");
}
__device__ __forceinline__ void transpose_item8(const float* W, int Kb, int N, unsigned char* WT, int k0, int n0, int drow0, LAS float* scr, int lane) {
    f32x4 v[16]; t8_load(v, W, N, k0, n0, lane); t8_finish(v, Kb, WT, k0, drow0, scr, lane);
}

struct In {
    const float *x, *c, *ctx, *c_ctx, *ada_w, *ada_b, *norm1_g, *norm2_g, *final_g, *win_w_in, *win_w_out, *win_sink, *diff_w_in, *diff_w_out, *diff_lambda, *diff_subln_g,
        *na_w_in, *na_w_out, *na_rpb, *router_w, *w_gate, *w_up, *w_down;
};

__device__ __forceinline__ void phase_prologue(Frame& F, unsigned char* ws) {
    int tid_ = threadIdx.x; asm volatile("" : "+v"(tid_)); const int lane_ = tid_ & 63; const int wave_ = __builtin_amdgcn_readfirstlane(tid_ >> 6);
    LAS float* scr = (LAS float*)(F.lds + wave_ * 16640);
    const int gw = F.vcu * NWAVES + wave_, NGW = F.G * NWAVES;
    if (F.vcu == 0) {
        float* tab = (float*)(ws + WS_TAB);
        for (int i = tid_; i < 1024; i += 512) { const int pos = i >> 4, f = i & 15; const float inv = 1.0f / powf(10000.0f, (float)(2 * f) / 32.0f); const float ang = (float)pos * inv;
            tab[TAB_COS + i] = cosf(ang); tab[TAB_SIN + i] = sinf(ang); }
        if (wave_ == 0) { const float* lp = karg(KA_diff_lambda); const float a = wave_sum(lp[lane_] * lp[64 + lane_]), b2 = wave_sum(lp[128 + lane_] * lp[192 + lane_]);
            const float li = 0.8f - 0.6f * expf(-0.3f * 1.0f); if (lane_ == 0) { tab[TAB_LAM] = expf(a) - expf(b2) + li; tab[TAB_LAM + 1] = 1.0f - li; } }
    }
    {
        bf16_t* pw = (bf16_t*)(ws + WS_PW);
        constexpr int IT_WI = 16 * 24, IT_O = 16 * 16, IT_3 = 16 * 48;
        constexpr int NIT = 2 * IT_WI + 2 * IT_O + IT_3 + IT_O + IT_3 + IT_O;
        for (int it = gw; it < NIT; it += NGW) {
            int r = it; const float* W; bf16_t* WT; int N;
            if (r < 2 * IT_WI) { const int s = r / IT_WI; r -= s * IT_WI; W = karg(KA_win_w_in) + (size_t)s * 1024 * 1536; WT = pw + (PW_WIN_IN / 2) + (size_t)s * 1536 * 1024; N = 1536; }
            else if ((r -= 2 * IT_WI) < 2 * IT_O) { const int s = r / IT_O; r -= s * IT_O; W = karg(KA_win_w_out) + (size_t)s * 1024 * 1024; WT = pw + (PW_WIN_OUT / 2) + (size_t)s * 1024 * 1024; N = 1024; }
            else if ((r -= 2 * IT_O) < IT_3) { W = karg(KA_diff_w_in); WT = pw + PW_DIFF_IN / 2; N = 3072; }
            else if ((r -= IT_3) < IT_O) { W = karg(KA_diff_w_out); WT = pw + PW_DIFF_OUT / 2; N = 1024; }
            else if ((r -= IT_O) < IT_3) { W = karg(KA_na_w_in); WT = pw + PW_NA_IN / 2; N = 3072; }
            else { r -= IT_3; W = karg(KA_na_w_out); WT = pw + PW_NA_OUT / 2; N = 1024; }
            const int nblk = N / 64, kb = r / nblk, nb = r % nblk;
            if ((INPROJ_FP8 && N != 1024) || (OUTPROJ_FP8 && N == 1024)) transpose_item8(W, 1024, N, (unsigned char*)WT, 64 * kb, 64 * nb, 64 * nb, scr, lane_);
            else transpose_item(W, 1024, N, WT, 64 * kb, 64 * nb, 64 * nb, scr, lane_);
        }
    }
    {
        const int NIT = 64 * 1536;
#define MW_DESC(it_, W_, N_, Kb_, WT_, k0_, n0_, dr_) do { const int le_ = (it_) / 1536; int r_ = (it_) % 1536; \
            unsigned char* W1t_ = ws + WS_MOEW + (size_t)le_ * MOEW_E; \
            if (r_ < 1024) { const bool up_ = r_ >= 512; r_ &= 511; W_ = (up_ ? karg(KA_w_up) : karg(KA_w_gate)) + (size_t)le_ * 1024 * 2048; N_ = 2048; Kb_ = 1024; WT_ = W1t_; \
                k0_ = 64 * (r_ / 32); n0_ = 64 * (r_ % 32); dr_ = (n0_ >> 7) * 256 + (up_ ? 128 : 0) + (n0_ & 127); } \
            else { r_ -= 1024; W_ = karg(KA_w_down) + (size_t)le_ * 2048 * 1024; N_ = 1024; Kb_ = 2048; WT_ = W1t_ + (size_t)4096 * 1024; k0_ = 64 * (r_ / 16); n0_ = 64 * (r_ % 16); dr_ = n0_; } } while (0)
        f32x4 va[16], vb[16];
        const float* Wc = nullptr; int Nc = 0, Kbc = 0, k0c = 0, n0c = 0, drc = 0; unsigned char* WTc = nullptr;
        int it = gw;
        if (it < NIT) { MW_DESC(it, Wc, Nc, Kbc, WTc, k0c, n0c, drc); t8_load(va, Wc, Nc, k0c, n0c, lane_); }
        while (it < NIT) {
            const int itn = it + NGW;
            const float* Wn = Wc; int Nn = Nc, Kbn = Kbc, k0n = k0c, n0n = n0c, drn = drc; unsigned char* WTn = WTc;
            if (itn < NIT) { MW_DESC(itn, Wn, Nn, Kbn, WTn, k0n, n0n, drn); t8_load(vb, Wn, Nn, k0n, n0n, lane_); }
            t8_finish(va, Kbc, WTc, k0c, drc, scr, lane_);
#pragma unroll
            for (int i = 0; i < 16; ++i) va[i] = vb[i];
            Wc = Wn; Nc = Nn; Kbc = Kbn; WTc = WTn; k0c = k0n; n0c = n0n; drc = drn; it = itn;
        }
#undef MW_DESC
    }
    __syncthreads();
    {
        LAS float* sc = (LAS float*)F.lds;
        LAS float* red = (LAS float*)(F.lds + 69632);
        for (int i = tid_; i < 17 * 1024; i += 512) { const float v = (i < 16384) ? karg(KA_c)[i] : karg(KA_c_ctx)[i - 16384]; sc[i] = siluf(v); }
        __syncthreads();
        float* mod = (float*)(ws + WS_MOD);
        for (int task = F.vcu; task < 4 * 192; task += F.G) {
            const int L = task / 192, cg = task % 192, col = cg * 32 + (lane_ & 31), kh = lane_ >> 5;
            const float* wp = karg(KA_ada_w) + (size_t)L * 1024 * 6144 + (size_t)(wave_ * 128 + kh * 64) * 6144 + col;
            const LAS float* scp = sc + wave_ * 128 + kh * 64;
            float acc[17];
#pragma unroll
            for (int r = 0; r < 17; ++r) acc[r] = 0.f;
            for (int k0 = 0; k0 < 64; k0 += 16) { float w[16];
#pragma unroll
                for (int kk = 0; kk < 16; ++kk) w[kk] = wp[(size_t)(k0 + kk) * 6144];
#pragma unroll
                for (int kk = 0; kk < 16; ++kk)
#pragma unroll
                    for (int r = 0; r < 17; ++r) acc[r] += scp[r * 1024 + k0 + kk] * w[kk]; }
#pragma unroll
            for (int r = 0; r < 17; ++r) { acc[r] += __shfl_xor(acc[r], 32); if (lane_ < 32) red[(wave_ * 17 + r) * 32 + lane_] = acc[r]; }
            __syncthreads();
            for (int i = tid_; i < 17 * 32; i += 512) { const int r = i >> 5, ln = i & 31; float sum = 0.f;
#pragma unroll
                for (int w = 0; w < 8; ++w) sum += red[(w * 17 + r) * 32 + ln];
                mod[((size_t)L * 17 + r) * 6144 + cg * 32 + ln] = sum + karg(KA_ada_b)[L * 6144 + cg * 32 + ln]; }
            __syncthreads();
        }
    }
}

__device__ __forceinline__ void load_row(const float* row, int lane, f32x4 (&v)[4]) {
    const f32x4* xr = (const f32x4*)row + lane;
#pragma unroll
    for (int j = 0; j < 4; ++j) v[j] = xr[64 * j];
}
__device__ __forceinline__ void load_row_bf16(const bf16_t* row, int lane, u32x2 (&w)[4]) {
    const u32x2* p = (const u32x2*)row + lane;
#pragma unroll
    for (int j = 0; j < 4; ++j) w[j] = p[64 * j];
}
__device__ __forceinline__ void cvt_row_bf16(f32x4 (&v)[4], const u32x2 (&w)[4]) {
#pragma unroll
    for (int j = 0; j < 4; ++j) { v[j].x = __builtin_bit_cast(float, w[j].x << 16); v[j].y = __builtin_bit_cast(float, w[j].x & 0xffff0000u);
        v[j].z = __builtin_bit_cast(float, w[j].y << 16); v[j].w = __builtin_bit_cast(float, w[j].y & 0xffff0000u); }
}
__device__ __forceinline__ void add_row_bf16(f32x4 (&v)[4], const u32x2 (&w)[4]) {
#pragma unroll
    for (int j = 0; j < 4; ++j) { v[j].x += __builtin_bit_cast(float, w[j].x << 16); v[j].y += __builtin_bit_cast(float, w[j].x & 0xffff0000u);
        v[j].z += __builtin_bit_cast(float, w[j].y << 16); v[j].w += __builtin_bit_cast(float, w[j].y & 0xffff0000u); }
}
__device__ __forceinline__ float row_rstd(const f32x4 (&v)[4]) {
    float s = 0.f;
#pragma unroll
    for (int j = 0; j < 4; ++j) s += (v[j].x * v[j].x + v[j].y * v[j].y) + (v[j].z * v[j].z + v[j].w * v[j].w);
    return rsqrtf(wave_sum_fast(s) * (1.f / DM) + RMS_EPS);
}
__device__ __forceinline__ void store_row_bf16(bf16_t* orow, int lane, const f32x4 (&v)[4]) {
    u32x2* o8 = (u32x2*)orow + lane;
#pragma unroll
    for (int j = 0; j < 4; ++j) { u32x2 w; w.x = cvtpk(v[j].x, v[j].y); w.y = cvtpk(v[j].z, v[j].w); o8[64 * j] = w; }
}
__device__ __forceinline__ void store_row_fp8(unsigned char* orow, int lane, const f32x4 (&v)[4], float scale) {
    unsigned* o4 = (unsigned*)orow + lane;
#pragma unroll
    for (int j = 0; j < 4; ++j) { int t = 0; t = __builtin_amdgcn_cvt_pk_fp8_f32(v[j].x * scale, v[j].y * scale, t, false); t = __builtin_amdgcn_cvt_pk_fp8_f32(v[j].z * scale, v[j].w * scale, t, true); o4[64 * j] = (unsigned)t; }
}
struct ModCache { f32x4 sc[4], sh[4]; int b; };
__device__ __forceinline__ void modcache_load(ModCache& M, int b, const float* g, const float* modL, int shift_chunk, int scale_chunk, int lane) {
    if (M.b == b) return; M.b = b;
    const float* mp = modL + (size_t)b * 6144;
#pragma unroll
    for (int j = 0; j < 4; ++j) { const f32x4 gg = ((const f32x4*)g)[lane + 64 * j], s = ((const f32x4*)(mp + scale_chunk * DM))[lane + 64 * j];
        M.sc[j] = gg * (1.f + s); M.sh[j] = ((const f32x4*)(mp + shift_chunk * DM))[lane + 64 * j]; }
}
__device__ __forceinline__ int row_batch(int m) { return m < MX ? (m >> 12) : 16; }

__device__ __forceinline__ void phase_norm1(Frame& F, const float* x, const float* ctx, const float* g1, const float* modL, bf16_t* H, bf16_t* XB) {
    int tid_ = threadIdx.x; asm volatile("" : "+v"(tid_)); const int lane_ = tid_ & 63; const int wave_ = __builtin_amdgcn_readfirstlane(tid_ >> 6);
    const int gw = F.vcu * NWAVES + wave_, NGW = F.G * NWAVES; const int per = (MT + NGW - 1) / NGW;
    ModCache M; M.b = -1;
    const int m0 = gw * per, m1 = min(MT, m0 + per);
    f32x4 nx[4];
    if (m0 < m1) load_row(m0 < MX ? x + (size_t)m0 * DM : ctx + (size_t)(m0 - MX) * DM, lane_, nx);
    for (int m = m0; m < m1; ++m) {
        f32x4 v[4];
#pragma unroll
        for (int j = 0; j < 4; ++j) v[j] = nx[j];
        if (m + 1 < m1) load_row((m + 1) < MX ? x + (size_t)(m + 1) * DM : ctx + (size_t)(m + 1 - MX) * DM, lane_, nx);
        modcache_load(M, row_batch(m), g1, modL, 0, 1, lane_);
        store_row_bf16(XB + (size_t)m * DM, lane_, v);
        const float rstd = row_rstd(v);
#pragma unroll
        for (int j = 0; j < 4; ++j) v[j] = v[j] * rstd * M.sc[j] + M.sh[j];
        if (INPROJ_FP8) store_row_fp8((unsigned char*)H + (size_t)m * DM, lane_, v, H2_SCALE); else store_row_bf16(H + (size_t)m * DM, lane_, v);
    }
}

__device__ __forceinline__ void phase_norm2_router(Frame& F, const bf16_t* XB, const float* g2, const float* modL, const float* rw, unsigned char* H8, float* aff, int nrows, const bf16_t* P, bool do_router = true) {
    int tid_ = threadIdx.x; asm volatile("" : "+v"(tid_)); const int lane = tid_ & 63; const int wave_ = __builtin_amdgcn_readfirstlane(tid_ >> 6);
    LAS float* rwT = (LAS float*)F.lds;
    for (int i = tid_; i < 16384; i += 512) { const int d = i >> 4, e = i & 15; rwT[e * 1024 + d] = rw[i]; }
    __syncthreads();
    const int gw = F.vcu * NWAVES + wave_, NGW = F.G * NWAVES; constexpr int NR2 = 1; const int ngroups = nrows / NR2; const int per = (ngroups + NGW - 1) / NGW;
    ModCache M; M.b = -1;
    const int g0 = gw * per, g1 = min(ngroups, g0 + per);
    constexpr int ND3 = 3;
    u32x2 nx[ND3][4];
#pragma unroll
    for (int k = 0; k < ND3; ++k) if (g0 + k < g1) { load_row_bf16(XB + (size_t)(g0 + k) * DM, lane, nx[k]); }
    for (int gb = g0; gb < g1; gb += ND3)
#pragma unroll
    for (int k = 0; k < ND3; ++k) {
        const int g = gb + k; if (g >= g1) break;
        const int m = NR2 * g;
        f32x4 v[NR2][4];
        cvt_row_bf16(v[0], nx[k]);
        if (g + ND3 < g1) { load_row_bf16(XB + (size_t)(g + ND3) * DM, lane, nx[k]); }
        modcache_load(M, row_batch(m), g2, modL, 3, 4, lane);
#pragma unroll
        for (int r = 0; r < NR2; ++r) { const float rstd = row_rstd(v[r]);
#pragma unroll
            for (int j = 0; j < 4; ++j) v[r][j] = v[r][j] * rstd * M.sc[j] + M.sh[j];
            store_row_fp8(H8 + (size_t)(m + r) * DM, lane, v[r], H2_SCALE); }
        if (!do_router) continue;
        float pe[NR2][16];
        int lo4 = 4 * lane; asm volatile("" : "+v"(lo4));
#pragma unroll
        for (int eb = 0; eb < 16; eb += 4) {
            f32x4 w[4][4];
#pragma unroll
            for (int e4 = 0; e4 < 4; ++e4)
#pragma unroll
                for (int j = 0; j < 4; ++j) w[e4][j] = *(const LAS f32x4*)(rwT + (eb + e4) * 1024 + lo4 + 256 * j);
            __builtin_amdgcn_sched_barrier(0);
#pragma unroll
            for (int e4 = 0; e4 < 4; ++e4) { f32x2 s2 = {0.f, 0.f};
#pragma unroll
                for (int j = 0; j < 4; ++j) { s2 = __builtin_elementwise_fma((f32x2){v[0][j].x, v[0][j].y}, (f32x2){w[e4][j].x, w[e4][j].y}, s2); s2 = __builtin_elementwise_fma((f32x2){v[0][j].z, v[0][j].w}, (f32x2){w[e4][j].z, w[e4][j].w}, s2); }
                pe[0][eb + e4] = s2.x + s2.y; }
            __builtin_amdgcn_sched_barrier(0);
        }
        {
            LAS float* red = (LAS float*)(F.lds + 65536) + wave_ * 1088;
#pragma unroll
            for (int e = 0; e < 16; ++e) red[lane * 17 + e] = pe[0][e];
            const LAS float* rp = red + (lane >> 4) * 272 + (lane & 15);
            float sacc = 0.f;
#pragma unroll
            for (int i = 0; i < 16; ++i) sacc += rp[i * 17];
            sacc += __shfl_xor(sacc, 16); sacc += __shfl_xor(sacc, 32);
            const float mx = row16_max(sacc);
            const float ex = expf(sacc - mx);
            const float sm = row16_sum(ex);
            if (lane < 16) aff[(size_t)m * 16 + lane] = ex / sm;
        }
    }
    __syncthreads();
}

__device__ __forceinline__ void phase_norm2_router_mfma(Frame& F, const bf16_t* XB, const float* g2, const float* modL, const float* rw, unsigned char* H8, float* aff, int nrows) {
    int tid_ = threadIdx.x; asm volatile("" : "+v"(tid_)); const int lane = tid_ & 63; const int wave_ = __builtin_amdgcn_readfirstlane(tid_ >> 6);
    constexpr int AST = 2064;
    LAS unsigned char* Ahi = F.lds; LAS unsigned char* Alo = F.lds + 16 * AST; LAS float* red = (LAS float*)(F.lds + 2 * 16 * AST);
    const int e_ = lane & 15, kg = lane >> 4;
    bf16x8 Bh[4], Bl[4];
#pragma unroll
    for (int s = 0; s < 4; ++s) { const float* wp = rw + (size_t)(128 * wave_ + 32 * s + 8 * kg) * 16 + e_;
        const float x0 = wp[0], x1 = wp[16], x2 = wp[32], x3 = wp[48], x4 = wp[64], x5 = wp[80], x6 = wp[96], x7 = wp[112];
        u32x4 h, l; h.x = cvtpk(x0, x1); h.y = cvtpk(x2, x3); h.z = cvtpk(x4, x5); h.w = cvtpk(x6, x7);
        l.x = cvtpk(x0 - __builtin_bit_cast(float, h.x << 16), x1 - __builtin_bit_cast(float, h.x & 0xffff0000u)); l.y = cvtpk(x2 - __builtin_bit_cast(float, h.y << 16), x3 - __builtin_bit_cast(float, h.y & 0xffff0000u));
        l.z = cvtpk(x4 - __builtin_bit_cast(float, h.z << 16), x5 - __builtin_bit_cast(float, h.z & 0xffff0000u)); l.w = cvtpk(x6 - __builtin_bit_cast(float, h.w << 16), x7 - __builtin_bit_cast(float, h.w & 0xffff0000u));
        Bh[s] = __builtin_bit_cast(bf16x8, h); Bl[s] = __builtin_bit_cast(bf16x8, l); }
    const int ngroups = nrows >> 4; const int per = (ngroups + F.G - 1) / F.G; const int gg0 = F.vcu * per, gg1 = min(ngroups, gg0 + per);
    ModCache M; M.b = -1;
    u32x2 nx[2][4];
    if (gg0 < gg1) { load_row_bf16(XB + (size_t)(gg0 * 16 + 2 * wave_) * DM, lane, nx[0]); load_row_bf16(XB + (size_t)(gg0 * 16 + 2 * wave_ + 1) * DM, lane, nx[1]); }
    for (int gg = gg0; gg < gg1; ++gg) {
        const int mbase = gg * 16;
        f32x4 v[2][4];
        cvt_row_bf16(v[0], nx[0]); cvt_row_bf16(v[1], nx[1]);
        if (gg + 1 < gg1) { load_row_bf16(XB + (size_t)(mbase + 16 + 2 * wave_) * DM, lane, nx[0]); load_row_bf16(XB + (size_t)(mbase + 16 + 2 * wave_ + 1) * DM, lane, nx[1]); }
#pragma unroll
        for (int r = 0; r < 2; ++r) { const int tok = 2 * wave_ + r, m = mbase + tok;
            modcache_load(M, row_batch(m), g2, modL, 3, 4, lane);
            const float rstd = row_rstd(v[r]);
#pragma unroll
            for (int j = 0; j < 4; ++j) v[r][j] = v[r][j] * rstd * M.sc[j] + M.sh[j];
            store_row_fp8(H8 + (size_t)m * DM, lane, v[r], H2_SCALE);
            LAS unsigned char* ah = Ahi + tok * AST + 8 * lane;
#pragma unroll
            for (int j = 0; j < 4; ++j) { const f32x4 x = v[r][j]; u32x2 h, l; h.x = cvtpk(x.x, x.y); h.y = cvtpk(x.z, x.w);
                l.x = cvtpk(x.x - __builtin_bit_cast(float, h.x << 16), x.y - __builtin_bit_cast(float, h.x & 0xffff0000u)); l.y = cvtpk(x.z - __builtin_bit_cast(float, h.y << 16), x.w - __builtin_bit_cast(float, h.y & 0xffff0000u));
                *(LAS u32x2*)(ah + 512 * j) = h; *(LAS u32x2*)(ah + 16 * AST + 512 * j) = l; } }
        __syncthreads();
        f32x4 acc = {0.f, 0.f, 0.f, 0.f};
#pragma unroll
        for (int s = 0; s < 4; ++s) { const LAS unsigned char* ap = Ahi + e_ * AST + 256 * wave_ + 64 * s + 16 * kg;
            const bf16x8 a_h = *(const LAS bf16x8*)ap, a_l = *(const LAS bf16x8*)(ap + 16 * AST);
            acc = __builtin_amdgcn_mfma_f32_16x16x32_bf16(a_h, Bh[s], acc, 0, 0, 0); acc = __builtin_amdgcn_mfma_f32_16x16x32_bf16(a_h, Bl[s], acc, 0, 0, 0); acc = __builtin_amdgcn_mfma_f32_16x16x32_bf16(a_l, Bh[s], acc, 0, 0, 0); }
#pragma unroll
        for (int r = 0; r < 4; ++r) red[wave_ * 256 + (4 * kg + r) * 16 + e_] = acc[r];
        __syncthreads();
        if (tid_ < 256) { float sacc = 0.f;
#pragma unroll
            for (int w = 0; w < 8; ++w) sacc += red[w * 256 + tid_];
            const float mx = row16_max(sacc);
            const float ex = expf(sacc - mx);
            const float sm = row16_sum(ex);
            aff[(size_t)(mbase + (tid_ >> 4)) * 16 + (tid_ & 15)] = ex / sm; }
    }
    __syncthreads();
}

template <int NPT>
__device__ __forceinline__ void topk_task(Frame& F, const float* aff, int rowbase, int n, int cap, int e, int slot_base, unsigned* rowsrc_e, short* slot) {
    int tid_ = threadIdx.x; asm volatile("" : "+v"(tid_)); const int lane_ = tid_ & 63; const int wave_ = __builtin_amdgcn_readfirstlane(tid_ >> 6);
    LAS unsigned* cnt = (LAS unsigned*)F.lds;
    const int tid = tid_, lane = lane_, wave = wave_;
    const bool act = tid * NPT < n;
    unsigned v[NPT];
#pragma unroll
    for (int j = 0; j < NPT; ++j) v[j] = act ? __float_as_uint(aff[(size_t)(rowbase + tid * NPT + j) * 16 + e]) : 0u;
    unsigned T = 0u;
    for (int bit = 30; bit >= 0; --bit) {
        const unsigned cand = T | (1u << bit);
        unsigned c = 0;
#pragma unroll
        for (int j = 0; j < NPT; ++j) c += (act && v[j] >= cand) ? 1u : 0u;
        c = (unsigned)wave_sum((float)c);
        LAS unsigned* cb = cnt + (bit & 1) * 8;
        if (lane == 0) cb[wave] = c;
        __syncthreads();
        unsigned tot = 0;
#pragma unroll
        for (int w = 0; w < 8; ++w) tot += cb[w];
        if (tot >= (unsigned)cap) T = cand;
    }
    unsigned ngt = 0, neq = 0;
#pragma unroll
    for (int j = 0; j < NPT; ++j) { ngt += (act && v[j] > T) ? 1u : 0u; neq += (act && v[j] == T) ? 1u : 0u; }
    unsigned pk = ngt | (neq << 16), inc = pk;
#pragma unroll
    for (int o = 1; o < 64; o <<= 1) { const unsigned t = __shfl_up(inc, o); if (lane >= o) inc += t; }
    LAS unsigned* wtot = cnt + 32;
    __syncthreads();
    if (lane == 63) wtot[wave] = inc;
    __syncthreads();
    unsigned wpre = 0, total = 0;
#pragma unroll
    for (int w = 0; w < 8; ++w) { const unsigned t = wtot[w]; if (w < wave) wpre += t; total += t; }
    const unsigned exc = wpre + inc - pk;
    const unsigned tot_gt = total & 0xffffu;
    const unsigned need_eq = (unsigned)cap - tot_gt;
    unsigned gt_before = exc & 0xffffu, eq_before = exc >> 16;
    if (act) {
#pragma unroll
        for (int j = 0; j < NPT; ++j) {
            const bool g = v[j] > T, q = v[j] == T;
            const bool sel = g || (q && eq_before < need_eq);
            const int tok = tid * NPT + j;
            short sv = -1;
            if (sel) { const unsigned pos = gt_before + min(eq_before, need_eq); sv = (short)(slot_base + pos); rowsrc_e[slot_base + pos] = (unsigned)(rowbase + tok); }
            slot[(size_t)(rowbase + tok) * 16 + e] = sv;
            gt_before += g ? 1u : 0u; eq_before += q ? 1u : 0u;
        }
    }
    __syncthreads();
}
__device__ __forceinline__ void phase_topk(Frame& F, const float* aff, unsigned* rowsrc, short* slot, int nMe, bool with_ctx) {
    const int ntask = NB * NE * (with_ctx ? 2 : 1);
    for (int t = F.vcu; t < ntask; t += F.G) {
        const bool cx = t >= NB * NE; const int tt = cx ? t - NB * NE : t; const int b = tt >> 4, e = tt & 15;
        unsigned* rs_e = rowsrc + (size_t)e * nMe * 256;
        if (!cx) topk_task<8>(F, aff, b * SEQ, SEQ, CAPX, e, b * CAPX, rs_e, slot);
        else topk_task<1>(F, aff, MX + b * CTXL, CTXL, CAPC, e, NB * CAPX + b * CAPC, rs_e, slot);
    }
}

__device__ __forceinline__ void phase_combine(Frame& F, bf16_t* XB, const bf16_t* P, float* xout, const float* modL, const float* aff, const short* slot, const bf16_t* ybuf, int nMe,
                                              int nrows, bool last, const float* gnext, const float* modN, bf16_t* H, const float* final_g, float* dump = nullptr) {
    int tid_ = threadIdx.x; asm volatile("" : "+v"(tid_)); const int lane = tid_ & 63; const int wave_ = __builtin_amdgcn_readfirstlane(tid_ >> 6);
    const int gw = F.vcu * NWAVES + wave_, NGW = F.G * NWAVES; const int per = (nrows + NGW - 1) / NGW;
    ModCache M; M.b = -1;
    f32x4 g2v[4]; int gb = -1;
    const int m0 = gw * per, m1 = min(nrows, m0 + per);
    const size_t estride = (size_t)nMe * 256 * DM;
#define CB_META(m, sv, av) do { sv = (int)slot[(size_t)(m) * 16 + (lane & 15)]; av = aff[(size_t)(m) * 16 + (lane & 15)]; } while (0)
#define CB_ISSUE(m, sv, av, X, Y, AK, REST) do { load_row_bf16(XB + (size_t)(m) * DM, lane, X); \
        unsigned mk_ = (unsigned)__ballot(sv >= 0) & 0xffffu; \
        _Pragma("unroll") for (int k = 0; k < 4; ++k) { \
            if (mk_) { const int e_ = __builtin_ctz(mk_); mk_ &= mk_ - 1u; const int s_ = __builtin_amdgcn_readlane(sv, e_); AK[k] = __builtin_bit_cast(float, __builtin_amdgcn_readlane(__builtin_bit_cast(int, av), e_)); \
                const u32x2* yr_ = (const u32x2*)(ybuf + (size_t)e_ * estride + (size_t)s_ * DM) + lane; \
                _Pragma("unroll") for (int j = 0; j < 4; ++j) Y[k][j] = yr_[64 * j]; } \
            else { AK[k] = 0.f; _Pragma("unroll") for (int j = 0; j < 4; ++j) Y[k][j] = (u32x2){0u, 0u}; } } \
        REST = mk_; } while (0)
    int sv1 = -1, sv2 = -1; float av1 = 0.f, av2 = 0.f;
    u32x2 X[4], Xn[4]; u32x2 Y[4][4], Yn[4][4]; float AK[4], AKn[4]; unsigned rest = 0, restn = 0; int svc = -1, svn = -1; float avc = 0.f, avn = 0.f;
    if (m0 < m1) { CB_META(m0, sv1, av1); CB_ISSUE(m0, sv1, av1, X, Y, AK, rest); svc = sv1; avc = av1; }
    if (m0 + 1 < m1) CB_META(m0 + 1, sv1, av1);
    for (int m = m0; m < m1; ++m) {
        if (m + 1 < m1) { CB_ISSUE(m + 1, sv1, av1, Xn, Yn, AKn, restn); svn = sv1; avn = av1; }
        if (m + 2 < m1) CB_META(m + 2, sv1, av1);
        const int b = row_batch(m);
        if (gb != b) { gb = b;
#pragma unroll
            for (int j = 0; j < 4; ++j) g2v[j] = ((const f32x4*)(modL + (size_t)b * 6144 + 5 * DM))[lane + 64 * j]; }
        f32x4 acc[4];
#pragma unroll
        for (int j = 0; j < 4; ++j) acc[j] = (f32x4){0.f, 0.f, 0.f, 0.f};
#pragma unroll
        for (int k = 0; k < 4; ++k) { const float a = AK[k];
#pragma unroll
            for (int j = 0; j < 4; ++j) { const u32x2 w = Y[k][j];
                acc[j].x += a * __builtin_bit_cast(float, w.x << 16); acc[j].y += a * __builtin_bit_cast(float, w.x & 0xffff0000u);
                acc[j].z += a * __builtin_bit_cast(float, w.y << 16); acc[j].w += a * __builtin_bit_cast(float, w.y & 0xffff0000u); } }
        while (rest) { const int e_ = __builtin_ctz(rest); rest &= rest - 1u; const int s_ = __builtin_amdgcn_readlane(svc, e_); const float a = __builtin_bit_cast(float, __builtin_amdgcn_readlane(__builtin_bit_cast(int, avc), e_));
            const u32x2* yr = (const u32x2*)(ybuf + (size_t)e_ * estride + (size_t)s_ * DM) + lane;
#pragma unroll
            for (int j = 0; j < 4; ++j) { const u32x2 w = yr[64 * j];
                acc[j].x += a * __builtin_bit_cast(float, w.x << 16); acc[j].y += a * __builtin_bit_cast(float, w.x & 0xffff0000u);
                acc[j].z += a * __builtin_bit_cast(float, w.y << 16); acc[j].w += a * __builtin_bit_cast(float, w.y & 0xffff0000u); } }
        f32x4 v[4];
        cvt_row_bf16(v, X);
#pragma unroll
        for (int j = 0; j < 4; ++j) v[j] = v[j] + g2v[j] * acc[j];
        const float rstd = row_rstd(v);
        if (!last) {
            store_row_bf16((dump ? (bf16_t*)dump : XB) + (size_t)m * DM, lane, v);
            modcache_load(M, b, gnext, modN, 0, 1, lane);
#pragma unroll
            for (int j = 0; j < 4; ++j) v[j] = v[j] * rstd * M.sc[j] + M.sh[j];
            if (INPROJ_FP8) store_row_fp8((unsigned char*)H + (size_t)m * DM, lane, v, H2_SCALE); else store_row_bf16(H + (size_t)m * DM, lane, v);
        } else {
            f32x4* o = (f32x4*)((dump ? dump : xout) + (size_t)m * DM) + lane;
#pragma unroll
            for (int j = 0; j < 4; ++j) o[64 * j] = v[j] * rstd * ((const f32x4*)final_g)[lane + 64 * j];
        }
#pragma unroll
        for (int j = 0; j < 4; ++j) { X[j] = Xn[j];
#pragma unroll
            for (int k = 0; k < 4; ++k) Y[k][j] = Yn[k][j]; }
#pragma unroll
        for (int k = 0; k < 4; ++k) AK[k] = AKn[k];
        rest = restn; svc = svn; avc = avn;
    }
#undef CB_META
#undef CB_ISSUE
}

struct Args { In in; float* out; unsigned char* ws; int ph_lo, ph_hi; };
#define WSP(off) ((unsigned char*)karg(KA_WS) + (off))
__global__ void __launch_bounds__(NWAVES * 64, 2) fwd(Args args) {
    extern __shared__ __attribute__((aligned(16))) unsigned char lds_raw[];
    Frame F;
    F.lds = (LAS unsigned char*)lds_raw;
    F.MISC = (volatile LAS unsigned*)(F.lds + MISC_OFF);
    F.tid = threadIdx.x; F.lane = F.tid & 63; F.wave = __builtin_amdgcn_readfirstlane(F.tid >> 6);
    F.G = gridDim.x; { const int bx = blockIdx.x; F.vcu = (F.G % 8 == 0) ? (bx % 8) * (F.G / 8) + bx / 8 : bx; }
    F.ctl = nullptr;
    if (F.tid < 64) ((LAS unsigned*)(F.lds + MISC_OFF))[F.tid] = 0u;
    __syncthreads();
    const int lo = args.ph_lo, hi = args.ph_hi;
    if (hi - lo > 1) (void)xcd_barrier_post((unsigned*)WSP(WS_CTL) + 1024, F.MISC + 8);
#ifndef DBG_ONLY
#define DBG_ONLY -1
#endif
#define PHEN(k) (DBG_ONLY < 0 || ((k) < 2 ? (k) : 2 + (((k) - 2) & 7)) == DBG_ONLY)
#define IN(k) (PHEN(k) && lo <= (k) && (k) < hi)
#ifndef ROUTER_MFMA
#define ROUTER_MFMA 1
#endif
#ifndef DUP_PH
#define DUP_PH -1
#endif
#ifndef DUP_LMASK
#define DUP_LMASK 0xF
#endif
#define NREP(k, L) ((DUP_PH == (k) && ((DUP_LMASK >> (L)) & 1)) ? 2 : 1)
#define SEAM(k) do { if (IN(k) && IN((k) + 1)) { XcdBarrier bar_; bar_.bar = (unsigned*)WSP(WS_CTL) + 1024; bar_.x = xb_xcc_id(); bar_.st = F.MISC + 8; xcd_barrier(bar_); } } while (0)

    if (IN(0)) { for (int rep_ = 0; rep_ < NREP(0, 0); ++rep_) phase_prologue(F, WSP(0)); } SEAM(0);
    if (IN(1)) { phase_norm1(F, karg(KA_x), karg(KA_ctx), karg(KA_norm1_g), (const float*)WSP(WS_MOD), (bf16_t*)WSP(WS_H), (bf16_t*)WSP(WS_XB)); } SEAM(1);

#pragma unroll 1
    for (int L = 0; L < DEPTH; ++L) {
        const int pb = 2 + 8 * L;
        if (hi <= pb || lo >= pb + 8) continue;
        if (IN(pb + 0)) for (int rep_ = 0; rep_ < NREP(2, L); ++rep_) {
            const int kind = L % 3, slot = L / 3; const int Nin = (kind == 0) ? 1536 : 3072;
            const bf16_t* Wt = (const bf16_t*)WSP(WS_PW) + (kind == 0 ? PW_WIN_IN / 2 + (size_t)slot * 1536 * 1024 : kind == 1 ? PW_DIFF_IN / 2 : PW_NA_IN / 2);
            pg8::Gemm g{(const char*)WSP(WS_H), (const char*)Wt, INPROJ_FP8 ? DM : DM * 2, 1 << 20, 0, nullptr};
            pg8::StaticOrder S; S.init(MT / 256, Nin / 256, F.G, (int)blockIdx.x);
            pg8::EpiInProj E{(bf16_t*)WSP(WS_QKV), Nin, 4, kind == 0 ? 5 : (kind == 1 ? 8 : 0), (const float*)WSP(WS_TAB), INPROJ_FP8 ? 1.f / (H2_SCALE * W8_SCALE) : 1.f, kind == 0 ? 5 : 8, (bf16_t*)WSP(WS_P)};
            pg8::gemm_phase<pg8::EpiInProj, false, true, INPROJ_FP8 != 0>(F.lds, g, S, E);
        }
        SEAM(pb + 0);
        if (IN(pb + 1)) for (int rep_ = 0; rep_ < NREP(3, L); ++rep_) {
            const int kind = L % 3, slot = L / 3; const int with_ctx = L < DEPTH - 1 ? 1 : 0;
            if (kind == 0) { att::A2Args A{(const bf16_t*)WSP(WS_QKV), (bf16_t*)WSP(WS_H), karg(KA_win_sink) + slot * 16, with_ctx, (const bf16_t*)WSP(WS_P)}; att::att2_phase<0>(F.lds, A, F.vcu, F.G); }
            else if (kind == 1) { const float* TAB = (const float*)WSP(WS_TAB); att::DiffArgs A{(const bf16_t*)WSP(WS_QKV), (bf16_t*)WSP(WS_H), karg(KA_diff_subln_g), TAB[TAB_LAM], TAB[TAB_LAM + 1], with_ctx, (const bf16_t*)WSP(WS_P)}; att::diff_phase3(F.lds, A, F.vcu, F.G); }
            else { att::A2Args A{(const bf16_t*)WSP(WS_QKV), (bf16_t*)WSP(WS_H), karg(KA_na_rpb), with_ctx, (const bf16_t*)WSP(WS_P)}; att::att2_phase<1>(F.lds, A, F.vcu, F.G); }
        }
        SEAM(pb + 1);
        if (IN(pb + 2)) {
            const int kind = L % 3, slot = L / 3; const bool with_ctx = L < DEPTH - 1;
            const bf16_t* Wt = (const bf16_t*)WSP(WS_PW) + (kind == 0 ? PW_WIN_OUT / 2 + (size_t)slot * 1024 * 1024 : kind == 1 ? PW_DIFF_OUT / 2 : PW_NA_OUT / 2);
            pg8::Gemm g{(const char*)WSP(WS_H), (const char*)Wt, OUTPROJ_FP8 ? DM : DM * 2, 1 << 20, 0, nullptr};
            pg8::StaticOrder S; S.init((with_ctx ? MT : MX) / 256, 4, F.G, (int)blockIdx.x);
            pg8::EpiOutProj E{(bf16_t*)WSP(WS_XB), (const float*)WSP(WS_MOD) + (size_t)L * 17 * 6144, OUTPROJ_FP8 ? 1.f / (Y_SCALE * W8_SCALE) : 1.f};
            pg8::gemm_phase<pg8::EpiOutProj, false, true, OUTPROJ_FP8 != 0>(F.lds, g, S, E);
        }
        SEAM(pb + 2);
        if (IN(pb + 3)) for (int rep_ = 0; rep_ < NREP(5, L); ++rep_) { const bool with_ctx = L < DEPTH - 1;
            if (ROUTER_MFMA && rep_ == 0) phase_norm2_router_mfma(F, (const bf16_t*)WSP(WS_XB), karg(KA_norm2_g) + L * DM, (const float*)WSP(WS_MOD) + (size_t)L * 17 * 6144, karg(KA_router_w) + (size_t)L * DM * NE,
                               (unsigned char*)WSP(WS_H), (float*)WSP(WS_AFF), with_ctx ? MT : MX);
            else phase_norm2_router(F, (const bf16_t*)WSP(WS_XB), karg(KA_norm2_g) + L * DM, (const float*)WSP(WS_MOD) + (size_t)L * 17 * 6144, karg(KA_router_w) + (size_t)L * DM * NE,
                               (unsigned char*)WSP(WS_H), (float*)WSP(WS_AFF), with_ctx ? MT : MX, (const bf16_t*)WSP(WS_P), rep_ == 0); }
        SEAM(pb + 3);
        if (IN(pb + 4)) for (int rep_ = 0; rep_ < NREP(6, L); ++rep_) { const bool with_ctx = L < DEPTH - 1; phase_topk(F, (const float*)WSP(WS_AFF), (unsigned*)WSP(WS_ROWSRC), (short*)WSP(WS_SLOT), with_ctx ? NME_FULL : NME_LAST, with_ctx); }
        SEAM(pb + 4);
        if (IN(pb + 5)) for (int rep_ = 0; rep_ < NREP(7, L); ++rep_) {
            const int nMe = (L < DEPTH - 1) ? NME_FULL : NME_LAST;
            pg8::Gemm g{(const char*)WSP(WS_H), (const char*)WSP(WS_MOEW + (size_t)L * 16 * MOEW_E), DM, nMe, MOEW_E, (const unsigned*)WSP(WS_ROWSRC)};
            pg8::StaticOrder S; S.init(16 * nMe, 16, F.G, (int)blockIdx.x);
            if (DUP_PH == 7 && rep_ == 1) { pg8::EpiSwiglu<true> E{(unsigned char*)WSP(WS_QKV), 1.f / (H2_SCALE * W8_SCALE), HID_SCALE};
                pg8::gemm_phase<pg8::EpiSwiglu<true>, true, true, true>(F.lds, g, S, E); }
            else { pg8::EpiSwiglu<false> E{(unsigned char*)WSP(WS_QKV), 1.f / (H2_SCALE * W8_SCALE), HID_SCALE};
                pg8::gemm_phase<pg8::EpiSwiglu<false>, true, true, true>(F.lds, g, S, E); }
        }
        SEAM(pb + 5);
        if (IN(pb + 6)) for (int rep_ = 0; rep_ < NREP(8, L); ++rep_) {
            const int nMe = (L < DEPTH - 1) ? NME_FULL : NME_LAST;
            pg8::Gemm g{(const char*)WSP(WS_QKV), (const char*)WSP(WS_MOEW + (size_t)L * 16 * MOEW_E + (size_t)4096 * 1024), FF, nMe, MOEW_E, nullptr};
            pg8::StaticOrder S; S.init(16 * nMe, 4, F.G, (int)blockIdx.x);
            pg8::EpiBf16 E{(bf16_t*)WSP(WS_YBUF), DM, 1.f / (HID_SCALE * W8_SCALE)};
            pg8::gemm_phase<pg8::EpiBf16, false, true, true, true>(F.lds, g, S, E);
        }
        SEAM(pb + 6);
        if (IN(pb + 7)) for (int rep_ = NREP(9, L) - 1; rep_ >= 0; --rep_) {
            const bool last = (L == DEPTH - 1); const bool with_ctx = !last;
            phase_combine(F, (bf16_t*)WSP(WS_XB), (const bf16_t*)WSP(WS_P), (float*)karg(KA_OUT), (const float*)WSP(WS_MOD) + (size_t)L * 17 * 6144, (const float*)WSP(WS_AFF), (const short*)WSP(WS_SLOT), (const bf16_t*)WSP(WS_YBUF),
                          with_ctx ? NME_FULL : NME_LAST, with_ctx ? MT : MX, last, karg(KA_norm1_g) + (last ? 0 : (L + 1) * DM), (const float*)WSP(WS_MOD) + (size_t)(last ? 0 : L + 1) * 17 * 6144,
                          rep_ ? (bf16_t*)WSP(WS_QKV + 300 * MiB) : (bf16_t*)WSP(WS_H), karg(KA_final_g), rep_ ? (float*)WSP(WS_QKV) : nullptr);
        }
        SEAM(pb + 7);
    }
#undef IN
#undef SEAM
}

extern "C" void kernel_launch(void* const* d_in, const int* in_sizes, int n_in, void* d_out, int out_size, void* d_ws, size_t ws_size, hipStream_t stream) {
    static int grid = 0;
    if (grid == 0) {
        if (n_in != 23 || out_size != MX * DM || ws_size < WS_END) { fprintf(stderr, "kernel_launch: unexpected shapes: n_in %d out %d ws %zu (need %zu)\n", n_in, out_size, ws_size, (size_t)WS_END); grid = -1; return; }
        int dev = 0, cus = 0, per_cu = 0;
        if (hipGetDevice(&dev) != hipSuccess || hipDeviceGetAttribute(&cus, hipDeviceAttributeMultiprocessorCount, dev) != hipSuccess) { grid = -1; return; }
        if (hipFuncSetAttribute((const void*)fwd, hipFuncAttributeMaxDynamicSharedMemorySize, LDS_BYTES) != hipSuccess) { fprintf(stderr, "kernel_launch: hipFuncSetAttribute failed\n"); grid = -1; return; }
        if (hipOccupancyMaxActiveBlocksPerMultiprocessor(&per_cu, (const void*)fwd, NWAVES * 64, LDS_BYTES) != hipSuccess || per_cu < 1) fprintf(stderr, "kernel_launch: occupancy query says %d\n", per_cu);
        (void)hipGetLastError();
        grid = cus;
    }
    if (grid < 0) return;
    (void)hipMemsetAsync((char*)d_ws + WS_CTL, 0, CTL_ZERO_BYTES, stream);
    Args a{};
    const float** ip = (const float**)&a.in;
    for (int i = 0; i < 23; ++i) ip[i] = (const float*)d_in[i];
    a.out = (float*)d_out; a.ws = (unsigned char*)d_ws;
    if (MK_N_LAUNCHES == 1) { a.ph_lo = 0; a.ph_hi = NPHASES; hipLaunchKernelGGL(fwd, dim3(grid), dim3(NWAVES * 64), LDS_BYTES, stream, a); }
    else for (int p = 0; p < NPHASES; ++p) { a.ph_lo = p; a.ph_hi = p + 1; hipLaunchKernelGGL(fwd, dim3(grid), dim3(NWAVES * 64), LDS_BYTES, stream, a); }
}
```

```cpp
#include <hip/hip_runtime.h>
#include <cstdio>
#include <cstdint>

#ifndef MK_N_LAUNCHES
#define MK_N_LAUNCHES 1
#endif

#define GAS __attribute__((address_space(1)))
#define LAS __attribute__((address_space(3)))
typedef unsigned short bf16_t;
typedef short bf16x8 __attribute__((ext_vector_type(8)));
typedef short s16x4 __attribute__((ext_vector_type(4)));
typedef float f32x4 __attribute__((ext_vector_type(4)));
typedef float f32x2 __attribute__((ext_vector_type(2)));
typedef float f32x16 __attribute__((ext_vector_type(16)));
typedef unsigned u32x4 __attribute__((ext_vector_type(4)));
typedef unsigned u32x2 __attribute__((ext_vector_type(2)));
typedef __bf16 bf16x2_t __attribute__((ext_vector_type(2)));
typedef GAS unsigned gu32;

constexpr int DM = 1024, NB = 16, SEQ = 4096, DEPTH = 4, CTXL = 256, NE = 16, FF = 2048;
constexpr int MX = NB * SEQ;
constexpr int MC = NB * CTXL;
constexpr int MT = MX + MC;
constexpr int CAPX = 512, CAPC = 32;
constexpr int NME_FULL = 34, NME_LAST = 32;
constexpr float C2 = 0.125f * 1.4426950408889634f;
constexpr float LOG2E = 1.4426950408889634f;
constexpr float RMS_EPS = 1e-6f;
constexpr float NEG_BIG = -1e30f;
constexpr int NWAVES = 8;
constexpr int NPHASES = 2 + 8 * DEPTH;

constexpr size_t MiB = 1u << 20;
constexpr size_t WS_CTL = 0, CTL_ZERO_BYTES = 64 * 1024;
constexpr size_t WS_MOD = 1 * MiB;
constexpr size_t WS_TAB = 3 * MiB;
constexpr size_t WS_AFF = 4 * MiB;
constexpr size_t WS_SLOT = 9 * MiB;
constexpr size_t WS_ROWSRC = 12 * MiB;
constexpr size_t WS_CTXRES = 13 * MiB;
constexpr size_t WS_PW = 29 * MiB;
constexpr size_t PW_WIN_IN = 0, PW_WIN_OUT = 6 * MiB, PW_DIFF_IN = 10 * MiB, PW_DIFF_OUT = 16 * MiB, PW_NA_IN = 18 * MiB, PW_NA_OUT = 24 * MiB;
constexpr size_t WS_H = 56 * MiB;
constexpr size_t WS_QKV = 192 * MiB;
constexpr size_t WS_YBUF = 736 * MiB;
constexpr size_t WS_MOEW = 1008 * MiB;
constexpr size_t MOEW_E = (size_t)(4096 * 1024 + 1024 * 2048);
#ifndef INPROJ_FP8
#define INPROJ_FP8 1
#endif
#ifndef OUTPROJ_FP8
#define OUTPROJ_FP8 0
#endif
constexpr float Y_SCALE = 8.f;
constexpr float H2_SCALE = 4.f, HID_SCALE = 2.f, W8_SCALE = 32.f;
constexpr size_t WS_XB = 1536 * MiB;
constexpr size_t WS_END = 1672 * MiB;
constexpr size_t WS_P = 1400 * MiB;
constexpr int TAB_COS = 0, TAB_SIN = 1024, TAB_LAM = 2048;

constexpr int RING_BYTES = 131072;
constexpr int MISC_OFF = 135168;
constexpr int LDS_BYTES = 147456;

#define LDS_WAIT() asm volatile("s_waitcnt lgkmcnt(0)" ::: "memory")
#define VM_WAIT() asm volatile("s_waitcnt vmcnt(0)" ::: "memory")

__device__ __forceinline__ unsigned cvtpk(float lo, float hi) { f32x2 v = {lo, hi}; bf16x2_t b = __builtin_convertvector(v, bf16x2_t); return __builtin_bit_cast(unsigned, b); }
__device__ __forceinline__ float bf2f(unsigned short u) { return __builtin_bit_cast(float, (unsigned)u << 16); }
__device__ __forceinline__ float wave_sum(float v) {
#pragma unroll
    for (int o = 1; o < 64; o <<= 1) v += __shfl_xor(v, o);
    return v;
}
template <int CTRL> __device__ __forceinline__ float dppf(float v) { return __builtin_bit_cast(float, __builtin_amdgcn_update_dpp(0, __builtin_bit_cast(int, v), CTRL, 0xF, 0xF, true)); }
__device__ __forceinline__ float row16_sum(float v) { v += dppf<0xB1>(v); v += dppf<0x4E>(v); v += dppf<0x141>(v); v += dppf<0x140>(v); return v; }
__device__ __forceinline__ float row16_max(float v) { v = fmaxf(v, dppf<0xB1>(v)); v = fmaxf(v, dppf<0x4E>(v)); v = fmaxf(v, dppf<0x141>(v)); v = fmaxf(v, dppf<0x140>(v)); return v; }
__device__ __forceinline__ float rdlane(float v, int l) { return __builtin_bit_cast(float, __builtin_amdgcn_readlane(__builtin_bit_cast(int, v), l)); }
__device__ __forceinline__ float wave_sum_fast(float v) { v = row16_sum(v); return (rdlane(v, 0) + rdlane(v, 16)) + (rdlane(v, 32) + rdlane(v, 48)); }
__device__ __forceinline__ float siluf(float v) { return v / (1.f + __expf(-v)); }

#define XB_TMO      128
#define XB_XCNT(j)  (256  + 64 * (j))
#define XB_XSUB(j)  (1280 + 64 * (j))
#define XB_XGEN(j)  (2304 + 64 * (j))
#define XB_TOP      3328
#define XB_TOPGEN   3392
#define XCD_BAR_WORDS 3456
#define XB_SPIN_CAP (1u << 18)
__device__ __forceinline__ unsigned xb_ld(unsigned* p)              { return __hip_atomic_load(p, __ATOMIC_RELAXED, __HIP_MEMORY_SCOPE_AGENT); }
__device__ __forceinline__ unsigned xb_add(unsigned* p, unsigned v) { return __hip_atomic_fetch_add(p, v, __ATOMIC_RELAXED, __HIP_MEMORY_SCOPE_AGENT); }
__device__ __forceinline__ unsigned xb_xcc_id() { return (unsigned)__builtin_amdgcn_s_getreg((3 << 11) | 20) & 0xFu; }
#define XB_SPIN(cond, bar) do { unsigned _sp = 0; while (cond) { __builtin_amdgcn_s_sleep(1); \
    if ((++_sp & 255u) == 0u) { if (xb_ld(&(bar)[XB_TMO])) break; if (_sp > XB_SPIN_CAP) { atomicAdd(&(bar)[XB_TMO], 1u); break; } } } } while (0)
struct XcdBarrier { unsigned* bar; unsigned x; volatile LAS unsigned* st; };
__device__ __forceinline__ XcdBarrier xcd_barrier_post(unsigned* bar, volatile LAS unsigned* st) {
    XcdBarrier b; b.bar = bar; b.x = xb_xcc_id(); b.st = st;
    if (threadIdx.x == 0) (void)xb_add(&bar[XB_XCNT(b.x)], 1u);
    return b;
}
__device__ __forceinline__ void xcd_barrier_complete(unsigned* bar, unsigned x, unsigned& nloc, unsigned& nx) {
    const unsigned G = gridDim.x * gridDim.y * gridDim.z;
    unsigned sum, cnt, mine, sp = 0u;
    for (;;) {
        sum = 0u; cnt = 0u; mine = 0u;
#pragma unroll
        for (unsigned j = 0; j < 16; ++j) { const unsigned c = xb_ld(&bar[XB_XCNT(j)]); sum += c; cnt += (c > 0u) ? 1u : 0u; mine = (j == x) ? c : mine; }
        if (sum == G) break;
        __builtin_amdgcn_s_sleep(1);
        if ((++sp & 255u) == 0u) { if (xb_ld(&bar[XB_TMO])) break; if (sp > XB_SPIN_CAP) { atomicAdd(&bar[XB_TMO], 1u); break; } }
    }
    nloc = mine > 0u ? mine : 1u; nx = cnt > 0u ? cnt : 1u;
}
__device__ __forceinline__ void xcd_barrier(const XcdBarrier& b) {
    asm volatile("s_waitcnt vmcnt(0)" ::: "memory");
    __syncthreads();
    if (threadIdx.x == 0) {
        unsigned* bar = b.bar;
        __builtin_amdgcn_s_waitcnt(0);
        unsigned nloc = b.st[0], nx = b.st[1];
        if (nloc == 0u) { xcd_barrier_complete(bar, b.x, nloc, nx); b.st[0] = nloc; b.st[1] = nx; }
        const unsigned old = xb_add(&bar[XB_XSUB(b.x)], 1u);
        const unsigned gen = old / nloc;
        if (old + 1u == (gen + 1u) * nloc) {
            __builtin_amdgcn_fence(__ATOMIC_RELEASE, "agent");
            asm volatile("s_waitcnt vmcnt(0)" ::: "memory");
            const unsigned og = xb_add(&bar[XB_TOP], 1u);
            const unsigned tg = og / nx;
            if (og + 1u == (tg + 1u) * nx) xb_add(&bar[XB_TOPGEN], 1u);
            else XB_SPIN(xb_ld(&bar[XB_TOPGEN]) == tg, bar);
            __builtin_amdgcn_fence(__ATOMIC_ACQUIRE, "agent");
            xb_add(&bar[XB_XGEN(b.x)], 1u);
            asm volatile("s_waitcnt vmcnt(0)" ::: "memory");
        } else {
            XB_SPIN(xb_ld(&bar[XB_XGEN(b.x)]) == gen, bar);
            __builtin_amdgcn_fence(__ATOMIC_ACQUIRE, "agent");
            asm volatile("s_waitcnt vmcnt(0)" ::: "memory");
        }
    }
    __syncthreads();
}

namespace pg8 {
constexpr int BM = 256, BK = 64, HALF = 128, HTB = HALF * BK * 2, NXCD = 8, WGM = 4;
typedef int v4i __attribute__((ext_vector_type(4)));
typedef int v8i __attribute__((ext_vector_type(8)));
__host__ __device__ __forceinline__ int lds_byte(int r, int c) { const int st = (r >> 4) * 2 + (c >> 5), rr = r & 15, cc = c & 31, ob = rr * 64 + cc * 2; return st * 1024 + (ob ^ (((ob >> 9) & 1) << 5)); }
__host__ __device__ __forceinline__ void stage_rc(int b, int& R, int& C) { const int st = b / 1024, sb = b % 1024, swz = sb ^ (((sb >> 9) & 1) << 5); R = (st >> 1) * 16 + swz / 64; C = (st & 1) * 32 + (swz % 64) / 2; }
__host__ __device__ __forceinline__ int perm32(int rho) { const int n = rho >> 4, i = rho & 15; return 8 * (i >> 2) + 4 * n + (i & 3); }

struct Unit { int pm, pn; };
struct Gemm { const char* A; const char* Bt; int Kb; int nMe; size_t b_estride; const unsigned* rowsrc; };

struct StaticOrder {
    int nM, nN, nwg, G, c;
    __device__ void init(int nM_, int nN_, int G_, int c_) { nM = nM_; nN = nN_; nwg = nM * nN; G = G_; c = c_; }
    __device__ bool next(int i, Unit& u) const {
        const long L = (long)i * G + c; if (L >= nwg) return false;
        int wgid = (int)L; { const int q = nwg / NXCD, r = nwg % NXCD, xcd = wgid % NXCD, off = wgid / NXCD; wgid = (xcd < r ? xcd * (q + 1) : r * (q + 1) + (xcd - r) * q) + off; }
        const int nig = WGM * nN, gid = wgid / nig, fm = gid * WGM, gsz = (nM - fm) < WGM ? (nM - fm) : WGM;
        u.pm = fm + ((wgid % nig) % gsz); u.pn = (wgid % nig) / gsz; return true;
    }
};

template <class Epi, bool GATHER, bool ALIGN_EPI, bool FP8 = false, bool ABLK = false>
__device__ __forceinline__ void gemm_phase(LAS unsigned char* lds, const Gemm g, const StaticOrder& S, const Epi& E) {
    int tid = threadIdx.x; asm volatile("" : "+v"(tid));
    const int wid = __builtin_amdgcn_readfirstlane(tid >> 6), lane = tid & 63, wr = wid >> 2, wc = wid & 3, fr = lane & 15, fq = lane >> 4;
    const int Kb = g.Kb, nt = Kb / (BK * 2);
    int Rr[2], Cc[2]; unsigned voffB[2];
#pragma unroll
    for (int i = 0; i < 2; ++i) { int R, C; stage_rc(tid * 16 + i * 8192, R, C); const int Rb = Epi::PERM ? ((R & ~31) + perm32(R & 31)) : R;
        Rr[i] = R; Cc[i] = C; voffB[i] = (unsigned)(Rb * Kb + C * 2); }
    const size_t kstep = (size_t)(BK * 2);
    const size_t kstepA = ABLK ? (size_t)32768 : kstep;
    const size_t hstep = (size_t)HALF * Kb;
    const size_t tstep = 2 * hstep;
    const unsigned ldsw = (unsigned)wid * 1024u;
    const int aoff = lds_byte(wr * 64 + fr, fq * 8), boff = lds_byte(wc * 32 + fr, fq * 8);
#define PG8_SA(b, h) (((b) * 2 + (h)) * HTB)
#define PG8_SB(b, h) ((4 + (b) * 2 + (h)) * HTB)
#define PG8_STAGE(bufoff, gbase, voff) do { _Pragma("unroll") for (int _i = 0; _i < 2; ++_i) \
        __builtin_amdgcn_global_load_lds((const unsigned*)((const char*)(gbase) + (voff)[_i]), (LAS unsigned*)(lds + (bufoff) + ldsw + _i * 8192), 16, 0, 0); } while (0)
#define PG8_LDA(dst, b, h) do { _Pragma("unroll") for (int m = 0; m < 4; ++m) _Pragma("unroll") for (int k = 0; k < 2; ++k) dst[m][k] = *(const LAS bf16x8*)(lds + PG8_SA(b, h) + aoff + m * 2048 + k * 1024); } while (0)
#define PG8_LDB(dst, b, h) do { _Pragma("unroll") for (int n = 0; n < 2; ++n) _Pragma("unroll") for (int k = 0; k < 2; ++k) dst[n][k] = *(const LAS bf16x8*)(lds + PG8_SB(b, h) + boff + n * 2048 + k * 1024); } while (0)
#define PG8_MMA(ai, bj, At, Bt, Z) do { __builtin_amdgcn_s_setprio(1); \
        if constexpr (FP8) { if (Epi::ZEROC && (Z)) { _Pragma("unroll") for (int m = 0; m < 4; ++m) _Pragma("unroll") for (int n = 0; n < 2; ++n) { \
            const v8i b8_ = __builtin_shufflevector(__builtin_bit_cast(v4i, Bt[n][0]), __builtin_bit_cast(v4i, Bt[n][1]), 0, 1, 2, 3, 4, 5, 6, 7); \
            const v8i a8_ = __builtin_shufflevector(__builtin_bit_cast(v4i, At[m][0]), __builtin_bit_cast(v4i, At[m][1]), 0, 1, 2, 3, 4, 5, 6, 7); \
            asm volatile("v_mfma_f32_16x16x128_f8f6f4 %0, %1, %2, 0" : "+v"(acc[ai][bj][m][n]) : "v"(b8_), "v"(a8_)); } }   \
          else { _Pragma("unroll") for (int m = 0; m < 4; ++m) _Pragma("unroll") for (int n = 0; n < 2; ++n) { \
            const v8i b8_ = __builtin_shufflevector(__builtin_bit_cast(v4i, Bt[n][0]), __builtin_bit_cast(v4i, Bt[n][1]), 0, 1, 2, 3, 4, 5, 6, 7); \
            const v8i a8_ = __builtin_shufflevector(__builtin_bit_cast(v4i, At[m][0]), __builtin_bit_cast(v4i, At[m][1]), 0, 1, 2, 3, 4, 5, 6, 7); \
            asm volatile("v_mfma_f32_16x16x128_f8f6f4 %0, %1, %2, %0" : "+v"(acc[ai][bj][m][n]) : "v"(b8_), "v"(a8_)); } } } \
        else { _Pragma("unroll") for (int m = 0; m < 4; ++m) _Pragma("unroll") for (int n = 0; n < 2; ++n) _Pragma("unroll") for (int k = 0; k < 2; ++k) \
            acc[ai][bj][m][n] = __builtin_amdgcn_mfma_f32_16x16x32_bf16(Bt[n][k], At[m][k], acc[ai][bj][m][n], 0, 0, 0); } \
        __builtin_amdgcn_s_setprio(0); } while (0)
#define PG8_WAIT_V(n) asm volatile("s_waitcnt vmcnt(" #n ")" ::: "memory")
#define PG8_WAIT_L(n) asm volatile("s_waitcnt lgkmcnt(" #n ")" ::: "memory")
#define PG8_BAR __builtin_amdgcn_s_barrier()
#define PG8_SCHED __builtin_amdgcn_sched_barrier(0)
#define PG8_CALC_VG(VG, U) do { _Pragma("unroll") for (int _h = 0; _h < 2; ++_h) _Pragma("unroll") for (int _i = 0; _i < 2; ++_i) { \
        const unsigned _row = (unsigned)((U).pm * BM + _h * HALF + Rr[_i]); const unsigned _src = GATHER ? g.rowsrc[_row] : _row; \
        if constexpr (ABLK) { const unsigned _r = (unsigned)(_h * HALF + Rr[_i]), _c = (unsigned)Cc[_i] >> 3; \
            VG[_h][_i] = (unsigned)(U).pm * (unsigned)(Kb * BM) + (_r >> 4) * 2048u + (_c >> 1) * 512u + (_r & 15u) * 32u + (_c & 1u) * 16u; } \
        else VG[_h][_i] = _src * (unsigned)Kb + (unsigned)Cc[_i] * 2u; } } while (0)
    Unit cur, nxt; int ui = 0;
    if (!S.next(0, cur)) return;
    f32x4 acc[2][2][4][2];
    if constexpr (!(FP8 && Epi::ZEROC)) {
#pragma unroll
    for (int a = 0; a < 2; ++a)
#pragma unroll
        for (int b = 0; b < 2; ++b)
#pragma unroll
            for (int m = 0; m < 4; ++m)
#pragma unroll
                for (int n = 0; n < 2; ++n) acc[a][b][m][n] = (f32x4){0.f, 0.f, 0.f, 0.f};
    }
    bf16x8 At[4][2], B0[2][2], B1[2][2];
    unsigned vg[2][2], vgn[2][2];
    PG8_CALC_VG(vg, cur);
    const char* const gA = g.A;
    const char* cB = g.Bt + (size_t)(cur.pm / g.nMe) * g.b_estride + (size_t)cur.pn * tstep;
    PG8_STAGE(PG8_SB(0, 0), cB, voffB); PG8_STAGE(PG8_SB(0, 1), cB + hstep, voffB); PG8_STAGE(PG8_SA(0, 0), gA, vg[0]); PG8_STAGE(PG8_SA(0, 1), gA, vg[1]);
    if (wr == 1) PG8_BAR;
    PG8_WAIT_V(2); PG8_BAR;
    PG8_STAGE(PG8_SB(1, 0), cB + kstep, voffB); PG8_STAGE(PG8_SA(1, 0), gA + kstepA, vg[0]); PG8_STAGE(PG8_SB(1, 1), cB + hstep + kstep, voffB);
    PG8_WAIT_V(6); PG8_BAR;
    for (;;) {
        const bool has_next = S.next(ui + 1, nxt);
        LAS unsigned char* const rsb = lds + 131072 + ((ui + 1) & 1) * 1024;
        if (has_next) {
            if constexpr (GATHER) { if (wid == 0) __builtin_amdgcn_global_load_lds((const unsigned*)(g.rowsrc + (size_t)nxt.pm * BM) + lane * 4, (LAS unsigned*)rsb, 16, 0, 0); }
            else { PG8_CALC_VG(vgn, nxt); } }
        else {
#pragma unroll
            for (int _h = 0; _h < 2; ++_h)
#pragma unroll
                for (int _i = 0; _i < 2; ++_i) vgn[_h][_i] = vg[_h][_i]; }
        const char* nB = has_next ? g.Bt + (size_t)(nxt.pm / g.nMe) * g.b_estride + (size_t)nxt.pn * tstep : cB;
        for (int t = 0; t < nt; t += 2) {
            const bool last = (t == nt - 2);
            const char* a1 = gA + (size_t)(t + 1) * kstepA;
            const char* a2 = last ? gA : gA + (size_t)(t + 2) * kstepA; const char* b2 = last ? nB : cB + (size_t)(t + 2) * kstep;
            const char* a3 = a2 + kstepA; const char* b3 = b2 + kstep;
            if constexpr (GATHER) { if (last && has_next) {
#pragma unroll
                for (int _h = 0; _h < 2; ++_h)
#pragma unroll
                    for (int _i = 0; _i < 2; ++_i) vgn[_h][_i] = *(const LAS unsigned*)(rsb + (_h * HALF + Rr[_i]) * 4) * (unsigned)Kb + (unsigned)Cc[_i] * 2u; } }
            unsigned w0[2], w1[2];
#pragma unroll
            for (int _i = 0; _i < 2; ++_i) { w0[_i] = last ? vgn[0][_i] : vg[0][_i]; w1[_i] = last ? vgn[1][_i] : vg[1][_i]; }
            PG8_LDB(B0, 0, 0); PG8_LDB(B1, 0, 1); PG8_SCHED; PG8_LDA(At, 0, 0); PG8_STAGE(PG8_SA(1, 1), a1, vg[1]);
            PG8_WAIT_V(8); PG8_WAIT_L(0); PG8_BAR; PG8_MMA(0, 0, At, B0, t == 0); PG8_MMA(0, 1, At, B1, t == 0); PG8_BAR; PG8_SCHED;
            PG8_LDA(At, 0, 1); PG8_STAGE(PG8_SB(0, 0), b2, voffB); PG8_STAGE(PG8_SB(0, 1), b2 + hstep, voffB); PG8_STAGE(PG8_SA(0, 0), a2, w0);
            PG8_WAIT_V(8); PG8_WAIT_L(0); PG8_BAR; PG8_MMA(1, 0, At, B0, t == 0); PG8_MMA(1, 1, At, B1, t == 0); PG8_BAR; PG8_SCHED;
            PG8_LDB(B0, 1, 0); PG8_LDB(B1, 1, 1); PG8_SCHED; PG8_LDA(At, 1, 0); PG8_STAGE(PG8_SA(0, 1), a2, w1);
            PG8_WAIT_V(8); PG8_WAIT_L(0); PG8_BAR; PG8_MMA(0, 0, At, B0, false); PG8_MMA(0, 1, At, B1, false); PG8_BAR; PG8_SCHED;
            PG8_LDA(At, 1, 1); PG8_STAGE(PG8_SB(1, 0), b3, voffB); PG8_STAGE(PG8_SB(1, 1), b3 + hstep, voffB); PG8_STAGE(PG8_SA(1, 0), a3, w0);
            PG8_WAIT_V(8); PG8_WAIT_L(0); PG8_BAR; PG8_MMA(1, 0, At, B0, false); PG8_MMA(1, 1, At, B1, false); PG8_BAR; PG8_SCHED;
        }
        if constexpr (ALIGN_EPI) { if (wr == 0) PG8_BAR; }
        if constexpr (FP8) asm volatile("s_nop 15\n\ts_nop 15" ::: "memory");
        E(acc, cur, wr, wc, fr, fq);
        if (!has_next) break;
        if constexpr (!(FP8 && Epi::ZEROC)) {
#pragma unroll
        for (int a = 0; a < 2; ++a)
#pragma unroll
            for (int b = 0; b < 2; ++b)
#pragma unroll
                for (int m = 0; m < 4; ++m)
#pragma unroll
                    for (int n = 0; n < 2; ++n) acc[a][b][m][n] = (f32x4){0.f, 0.f, 0.f, 0.f};
        }
        cur = nxt; cB = nB; ++ui;
#pragma unroll
        for (int _h = 0; _h < 2; ++_h)
#pragma unroll
            for (int _i = 0; _i < 2; ++_i) vg[_h][_i] = vgn[_h][_i];
        if constexpr (ALIGN_EPI) { if (wr == 1) PG8_BAR; }
    }
    PG8_WAIT_V(0);
    if constexpr (!ALIGN_EPI) { if (wr == 0) PG8_BAR; }
    PG8_BAR;
#undef PG8_SA
#undef PG8_SB
#undef PG8_STAGE
#undef PG8_LDA
#undef PG8_LDB
#undef PG8_MMA
#undef PG8_WAIT_V
#undef PG8_WAIT_L
#undef PG8_BAR
#undef PG8_SCHED
#undef PG8_CALC_VG
}

struct EpiInProj {
    static constexpr bool PERM = false; static constexpr bool ZEROC = false;
    bf16_t* O; int ldc; int q_tiles; int rope_tiles; const float* tab; float osc; int v_tile0; bf16_t* Q;
    __device__ __forceinline__ void operator()(const f32x4 (&acc)[2][2][4][2], const Unit& u, int wr, int wc, int fr, int fq) const {
        const int row0 = u.pm * BM + wr * 64 + fr, col0 = u.pn * BM + wc * 32 + 4 * fq;
        const float sc = ((u.pn < q_tiles) ? C2 : 1.f) * osc;
        const bool rope = (u.pn < rope_tiles) && (u.pm < MX / BM);
        const int axis = wc & 1; const bool isv = u.pn >= v_tile0;
#pragma unroll
        for (int ai = 0; ai < 2; ++ai)
#pragma unroll
            for (int m = 0; m < 4; ++m) {
                const int row = row0 + ai * HALF + m * 16;
                f32x4 cs = {1.f, 1.f, 1.f, 1.f}, sn = {0.f, 0.f, 0.f, 0.f};
                if (rope) { const int t = row & (SEQ - 1); const int pos = axis ? (t & 63) : (t >> 6); cs = *(const f32x4*)(tab + TAB_COS + pos * 16 + 4 * fq); sn = *(const f32x4*)(tab + TAB_SIN + pos * 16 + 4 * fq); }
                bf16_t* rowp = O + (size_t)row * ldc + col0;
                bf16_t* rowq = (u.pn < q_tiles) ? Q + ((size_t)(row >> 5) * 16 + 4 * u.pn + (wc >> 1)) * 2048 + (2 * (wc & 1) + (fq >> 1)) * 512 + (fq & 1) * 256 + (row & 31) * 8
                                                : O + (size_t)row * ldc + u.pn * BM + wc * 32 + 8 * fq;
                const int qstep = (u.pn < q_tiles) ? 2 * 2048 : HALF;
#pragma unroll
                for (int bj = 0; bj < 2; ++bj) {
                    const f32x4 x1 = acc[ai][bj][m][0] * sc, x2 = acc[ai][bj][m][1] * sc;
                    const f32x4 o1 = x1 * cs - x2 * sn, o2 = x2 * cs + x1 * sn;
                    u32x2 w1, w2; w1.x = cvtpk(o1[0], o1[1]); w1.y = cvtpk(o1[2], o1[3]); w2.x = cvtpk(o2[0], o2[1]); w2.y = cvtpk(o2[2], o2[3]);
                    if (isv) { *(u32x2*)(rowp + bj * HALF) = w1; *(u32x2*)(rowp + bj * HALF + 16) = w2; }
                    else *(u32x4*)(rowq + bj * qstep) = (u32x4){w1.x, w1.y, w2.x, w2.y}; }
            }
    }
};
struct EpiOutProj {
    static constexpr bool PERM = true; static constexpr bool ZEROC = false;
    bf16_t* P; const float* mod; float osc;
    __device__ __forceinline__ void operator()(const f32x4 (&acc)[2][2][4][2], const Unit& u, int wr, int wc, int fr, int fq) const {
        const int b = (u.pm < MX / BM) ? ((u.pm * BM) >> 12) : 16;
        const int row0 = u.pm * BM + wr * 64 + fr, col0 = u.pn * BM + wc * 32 + 8 * fq;
        const float* gp = mod + (size_t)b * 6144 + 2 * DM + col0;
        f32x4 gv[2][2];
#pragma unroll
        for (int bj = 0; bj < 2; ++bj)
#pragma unroll
            for (int n = 0; n < 2; ++n) gv[bj][n] = *(const f32x4*)(gp + bj * HALF + 4 * n) * osc;
#pragma unroll
        for (int ai = 0; ai < 2; ++ai)
#pragma unroll
            for (int m = 0; m < 4; ++m) { bf16_t* rowp = P + (size_t)(row0 + ai * HALF + m * 16) * DM + col0;
                u32x4 xr[2]; xr[0] = *(const u32x4*)rowp; xr[1] = *(const u32x4*)(rowp + HALF);
#pragma unroll
                for (int bj = 0; bj < 2; ++bj) { const f32x4 v0 = acc[ai][bj][m][0] * gv[bj][0], v1 = acc[ai][bj][m][1] * gv[bj][1]; const u32x4 x = xr[bj];
                    u32x4 w; w.x = cvtpk(v0[0] + __builtin_bit_cast(float, x.x << 16), v0[1] + __builtin_bit_cast(float, x.x & 0xffff0000u));
                    w.y = cvtpk(v0[2] + __builtin_bit_cast(float, x.y << 16), v0[3] + __builtin_bit_cast(float, x.y & 0xffff0000u));
                    w.z = cvtpk(v1[0] + __builtin_bit_cast(float, x.z << 16), v1[1] + __builtin_bit_cast(float, x.z & 0xffff0000u));
                    w.w = cvtpk(v1[2] + __builtin_bit_cast(float, x.w << 16), v1[3] + __builtin_bit_cast(float, x.w & 0xffff0000u));
                    *(u32x4*)(rowp + bj * HALF) = w; } }
    }
};
template <bool NOSTORE = false> struct EpiSwiglu {
    static constexpr bool PERM = true; static constexpr bool ZEROC = true;
    unsigned char* O; float in_scale; float out_scale;
    __device__ __forceinline__ void operator()(const f32x4 (&acc)[2][2][4][2], const Unit& u, int wr, int wc, int fr, int fq) const {
        const int row0 = u.pm * BM + wr * 64 + fr, col0 = u.pn * HALF + wc * 32 + 8 * fq;
#pragma unroll
        for (int ai = 0; ai < 2; ++ai)
#pragma unroll
            for (int m = 0; m < 4; ++m) { unsigned char* rowp = O + ((size_t)u.pm * 16 + u.pn) * 32768 + (8 * ai + 4 * wr + m) * 2048 + wc * 512 + fr * 32 + fq * 8;
                float h[8];
                const float c1 = -LOG2E * in_scale, c2i = 1.f / (in_scale * in_scale * out_scale);
#pragma unroll
                for (int n = 0; n < 2; ++n)
#pragma unroll
                    for (int j = 0; j < 4; j += 2) { const f32x2 ag = {acc[ai][0][m][n][j], acc[ai][0][m][n][j + 1]}, au = {acc[ai][1][m][n][j], acc[ai][1][m][n][j + 1]};
                        const f32x2 ea = ag * c1; f32x2 t; t.x = __builtin_amdgcn_exp2f(ea.x); t.y = __builtin_amdgcn_exp2f(ea.y);
                        const f32x2 d = __builtin_elementwise_fma(t, (f32x2){c2i, c2i}, (f32x2){c2i, c2i}); f32x2 r; r.x = __builtin_amdgcn_rcpf(d.x); r.y = __builtin_amdgcn_rcpf(d.y);
                        const f32x2 hv = (ag * au) * r; h[n * 4 + j] = hv.x; h[n * 4 + j + 1] = hv.y; }
                int w0 = 0, w1 = 0;
                w0 = __builtin_amdgcn_cvt_pk_fp8_f32(h[0], h[1], w0, false); w0 = __builtin_amdgcn_cvt_pk_fp8_f32(h[2], h[3], w0, true);
                w1 = __builtin_amdgcn_cvt_pk_fp8_f32(h[4], h[5], w1, false); w1 = __builtin_amdgcn_cvt_pk_fp8_f32(h[6], h[7], w1, true);
                if (NOSTORE) asm volatile("" :: "v"(w0), "v"(w1)); else *(u32x2*)rowp = (u32x2){(unsigned)w0, (unsigned)w1}; }
    }
};
struct EpiBf16 {
    static constexpr bool PERM = true; static constexpr bool ZEROC = true;
    bf16_t* O; int ldc; float sc;
    __device__ __forceinline__ void operator()(const f32x4 (&acc)[2][2][4][2], const Unit& u, int wr, int wc, int fr, int fq) const {
        const int row0 = u.pm * BM + wr * 64 + fr, col0 = u.pn * BM + wc * 32 + 8 * fq;
#pragma unroll
        for (int ai = 0; ai < 2; ++ai)
#pragma unroll
            for (int m = 0; m < 4; ++m) { bf16_t* rowp = O + (size_t)(row0 + ai * HALF + m * 16) * ldc + col0;
#pragma unroll
                for (int bj = 0; bj < 2; ++bj) { const f32x4 v0 = acc[ai][bj][m][0] * sc, v1 = acc[ai][bj][m][1] * sc;
                    u32x4 w; w.x = cvtpk(v0[0], v0[1]); w.y = cvtpk(v0[2], v0[3]); w.z = cvtpk(v1[0], v1[1]); w.w = cvtpk(v1[2], v1[3]);
                    *(u32x4*)(rowp + bj * HALF) = w; } }
    }
};
}

namespace att {
#define SBAR() __builtin_amdgcn_sched_barrier(0)
__device__ __forceinline__ int crow(int r, int hi) { return (r & 3) + 8 * (r >> 2) + 4 * hi; }
__device__ __forceinline__ void glds16(const void* gsrc, unsigned lds_dst) { unsigned keep;
    asm volatile("s_mov_b32 %0, m0\n\ts_mov_b32 m0, %2\n\ts_nop 0\n\tglobal_load_lds_dwordx4 %1, off\n\ts_mov_b32 m0, %0" : "=&s"(keep) : "v"(gsrc), "s"(lds_dst) : "memory"); }
#define WAIT_BAR0() asm volatile("s_waitcnt vmcnt(0) lgkmcnt(0)\n\ts_barrier" ::: "memory")
typedef LAS const char* lds_cptr;
typedef short v4i16_t __attribute__((ext_vector_type(4)));
__device__ __forceinline__ s16x4 vtr(lds_cptr p) { return __builtin_bit_cast(s16x4, __builtin_amdgcn_ds_read_tr16_b64_v4i16((LAS v4i16_t*)p)); }
__device__ __forceinline__ float hmax(float m) { auto rr = __builtin_amdgcn_permlane32_swap(__float_as_uint(m), __float_as_uint(m), false, false); return fmaxf(__uint_as_float(rr[0]), __uint_as_float(rr[1])); }
__device__ __forceinline__ float hsum(float m) { auto rr = __builtin_amdgcn_permlane32_swap(__float_as_uint(m), __float_as_uint(m), false, false); return __uint_as_float(rr[0]) + __uint_as_float(rr[1]); }

__device__ __forceinline__ void qkt(f32x16& p0, f32x16& p1, lds_cptr kb, const bf16x8 (&qr)[4]) {
    p0 = f32x16{}; p1 = f32x16{};
#pragma unroll
    for (int d0 = 0; d0 < 4; ++d0) {
        const bf16x8 b0 = *(const LAS bf16x8*)(kb + d0 * 2048), b1 = *(const LAS bf16x8*)(kb + d0 * 2048 + 512);
        p0 = __builtin_amdgcn_mfma_f32_32x32x16_bf16(b0, qr[d0], p0, 0, 0, 0);
        p1 = __builtin_amdgcn_mfma_f32_32x32x16_bf16(b1, qr[d0], p1, 0, 0, 0); }
}
template <int ND>
__device__ __forceinline__ void softmax_pv(f32x16& p0, f32x16& p1, f32x16 (&oT)[ND], float& m, float& l, lds_cptr vp) {
    float rm = p0[0];
#pragma unroll
    for (int r = 1; r < 16; ++r) rm = fmaxf(rm, p0[r]);
#pragma unroll
    for (int r = 0; r < 16; ++r) rm = fmaxf(rm, p1[r]);
    rm = hmax(rm);
    const float mn = fmaxf(m, rm);
    const float alpha = __builtin_amdgcn_exp2f(m - mn);
    m = mn;
    float s = 0.f;
#pragma unroll
    for (int r = 0; r < 16; ++r) { p0[r] = __builtin_amdgcn_exp2f(p0[r] - mn); p1[r] = __builtin_amdgcn_exp2f(p1[r] - mn); s += p0[r] + p1[r]; }
    l = l * alpha + s;
#pragma unroll
    for (int d = 0; d < ND; ++d) oT[d] = oT[d] * alpha;
    u32x4 pw[4];
#pragma unroll
    for (int k = 0; k < 2; ++k) {
        pw[k]     = (u32x4){cvtpk(p0[8 * k], p0[8 * k + 1]), cvtpk(p0[8 * k + 2], p0[8 * k + 3]), cvtpk(p0[8 * k + 4], p0[8 * k + 5]), cvtpk(p0[8 * k + 6], p0[8 * k + 7])};
        pw[2 + k] = (u32x4){cvtpk(p1[8 * k], p1[8 * k + 1]), cvtpk(p1[8 * k + 2], p1[8 * k + 3]), cvtpk(p1[8 * k + 4], p1[8 * k + 5]), cvtpk(p1[8 * k + 6], p1[8 * k + 7])}; }
#pragma unroll
    for (int d = 0; d < ND; ++d)
#pragma unroll
        for (int ks = 0; ks < 4; ++ks) {
            const s16x4 lo = vtr(vp + d * 4096 + ks * 1024), hi = vtr(vp + d * 4096 + ks * 1024 + 512);
            const bf16x8 vf = (bf16x8){lo[0], lo[1], lo[2], lo[3], hi[0], hi[1], hi[2], hi[3]};
            oT[d] = __builtin_amdgcn_mfma_f32_32x32x16_bf16(vf, __builtin_bit_cast(bf16x8, pw[ks]), oT[d], 0, 0, 0); }
}
template <int ND>
__device__ __forceinline__ void stg_flush(const LAS unsigned char* stg, bf16_t* ybase, int lane) {
    constexpr int RB = ND * 64 + 16, CPR = ND * 4;
#pragma unroll
    for (int i = 0; i < 32 * CPR / 64; ++i) { const int idx = i * 64 + lane, row = idx / CPR, ch = idx % CPR;
        const u32x4 v = *(const LAS u32x4*)(stg + row * RB + ch * 16); *(u32x4*)(ybase + (size_t)row * DM + ch * 8) = v; }
}
template <int ND>
__device__ __forceinline__ void store_oT(const f32x16 (&oT)[ND], float scale, bf16_t* ybase, size_t elem_off, int hi) {
    if (OUTPROJ_FP8) { unsigned char* orow = (unsigned char*)ybase + elem_off; const float sc8 = scale * Y_SCALE;
#pragma unroll
        for (int d = 0; d < ND; ++d)
#pragma unroll
            for (int g = 0; g < 4; ++g) { int t = 0; t = __builtin_amdgcn_cvt_pk_fp8_f32(oT[d][4 * g] * sc8, oT[d][4 * g + 1] * sc8, t, false); t = __builtin_amdgcn_cvt_pk_fp8_f32(oT[d][4 * g + 2] * sc8, oT[d][4 * g + 3] * sc8, t, true);
                *(unsigned*)(orow + d * 32 + 8 * g + 4 * hi) = (unsigned)t; } }
    else { bf16_t* orow = ybase + elem_off;
#pragma unroll
        for (int d = 0; d < ND; ++d)
#pragma unroll
            for (int g = 0; g < 4; ++g) { u32x2 w; w.x = cvtpk(oT[d][4 * g] * scale, oT[d][4 * g + 1] * scale); w.y = cvtpk(oT[d][4 * g + 2] * scale, oT[d][4 * g + 3] * scale);
                *(u32x2*)(orow + d * 32 + 8 * g + 4 * hi) = w; } }
}
constexpr int NA_BIAS_OFF = 65536;
struct DiffArgs { const bf16_t* qkv; bf16_t* y; const float* subln_g; float lam; float omli; int with_ctx; const bf16_t* q; };

#define DF_THR 8.0f
#define DF_BAR()   asm volatile("s_waitcnt lgkmcnt(0)\n\ts_barrier" ::: "memory")
#define DF_BARV()  asm volatile("s_waitcnt vmcnt(0) lgkmcnt(0)\n\ts_barrier" ::: "memory")
__device__ __forceinline__ void diff_phase2(LAS unsigned char* lds, const DiffArgs A, int vcu, int G) {
    int tid = threadIdx.x; asm volatile("" : "+v"(tid));
    const int lane = tid & 63, r32 = lane & 31, hi = lane >> 5; const int wid = __builtin_amdgcn_readfirstlane(tid >> 6);
    constexpr int P = 3072;
    const unsigned lds0 = (unsigned)(uintptr_t)lds;
    const lds_cptr l3 = (lds_cptr)lds;
    const int mp = wid >> 2, qsub = wid & 3;
    LAS float* xch = (LAS float*)lds + qsub * 4096 + lane;
    const int nmain = NB * 8 * 32, nunits = nmain + (A.with_ctx ? NB * 8 * 2 : 0);
    for (int u = vcu; u < nunits; u += G) {
        int b, h, qrow0, NT; const bool ctxu = u >= nmain;
        if (!ctxu) { const int qb = u & 31; h = (u >> 5) & 7; b = u >> 8; qrow0 = b * SEQ + 128 * qb + 32 * qsub; NT = 4 + 64; }
        else { const int v = u - nmain; const int qb = v & 1; h = (v >> 1) & 7; b = v >> 4; qrow0 = MX + b * CTXL + 128 * qb + 32 * qsub; NT = 4; }
        const bf16_t* Kc = A.qkv + (size_t)(MX + b * CTXL) * P + 1024 + 128 * h;
        const bf16_t* Kx = A.qkv + (size_t)(b * SEQ) * P + 1024 + 128 * h;
        const int krow = 8 * wid + (lane >> 3); const size_t koff = (size_t)krow * P + (((lane & 7) ^ ((krow >> 1) & 7)) * 8);
        const int pv0 = 2 * wid, pv1 = 2 * wid + 1;
        const int vra = 4 * pv0 + (lane >> 4), vrb = 4 * pv1 + (lane >> 4); const int vph = lane & 15;
        const size_t voffa = (size_t)vra * P + 1024 + ((((vph >> 2) ^ (vra & 3)) << 2) | (vph & 3)) * 8;
        const size_t voffb = (size_t)vrb * P + 1024 + ((((vph >> 2) ^ (vrb & 3)) << 2) | (vph & 3)) * 8;
#define DF_DMA(t) do { if ((t) < NT) { const int slot_ = (t) % 3; const bf16_t* base_ = ((t) < 4) ? Kc + (size_t)(t) * 64 * P : Kx + (size_t)((t) - 4) * 64 * P; \
        glds16(base_ + koff,      (unsigned)__builtin_amdgcn_readfirstlane(lds0 + slot_ * 32768 + wid * 1024)); \
        glds16(base_ + koff + 64, (unsigned)__builtin_amdgcn_readfirstlane(lds0 + slot_ * 32768 + 8192 + wid * 1024)); \
        glds16(base_ + voffa,     (unsigned)__builtin_amdgcn_readfirstlane(lds0 + slot_ * 32768 + 16384 + pv0 * 1024)); \
        glds16(base_ + voffb,     (unsigned)__builtin_amdgcn_readfirstlane(lds0 + slot_ * 32768 + 16384 + pv1 * 1024)); } } while (0)
        DF_DMA(0);
        bf16x8 qr[4];
        { const bf16_t* Qw = A.qkv + (size_t)(qrow0 + r32) * P + h * 128 + mp * 64;
#pragma unroll
          for (int d0 = 0; d0 < 4; ++d0) qr[d0] = *(const bf16x8*)(Qw + d0 * 16 + hi * 8); }
        f32x16 oT[4]; oT[0] = f32x16{}; oT[1] = f32x16{}; oT[2] = f32x16{}; oT[3] = f32x16{};
        float m = 0.f, l = 0.f;
        f32x16 p0, p1; u32x4 pw[4];
        const int ksw = (r32 >> 1) & 7; const lds_cptr kp0 = l3 + mp * 8192 + r32 * 128 + ((hi ^ (ksw & 1)) << 4); const int ks2 = ksw >> 1;
        const int vq = (lane & 15) >> 2; const lds_cptr vp0 = l3 + 16384 + (4 * hi + vq) * 256 + ((lane >> 4) & 1) * 32 + (lane & 3) * 8;
#define DF_LOADV(dst, vp_, d) do { const lds_cptr vd_ = (vp_) + (((d) ^ vq) << 6); _Pragma("unroll") for (int ks = 0; ks < 4; ++ks) { const s16x4 lo_ = vtr(vd_ + ks * 4096), hi_ = vtr(vd_ + ks * 4096 + 2048); \
            dst[ks] = (bf16x8){lo_[0], lo_[1], lo_[2], lo_[3], hi_[0], hi_[1], hi_[2], hi_[3]}; } } while (0)
#define DF_PV4(src, d) do { _Pragma("unroll") for (int ks = 0; ks < 4; ++ks) oT[d] = __builtin_amdgcn_mfma_f32_32x32x16_bf16(src[ks], __builtin_bit_cast(bf16x8, pw[ks]), oT[d], 0, 0, 0); } while (0)
#define DF_LOADK(dst, kb_, dd) do { dst[0] = *(const LAS bf16x8*)((kb_) + ((((dd)) ^ ks2) << 5)); dst[1] = *(const LAS bf16x8*)((kb_) + ((((dd)) ^ ks2) << 5) + 4096); \
            dst[2] = *(const LAS bf16x8*)((kb_) + ((((dd) + 1) ^ ks2) << 5)); dst[3] = *(const LAS bf16x8*)((kb_) + ((((dd) + 1) ^ ks2) << 5) + 4096); } while (0)
#define DF_QK4(src, dd) do { p0 = __builtin_amdgcn_mfma_f32_32x32x16_bf16(src[0], qr[dd], p0, 0, 0, 0); p1 = __builtin_amdgcn_mfma_f32_32x32x16_bf16(src[1], qr[dd], p1, 0, 0, 0); \
            p0 = __builtin_amdgcn_mfma_f32_32x32x16_bf16(src[2], qr[(dd) + 1], p0, 0, 0, 0); p1 = __builtin_amdgcn_mfma_f32_32x32x16_bf16(src[3], qr[(dd) + 1], p1, 0, 0, 0); } while (0)
#define DF_PREV(vso) do { const lds_cptr vq_ = vp0 + (vso); DF_LOADV(fa, vq_, 0); DF_LOADV(fb, vq_, 1); SBAR(); } while (0)
#define DF_PINIT() do { _Pragma("unroll") for (int r = 0; r < 16; ++r) { p0[r] = -m; p1[r] = -m; } } while (0)
#define DF_SEGM(DO_PV, DO_QK, vso, kso) do { const lds_cptr vp_ = vp0 + (vso); const lds_cptr kb_ = kp0 + (kso); SBAR(); __builtin_amdgcn_s_setprio(1); \
        if (DO_PV) { DF_PV4(fa, 0); SBAR(); DF_LOADV(fa, vp_, 2); SBAR(); \
            DF_PV4(fb, 1); SBAR(); DF_LOADV(fb, vp_, 3); if (DO_QK) { DF_PINIT(); } SBAR(); \
            DF_PV4(fa, 2); SBAR(); if (DO_QK) { DF_LOADK(fa, kb_, 0); } SBAR(); \
            DF_PV4(fb, 3); SBAR(); if (DO_QK) { DF_LOADK(fb, kb_, 2); } SBAR(); } \
        else if (DO_QK) { DF_LOADK(fa, kb_, 0); DF_LOADK(fb, kb_, 2); DF_PINIT(); SBAR(); } \
        if (DO_QK) { DF_QK4(fa, 0); SBAR(); DF_QK4(fb, 2); SBAR(); } \
        __builtin_amdgcn_s_setprio(0); } while (0)
#define DF_SEGV(t) do { \
        float rm = p0[0]; \
        _Pragma("unroll") for (int r = 1; r < 16; ++r) rm = fmaxf(rm, p0[r]); \
        _Pragma("unroll") for (int r = 0; r < 16; ++r) rm = fmaxf(rm, p1[r]); \
        rm = hmax(rm); \
        if ((t) == 0 || __any(rm > DF_THR)) { const float dl = ((t) == 0) ? rm : fmaxf(rm, 0.f); m += dl; \
            _Pragma("unroll") for (int r = 0; r < 16; ++r) { p0[r] -= dl; p1[r] -= dl; } \
            const float f = __builtin_amdgcn_exp2f(-dl); l *= f; \
            _Pragma("unroll") for (int d = 0; d < 4; ++d) oT[d] = oT[d] * f; } \
        float s_ = 0.f; \
        _Pragma("unroll") for (int r = 0; r < 16; ++r) { p0[r] = __builtin_amdgcn_exp2f(p0[r]); p1[r] = __builtin_amdgcn_exp2f(p1[r]); s_ += p0[r] + p1[r]; } \
        l += s_; \
        _Pragma("unroll") for (int k = 0; k < 2; ++k) { \
            pw[k]     = (u32x4){cvtpk(p0[8 * k], p0[8 * k + 1]), cvtpk(p0[8 * k + 2], p0[8 * k + 3]), cvtpk(p0[8 * k + 4], p0[8 * k + 5]), cvtpk(p0[8 * k + 6], p0[8 * k + 7])}; \
            pw[2 + k] = (u32x4){cvtpk(p1[8 * k], p1[8 * k + 1]), cvtpk(p1[8 * k + 2], p1[8 * k + 3]), cvtpk(p1[8 * k + 4], p1[8 * k + 5]), cvtpk(p1[8 * k + 6], p1[8 * k + 7])}; } \
        } while (0)
        DF_BARV();
        int so_p = 0, so_c = 0;
#define DF_ROT() do { so_p = so_c; so_c = (so_c == 65536) ? 0 : so_c + 32768; } while (0)
        bf16x8 fa[4], fb[4];
        if (mp == 0) {
            DF_DMA(1); DF_SEGM(false, true, 0, so_c); SBAR(); DF_PREV(so_c); DF_SEGV(0); SBAR(); DF_BARV(); SBAR();
            for (int t = 1; t < NT; ++t) { DF_ROT();
                DF_DMA(t + 1); DF_SEGM(true, true, so_p, so_c); SBAR(); DF_PREV(so_c); DF_SEGV(t); SBAR(); DF_BARV(); SBAR(); }
            DF_ROT();
            DF_SEGM(true, false, so_p, 0); SBAR(); DF_BARV(); SBAR();
        } else {
            DF_DMA(1); DF_SEGM(false, true, 0, so_c); SBAR(); DF_BARV(); SBAR();
            for (int t = 1; t < NT; ++t) { DF_ROT();
                DF_DMA(t + 1); DF_PREV(so_p); DF_SEGV(t - 1); SBAR(); DF_SEGM(true, true, so_p, so_c); SBAR(); DF_BARV(); SBAR(); }
            DF_ROT();
            DF_PREV(so_p); DF_SEGV(NT - 1); SBAR(); DF_SEGM(true, false, so_p, 0); SBAR(); DF_BARV(); SBAR();
        }
#undef DF_ROT
        l = hsum(l);
        const float il = 1.f / l;
        if (mp == 1) { const float sc = il * A.lam;
#pragma unroll
            for (int d = 0; d < 4; ++d)
#pragma unroll
                for (int q = 0; q < 16; ++q) xch[(d * 16 + q) * 64] = oT[d][q] * sc; }
        DF_BARV();
        if (mp == 0) {
            float ss = 0.f;
#pragma unroll
            for (int d = 0; d < 4; ++d)
#pragma unroll
                for (int q = 0; q < 16; ++q) { const float v = oT[d][q] * il - xch[(d * 16 + q) * 64]; oT[d][q] = v; ss += v * v; }
            ss = hsum(ss);
            const float rstd = rsqrtf(ss * (1.f / 128.f) + RMS_EPS) * A.omli;
            const size_t eo = (size_t)(qrow0 + r32) * DM + h * 128;
#pragma unroll
            for (int d = 0; d < 4; ++d)
#pragma unroll
                for (int g = 0; g < 4; ++g) { const f32x4 gg = *(const f32x4*)(A.subln_g + d * 32 + 8 * g + 4 * hi);
                    if (OUTPROJ_FP8) { const float r8 = rstd * Y_SCALE; int t = 0; t = __builtin_amdgcn_cvt_pk_fp8_f32(oT[d][4 * g] * r8 * gg[0], oT[d][4 * g + 1] * r8 * gg[1], t, false);
                        t = __builtin_amdgcn_cvt_pk_fp8_f32(oT[d][4 * g + 2] * r8 * gg[2], oT[d][4 * g + 3] * r8 * gg[3], t, true);
                        *(unsigned*)((unsigned char*)A.y + eo + d * 32 + 8 * g + 4 * hi) = (unsigned)t; }
                    else { u32x2 w; w.x = cvtpk(oT[d][4 * g] * rstd * gg[0], oT[d][4 * g + 1] * rstd * gg[1]); w.y = cvtpk(oT[d][4 * g + 2] * rstd * gg[2], oT[d][4 * g + 3] * rstd * gg[3]);
                        *(u32x2*)(A.y + eo + d * 32 + 8 * g + 4 * hi) = w; } }
        }
        DF_BAR();
#undef DF_DMA
#undef DF_SEGM
#undef DF_SEGV
#undef DF_PINIT
#undef DF_PREV
#undef DF_LOADV
#undef DF_PV4
#undef DF_LOADK
#undef DF_QK4
    }
}

#define D3_PIN(x) asm volatile("" : "+v"(x))
#define D3_EX(v) __builtin_amdgcn_exp2f(v)
__device__ __forceinline__ void diff_phase3(LAS unsigned char* lds, const DiffArgs A, int vcu, int G) {
    int tid = threadIdx.x; asm volatile("" : "+v"(tid));
    const int lane = tid & 63, r32 = lane & 31, hi = lane >> 5; const int wid = __builtin_amdgcn_readfirstlane(tid >> 6);
    constexpr int P = 3072;
    const unsigned lds0 = (unsigned)(uintptr_t)lds;
    const lds_cptr l3 = (lds_cptr)lds;
    const int mp = wid >> 2, qsub = wid & 3;
    const int nmain = NB * 8 * 32, nunits = nmain + (A.with_ctx ? NB * 8 * 2 : 0);
    for (int u = vcu; u < nunits; u += G) {
        int b, h, qrow0, NT; const bool ctxu = u >= nmain;
        if (!ctxu) { const int qb = u & 31; h = (u >> 5) & 7; b = u >> 8; qrow0 = b * SEQ + 128 * qb + 32 * qsub; NT = 4 + 64; }
        else { const int v = u - nmain; const int qb = v & 1; h = (v >> 1) & 7; b = v >> 4; qrow0 = MX + b * CTXL + 128 * qb + 32 * qsub; NT = 4; }
        const bf16_t* Kc = A.qkv + (size_t)(MX + b * CTXL) * P + 1024 + 128 * h;
        const bf16_t* Kx = A.qkv + (size_t)(b * SEQ) * P + 1024 + 128 * h;
        const int kra = 16 * qsub + (lane >> 3), krb = kra + 8; const int vr0 = 16 * qsub + (lane >> 4); const int vph = lane & 15;
        const unsigned d0 = mp ? (unsigned)vr0 * P + 1024 + ((((vph >> 2) ^ (vr0 & 3)) << 2) | (vph & 3)) * 8 : (unsigned)kra * P + (((lane & 7) ^ ((kra >> 1) & 7)) * 8);
        const unsigned d1 = mp ? d0 + 4 * P : (unsigned)krb * P + (((lane & 7) ^ ((krb >> 1) & 7)) * 8);
        const unsigned inc2 = mp ? 8 * P : 64;
        const unsigned e0 = lds0 + (mp ? 32768 + qsub * 4096 : qsub * 2048), e2 = e0 + (mp ? 2048 : 8192);
#define D3_DMA(t) do { const int t_ = (t); if (t_ < NT) { const bf16_t* base_ = (t_ < 4) ? Kc + (size_t)t_ * 64 * P : Kx + (size_t)(t_ - 4) * 64 * P; \
        const unsigned so_ = (mp ? (t_ & 3) : (t_ & 1)) * 16384; \
        glds16(base_ + d0,        (unsigned)__builtin_amdgcn_readfirstlane(e0 + so_)); \
        glds16(base_ + d1,        (unsigned)__builtin_amdgcn_readfirstlane(e0 + so_ + 1024)); \
        glds16(base_ + d0 + inc2, (unsigned)__builtin_amdgcn_readfirstlane(e2 + so_)); \
        glds16(base_ + d1 + inc2, (unsigned)__builtin_amdgcn_readfirstlane(e2 + so_ + 1024)); } } while (0)
#define D3_WAITBAR(T) do { if (mp == 0 || (T) + 1 >= NT) DF_BARV(); else asm volatile("s_waitcnt vmcnt(4) lgkmcnt(0)\n\ts_barrier" ::: "memory"); } while (0)
        D3_DMA(0);
        bf16x8 qr[4];
        { const bf16_t* Qw = A.q + ((size_t)(qrow0 >> 5) * 16 + 2 * h + mp) * 2048 + hi * 256 + r32 * 8;
#pragma unroll
          for (int d0 = 0; d0 < 4; ++d0) qr[d0] = *(const bf16x8*)(Qw + d0 * 512); }
        f32x16 oT[4]; oT[0] = f32x16{}; oT[1] = f32x16{}; oT[2] = f32x16{}; oT[3] = f32x16{};
        f32x16 negm;
        float m = 0.f, l = 0.f, rf = 1.f; bool resc = false;
        f32x16 pA0, pA1, pB0, pB1; u32x4 pw0, pw1, pw2, pw3;
        const int ksw = (r32 >> 1) & 7; const lds_cptr kp0 = l3 + mp * 8192 + r32 * 128 + ((hi ^ (ksw & 1)) << 4); const int ks2 = ksw >> 1;
        const int vq = (lane & 15) >> 2; const lds_cptr vp0 = l3 + 32768 + (4 * hi + vq) * 256 + ((lane >> 4) & 1) * 32 + (lane & 3) * 8;
#define D3_KF(kb_, g) (*(const LAS bf16x8*)((kb_) + (((((g) >> 1)) ^ ks2) << 5) + ((g) & 1) * 4096))
#define D3_VF(vp_, g) ({ const lds_cptr vd_ = (vp_) + (((((g) >> 2)) ^ vq) << 6) + ((g) & 3) * 4096; const s16x4 lo_ = vtr(vd_), hi_ = vtr(vd_ + 2048); (bf16x8){lo_[0], lo_[1], lo_[2], lo_[3], hi_[0], hi_[1], hi_[2], hi_[3]}; })
#define D3_PK(P, B) cvtpk(P[B], P[(B) + 1])
#define D3_KSEL(g) (((g) & 1) ? kf1 : kf0)
#define D3_GA(g, C0, C1, Q0, Q1, HASQK, HASVA, FIRST) do { \
        if (HASQK) { \
            if ((g) == 0) { if (FIRST) C0 = __builtin_amdgcn_mfma_f32_32x32x16_bf16(D3_KSEL(g), qr[0], f32x16{}, 0, 0, 0); else C0 = __builtin_amdgcn_mfma_f32_32x32x16_bf16(D3_KSEL(g), qr[0], negm, 0, 0, 0); } \
            else if ((g) == 1) { if (FIRST) C1 = __builtin_amdgcn_mfma_f32_32x32x16_bf16(D3_KSEL(g), qr[0], f32x16{}, 0, 0, 0); else C1 = __builtin_amdgcn_mfma_f32_32x32x16_bf16(D3_KSEL(g), qr[0], negm, 0, 0, 0); } \
            else if ((g) & 1) C1 = __builtin_amdgcn_mfma_f32_32x32x16_bf16(D3_KSEL(g), qr[(g) >> 1], C1, 0, 0, 0); else C0 = __builtin_amdgcn_mfma_f32_32x32x16_bf16(D3_KSEL(g), qr[(g) >> 1], C0, 0, 0, 0); \
            if ((g) + 2 < 8) { if ((g) & 1) kf1 = D3_KF(kb_, (g) + 2); else kf0 = D3_KF(kb_, (g) + 2); } } \
        if (HASVA) { if ((g) == 6) vf0 = D3_VF(vp_, 0); if ((g) == 7) vf1 = D3_VF(vp_, 1); } \
        if (HASVA) { if ((g) < 5) { Q1[5 + 2 * (g)] = D3_EX(Q1[5 + 2 * (g)]); Q1[6 + 2 * (g)] = D3_EX(Q1[6 + 2 * (g)]); } if ((g) == 5) { Q1[15] = D3_EX(Q1[15]); } \
            if ((g) == 0) { pw0[0] = D3_PK(Q0, 0); pw0[1] = D3_PK(Q0, 2); } if ((g) == 1) { pw0[2] = D3_PK(Q0, 4); pw0[3] = D3_PK(Q0, 6); D3_PIN(pw0); } \
            if ((g) == 2) { pw1[0] = D3_PK(Q0, 8); pw1[1] = D3_PK(Q0, 10); } if ((g) == 3) { pw1[2] = D3_PK(Q0, 12); pw1[3] = D3_PK(Q0, 14); D3_PIN(pw1); } \
            if ((g) == 4) { pw2[0] = D3_PK(Q1, 0); pw2[1] = D3_PK(Q1, 2); } if ((g) == 5) { pw2[2] = D3_PK(Q1, 4); pw2[3] = D3_PK(Q1, 6); D3_PIN(pw2); } \
            if ((g) == 6) { pw3[0] = D3_PK(Q1, 8); pw3[1] = D3_PK(Q1, 10); } if ((g) == 7) { pw3[2] = D3_PK(Q1, 12); pw3[3] = D3_PK(Q1, 14); D3_PIN(pw3); } \
            } \
        SBAR(); } while (0)
#define D3_PWSEL(g) (((g) & 3) == 0 ? pw0 : ((g) & 3) == 1 ? pw1 : ((g) & 3) == 2 ? pw2 : pw3)
#define D3_EXI(C0, C1, e) do { if ((e) < 16) C0[(e) & 15] = D3_EX(C0[(e) & 15]); else C1[(e) & 15] = D3_EX(C1[(e) & 15]); } while (0)
#define D3_GB(g, C0, C1, Q0, Q1, HASPV, HASVB, FIRST) do { \
        if (HASPV) { \
            oT[(g) >> 2] = __builtin_amdgcn_mfma_f32_32x32x16_bf16(((g) & 1) ? vf1 : vf0, __builtin_bit_cast(bf16x8, D3_PWSEL(g)), oT[(g) >> 2], 0, 0, 0); \
            if ((g) + 2 < 16) { if ((g) & 1) vf1 = D3_VF(vp_, (g) + 2); else vf0 = D3_VF(vp_, (g) + 2); } } \
        if (HASPV) { if ((g) < 4) { sacc += Q0[4 * ((g) & 3)]; sacc += Q0[4 * ((g) & 3) + 1]; sacc += Q0[4 * ((g) & 3) + 2]; sacc += Q0[4 * ((g) & 3) + 3]; D3_PIN(sacc); } \
            else if ((g) < 8) { sacc += Q1[4 * ((g) & 3)]; sacc += Q1[4 * ((g) & 3) + 1]; sacc += Q1[4 * ((g) & 3) + 2]; sacc += Q1[4 * ((g) & 3) + 3]; D3_PIN(sacc); } \
            else if ((g) == 8) { l += sacc; } } \
        if (HASVB) { if ((g) < 4) { rmx = fmaxf(fmaxf(rmx, C0[4 * ((g) & 3)]), C0[4 * ((g) & 3) + 1]); rmx = fmaxf(fmaxf(rmx, C0[4 * ((g) & 3) + 2]), C0[4 * ((g) & 3) + 3]); D3_PIN(rmx); } \
            else if ((g) < 8) { rmx = fmaxf(fmaxf(rmx, C1[4 * ((g) & 3)]), C1[4 * ((g) & 3) + 1]); rmx = fmaxf(fmaxf(rmx, C1[4 * ((g) & 3) + 2]), C1[4 * ((g) & 3) + 3]); D3_PIN(rmx); } \
            else if ((g) == 8) { rmx = hmax(rmx); resc = false; \
                if (FIRST || __any(rmx > DF_THR)) { const float dl = FIRST ? rmx : fmaxf(rmx, 0.f); m += dl; \
                    _Pragma("unroll") for (int r_ = 0; r_ < 16; ++r_) { C0[r_] -= dl; C1[r_] -= dl; negm[r_] = -m; } D3_PIN(negm); \
                    rf = D3_EX(-dl); l *= rf; resc = true; } } \
            else { const int e0_ = 3 * ((g) - 9);   \
                D3_EXI(C0, C1, e0_); D3_EXI(C0, C1, e0_ + 1); D3_EXI(C0, C1, e0_ + 2); if (e0_ + 2 < 16) D3_PIN(C0); else D3_PIN(C1); } } \
        SBAR(); } while (0)
#define D3_STEP(C0, C1, Q0, Q1, HASQK, HASPREV, FIRST, T) do { \
        const lds_cptr kb_ = kp0 + ((T) & 1) * 16384; const lds_cptr vp_ = vp0 + (((T) - 1) & 3) * 16384; bf16x8 kf0, kf1, vf0, vf1; float sacc = 0.f, rmx = -3.0e38f; \
        if (HASQK) D3_DMA((T) + 1); \
        SBAR(); if (HASQK) { kf0 = D3_KF(kb_, 0); kf1 = D3_KF(kb_, 1); } \
        D3_GA(0, C0, C1, Q0, Q1, HASQK, HASPREV, FIRST); D3_GA(1, C0, C1, Q0, Q1, HASQK, HASPREV, FIRST); D3_GA(2, C0, C1, Q0, Q1, HASQK, HASPREV, FIRST); D3_GA(3, C0, C1, Q0, Q1, HASQK, HASPREV, FIRST); \
        D3_GA(4, C0, C1, Q0, Q1, HASQK, HASPREV, FIRST); D3_GA(5, C0, C1, Q0, Q1, HASQK, HASPREV, FIRST); D3_GA(6, C0, C1, Q0, Q1, HASQK, HASPREV, FIRST); D3_GA(7, C0, C1, Q0, Q1, HASQK, HASPREV, FIRST); \
        if (HASQK) { if (mp == 1) D3_WAITBAR(T); } \
        D3_GB(0, C0, C1, Q0, Q1, HASPREV, HASQK, FIRST); D3_GB(1, C0, C1, Q0, Q1, HASPREV, HASQK, FIRST); D3_GB(2, C0, C1, Q0, Q1, HASPREV, HASQK, FIRST); D3_GB(3, C0, C1, Q0, Q1, HASPREV, HASQK, FIRST); \
        D3_GB(4, C0, C1, Q0, Q1, HASPREV, HASQK, FIRST); D3_GB(5, C0, C1, Q0, Q1, HASPREV, HASQK, FIRST); D3_GB(6, C0, C1, Q0, Q1, HASPREV, HASQK, FIRST); D3_GB(7, C0, C1, Q0, Q1, HASPREV, HASQK, FIRST); \
        D3_GB(8, C0, C1, Q0, Q1, HASPREV, HASQK, FIRST); D3_GB(9, C0, C1, Q0, Q1, HASPREV, HASQK, FIRST); D3_GB(10, C0, C1, Q0, Q1, HASPREV, HASQK, FIRST); D3_GB(11, C0, C1, Q0, Q1, HASPREV, HASQK, FIRST); \
        D3_GB(12, C0, C1, Q0, Q1, HASPREV, HASQK, FIRST); D3_GB(13, C0, C1, Q0, Q1, HASPREV, HASQK, FIRST); D3_GB(14, C0, C1, Q0, Q1, HASPREV, HASQK, FIRST); D3_GB(15, C0, C1, Q0, Q1, HASPREV, HASQK, FIRST); \
        if (HASQK && resc) { _Pragma("unroll") for (int d_ = 0; d_ < 4; ++d_) oT[d_] = oT[d_] * rf; } \
        if (HASQK) { if (mp == 0) D3_WAITBAR(T); } \
        } while (0)
        DF_BARV();
        D3_STEP(pA0, pA1, pB0, pB1, true, false, true, 0);
        int t = 1;
        for (; t + 1 < NT; t += 2) {
            D3_STEP(pB0, pB1, pA0, pA1, true, true, false, t);
            D3_STEP(pA0, pA1, pB0, pB1, true, true, false, t + 1);
        }
        D3_STEP(pB0, pB1, pA0, pA1, true, true, false, t);
        D3_STEP(pA0, pA1, pB0, pB1, false, true, false, NT);
        l = hsum(l);
        const float il = 1.f / l;
        DF_BAR();
        LAS float* xch = (LAS float*)lds + qsub * 4096 + lane;
        if (mp == 1) { const float sc = il * A.lam;
#pragma unroll
            for (int d = 0; d < 4; ++d)
#pragma unroll
                for (int q = 0; q < 16; ++q) xch[(d * 16 + q) * 64] = oT[d][q] * sc; }
        DF_BAR();
        if (mp == 0) {
            float ss = 0.f;
#pragma unroll
            for (int d = 0; d < 4; ++d)
#pragma unroll
                for (int q = 0; q < 16; ++q) { const float v = oT[d][q] * il - xch[(d * 16 + q) * 64]; oT[d][q] = v; ss += v * v; }
            ss = hsum(ss);
            const float rstd = rsqrtf(ss * (1.f / 128.f) + RMS_EPS) * A.omli;
            LAS unsigned char* stg = lds + qsub * 16384;
#pragma unroll
            for (int d = 0; d < 4; ++d)
#pragma unroll
                for (int g = 0; g < 4; ++g) { const f32x4 gg = *(const f32x4*)(A.subln_g + d * 32 + 8 * g + 4 * hi);
                    u32x2 w; w.x = cvtpk(oT[d][4 * g] * rstd * gg[0], oT[d][4 * g + 1] * rstd * gg[1]); w.y = cvtpk(oT[d][4 * g + 2] * rstd * gg[2], oT[d][4 * g + 3] * rstd * gg[3]);
                    *(LAS u32x2*)(stg + r32 * 272 + (d * 32 + 8 * g + 4 * hi) * 2) = w; }
            stg_flush<4>(stg, A.y + (size_t)qrow0 * DM + h * 128, lane);
        }
        DF_BAR();
#undef D3_DMA
#undef D3_KF
#undef D3_KSEL
#undef D3_VF
#undef D3_PK
#undef D3_GA
#undef D3_GB
#undef D3_EXI
#undef D3_PWSEL
#undef D3_STEP
#undef D3_WAITBAR
    }
}

struct A2Args { const bf16_t* qkv; bf16_t* y; const float* aux; int with_ctx; const bf16_t* q; };
template <int MODE  >
__device__ __forceinline__ void att2_phase(LAS unsigned char* lds, const A2Args A, int vcu, int G) {
    int tid = threadIdx.x; asm volatile("" : "+v"(tid));
    const int lane = tid & 63, r32 = lane & 31, hi = lane >> 5; const int wid = __builtin_amdgcn_readfirstlane(tid >> 6);
    constexpr int P = MODE == 0 ? 1536 : 3072; constexpr int VOFF = MODE == 0 ? 256 : 1024;
    const unsigned lds0 = (unsigned)(uintptr_t)lds;
    const lds_cptr l3 = (lds_cptr)lds;
    const int grp = wid >> 2;
    LAS float* btab = (LAS float*)(lds + NA_BIAS_OFF + 1024);
    const int nmain = MODE == 0 ? NB * 4 * 32 * 2 : NB * 16 * 16;
    const int nunits = nmain + (A.with_ctx ? (MODE == 0 ? NB * 4 * 4 : NB * 16) : 0);
    for (int u = vcu; u < nunits; u += G) {
        int b, hk, hq, qrow0, nwin, k0win; const bool ctxu = u >= nmain; int qs = 0, r = 0, c = 0;
        if (MODE == 0) {
            if (!ctxu) { const int jj = u & 63; hk = (u >> 6) & 3; b = u >> 8; hq = 4 * hk + (wid >> 1); qs = 64 * jj + 32 * (wid & 1); qrow0 = b * SEQ + qs;
                const int ks = max(0, 64 * jj - 128), ke = min(SEQ, 64 * jj + 192); k0win = ks; nwin = (ke - ks) / 64; }
            else { const int v = u - nmain; hk = (v >> 2) & 3; hq = 4 * hk + (v & 3); b = v >> 4; qrow0 = MX + b * CTXL + 32 * wid; nwin = 0; k0win = 0; }
        } else {
            if (!ctxu) { const int uu = u & 15; hk = hq = (u >> 4) & 15; b = u >> 8; r = 4 * uu + (wid >> 1); c = 32 * (wid & 1) + r32; qrow0 = b * SEQ + r * 64 + 32 * (wid & 1);
                const int rs_lo = min(max(4 * uu - 4, 0), 56), rs_hi = min(max(4 * uu + 3 - 4, 0), 56); k0win = rs_lo * 64; nwin = rs_hi + 8 - rs_lo; }
            else { const int v = u - nmain; hk = hq = v & 15; b = v >> 4; qrow0 = MX + b * CTXL + 32 * wid; nwin = 0; k0win = 0; }
        }
        const int NT = 4 + nwin;
        const bf16_t* Kc = A.qkv + (size_t)(MX + b * CTXL) * P + 1024 + 64 * hk;
        const bf16_t* Kx = A.qkv + (size_t)(b * SEQ + k0win) * P + 1024 + 64 * hk;
        const int krow = 8 * wid + (lane >> 3); const size_t koff = (size_t)krow * P + (((lane & 7) ^ ((krow >> 1) & 7)) * 8), voff = (size_t)krow * P + VOFF + (((lane & 7) ^ (((krow >> 1) & 1) << 2)) * 8);
#define A2_DMA(t) do { if ((t) < NT) { const int slot_ = (t) % 3; const bf16_t* base_ = ((t) < 4) ? Kc + (size_t)(t) * 64 * P : Kx + (size_t)((t) - 4) * 64 * P; \
        glds16(base_ + koff, (unsigned)__builtin_amdgcn_readfirstlane(lds0 + slot_ * 16384 + wid * 1024)); \
        glds16(base_ + voff, (unsigned)__builtin_amdgcn_readfirstlane(lds0 + slot_ * 16384 + 8192 + wid * 1024)); } } while (0)
        A2_DMA(0);
        if (MODE == 1) { if (!ctxu && tid < 15 * 31) btab[tid] = A.aux[hq * 465 + tid] * LOG2E; }
        bf16x8 qr[4];
        { const bf16_t* Qw = A.q + ((size_t)(qrow0 >> 5) * 16 + hq) * 2048 + hi * 256 + r32 * 8;
#pragma unroll
          for (int d0 = 0; d0 < 4; ++d0) qr[d0] = *(const bf16x8*)(Qw + d0 * 512); }
        f32x16 oT[2]; oT[0] = f32x16{}; oT[1] = f32x16{};
        float m = 0.f, l = 0.f;
        f32x16 p0, p1; u32x4 pw[4];
        const int ksw = (r32 >> 1) & 7; const lds_cptr kp0 = l3 + r32 * 128 + ((hi ^ (ksw & 1)) << 4); const int ks2 = ksw >> 1;
        const int vq = (lane & 15) >> 2, vsq = (vq >> 1) & 1; const lds_cptr vp0 = l3 + 8192 + (4 * hi + vq) * 128 + ((lane >> 4) & 1) * 32 + (lane & 3) * 8;
        const int rs = min(max(r - 4, 0), 56), cs = min(max(c - 8, 0), 48);
#define A2_LOADV(dst, vp_, d) do { const lds_cptr vd_ = (vp_) + (((d) ^ vsq) << 6); _Pragma("unroll") for (int ks = 0; ks < 4; ++ks) { const s16x4 lo_ = vtr(vd_ + ks * 2048), hi_ = vtr(vd_ + ks * 2048 + 1024); \
            dst[ks] = (bf16x8){lo_[0], lo_[1], lo_[2], lo_[3], hi_[0], hi_[1], hi_[2], hi_[3]}; } } while (0)
#define A2_PV4(src, d) do { _Pragma("unroll") for (int ks = 0; ks < 4; ++ks) oT[d] = __builtin_amdgcn_mfma_f32_32x32x16_bf16(src[ks], __builtin_bit_cast(bf16x8, pw[ks]), oT[d], 0, 0, 0); } while (0)
#define A2_LOADK(dst, kb_, dd) do { dst[0] = *(const LAS bf16x8*)((kb_) + ((((dd)) ^ ks2) << 5)); dst[1] = *(const LAS bf16x8*)((kb_) + ((((dd)) ^ ks2) << 5) + 4096); \
            dst[2] = *(const LAS bf16x8*)((kb_) + ((((dd) + 1) ^ ks2) << 5)); dst[3] = *(const LAS bf16x8*)((kb_) + ((((dd) + 1) ^ ks2) << 5) + 4096); } while (0)
#define A2_QK4(src, dd) do { p0 = __builtin_amdgcn_mfma_f32_32x32x16_bf16(src[0], qr[dd], p0, 0, 0, 0); p1 = __builtin_amdgcn_mfma_f32_32x32x16_bf16(src[1], qr[dd], p1, 0, 0, 0); \
            p0 = __builtin_amdgcn_mfma_f32_32x32x16_bf16(src[2], qr[(dd) + 1], p0, 0, 0, 0); p1 = __builtin_amdgcn_mfma_f32_32x32x16_bf16(src[3], qr[(dd) + 1], p1, 0, 0, 0); } while (0)
#define A2_PREV(vso) do { const lds_cptr vq_ = vp0 + (vso); A2_LOADV(fa, vq_, 0); A2_LOADV(fb, vq_, 1); SBAR(); } while (0)
#define A2_PINIT() do { _Pragma("unroll") for (int q_ = 0; q_ < 16; ++q_) { p0[q_] = -m; p1[q_] = -m; } } while (0)
#define A2_SEGM(DO_PV, DO_QK, vso, kso) do { const lds_cptr kb_ = kp0 + (kso); SBAR(); __builtin_amdgcn_s_setprio(1); \
        if (DO_PV) { A2_PV4(fa, 0); if (DO_QK) { A2_PINIT(); } SBAR(); if (DO_QK) { A2_LOADK(fa, kb_, 0); } SBAR(); A2_PV4(fb, 1); SBAR(); if (DO_QK) { A2_LOADK(fb, kb_, 2); } SBAR(); } \
        else if (DO_QK) { A2_LOADK(fa, kb_, 0); A2_LOADK(fb, kb_, 2); A2_PINIT(); SBAR(); } \
        if (DO_QK) { A2_QK4(fa, 0); SBAR(); A2_QK4(fb, 2); SBAR(); } \
        __builtin_amdgcn_s_setprio(0); } while (0)
#define A2_SEGV(t) do { \
        if ((t) >= 4) { \
            if (MODE == 0) { const int kb0_ = k0win + 64 * ((t) - 4); if ((kb0_ + 63 > qs + 128) || (kb0_ < qs + 31 - 128)) { const int dq_ = kb0_ + 4 * hi - (qs + r32) + 128; \
                _Pragma("unroll") for (int q_ = 0; q_ < 16; ++q_) { const int kk_ = (q_ & 3) + 8 * (q_ >> 2); if ((unsigned)(dq_ + kk_) > 256u) p0[q_] = NEG_BIG; if ((unsigned)(dq_ + kk_ + 32) > 256u) p1[q_] = NEG_BIG; } } } \
            else { const int kr_ = (k0win >> 6) + (t) - 4; const bool rowok_ = (kr_ >= rs) && (kr_ < rs + 8); const int rel_ = rowok_ ? 4 * hi - cs : 1000; const LAS float* bp_ = btab + (rowok_ ? kr_ - r + 7 : 0) * 31 + 4 * hi - c + 15; \
                _Pragma("unroll") for (int q_ = 0; q_ < 16; ++q_) { const int kk_ = (q_ & 3) + 8 * (q_ >> 2); const float b0_ = bp_[kk_], b1_ = bp_[kk_ + 32]; \
                    p0[q_] = ((unsigned)(rel_ + kk_) < 16u) ? p0[q_] + b0_ : NEG_BIG; p1[q_] = ((unsigned)(rel_ + kk_ + 32) < 16u) ? p1[q_] + b1_ : NEG_BIG; } } } \
        float rm = p0[0]; \
        _Pragma("unroll") for (int q_ = 1; q_ < 16; ++q_) rm = fmaxf(rm, p0[q_]); \
        _Pragma("unroll") for (int q_ = 0; q_ < 16; ++q_) rm = fmaxf(rm, p1[q_]); \
        rm = hmax(rm); \
        if ((t) == 0 || __any(rm > DF_THR)) { const float dl = ((t) == 0) ? rm : fmaxf(rm, 0.f); m += dl; \
            _Pragma("unroll") for (int q_ = 0; q_ < 16; ++q_) { p0[q_] -= dl; p1[q_] -= dl; } \
            const float f = __builtin_amdgcn_exp2f(-dl); l *= f; oT[0] = oT[0] * f; oT[1] = oT[1] * f; } \
        float s_ = 0.f; \
        _Pragma("unroll") for (int q_ = 0; q_ < 16; ++q_) { p0[q_] = __builtin_amdgcn_exp2f(p0[q_]); p1[q_] = __builtin_amdgcn_exp2f(p1[q_]); s_ += p0[q_] + p1[q_]; } \
        l += s_; \
        _Pragma("unroll") for (int k = 0; k < 2; ++k) { \
            pw[k]     = (u32x4){cvtpk(p0[8 * k], p0[8 * k + 1]), cvtpk(p0[8 * k + 2], p0[8 * k + 3]), cvtpk(p0[8 * k + 4], p0[8 * k + 5]), cvtpk(p0[8 * k + 6], p0[8 * k + 7])}; \
            pw[2 + k] = (u32x4){cvtpk(p1[8 * k], p1[8 * k + 1]), cvtpk(p1[8 * k + 2], p1[8 * k + 3]), cvtpk(p1[8 * k + 4], p1[8 * k + 5]), cvtpk(p1[8 * k + 6], p1[8 * k + 7])}; } \
        } while (0)
        DF_BARV();
        int so_p = 0, so_c = 0;
#define A2_ROT() do { so_p = so_c; so_c = (so_c == 32768) ? 0 : so_c + 16384; } while (0)
        bf16x8 fa[4], fb[4];
        if (grp == 0) {
            A2_DMA(1); A2_SEGM(false, true, 0, so_c); SBAR(); A2_PREV(so_c); A2_SEGV(0); SBAR(); DF_BARV(); SBAR();
            for (int t = 1; t < NT; ++t) { A2_ROT();
                A2_DMA(t + 1); A2_SEGM(true, true, so_p, so_c); SBAR(); A2_PREV(so_c); A2_SEGV(t); SBAR(); DF_BARV(); SBAR(); }
            A2_ROT();
            A2_SEGM(true, false, so_p, 0); SBAR(); DF_BARV(); SBAR();
        } else {
            A2_DMA(1); A2_SEGM(false, true, 0, so_c); SBAR(); DF_BARV(); SBAR();
            for (int t = 1; t < NT; ++t) { A2_ROT();
                A2_DMA(t + 1); A2_PREV(so_p); A2_SEGV(t - 1); SBAR(); A2_SEGM(true, true, so_p, so_c); SBAR(); DF_BARV(); SBAR(); }
            A2_ROT();
            A2_PREV(so_p); A2_SEGV(NT - 1); SBAR(); A2_SEGM(true, false, so_p, 0); SBAR(); DF_BARV(); SBAR();
        }
        l = hsum(l);
        if (MODE == 0) l += __builtin_amdgcn_exp2f(A.aux[hq] * LOG2E - m);
        if (OUTPROJ_FP8) store_oT<2>(oT, 1.f / l, A.y, (size_t)(qrow0 + r32) * DM + hq * 64, hi);
        else { LAS unsigned char* stg = lds + wid * 8192; const float sc_ = 1.f / l;
#pragma unroll
            for (int d = 0; d < 2; ++d)
#pragma unroll
                for (int g = 0; g < 4; ++g) { u32x2 w; w.x = cvtpk(oT[d][4 * g] * sc_, oT[d][4 * g + 1] * sc_); w.y = cvtpk(oT[d][4 * g + 2] * sc_, oT[d][4 * g + 3] * sc_);
                    *(LAS u32x2*)(stg + r32 * 144 + (d * 32 + 8 * g + 4 * hi) * 2) = w; }
            stg_flush<2>(stg, A.y + (size_t)qrow0 * DM + hq * 64, lane); }
        DF_BAR();
#undef A2_DMA
#undef A2_LOADV
#undef A2_PV4
#undef A2_LOADK
#undef A2_QK4
#undef A2_SEGM
#undef A2_SEGV
#undef A2_PREV
#undef A2_PINIT
#undef A2_ROT
    }
}
#undef SBAR
}

struct Frame {
    LAS unsigned char* lds; volatile LAS unsigned* MISC; unsigned* ctl;
    int tid, lane, wave, vcu, G;
};

__device__ __forceinline__ void transpose_item(const float* W, int K, int N, bf16_t* WT, int k0, int n0, int drow0, LAS float* scr, int lane) {
    f32x4 v[16];
    const float* src = W + (size_t)(k0 + (lane >> 4)) * N + n0 + 4 * (lane & 15);
#pragma unroll
    for (int i = 0; i < 16; ++i) v[i] = *(const f32x4*)(src + (size_t)(4 * i) * N);
#pragma unroll
    for (int i = 0; i < 16; ++i) { LAS float* d = scr + (4 * i + (lane >> 4)) * 65 + 4 * (lane & 15); d[0] = v[i].x; d[1] = v[i].y; d[2] = v[i].z; d[3] = v[i].w; }
    LDS_WAIT(); asm volatile("" ::: "memory");
    const int c = lane & 7;
#pragma unroll
    for (int j = 0; j < 8; ++j) { const int n = (lane >> 3) + 8 * j; const LAS float* s = scr + (8 * c) * 65 + n;
        u32x4 o; o.x = cvtpk(s[0 * 65], s[1 * 65]); o.y = cvtpk(s[2 * 65], s[3 * 65]); o.z = cvtpk(s[4 * 65], s[5 * 65]); o.w = cvtpk(s[6 * 65], s[7 * 65]);
        *(u32x4*)(WT + (size_t)(drow0 + n) * K + k0 + 8 * c) = o; }
    LDS_WAIT(); asm volatile("" ::: "memory");
}

enum { KA_x, KA_c, KA_ctx, KA_c_ctx, KA_ada_w, KA_ada_b, KA_norm1_g, KA_norm2_g, KA_final_g, KA_win_w_in, KA_win_w_out, KA_win_sink, KA_diff_w_in, KA_diff_w_out, KA_diff_lambda, KA_diff_subln_g,
       KA_na_w_in, KA_na_w_out, KA_na_rpb, KA_router_w, KA_w_gate, KA_w_up, KA_w_down, KA_OUT, KA_WS };
__device__ __forceinline__ const float* karg(int i) { asm volatile("" : "+s"(i)); return (const float*)(((const unsigned long long __attribute__((address_space(4)))*)__builtin_amdgcn_kernarg_segment_ptr())[i]); }
__device__ __forceinline__ void t8_load(f32x4 (&v)[16], const float* W, int N, int k0, int n0, int lane) {
    const float* src = W + (size_t)(k0 + (lane >> 4)) * N + n0 + 4 * (lane & 15);
#pragma unroll
    for (int i = 0; i < 16; ++i) v[i] = *(const f32x4*)(src + (size_t)(4 * i) * N);
}
__device__ __forceinline__ void t8_finish(const f32x4 (&v)[16], int Kb, unsigned char* WT, int k0, int drow0, LAS float* scr, int lane) {
#pragma unroll
    for (int i = 0; i < 16; ++i) { LAS float* d = scr + (4 * i + (lane >> 4)) * 65 + 4 * (lane & 15); d[0] = v[i].x * W8_SCALE; d[1] = v[i].y * W8_SCALE; d[2] = v[i].z * W8_SCALE; d[3] = v[i].w * W8_SCALE; }
    LDS_WAIT(); asm volatile("" ::: "memory");
    const int c = lane & 3;
#pragma unroll
    for (int j = 0; j < 4; ++j) { const int n = (lane >> 2) + 16 * j; const LAS float* s = scr + (16 * c) * 65 + n;
        int w[4];
#pragma unroll
        for (int q = 0; q < 4; ++q) { int t = 0; t = __builtin_amdgcn_cvt_pk_fp8_f32(s[(4 * q) * 65], s[(4 * q + 1) * 65], t, false); t = __builtin_amdgcn_cvt_pk_fp8_f32(s[(4 * q + 2) * 65], s[(4 * q + 3) * 65], t, true); w[q] = t; }
        *(u32x4*)(WT + (size_t)(drow0 + n) * Kb + k0 + 16 * c) = (u32x4){(unsigned)w[0], (unsigned)w[1], (unsigned)w[2], (unsigned)w[3]}; }
    LDS_WAIT(); asm volatile("" ::: "memory");
}
__device__ __forceinline__ void transpose_item8(const float* W, int Kb, int N, unsigned char* WT, int k0, int n0, int drow0, LAS float* scr, int lane) {
    f32x4 v[16]; t8_load(v, W, N, k0, n0, lane); t8_finish(v, Kb, WT, k0, drow0, scr, lane);
}

struct In {
    const float *x, *c, *ctx, *c_ctx, *ada_w, *ada_b, *norm1_g, *norm2_g, *final_g, *win_w_in, *win_w_out, *win_sink, *diff_w_in, *diff_w_out, *diff_lambda, *diff_subln_g,
        *na_w_in, *na_w_out, *na_rpb, *router_w, *w_gate, *w_up, *w_down;
};

__device__ __forceinline__ void phase_prologue(Frame& F, unsigned char* ws) {
    int tid_ = threadIdx.x; asm volatile("" : "+v"(tid_)); const int lane_ = tid_ & 63; const int wave_ = __builtin_amdgcn_readfirstlane(tid_ >> 6);
    LAS float* scr = (LAS float*)(F.lds + wave_ * 16640);
    const int gw = F.vcu * NWAVES + wave_, NGW = F.G * NWAVES;
    if (F.vcu == 0) {
        float* tab = (float*)(ws + WS_TAB);
        for (int i = tid_; i < 1024; i += 512) { const int pos = i >> 4, f = i & 15; const float inv = 1.0f / powf(10000.0f, (float)(2 * f) / 32.0f); const float ang = (float)pos * inv;
            tab[TAB_COS + i] = cosf(ang); tab[TAB_SIN + i] = sinf(ang); }
        if (wave_ == 0) { const float* lp = karg(KA_diff_lambda); const float a = wave_sum(lp[lane_] * lp[64 + lane_]), b2 = wave_sum(lp[128 + lane_] * lp[192 + lane_]);
            const float li = 0.8f - 0.6f * expf(-0.3f * 1.0f); if (lane_ == 0) { tab[TAB_LAM] = expf(a) - expf(b2) + li; tab[TAB_LAM + 1] = 1.0f - li; } }
    }
    {
        bf16_t* pw = (bf16_t*)(ws + WS_PW);
        constexpr int IT_WI = 16 * 24, IT_O = 16 * 16, IT_3 = 16 * 48;
        constexpr int NIT = 2 * IT_WI + 2 * IT_O + IT_3 + IT_O + IT_3 + IT_O;
        for (int it = gw; it < NIT; it += NGW) {
            int r = it; const float* W; bf16_t* WT; int N;
            if (r < 2 * IT_WI) { const int s = r / IT_WI; r -= s * IT_WI; W = karg(KA_win_w_in) + (size_t)s * 1024 * 1536; WT = pw + (PW_WIN_IN / 2) + (size_t)s * 1536 * 1024; N = 1536; }
            else if ((r -= 2 * IT_WI) < 2 * IT_O) { const int s = r / IT_O; r -= s * IT_O; W = karg(KA_win_w_out) + (size_t)s * 1024 * 1024; WT = pw + (PW_WIN_OUT / 2) + (size_t)s * 1024 * 1024; N = 1024; }
            else if ((r -= 2 * IT_O) < IT_3) { W = karg(KA_diff_w_in); WT = pw + PW_DIFF_IN / 2; N = 3072; }
            else if ((r -= IT_3) < IT_O) { W = karg(KA_diff_w_out); WT = pw + PW_DIFF_OUT / 2; N = 1024; }
            else if ((r -= IT_O) < IT_3) { W = karg(KA_na_w_in); WT = pw + PW_NA_IN / 2; N = 3072; }
            else { r -= IT_3; W = karg(KA_na_w_out); WT = pw + PW_NA_OUT / 2; N = 1024; }
            const int nblk = N / 64, kb = r / nblk, nb = r % nblk;
            if ((INPROJ_FP8 && N != 1024) || (OUTPROJ_FP8 && N == 1024)) transpose_item8(W, 1024, N, (unsigned char*)WT, 64 * kb, 64 * nb, 64 * nb, scr, lane_);
            else transpose_item(W, 1024, N, WT, 64 * kb, 64 * nb, 64 * nb, scr, lane_);
        }
    }
    {
        const int NIT = 64 * 1536;
#define MW_DESC(it_, W_, N_, Kb_, WT_, k0_, n0_, dr_) do { const int le_ = (it_) / 1536; int r_ = (it_) % 1536; \
            unsigned char* W1t_ = ws + WS_MOEW + (size_t)le_ * MOEW_E; \
            if (r_ < 1024) { const bool up_ = r_ >= 512; r_ &= 511; W_ = (up_ ? karg(KA_w_up) : karg(KA_w_gate)) + (size_t)le_ * 1024 * 2048; N_ = 2048; Kb_ = 1024; WT_ = W1t_; \
                k0_ = 64 * (r_ / 32); n0_ = 64 * (r_ % 32); dr_ = (n0_ >> 7) * 256 + (up_ ? 128 : 0) + (n0_ & 127); } \
            else { r_ -= 1024; W_ = karg(KA_w_down) + (size_t)le_ * 2048 * 1024; N_ = 1024; Kb_ = 2048; WT_ = W1t_ + (size_t)4096 * 1024; k0_ = 64 * (r_ / 16); n0_ = 64 * (r_ % 16); dr_ = n0_; } } while (0)
        f32x4 va[16], vb[16];
        const float* Wc = nullptr; int Nc = 0, Kbc = 0, k0c = 0, n0c = 0, drc = 0; unsigned char* WTc = nullptr;
        int it = gw;
        if (it < NIT) { MW_DESC(it, Wc, Nc, Kbc, WTc, k0c, n0c, drc); t8_load(va, Wc, Nc, k0c, n0c, lane_); }
        while (it < NIT) {
            const int itn = it + NGW;
            const float* Wn = Wc; int Nn = Nc, Kbn = Kbc, k0n = k0c, n0n = n0c, drn = drc; unsigned char* WTn = WTc;
            if (itn < NIT) { MW_DESC(itn, Wn, Nn, Kbn, WTn, k0n, n0n, drn); t8_load(vb, Wn, Nn, k0n, n0n, lane_); }
            t8_finish(va, Kbc, WTc, k0c, drc, scr, lane_);
#pragma unroll
            for (int i = 0; i < 16; ++i) va[i] = vb[i];
            Wc = Wn; Nc = Nn; Kbc = Kbn; WTc = WTn; k0c = k0n; n0c = n0n; drc = drn; it = itn;
        }
#undef MW_DESC
    }
    __syncthreads();
    {
        LAS float* sc = (LAS float*)F.lds;
        LAS float* red = (LAS float*)(F.lds + 69632);
        for (int i = tid_; i < 17 * 1024; i += 512) { const float v = (i < 16384) ? karg(KA_c)[i] : karg(KA_c_ctx)[i - 16384]; sc[i] = siluf(v); }
        __syncthreads();
        float* mod = (float*)(ws + WS_MOD);
        for (int task = F.vcu; task < 4 * 192; task += F.G) {
            const int L = task / 192, cg = task % 192, col = cg * 32 + (lane_ & 31), kh = lane_ >> 5;
            const float* wp = karg(KA_ada_w) + (size_t)L * 1024 * 6144 + (size_t)(wave_ * 128 + kh * 64) * 6144 + col;
            const LAS float* scp = sc + wave_ * 128 + kh * 64;
            float acc[17];
#pragma unroll
            for (int r = 0; r < 17; ++r) acc[r] = 0.f;
            for (int k0 = 0; k0 < 64; k0 += 16) { float w[16];
#pragma unroll
                for (int kk = 0; kk < 16; ++kk) w[kk] = wp[(size_t)(k0 + kk) * 6144];
#pragma unroll
                for (int kk = 0; kk < 16; ++kk)
#pragma unroll
                    for (int r = 0; r < 17; ++r) acc[r] += scp[r * 1024 + k0 + kk] * w[kk]; }
#pragma unroll
            for (int r = 0; r < 17; ++r) { acc[r] += __shfl_xor(acc[r], 32); if (lane_ < 32) red[(wave_ * 17 + r) * 32 + lane_] = acc[r]; }
            __syncthreads();
            for (int i = tid_; i < 17 * 32; i += 512) { const int r = i >> 5, ln = i & 31; float sum = 0.f;
#pragma unroll
                for (int w = 0; w < 8; ++w) sum += red[(w * 17 + r) * 32 + ln];
                mod[((size_t)L * 17 + r) * 6144 + cg * 32 + ln] = sum + karg(KA_ada_b)[L * 6144 + cg * 32 + ln]; }
            __syncthreads();
        }
    }
}

__device__ __forceinline__ void load_row(const float* row, int lane, f32x4 (&v)[4]) {
    const f32x4* xr = (const f32x4*)row + lane;
#pragma unroll
    for (int j = 0; j < 4; ++j) v[j] = xr[64 * j];
}
__device__ __forceinline__ void load_row_bf16(const bf16_t* row, int lane, u32x2 (&w)[4]) {
    const u32x2* p = (const u32x2*)row + lane;
#pragma unroll
    for (int j = 0; j < 4; ++j) w[j] = p[64 * j];
}
__device__ __forceinline__ void cvt_row_bf16(f32x4 (&v)[4], const u32x2 (&w)[4]) {
#pragma unroll
    for (int j = 0; j < 4; ++j) { v[j].x = __builtin_bit_cast(float, w[j].x << 16); v[j].y = __builtin_bit_cast(float, w[j].x & 0xffff0000u);
        v[j].z = __builtin_bit_cast(float, w[j].y << 16); v[j].w = __builtin_bit_cast(float, w[j].y & 0xffff0000u); }
}
__device__ __forceinline__ void add_row_bf16(f32x4 (&v)[4], const u32x2 (&w)[4]) {
#pragma unroll
    for (int j = 0; j < 4; ++j) { v[j].x += __builtin_bit_cast(float, w[j].x << 16); v[j].y += __builtin_bit_cast(float, w[j].x & 0xffff0000u);
        v[j].z += __builtin_bit_cast(float, w[j].y << 16); v[j].w += __builtin_bit_cast(float, w[j].y & 0xffff0000u); }
}
__device__ __forceinline__ float row_rstd(const f32x4 (&v)[4]) {
    float s = 0.f;
#pragma unroll
    for (int j = 0; j < 4; ++j) s += (v[j].x * v[j].x + v[j].y * v[j].y) + (v[j].z * v[j].z + v[j].w * v[j].w);
    return rsqrtf(wave_sum_fast(s) * (1.f / DM) + RMS_EPS);
}
__device__ __forceinline__ void store_row_bf16(bf16_t* orow, int lane, const f32x4 (&v)[4]) {
    u32x2* o8 = (u32x2*)orow + lane;
#pragma unroll
    for (int j = 0; j < 4; ++j) { u32x2 w; w.x = cvtpk(v[j].x, v[j].y); w.y = cvtpk(v[j].z, v[j].w); o8[64 * j] = w; }
}
__device__ __forceinline__ void store_row_fp8(unsigned char* orow, int lane, const f32x4 (&v)[4], float scale) {
    unsigned* o4 = (unsigned*)orow + lane;
#pragma unroll
    for (int j = 0; j < 4; ++j) { int t = 0; t = __builtin_amdgcn_cvt_pk_fp8_f32(v[j].x * scale, v[j].y * scale, t, false); t = __builtin_amdgcn_cvt_pk_fp8_f32(v[j].z * scale, v[j].w * scale, t, true); o4[64 * j] = (unsigned)t; }
}
struct ModCache { f32x4 sc[4], sh[4]; int b; };
__device__ __forceinline__ void modcache_load(ModCache& M, int b, const float* g, const float* modL, int shift_chunk, int scale_chunk, int lane) {
    if (M.b == b) return; M.b = b;
    const float* mp = modL + (size_t)b * 6144;
#pragma unroll
    for (int j = 0; j < 4; ++j) { const f32x4 gg = ((const f32x4*)g)[lane + 64 * j], s = ((const f32x4*)(mp + scale_chunk * DM))[lane + 64 * j];
        M.sc[j] = gg * (1.f + s); M.sh[j] = ((const f32x4*)(mp + shift_chunk * DM))[lane + 64 * j]; }
}
__device__ __forceinline__ int row_batch(int m) { return m < MX ? (m >> 12) : 16; }

__device__ __forceinline__ void phase_norm1(Frame& F, const float* x, const float* ctx, const float* g1, const float* modL, bf16_t* H, bf16_t* XB) {
    int tid_ = threadIdx.x; asm volatile("" : "+v"(tid_)); const int lane_ = tid_ & 63; const int wave_ = __builtin_amdgcn_readfirstlane(tid_ >> 6);
    const int gw = F.vcu * NWAVES + wave_, NGW = F.G * NWAVES; const int per = (MT + NGW - 1) / NGW;
    ModCache M; M.b = -1;
    const int m0 = gw * per, m1 = min(MT, m0 + per);
    f32x4 nx[4];
    if (m0 < m1) load_row(m0 < MX ? x + (size_t)m0 * DM : ctx + (size_t)(m0 - MX) * DM, lane_, nx);
    for (int m = m0; m < m1; ++m) {
        f32x4 v[4];
#pragma unroll
        for (int j = 0; j < 4; ++j) v[j] = nx[j];
        if (m + 1 < m1) load_row((m + 1) < MX ? x + (size_t)(m + 1) * DM : ctx + (size_t)(m + 1 - MX) * DM, lane_, nx);
        modcache_load(M, row_batch(m), g1, modL, 0, 1, lane_);
        store_row_bf16(XB + (size_t)m * DM, lane_, v);
        const float rstd = row_rstd(v);
#pragma unroll
        for (int j = 0; j < 4; ++j) v[j] = v[j] * rstd * M.sc[j] + M.sh[j];
        if (INPROJ_FP8) store_row_fp8((unsigned char*)H + (size_t)m * DM, lane_, v, H2_SCALE); else store_row_bf16(H + (size_t)m * DM, lane_, v);
    }
}

__device__ __forceinline__ void phase_norm2_router(Frame& F, const bf16_t* XB, const float* g2, const float* modL, const float* rw, unsigned char* H8, float* aff, int nrows, const bf16_t* P, bool do_router = true) {
    int tid_ = threadIdx.x; asm volatile("" : "+v"(tid_)); const int lane = tid_ & 63; const int wave_ = __builtin_amdgcn_readfirstlane(tid_ >> 6);
    LAS float* rwT = (LAS float*)F.lds;
    for (int i = tid_; i < 16384; i += 512) { const int d = i >> 4, e = i & 15; rwT[e * 1024 + d] = rw[i]; }
    __syncthreads();
    const int gw = F.vcu * NWAVES + wave_, NGW = F.G * NWAVES; constexpr int NR2 = 1; const int ngroups = nrows / NR2; const int per = (ngroups + NGW - 1) / NGW;
    ModCache M; M.b = -1;
    const int g0 = gw * per, g1 = min(ngroups, g0 + per);
    constexpr int ND3 = 3;
    u32x2 nx[ND3][4];
#pragma unroll
    for (int k = 0; k < ND3; ++k) if (g0 + k < g1) { load_row_bf16(XB + (size_t)(g0 + k) * DM, lane, nx[k]); }
    for (int gb = g0; gb < g1; gb += ND3)
#pragma unroll
    for (int k = 0; k < ND3; ++k) {
        const int g = gb + k; if (g >= g1) break;
        const int m = NR2 * g;
        f32x4 v[NR2][4];
        cvt_row_bf16(v[0], nx[k]);
        if (g + ND3 < g1) { load_row_bf16(XB + (size_t)(g + ND3) * DM, lane, nx[k]); }
        modcache_load(M, row_batch(m), g2, modL, 3, 4, lane);
#pragma unroll
        for (int r = 0; r < NR2; ++r) { const float rstd = row_rstd(v[r]);
#pragma unroll
            for (int j = 0; j < 4; ++j) v[r][j] = v[r][j] * rstd * M.sc[j] + M.sh[j];
            store_row_fp8(H8 + (size_t)(m + r) * DM, lane, v[r], H2_SCALE); }
        if (!do_router) continue;
        float pe[NR2][16];
        int lo4 = 4 * lane; asm volatile("" : "+v"(lo4));
#pragma unroll
        for (int eb = 0; eb < 16; eb += 4) {
            f32x4 w[4][4];
#pragma unroll
            for (int e4 = 0; e4 < 4; ++e4)
#pragma unroll
                for (int j = 0; j < 4; ++j) w[e4][j] = *(const LAS f32x4*)(rwT + (eb + e4) * 1024 + lo4 + 256 * j);
            __builtin_amdgcn_sched_barrier(0);
#pragma unroll
            for (int e4 = 0; e4 < 4; ++e4) { f32x2 s2 = {0.f, 0.f};
#pragma unroll
                for (int j = 0; j < 4; ++j) { s2 = __builtin_elementwise_fma((f32x2){v[0][j].x, v[0][j].y}, (f32x2){w[e4][j].x, w[e4][j].y}, s2); s2 = __builtin_elementwise_fma((f32x2){v[0][j].z, v[0][j].w}, (f32x2){w[e4][j].z, w[e4][j].w}, s2); }
                pe[0][eb + e4] = s2.x + s2.y; }
            __builtin_amdgcn_sched_barrier(0);
        }
        {
            LAS float* red = (LAS float*)(F.lds + 65536) + wave_ * 1088;
#pragma unroll
            for (int e = 0; e < 16; ++e) red[lane * 17 + e] = pe[0][e];
            const LAS float* rp = red + (lane >> 4) * 272 + (lane & 15);
            float sacc = 0.f;
#pragma unroll
            for (int i = 0; i < 16; ++i) sacc += rp[i * 17];
            sacc += __shfl_xor(sacc, 16); sacc += __shfl_xor(sacc, 32);
            const float mx = row16_max(sacc);
            const float ex = expf(sacc - mx);
            const float sm = row16_sum(ex);
            if (lane < 16) aff[(size_t)m * 16 + lane] = ex / sm;
        }
    }
    __syncthreads();
}

__device__ __forceinline__ void phase_norm2_router_mfma(Frame& F, const bf16_t* XB, const float* g2, const float* modL, const float* rw, unsigned char* H8, float* aff, int nrows) {
    int tid_ = threadIdx.x; asm volatile("" : "+v"(tid_)); const int lane = tid_ & 63; const int wave_ = __builtin_amdgcn_readfirstlane(tid_ >> 6);
    constexpr int AST = 2064;
    LAS unsigned char* Ahi = F.lds; LAS unsigned char* Alo = F.lds + 16 * AST; LAS float* red = (LAS float*)(F.lds + 2 * 16 * AST);
    const int e_ = lane & 15, kg = lane >> 4;
    bf16x8 Bh[4], Bl[4];
#pragma unroll
    for (int s = 0; s < 4; ++s) { const float* wp = rw + (size_t)(128 * wave_ + 32 * s + 8 * kg) * 16 + e_;
        const float x0 = wp[0], x1 = wp[16], x2 = wp[32], x3 = wp[48], x4 = wp[64], x5 = wp[80], x6 = wp[96], x7 = wp[112];
        u32x4 h, l; h.x = cvtpk(x0, x1); h.y = cvtpk(x2, x3); h.z = cvtpk(x4, x5); h.w = cvtpk(x6, x7);
        l.x = cvtpk(x0 - __builtin_bit_cast(float, h.x << 16), x1 - __builtin_bit_cast(float, h.x & 0xffff0000u)); l.y = cvtpk(x2 - __builtin_bit_cast(float, h.y << 16), x3 - __builtin_bit_cast(float, h.y & 0xffff0000u));
        l.z = cvtpk(x4 - __builtin_bit_cast(float, h.z << 16), x5 - __builtin_bit_cast(float, h.z & 0xffff0000u)); l.w = cvtpk(x6 - __builtin_bit_cast(float, h.w << 16), x7 - __builtin_bit_cast(float, h.w & 0xffff0000u));
        Bh[s] = __builtin_bit_cast(bf16x8, h); Bl[s] = __builtin_bit_cast(bf16x8, l); }
    const int ngroups = nrows >> 4; const bool ilv = (F.G == 256); const int per = ilv ? (ngroups >> 8) : (ngroups + F.G - 1) / F.G; const int gg0 = ilv ? 0 : F.vcu * per, gg1 = ilv ? per : min(ngroups, gg0 + per);
#define N2_GROUP(i) (ilv ? ((i) < 16 ? 256 * (F.vcu >> 4) + (F.vcu & 15) + 16 * (i) : 4096 + F.vcu) : (i))
    ModCache M; M.b = -1;
    u32x2 nx[2][4];
    if (gg0 < gg1) { load_row_bf16(XB + (size_t)(N2_GROUP(gg0) * 16 + 2 * wave_) * DM, lane, nx[0]); load_row_bf16(XB + (size_t)(N2_GROUP(gg0) * 16 + 2 * wave_ + 1) * DM, lane, nx[1]); }
    for (int gg = gg0; gg < gg1; ++gg) {
        const int mbase = N2_GROUP(gg) * 16;
        f32x4 v[2][4];
        cvt_row_bf16(v[0], nx[0]); cvt_row_bf16(v[1], nx[1]);
        if (gg + 1 < gg1) { const int mn_ = N2_GROUP(gg + 1) * 16; load_row_bf16(XB + (size_t)(mn_ + 2 * wave_) * DM, lane, nx[0]); load_row_bf16(XB + (size_t)(mn_ + 2 * wave_ + 1) * DM, lane, nx[1]); }
#pragma unroll
        for (int r = 0; r < 2; ++r) { const int tok = 2 * wave_ + r, m = mbase + tok;
            modcache_load(M, row_batch(m), g2, modL, 3, 4, lane);
            const float rstd = row_rstd(v[r]);
#pragma unroll
            for (int j = 0; j < 4; ++j) v[r][j] = v[r][j] * rstd * M.sc[j] + M.sh[j];
            store_row_fp8(H8 + (size_t)m * DM, lane, v[r], H2_SCALE);
            LAS unsigned char* ah = Ahi + tok * AST + 8 * lane;
#pragma unroll
            for (int j = 0; j < 4; ++j) { const f32x4 x = v[r][j]; u32x2 h, l; h.x = cvtpk(x.x, x.y); h.y = cvtpk(x.z, x.w);
                l.x = cvtpk(x.x - __builtin_bit_cast(float, h.x << 16), x.y - __builtin_bit_cast(float, h.x & 0xffff0000u)); l.y = cvtpk(x.z - __builtin_bit_cast(float, h.y << 16), x.w - __builtin_bit_cast(float, h.y & 0xffff0000u));
                *(LAS u32x2*)(ah + 512 * j) = h; *(LAS u32x2*)(ah + 16 * AST + 512 * j) = l; } }
        __syncthreads();
        f32x4 acc = {0.f, 0.f, 0.f, 0.f};
#pragma unroll
        for (int s = 0; s < 4; ++s) { const LAS unsigned char* ap = Ahi + e_ * AST + 256 * wave_ + 64 * s + 16 * kg;
            const bf16x8 a_h = *(const LAS bf16x8*)ap, a_l = *(const LAS bf16x8*)(ap + 16 * AST);
            acc = __builtin_amdgcn_mfma_f32_16x16x32_bf16(a_h, Bh[s], acc, 0, 0, 0); acc = __builtin_amdgcn_mfma_f32_16x16x32_bf16(a_h, Bl[s], acc, 0, 0, 0); acc = __builtin_amdgcn_mfma_f32_16x16x32_bf16(a_l, Bh[s], acc, 0, 0, 0); }
#pragma unroll
        for (int r = 0; r < 4; ++r) red[wave_ * 256 + (4 * kg + r) * 16 + e_] = acc[r];
        __syncthreads();
        if (tid_ < 256) { float sacc = 0.f;
#pragma unroll
            for (int w = 0; w < 8; ++w) sacc += red[w * 256 + tid_];
            const float mx = row16_max(sacc);
            const float ex = expf(sacc - mx);
            const float sm = row16_sum(ex);
            aff[(size_t)(mbase + (tid_ >> 4)) * 16 + (tid_ & 15)] = ex / sm; }
    }
    __syncthreads();
#undef N2_GROUP
}

template <int NPT>
__device__ __forceinline__ void topk_task(Frame& F, const float* aff, int rowbase, int n, int cap, int e, int slot_base, unsigned* rowsrc_e, short* slot) {
    int tid_ = threadIdx.x; asm volatile("" : "+v"(tid_)); const int lane_ = tid_ & 63; const int wave_ = __builtin_amdgcn_readfirstlane(tid_ >> 6);
    LAS unsigned* cnt = (LAS unsigned*)F.lds;
    const int tid = tid_, lane = lane_, wave = wave_;
    const bool act = tid * NPT < n;
    unsigned v[NPT];
#pragma unroll
    for (int j = 0; j < NPT; ++j) v[j] = act ? __float_as_uint(aff[(size_t)(rowbase + tid * NPT + j) * 16 + e]) : 0u;
    unsigned T = 0u;
    for (int bit = 30; bit >= 0; --bit) {
        const unsigned cand = T | (1u << bit);
        unsigned c = 0;
#pragma unroll
        for (int j = 0; j < NPT; ++j) c += (act && v[j] >= cand) ? 1u : 0u;
        c = (unsigned)wave_sum((float)c);
        LAS unsigned* cb = cnt + (bit & 1) * 8;
        if (lane == 0) cb[wave] = c;
        __syncthreads();
        unsigned tot = 0;
#pragma unroll
        for (int w = 0; w < 8; ++w) tot += cb[w];
        if (tot >= (unsigned)cap) T = cand;
    }
    unsigned ngt = 0, neq = 0;
#pragma unroll
    for (int j = 0; j < NPT; ++j) { ngt += (act && v[j] > T) ? 1u : 0u; neq += (act && v[j] == T) ? 1u : 0u; }
    unsigned pk = ngt | (neq << 16), inc = pk;
#pragma unroll
    for (int o = 1; o < 64; o <<= 1) { const unsigned t = __shfl_up(inc, o); if (lane >= o) inc += t; }
    LAS unsigned* wtot = cnt + 32;
    __syncthreads();
    if (lane == 63) wtot[wave] = inc;
    __syncthreads();
    unsigned wpre = 0, total = 0;
#pragma unroll
    for (int w = 0; w < 8; ++w) { const unsigned t = wtot[w]; if (w < wave) wpre += t; total += t; }
    const unsigned exc = wpre + inc - pk;
    const unsigned tot_gt = total & 0xffffu;
    const unsigned need_eq = (unsigned)cap - tot_gt;
    unsigned gt_before = exc & 0xffffu, eq_before = exc >> 16;
    if (act) {
#pragma unroll
        for (int j = 0; j < NPT; ++j) {
            const bool g = v[j] > T, q = v[j] == T;
            const bool sel = g || (q && eq_before < need_eq);
            const int tok = tid * NPT + j;
            short sv = -1;
            if (sel) { const unsigned pos = gt_before + min(eq_before, need_eq); sv = (short)(slot_base + pos); rowsrc_e[slot_base + pos] = (unsigned)(rowbase + tok); }
            slot[(size_t)(rowbase + tok) * 16 + e] = sv;
            gt_before += g ? 1u : 0u; eq_before += q ? 1u : 0u;
        }
    }
    __syncthreads();
}
__device__ __forceinline__ void phase_topk(Frame& F, const float* aff, unsigned* rowsrc, short* slot, int nMe, bool with_ctx) {
    const int ntask = NB * NE * (with_ctx ? 2 : 1);
    for (int t = F.vcu; t < ntask; t += F.G) {
        const bool cx = t >= NB * NE; const int tt = cx ? t - NB * NE : t; const int b = tt >> 4, e = tt & 15;
        unsigned* rs_e = rowsrc + (size_t)e * nMe * 256;
        if (!cx) topk_task<8>(F, aff, b * SEQ, SEQ, CAPX, e, b * CAPX, rs_e, slot);
        else topk_task<1>(F, aff, MX + b * CTXL, CTXL, CAPC, e, NB * CAPX + b * CAPC, rs_e, slot);
    }
}

__device__ __forceinline__ void phase_combine(Frame& F, bf16_t* XB, const bf16_t* P, float* xout, const float* modL, const float* aff, const short* slot, const bf16_t* ybuf, int nMe,
                                              int nrows, bool last, const float* gnext, const float* modN, bf16_t* H, const float* final_g, float* dump = nullptr) {
    int tid_ = threadIdx.x; asm volatile("" : "+v"(tid_)); const int lane = tid_ & 63; const int wave_ = __builtin_amdgcn_readfirstlane(tid_ >> 6);
    const int gw = F.vcu * NWAVES + wave_, NGW = F.G * NWAVES; const int per = (nrows + NGW - 1) / NGW;
    ModCache M; M.b = -1;
    f32x4 g2v[4]; int gb = -1;
    const int m0 = gw * per, m1 = min(nrows, m0 + per);
    const size_t estride = (size_t)nMe * 256 * DM;
#define CB_META(m, sv, av) do { sv = (int)slot[(size_t)(m) * 16 + (lane & 15)]; av = aff[(size_t)(m) * 16 + (lane & 15)]; } while (0)
#define CB_ISSUE(m, sv, av, X, Y, AK, REST) do { load_row_bf16(XB + (size_t)(m) * DM, lane, X); \
        unsigned mk_ = (unsigned)__ballot(sv >= 0) & 0xffffu; \
        _Pragma("unroll") for (int k = 0; k < 4; ++k) { \
            if (mk_) { const int e_ = __builtin_ctz(mk_); mk_ &= mk_ - 1u; const int s_ = __builtin_amdgcn_readlane(sv, e_); AK[k] = __builtin_bit_cast(float, __builtin_amdgcn_readlane(__builtin_bit_cast(int, av), e_)); \
                const u32x2* yr_ = (const u32x2*)(ybuf + (size_t)e_ * estride + (size_t)s_ * DM) + lane; \
                _Pragma("unroll") for (int j = 0; j < 4; ++j) Y[k][j] = yr_[64 * j]; } \
            else { AK[k] = 0.f; _Pragma("unroll") for (int j = 0; j < 4; ++j) Y[k][j] = (u32x2){0u, 0u}; } } \
        REST = mk_; } while (0)
    int sv1 = -1, sv2 = -1; float av1 = 0.f, av2 = 0.f;
    u32x2 X[4], Xn[4]; u32x2 Y[4][4], Yn[4][4]; float AK[4], AKn[4]; unsigned rest = 0, restn = 0; int svc = -1, svn = -1; float avc = 0.f, avn = 0.f;
    if (m0 < m1) { CB_META(m0, sv1, av1); CB_ISSUE(m0, sv1, av1, X, Y, AK, rest); svc = sv1; avc = av1; }
    if (m0 + 1 < m1) CB_META(m0 + 1, sv1, av1);
    for (int m = m0; m < m1; ++m) {
        if (m + 1 < m1) { CB_ISSUE(m + 1, sv1, av1, Xn, Yn, AKn, restn); svn = sv1; avn = av1; }
        if (m + 2 < m1) CB_META(m + 2, sv1, av1);
        const int b = row_batch(m);
        if (gb != b) { gb = b;
#pragma unroll
            for (int j = 0; j < 4; ++j) g2v[j] = ((const f32x4*)(modL + (size_t)b * 6144 + 5 * DM))[lane + 64 * j]; }
        f32x4 acc[4];
#pragma unroll
        for (int j = 0; j < 4; ++j) acc[j] = (f32x4){0.f, 0.f, 0.f, 0.f};
#pragma unroll
        for (int k = 0; k < 4; ++k) { const float a = AK[k];
#pragma unroll
            for (int j = 0; j < 4; ++j) { const u32x2 w = Y[k][j];
                acc[j].x += a * __builtin_bit_cast(float, w.x << 16); acc[j].y += a * __builtin_bit_cast(float, w.x & 0xffff0000u);
                acc[j].z += a * __builtin_bit_cast(float, w.y << 16); acc[j].w += a * __builtin_bit_cast(float, w.y & 0xffff0000u); } }
        while (rest) { const int e_ = __builtin_ctz(rest); rest &= rest - 1u; const int s_ = __builtin_amdgcn_readlane(svc, e_); const float a = __builtin_bit_cast(float, __builtin_amdgcn_readlane(__builtin_bit_cast(int, avc), e_));
            const u32x2* yr = (const u32x2*)(ybuf + (size_t)e_ * estride + (size_t)s_ * DM) + lane;
#pragma unroll
            for (int j = 0; j < 4; ++j) { const u32x2 w = yr[64 * j];
                acc[j].x += a * __builtin_bit_cast(float, w.x << 16); acc[j].y += a * __builtin_bit_cast(float, w.x & 0xffff0000u);
                acc[j].z += a * __builtin_bit_cast(float, w.y << 16); acc[j].w += a * __builtin_bit_cast(float, w.y & 0xffff0000u); } }
        f32x4 v[4];
        cvt_row_bf16(v, X);
#pragma unroll
        for (int j = 0; j < 4; ++j) v[j] = v[j] + g2v[j] * acc[j];
        const float rstd = row_rstd(v);
        if (!last) {
            store_row_bf16((dump ? (bf16_t*)dump : XB) + (size_t)m * DM, lane, v);
            modcache_load(M, b, gnext, modN, 0, 1, lane);
#pragma unroll
            for (int j = 0; j < 4; ++j) v[j] = v[j] * rstd * M.sc[j] + M.sh[j];
            if (INPROJ_FP8) store_row_fp8((unsigned char*)H + (size_t)m * DM, lane, v, H2_SCALE); else store_row_bf16(H + (size_t)m * DM, lane, v);
        } else {
            f32x4* o = (f32x4*)((dump ? dump : xout) + (size_t)m * DM) + lane;
#pragma unroll
            for (int j = 0; j < 4; ++j) o[64 * j] = v[j] * rstd * ((const f32x4*)final_g)[lane + 64 * j];
        }
#pragma unroll
        for (int j = 0; j < 4; ++j) { X[j] = Xn[j];
#pragma unroll
            for (int k = 0; k < 4; ++k) Y[k][j] = Yn[k][j]; }
#pragma unroll
        for (int k = 0; k < 4; ++k) AK[k] = AKn[k];
        rest = restn; svc = svn; avc = avn;
    }
#undef CB_META
#undef CB_ISSUE
}

struct Args { In in; float* out; unsigned char* ws; int ph_lo, ph_hi; };
#define WSP(off) ((unsigned char*)karg(KA_WS) + (off))
__global__ void __launch_bounds__(NWAVES * 64, 2) fwd(Args args) {
    extern __shared__ __attribute__((aligned(16))) unsigned char lds_raw[];
    Frame F;
    F.lds = (LAS unsigned char*)lds_raw;
    F.MISC = (volatile LAS unsigned*)(F.lds + MISC_OFF);
    F.tid = threadIdx.x; F.lane = F.tid & 63; F.wave = __builtin_amdgcn_readfirstlane(F.tid >> 6);
    F.G = gridDim.x; { const int bx = blockIdx.x; F.vcu = (F.G % 8 == 0) ? (bx % 8) * (F.G / 8) + bx / 8 : bx; }
    F.ctl = nullptr;
    if (F.tid < 64) ((LAS unsigned*)(F.lds + MISC_OFF))[F.tid] = 0u;
    __syncthreads();
    const int lo = args.ph_lo, hi = args.ph_hi;
    if (hi - lo > 1) (void)xcd_barrier_post((unsigned*)WSP(WS_CTL) + 1024, F.MISC + 8);
#ifndef DBG_ONLY
#define DBG_ONLY -1
#endif
#define PHEN(k) (DBG_ONLY < 0 || ((k) < 2 ? (k) : 2 + (((k) - 2) & 7)) == DBG_ONLY)
#define IN(k) (PHEN(k) && lo <= (k) && (k) < hi)
#ifndef ROUTER_MFMA
#define ROUTER_MFMA 1
#endif
#ifndef DUP_PH
#define DUP_PH -1
#endif
#ifndef DUP_LMASK
#define DUP_LMASK 0xF
#endif
#define NREP(k, L) ((DUP_PH == (k) && ((DUP_LMASK >> (L)) & 1)) ? 2 : 1)
#define SEAM(k) do { if (IN(k) && IN((k) + 1)) { XcdBarrier bar_; bar_.bar = (unsigned*)WSP(WS_CTL) + 1024; bar_.x = xb_xcc_id(); bar_.st = F.MISC + 8; xcd_barrier(bar_); } } while (0)

    if (IN(0)) { for (int rep_ = 0; rep_ < NREP(0, 0); ++rep_) phase_prologue(F, WSP(0)); } SEAM(0);
    if (IN(1)) { phase_norm1(F, karg(KA_x), karg(KA_ctx), karg(KA_norm1_g), (const float*)WSP(WS_MOD), (bf16_t*)WSP(WS_H), (bf16_t*)WSP(WS_XB)); } SEAM(1);

#pragma unroll 1
    for (int L = 0; L < DEPTH; ++L) {
        const int pb = 2 + 8 * L;
        if (hi <= pb || lo >= pb + 8) continue;
        if (IN(pb + 0)) for (int rep_ = 0; rep_ < NREP(2, L); ++rep_) {
            const int kind = L % 3, slot = L / 3; const int Nin = (kind == 0) ? 1536 : 3072;
            const bf16_t* Wt = (const bf16_t*)WSP(WS_PW) + (kind == 0 ? PW_WIN_IN / 2 + (size_t)slot * 1536 * 1024 : kind == 1 ? PW_DIFF_IN / 2 : PW_NA_IN / 2);
            pg8::Gemm g{(const char*)WSP(WS_H), (const char*)Wt, INPROJ_FP8 ? DM : DM * 2, 1 << 20, 0, nullptr};
            pg8::StaticOrder S; S.init(MT / 256, Nin / 256, F.G, (int)blockIdx.x);
            pg8::EpiInProj E{(bf16_t*)WSP(WS_QKV), Nin, 4, kind == 0 ? 5 : (kind == 1 ? 8 : 0), (const float*)WSP(WS_TAB), INPROJ_FP8 ? 1.f / (H2_SCALE * W8_SCALE) : 1.f, kind == 0 ? 5 : 8, (bf16_t*)WSP(WS_P)};
            pg8::gemm_phase<pg8::EpiInProj, false, true, INPROJ_FP8 != 0>(F.lds, g, S, E);
        }
        SEAM(pb + 0);
        if (IN(pb + 1)) for (int rep_ = 0; rep_ < NREP(3, L); ++rep_) {
            const int kind = L % 3, slot = L / 3; const int with_ctx = L < DEPTH - 1 ? 1 : 0;
            if (kind == 0) { att::A2Args A{(const bf16_t*)WSP(WS_QKV), (bf16_t*)WSP(WS_H), karg(KA_win_sink) + slot * 16, with_ctx, (const bf16_t*)WSP(WS_P)}; att::att2_phase<0>(F.lds, A, F.vcu, F.G); }
            else if (kind == 1) { const float* TAB = (const float*)WSP(WS_TAB); att::DiffArgs A{(const bf16_t*)WSP(WS_QKV), (bf16_t*)WSP(WS_H), karg(KA_diff_subln_g), TAB[TAB_LAM], TAB[TAB_LAM + 1], with_ctx, (const bf16_t*)WSP(WS_P)}; att::diff_phase3(F.lds, A, F.vcu, F.G); }
            else { att::A2Args A{(const bf16_t*)WSP(WS_QKV), (bf16_t*)WSP(WS_H), karg(KA_na_rpb), with_ctx, (const bf16_t*)WSP(WS_P)}; att::att2_phase<1>(F.lds, A, F.vcu, F.G); }
        }
        SEAM(pb + 1);
        if (IN(pb + 2)) {
            const int kind = L % 3, slot = L / 3; const bool with_ctx = L < DEPTH - 1;
            const bf16_t* Wt = (const bf16_t*)WSP(WS_PW) + (kind == 0 ? PW_WIN_OUT / 2 + (size_t)slot * 1024 * 1024 : kind == 1 ? PW_DIFF_OUT / 2 : PW_NA_OUT / 2);
            pg8::Gemm g{(const char*)WSP(WS_H), (const char*)Wt, OUTPROJ_FP8 ? DM : DM * 2, 1 << 20, 0, nullptr};
            pg8::StaticOrder S; S.init((with_ctx ? MT : MX) / 256, 4, F.G, (int)blockIdx.x);
            pg8::EpiOutProj E{(bf16_t*)WSP(WS_XB), (const float*)WSP(WS_MOD) + (size_t)L * 17 * 6144, OUTPROJ_FP8 ? 1.f / (Y_SCALE * W8_SCALE) : 1.f};
            pg8::gemm_phase<pg8::EpiOutProj, false, true, OUTPROJ_FP8 != 0>(F.lds, g, S, E);
        }
        SEAM(pb + 2);
        if (IN(pb + 3)) for (int rep_ = 0; rep_ < NREP(5, L); ++rep_) { const bool with_ctx = L < DEPTH - 1;
            if (ROUTER_MFMA && rep_ == 0) phase_norm2_router_mfma(F, (const bf16_t*)WSP(WS_XB), karg(KA_norm2_g) + L * DM, (const float*)WSP(WS_MOD) + (size_t)L * 17 * 6144, karg(KA_router_w) + (size_t)L * DM * NE,
                               (unsigned char*)WSP(WS_H), (float*)WSP(WS_AFF), with_ctx ? MT : MX);
            else phase_norm2_router(F, (const bf16_t*)WSP(WS_XB), karg(KA_norm2_g) + L * DM, (const float*)WSP(WS_MOD) + (size_t)L * 17 * 6144, karg(KA_router_w) + (size_t)L * DM * NE,
                               (unsigned char*)WSP(WS_H), (float*)WSP(WS_AFF), with_ctx ? MT : MX, (const bf16_t*)WSP(WS_P), rep_ == 0); }
        SEAM(pb + 3);
        if (IN(pb + 4)) for (int rep_ = 0; rep_ < NREP(6, L); ++rep_) { const bool with_ctx = L < DEPTH - 1; phase_topk(F, (const float*)WSP(WS_AFF), (unsigned*)WSP(WS_ROWSRC), (short*)WSP(WS_SLOT), with_ctx ? NME_FULL : NME_LAST, with_ctx); }
        SEAM(pb + 4);
        if (IN(pb + 5)) for (int rep_ = 0; rep_ < NREP(7, L); ++rep_) {
            const int nMe = (L < DEPTH - 1) ? NME_FULL : NME_LAST;
            pg8::Gemm g{(const char*)WSP(WS_H), (const char*)WSP(WS_MOEW + (size_t)L * 16 * MOEW_E), DM, nMe, MOEW_E, (const unsigned*)WSP(WS_ROWSRC)};
            pg8::StaticOrder S; S.init(16 * nMe, 16, F.G, (int)blockIdx.x);
            if (DUP_PH == 7 && rep_ == 1) { pg8::EpiSwiglu<true> E{(unsigned char*)WSP(WS_QKV), 1.f / (H2_SCALE * W8_SCALE), HID_SCALE};
                pg8::gemm_phase<pg8::EpiSwiglu<true>, true, true, true>(F.lds, g, S, E); }
            else { pg8::EpiSwiglu<false> E{(unsigned char*)WSP(WS_QKV), 1.f / (H2_SCALE * W8_SCALE), HID_SCALE};
                pg8::gemm_phase<pg8::EpiSwiglu<false>, true, true, true>(F.lds, g, S, E); }
        }
        SEAM(pb + 5);
        if (IN(pb + 6)) for (int rep_ = 0; rep_ < NREP(8, L); ++rep_) {
            const int nMe = (L < DEPTH - 1) ? NME_FULL : NME_LAST;
            pg8::Gemm g{(const char*)WSP(WS_QKV), (const char*)WSP(WS_MOEW + (size_t)L * 16 * MOEW_E + (size_t)4096 * 1024), FF, nMe, MOEW_E, nullptr};
            pg8::StaticOrder S; S.init(16 * nMe, 4, F.G, (int)blockIdx.x);
            pg8::EpiBf16 E{(bf16_t*)WSP(WS_YBUF), DM, 1.f / (HID_SCALE * W8_SCALE)};
            pg8::gemm_phase<pg8::EpiBf16, false, true, true, true>(F.lds, g, S, E);
        }
        SEAM(pb + 6);
        if (IN(pb + 7)) for (int rep_ = NREP(9, L) - 1; rep_ >= 0; --rep_) {
            const bool last = (L == DEPTH - 1); const bool with_ctx = !last;
            phase_combine(F, (bf16_t*)WSP(WS_XB), (const bf16_t*)WSP(WS_P), (float*)karg(KA_OUT), (const float*)WSP(WS_MOD) + (size_t)L * 17 * 6144, (const float*)WSP(WS_AFF), (const short*)WSP(WS_SLOT), (const bf16_t*)WSP(WS_YBUF),
                          with_ctx ? NME_FULL : NME_LAST, with_ctx ? MT : MX, last, karg(KA_norm1_g) + (last ? 0 : (L + 1) * DM), (const float*)WSP(WS_MOD) + (size_t)(last ? 0 : L + 1) * 17 * 6144,
                          rep_ ? (bf16_t*)WSP(WS_QKV + 300 * MiB) : (bf16_t*)WSP(WS_H), karg(KA_final_g), rep_ ? (float*)WSP(WS_QKV) : nullptr);
        }
        SEAM(pb + 7);
    }
#undef IN
#undef SEAM
}

extern "C" void kernel_launch(void* const* d_in, const int* in_sizes, int n_in, void* d_out, int out_size, void* d_ws, size_t ws_size, hipStream_t stream) {
    static int grid = 0;
    if (grid == 0) {
        if (n_in != 23 || out_size != MX * DM || ws_size < WS_END) { fprintf(stderr, "kernel_launch: unexpected shapes: n_in %d out %d ws %zu (need %zu)\n", n_in, out_size, ws_size, (size_t)WS_END); grid = -1; return; }
        int dev = 0, cus = 0, per_cu = 0;
        if (hipGetDevice(&dev) != hipSuccess || hipDeviceGetAttribute(&cus, hipDeviceAttributeMultiprocessorCount, dev) != hipSuccess) { grid = -1; return; }
        if (hipFuncSetAttribute((const void*)fwd, hipFuncAttributeMaxDynamicSharedMemorySize, LDS_BYTES) != hipSuccess) { fprintf(stderr, "kernel_launch: hipFuncSetAttribute failed\n"); grid = -1; return; }
        if (hipOccupancyMaxActiveBlocksPerMultiprocessor(&per_cu, (const void*)fwd, NWAVES * 64, LDS_BYTES) != hipSuccess || per_cu < 1) fprintf(stderr, "kernel_launch: occupancy query says %d\n", per_cu);
        (void)hipGetLastError();
        grid = cus;
    }
    if (grid < 0) return;
    (void)hipMemsetAsync((char*)d_ws + WS_CTL, 0, CTL_ZERO_BYTES, stream);
    Args a{};
    const float** ip = (const float**)&a.in;
    for (int i = 0; i < 23; ++i) ip[i] = (const float*)d_in[i];
    a.out = (float*)d_out; a.ws = (unsigned char*)d_ws;
    if (MK_N_LAUNCHES == 1) { a.ph_lo = 0; a.ph_hi = NPHASES; hipLaunchKernelGGL(fwd, dim3(grid), dim3(NWAVES * 64), LDS_BYTES, stream, a); }
    else for (int p = 0; p < NPHASES; ++p) { a.ph_lo = p; a.ph_hi = p + 1; hipLaunchKernelGGL(fwd, dim3(grid), dim3(NWAVES * 64), LDS_BYTES, stream, a); }
}
```

```cpp
#include <hip/hip_runtime.h>
#include <cstdio>
#include <cstdint>

#ifndef MK_N_LAUNCHES
#define MK_N_LAUNCHES 1
#endif

#define GAS __attribute__((address_space(1)))
#define LAS __attribute__((address_space(3)))
typedef unsigned short bf16_t;
typedef short bf16x8 __attribute__((ext_vector_type(8)));
typedef short s16x4 __attribute__((ext_vector_type(4)));
typedef float f32x4 __attribute__((ext_vector_type(4)));
typedef float f32x2 __attribute__((ext_vector_type(2)));
typedef float f32x16 __attribute__((ext_vector_type(16)));
typedef unsigned u32x4 __attribute__((ext_vector_type(4)));
typedef unsigned u32x2 __attribute__((ext_vector_type(2)));
typedef __bf16 bf16x2_t __attribute__((ext_vector_type(2)));
typedef GAS unsigned gu32;

constexpr int DM = 1024, NB = 16, SEQ = 4096, DEPTH = 4, CTXL = 256, NE = 16, FF = 2048;
constexpr int MX = NB * SEQ;
constexpr int MC = NB * CTXL;
constexpr int MT = MX + MC;
constexpr int CAPX = 512, CAPC = 32;
constexpr int NME_FULL = 34, NME_LAST = 32;
constexpr float C2 = 0.125f * 1.4426950408889634f;
constexpr float LOG2E = 1.4426950408889634f;
constexpr float RMS_EPS = 1e-6f;
constexpr float NEG_BIG = -1e30f;
constexpr int NWAVES = 8;
constexpr int NPHASES = 2 + 8 * DEPTH;

constexpr size_t MiB = 1u << 20;
constexpr size_t WS_CTL = 0, CTL_ZERO_BYTES = 64 * 1024;
constexpr size_t WS_MOD = 1 * MiB;
constexpr size_t WS_TAB = 3 * MiB;
constexpr size_t WS_AFF = 4 * MiB;
constexpr size_t WS_SLOT = 9 * MiB;
constexpr size_t WS_ROWSRC = 12 * MiB;
constexpr size_t WS_CTXRES = 13 * MiB;
constexpr size_t WS_PW = 29 * MiB;
constexpr size_t PW_WIN_IN = 0, PW_WIN_OUT = 6 * MiB, PW_DIFF_IN = 10 * MiB, PW_DIFF_OUT = 16 * MiB, PW_NA_IN = 18 * MiB, PW_NA_OUT = 24 * MiB;
constexpr size_t WS_H = 56 * MiB;
constexpr size_t WS_QKV = 192 * MiB;
constexpr size_t WS_YBUF = 736 * MiB;
constexpr size_t WS_MOEW = 1008 * MiB;
constexpr size_t MOEW_E = (size_t)(4096 * 1024 + 1024 * 2048);
#ifndef INPROJ_FP8
#define INPROJ_FP8 1
#endif
#ifndef OUTPROJ_FP8
#define OUTPROJ_FP8 0
#endif
constexpr float Y_SCALE = 8.f;
constexpr float H2_SCALE = 4.f, HID_SCALE = 2.f, W8_SCALE = 32.f;
constexpr size_t WS_XB = 1536 * MiB;
constexpr size_t WS_END = 1672 * MiB;
constexpr size_t WS_P = 1400 * MiB;
constexpr int TAB_COS = 0, TAB_SIN = 1024, TAB_LAM = 2048;

constexpr int RING_BYTES = 131072;
constexpr int MISC_OFF = 135168;
constexpr int LDS_BYTES = 147456;

#define LDS_WAIT() asm volatile("s_waitcnt lgkmcnt(0)" ::: "memory")
#define VM_WAIT() asm volatile("s_waitcnt vmcnt(0)" ::: "memory")

__device__ __forceinline__ unsigned cvtpk(float lo, float hi) { f32x2 v = {lo, hi}; bf16x2_t b = __builtin_convertvector(v, bf16x2_t); return __builtin_bit_cast(unsigned, b); }
__device__ __forceinline__ float bf2f(unsigned short u) { return __builtin_bit_cast(float, (unsigned)u << 16); }
__device__ __forceinline__ float wave_sum(float v) {
#pragma unroll
    for (int o = 1; o < 64; o <<= 1) v += __shfl_xor(v, o);
    return v;
}
template <int CTRL> __device__ __forceinline__ float dppf(float v) { return __builtin_bit_cast(float, __builtin_amdgcn_update_dpp(0, __builtin_bit_cast(int, v), CTRL, 0xF, 0xF, true)); }
__device__ __forceinline__ float row16_sum(float v) { v += dppf<0xB1>(v); v += dppf<0x4E>(v); v += dppf<0x141>(v); v += dppf<0x140>(v); return v; }
__device__ __forceinline__ float row16_max(float v) { v = fmaxf(v, dppf<0xB1>(v)); v = fmaxf(v, dppf<0x4E>(v)); v = fmaxf(v, dppf<0x141>(v)); v = fmaxf(v, dppf<0x140>(v)); return v; }
__device__ __forceinline__ float rdlane(float v, int l) { return __builtin_bit_cast(float, __builtin_amdgcn_readlane(__builtin_bit_cast(int, v), l)); }
__device__ __forceinline__ float wave_sum_fast(float v) { v = row16_sum(v); return (rdlane(v, 0) + rdlane(v, 16)) + (rdlane(v, 32) + rdlane(v, 48)); }
__device__ __forceinline__ float siluf(float v) { return v / (1.f + __expf(-v)); }

#define XB_TMO      128
#define XB_XCNT(j)  (256  + 64 * (j))
#define XB_XSUB(j)  (1280 + 64 * (j))
#define XB_XGEN(j)  (2304 + 64 * (j))
#define XB_TOP      3328
#define XB_TOPGEN   3392
#define XCD_BAR_WORDS 3456
#define XB_SPIN_CAP (1u << 18)
__device__ __forceinline__ unsigned xb_ld(unsigned* p)              { return __hip_atomic_load(p, __ATOMIC_RELAXED, __HIP_MEMORY_SCOPE_AGENT); }
__device__ __forceinline__ unsigned xb_add(unsigned* p, unsigned v) { return __hip_atomic_fetch_add(p, v, __ATOMIC_RELAXED, __HIP_MEMORY_SCOPE_AGENT); }
__device__ __forceinline__ unsigned xb_xcc_id() { return (unsigned)__builtin_amdgcn_s_getreg((3 << 11) | 20) & 0xFu; }
#define XB_SPIN(cond, bar) do { unsigned _sp = 0; while (cond) { __builtin_amdgcn_s_sleep(1); \
    if ((++_sp & 255u) == 0u) { if (xb_ld(&(bar)[XB_TMO])) break; if (_sp > XB_SPIN_CAP) { atomicAdd(&(bar)[XB_TMO], 1u); break; } } } } while (0)
struct XcdBarrier { unsigned* bar; unsigned x; volatile LAS unsigned* st; };
__device__ __forceinline__ XcdBarrier xcd_barrier_post(unsigned* bar, volatile LAS unsigned* st) {
    XcdBarrier b; b.bar = bar; b.x = xb_xcc_id(); b.st = st;
    if (threadIdx.x == 0) (void)xb_add(&bar[XB_XCNT(b.x)], 1u);
    return b;
}
__device__ __forceinline__ void xcd_barrier_complete(unsigned* bar, unsigned x, unsigned& nloc, unsigned& nx) {
    const unsigned G = gridDim.x * gridDim.y * gridDim.z;
    unsigned sum, cnt, mine, sp = 0u;
    for (;;) {
        sum = 0u; cnt = 0u; mine = 0u;
#pragma unroll
        for (unsigned j = 0; j < 16; ++j) { const unsigned c = xb_ld(&bar[XB_XCNT(j)]); sum += c; cnt += (c > 0u) ? 1u : 0u; mine = (j == x) ? c : mine; }
        if (sum == G) break;
        __builtin_amdgcn_s_sleep(1);
        if ((++sp & 255u) == 0u) { if (xb_ld(&bar[XB_TMO])) break; if (sp > XB_SPIN_CAP) { atomicAdd(&bar[XB_TMO], 1u); break; } }
    }
    nloc = mine > 0u ? mine : 1u; nx = cnt > 0u ? cnt : 1u;
}
__device__ __forceinline__ void xcd_barrier(const XcdBarrier& b) {
    asm volatile("s_waitcnt vmcnt(0)" ::: "memory");
    __syncthreads();
    if (threadIdx.x == 0) {
        unsigned* bar = b.bar;
        __builtin_amdgcn_s_waitcnt(0);
        unsigned nloc = b.st[0], nx = b.st[1];
        if (nloc == 0u) { xcd_barrier_complete(bar, b.x, nloc, nx); b.st[0] = nloc; b.st[1] = nx; }
        const unsigned old = xb_add(&bar[XB_XSUB(b.x)], 1u);
        const unsigned gen = old / nloc;
        if (old + 1u == (gen + 1u) * nloc) {
            __builtin_amdgcn_fence(__ATOMIC_RELEASE, "agent");
            asm volatile("s_waitcnt vmcnt(0)" ::: "memory");
            const unsigned og = xb_add(&bar[XB_TOP], 1u);
            const unsigned tg = og / nx;
            if (og + 1u == (tg + 1u) * nx) xb_add(&bar[XB_TOPGEN], 1u);
            else XB_SPIN(xb_ld(&bar[XB_TOPGEN]) == tg, bar);
            __builtin_amdgcn_fence(__ATOMIC_ACQUIRE, "agent");
            xb_add(&bar[XB_XGEN(b.x)], 1u);
            asm volatile("s_waitcnt vmcnt(0)" ::: "memory");
        } else {
            XB_SPIN(xb_ld(&bar[XB_XGEN(b.x)]) == gen, bar);
            __builtin_amdgcn_fence(__ATOMIC_ACQUIRE, "agent");
            asm volatile("s_waitcnt vmcnt(0)" ::: "memory");
        }
    }
    __syncthreads();
}

namespace pg8 {
constexpr int BM = 256, BK = 64, HALF = 128, HTB = HALF * BK * 2, NXCD = 8, WGM = 4;
typedef int v4i __attribute__((ext_vector_type(4)));
typedef int v8i __attribute__((ext_vector_type(8)));
__host__ __device__ __forceinline__ int lds_byte(int r, int c) { const int st = (r >> 4) * 2 + (c >> 5), rr = r & 15, cc = c & 31, ob = rr * 64 + cc * 2; return st * 1024 + (ob ^ (((ob >> 9) & 1) << 5)); }
__host__ __device__ __forceinline__ void stage_rc(int b, int& R, int& C) { const int st = b / 1024, sb = b % 1024, swz = sb ^ (((sb >> 9) & 1) << 5); R = (st >> 1) * 16 + swz / 64; C = (st & 1) * 32 + (swz % 64) / 2; }
__host__ __device__ __forceinline__ int perm32(int rho) { const int n = rho >> 4, i = rho & 15; return 8 * (i >> 2) + 4 * n + (i & 3); }

struct Unit { int pm, pn; };
struct Gemm { const char* A; const char* Bt; int Kb; int nMe; size_t b_estride; const unsigned* rowsrc; };

struct StaticOrder {
    int nM, nN, nwg, G, c;
    __device__ void init(int nM_, int nN_, int G_, int c_) { nM = nM_; nN = nN_; nwg = nM * nN; G = G_; c = c_; }
    __device__ bool next(int i, Unit& u) const {
        const long L = (long)i * G + c; if (L >= nwg) return false;
        int wgid = (int)L; { const int q = nwg / NXCD, r = nwg % NXCD, xcd = wgid % NXCD, off = wgid / NXCD; wgid = (xcd < r ? xcd * (q + 1) : r * (q + 1) + (xcd - r) * q) + off; }
        const int nig = WGM * nN, gid = wgid / nig, fm = gid * WGM, gsz = (nM - fm) < WGM ? (nM - fm) : WGM;
        u.pm = fm + ((wgid % nig) % gsz); u.pn = (wgid % nig) / gsz; return true;
    }
};

template <class Epi, bool GATHER, bool ALIGN_EPI, bool FP8 = false, bool ABLK = false>
__device__ __forceinline__ void gemm_phase(LAS unsigned char* lds, const Gemm g, const StaticOrder& S, const Epi& E) {
    int tid = threadIdx.x; asm volatile("" : "+v"(tid));
    const int wid = __builtin_amdgcn_readfirstlane(tid >> 6), lane = tid & 63, wr = wid >> 2, wc = wid & 3, fr = lane & 15, fq = lane >> 4;
    const int Kb = g.Kb, nt = Kb / (BK * 2);
    int Rr[2], Cc[2]; unsigned voffB[2];
#pragma unroll
    for (int i = 0; i < 2; ++i) { int R, C; stage_rc(tid * 16 + i * 8192, R, C); const int Rb = Epi::PERM ? ((R & ~31) + perm32(R & 31)) : R;
        Rr[i] = R; Cc[i] = C; voffB[i] = (unsigned)(Rb * Kb + C * 2); }
    const size_t kstep = (size_t)(BK * 2);
    const size_t kstepA = ABLK ? (size_t)32768 : kstep;
    const size_t hstep = (size_t)HALF * Kb;
    const size_t tstep = 2 * hstep;
    const unsigned ldsw = (unsigned)wid * 1024u;
    const int aoff = lds_byte(wr * 64 + fr, fq * 8), boff = lds_byte(wc * 32 + fr, fq * 8);
#define PG8_SA(b, h) (((b) * 2 + (h)) * HTB)
#define PG8_SB(b, h) ((4 + (b) * 2 + (h)) * HTB)
#define PG8_STAGE(bufoff, gbase, voff) do { _Pragma("unroll") for (int _i = 0; _i < 2; ++_i) \
        __builtin_amdgcn_global_load_lds((const unsigned*)((const char*)(gbase) + (voff)[_i]), (LAS unsigned*)(lds + (bufoff) + ldsw + _i * 8192), 16, 0, 0); } while (0)
#define PG8_LDA(dst, b, h) do { _Pragma("unroll") for (int m = 0; m < 4; ++m) _Pragma("unroll") for (int k = 0; k < 2; ++k) dst[m][k] = *(const LAS bf16x8*)(lds + PG8_SA(b, h) + aoff + m * 2048 + k * 1024); } while (0)
#define PG8_LDB(dst, b, h) do { _Pragma("unroll") for (int n = 0; n < 2; ++n) _Pragma("unroll") for (int k = 0; k < 2; ++k) dst[n][k] = *(const LAS bf16x8*)(lds + PG8_SB(b, h) + boff + n * 2048 + k * 1024); } while (0)
#define PG8_MMA(ai, bj, At, Bt, Z) do { __builtin_amdgcn_s_setprio(1); \
        if constexpr (FP8) { if (Epi::ZEROC && (Z)) { _Pragma("unroll") for (int m = 0; m < 4; ++m) _Pragma("unroll") for (int n = 0; n < 2; ++n) { \
            const v8i b8_ = __builtin_shufflevector(__builtin_bit_cast(v4i, Bt[n][0]), __builtin_bit_cast(v4i, Bt[n][1]), 0, 1, 2, 3, 4, 5, 6, 7); \
            const v8i a8_ = __builtin_shufflevector(__builtin_bit_cast(v4i, At[m][0]), __builtin_bit_cast(v4i, At[m][1]), 0, 1, 2, 3, 4, 5, 6, 7); \
            asm volatile("v_mfma_f32_16x16x128_f8f6f4 %0, %1, %2, 0" : "+v"(acc[ai][bj][m][n]) : "v"(b8_), "v"(a8_)); } }   \
          else { _Pragma("unroll") for (int m = 0; m < 4; ++m) _Pragma("unroll") for (int n = 0; n < 2; ++n) { \
            const v8i b8_ = __builtin_shufflevector(__builtin_bit_cast(v4i, Bt[n][0]), __builtin_bit_cast(v4i, Bt[n][1]), 0, 1, 2, 3, 4, 5, 6, 7); \
            const v8i a8_ = __builtin_shufflevector(__builtin_bit_cast(v4i, At[m][0]), __builtin_bit_cast(v4i, At[m][1]), 0, 1, 2, 3, 4, 5, 6, 7); \
            asm volatile("v_mfma_f32_16x16x128_f8f6f4 %0, %1, %2, %0" : "+v"(acc[ai][bj][m][n]) : "v"(b8_), "v"(a8_)); } } } \
        else { _Pragma("unroll") for (int m = 0; m < 4; ++m) _Pragma("unroll") for (int n = 0; n < 2; ++n) _Pragma("unroll") for (int k = 0; k < 2; ++k) \
            acc[ai][bj][m][n] = __builtin_amdgcn_mfma_f32_16x16x32_bf16(Bt[n][k], At[m][k], acc[ai][bj][m][n], 0, 0, 0); } \
        __builtin_amdgcn_s_setprio(0); } while (0)
#define PG8_WAIT_V(n) asm volatile("s_waitcnt vmcnt(" #n ")" ::: "memory")
#define PG8_WAIT_L(n) asm volatile("s_waitcnt lgkmcnt(" #n ")" ::: "memory")
#define PG8_BAR __builtin_amdgcn_s_barrier()
#define PG8_SCHED __builtin_amdgcn_sched_barrier(0)
#define PG8_CALC_VG(VG, U) do { _Pragma("unroll") for (int _h = 0; _h < 2; ++_h) _Pragma("unroll") for (int _i = 0; _i < 2; ++_i) { \
        const unsigned _row = (unsigned)((U).pm * BM + _h * HALF + Rr[_i]); const unsigned _src = GATHER ? g.rowsrc[_row] : _row; \
        if constexpr (ABLK) { const unsigned _r = (unsigned)(_h * HALF + Rr[_i]), _c = (unsigned)Cc[_i] >> 3; \
            VG[_h][_i] = (unsigned)(U).pm * (unsigned)(Kb * BM) + (_r >> 4) * 2048u + (_c >> 1) * 512u + (_r & 15u) * 32u + (_c & 1u) * 16u; } \
        else VG[_h][_i] = _src * (unsigned)Kb + (unsigned)Cc[_i] * 2u; } } while (0)
    Unit cur, nxt; int ui = 0;
    if (!S.next(0, cur)) return;
    f32x4 acc[2][2][4][2];
    if constexpr (!(FP8 && Epi::ZEROC)) {
#pragma unroll
    for (int a = 0; a < 2; ++a)
#pragma unroll
        for (int b = 0; b < 2; ++b)
#pragma unroll
            for (int m = 0; m < 4; ++m)
#pragma unroll
                for (int n = 0; n < 2; ++n) acc[a][b][m][n] = (f32x4){0.f, 0.f, 0.f, 0.f};
    }
    bf16x8 At[4][2], B0[2][2], B1[2][2];
    unsigned vg[2][2], vgn[2][2];
    PG8_CALC_VG(vg, cur);
    const char* const gA = g.A;
    const char* cB = g.Bt + (size_t)(cur.pm / g.nMe) * g.b_estride + (size_t)cur.pn * tstep;
    PG8_STAGE(PG8_SB(0, 0), cB, voffB); PG8_STAGE(PG8_SB(0, 1), cB + hstep, voffB); PG8_STAGE(PG8_SA(0, 0), gA, vg[0]); PG8_STAGE(PG8_SA(0, 1), gA, vg[1]);
    if (wr == 1) PG8_BAR;
    PG8_WAIT_V(2); PG8_BAR;
    PG8_STAGE(PG8_SB(1, 0), cB + kstep, voffB); PG8_STAGE(PG8_SA(1, 0), gA + kstepA, vg[0]); PG8_STAGE(PG8_SB(1, 1), cB + hstep + kstep, voffB);
    PG8_WAIT_V(6); PG8_BAR;
    for (;;) {
        const bool has_next = S.next(ui + 1, nxt);
        LAS unsigned char* const rsb = lds + 131072 + ((ui + 1) & 1) * 1024;
        if (has_next) {
            if constexpr (GATHER) { if (wid == 0) __builtin_amdgcn_global_load_lds((const unsigned*)(g.rowsrc + (size_t)nxt.pm * BM) + lane * 4, (LAS unsigned*)rsb, 16, 0, 0); }
            else { PG8_CALC_VG(vgn, nxt); } }
        else {
#pragma unroll
            for (int _h = 0; _h < 2; ++_h)
#pragma unroll
                for (int _i = 0; _i < 2; ++_i) vgn[_h][_i] = vg[_h][_i]; }
        const char* nB = has_next ? g.Bt + (size_t)(nxt.pm / g.nMe) * g.b_estride + (size_t)nxt.pn * tstep : cB;
        for (int t = 0; t < nt; t += 2) {
            const bool last = (t == nt - 2);
            const char* a1 = gA + (size_t)(t + 1) * kstepA;
            const char* a2 = last ? gA : gA + (size_t)(t + 2) * kstepA; const char* b2 = last ? nB : cB + (size_t)(t + 2) * kstep;
            const char* a3 = a2 + kstepA; const char* b3 = b2 + kstep;
            if constexpr (GATHER) { if (last && has_next) {
#pragma unroll
                for (int _h = 0; _h < 2; ++_h)
#pragma unroll
                    for (int _i = 0; _i < 2; ++_i) vgn[_h][_i] = *(const LAS unsigned*)(rsb + (_h * HALF + Rr[_i]) * 4) * (unsigned)Kb + (unsigned)Cc[_i] * 2u; } }
            unsigned w0[2], w1[2];
#pragma unroll
            for (int _i = 0; _i < 2; ++_i) { w0[_i] = last ? vgn[0][_i] : vg[0][_i]; w1[_i] = last ? vgn[1][_i] : vg[1][_i]; }
            PG8_LDB(B0, 0, 0); PG8_LDB(B1, 0, 1); PG8_SCHED; PG8_LDA(At, 0, 0); PG8_STAGE(PG8_SA(1, 1), a1, vg[1]);
            PG8_WAIT_V(8); PG8_WAIT_L(0); PG8_BAR; PG8_MMA(0, 0, At, B0, t == 0); PG8_MMA(0, 1, At, B1, t == 0); PG8_BAR; PG8_SCHED;
            PG8_LDA(At, 0, 1); PG8_STAGE(PG8_SB(0, 0), b2, voffB); PG8_STAGE(PG8_SB(0, 1), b2 + hstep, voffB); PG8_STAGE(PG8_SA(0, 0), a2, w0);
            PG8_WAIT_V(8); PG8_WAIT_L(0); PG8_BAR; PG8_MMA(1, 0, At, B0, t == 0); PG8_MMA(1, 1, At, B1, t == 0); PG8_BAR; PG8_SCHED;
            PG8_LDB(B0, 1, 0); PG8_LDB(B1, 1, 1); PG8_SCHED; PG8_LDA(At, 1, 0); PG8_STAGE(PG8_SA(0, 1), a2, w1);
            PG8_WAIT_V(8); PG8_WAIT_L(0); PG8_BAR; PG8_MMA(0, 0, At, B0, false); PG8_MMA(0, 1, At, B1, false); PG8_BAR; PG8_SCHED;
            PG8_LDA(At, 1, 1); PG8_STAGE(PG8_SB(1, 0), b3, voffB); PG8_STAGE(PG8_SB(1, 1), b3 + hstep, voffB); PG8_STAGE(PG8_SA(1, 0), a3, w0);
            PG8_WAIT_V(8); PG8_WAIT_L(0); PG8_BAR; PG8_MMA(1, 0, At, B0, false); PG8_MMA(1, 1, At, B1, false); PG8_BAR; PG8_SCHED;
        }
        if constexpr (ALIGN_EPI) { if (wr == 0) PG8_BAR; }
        if constexpr (FP8) asm volatile("s_nop 15\n\ts_nop 15" ::: "memory");
        E(acc, cur, wr, wc, fr, fq);
        if (!has_next) break;
        if constexpr (!(FP8 && Epi::ZEROC)) {
#pragma unroll
        for (int a = 0; a < 2; ++a)
#pragma unroll
            for (int b = 0; b < 2; ++b)
#pragma unroll
                for (int m = 0; m < 4; ++m)
#pragma unroll
                    for (int n = 0; n < 2; ++n) acc[a][b][m][n] = (f32x4){0.f, 0.f, 0.f, 0.f};
        }
        cur = nxt; cB = nB; ++ui;
#pragma unroll
        for (int _h = 0; _h < 2; ++_h)
#pragma unroll
            for (int _i = 0; _i < 2; ++_i) vg[_h][_i] = vgn[_h][_i];
        if constexpr (ALIGN_EPI) { if (wr == 1) PG8_BAR; }
    }
    PG8_WAIT_V(0);
    if constexpr (!ALIGN_EPI) { if (wr == 0) PG8_BAR; }
    PG8_BAR;
#undef PG8_SA
#undef PG8_SB
#undef PG8_STAGE
#undef PG8_LDA
#undef PG8_LDB
#undef PG8_MMA
#undef PG8_WAIT_V
#undef PG8_WAIT_L
#undef PG8_BAR
#undef PG8_SCHED
#undef PG8_CALC_VG
}

struct EpiInProj {
    static constexpr bool PERM = false; static constexpr bool ZEROC = false;
    bf16_t* O; int ldc; int q_tiles; int rope_tiles; const float* tab; float osc; int v_tile0; bf16_t* Q;
    __device__ __forceinline__ void operator()(const f32x4 (&acc)[2][2][4][2], const Unit& u, int wr, int wc, int fr, int fq) const {
        const int row0 = u.pm * BM + wr * 64 + fr, col0 = u.pn * BM + wc * 32 + 4 * fq;
        const float sc = ((u.pn < q_tiles) ? C2 : 1.f) * osc;
        const bool rope = (u.pn < rope_tiles) && (u.pm < MX / BM);
        const int axis = wc & 1; const bool isv = u.pn >= v_tile0;
#pragma unroll
        for (int ai = 0; ai < 2; ++ai)
#pragma unroll
            for (int m = 0; m < 4; ++m) {
                const int row = row0 + ai * HALF + m * 16;
                f32x4 cs = {1.f, 1.f, 1.f, 1.f}, sn = {0.f, 0.f, 0.f, 0.f};
                if (rope) { const int t = row & (SEQ - 1); const int pos = axis ? (t & 63) : (t >> 6); cs = *(const f32x4*)(tab + TAB_COS + pos * 16 + 4 * fq); sn = *(const f32x4*)(tab + TAB_SIN + pos * 16 + 4 * fq); }
                bf16_t* rowp = O + (size_t)row * ldc + col0;
                bf16_t* rowq = (u.pn < q_tiles) ? Q + ((size_t)(row >> 5) * 16 + 4 * u.pn + (wc >> 1)) * 2048 + (2 * (wc & 1) + (fq >> 1)) * 512 + (fq & 1) * 256 + (row & 31) * 8
                                                : O + (size_t)row * ldc + u.pn * BM + wc * 32 + 8 * fq;
                const int qstep = (u.pn < q_tiles) ? 2 * 2048 : HALF;
#pragma unroll
                for (int bj = 0; bj < 2; ++bj) {
                    const f32x4 x1 = acc[ai][bj][m][0] * sc, x2 = acc[ai][bj][m][1] * sc;
                    const f32x4 o1 = x1 * cs - x2 * sn, o2 = x2 * cs + x1 * sn;
                    u32x2 w1, w2; w1.x = cvtpk(o1[0], o1[1]); w1.y = cvtpk(o1[2], o1[3]); w2.x = cvtpk(o2[0], o2[1]); w2.y = cvtpk(o2[2], o2[3]);
                    if (isv) { *(u32x2*)(rowp + bj * HALF) = w1; *(u32x2*)(rowp + bj * HALF + 16) = w2; }
                    else *(u32x4*)(rowq + bj * qstep) = (u32x4){w1.x, w1.y, w2.x, w2.y}; }
            }
    }
};
struct EpiOutProj {
    static constexpr bool PERM = true; static constexpr bool ZEROC = false;
    bf16_t* P; const float* mod; float osc;
    __device__ __forceinline__ void operator()(const f32x4 (&acc)[2][2][4][2], const Unit& u, int wr, int wc, int fr, int fq) const {
        const int b = (u.pm < MX / BM) ? ((u.pm * BM) >> 12) : 16;
        const int row0 = u.pm * BM + wr * 64 + fr, col0 = u.pn * BM + wc * 32 + 8 * fq;
        const float* gp = mod + (size_t)b * 6144 + 2 * DM + col0;
        f32x4 gv[2][2];
#pragma unroll
        for (int bj = 0; bj < 2; ++bj)
#pragma unroll
            for (int n = 0; n < 2; ++n) gv[bj][n] = *(const f32x4*)(gp + bj * HALF + 4 * n) * osc;
#pragma unroll
        for (int ai = 0; ai < 2; ++ai)
#pragma unroll
            for (int m = 0; m < 4; ++m) { bf16_t* rowp = P + (size_t)(row0 + ai * HALF + m * 16) * DM + col0;
                u32x4 xr[2]; xr[0] = *(const u32x4*)rowp; xr[1] = *(const u32x4*)(rowp + HALF);
#pragma unroll
                for (int bj = 0; bj < 2; ++bj) { const f32x4 v0 = acc[ai][bj][m][0] * gv[bj][0], v1 = acc[ai][bj][m][1] * gv[bj][1]; const u32x4 x = xr[bj];
                    u32x4 w; w.x = cvtpk(v0[0] + __builtin_bit_cast(float, x.x << 16), v0[1] + __builtin_bit_cast(float, x.x & 0xffff0000u));
                    w.y = cvtpk(v0[2] + __builtin_bit_cast(float, x.y << 16), v0[3] + __builtin_bit_cast(float, x.y & 0xffff0000u));
                    w.z = cvtpk(v1[0] + __builtin_bit_cast(float, x.z << 16), v1[1] + __builtin_bit_cast(float, x.z & 0xffff0000u));
                    w.w = cvtpk(v1[2] + __builtin_bit_cast(float, x.w << 16), v1[3] + __builtin_bit_cast(float, x.w & 0xffff0000u));
                    *(u32x4*)(rowp + bj * HALF) = w; } }
    }
};
template <bool NOSTORE = false> struct EpiSwiglu {
    static constexpr bool PERM = true; static constexpr bool ZEROC = true;
    unsigned char* O; float in_scale; float out_scale;
    __device__ __forceinline__ void operator()(const f32x4 (&acc)[2][2][4][2], const Unit& u, int wr, int wc, int fr, int fq) const {
        const int row0 = u.pm * BM + wr * 64 + fr, col0 = u.pn * HALF + wc * 32 + 8 * fq;
#pragma unroll
        for (int ai = 0; ai < 2; ++ai)
#pragma unroll
            for (int m = 0; m < 4; ++m) { unsigned char* rowp = O + ((size_t)u.pm * 16 + u.pn) * 32768 + (8 * ai + 4 * wr + m) * 2048 + wc * 512 + fr * 32 + fq * 8;
                float h[8];
                const float c1 = -LOG2E * in_scale, c2i = 1.f / (in_scale * in_scale * out_scale);
#pragma unroll
                for (int n = 0; n < 2; ++n)
#pragma unroll
                    for (int j = 0; j < 4; j += 2) { const f32x2 ag = {acc[ai][0][m][n][j], acc[ai][0][m][n][j + 1]}, au = {acc[ai][1][m][n][j], acc[ai][1][m][n][j + 1]};
                        const f32x2 ea = ag * c1; f32x2 t; t.x = __builtin_amdgcn_exp2f(ea.x); t.y = __builtin_amdgcn_exp2f(ea.y);
                        const f32x2 d = __builtin_elementwise_fma(t, (f32x2){c2i, c2i}, (f32x2){c2i, c2i}); f32x2 r; r.x = __builtin_amdgcn_rcpf(d.x); r.y = __builtin_amdgcn_rcpf(d.y);
                        const f32x2 hv = (ag * au) * r; h[n * 4 + j] = hv.x; h[n * 4 + j + 1] = hv.y; }
                int w0 = 0, w1 = 0;
                w0 = __builtin_amdgcn_cvt_pk_fp8_f32(h[0], h[1], w0, false); w0 = __builtin_amdgcn_cvt_pk_fp8_f32(h[2], h[3], w0, true);
                w1 = __builtin_amdgcn_cvt_pk_fp8_f32(h[4], h[5], w1, false); w1 = __builtin_amdgcn_cvt_pk_fp8_f32(h[6], h[7], w1, true);
                if (NOSTORE) asm volatile("" :: "v"(w0), "v"(w1)); else *(u32x2*)rowp = (u32x2){(unsigned)w0, (unsigned)w1}; }
    }
};
struct EpiBf16 {
    static constexpr bool PERM = true; static constexpr bool ZEROC = true;
    bf16_t* O; int ldc; float sc;
    __device__ __forceinline__ void operator()(const f32x4 (&acc)[2][2][4][2], const Unit& u, int wr, int wc, int fr, int fq) const {
        const int row0 = u.pm * BM + wr * 64 + fr, col0 = u.pn * BM + wc * 32 + 8 * fq;
#pragma unroll
        for (int ai = 0; ai < 2; ++ai)
#pragma unroll
            for (int m = 0; m < 4; ++m) { bf16_t* rowp = O + (size_t)(row0 + ai * HALF + m * 16) * ldc + col0;
#pragma unroll
                for (int bj = 0; bj < 2; ++bj) { const f32x4 v0 = acc[ai][bj][m][0] * sc, v1 = acc[ai][bj][m][1] * sc;
                    u32x4 w; w.x = cvtpk(v0[0], v0[1]); w.y = cvtpk(v0[2], v0[3]); w.z = cvtpk(v1[0], v1[1]); w.w = cvtpk(v1[2], v1[3]);
                    *(u32x4*)(rowp + bj * HALF) = w; } }
    }
};
}

namespace att {
#define SBAR() __builtin_amdgcn_sched_barrier(0)
__device__ __forceinline__ int crow(int r, int hi) { return (r & 3) + 8 * (r >> 2) + 4 * hi; }
__device__ __forceinline__ void glds16(const void* gsrc, unsigned lds_dst) { unsigned keep;
    asm volatile("s_mov_b32 %0, m0\n\ts_mov_b32 m0, %2\n\ts_nop 0\n\tglobal_load_lds_dwordx4 %1, off\n\ts_mov_b32 m0, %0" : "=&s"(keep) : "v"(gsrc), "s"(lds_dst) : "memory"); }
#define WAIT_BAR0() asm volatile("s_waitcnt vmcnt(0) lgkmcnt(0)\n\ts_barrier" ::: "memory")
typedef LAS const char* lds_cptr;
typedef short v4i16_t __attribute__((ext_vector_type(4)));
__device__ __forceinline__ s16x4 vtr(lds_cptr p) { return __builtin_bit_cast(s16x4, __builtin_amdgcn_ds_read_tr16_b64_v4i16((LAS v4i16_t*)p)); }
__device__ __forceinline__ float hmax(float m) { auto rr = __builtin_amdgcn_permlane32_swap(__float_as_uint(m), __float_as_uint(m), false, false); return fmaxf(__uint_as_float(rr[0]), __uint_as_float(rr[1])); }
__device__ __forceinline__ float hsum(float m) { auto rr = __builtin_amdgcn_permlane32_swap(__float_as_uint(m), __float_as_uint(m), false, false); return __uint_as_float(rr[0]) + __uint_as_float(rr[1]); }

__device__ __forceinline__ void qkt(f32x16& p0, f32x16& p1, lds_cptr kb, const bf16x8 (&qr)[4]) {
    p0 = f32x16{}; p1 = f32x16{};
#pragma unroll
    for (int d0 = 0; d0 < 4; ++d0) {
        const bf16x8 b0 = *(const LAS bf16x8*)(kb + d0 * 2048), b1 = *(const LAS bf16x8*)(kb + d0 * 2048 + 512);
        p0 = __builtin_amdgcn_mfma_f32_32x32x16_bf16(b0, qr[d0], p0, 0, 0, 0);
        p1 = __builtin_amdgcn_mfma_f32_32x32x16_bf16(b1, qr[d0], p1, 0, 0, 0); }
}
template <int ND>
__device__ __forceinline__ void softmax_pv(f32x16& p0, f32x16& p1, f32x16 (&oT)[ND], float& m, float& l, lds_cptr vp) {
    float rm = p0[0];
#pragma unroll
    for (int r = 1; r < 16; ++r) rm = fmaxf(rm, p0[r]);
#pragma unroll
    for (int r = 0; r < 16; ++r) rm = fmaxf(rm, p1[r]);
    rm = hmax(rm);
    const float mn = fmaxf(m, rm);
    const float alpha = __builtin_amdgcn_exp2f(m - mn);
    m = mn;
    float s = 0.f;
#pragma unroll
    for (int r = 0; r < 16; ++r) { p0[r] = __builtin_amdgcn_exp2f(p0[r] - mn); p1[r] = __builtin_amdgcn_exp2f(p1[r] - mn); s += p0[r] + p1[r]; }
    l = l * alpha + s;
#pragma unroll
    for (int d = 0; d < ND; ++d) oT[d] = oT[d] * alpha;
    u32x4 pw[4];
#pragma unroll
    for (int k = 0; k < 2; ++k) {
        pw[k]     = (u32x4){cvtpk(p0[8 * k], p0[8 * k + 1]), cvtpk(p0[8 * k + 2], p0[8 * k + 3]), cvtpk(p0[8 * k + 4], p0[8 * k + 5]), cvtpk(p0[8 * k + 6], p0[8 * k + 7])};
        pw[2 + k] = (u32x4){cvtpk(p1[8 * k], p1[8 * k + 1]), cvtpk(p1[8 * k + 2], p1[8 * k + 3]), cvtpk(p1[8 * k + 4], p1[8 * k + 5]), cvtpk(p1[8 * k + 6], p1[8 * k + 7])}; }
#pragma unroll
    for (int d = 0; d < ND; ++d)
#pragma unroll
        for (int ks = 0; ks < 4; ++ks) {
            const s16x4 lo = vtr(vp + d * 4096 + ks * 1024), hi = vtr(vp + d * 4096 + ks * 1024 + 512);
            const bf16x8 vf = (bf16x8){lo[0], lo[1], lo[2], lo[3], hi[0], hi[1], hi[2], hi[3]};
            oT[d] = __builtin_amdgcn_mfma_f32_32x32x16_bf16(vf, __builtin_bit_cast(bf16x8, pw[ks]), oT[d], 0, 0, 0); }
}
template <int ND>
__device__ __forceinline__ void stg_flush(const LAS unsigned char* stg, bf16_t* ybase, int lane) {
    constexpr int RB = ND * 64 + 16, CPR = ND * 4;
#pragma unroll
    for (int i = 0; i < 32 * CPR / 64; ++i) { const int idx = i * 64 + lane, row = idx / CPR, ch = idx % CPR;
        const u32x4 v = *(const LAS u32x4*)(stg + row * RB + ch * 16); *(u32x4*)(ybase + (size_t)row * DM + ch * 8) = v; }
}
template <int ND>
__device__ __forceinline__ void store_oT(const f32x16 (&oT)[ND], float scale, bf16_t* ybase, size_t elem_off, int hi) {
    if (OUTPROJ_FP8) { unsigned char* orow = (unsigned char*)ybase + elem_off; const float sc8 = scale * Y_SCALE;
#pragma unroll
        for (int d = 0; d < ND; ++d)
#pragma unroll
            for (int g = 0; g < 4; ++g) { int t = 0; t = __builtin_amdgcn_cvt_pk_fp8_f32(oT[d][4 * g] * sc8, oT[d][4 * g + 1] * sc8, t, false); t = __builtin_amdgcn_cvt_pk_fp8_f32(oT[d][4 * g + 2] * sc8, oT[d][4 * g + 3] * sc8, t, true);
                *(unsigned*)(orow + d * 32 + 8 * g + 4 * hi) = (unsigned)t; } }
    else { bf16_t* orow = ybase + elem_off;
#pragma unroll
        for (int d = 0; d < ND; ++d)
#pragma unroll
            for (int g = 0; g < 4; ++g) { u32x2 w; w.x = cvtpk(oT[d][4 * g] * scale, oT[d][4 * g + 1] * scale); w.y = cvtpk(oT[d][4 * g + 2] * scale, oT[d][4 * g + 3] * scale);
                *(u32x2*)(orow + d * 32 + 8 * g + 4 * hi) = w; } }
}
constexpr int NA_BIAS_OFF = 65536;
struct DiffArgs { const bf16_t* qkv; bf16_t* y; const float* subln_g; float lam; float omli; int with_ctx; const bf16_t* q; };

#define DF_THR 8.0f
#define DF_BAR()   asm volatile("s_waitcnt lgkmcnt(0)\n\ts_barrier" ::: "memory")
#define DF_BARV()  asm volatile("s_waitcnt vmcnt(0) lgkmcnt(0)\n\ts_barrier" ::: "memory")
__device__ __forceinline__ void diff_phase2(LAS unsigned char* lds, const DiffArgs A, int vcu, int G) {
    int tid = threadIdx.x; asm volatile("" : "+v"(tid));
    const int lane = tid & 63, r32 = lane & 31, hi = lane >> 5; const int wid = __builtin_amdgcn_readfirstlane(tid >> 6);
    constexpr int P = 3072;
    const unsigned lds0 = (unsigned)(uintptr_t)lds;
    const lds_cptr l3 = (lds_cptr)lds;
    const int mp = wid >> 2, qsub = wid & 3;
    LAS float* xch = (LAS float*)lds + qsub * 4096 + lane;
    const int nmain = NB * 8 * 32, nunits = nmain + (A.with_ctx ? NB * 8 * 2 : 0);
    for (int u = vcu; u < nunits; u += G) {
        int b, h, qrow0, NT; const bool ctxu = u >= nmain;
        if (!ctxu) { const int qb = u & 31; h = (u >> 5) & 7; b = u >> 8; qrow0 = b * SEQ + 128 * qb + 32 * qsub; NT = 4 + 64; }
        else { const int v = u - nmain; const int qb = v & 1; h = (v >> 1) & 7; b = v >> 4; qrow0 = MX + b * CTXL + 128 * qb + 32 * qsub; NT = 4; }
        const bf16_t* Kc = A.qkv + (size_t)(MX + b * CTXL) * P + 1024 + 128 * h;
        const bf16_t* Kx = A.qkv + (size_t)(b * SEQ) * P + 1024 + 128 * h;
        const int krow = 8 * wid + (lane >> 3); const size_t koff = (size_t)krow * P + (((lane & 7) ^ ((krow >> 1) & 7)) * 8);
        const int pv0 = 2 * wid, pv1 = 2 * wid + 1;
        const int vra = 4 * pv0 + (lane >> 4), vrb = 4 * pv1 + (lane >> 4); const int vph = lane & 15;
        const size_t voffa = (size_t)vra * P + 1024 + ((((vph >> 2) ^ (vra & 3)) << 2) | (vph & 3)) * 8;
        const size_t voffb = (size_t)vrb * P + 1024 + ((((vph >> 2) ^ (vrb & 3)) << 2) | (vph & 3)) * 8;
#define DF_DMA(t) do { if ((t) < NT) { const int slot_ = (t) % 3; const bf16_t* base_ = ((t) < 4) ? Kc + (size_t)(t) * 64 * P : Kx + (size_t)((t) - 4) * 64 * P; \
        glds16(base_ + koff,      (unsigned)__builtin_amdgcn_readfirstlane(lds0 + slot_ * 32768 + wid * 1024)); \
        glds16(base_ + koff + 64, (unsigned)__builtin_amdgcn_readfirstlane(lds0 + slot_ * 32768 + 8192 + wid * 1024)); \
        glds16(base_ + voffa,     (unsigned)__builtin_amdgcn_readfirstlane(lds0 + slot_ * 32768 + 16384 + pv0 * 1024)); \
        glds16(base_ + voffb,     (unsigned)__builtin_amdgcn_readfirstlane(lds0 + slot_ * 32768 + 16384 + pv1 * 1024)); } } while (0)
        DF_DMA(0);
        bf16x8 qr[4];
        { const bf16_t* Qw = A.qkv + (size_t)(qrow0 + r32) * P + h * 128 + mp * 64;
#pragma unroll
          for (int d0 = 0; d0 < 4; ++d0) qr[d0] = *(const bf16x8*)(Qw + d0 * 16 + hi * 8); }
        f32x16 oT[4]; oT[0] = f32x16{}; oT[1] = f32x16{}; oT[2] = f32x16{}; oT[3] = f32x16{};
        float m = 0.f, l = 0.f;
        f32x16 p0, p1; u32x4 pw[4];
        const int ksw = (r32 >> 1) & 7; const lds_cptr kp0 = l3 + mp * 8192 + r32 * 128 + ((hi ^ (ksw & 1)) << 4); const int ks2 = ksw >> 1;
        const int vq = (lane & 15) >> 2; const lds_cptr vp0 = l3 + 16384 + (4 * hi + vq) * 256 + ((lane >> 4) & 1) * 32 + (lane & 3) * 8;
#define DF_LOADV(dst, vp_, d) do { const lds_cptr vd_ = (vp_) + (((d) ^ vq) << 6); _Pragma("unroll") for (int ks = 0; ks < 4; ++ks) { const s16x4 lo_ = vtr(vd_ + ks * 4096), hi_ = vtr(vd_ + ks * 4096 + 2048); \
            dst[ks] = (bf16x8){lo_[0], lo_[1], lo_[2], lo_[3], hi_[0], hi_[1], hi_[2], hi_[3]}; } } while (0)
#define DF_PV4(src, d) do { _Pragma("unroll") for (int ks = 0; ks < 4; ++ks) oT[d] = __builtin_amdgcn_mfma_f32_32x32x16_bf16(src[ks], __builtin_bit_cast(bf16x8, pw[ks]), oT[d], 0, 0, 0); } while (0)
#define DF_LOADK(dst, kb_, dd) do { dst[0] = *(const LAS bf16x8*)((kb_) + ((((dd)) ^ ks2) << 5)); dst[1] = *(const LAS bf16x8*)((kb_) + ((((dd)) ^ ks2) << 5) + 4096); \
            dst[2] = *(const LAS bf16x8*)((kb_) + ((((dd) + 1) ^ ks2) << 5)); dst[3] = *(const LAS bf16x8*)((kb_) + ((((dd) + 1) ^ ks2) << 5) + 4096); } while (0)
#define DF_QK4(src, dd) do { p0 = __builtin_amdgcn_mfma_f32_32x32x16_bf16(src[0], qr[dd], p0, 0, 0, 0); p1 = __builtin_amdgcn_mfma_f32_32x32x16_bf16(src[1], qr[dd], p1, 0, 0, 0); \
            p0 = __builtin_amdgcn_mfma_f32_32x32x16_bf16(src[2], qr[(dd) + 1], p0, 0, 0, 0); p1 = __builtin_amdgcn_mfma_f32_32x32x16_bf16(src[3], qr[(dd) + 1], p1, 0, 0, 0); } while (0)
#define DF_PREV(vso) do { const lds_cptr vq_ = vp0 + (vso); DF_LOADV(fa, vq_, 0); DF_LOADV(fb, vq_, 1); SBAR(); } while (0)
#define DF_PINIT() do { _Pragma("unroll") for (int r = 0; r < 16; ++r) { p0[r] = -m; p1[r] = -m; } } while (0)
#define DF_SEGM(DO_PV, DO_QK, vso, kso) do { const lds_cptr vp_ = vp0 + (vso); const lds_cptr kb_ = kp0 + (kso); SBAR(); __builtin_amdgcn_s_setprio(1); \
        if (DO_PV) { DF_PV4(fa, 0); SBAR(); DF_LOADV(fa, vp_, 2); SBAR(); \
            DF_PV4(fb, 1); SBAR(); DF_LOADV(fb, vp_, 3); if (DO_QK) { DF_PINIT(); } SBAR(); \
            DF_PV4(fa, 2); SBAR(); if (DO_QK) { DF_LOADK(fa, kb_, 0); } SBAR(); \
            DF_PV4(fb, 3); SBAR(); if (DO_QK) { DF_LOADK(fb, kb_, 2); } SBAR(); } \
        else if (DO_QK) { DF_LOADK(fa, kb_, 0); DF_LOADK(fb, kb_, 2); DF_PINIT(); SBAR(); } \
        if (DO_QK) { DF_QK4(fa, 0); SBAR(); DF_QK4(fb, 2); SBAR(); } \
        __builtin_amdgcn_s_setprio(0); } while (0)
#define DF_SEGV(t) do { \
        float rm = p0[0]; \
        _Pragma("unroll") for (int r = 1; r < 16; ++r) rm = fmaxf(rm, p0[r]); \
        _Pragma("unroll") for (int r = 0; r < 16; ++r) rm = fmaxf(rm, p1[r]); \
        rm = hmax(rm); \
        if ((t) == 0 || __any(rm > DF_THR)) { const float dl = ((t) == 0) ? rm : fmaxf(rm, 0.f); m += dl; \
            _Pragma("unroll") for (int r = 0; r < 16; ++r) { p0[r] -= dl; p1[r] -= dl; } \
            const float f = __builtin_amdgcn_exp2f(-dl); l *= f; \
            _Pragma("unroll") for (int d = 0; d < 4; ++d) oT[d] = oT[d] * f; } \
        float s_ = 0.f; \
        _Pragma("unroll") for (int r = 0; r < 16; ++r) { p0[r] = __builtin_amdgcn_exp2f(p0[r]); p1[r] = __builtin_amdgcn_exp2f(p1[r]); s_ += p0[r] + p1[r]; } \
        l += s_; \
        _Pragma("unroll") for (int k = 0; k < 2; ++k) { \
            pw[k]     = (u32x4){cvtpk(p0[8 * k], p0[8 * k + 1]), cvtpk(p0[8 * k + 2], p0[8 * k + 3]), cvtpk(p0[8 * k + 4], p0[8 * k + 5]), cvtpk(p0[8 * k + 6], p0[8 * k + 7])}; \
            pw[2 + k] = (u32x4){cvtpk(p1[8 * k], p1[8 * k + 1]), cvtpk(p1[8 * k + 2], p1[8 * k + 3]), cvtpk(p1[8 * k + 4], p1[8 * k + 5]), cvtpk(p1[8 * k + 6], p1[8 * k + 7])}; } \
        } while (0)
        DF_BARV();
        int so_p = 0, so_c = 0;
#define DF_ROT() do { so_p = so_c; so_c = (so_c == 65536) ? 0 : so_c + 32768; } while (0)
        bf16x8 fa[4], fb[4];
        if (mp == 0) {
            DF_DMA(1); DF_SEGM(false, true, 0, so_c); SBAR(); DF_PREV(so_c); DF_SEGV(0); SBAR(); DF_BARV(); SBAR();
            for (int t = 1; t < NT; ++t) { DF_ROT();
                DF_DMA(t + 1); DF_SEGM(true, true, so_p, so_c); SBAR(); DF_PREV(so_c); DF_SEGV(t); SBAR(); DF_BARV(); SBAR(); }
            DF_ROT();
            DF_SEGM(true, false, so_p, 0); SBAR(); DF_BARV(); SBAR();
        } else {
            DF_DMA(1); DF_SEGM(false, true, 0, so_c); SBAR(); DF_BARV(); SBAR();
            for (int t = 1; t < NT; ++t) { DF_ROT();
                DF_DMA(t + 1); DF_PREV(so_p); DF_SEGV(t - 1); SBAR(); DF_SEGM(true, true, so_p, so_c); SBAR(); DF_BARV(); SBAR(); }
            DF_ROT();
            DF_PREV(so_p); DF_SEGV(NT - 1); SBAR(); DF_SEGM(true, false, so_p, 0); SBAR(); DF_BARV(); SBAR();
        }
#undef DF_ROT
        l = hsum(l);
        const float il = 1.f / l;
        if (mp == 1) { const float sc = il * A.lam;
#pragma unroll
            for (int d = 0; d < 4; ++d)
#pragma unroll
                for (int q = 0; q < 16; ++q) xch[(d * 16 + q) * 64] = oT[d][q] * sc; }
        DF_BARV();
        if (mp == 0) {
            float ss = 0.f;
#pragma unroll
            for (int d = 0; d < 4; ++d)
#pragma unroll
                for (int q = 0; q < 16; ++q) { const float v = oT[d][q] * il - xch[(d * 16 + q) * 64]; oT[d][q] = v; ss += v * v; }
            ss = hsum(ss);
            const float rstd = rsqrtf(ss * (1.f / 128.f) + RMS_EPS) * A.omli;
            const size_t eo = (size_t)(qrow0 + r32) * DM + h * 128;
#pragma unroll
            for (int d = 0; d < 4; ++d)
#pragma unroll
                for (int g = 0; g < 4; ++g) { const f32x4 gg = *(const f32x4*)(A.subln_g + d * 32 + 8 * g + 4 * hi);
                    if (OUTPROJ_FP8) { const float r8 = rstd * Y_SCALE; int t = 0; t = __builtin_amdgcn_cvt_pk_fp8_f32(oT[d][4 * g] * r8 * gg[0], oT[d][4 * g + 1] * r8 * gg[1], t, false);
                        t = __builtin_amdgcn_cvt_pk_fp8_f32(oT[d][4 * g + 2] * r8 * gg[2], oT[d][4 * g + 3] * r8 * gg[3], t, true);
                        *(unsigned*)((unsigned char*)A.y + eo + d * 32 + 8 * g + 4 * hi) = (unsigned)t; }
                    else { u32x2 w; w.x = cvtpk(oT[d][4 * g] * rstd * gg[0], oT[d][4 * g + 1] * rstd * gg[1]); w.y = cvtpk(oT[d][4 * g + 2] * rstd * gg[2], oT[d][4 * g + 3] * rstd * gg[3]);
                        *(u32x2*)(A.y + eo + d * 32 + 8 * g + 4 * hi) = w; } }
        }
        DF_BAR();
#undef DF_DMA
#undef DF_SEGM
#undef DF_SEGV
#undef DF_PINIT
#undef DF_PREV
#undef DF_LOADV
#undef DF_PV4
#undef DF_LOADK
#undef DF_QK4
    }
}

#define D3_PIN(x) asm volatile("" : "+v"(x))
#define D3_EX(v) __builtin_amdgcn_exp2f(v)
__device__ __forceinline__ void diff_phase3(LAS unsigned char* lds, const DiffArgs A, int vcu, int G) {
    int tid = threadIdx.x; asm volatile("" : "+v"(tid));
    const int lane = tid & 63, r32 = lane & 31, hi = lane >> 5; const int wid = __builtin_amdgcn_readfirstlane(tid >> 6);
    constexpr int P = 3072;
    const unsigned lds0 = (unsigned)(uintptr_t)lds;
    const lds_cptr l3 = (lds_cptr)lds;
    const int mp = wid >> 2, qsub = wid & 3;
    const int nmain = NB * 8 * 32, nunits = nmain + (A.with_ctx ? NB * 8 * 2 : 0);
    for (int u = vcu; u < nunits; u += G) {
        int b, h, qrow0, NT; const bool ctxu = u >= nmain;
        if (!ctxu) { const int qb = u & 31; h = (u >> 5) & 7; b = u >> 8; qrow0 = b * SEQ + 128 * qb + 32 * qsub; NT = 4 + 64; }
        else { const int v = u - nmain; const int qb = v & 1; h = (v >> 1) & 7; b = v >> 4; qrow0 = MX + b * CTXL + 128 * qb + 32 * qsub; NT = 4; }
        const bf16_t* Kc = A.qkv + (size_t)(MX + b * CTXL) * P + 1024 + 128 * h;
        const bf16_t* Kx = A.qkv + (size_t)(b * SEQ) * P + 1024 + 128 * h;
        const int kra = 16 * qsub + (lane >> 3), krb = kra + 8; const int vr0 = 16 * qsub + (lane >> 4); const int vph = lane & 15;
        const unsigned d0 = mp ? (unsigned)vr0 * P + 1024 + ((((vph >> 2) ^ (vr0 & 3)) << 2) | (vph & 3)) * 8 : (unsigned)kra * P + (((lane & 7) ^ ((kra >> 1) & 7)) * 8);
        const unsigned d1 = mp ? d0 + 4 * P : (unsigned)krb * P + (((lane & 7) ^ ((krb >> 1) & 7)) * 8);
        const unsigned inc2 = mp ? 8 * P : 64;
        const unsigned e0 = lds0 + (mp ? 32768 + qsub * 4096 : qsub * 2048), e2 = e0 + (mp ? 2048 : 8192);
#define D3_DMA(t) do { const int t_ = (t); if (t_ < NT) { const bf16_t* base_ = (t_ < 4) ? Kc + (size_t)t_ * 64 * P : Kx + (size_t)(t_ - 4) * 64 * P; \
        const unsigned so_ = (mp ? (t_ & 3) : (t_ & 1)) * 16384; \
        glds16(base_ + d0,        (unsigned)__builtin_amdgcn_readfirstlane(e0 + so_)); \
        glds16(base_ + d1,        (unsigned)__builtin_amdgcn_readfirstlane(e0 + so_ + 1024)); \
        glds16(base_ + d0 + inc2, (unsigned)__builtin_amdgcn_readfirstlane(e2 + so_)); \
        glds16(base_ + d1 + inc2, (unsigned)__builtin_amdgcn_readfirstlane(e2 + so_ + 1024)); } } while (0)
#define D3_WAITBAR(T) do { if (mp == 0 || (T) + 1 >= NT) DF_BARV(); else asm volatile("s_waitcnt vmcnt(4) lgkmcnt(0)\n\ts_barrier" ::: "memory"); } while (0)
        D3_DMA(0);
        bf16x8 qr[4];
        { const bf16_t* Qw = A.q + ((size_t)(qrow0 >> 5) * 16 + 2 * h + mp) * 2048 + hi * 256 + r32 * 8;
#pragma unroll
          for (int d0 = 0; d0 < 4; ++d0) qr[d0] = *(const bf16x8*)(Qw + d0 * 512); }
        f32x16 oT[4]; oT[0] = f32x16{}; oT[1] = f32x16{}; oT[2] = f32x16{}; oT[3] = f32x16{};
        f32x16 negm;
        float m = 0.f, l = 0.f, rf = 1.f; bool resc = false;
        f32x16 pA0, pA1, pB0, pB1; u32x4 pw0, pw1, pw2, pw3;
        const int ksw = (r32 >> 1) & 7; const lds_cptr kp0 = l3 + mp * 8192 + r32 * 128 + ((hi ^ (ksw & 1)) << 4); const int ks2 = ksw >> 1;
        const int vq = (lane & 15) >> 2; const lds_cptr vp0 = l3 + 32768 + (4 * hi + vq) * 256 + ((lane >> 4) & 1) * 32 + (lane & 3) * 8;
#define D3_KF(kb_, g) (*(const LAS bf16x8*)((kb_) + (((((g) >> 1)) ^ ks2) << 5) + ((g) & 1) * 4096))
#define D3_VF(vp_, g) ({ const lds_cptr vd_ = (vp_) + (((((g) >> 2)) ^ vq) << 6) + ((g) & 3) * 4096; const s16x4 lo_ = vtr(vd_), hi_ = vtr(vd_ + 2048); (bf16x8){lo_[0], lo_[1], lo_[2], lo_[3], hi_[0], hi_[1], hi_[2], hi_[3]}; })
#define D3_PK(P, B) cvtpk(P[B], P[(B) + 1])
#define D3_KSEL(g) (((g) & 1) ? kf1 : kf0)
#define D3_GA(g, C0, C1, Q0, Q1, HASQK, HASVA, FIRST) do { \
        if (HASQK) { \
            if ((g) == 0) { if (FIRST) C0 = __builtin_amdgcn_mfma_f32_32x32x16_bf16(D3_KSEL(g), qr[0], f32x16{}, 0, 0, 0); else C0 = __builtin_amdgcn_mfma_f32_32x32x16_bf16(D3_KSEL(g), qr[0], negm, 0, 0, 0); } \
            else if ((g) == 1) { if (FIRST) C1 = __builtin_amdgcn_mfma_f32_32x32x16_bf16(D3_KSEL(g), qr[0], f32x16{}, 0, 0, 0); else C1 = __builtin_amdgcn_mfma_f32_32x32x16_bf16(D3_KSEL(g), qr[0], negm, 0, 0, 0); } \
            else if ((g) & 1) C1 = __builtin_amdgcn_mfma_f32_32x32x16_bf16(D3_KSEL(g), qr[(g) >> 1], C1, 0, 0, 0); else C0 = __builtin_amdgcn_mfma_f32_32x32x16_bf16(D3_KSEL(g), qr[(g) >> 1], C0, 0, 0, 0); \
            if ((g) + 2 < 8) { if ((g) & 1) kf1 = D3_KF(kb_, (g) + 2); else kf0 = D3_KF(kb_, (g) + 2); } } \
        if (HASVA) { if ((g) == 6) vf0 = D3_VF(vp_, 0); if ((g) == 7) vf1 = D3_VF(vp_, 1); } \
        if (HASVA) { if ((g) < 5) { Q1[5 + 2 * (g)] = D3_EX(Q1[5 + 2 * (g)]); Q1[6 + 2 * (g)] = D3_EX(Q1[6 + 2 * (g)]); } if ((g) == 5) { Q1[15] = D3_EX(Q1[15]); } \
            if ((g) == 0) { pw0[0] = D3_PK(Q0, 0); pw0[1] = D3_PK(Q0, 2); } if ((g) == 1) { pw0[2] = D3_PK(Q0, 4); pw0[3] = D3_PK(Q0, 6); D3_PIN(pw0); } \
            if ((g) == 2) { pw1[0] = D3_PK(Q0, 8); pw1[1] = D3_PK(Q0, 10); } if ((g) == 3) { pw1[2] = D3_PK(Q0, 12); pw1[3] = D3_PK(Q0, 14); D3_PIN(pw1); } \
            if ((g) == 4) { pw2[0] = D3_PK(Q1, 0); pw2[1] = D3_PK(Q1, 2); } if ((g) == 5) { pw2[2] = D3_PK(Q1, 4); pw2[3] = D3_PK(Q1, 6); D3_PIN(pw2); } \
            if ((g) == 6) { pw3[0] = D3_PK(Q1, 8); pw3[1] = D3_PK(Q1, 10); } if ((g) == 7) { pw3[2] = D3_PK(Q1, 12); pw3[3] = D3_PK(Q1, 14); D3_PIN(pw3); } \
            } \
        SBAR(); } while (0)
#define D3_PWSEL(g) (((g) & 3) == 0 ? pw0 : ((g) & 3) == 1 ? pw1 : ((g) & 3) == 2 ? pw2 : pw3)
#define D3_EXI(C0, C1, e) do { if ((e) < 16) C0[(e) & 15] = D3_EX(C0[(e) & 15]); else C1[(e) & 15] = D3_EX(C1[(e) & 15]); } while (0)
#define D3_GB(g, C0, C1, Q0, Q1, HASPV, HASVB, FIRST) do { \
        if (HASPV) { \
            oT[(g) >> 2] = __builtin_amdgcn_mfma_f32_32x32x16_bf16(((g) & 1) ? vf1 : vf0, __builtin_bit_cast(bf16x8, D3_PWSEL(g)), oT[(g) >> 2], 0, 0, 0); \
            if ((g) + 2 < 16) { if ((g) & 1) vf1 = D3_VF(vp_, (g) + 2); else vf0 = D3_VF(vp_, (g) + 2); } } \
        if (HASPV) { if ((g) < 4) { sacc += Q0[4 * ((g) & 3)]; sacc += Q0[4 * ((g) & 3) + 1]; sacc += Q0[4 * ((g) & 3) + 2]; sacc += Q0[4 * ((g) & 3) + 3]; D3_PIN(sacc); } \
            else if ((g) < 8) { sacc += Q1[4 * ((g) & 3)]; sacc += Q1[4 * ((g) & 3) + 1]; sacc += Q1[4 * ((g) & 3) + 2]; sacc += Q1[4 * ((g) & 3) + 3]; D3_PIN(sacc); } \
            else if ((g) == 8) { l += sacc; } } \
        if (HASVB) { if ((g) < 4) { rmx = fmaxf(fmaxf(rmx, C0[4 * ((g) & 3)]), C0[4 * ((g) & 3) + 1]); rmx = fmaxf(fmaxf(rmx, C0[4 * ((g) & 3) + 2]), C0[4 * ((g) & 3) + 3]); D3_PIN(rmx); } \
            else if ((g) < 8) { rmx = fmaxf(fmaxf(rmx, C1[4 * ((g) & 3)]), C1[4 * ((g) & 3) + 1]); rmx = fmaxf(fmaxf(rmx, C1[4 * ((g) & 3) + 2]), C1[4 * ((g) & 3) + 3]); D3_PIN(rmx); } \
            else if ((g) == 8) { rmx = hmax(rmx); resc = false; \
                if (FIRST || __any(rmx > DF_THR)) { const float dl = FIRST ? rmx : fmaxf(rmx, 0.f); m += dl; \
                    _Pragma("unroll") for (int r_ = 0; r_ < 16; ++r_) { C0[r_] -= dl; C1[r_] -= dl; negm[r_] = -m; } D3_PIN(negm); \
                    rf = D3_EX(-dl); l *= rf; resc = true; } } \
            else { const int e0_ = 3 * ((g) - 9);   \
                D3_EXI(C0, C1, e0_); D3_EXI(C0, C1, e0_ + 1); D3_EXI(C0, C1, e0_ + 2); if (e0_ + 2 < 16) D3_PIN(C0); else D3_PIN(C1); } } \
        SBAR(); } while (0)
#define D3_STEP(C0, C1, Q0, Q1, HASQK, HASPREV, FIRST, T) do { \
        const lds_cptr kb_ = kp0 + ((T) & 1) * 16384; const lds_cptr vp_ = vp0 + (((T) - 1) & 3) * 16384; bf16x8 kf0, kf1, vf0, vf1; float sacc = 0.f, rmx = -3.0e38f; \
        if (HASQK) D3_DMA((T) + 1); \
        SBAR(); if (HASQK) { kf0 = D3_KF(kb_, 0); kf1 = D3_KF(kb_, 1); } \
        D3_GA(0, C0, C1, Q0, Q1, HASQK, HASPREV, FIRST); D3_GA(1, C0, C1, Q0, Q1, HASQK, HASPREV, FIRST); D3_GA(2, C0, C1, Q0, Q1, HASQK, HASPREV, FIRST); D3_GA(3, C0, C1, Q0, Q1, HASQK, HASPREV, FIRST); \
        D3_GA(4, C0, C1, Q0, Q1, HASQK, HASPREV, FIRST); D3_GA(5, C0, C1, Q0, Q1, HASQK, HASPREV, FIRST); D3_GA(6, C0, C1, Q0, Q1, HASQK, HASPREV, FIRST); D3_GA(7, C0, C1, Q0, Q1, HASQK, HASPREV, FIRST); \
        if (HASQK) { if (mp == 1) D3_WAITBAR(T); } \
        D3_GB(0, C0, C1, Q0, Q1, HASPREV, HASQK, FIRST); D3_GB(1, C0, C1, Q0, Q1, HASPREV, HASQK, FIRST); D3_GB(2, C0, C1, Q0, Q1, HASPREV, HASQK, FIRST); D3_GB(3, C0, C1, Q0, Q1, HASPREV, HASQK, FIRST); \
        D3_GB(4, C0, C1, Q0, Q1, HASPREV, HASQK, FIRST); D3_GB(5, C0, C1, Q0, Q1, HASPREV, HASQK, FIRST); D3_GB(6, C0, C1, Q0, Q1, HASPREV, HASQK, FIRST); D3_GB(7, C0, C1, Q0, Q1, HASPREV, HASQK, FIRST); \
        D3_GB(8, C0, C1, Q0, Q1, HASPREV, HASQK, FIRST); D3_GB(9, C0, C1, Q0, Q1, HASPREV, HASQK, FIRST); D3_GB(10, C0, C1, Q0, Q1, HASPREV, HASQK, FIRST); D3_GB(11, C0, C1, Q0, Q1, HASPREV, HASQK, FIRST); \
        D3_GB(12, C0, C1, Q0, Q1, HASPREV, HASQK, FIRST); D3_GB(13, C0, C1, Q0, Q1, HASPREV, HASQK, FIRST); D3_GB(14, C0, C1, Q0, Q1, HASPREV, HASQK, FIRST); D3_GB(15, C0, C1, Q0, Q1, HASPREV, HASQK, FIRST); \
        if (HASQK && resc) { _Pragma("unroll") for (int d_ = 0; d_ < 4; ++d_) oT[d_] = oT[d_] * rf; } \
        if (HASQK) { if (mp == 0) D3_WAITBAR(T); } \
        } while (0)
        DF_BARV();
        D3_STEP(pA0, pA1, pB0, pB1, true, false, true, 0);
        int t = 1;
        for (; t + 1 < NT; t += 2) {
            D3_STEP(pB0, pB1, pA0, pA1, true, true, false, t);
            D3_STEP(pA0, pA1, pB0, pB1, true, true, false, t + 1);
        }
        D3_STEP(pB0, pB1, pA0, pA1, true, true, false, t);
        D3_STEP(pA0, pA1, pB0, pB1, false, true, false, NT);
        l = hsum(l);
        const float il = 1.f / l;
        DF_BAR();
        LAS float* xch = (LAS float*)lds + qsub * 4096 + lane;
        if (mp == 1) { const float sc = il * A.lam;
#pragma unroll
            for (int d = 0; d < 4; ++d)
#pragma unroll
                for (int q = 0; q < 16; ++q) xch[(d * 16 + q) * 64] = oT[d][q] * sc; }
        DF_BAR();
        if (mp == 0) {
            float ss = 0.f;
#pragma unroll
            for (int d = 0; d < 4; ++d)
#pragma unroll
                for (int q = 0; q < 16; ++q) { const float v = oT[d][q] * il - xch[(d * 16 + q) * 64]; oT[d][q] = v; ss += v * v; }
            ss = hsum(ss);
            const float rstd = rsqrtf(ss * (1.f / 128.f) + RMS_EPS) * A.omli;
            LAS unsigned char* stg = lds + qsub * 16384;
#pragma unroll
            for (int d = 0; d < 4; ++d)
#pragma unroll
                for (int g = 0; g < 4; ++g) { const f32x4 gg = *(const f32x4*)(A.subln_g + d * 32 + 8 * g + 4 * hi);
                    u32x2 w; w.x = cvtpk(oT[d][4 * g] * rstd * gg[0], oT[d][4 * g + 1] * rstd * gg[1]); w.y = cvtpk(oT[d][4 * g + 2] * rstd * gg[2], oT[d][4 * g + 3] * rstd * gg[3]);
                    *(LAS u32x2*)(stg + r32 * 272 + (d * 32 + 8 * g + 4 * hi) * 2) = w; }
            stg_flush<4>(stg, A.y + (size_t)qrow0 * DM + h * 128, lane);
        }
        DF_BAR();
#undef D3_DMA
#undef D3_KF
#undef D3_KSEL
#undef D3_VF
#undef D3_PK
#undef D3_GA
#undef D3_GB
#undef D3_EXI
#undef D3_PWSEL
#undef D3_STEP
#undef D3_WAITBAR
    }
}

struct A2Args { const bf16_t* qkv; bf16_t* y; const float* aux; int with_ctx; const bf16_t* q; };
template <int MODE  >
__device__ __forceinline__ void att2_phase(LAS unsigned char* lds, const A2Args A, int vcu, int G) {
    int tid = threadIdx.x; asm volatile("" : "+v"(tid));
    const int lane = tid & 63, r32 = lane & 31, hi = lane >> 5; const int wid = __builtin_amdgcn_readfirstlane(tid >> 6);
    constexpr int P = MODE == 0 ? 1536 : 3072; constexpr int VOFF = MODE == 0 ? 256 : 1024;
    const unsigned lds0 = (unsigned)(uintptr_t)lds;
    const lds_cptr l3 = (lds_cptr)lds;
    const int grp = wid >> 2;
    LAS float* btab = (LAS float*)(lds + NA_BIAS_OFF + 1024);
    const int nmain = MODE == 0 ? NB * 4 * 32 * 2 : NB * 16 * 16;
    const int nunits = nmain + (A.with_ctx ? (MODE == 0 ? NB * 4 * 4 : NB * 16) : 0);
    for (int u = vcu; u < nunits; u += G) {
        int b, hk, hq, qrow0, nwin, k0win; const bool ctxu = u >= nmain; int qs = 0, r = 0, c = 0;
        if (MODE == 0) {
            if (!ctxu) { const int jj = u & 63; hk = (u >> 6) & 3; b = u >> 8; hq = 4 * hk + (wid >> 1); qs = 64 * jj + 32 * (wid & 1); qrow0 = b * SEQ + qs;
                const int ks = max(0, 64 * jj - 128), ke = min(SEQ, 64 * jj + 192); k0win = ks; nwin = (ke - ks) / 64; }
            else { const int v = u - nmain; hk = (v >> 2) & 3; hq = 4 * hk + (v & 3); b = v >> 4; qrow0 = MX + b * CTXL + 32 * wid; nwin = 0; k0win = 0; }
        } else {
            if (!ctxu) { const int uu = u & 15; hk = hq = (u >> 4) & 15; b = u >> 8; r = 4 * uu + (wid >> 1); c = 32 * (wid & 1) + r32; qrow0 = b * SEQ + r * 64 + 32 * (wid & 1);
                const int rs_lo = min(max(4 * uu - 4, 0), 56), rs_hi = min(max(4 * uu + 3 - 4, 0), 56); k0win = rs_lo * 64; nwin = rs_hi + 8 - rs_lo; }
            else { const int v = u - nmain; hk = hq = v & 15; b = v >> 4; qrow0 = MX + b * CTXL + 32 * wid; nwin = 0; k0win = 0; }
        }
        const int NT = 4 + nwin;
        const bf16_t* Kc = A.qkv + (size_t)(MX + b * CTXL) * P + 1024 + 64 * hk;
        const bf16_t* Kx = A.qkv + (size_t)(b * SEQ + k0win) * P + 1024 + 64 * hk;
        const int krow = 8 * wid + (lane >> 3); const size_t koff = (size_t)krow * P + (((lane & 7) ^ ((krow >> 1) & 7)) * 8), voff = (size_t)krow * P + VOFF + (((lane & 7) ^ (((krow >> 1) & 1) << 2)) * 8);
#define A2_DMA(t) do { if ((t) < NT) { const int slot_ = (t) % 3; const bf16_t* base_ = ((t) < 4) ? Kc + (size_t)(t) * 64 * P : Kx + (size_t)((t) - 4) * 64 * P; \
        glds16(base_ + koff, (unsigned)__builtin_amdgcn_readfirstlane(lds0 + slot_ * 16384 + wid * 1024)); \
        glds16(base_ + voff, (unsigned)__builtin_amdgcn_readfirstlane(lds0 + slot_ * 16384 + 8192 + wid * 1024)); } } while (0)
        A2_DMA(0);
        if (MODE == 1) { if (!ctxu && tid < 15 * 31) btab[tid] = A.aux[hq * 465 + tid] * LOG2E; }
        bf16x8 qr[4];
        { const bf16_t* Qw = A.q + ((size_t)(qrow0 >> 5) * 16 + hq) * 2048 + hi * 256 + r32 * 8;
#pragma unroll
          for (int d0 = 0; d0 < 4; ++d0) qr[d0] = *(const bf16x8*)(Qw + d0 * 512); }
        f32x16 oT[2]; oT[0] = f32x16{}; oT[1] = f32x16{};
        float m = 0.f, l = 0.f;
        f32x16 p0, p1; u32x4 pw[4];
        const int ksw = (r32 >> 1) & 7; const lds_cptr kp0 = l3 + r32 * 128 + ((hi ^ (ksw & 1)) << 4); const int ks2 = ksw >> 1;
        const int vq = (lane & 15) >> 2, vsq = (vq >> 1) & 1; const lds_cptr vp0 = l3 + 8192 + (4 * hi + vq) * 128 + ((lane >> 4) & 1) * 32 + (lane & 3) * 8;
        const int rs = min(max(r - 4, 0), 56), cs = min(max(c - 8, 0), 48);
#define A2_LOADV(dst, vp_, d) do { const lds_cptr vd_ = (vp_) + (((d) ^ vsq) << 6); _Pragma("unroll") for (int ks = 0; ks < 4; ++ks) { const s16x4 lo_ = vtr(vd_ + ks * 2048), hi_ = vtr(vd_ + ks * 2048 + 1024); \
            dst[ks] = (bf16x8){lo_[0], lo_[1], lo_[2], lo_[3], hi_[0], hi_[1], hi_[2], hi_[3]}; } } while (0)
#define A2_PV4(src, d) do { _Pragma("unroll") for (int ks = 0; ks < 4; ++ks) oT[d] = __builtin_amdgcn_mfma_f32_32x32x16_bf16(src[ks], __builtin_bit_cast(bf16x8, pw[ks]), oT[d], 0, 0, 0); } while (0)
#define A2_LOADK(dst, kb_, dd) do { dst[0] = *(const LAS bf16x8*)((kb_) + ((((dd)) ^ ks2) << 5)); dst[1] = *(const LAS bf16x8*)((kb_) + ((((dd)) ^ ks2) << 5) + 4096); \
            dst[2] = *(const LAS bf16x8*)((kb_) + ((((dd) + 1) ^ ks2) << 5)); dst[3] = *(const LAS bf16x8*)((kb_) + ((((dd) + 1) ^ ks2) << 5) + 4096); } while (0)
#define A2_QK4(src, dd) do { p0 = __builtin_amdgcn_mfma_f32_32x32x16_bf16(src[0], qr[dd], p0, 0, 0, 0); p1 = __builtin_amdgcn_mfma_f32_32x32x16_bf16(src[1], qr[dd], p1, 0, 0, 0); \
            p0 = __builtin_amdgcn_mfma_f32_32x32x16_bf16(src[2], qr[(dd) + 1], p0, 0, 0, 0); p1 = __builtin_amdgcn_mfma_f32_32x32x16_bf16(src[3], qr[(dd) + 1], p1, 0, 0, 0); } while (0)
#define A2_PREV(vso) do { const lds_cptr vq_ = vp0 + (vso); A2_LOADV(fa, vq_, 0); A2_LOADV(fb, vq_, 1); SBAR(); } while (0)
#define A2_PINIT() do { _Pragma("unroll") for (int q_ = 0; q_ < 16; ++q_) { p0[q_] = -m; p1[q_] = -m; } } while (0)
#define A2_SEGM(DO_PV, DO_QK, vso, kso) do { const lds_cptr kb_ = kp0 + (kso); SBAR(); __builtin_amdgcn_s_setprio(1); \
        if (DO_PV) { A2_PV4(fa, 0); if (DO_QK) { A2_PINIT(); } SBAR(); if (DO_QK) { A2_LOADK(fa, kb_, 0); } SBAR(); A2_PV4(fb, 1); SBAR(); if (DO_QK) { A2_LOADK(fb, kb_, 2); } SBAR(); } \
        else if (DO_QK) { A2_LOADK(fa, kb_, 0); A2_LOADK(fb, kb_, 2); A2_PINIT(); SBAR(); } \
        if (DO_QK) { A2_QK4(fa, 0); SBAR(); A2_QK4(fb, 2); SBAR(); } \
        __builtin_amdgcn_s_setprio(0); } while (0)
#define A2_SEGV(t) do { \
        if ((t) >= 4) { \
            if (MODE == 0) { const int kb0_ = k0win + 64 * ((t) - 4); if ((kb0_ + 63 > qs + 128) || (kb0_ < qs + 31 - 128)) { const int dq_ = kb0_ + 4 * hi - (qs + r32) + 128; \
                _Pragma("unroll") for (int q_ = 0; q_ < 16; ++q_) { const int kk_ = (q_ & 3) + 8 * (q_ >> 2); if ((unsigned)(dq_ + kk_) > 256u) p0[q_] = NEG_BIG; if ((unsigned)(dq_ + kk_ + 32) > 256u) p1[q_] = NEG_BIG; } } } \
            else { const int kr_ = (k0win >> 6) + (t) - 4; const bool rowok_ = (kr_ >= rs) && (kr_ < rs + 8); const int rel_ = rowok_ ? 4 * hi - cs : 1000; const LAS float* bp_ = btab + (rowok_ ? kr_ - r + 7 : 0) * 31 + 4 * hi - c + 15; \
                _Pragma("unroll") for (int q_ = 0; q_ < 16; ++q_) { const int kk_ = (q_ & 3) + 8 * (q_ >> 2); const float b0_ = bp_[kk_], b1_ = bp_[kk_ + 32]; \
                    p0[q_] = ((unsigned)(rel_ + kk_) < 16u) ? p0[q_] + b0_ : NEG_BIG; p1[q_] = ((unsigned)(rel_ + kk_ + 32) < 16u) ? p1[q_] + b1_ : NEG_BIG; } } } \
        float rm = p0[0]; \
        _Pragma("unroll") for (int q_ = 1; q_ < 16; ++q_) rm = fmaxf(rm, p0[q_]); \
        _Pragma("unroll") for (int q_ = 0; q_ < 16; ++q_) rm = fmaxf(rm, p1[q_]); \
        rm = hmax(rm); \
        if ((t) == 0 || __any(rm > DF_THR)) { const float dl = ((t) == 0) ? rm : fmaxf(rm, 0.f); m += dl; \
            _Pragma("unroll") for (int q_ = 0; q_ < 16; ++q_) { p0[q_] -= dl; p1[q_] -= dl; } \
            const float f = __builtin_amdgcn_exp2f(-dl); l *= f; oT[0] = oT[0] * f; oT[1] = oT[1] * f; } \
        float s_ = 0.f; \
        _Pragma("unroll") for (int q_ = 0; q_ < 16; ++q_) { p0[q_] = __builtin_amdgcn_exp2f(p0[q_]); p1[q_] = __builtin_amdgcn_exp2f(p1[q_]); s_ += p0[q_] + p1[q_]; } \
        l += s_; \
        _Pragma("unroll") for (int k = 0; k < 2; ++k) { \
            pw[k]     = (u32x4){cvtpk(p0[8 * k], p0[8 * k + 1]), cvtpk(p0[8 * k + 2], p0[8 * k + 3]), cvtpk(p0[8 * k + 4], p0[8 * k + 5]), cvtpk(p0[8 * k + 6], p0[8 * k + 7])}; \
            pw[2 + k] = (u32x4){cvtpk(p1[8 * k], p1[8 * k + 1]), cvtpk(p1[8 * k + 2], p1[8 * k + 3]), cvtpk(p1[8 * k + 4], p1[8 * k + 5]), cvtpk(p1[8 * k + 6], p1[8 * k + 7])}; } \
        } while (0)
        DF_BARV();
        int so_p = 0, so_c = 0;
#define A2_ROT() do { so_p = so_c; so_c = (so_c == 32768) ? 0 : so_c + 16384; } while (0)
        bf16x8 fa[4], fb[4];
        if (grp == 0) {
            A2_DMA(1); A2_SEGM(false, true, 0, so_c); SBAR(); A2_PREV(so_c); A2_SEGV(0); SBAR(); DF_BARV(); SBAR();
            for (int t = 1; t < NT; ++t) { A2_ROT();
                A2_DMA(t + 1); A2_SEGM(true, true, so_p, so_c); SBAR(); A2_PREV(so_c); A2_SEGV(t); SBAR(); DF_BARV(); SBAR(); }
            A2_ROT();
            A2_SEGM(true, false, so_p, 0); SBAR(); DF_BARV(); SBAR();
        } else {
            A2_DMA(1); A2_SEGM(false, true, 0, so_c); SBAR(); DF_BARV(); SBAR();
            for (int t = 1; t < NT; ++t) { A2_ROT();
                A2_DMA(t + 1); A2_PREV(so_p); A2_SEGV(t - 1); SBAR(); A2_SEGM(true, true, so_p, so_c); SBAR(); DF_BARV(); SBAR(); }
            A2_ROT();
            A2_PREV(so_p); A2_SEGV(NT - 1); SBAR(); A2_SEGM(true, false, so_p, 0); SBAR(); DF_BARV(); SBAR();
        }
        l = hsum(l);
        if (MODE == 0) l += __builtin_amdgcn_exp2f(A.aux[hq] * LOG2E - m);
        if (OUTPROJ_FP8) store_oT<2>(oT, 1.f / l, A.y, (size_t)(qrow0 + r32) * DM + hq * 64, hi);
        else { LAS unsigned char* stg = lds + wid * 8192; const float sc_ = 1.f / l;
#pragma unroll
            for (int d = 0; d < 2; ++d)
#pragma unroll
                for (int g = 0; g < 4; ++g) { u32x2 w; w.x = cvtpk(oT[d][4 * g] * sc_, oT[d][4 * g + 1] * sc_); w.y = cvtpk(oT[d][4 * g + 2] * sc_, oT[d][4 * g + 3] * sc_);
                    *(LAS u32x2*)(stg + r32 * 144 + (d * 32 + 8 * g + 4 * hi) * 2) = w; }
            stg_flush<2>(stg, A.y + (size_t)qrow0 * DM + hq * 64, lane); }
        DF_BAR();
#undef A2_DMA
#undef A2_LOADV
#undef A2_PV4
#undef A2_LOADK
#undef A2_QK4
#undef A2_SEGM
#undef A2_SEGV
#undef A2_PREV
#undef A2_PINIT
#undef A2_ROT
    }
}
#undef SBAR
}

struct Frame {
    LAS unsigned char* lds; volatile LAS unsigned* MISC; unsigned* ctl;
    int tid, lane, wave, vcu, G;
};

__device__ __forceinline__ void transpose_item(const float* W, int K, int N, bf16_t* WT, int k0, int n0, int drow0, LAS float* scr, int lane) {
    f32x4 v[16];
    const float* src = W + (size_t)(k0 + (lane >> 4)) * N + n0 + 4 * (lane & 15);
#pragma unroll
    for (int i = 0; i < 16; ++i) v[i] = *(const f32x4*)(src + (size_t)(4 * i) * N);
#pragma unroll
    for (int i = 0; i < 16; ++i) { LAS float* d = scr + (4 * i + (lane >> 4)) * 65 + 4 * (lane & 15); d[0] = v[i].x; d[1] = v[i].y; d[2] = v[i].z; d[3] = v[i].w; }
    LDS_WAIT(); asm volatile("" ::: "memory");
    const int c = lane & 7;
#pragma unroll
    for (int j = 0; j < 8; ++j) { const int n = (lane >> 3) + 8 * j; const LAS float* s = scr + (8 * c) * 65 + n;
        u32x4 o; o.x = cvtpk(s[0 * 65], s[1 * 65]); o.y = cvtpk(s[2 * 65], s[3 * 65]); o.z = cvtpk(s[4 * 65], s[5 * 65]); o.w = cvtpk(s[6 * 65], s[7 * 65]);
        *(u32x4*)(WT + (size_t)(drow0 + n) * K + k0 + 8 * c) = o; }
    LDS_WAIT(); asm volatile("" ::: "memory");
}

enum { KA_x, KA_c, KA_ctx, KA_c_ctx, KA_ada_w, KA_ada_b, KA_norm1_g, KA_norm2_g, KA_final_g, KA_win_w_in, KA_win_w_out, KA_win_sink, KA_diff_w_in, KA_diff_w_out, KA_diff_lambda, KA_diff_subln_g,
       KA_na_w_in, KA_na_w_out, KA_na_rpb, KA_router_w, KA_w_gate, KA_w_up, KA_w_down, KA_OUT, KA_WS };
__device__ __forceinline__ const float* karg(int i) { asm volatile("" : "+s"(i)); return (const float*)(GAS const float*)(((const unsigned long long __attribute__((address_space(4)))*)__builtin_amdgcn_kernarg_segment_ptr())[i]); }
__device__ __forceinline__ void t8_load(f32x4 (&v)[16], const float* W, int N, int k0, int n0, int lane) {
    const float* src = W + (size_t)(k0 + (lane >> 4)) * N + n0 + 4 * (lane & 15);
#pragma unroll
    for (int i = 0; i < 16; ++i) v[i] = *(const f32x4*)(src + (size_t)(4 * i) * N);
}
__device__ __forceinline__ void t8_finish(const f32x4 (&v)[16], int Kb, unsigned char* WT, int k0, int drow0, LAS float* scr, int lane) {
#pragma unroll
    for (int i = 0; i < 16; ++i) { LAS float* d = scr + (4 * i + (lane >> 4)) * 65 + 4 * (lane & 15); d[0] = v[i].x * W8_SCALE; d[1] = v[i].y * W8_SCALE; d[2] = v[i].z * W8_SCALE; d[3] = v[i].w * W8_SCALE; }
    LDS_WAIT(); asm volatile("" ::: "memory");
    const int c = lane & 3;
#pragma unroll
    for (int j = 0; j < 4; ++j) { const int n = (lane >> 2) + 16 * j; const LAS float* s = scr + (16 * c) * 65 + n;
        int w[4];
#pragma unroll
        for (int q = 0; q < 4; ++q) { int t = 0; t = __builtin_amdgcn_cvt_pk_fp8_f32(s[(4 * q) * 65], s[(4 * q + 1) * 65], t, false); t = __builtin_amdgcn_cvt_pk_fp8_f32(s[(4 * q + 2) * 65], s[(4 * q + 3) * 65], t, true); w[q] = t; }
        *(u32x4*)(WT + (size_t)(drow0 + n) * Kb + k0 + 16 * c) = (u32x4){(unsigned)w[0], (unsigned)w[1], (unsigned)w[2], (unsigned)w[3]}; }
    LDS_WAIT(); asm volatile("" ::: "memory");
}
__device__ __forceinline__ void transpose_item8(const float* W, int Kb, int N, unsigned char* WT, int k0, int n0, int drow0, LAS float* scr, int lane) {
    f32x4 v[16]; t8_load(v, W, N, k0, n0, lane); t8_finish(v, Kb, WT, k0, drow0, scr, lane);
}

struct In {
    const float *x, *c, *ctx, *c_ctx, *ada_w, *ada_b, *norm1_g, *norm2_g, *final_g, *win_w_in, *win_w_out, *win_sink, *diff_w_in, *diff_w_out, *diff_lambda, *diff_subln_g,
        *na_w_in, *na_w_out, *na_rpb, *router_w, *w_gate, *w_up, *w_down;
};

__device__ __forceinline__ void phase_prologue(Frame& F, unsigned char* ws) {
    int tid_ = threadIdx.x; asm volatile("" : "+v"(tid_)); const int lane_ = tid_ & 63; const int wave_ = __builtin_amdgcn_readfirstlane(tid_ >> 6);
    LAS float* scr = (LAS float*)(F.lds + wave_ * 16640);
    const int gw = F.vcu * NWAVES + wave_, NGW = F.G * NWAVES;
    if (F.vcu == 0) {
        float* tab = (float*)(ws + WS_TAB);
        for (int i = tid_; i < 1024; i += 512) { const int pos = i >> 4, f = i & 15; const float inv = 1.0f / powf(10000.0f, (float)(2 * f) / 32.0f); const float ang = (float)pos * inv;
            tab[TAB_COS + i] = cosf(ang); tab[TAB_SIN + i] = sinf(ang); }
        if (wave_ == 0) { const float* lp = karg(KA_diff_lambda); const float a = wave_sum(lp[lane_] * lp[64 + lane_]), b2 = wave_sum(lp[128 + lane_] * lp[192 + lane_]);
            const float li = 0.8f - 0.6f * expf(-0.3f * 1.0f); if (lane_ == 0) { tab[TAB_LAM] = expf(a) - expf(b2) + li; tab[TAB_LAM + 1] = 1.0f - li; } }
    }
    {
        bf16_t* pw = (bf16_t*)(ws + WS_PW);
        constexpr int IT_WI = 16 * 24, IT_O = 16 * 16, IT_3 = 16 * 48;
        constexpr int NIT = 2 * IT_WI + 2 * IT_O + IT_3 + IT_O + IT_3 + IT_O;
        for (int it = gw; it < NIT; it += NGW) {
            int r = it; const float* W; bf16_t* WT; int N;
            if (r < 2 * IT_WI) { const int s = r / IT_WI; r -= s * IT_WI; W = karg(KA_win_w_in) + (size_t)s * 1024 * 1536; WT = pw + (PW_WIN_IN / 2) + (size_t)s * 1536 * 1024; N = 1536; }
            else if ((r -= 2 * IT_WI) < 2 * IT_O) { const int s = r / IT_O; r -= s * IT_O; W = karg(KA_win_w_out) + (size_t)s * 1024 * 1024; WT = pw + (PW_WIN_OUT / 2) + (size_t)s * 1024 * 1024; N = 1024; }
            else if ((r -= 2 * IT_O) < IT_3) { W = karg(KA_diff_w_in); WT = pw + PW_DIFF_IN / 2; N = 3072; }
            else if ((r -= IT_3) < IT_O) { W = karg(KA_diff_w_out); WT = pw + PW_DIFF_OUT / 2; N = 1024; }
            else if ((r -= IT_O) < IT_3) { W = karg(KA_na_w_in); WT = pw + PW_NA_IN / 2; N = 3072; }
            else { r -= IT_3; W = karg(KA_na_w_out); WT = pw + PW_NA_OUT / 2; N = 1024; }
            const int nblk = N / 64, kb = r / nblk, nb = r % nblk;
            if ((INPROJ_FP8 && N != 1024) || (OUTPROJ_FP8 && N == 1024)) transpose_item8(W, 1024, N, (unsigned char*)WT, 64 * kb, 64 * nb, 64 * nb, scr, lane_);
            else transpose_item(W, 1024, N, WT, 64 * kb, 64 * nb, 64 * nb, scr, lane_);
        }
    }
    {
        const int NIT = 64 * 1536;
#define MW_DESC(it_, W_, N_, Kb_, WT_, k0_, n0_, dr_) do { const int le_ = (it_) / 1536; int r_ = (it_) % 1536; \
            unsigned char* W1t_ = ws + WS_MOEW + (size_t)le_ * MOEW_E; \
            if (r_ < 1024) { const bool up_ = r_ >= 512; r_ &= 511; W_ = (up_ ? karg(KA_w_up) : karg(KA_w_gate)) + (size_t)le_ * 1024 * 2048; N_ = 2048; Kb_ = 1024; WT_ = W1t_; \
                k0_ = 64 * (r_ / 32); n0_ = 64 * (r_ % 32); dr_ = (n0_ >> 7) * 256 + (up_ ? 128 : 0) + (n0_ & 127); } \
            else { r_ -= 1024; W_ = karg(KA_w_down) + (size_t)le_ * 2048 * 1024; N_ = 1024; Kb_ = 2048; WT_ = W1t_ + (size_t)4096 * 1024; k0_ = 64 * (r_ / 16); n0_ = 64 * (r_ % 16); dr_ = n0_; } } while (0)
        f32x4 va[16], vb[16];
        const float* Wc = nullptr; int Nc = 0, Kbc = 0, k0c = 0, n0c = 0, drc = 0; unsigned char* WTc = nullptr;
        int it = gw;
        if (it < NIT) { MW_DESC(it, Wc, Nc, Kbc, WTc, k0c, n0c, drc); t8_load(va, Wc, Nc, k0c, n0c, lane_); }
        while (it < NIT) {
            const int itn = it + NGW;
            const float* Wn = Wc; int Nn = Nc, Kbn = Kbc, k0n = k0c, n0n = n0c, drn = drc; unsigned char* WTn = WTc;
            if (itn < NIT) { MW_DESC(itn, Wn, Nn, Kbn, WTn, k0n, n0n, drn); t8_load(vb, Wn, Nn, k0n, n0n, lane_); }
            t8_finish(va, Kbc, WTc, k0c, drc, scr, lane_);
#pragma unroll
            for (int i = 0; i < 16; ++i) va[i] = vb[i];
            Wc = Wn; Nc = Nn; Kbc = Kbn; WTc = WTn; k0c = k0n; n0c = n0n; drc = drn; it = itn;
        }
#undef MW_DESC
    }
    __syncthreads();
    {
        LAS float* sc = (LAS float*)F.lds;
        LAS float* red = (LAS float*)(F.lds + 69632);
        for (int i = tid_; i < 17 * 1024; i += 512) { const float v = (i < 16384) ? karg(KA_c)[i] : karg(KA_c_ctx)[i - 16384]; sc[i] = siluf(v); }
        __syncthreads();
        float* mod = (float*)(ws + WS_MOD);
        for (int task = F.vcu; task < 4 * 192; task += F.G) {
            const int L = task / 192, cg = task % 192, col = cg * 32 + (lane_ & 31), kh = lane_ >> 5;
            const float* wp = karg(KA_ada_w) + (size_t)L * 1024 * 6144 + (size_t)(wave_ * 128 + kh * 64) * 6144 + col;
            const LAS float* scp = sc + wave_ * 128 + kh * 64;
            float acc[17];
#pragma unroll
            for (int r = 0; r < 17; ++r) acc[r] = 0.f;
            for (int k0 = 0; k0 < 64; k0 += 16) { float w[16];
#pragma unroll
                for (int kk = 0; kk < 16; ++kk) w[kk] = wp[(size_t)(k0 + kk) * 6144];
#pragma unroll
                for (int kk = 0; kk < 16; ++kk)
#pragma unroll
                    for (int r = 0; r < 17; ++r) acc[r] += scp[r * 1024 + k0 + kk] * w[kk]; }
#pragma unroll
            for (int r = 0; r < 17; ++r) { acc[r] += __shfl_xor(acc[r], 32); if (lane_ < 32) red[(wave_ * 17 + r) * 32 + lane_] = acc[r]; }
            __syncthreads();
            for (int i = tid_; i < 17 * 32; i += 512) { const int r = i >> 5, ln = i & 31; float sum = 0.f;
#pragma unroll
                for (int w = 0; w < 8; ++w) sum += red[(w * 17 + r) * 32 + ln];
                mod[((size_t)L * 17 + r) * 6144 + cg * 32 + ln] = sum + karg(KA_ada_b)[L * 6144 + cg * 32 + ln]; }
            __syncthreads();
        }
    }
}

__device__ __forceinline__ void load_row(const float* row, int lane, f32x4 (&v)[4]) {
    const f32x4* xr = (const f32x4*)row + lane;
#pragma unroll
    for (int j = 0; j < 4; ++j) v[j] = xr[64 * j];
}
__device__ __forceinline__ void load_row_bf16(const bf16_t* row, int lane, u32x2 (&w)[4]) {
    const u32x2* p = (const u32x2*)row + lane;
#pragma unroll
    for (int j = 0; j < 4; ++j) w[j] = p[64 * j];
}
__device__ __forceinline__ void cvt_row_bf16(f32x4 (&v)[4], const u32x2 (&w)[4]) {
#pragma unroll
    for (int j = 0; j < 4; ++j) { v[j].x = __builtin_bit_cast(float, w[j].x << 16); v[j].y = __builtin_bit_cast(float, w[j].x & 0xffff0000u);
        v[j].z = __builtin_bit_cast(float, w[j].y << 16); v[j].w = __builtin_bit_cast(float, w[j].y & 0xffff0000u); }
}
__device__ __forceinline__ void add_row_bf16(f32x4 (&v)[4], const u32x2 (&w)[4]) {
#pragma unroll
    for (int j = 0; j < 4; ++j) { v[j].x += __builtin_bit_cast(float, w[j].x << 16); v[j].y += __builtin_bit_cast(float, w[j].x & 0xffff0000u);
        v[j].z += __builtin_bit_cast(float, w[j].y << 16); v[j].w += __builtin_bit_cast(float, w[j].y & 0xffff0000u); }
}
__device__ __forceinline__ float row_rstd(const f32x4 (&v)[4]) {
    float s = 0.f;
#pragma unroll
    for (int j = 0; j < 4; ++j) s += (v[j].x * v[j].x + v[j].y * v[j].y) + (v[j].z * v[j].z + v[j].w * v[j].w);
    return rsqrtf(wave_sum_fast(s) * (1.f / DM) + RMS_EPS);
}
__device__ __forceinline__ void store_row_bf16(bf16_t* orow, int lane, const f32x4 (&v)[4]) {
    u32x2* o8 = (u32x2*)orow + lane;
#pragma unroll
    for (int j = 0; j < 4; ++j) { u32x2 w; w.x = cvtpk(v[j].x, v[j].y); w.y = cvtpk(v[j].z, v[j].w); o8[64 * j] = w; }
}
__device__ __forceinline__ void store_row_fp8(unsigned char* orow, int lane, const f32x4 (&v)[4], float scale) {
    unsigned* o4 = (unsigned*)orow + lane;
#pragma unroll
    for (int j = 0; j < 4; ++j) { int t = 0; t = __builtin_amdgcn_cvt_pk_fp8_f32(v[j].x * scale, v[j].y * scale, t, false); t = __builtin_amdgcn_cvt_pk_fp8_f32(v[j].z * scale, v[j].w * scale, t, true); o4[64 * j] = (unsigned)t; }
}
struct ModCache { f32x4 sc[4], sh[4]; int b; };
__device__ __forceinline__ void modcache_load(ModCache& M, int b, const float* g, const float* modL, int shift_chunk, int scale_chunk, int lane) {
    if (M.b == b) return; M.b = b;
    const float* mp = modL + (size_t)b * 6144;
#pragma unroll
    for (int j = 0; j < 4; ++j) { const f32x4 gg = ((const f32x4*)g)[lane + 64 * j], s = ((const f32x4*)(mp + scale_chunk * DM))[lane + 64 * j];
        M.sc[j] = gg * (1.f + s); M.sh[j] = ((const f32x4*)(mp + shift_chunk * DM))[lane + 64 * j]; }
}
__device__ __forceinline__ int row_batch(int m) { return m < MX ? (m >> 12) : 16; }

__device__ __forceinline__ void phase_norm1(Frame& F, const float* x, const float* ctx, const float* g1, const float* modL, bf16_t* H, bf16_t* XB) {
    int tid_ = threadIdx.x; asm volatile("" : "+v"(tid_)); const int lane_ = tid_ & 63; const int wave_ = __builtin_amdgcn_readfirstlane(tid_ >> 6);
    const int gw = F.vcu * NWAVES + wave_, NGW = F.G * NWAVES; const int per = (MT + NGW - 1) / NGW;
    ModCache M; M.b = -1;
    const int m0 = gw * per, m1 = min(MT, m0 + per);
    f32x4 nx[4];
    if (m0 < m1) load_row(m0 < MX ? x + (size_t)m0 * DM : ctx + (size_t)(m0 - MX) * DM, lane_, nx);
    for (int m = m0; m < m1; ++m) {
        f32x4 v[4];
#pragma unroll
        for (int j = 0; j < 4; ++j) v[j] = nx[j];
        if (m + 1 < m1) load_row((m + 1) < MX ? x + (size_t)(m + 1) * DM : ctx + (size_t)(m + 1 - MX) * DM, lane_, nx);
        modcache_load(M, row_batch(m), g1, modL, 0, 1, lane_);
        store_row_bf16(XB + (size_t)m * DM, lane_, v);
        const float rstd = row_rstd(v);
#pragma unroll
        for (int j = 0; j < 4; ++j) v[j] = v[j] * rstd * M.sc[j] + M.sh[j];
        if (INPROJ_FP8) store_row_fp8((unsigned char*)H + (size_t)m * DM, lane_, v, H2_SCALE); else store_row_bf16(H + (size_t)m * DM, lane_, v);
    }
}

__device__ __forceinline__ void phase_norm2_router(Frame& F, const bf16_t* XB, const float* g2, const float* modL, const float* rw, unsigned char* H8, float* aff, int nrows, const bf16_t* P, bool do_router = true) {
    int tid_ = threadIdx.x; asm volatile("" : "+v"(tid_)); const int lane = tid_ & 63; const int wave_ = __builtin_amdgcn_readfirstlane(tid_ >> 6);
    LAS float* rwT = (LAS float*)F.lds;
    for (int i = tid_; i < 16384; i += 512) { const int d = i >> 4, e = i & 15; rwT[e * 1024 + d] = rw[i]; }
    __syncthreads();
    const int gw = F.vcu * NWAVES + wave_, NGW = F.G * NWAVES; constexpr int NR2 = 1; const int ngroups = nrows / NR2; const int per = (ngroups + NGW - 1) / NGW;
    ModCache M; M.b = -1;
    const int g0 = gw * per, g1 = min(ngroups, g0 + per);
    constexpr int ND3 = 3;
    u32x2 nx[ND3][4];
#pragma unroll
    for (int k = 0; k < ND3; ++k) if (g0 + k < g1) { load_row_bf16(XB + (size_t)(g0 + k) * DM, lane, nx[k]); }
    for (int gb = g0; gb < g1; gb += ND3)
#pragma unroll
    for (int k = 0; k < ND3; ++k) {
        const int g = gb + k; if (g >= g1) break;
        const int m = NR2 * g;
        f32x4 v[NR2][4];
        cvt_row_bf16(v[0], nx[k]);
        if (g + ND3 < g1) { load_row_bf16(XB + (size_t)(g + ND3) * DM, lane, nx[k]); }
        modcache_load(M, row_batch(m), g2, modL, 3, 4, lane);
#pragma unroll
        for (int r = 0; r < NR2; ++r) { const float rstd = row_rstd(v[r]);
#pragma unroll
            for (int j = 0; j < 4; ++j) v[r][j] = v[r][j] * rstd * M.sc[j] + M.sh[j];
            store_row_fp8(H8 + (size_t)(m + r) * DM, lane, v[r], H2_SCALE); }
        if (!do_router) continue;
        float pe[NR2][16];
        int lo4 = 4 * lane; asm volatile("" : "+v"(lo4));
#pragma unroll
        for (int eb = 0; eb < 16; eb += 4) {
            f32x4 w[4][4];
#pragma unroll
            for (int e4 = 0; e4 < 4; ++e4)
#pragma unroll
                for (int j = 0; j < 4; ++j) w[e4][j] = *(const LAS f32x4*)(rwT + (eb + e4) * 1024 + lo4 + 256 * j);
            __builtin_amdgcn_sched_barrier(0);
#pragma unroll
            for (int e4 = 0; e4 < 4; ++e4) { f32x2 s2 = {0.f, 0.f};
#pragma unroll
                for (int j = 0; j < 4; ++j) { s2 = __builtin_elementwise_fma((f32x2){v[0][j].x, v[0][j].y}, (f32x2){w[e4][j].x, w[e4][j].y}, s2); s2 = __builtin_elementwise_fma((f32x2){v[0][j].z, v[0][j].w}, (f32x2){w[e4][j].z, w[e4][j].w}, s2); }
                pe[0][eb + e4] = s2.x + s2.y; }
            __builtin_amdgcn_sched_barrier(0);
        }
        {
            LAS float* red = (LAS float*)(F.lds + 65536) + wave_ * 1088;
#pragma unroll
            for (int e = 0; e < 16; ++e) red[lane * 17 + e] = pe[0][e];
            const LAS float* rp = red + (lane >> 4) * 272 + (lane & 15);
            float sacc = 0.f;
#pragma unroll
            for (int i = 0; i < 16; ++i) sacc += rp[i * 17];
            sacc += __shfl_xor(sacc, 16); sacc += __shfl_xor(sacc, 32);
            const float mx = row16_max(sacc);
            const float ex = expf(sacc - mx);
            const float sm = row16_sum(ex);
            if (lane < 16) aff[(size_t)m * 16 + lane] = ex / sm;
        }
    }
    __syncthreads();
}

#define N2_BAR() asm volatile("s_waitcnt lgkmcnt(0)\n\ts_barrier" ::: "memory")
__device__ __forceinline__ void phase_norm2_router_mfma(Frame& F, const bf16_t* XB, const float* g2, const float* modL, const float* rw, unsigned char* H8, float* aff, int nrows) {
    int tid_ = threadIdx.x; asm volatile("" : "+v"(tid_)); const int lane = tid_ & 63; const int wave_ = __builtin_amdgcn_readfirstlane(tid_ >> 6);
    constexpr int AST = 2064;
    LAS unsigned char* Ahi = F.lds; LAS unsigned char* Alo = F.lds + 16 * AST; LAS float* red = (LAS float*)(F.lds + 2 * 16 * AST);
    const int e_ = lane & 15, kg = lane >> 4;
    bf16x8 Bh[4], Bl[4];
#pragma unroll
    for (int s = 0; s < 4; ++s) { const float* wp = rw + (size_t)(128 * wave_ + 32 * s + 8 * kg) * 16 + e_;
        const float x0 = wp[0], x1 = wp[16], x2 = wp[32], x3 = wp[48], x4 = wp[64], x5 = wp[80], x6 = wp[96], x7 = wp[112];
        u32x4 h, l; h.x = cvtpk(x0, x1); h.y = cvtpk(x2, x3); h.z = cvtpk(x4, x5); h.w = cvtpk(x6, x7);
        l.x = cvtpk(x0 - __builtin_bit_cast(float, h.x << 16), x1 - __builtin_bit_cast(float, h.x & 0xffff0000u)); l.y = cvtpk(x2 - __builtin_bit_cast(float, h.y << 16), x3 - __builtin_bit_cast(float, h.y & 0xffff0000u));
        l.z = cvtpk(x4 - __builtin_bit_cast(float, h.z << 16), x5 - __builtin_bit_cast(float, h.z & 0xffff0000u)); l.w = cvtpk(x6 - __builtin_bit_cast(float, h.w << 16), x7 - __builtin_bit_cast(float, h.w & 0xffff0000u));
        Bh[s] = __builtin_bit_cast(bf16x8, h); Bl[s] = __builtin_bit_cast(bf16x8, l); }
    const int ngroups = nrows >> 4; const bool ilv = (F.G == 256); const int per = ilv ? (ngroups >> 8) : (ngroups + F.G - 1) / F.G; const int gg0 = ilv ? 0 : F.vcu * per, gg1 = ilv ? per : min(ngroups, gg0 + per);
#define N2_GROUP(i) (ilv ? ((i) < 16 ? 256 * (F.vcu >> 4) + (F.vcu & 15) + 16 * (i) : 4096 + F.vcu) : (i))
    ModCache M; M.b = -1;
    u32x2 nx[2][4];
    if (gg0 < gg1) { load_row_bf16(XB + (size_t)(N2_GROUP(gg0) * 16 + 2 * wave_) * DM, lane, nx[0]); load_row_bf16(XB + (size_t)(N2_GROUP(gg0) * 16 + 2 * wave_ + 1) * DM, lane, nx[1]); }
    for (int gg = gg0; gg < gg1; ++gg) {
        const int mbase = N2_GROUP(gg) * 16;
        f32x4 v[2][4];
        cvt_row_bf16(v[0], nx[0]); cvt_row_bf16(v[1], nx[1]);
        if (gg + 1 < gg1) { const int mn_ = N2_GROUP(gg + 1) * 16; load_row_bf16(XB + (size_t)(mn_ + 2 * wave_) * DM, lane, nx[0]); load_row_bf16(XB + (size_t)(mn_ + 2 * wave_ + 1) * DM, lane, nx[1]); }
#pragma unroll
        for (int r = 0; r < 2; ++r) { const int tok = 2 * wave_ + r, m = mbase + tok;
            modcache_load(M, row_batch(m), g2, modL, 3, 4, lane);
            const float rstd = row_rstd(v[r]);
#pragma unroll
            for (int j = 0; j < 4; ++j) v[r][j] = v[r][j] * rstd * M.sc[j] + M.sh[j];
            store_row_fp8(H8 + (size_t)m * DM, lane, v[r], H2_SCALE);
            LAS unsigned char* ah = Ahi + tok * AST + 8 * lane;
#pragma unroll
            for (int j = 0; j < 4; ++j) { const f32x4 x = v[r][j]; u32x2 h, l; h.x = cvtpk(x.x, x.y); h.y = cvtpk(x.z, x.w);
                l.x = cvtpk(x.x - __builtin_bit_cast(float, h.x << 16), x.y - __builtin_bit_cast(float, h.x & 0xffff0000u)); l.y = cvtpk(x.z - __builtin_bit_cast(float, h.y << 16), x.w - __builtin_bit_cast(float, h.y & 0xffff0000u));
                *(LAS u32x2*)(ah + 512 * j) = h; *(LAS u32x2*)(ah + 16 * AST + 512 * j) = l; } }
        N2_BAR();
        f32x4 acc = {0.f, 0.f, 0.f, 0.f};
#pragma unroll
        for (int s = 0; s < 4; ++s) { const LAS unsigned char* ap = Ahi + e_ * AST + 256 * wave_ + 64 * s + 16 * kg;
            const bf16x8 a_h = *(const LAS bf16x8*)ap, a_l = *(const LAS bf16x8*)(ap + 16 * AST);
            acc = __builtin_amdgcn_mfma_f32_16x16x32_bf16(a_h, Bh[s], acc, 0, 0, 0); acc = __builtin_amdgcn_mfma_f32_16x16x32_bf16(a_h, Bl[s], acc, 0, 0, 0); acc = __builtin_amdgcn_mfma_f32_16x16x32_bf16(a_l, Bh[s], acc, 0, 0, 0); }
#pragma unroll
        for (int r = 0; r < 4; ++r) red[wave_ * 256 + (4 * kg + r) * 16 + e_] = acc[r];
        N2_BAR();
        if (tid_ < 256) { float sacc = 0.f;
#pragma unroll
            for (int w = 0; w < 8; ++w) sacc += red[w * 256 + tid_];
            const float mx = row16_max(sacc);
            const float ex = expf(sacc - mx);
            const float sm = row16_sum(ex);
            aff[(size_t)(mbase + (tid_ >> 4)) * 16 + (tid_ & 15)] = ex / sm; }
    }
    __syncthreads();
#undef N2_GROUP
}

template <int NPT>
__device__ __forceinline__ void topk_task(Frame& F, const float* aff, int rowbase, int n, int cap, int e, int slot_base, unsigned* rowsrc_e, short* slot) {
    int tid_ = threadIdx.x; asm volatile("" : "+v"(tid_)); const int lane_ = tid_ & 63; const int wave_ = __builtin_amdgcn_readfirstlane(tid_ >> 6);
    LAS unsigned* cnt = (LAS unsigned*)F.lds;
    const int tid = tid_, lane = lane_, wave = wave_;
    const bool act = tid * NPT < n;
    unsigned v[NPT];
#pragma unroll
    for (int j = 0; j < NPT; ++j) v[j] = act ? __float_as_uint(aff[(size_t)(rowbase + tid * NPT + j) * 16 + e]) : 0u;
    unsigned T = 0u;
    for (int bit = 30; bit >= 0; --bit) {
        const unsigned cand = T | (1u << bit);
        unsigned c = 0;
#pragma unroll
        for (int j = 0; j < NPT; ++j) c += (act && v[j] >= cand) ? 1u : 0u;
        c = (unsigned)wave_sum((float)c);
        LAS unsigned* cb = cnt + (bit & 1) * 8;
        if (lane == 0) cb[wave] = c;
        __syncthreads();
        unsigned tot = 0;
#pragma unroll
        for (int w = 0; w < 8; ++w) tot += cb[w];
        if (tot >= (unsigned)cap) T = cand;
    }
    unsigned ngt = 0, neq = 0;
#pragma unroll
    for (int j = 0; j < NPT; ++j) { ngt += (act && v[j] > T) ? 1u : 0u; neq += (act && v[j] == T) ? 1u : 0u; }
    unsigned pk = ngt | (neq << 16), inc = pk;
#pragma unroll
    for (int o = 1; o < 64; o <<= 1) { const unsigned t = __shfl_up(inc, o); if (lane >= o) inc += t; }
    LAS unsigned* wtot = cnt + 32;
    __syncthreads();
    if (lane == 63) wtot[wave] = inc;
    __syncthreads();
    unsigned wpre = 0, total = 0;
#pragma unroll
    for (int w = 0; w < 8; ++w) { const unsigned t = wtot[w]; if (w < wave) wpre += t; total += t; }
    const unsigned exc = wpre + inc - pk;
    const unsigned tot_gt = total & 0xffffu;
    const unsigned need_eq = (unsigned)cap - tot_gt;
    unsigned gt_before = exc & 0xffffu, eq_before = exc >> 16;
    if (act) {
#pragma unroll
        for (int j = 0; j < NPT; ++j) {
            const bool g = v[j] > T, q = v[j] == T;
            const bool sel = g || (q && eq_before < need_eq);
            const int tok = tid * NPT + j;
            short sv = -1;
            if (sel) { const unsigned pos = gt_before + min(eq_before, need_eq); sv = (short)(slot_base + pos); rowsrc_e[slot_base + pos] = (unsigned)(rowbase + tok); }
            slot[(size_t)(rowbase + tok) * 16 + e] = sv;
            gt_before += g ? 1u : 0u; eq_before += q ? 1u : 0u;
        }
    }
    __syncthreads();
}
__device__ __forceinline__ void phase_topk(Frame& F, const float* aff, unsigned* rowsrc, short* slot, int nMe, bool with_ctx) {
    const int ntask = NB * NE * (with_ctx ? 2 : 1);
    for (int t = F.vcu; t < ntask; t += F.G) {
        const bool cx = t >= NB * NE; const int tt = cx ? t - NB * NE : t; const int b = tt >> 4, e = tt & 15;
        unsigned* rs_e = rowsrc + (size_t)e * nMe * 256;
        if (!cx) topk_task<8>(F, aff, b * SEQ, SEQ, CAPX, e, b * CAPX, rs_e, slot);
        else topk_task<1>(F, aff, MX + b * CTXL, CTXL, CAPC, e, NB * CAPX + b * CAPC, rs_e, slot);
    }
}

__device__ __forceinline__ void phase_combine(Frame& F, bf16_t* XB, const bf16_t* P, float* xout, const float* modL, const float* aff, const short* slot, const bf16_t* ybuf, int nMe,
                                              int nrows, bool last, const float* gnext, const float* modN, bf16_t* H, const float* final_g, float* dump = nullptr) {
    int tid_ = threadIdx.x; asm volatile("" : "+v"(tid_)); const int lane = tid_ & 63; const int wave_ = __builtin_amdgcn_readfirstlane(tid_ >> 6);
    const int gw = F.vcu * NWAVES + wave_, NGW = F.G * NWAVES; const int per = (nrows + NGW - 1) / NGW;
    ModCache M; M.b = -1;
    f32x4 g2v[4]; int gb = -1;
    const int m0 = gw * per, m1 = min(nrows, m0 + per);
    const size_t estride = (size_t)nMe * 256 * DM;
#define CB_META(m, sv, av) do { sv = (int)slot[(size_t)(m) * 16 + (lane & 15)]; av = aff[(size_t)(m) * 16 + (lane & 15)]; } while (0)
#define CB_ISSUE(m, sv, av, X, Y, AK, REST) do { load_row_bf16(XB + (size_t)(m) * DM, lane, X); \
        unsigned mk_ = (unsigned)__ballot(sv >= 0) & 0xffffu; \
        _Pragma("unroll") for (int k = 0; k < 4; ++k) { \
            if (mk_) { const int e_ = __builtin_ctz(mk_); mk_ &= mk_ - 1u; const int s_ = __builtin_amdgcn_readlane(sv, e_); AK[k] = __builtin_bit_cast(float, __builtin_amdgcn_readlane(__builtin_bit_cast(int, av), e_)); \
                const u32x2* yr_ = (const u32x2*)(ybuf + (size_t)e_ * estride + (size_t)s_ * DM) + lane; \
                _Pragma("unroll") for (int j = 0; j < 4; ++j) Y[k][j] = yr_[64 * j]; } \
            else { AK[k] = 0.f; _Pragma("unroll") for (int j = 0; j < 4; ++j) Y[k][j] = (u32x2){0u, 0u}; } } \
        REST = mk_; } while (0)
    int sv1 = -1, sv2 = -1; float av1 = 0.f, av2 = 0.f;
    u32x2 X[4], Xn[4]; u32x2 Y[4][4], Yn[4][4]; float AK[4], AKn[4]; unsigned rest = 0, restn = 0; int svc = -1, svn = -1; float avc = 0.f, avn = 0.f;
    if (m0 < m1) { CB_META(m0, sv1, av1); CB_ISSUE(m0, sv1, av1, X, Y, AK, rest); svc = sv1; avc = av1; }
    if (m0 + 1 < m1) CB_META(m0 + 1, sv1, av1);
    for (int m = m0; m < m1; ++m) {
        if (m + 1 < m1) { CB_ISSUE(m + 1, sv1, av1, Xn, Yn, AKn, restn); svn = sv1; avn = av1; }
        if (m + 2 < m1) CB_META(m + 2, sv1, av1);
        const int b = row_batch(m);
        if (gb != b) { gb = b;
#pragma unroll
            for (int j = 0; j < 4; ++j) g2v[j] = ((const f32x4*)(modL + (size_t)b * 6144 + 5 * DM))[lane + 64 * j]; }
        f32x4 acc[4];
#pragma unroll
        for (int j = 0; j < 4; ++j) acc[j] = (f32x4){0.f, 0.f, 0.f, 0.f};
#pragma unroll
        for (int k = 0; k < 4; ++k) { const float a = AK[k];
#pragma unroll
            for (int j = 0; j < 4; ++j) { const u32x2 w = Y[k][j];
                acc[j].x += a * __builtin_bit_cast(float, w.x << 16); acc[j].y += a * __builtin_bit_cast(float, w.x & 0xffff0000u);
                acc[j].z += a * __builtin_bit_cast(float, w.y << 16); acc[j].w += a * __builtin_bit_cast(float, w.y & 0xffff0000u); } }
        while (rest) { const int e_ = __builtin_ctz(rest); rest &= rest - 1u; const int s_ = __builtin_amdgcn_readlane(svc, e_); const float a = __builtin_bit_cast(float, __builtin_amdgcn_readlane(__builtin_bit_cast(int, avc), e_));
            const u32x2* yr = (const u32x2*)(ybuf + (size_t)e_ * estride + (size_t)s_ * DM) + lane;
#pragma unroll
            for (int j = 0; j < 4; ++j) { const u32x2 w = yr[64 * j];
                acc[j].x += a * __builtin_bit_cast(float, w.x << 16); acc[j].y += a * __builtin_bit_cast(float, w.x & 0xffff0000u);
                acc[j].z += a * __builtin_bit_cast(float, w.y << 16); acc[j].w += a * __builtin_bit_cast(float, w.y & 0xffff0000u); } }
        f32x4 v[4];
        cvt_row_bf16(v, X);
#pragma unroll
        for (int j = 0; j < 4; ++j) v[j] = v[j] + g2v[j] * acc[j];
        const float rstd = row_rstd(v);
        if (!last) {
            store_row_bf16((dump ? (bf16_t*)dump : XB) + (size_t)m * DM, lane, v);
            modcache_load(M, b, gnext, modN, 0, 1, lane);
#pragma unroll
            for (int j = 0; j < 4; ++j) v[j] = v[j] * rstd * M.sc[j] + M.sh[j];
            if (INPROJ_FP8) store_row_fp8((unsigned char*)H + (size_t)m * DM, lane, v, H2_SCALE); else store_row_bf16(H + (size_t)m * DM, lane, v);
        } else {
            f32x4* o = (f32x4*)((dump ? dump : xout) + (size_t)m * DM) + lane;
#pragma unroll
            for (int j = 0; j < 4; ++j) o[64 * j] = v[j] * rstd * ((const f32x4*)final_g)[lane + 64 * j];
        }
#pragma unroll
        for (int j = 0; j < 4; ++j) { X[j] = Xn[j];
#pragma unroll
            for (int k = 0; k < 4; ++k) Y[k][j] = Yn[k][j]; }
#pragma unroll
        for (int k = 0; k < 4; ++k) AK[k] = AKn[k];
        rest = restn; svc = svn; avc = avn;
    }
#undef CB_META
#undef CB_ISSUE
}

struct Args { In in; float* out; unsigned char* ws; int ph_lo, ph_hi; };
#define WSP(off) ((unsigned char*)karg(KA_WS) + (off))
__global__ void __launch_bounds__(NWAVES * 64, 2) fwd(Args args) {
    extern __shared__ __attribute__((aligned(16))) unsigned char lds_raw[];
    Frame F;
    F.lds = (LAS unsigned char*)lds_raw;
    F.MISC = (volatile LAS unsigned*)(F.lds + MISC_OFF);
    F.tid = threadIdx.x; F.lane = F.tid & 63; F.wave = __builtin_amdgcn_readfirstlane(F.tid >> 6);
    F.G = gridDim.x; { const int bx = blockIdx.x; F.vcu = (F.G % 8 == 0) ? (bx % 8) * (F.G / 8) + bx / 8 : bx; }
    F.ctl = nullptr;
    if (F.tid < 64) ((LAS unsigned*)(F.lds + MISC_OFF))[F.tid] = 0u;
    __syncthreads();
    const int lo = args.ph_lo, hi = args.ph_hi;
    if (hi - lo > 1) (void)xcd_barrier_post((unsigned*)WSP(WS_CTL) + 1024, F.MISC + 8);
#ifndef DBG_ONLY
#define DBG_ONLY -1
#endif
#define PHEN(k) (DBG_ONLY < 0 || ((k) < 2 ? (k) : 2 + (((k) - 2) & 7)) == DBG_ONLY)
#define IN(k) (PHEN(k) && lo <= (k) && (k) < hi)
#ifndef ROUTER_MFMA
#define ROUTER_MFMA 1
#endif
#ifndef DUP_PH
#define DUP_PH -1
#endif
#ifndef DUP_LMASK
#define DUP_LMASK 0xF
#endif
#define NREP(k, L) ((DUP_PH == (k) && ((DUP_LMASK >> (L)) & 1)) ? 2 : 1)
#define SEAM(k) do { if (IN(k) && IN((k) + 1)) { XcdBarrier bar_; bar_.bar = (unsigned*)WSP(WS_CTL) + 1024; bar_.x = xb_xcc_id(); bar_.st = F.MISC + 8; xcd_barrier(bar_); } } while (0)

    if (IN(0)) { for (int rep_ = 0; rep_ < NREP(0, 0); ++rep_) phase_prologue(F, WSP(0)); } SEAM(0);
    if (IN(1)) { phase_norm1(F, karg(KA_x), karg(KA_ctx), karg(KA_norm1_g), (const float*)WSP(WS_MOD), (bf16_t*)WSP(WS_H), (bf16_t*)WSP(WS_XB)); } SEAM(1);

#pragma unroll 1
    for (int L = 0; L < DEPTH; ++L) {
        const int pb = 2 + 8 * L;
        if (hi <= pb || lo >= pb + 8) continue;
        if (IN(pb + 0)) for (int rep_ = 0; rep_ < NREP(2, L); ++rep_) {
            const int kind = L % 3, slot = L / 3; const int Nin = (kind == 0) ? 1536 : 3072;
            const bf16_t* Wt = (const bf16_t*)WSP(WS_PW) + (kind == 0 ? PW_WIN_IN / 2 + (size_t)slot * 1536 * 1024 : kind == 1 ? PW_DIFF_IN / 2 : PW_NA_IN / 2);
            pg8::Gemm g{(const char*)WSP(WS_H), (const char*)Wt, INPROJ_FP8 ? DM : DM * 2, 1 << 20, 0, nullptr};
            pg8::StaticOrder S; S.init(MT / 256, Nin / 256, F.G, (int)blockIdx.x);
            pg8::EpiInProj E{(bf16_t*)WSP(WS_QKV), Nin, 4, kind == 0 ? 5 : (kind == 1 ? 8 : 0), (const float*)WSP(WS_TAB), INPROJ_FP8 ? 1.f / (H2_SCALE * W8_SCALE) : 1.f, kind == 0 ? 5 : 8, (bf16_t*)WSP(WS_P)};
            pg8::gemm_phase<pg8::EpiInProj, false, true, INPROJ_FP8 != 0>(F.lds, g, S, E);
        }
        SEAM(pb + 0);
        if (IN(pb + 1)) for (int rep_ = 0; rep_ < NREP(3, L); ++rep_) {
            const int kind = L % 3, slot = L / 3; const int with_ctx = L < DEPTH - 1 ? 1 : 0;
            if (kind == 0) { att::A2Args A{(const bf16_t*)WSP(WS_QKV), (bf16_t*)WSP(WS_H), karg(KA_win_sink) + slot * 16, with_ctx, (const bf16_t*)WSP(WS_P)}; att::att2_phase<0>(F.lds, A, F.vcu, F.G); }
            else if (kind == 1) { const float* TAB = (const float*)WSP(WS_TAB); att::DiffArgs A{(const bf16_t*)WSP(WS_QKV), (bf16_t*)WSP(WS_H), karg(KA_diff_subln_g), TAB[TAB_LAM], TAB[TAB_LAM + 1], with_ctx, (const bf16_t*)WSP(WS_P)}; att::diff_phase3(F.lds, A, F.vcu, F.G); }
            else { att::A2Args A{(const bf16_t*)WSP(WS_QKV), (bf16_t*)WSP(WS_H), karg(KA_na_rpb), with_ctx, (const bf16_t*)WSP(WS_P)}; att::att2_phase<1>(F.lds, A, F.vcu, F.G); }
        }
        SEAM(pb + 1);
        if (IN(pb + 2)) {
            const int kind = L % 3, slot = L / 3; const bool with_ctx = L < DEPTH - 1;
            const bf16_t* Wt = (const bf16_t*)WSP(WS_PW) + (kind == 0 ? PW_WIN_OUT / 2 + (size_t)slot * 1024 * 1024 : kind == 1 ? PW_DIFF_OUT / 2 : PW_NA_OUT / 2);
            pg8::Gemm g{(const char*)WSP(WS_H), (const char*)Wt, OUTPROJ_FP8 ? DM : DM * 2, 1 << 20, 0, nullptr};
            pg8::StaticOrder S; S.init((with_ctx ? MT : MX) / 256, 4, F.G, (int)blockIdx.x);
            pg8::EpiOutProj E{(bf16_t*)WSP(WS_XB), (const float*)WSP(WS_MOD) + (size_t)L * 17 * 6144, OUTPROJ_FP8 ? 1.f / (Y_SCALE * W8_SCALE) : 1.f};
            pg8::gemm_phase<pg8::EpiOutProj, false, true, OUTPROJ_FP8 != 0>(F.lds, g, S, E);
        }
        SEAM(pb + 2);
        if (IN(pb + 3)) for (int rep_ = 0; rep_ < NREP(5, L); ++rep_) { const bool with_ctx = L < DEPTH - 1;
            if (ROUTER_MFMA && rep_ == 0) phase_norm2_router_mfma(F, (const bf16_t*)WSP(WS_XB), karg(KA_norm2_g) + L * DM, (const float*)WSP(WS_MOD) + (size_t)L * 17 * 6144, karg(KA_router_w) + (size_t)L * DM * NE,
                               (unsigned char*)WSP(WS_H), (float*)WSP(WS_AFF), with_ctx ? MT : MX);
            else phase_norm2_router(F, (const bf16_t*)WSP(WS_XB), karg(KA_norm2_g) + L * DM, (const float*)WSP(WS_MOD) + (size_t)L * 17 * 6144, karg(KA_router_w) + (size_t)L * DM * NE,
                               (unsigned char*)WSP(WS_H), (float*)WSP(WS_AFF), with_ctx ? MT : MX, (const bf16_t*)WSP(WS_P), rep_ == 0); }
        SEAM(pb + 3);
        if (IN(pb + 4)) for (int rep_ = 0; rep_ < NREP(6, L); ++rep_) { const bool with_ctx = L < DEPTH - 1; phase_topk(F, (const float*)WSP(WS_AFF), (unsigned*)WSP(WS_ROWSRC), (short*)WSP(WS_SLOT), with_ctx ? NME_FULL : NME_LAST, with_ctx); }
        SEAM(pb + 4);
        if (IN(pb + 5)) for (int rep_ = 0; rep_ < NREP(7, L); ++rep_) {
            const int nMe = (L < DEPTH - 1) ? NME_FULL : NME_LAST;
            pg8::Gemm g{(const char*)WSP(WS_H), (const char*)WSP(WS_MOEW + (size_t)L * 16 * MOEW_E), DM, nMe, MOEW_E, (const unsigned*)WSP(WS_ROWSRC)};
            pg8::StaticOrder S; S.init(16 * nMe, 16, F.G, (int)blockIdx.x);
            if (DUP_PH == 7 && rep_ == 1) { pg8::EpiSwiglu<true> E{(unsigned char*)WSP(WS_QKV), 1.f / (H2_SCALE * W8_SCALE), HID_SCALE};
                pg8::gemm_phase<pg8::EpiSwiglu<true>, true, true, true>(F.lds, g, S, E); }
            else { pg8::EpiSwiglu<false> E{(unsigned char*)WSP(WS_QKV), 1.f / (H2_SCALE * W8_SCALE), HID_SCALE};
                pg8::gemm_phase<pg8::EpiSwiglu<false>, true, true, true>(F.lds, g, S, E); }
        }
        SEAM(pb + 5);
        if (IN(pb + 6)) for (int rep_ = 0; rep_ < NREP(8, L); ++rep_) {
            const int nMe = (L < DEPTH - 1) ? NME_FULL : NME_LAST;
            pg8::Gemm g{(const char*)WSP(WS_QKV), (const char*)WSP(WS_MOEW + (size_t)L * 16 * MOEW_E + (size_t)4096 * 1024), FF, nMe, MOEW_E, nullptr};
            pg8::StaticOrder S; S.init(16 * nMe, 4, F.G, (int)blockIdx.x);
            pg8::EpiBf16 E{(bf16_t*)WSP(WS_YBUF), DM, 1.f / (HID_SCALE * W8_SCALE)};
            pg8::gemm_phase<pg8::EpiBf16, false, true, true, true>(F.lds, g, S, E);
        }
        SEAM(pb + 6);
        if (IN(pb + 7)) for (int rep_ = NREP(9, L) - 1; rep_ >= 0; --rep_) {
            const bool last = (L == DEPTH - 1); const bool with_ctx = !last;
            phase_combine(F, (bf16_t*)WSP(WS_XB), (const bf16_t*)WSP(WS_P), (float*)karg(KA_OUT), (const float*)WSP(WS_MOD) + (size_t)L * 17 * 6144, (const float*)WSP(WS_AFF), (const short*)WSP(WS_SLOT), (const bf16_t*)WSP(WS_YBUF),
                          with_ctx ? NME_FULL : NME_LAST, with_ctx ? MT : MX, last, karg(KA_norm1_g) + (last ? 0 : (L + 1) * DM), (const float*)WSP(WS_MOD) + (size_t)(last ? 0 : L + 1) * 17 * 6144,
                          rep_ ? (bf16_t*)WSP(WS_QKV + 300 * MiB) : (bf16_t*)WSP(WS_H), karg(KA_final_g), rep_ ? (float*)WSP(WS_QKV) : nullptr);
        }
        SEAM(pb + 7);
    }
#undef IN
#undef SEAM
}

extern "C" void kernel_launch(void* const* d_in, const int* in_sizes, int n_in, void* d_out, int out_size, void* d_ws, size_t ws_size, hipStream_t stream) {
    static int grid = 0;
    if (grid == 0) {
        if (n_in != 23 || out_size != MX * DM || ws_size < WS_END) { fprintf(stderr, "kernel_launch: unexpected shapes: n_in %d out %d ws %zu (need %zu)\n", n_in, out_size, ws_size, (size_t)WS_END); grid = -1; return; }
        int dev = 0, cus = 0, per_cu = 0;
        if (hipGetDevice(&dev) != hipSuccess || hipDeviceGetAttribute(&cus, hipDeviceAttributeMultiprocessorCount, dev) != hipSuccess) { grid = -1; return; }
        if (hipFuncSetAttribute((const void*)fwd, hipFuncAttributeMaxDynamicSharedMemorySize, LDS_BYTES) != hipSuccess) { fprintf(stderr, "kernel_launch: hipFuncSetAttribute failed\n"); grid = -1; return; }
        if (hipOccupancyMaxActiveBlocksPerMultiprocessor(&per_cu, (const void*)fwd, NWAVES * 64, LDS_BYTES) != hipSuccess || per_cu < 1) fprintf(stderr, "kernel_launch: occupancy query says %d\n", per_cu);
        (void)hipGetLastError();
        grid = cus;
    }
    if (grid < 0) return;
    (void)hipMemsetAsync((char*)d_ws + WS_CTL, 0, CTL_ZERO_BYTES, stream);
    Args a{};
    const float** ip = (const float**)&a.in;
    for (int i = 0; i < 23; ++i) ip[i] = (const float*)d_in[i];
    a.out = (float*)d_out; a.ws = (unsigned char*)d_ws;
    if (MK_N_LAUNCHES == 1) { a.ph_lo = 0; a.ph_hi = NPHASES; hipLaunchKernelGGL(fwd, dim3(grid), dim3(NWAVES * 64), LDS_BYTES, stream, a); }
    else for (int p = 0; p < NPHASES; ++p) { a.ph_lo = p; a.ph_hi = p + 1; hipLaunchKernelGGL(fwd, dim3(grid), dim3(NWAVES * 64), LDS_BYTES, stream, a); }
}
```

```cpp
#include <hip/hip_runtime.h>
#include <cstdio>
#include <cstdint>

#ifndef MK_N_LAUNCHES
#define MK_N_LAUNCHES 1
#endif

#define GAS __attribute__((address_space(1)))
#define LAS __attribute__((address_space(3)))
typedef unsigned short bf16_t;
typedef short bf16x8 __attribute__((ext_vector_type(8)));
typedef short s16x4 __attribute__((ext_vector_type(4)));
typedef float f32x4 __attribute__((ext_vector_type(4)));
typedef float f32x2 __attribute__((ext_vector_type(2)));
typedef float f32x16 __attribute__((ext_vector_type(16)));
typedef unsigned u32x4 __attribute__((ext_vector_type(4)));
typedef unsigned u32x2 __attribute__((ext_vector_type(2)));
typedef __bf16 bf16x2_t __attribute__((ext_vector_type(2)));
typedef GAS unsigned gu32;

constexpr int DM = 1024, NB = 16, SEQ = 4096, DEPTH = 4, CTXL = 256, NE = 16, FF = 2048;
constexpr int MX = NB * SEQ;
constexpr int MC = NB * CTXL;
constexpr int MT = MX + MC;
constexpr int CAPX = 512, CAPC = 32;
constexpr int NME_FULL = 34, NME_LAST = 32;
constexpr float C2 = 0.125f * 1.4426950408889634f;
constexpr float LOG2E = 1.4426950408889634f;
constexpr float RMS_EPS = 1e-6f;
constexpr float NEG_BIG = -1e30f;
constexpr int NWAVES = 8;
constexpr int NPHASES = 2 + 8 * DEPTH;

constexpr size_t MiB = 1u << 20;
constexpr size_t WS_CTL = 0, CTL_ZERO_BYTES = 64 * 1024;
constexpr size_t WS_MOD = 1 * MiB;
constexpr size_t WS_TAB = 3 * MiB;
constexpr size_t WS_AFF = 4 * MiB;
constexpr size_t WS_SLOT = 9 * MiB;
constexpr size_t WS_ROWSRC = 12 * MiB;
constexpr size_t WS_CTXRES = 13 * MiB;
constexpr size_t WS_PW = 29 * MiB;
constexpr size_t PW_WIN_IN = 0, PW_WIN_OUT = 6 * MiB, PW_DIFF_IN = 10 * MiB, PW_DIFF_OUT = 16 * MiB, PW_NA_IN = 18 * MiB, PW_NA_OUT = 24 * MiB;
constexpr size_t WS_H = 56 * MiB;
constexpr size_t WS_QKV = 192 * MiB;
constexpr size_t WS_YBUF = 736 * MiB;
constexpr size_t WS_MOEW = 1008 * MiB;
constexpr size_t MOEW_E = (size_t)(4096 * 1024 + 1024 * 2048);
#ifndef INPROJ_FP8
#define INPROJ_FP8 1
#endif
#ifndef OUTPROJ_FP8
#define OUTPROJ_FP8 1
#endif
constexpr float Y_SCALE = 8.f;
constexpr float H2_SCALE = 4.f, HID_SCALE = 2.f, W8_SCALE = 32.f;
constexpr size_t WS_XB = 1536 * MiB;
constexpr size_t WS_END = 1672 * MiB;
constexpr size_t WS_P = 1400 * MiB;
constexpr int TAB_COS = 0, TAB_SIN = 1024, TAB_LAM = 2048;

constexpr int RING_BYTES = 131072;
constexpr int MISC_OFF = 135168;
constexpr int LDS_BYTES = 147456;

#define LDS_WAIT() asm volatile("s_waitcnt lgkmcnt(0)" ::: "memory")
#define VM_WAIT() asm volatile("s_waitcnt vmcnt(0)" ::: "memory")

__device__ __forceinline__ unsigned cvtpk(float lo, float hi) { f32x2 v = {lo, hi}; bf16x2_t b = __builtin_convertvector(v, bf16x2_t); return __builtin_bit_cast(unsigned, b); }
__device__ __forceinline__ float bf2f(unsigned short u) { return __builtin_bit_cast(float, (unsigned)u << 16); }
__device__ __forceinline__ float wave_sum(float v) {
#pragma unroll
    for (int o = 1; o < 64; o <<= 1) v += __shfl_xor(v, o);
    return v;
}
template <int CTRL> __device__ __forceinline__ float dppf(float v) { return __builtin_bit_cast(float, __builtin_amdgcn_update_dpp(0, __builtin_bit_cast(int, v), CTRL, 0xF, 0xF, true)); }
__device__ __forceinline__ float row16_sum(float v) { v += dppf<0xB1>(v); v += dppf<0x4E>(v); v += dppf<0x141>(v); v += dppf<0x140>(v); return v; }
__device__ __forceinline__ float row16_max(float v) { v = fmaxf(v, dppf<0xB1>(v)); v = fmaxf(v, dppf<0x4E>(v)); v = fmaxf(v, dppf<0x141>(v)); v = fmaxf(v, dppf<0x140>(v)); return v; }
__device__ __forceinline__ float rdlane(float v, int l) { return __builtin_bit_cast(float, __builtin_amdgcn_readlane(__builtin_bit_cast(int, v), l)); }
__device__ __forceinline__ float wave_sum_fast(float v) { v = row16_sum(v); return (rdlane(v, 0) + rdlane(v, 16)) + (rdlane(v, 32) + rdlane(v, 48)); }
__device__ __forceinline__ float siluf(float v) { return v / (1.f + __expf(-v)); }

#define XB_TMO      128
#define XB_XCNT(j)  (256  + 64 * (j))
#define XB_XSUB(j)  (1280 + 64 * (j))
#define XB_XGEN(j)  (2304 + 64 * (j))
#define XB_TOP      3328
#define XB_TOPGEN   3392
#define XCD_BAR_WORDS 3456
#define XB_SPIN_CAP (1u << 18)
__device__ __forceinline__ unsigned xb_ld(unsigned* p)              { return __hip_atomic_load(p, __ATOMIC_RELAXED, __HIP_MEMORY_SCOPE_AGENT); }
__device__ __forceinline__ unsigned xb_add(unsigned* p, unsigned v) { return __hip_atomic_fetch_add(p, v, __ATOMIC_RELAXED, __HIP_MEMORY_SCOPE_AGENT); }
__device__ __forceinline__ unsigned xb_xcc_id() { return (unsigned)__builtin_amdgcn_s_getreg((3 << 11) | 20) & 0xFu; }
#define XB_SPIN(cond, bar) do { unsigned _sp = 0; while (cond) { __builtin_amdgcn_s_sleep(1); \
    if ((++_sp & 255u) == 0u) { if (xb_ld(&(bar)[XB_TMO])) break; if (_sp > XB_SPIN_CAP) { atomicAdd(&(bar)[XB_TMO], 1u); break; } } } } while (0)
struct XcdBarrier { unsigned* bar; unsigned x; volatile LAS unsigned* st; };
__device__ __forceinline__ XcdBarrier xcd_barrier_post(unsigned* bar, volatile LAS unsigned* st) {
    XcdBarrier b; b.bar = bar; b.x = xb_xcc_id(); b.st = st;
    if (threadIdx.x == 0) (void)xb_add(&bar[XB_XCNT(b.x)], 1u);
    return b;
}
__device__ __forceinline__ void xcd_barrier_complete(unsigned* bar, unsigned x, unsigned& nloc, unsigned& nx) {
    const unsigned G = gridDim.x * gridDim.y * gridDim.z;
    unsigned sum, cnt, mine, sp = 0u;
    for (;;) {
        sum = 0u; cnt = 0u; mine = 0u;
#pragma unroll
        for (unsigned j = 0; j < 16; ++j) { const unsigned c = xb_ld(&bar[XB_XCNT(j)]); sum += c; cnt += (c > 0u) ? 1u : 0u; mine = (j == x) ? c : mine; }
        if (sum == G) break;
        __builtin_amdgcn_s_sleep(1);
        if ((++sp & 255u) == 0u) { if (xb_ld(&bar[XB_TMO])) break; if (sp > XB_SPIN_CAP) { atomicAdd(&bar[XB_TMO], 1u); break; } }
    }
    nloc = mine > 0u ? mine : 1u; nx = cnt > 0u ? cnt : 1u;
}
__device__ __forceinline__ void xcd_barrier(const XcdBarrier& b) {
    asm volatile("s_waitcnt vmcnt(0)" ::: "memory");
    __syncthreads();
    if (threadIdx.x == 0) {
        unsigned* bar = b.bar;
        __builtin_amdgcn_s_waitcnt(0);
        unsigned nloc = b.st[0], nx = b.st[1];
        if (nloc == 0u) { xcd_barrier_complete(bar, b.x, nloc, nx); b.st[0] = nloc; b.st[1] = nx; }
        const unsigned old = xb_add(&bar[XB_XSUB(b.x)], 1u);
        const unsigned gen = old / nloc;
        if (old + 1u == (gen + 1u) * nloc) {
            __builtin_amdgcn_fence(__ATOMIC_RELEASE, "agent");
            asm volatile("s_waitcnt vmcnt(0)" ::: "memory");
            const unsigned og = xb_add(&bar[XB_TOP], 1u);
            const unsigned tg = og / nx;
            if (og + 1u == (tg + 1u) * nx) xb_add(&bar[XB_TOPGEN], 1u);
            else XB_SPIN(xb_ld(&bar[XB_TOPGEN]) == tg, bar);
            __builtin_amdgcn_fence(__ATOMIC_ACQUIRE, "agent");
            xb_add(&bar[XB_XGEN(b.x)], 1u);
            asm volatile("s_waitcnt vmcnt(0)" ::: "memory");
        } else {
            XB_SPIN(xb_ld(&bar[XB_XGEN(b.x)]) == gen, bar);
            __builtin_amdgcn_fence(__ATOMIC_ACQUIRE, "agent");
            asm volatile("s_waitcnt vmcnt(0)" ::: "memory");
        }
    }
    __syncthreads();
}

namespace pg8 {
constexpr int BM = 256, BK = 64, HALF = 128, HTB = HALF * BK * 2, NXCD = 8, WGM = 4;
typedef int v4i __attribute__((ext_vector_type(4)));
typedef int v8i __attribute__((ext_vector_type(8)));
__host__ __device__ __forceinline__ int lds_byte(int r, int c) { const int st = (r >> 4) * 2 + (c >> 5), rr = r & 15, cc = c & 31, ob = rr * 64 + cc * 2; return st * 1024 + (ob ^ (((ob >> 9) & 1) << 5)); }
__host__ __device__ __forceinline__ void stage_rc(int b, int& R, int& C) { const int st = b / 1024, sb = b % 1024, swz = sb ^ (((sb >> 9) & 1) << 5); R = (st >> 1) * 16 + swz / 64; C = (st & 1) * 32 + (swz % 64) / 2; }
__host__ __device__ __forceinline__ int perm32(int rho) { const int n = rho >> 4, i = rho & 15; return 8 * (i >> 2) + 4 * n + (i & 3); }

struct Unit { int pm, pn; };
struct Gemm { const char* A; const char* Bt; int Kb; int nMe; size_t b_estride; const unsigned* rowsrc; };

struct StaticOrder {
    int nM, nN, nwg, G, c;
    __device__ void init(int nM_, int nN_, int G_, int c_) { nM = nM_; nN = nN_; nwg = nM * nN; G = G_; c = c_; }
    __device__ bool next(int i, Unit& u) const {
        const long L = (long)i * G + c; if (L >= nwg) return false;
        int wgid = (int)L; { const int q = nwg / NXCD, r = nwg % NXCD, xcd = wgid % NXCD, off = wgid / NXCD; wgid = (xcd < r ? xcd * (q + 1) : r * (q + 1) + (xcd - r) * q) + off; }
        const int nig = WGM * nN, gid = wgid / nig, fm = gid * WGM, gsz = (nM - fm) < WGM ? (nM - fm) : WGM;
        u.pm = fm + ((wgid % nig) % gsz); u.pn = (wgid % nig) / gsz; return true;
    }
};

template <class Epi, bool GATHER, bool ALIGN_EPI, bool FP8 = false, bool ABLK = false>
__device__ __forceinline__ void gemm_phase(LAS unsigned char* lds, const Gemm g, const StaticOrder& S, const Epi& E) {
    int tid = threadIdx.x; asm volatile("" : "+v"(tid));
    const int wid = __builtin_amdgcn_readfirstlane(tid >> 6), lane = tid & 63, wr = wid >> 2, wc = wid & 3, fr = lane & 15, fq = lane >> 4;
    const int Kb = g.Kb, nt = Kb / (BK * 2);
    int Rr[2], Cc[2]; unsigned voffB[2];
#pragma unroll
    for (int i = 0; i < 2; ++i) { int R, C; stage_rc(tid * 16 + i * 8192, R, C); const int Rb = Epi::PERM ? ((R & ~31) + perm32(R & 31)) : R;
        Rr[i] = R; Cc[i] = C; voffB[i] = (unsigned)(Rb * Kb + C * 2); }
    const size_t kstep = (size_t)(BK * 2);
    const size_t kstepA = ABLK ? (size_t)32768 : kstep;
    const size_t hstep = (size_t)HALF * Kb;
    const size_t tstep = 2 * hstep;
    const unsigned ldsw = (unsigned)wid * 1024u;
    const int aoff = lds_byte(wr * 64 + fr, fq * 8), boff = lds_byte(wc * 32 + fr, fq * 8);
#define PG8_SA(b, h) (((b) * 2 + (h)) * HTB)
#define PG8_SB(b, h) ((4 + (b) * 2 + (h)) * HTB)
#define PG8_STAGE(bufoff, gbase, voff) do { _Pragma("unroll") for (int _i = 0; _i < 2; ++_i) \
        __builtin_amdgcn_global_load_lds((const unsigned*)((const char*)(gbase) + (voff)[_i]), (LAS unsigned*)(lds + (bufoff) + ldsw + _i * 8192), 16, 0, 0); } while (0)
#define PG8_LDA(dst, b, h) do { _Pragma("unroll") for (int m = 0; m < 4; ++m) _Pragma("unroll") for (int k = 0; k < 2; ++k) dst[m][k] = *(const LAS bf16x8*)(lds + PG8_SA(b, h) + aoff + m * 2048 + k * 1024); } while (0)
#define PG8_LDB(dst, b, h) do { _Pragma("unroll") for (int n = 0; n < 2; ++n) _Pragma("unroll") for (int k = 0; k < 2; ++k) dst[n][k] = *(const LAS bf16x8*)(lds + PG8_SB(b, h) + boff + n * 2048 + k * 1024); } while (0)
#define PG8_MMA(ai, bj, At, Bt, Z) do { __builtin_amdgcn_s_setprio(1); \
        if constexpr (FP8) { if (Epi::ZEROC && (Z)) { _Pragma("unroll") for (int m = 0; m < 4; ++m) _Pragma("unroll") for (int n = 0; n < 2; ++n) { \
            const v8i b8_ = __builtin_shufflevector(__builtin_bit_cast(v4i, Bt[n][0]), __builtin_bit_cast(v4i, Bt[n][1]), 0, 1, 2, 3, 4, 5, 6, 7); \
            const v8i a8_ = __builtin_shufflevector(__builtin_bit_cast(v4i, At[m][0]), __builtin_bit_cast(v4i, At[m][1]), 0, 1, 2, 3, 4, 5, 6, 7); \
            asm volatile("v_mfma_f32_16x16x128_f8f6f4 %0, %1, %2, 0" : "+v"(acc[ai][bj][m][n]) : "v"(b8_), "v"(a8_)); } }   \
          else { _Pragma("unroll") for (int m = 0; m < 4; ++m) _Pragma("unroll") for (int n = 0; n < 2; ++n) { \
            const v8i b8_ = __builtin_shufflevector(__builtin_bit_cast(v4i, Bt[n][0]), __builtin_bit_cast(v4i, Bt[n][1]), 0, 1, 2, 3, 4, 5, 6, 7); \
            const v8i a8_ = __builtin_shufflevector(__builtin_bit_cast(v4i, At[m][0]), __builtin_bit_cast(v4i, At[m][1]), 0, 1, 2, 3, 4, 5, 6, 7); \
            asm volatile("v_mfma_f32_16x16x128_f8f6f4 %0, %1, %2, %0" : "+v"(acc[ai][bj][m][n]) : "v"(b8_), "v"(a8_)); } } } \
        else { _Pragma("unroll") for (int m = 0; m < 4; ++m) _Pragma("unroll") for (int n = 0; n < 2; ++n) _Pragma("unroll") for (int k = 0; k < 2; ++k) \
            acc[ai][bj][m][n] = __builtin_amdgcn_mfma_f32_16x16x32_bf16(Bt[n][k], At[m][k], acc[ai][bj][m][n], 0, 0, 0); } \
        __builtin_amdgcn_s_setprio(0); } while (0)
#define PG8_WAIT_V(n) asm volatile("s_waitcnt vmcnt(" #n ")" ::: "memory")
#define PG8_WAIT_L(n) asm volatile("s_waitcnt lgkmcnt(" #n ")" ::: "memory")
#define PG8_BAR __builtin_amdgcn_s_barrier()
#define PG8_SCHED __builtin_amdgcn_sched_barrier(0)
#define PG8_CALC_VG(VG, U) do { _Pragma("unroll") for (int _h = 0; _h < 2; ++_h) _Pragma("unroll") for (int _i = 0; _i < 2; ++_i) { \
        const unsigned _row = (unsigned)((U).pm * BM + _h * HALF + Rr[_i]); const unsigned _src = GATHER ? g.rowsrc[_row] : _row; \
        if constexpr (ABLK) { const unsigned _r = (unsigned)(_h * HALF + Rr[_i]), _c = (unsigned)Cc[_i] >> 3; \
            VG[_h][_i] = (unsigned)(U).pm * (unsigned)(Kb * BM) + (_r >> 4) * 2048u + (_c >> 1) * 512u + (_r & 15u) * 32u + (_c & 1u) * 16u; } \
        else VG[_h][_i] = _src * (unsigned)Kb + (unsigned)Cc[_i] * 2u; } } while (0)
    Unit cur, nxt; int ui = 0;
    if (!S.next(0, cur)) return;
    f32x4 acc[2][2][4][2];
    if constexpr (!(FP8 && Epi::ZEROC)) {
#pragma unroll
    for (int a = 0; a < 2; ++a)
#pragma unroll
        for (int b = 0; b < 2; ++b)
#pragma unroll
            for (int m = 0; m < 4; ++m)
#pragma unroll
                for (int n = 0; n < 2; ++n) acc[a][b][m][n] = (f32x4){0.f, 0.f, 0.f, 0.f};
    }
    bf16x8 At[4][2], B0[2][2], B1[2][2];
    unsigned vg[2][2], vgn[2][2];
    PG8_CALC_VG(vg, cur);
    const char* const gA = g.A;
    const char* cB = g.Bt + (size_t)(cur.pm / g.nMe) * g.b_estride + (size_t)cur.pn * tstep;
    PG8_STAGE(PG8_SB(0, 0), cB, voffB); PG8_STAGE(PG8_SB(0, 1), cB + hstep, voffB); PG8_STAGE(PG8_SA(0, 0), gA, vg[0]); PG8_STAGE(PG8_SA(0, 1), gA, vg[1]);
    if (wr == 1) PG8_BAR;
    PG8_WAIT_V(2); PG8_BAR;
    PG8_STAGE(PG8_SB(1, 0), cB + kstep, voffB); PG8_STAGE(PG8_SA(1, 0), gA + kstepA, vg[0]); PG8_STAGE(PG8_SB(1, 1), cB + hstep + kstep, voffB);
    PG8_WAIT_V(6); PG8_BAR;
    for (;;) {
        const bool has_next = S.next(ui + 1, nxt);
        LAS unsigned char* const rsb = lds + 131072 + ((ui + 1) & 1) * 1024;
        if (has_next) {
            if constexpr (GATHER) { if (wid == 0) __builtin_amdgcn_global_load_lds((const unsigned*)(g.rowsrc + (size_t)nxt.pm * BM) + lane * 4, (LAS unsigned*)rsb, 16, 0, 0); }
            else { PG8_CALC_VG(vgn, nxt); } }
        else {
#pragma unroll
            for (int _h = 0; _h < 2; ++_h)
#pragma unroll
                for (int _i = 0; _i < 2; ++_i) vgn[_h][_i] = vg[_h][_i]; }
        const char* nB = has_next ? g.Bt + (size_t)(nxt.pm / g.nMe) * g.b_estride + (size_t)nxt.pn * tstep : cB;
        for (int t = 0; t < nt; t += 2) {
            const bool last = (t == nt - 2);
            const char* a1 = gA + (size_t)(t + 1) * kstepA;
            const char* a2 = last ? gA : gA + (size_t)(t + 2) * kstepA; const char* b2 = last ? nB : cB + (size_t)(t + 2) * kstep;
            const char* a3 = a2 + kstepA; const char* b3 = b2 + kstep;
            if constexpr (GATHER) { if (last && has_next) {
#pragma unroll
                for (int _h = 0; _h < 2; ++_h)
#pragma unroll
                    for (int _i = 0; _i < 2; ++_i) vgn[_h][_i] = *(const LAS unsigned*)(rsb + (_h * HALF + Rr[_i]) * 4) * (unsigned)Kb + (unsigned)Cc[_i] * 2u; } }
            unsigned w0[2], w1[2];
#pragma unroll
            for (int _i = 0; _i < 2; ++_i) { w0[_i] = last ? vgn[0][_i] : vg[0][_i]; w1[_i] = last ? vgn[1][_i] : vg[1][_i]; }
            PG8_LDB(B0, 0, 0); PG8_LDB(B1, 0, 1); PG8_SCHED; PG8_LDA(At, 0, 0); PG8_STAGE(PG8_SA(1, 1), a1, vg[1]);
            PG8_WAIT_V(8); PG8_WAIT_L(0); PG8_BAR; PG8_MMA(0, 0, At, B0, t == 0); PG8_MMA(0, 1, At, B1, t == 0); PG8_BAR; PG8_SCHED;
            PG8_LDA(At, 0, 1); PG8_STAGE(PG8_SB(0, 0), b2, voffB); PG8_STAGE(PG8_SB(0, 1), b2 + hstep, voffB); PG8_STAGE(PG8_SA(0, 0), a2, w0);
            PG8_WAIT_V(8); PG8_WAIT_L(0); PG8_BAR; PG8_MMA(1, 0, At, B0, t == 0); PG8_MMA(1, 1, At, B1, t == 0); PG8_BAR; PG8_SCHED;
            PG8_LDB(B0, 1, 0); PG8_LDB(B1, 1, 1); PG8_SCHED; PG8_LDA(At, 1, 0); PG8_STAGE(PG8_SA(0, 1), a2, w1);
            PG8_WAIT_V(8); PG8_WAIT_L(0); PG8_BAR; PG8_MMA(0, 0, At, B0, false); PG8_MMA(0, 1, At, B1, false); PG8_BAR; PG8_SCHED;
            PG8_LDA(At, 1, 1); PG8_STAGE(PG8_SB(1, 0), b3, voffB); PG8_STAGE(PG8_SB(1, 1), b3 + hstep, voffB); PG8_STAGE(PG8_SA(1, 0), a3, w0);
            PG8_WAIT_V(8); PG8_WAIT_L(0); PG8_BAR; PG8_MMA(1, 0, At, B0, false); PG8_MMA(1, 1, At, B1, false); PG8_BAR; PG8_SCHED;
        }
        if constexpr (ALIGN_EPI) { if (wr == 0) PG8_BAR; }
        if constexpr (FP8) asm volatile("s_nop 15\n\ts_nop 15" ::: "memory");
        E(acc, cur, wr, wc, fr, fq);
        if (!has_next) break;
        if constexpr (!(FP8 && Epi::ZEROC)) {
#pragma unroll
        for (int a = 0; a < 2; ++a)
#pragma unroll
            for (int b = 0; b < 2; ++b)
#pragma unroll
                for (int m = 0; m < 4; ++m)
#pragma unroll
                    for (int n = 0; n < 2; ++n) acc[a][b][m][n] = (f32x4){0.f, 0.f, 0.f, 0.f};
        }
        cur = nxt; cB = nB; ++ui;
#pragma unroll
        for (int _h = 0; _h < 2; ++_h)
#pragma unroll
            for (int _i = 0; _i < 2; ++_i) vg[_h][_i] = vgn[_h][_i];
        if constexpr (ALIGN_EPI) { if (wr == 1) PG8_BAR; }
    }
    PG8_WAIT_V(0);
    if constexpr (!ALIGN_EPI) { if (wr == 0) PG8_BAR; }
    PG8_BAR;
#undef PG8_SA
#undef PG8_SB
#undef PG8_STAGE
#undef PG8_LDA
#undef PG8_LDB
#undef PG8_MMA
#undef PG8_WAIT_V
#undef PG8_WAIT_L
#undef PG8_BAR
#undef PG8_SCHED
#undef PG8_CALC_VG
}

struct EpiInProj {
    static constexpr bool PERM = false; static constexpr bool ZEROC = false;
    bf16_t* O; int ldc; int q_tiles; int rope_tiles; const float* tab; float osc; int v_tile0; bf16_t* Q;
    __device__ __forceinline__ void operator()(const f32x4 (&acc)[2][2][4][2], const Unit& u, int wr, int wc, int fr, int fq) const {
        const int row0 = u.pm * BM + wr * 64 + fr, col0 = u.pn * BM + wc * 32 + 4 * fq;
        const float sc = ((u.pn < q_tiles) ? C2 : 1.f) * osc;
        const bool rope = (u.pn < rope_tiles) && (u.pm < MX / BM);
        const int axis = wc & 1; const bool isv = u.pn >= v_tile0;
#pragma unroll
        for (int ai = 0; ai < 2; ++ai)
#pragma unroll
            for (int m = 0; m < 4; ++m) {
                const int row = row0 + ai * HALF + m * 16;
                f32x4 cs = {1.f, 1.f, 1.f, 1.f}, sn = {0.f, 0.f, 0.f, 0.f};
                if (rope) { const int t = row & (SEQ - 1); const int pos = axis ? (t & 63) : (t >> 6); cs = *(const f32x4*)(tab + TAB_COS + pos * 16 + 4 * fq); sn = *(const f32x4*)(tab + TAB_SIN + pos * 16 + 4 * fq); }
                bf16_t* rowp = O + (size_t)row * ldc + col0;
                bf16_t* rowq = (u.pn < q_tiles) ? Q + ((size_t)(row >> 5) * 16 + 4 * u.pn + (wc >> 1)) * 2048 + (2 * (wc & 1) + (fq >> 1)) * 512 + (fq & 1) * 256 + (row & 31) * 8
                                                : O + (size_t)row * ldc + u.pn * BM + wc * 32 + 8 * fq;
                const int qstep = (u.pn < q_tiles) ? 2 * 2048 : HALF;
#pragma unroll
                for (int bj = 0; bj < 2; ++bj) {
                    const f32x4 x1 = acc[ai][bj][m][0] * sc, x2 = acc[ai][bj][m][1] * sc;
                    const f32x4 o1 = x1 * cs - x2 * sn, o2 = x2 * cs + x1 * sn;
                    u32x2 w1, w2; w1.x = cvtpk(o1[0], o1[1]); w1.y = cvtpk(o1[2], o1[3]); w2.x = cvtpk(o2[0], o2[1]); w2.y = cvtpk(o2[2], o2[3]);
                    if (isv) { *(u32x2*)(rowp + bj * HALF) = w1; *(u32x2*)(rowp + bj * HALF + 16) = w2; }
                    else *(u32x4*)(rowq + bj * qstep) = (u32x4){w1.x, w1.y, w2.x, w2.y}; }
            }
    }
};
struct EpiOutProj {
    static constexpr bool PERM = true; static constexpr bool ZEROC = false;
    bf16_t* P; const float* mod; float osc;
    __device__ __forceinline__ void operator()(const f32x4 (&acc)[2][2][4][2], const Unit& u, int wr, int wc, int fr, int fq) const {
        const int b = (u.pm < MX / BM) ? ((u.pm * BM) >> 12) : 16;
        const int row0 = u.pm * BM + wr * 64 + fr, col0 = u.pn * BM + wc * 32 + 8 * fq;
        const float* gp = mod + (size_t)b * 6144 + 2 * DM + col0;
        f32x4 gv[2][2];
#pragma unroll
        for (int bj = 0; bj < 2; ++bj)
#pragma unroll
            for (int n = 0; n < 2; ++n) gv[bj][n] = *(const f32x4*)(gp + bj * HALF + 4 * n) * osc;
#pragma unroll
        for (int ai = 0; ai < 2; ++ai)
#pragma unroll
            for (int m = 0; m < 4; ++m) { bf16_t* rowp = P + (size_t)(row0 + ai * HALF + m * 16) * DM + col0;
                u32x4 xr[2]; xr[0] = *(const u32x4*)rowp; xr[1] = *(const u32x4*)(rowp + HALF);
#pragma unroll
                for (int bj = 0; bj < 2; ++bj) { const f32x4 v0 = acc[ai][bj][m][0] * gv[bj][0], v1 = acc[ai][bj][m][1] * gv[bj][1]; const u32x4 x = xr[bj];
                    u32x4 w; w.x = cvtpk(v0[0] + __builtin_bit_cast(float, x.x << 16), v0[1] + __builtin_bit_cast(float, x.x & 0xffff0000u));
                    w.y = cvtpk(v0[2] + __builtin_bit_cast(float, x.y << 16), v0[3] + __builtin_bit_cast(float, x.y & 0xffff0000u));
                    w.z = cvtpk(v1[0] + __builtin_bit_cast(float, x.z << 16), v1[1] + __builtin_bit_cast(float, x.z & 0xffff0000u));
                    w.w = cvtpk(v1[2] + __builtin_bit_cast(float, x.w << 16), v1[3] + __builtin_bit_cast(float, x.w & 0xffff0000u));
                    *(u32x4*)(rowp + bj * HALF) = w; } }
    }
};
template <bool NOSTORE = false> struct EpiSwiglu {
    static constexpr bool PERM = true; static constexpr bool ZEROC = true;
    unsigned char* O; float in_scale; float out_scale;
    __device__ __forceinline__ void operator()(const f32x4 (&acc)[2][2][4][2], const Unit& u, int wr, int wc, int fr, int fq) const {
        const int row0 = u.pm * BM + wr * 64 + fr, col0 = u.pn * HALF + wc * 32 + 8 * fq;
#pragma unroll
        for (int ai = 0; ai < 2; ++ai)
#pragma unroll
            for (int m = 0; m < 4; ++m) { unsigned char* rowp = O + ((size_t)u.pm * 16 + u.pn) * 32768 + (8 * ai + 4 * wr + m) * 2048 + wc * 512 + fr * 32 + fq * 8;
                float h[8];
                const float c1 = -LOG2E * in_scale, c2i = 1.f / (in_scale * in_scale * out_scale);
#pragma unroll
                for (int n = 0; n < 2; ++n)
#pragma unroll
                    for (int j = 0; j < 4; j += 2) { const f32x2 ag = {acc[ai][0][m][n][j], acc[ai][0][m][n][j + 1]}, au = {acc[ai][1][m][n][j], acc[ai][1][m][n][j + 1]};
                        const f32x2 ea = ag * c1; f32x2 t; t.x = __builtin_amdgcn_exp2f(ea.x); t.y = __builtin_amdgcn_exp2f(ea.y);
                        const f32x2 d = __builtin_elementwise_fma(t, (f32x2){c2i, c2i}, (f32x2){c2i, c2i}); f32x2 r; r.x = __builtin_amdgcn_rcpf(d.x); r.y = __builtin_amdgcn_rcpf(d.y);
                        const f32x2 hv = (ag * au) * r; h[n * 4 + j] = hv.x; h[n * 4 + j + 1] = hv.y; }
                int w0 = 0, w1 = 0;
                w0 = __builtin_amdgcn_cvt_pk_fp8_f32(h[0], h[1], w0, false); w0 = __builtin_amdgcn_cvt_pk_fp8_f32(h[2], h[3], w0, true);
                w1 = __builtin_amdgcn_cvt_pk_fp8_f32(h[4], h[5], w1, false); w1 = __builtin_amdgcn_cvt_pk_fp8_f32(h[6], h[7], w1, true);
                if (NOSTORE) asm volatile("" :: "v"(w0), "v"(w1)); else *(u32x2*)rowp = (u32x2){(unsigned)w0, (unsigned)w1}; }
    }
};
struct EpiBf16 {
    static constexpr bool PERM = true; static constexpr bool ZEROC = true;
    bf16_t* O; int ldc; float sc;
    __device__ __forceinline__ void operator()(const f32x4 (&acc)[2][2][4][2], const Unit& u, int wr, int wc, int fr, int fq) const {
        const int row0 = u.pm * BM + wr * 64 + fr, col0 = u.pn * BM + wc * 32 + 8 * fq;
#pragma unroll
        for (int ai = 0; ai < 2; ++ai)
#pragma unroll
            for (int m = 0; m < 4; ++m) { bf16_t* rowp = O + (size_t)(row0 + ai * HALF + m * 16) * ldc + col0;
#pragma unroll
                for (int bj = 0; bj < 2; ++bj) { const f32x4 v0 = acc[ai][bj][m][0] * sc, v1 = acc[ai][bj][m][1] * sc;
                    u32x4 w; w.x = cvtpk(v0[0], v0[1]); w.y = cvtpk(v0[2], v0[3]); w.z = cvtpk(v1[0], v1[1]); w.w = cvtpk(v1[2], v1[3]);
                    *(u32x4*)(rowp + bj * HALF) = w; } }
    }
};
}

namespace att {
#define SBAR() __builtin_amdgcn_sched_barrier(0)
__device__ __forceinline__ int crow(int r, int hi) { return (r & 3) + 8 * (r >> 2) + 4 * hi; }
__device__ __forceinline__ void glds16(const void* gsrc, unsigned lds_dst) { unsigned keep;
    asm volatile("s_mov_b32 %0, m0\n\ts_mov_b32 m0, %2\n\ts_nop 0\n\tglobal_load_lds_dwordx4 %1, off\n\ts_mov_b32 m0, %0" : "=&s"(keep) : "v"(gsrc), "s"(lds_dst) : "memory"); }
#define WAIT_BAR0() asm volatile("s_waitcnt vmcnt(0) lgkmcnt(0)\n\ts_barrier" ::: "memory")
typedef LAS const char* lds_cptr;
typedef short v4i16_t __attribute__((ext_vector_type(4)));
__device__ __forceinline__ s16x4 vtr(lds_cptr p) { return __builtin_bit_cast(s16x4, __builtin_amdgcn_ds_read_tr16_b64_v4i16((LAS v4i16_t*)p)); }
__device__ __forceinline__ float hmax(float m) { auto rr = __builtin_amdgcn_permlane32_swap(__float_as_uint(m), __float_as_uint(m), false, false); return fmaxf(__uint_as_float(rr[0]), __uint_as_float(rr[1])); }
__device__ __forceinline__ float hsum(float m) { auto rr = __builtin_amdgcn_permlane32_swap(__float_as_uint(m), __float_as_uint(m), false, false); return __uint_as_float(rr[0]) + __uint_as_float(rr[1]); }

__device__ __forceinline__ void qkt(f32x16& p0, f32x16& p1, lds_cptr kb, const bf16x8 (&qr)[4]) {
    p0 = f32x16{}; p1 = f32x16{};
#pragma unroll
    for (int d0 = 0; d0 < 4; ++d0) {
        const bf16x8 b0 = *(const LAS bf16x8*)(kb + d0 * 2048), b1 = *(const LAS bf16x8*)(kb + d0 * 2048 + 512);
        p0 = __builtin_amdgcn_mfma_f32_32x32x16_bf16(b0, qr[d0], p0, 0, 0, 0);
        p1 = __builtin_amdgcn_mfma_f32_32x32x16_bf16(b1, qr[d0], p1, 0, 0, 0); }
}
template <int ND>
__device__ __forceinline__ void softmax_pv(f32x16& p0, f32x16& p1, f32x16 (&oT)[ND], float& m, float& l, lds_cptr vp) {
    float rm = p0[0];
#pragma unroll
    for (int r = 1; r < 16; ++r) rm = fmaxf(rm, p0[r]);
#pragma unroll
    for (int r = 0; r < 16; ++r) rm = fmaxf(rm, p1[r]);
    rm = hmax(rm);
    const float mn = fmaxf(m, rm);
    const float alpha = __builtin_amdgcn_exp2f(m - mn);
    m = mn;
    float s = 0.f;
#pragma unroll
    for (int r = 0; r < 16; ++r) { p0[r] = __builtin_amdgcn_exp2f(p0[r] - mn); p1[r] = __builtin_amdgcn_exp2f(p1[r] - mn); s += p0[r] + p1[r]; }
    l = l * alpha + s;
#pragma unroll
    for (int d = 0; d < ND; ++d) oT[d] = oT[d] * alpha;
    u32x4 pw[4];
#pragma unroll
    for (int k = 0; k < 2; ++k) {
        pw[k]     = (u32x4){cvtpk(p0[8 * k], p0[8 * k + 1]), cvtpk(p0[8 * k + 2], p0[8 * k + 3]), cvtpk(p0[8 * k + 4], p0[8 * k + 5]), cvtpk(p0[8 * k + 6], p0[8 * k + 7])};
        pw[2 + k] = (u32x4){cvtpk(p1[8 * k], p1[8 * k + 1]), cvtpk(p1[8 * k + 2], p1[8 * k + 3]), cvtpk(p1[8 * k + 4], p1[8 * k + 5]), cvtpk(p1[8 * k + 6], p1[8 * k + 7])}; }
#pragma unroll
    for (int d = 0; d < ND; ++d)
#pragma unroll
        for (int ks = 0; ks < 4; ++ks) {
            const s16x4 lo = vtr(vp + d * 4096 + ks * 1024), hi = vtr(vp + d * 4096 + ks * 1024 + 512);
            const bf16x8 vf = (bf16x8){lo[0], lo[1], lo[2], lo[3], hi[0], hi[1], hi[2], hi[3]};
            oT[d] = __builtin_amdgcn_mfma_f32_32x32x16_bf16(vf, __builtin_bit_cast(bf16x8, pw[ks]), oT[d], 0, 0, 0); }
}
template <int ND>
__device__ __forceinline__ void stg_flush(const LAS unsigned char* stg, bf16_t* ybase, int lane) {
    constexpr int RB = ND * 64 + 16, CPR = ND * 4;
#pragma unroll
    for (int i = 0; i < 32 * CPR / 64; ++i) { const int idx = i * 64 + lane, row = idx / CPR, ch = idx % CPR;
        const u32x4 v = *(const LAS u32x4*)(stg + row * RB + ch * 16); *(u32x4*)(ybase + (size_t)row * DM + ch * 8) = v; }
}
template <int ROWB>
__device__ __forceinline__ void stg_flush_bytes(const LAS unsigned char* stg, unsigned char* ybase, size_t ystride, int lane) {
    constexpr int RB = ROWB + 16, CPR = ROWB / 16;
#pragma unroll
    for (int i = 0; i < 32 * CPR / 64; ++i) { const int idx = i * 64 + lane, row = idx / CPR, ch = idx % CPR;
        const u32x4 v = *(const LAS u32x4*)(stg + row * RB + ch * 16); *(u32x4*)(ybase + (size_t)row * ystride + ch * 16) = v; }
}
template <int ND>
__device__ __forceinline__ void store_oT(const f32x16 (&oT)[ND], float scale, bf16_t* ybase, size_t elem_off, int hi) {
    if (OUTPROJ_FP8) { unsigned char* orow = (unsigned char*)ybase + elem_off; const float sc8 = scale * Y_SCALE;
#pragma unroll
        for (int d = 0; d < ND; ++d)
#pragma unroll
            for (int g = 0; g < 4; ++g) { int t = 0; t = __builtin_amdgcn_cvt_pk_fp8_f32(oT[d][4 * g] * sc8, oT[d][4 * g + 1] * sc8, t, false); t = __builtin_amdgcn_cvt_pk_fp8_f32(oT[d][4 * g + 2] * sc8, oT[d][4 * g + 3] * sc8, t, true);
                *(unsigned*)(orow + d * 32 + 8 * g + 4 * hi) = (unsigned)t; } }
    else { bf16_t* orow = ybase + elem_off;
#pragma unroll
        for (int d = 0; d < ND; ++d)
#pragma unroll
            for (int g = 0; g < 4; ++g) { u32x2 w; w.x = cvtpk(oT[d][4 * g] * scale, oT[d][4 * g + 1] * scale); w.y = cvtpk(oT[d][4 * g + 2] * scale, oT[d][4 * g + 3] * scale);
                *(u32x2*)(orow + d * 32 + 8 * g + 4 * hi) = w; } }
}
constexpr int NA_BIAS_OFF = 65536;
struct DiffArgs { const bf16_t* qkv; bf16_t* y; const float* subln_g; float lam; float omli; int with_ctx; const bf16_t* q; };

#define DF_THR 8.0f
#define DF_BAR()   asm volatile("s_waitcnt lgkmcnt(0)\n\ts_barrier" ::: "memory")
#define DF_BARV()  asm volatile("s_waitcnt vmcnt(0) lgkmcnt(0)\n\ts_barrier" ::: "memory")
__device__ __forceinline__ void diff_phase2(LAS unsigned char* lds, const DiffArgs A, int vcu, int G) {
    int tid = threadIdx.x; asm volatile("" : "+v"(tid));
    const int lane = tid & 63, r32 = lane & 31, hi = lane >> 5; const int wid = __builtin_amdgcn_readfirstlane(tid >> 6);
    constexpr int P = 3072;
    const unsigned lds0 = (unsigned)(uintptr_t)lds;
    const lds_cptr l3 = (lds_cptr)lds;
    const int mp = wid >> 2, qsub = wid & 3;
    LAS float* xch = (LAS float*)lds + qsub * 4096 + lane;
    const int nmain = NB * 8 * 32, nunits = nmain + (A.with_ctx ? NB * 8 * 2 : 0);
    for (int u = vcu; u < nunits; u += G) {
        int b, h, qrow0, NT; const bool ctxu = u >= nmain;
        if (!ctxu) { const int qb = u & 31; h = (u >> 5) & 7; b = u >> 8; qrow0 = b * SEQ + 128 * qb + 32 * qsub; NT = 4 + 64; }
        else { const int v = u - nmain; const int qb = v & 1; h = (v >> 1) & 7; b = v >> 4; qrow0 = MX + b * CTXL + 128 * qb + 32 * qsub; NT = 4; }
        const bf16_t* Kc = A.qkv + (size_t)(MX + b * CTXL) * P + 1024 + 128 * h;
        const bf16_t* Kx = A.qkv + (size_t)(b * SEQ) * P + 1024 + 128 * h;
        const int krow = 8 * wid + (lane >> 3); const size_t koff = (size_t)krow * P + (((lane & 7) ^ ((krow >> 1) & 7)) * 8);
        const int pv0 = 2 * wid, pv1 = 2 * wid + 1;
        const int vra = 4 * pv0 + (lane >> 4), vrb = 4 * pv1 + (lane >> 4); const int vph = lane & 15;
        const size_t voffa = (size_t)vra * P + 1024 + ((((vph >> 2) ^ (vra & 3)) << 2) | (vph & 3)) * 8;
        const size_t voffb = (size_t)vrb * P + 1024 + ((((vph >> 2) ^ (vrb & 3)) << 2) | (vph & 3)) * 8;
#define DF_DMA(t) do { if ((t) < NT) { const int slot_ = (t) % 3; const bf16_t* base_ = ((t) < 4) ? Kc + (size_t)(t) * 64 * P : Kx + (size_t)((t) - 4) * 64 * P; \
        glds16(base_ + koff,      (unsigned)__builtin_amdgcn_readfirstlane(lds0 + slot_ * 32768 + wid * 1024)); \
        glds16(base_ + koff + 64, (unsigned)__builtin_amdgcn_readfirstlane(lds0 + slot_ * 32768 + 8192 + wid * 1024)); \
        glds16(base_ + voffa,     (unsigned)__builtin_amdgcn_readfirstlane(lds0 + slot_ * 32768 + 16384 + pv0 * 1024)); \
        glds16(base_ + voffb,     (unsigned)__builtin_amdgcn_readfirstlane(lds0 + slot_ * 32768 + 16384 + pv1 * 1024)); } } while (0)
        DF_DMA(0);
        bf16x8 qr[4];
        { const bf16_t* Qw = A.qkv + (size_t)(qrow0 + r32) * P + h * 128 + mp * 64;
#pragma unroll
          for (int d0 = 0; d0 < 4; ++d0) qr[d0] = *(const bf16x8*)(Qw + d0 * 16 + hi * 8); }
        f32x16 oT[4]; oT[0] = f32x16{}; oT[1] = f32x16{}; oT[2] = f32x16{}; oT[3] = f32x16{};
        float m = 0.f, l = 0.f;
        f32x16 p0, p1; u32x4 pw[4];
        const int ksw = (r32 >> 1) & 7; const lds_cptr kp0 = l3 + mp * 8192 + r32 * 128 + ((hi ^ (ksw & 1)) << 4); const int ks2 = ksw >> 1;
        const int vq = (lane & 15) >> 2; const lds_cptr vp0 = l3 + 16384 + (4 * hi + vq) * 256 + ((lane >> 4) & 1) * 32 + (lane & 3) * 8;
#define DF_LOADV(dst, vp_, d) do { const lds_cptr vd_ = (vp_) + (((d) ^ vq) << 6); _Pragma("unroll") for (int ks = 0; ks < 4; ++ks) { const s16x4 lo_ = vtr(vd_ + ks * 4096), hi_ = vtr(vd_ + ks * 4096 + 2048); \
            dst[ks] = (bf16x8){lo_[0], lo_[1], lo_[2], lo_[3], hi_[0], hi_[1], hi_[2], hi_[3]}; } } while (0)
#define DF_PV4(src, d) do { _Pragma("unroll") for (int ks = 0; ks < 4; ++ks) oT[d] = __builtin_amdgcn_mfma_f32_32x32x16_bf16(src[ks], __builtin_bit_cast(bf16x8, pw[ks]), oT[d], 0, 0, 0); } while (0)
#define DF_LOADK(dst, kb_, dd) do { dst[0] = *(const LAS bf16x8*)((kb_) + ((((dd)) ^ ks2) << 5)); dst[1] = *(const LAS bf16x8*)((kb_) + ((((dd)) ^ ks2) << 5) + 4096); \
            dst[2] = *(const LAS bf16x8*)((kb_) + ((((dd) + 1) ^ ks2) << 5)); dst[3] = *(const LAS bf16x8*)((kb_) + ((((dd) + 1) ^ ks2) << 5) + 4096); } while (0)
#define DF_QK4(src, dd) do { p0 = __builtin_amdgcn_mfma_f32_32x32x16_bf16(src[0], qr[dd], p0, 0, 0, 0); p1 = __builtin_amdgcn_mfma_f32_32x32x16_bf16(src[1], qr[dd], p1, 0, 0, 0); \
            p0 = __builtin_amdgcn_mfma_f32_32x32x16_bf16(src[2], qr[(dd) + 1], p0, 0, 0, 0); p1 = __builtin_amdgcn_mfma_f32_32x32x16_bf16(src[3], qr[(dd) + 1], p1, 0, 0, 0); } while (0)
#define DF_PREV(vso) do { const lds_cptr vq_ = vp0 + (vso); DF_LOADV(fa, vq_, 0); DF_LOADV(fb, vq_, 1); SBAR(); } while (0)
#define DF_PINIT() do { _Pragma("unroll") for (int r = 0; r < 16; ++r) { p0[r] = -m; p1[r] = -m; } } while (0)
#define DF_SEGM(DO_PV, DO_QK, vso, kso) do { const lds_cptr vp_ = vp0 + (vso); const lds_cptr kb_ = kp0 + (kso); SBAR(); __builtin_amdgcn_s_setprio(1); \
        if (DO_PV) { DF_PV4(fa, 0); SBAR(); DF_LOADV(fa, vp_, 2); SBAR(); \
            DF_PV4(fb, 1); SBAR(); DF_LOADV(fb, vp_, 3); if (DO_QK) { DF_PINIT(); } SBAR(); \
            DF_PV4(fa, 2); SBAR(); if (DO_QK) { DF_LOADK(fa, kb_, 0); } SBAR(); \
            DF_PV4(fb, 3); SBAR(); if (DO_QK) { DF_LOADK(fb, kb_, 2); } SBAR(); } \
        else if (DO_QK) { DF_LOADK(fa, kb_, 0); DF_LOADK(fb, kb_, 2); DF_PINIT(); SBAR(); } \
        if (DO_QK) { DF_QK4(fa, 0); SBAR(); DF_QK4(fb, 2); SBAR(); } \
        __builtin_amdgcn_s_setprio(0); } while (0)
#define DF_SEGV(t) do { \
        float rm = p0[0]; \
        _Pragma("unroll") for (int r = 1; r < 16; ++r) rm = fmaxf(rm, p0[r]); \
        _Pragma("unroll") for (int r = 0; r < 16; ++r) rm = fmaxf(rm, p1[r]); \
        rm = hmax(rm); \
        if ((t) == 0 || __any(rm > DF_THR)) { const float dl = ((t) == 0) ? rm : fmaxf(rm, 0.f); m += dl; \
            _Pragma("unroll") for (int r = 0; r < 16; ++r) { p0[r] -= dl; p1[r] -= dl; } \
            const float f = __builtin_amdgcn_exp2f(-dl); l *= f; \
            _Pragma("unroll") for (int d = 0; d < 4; ++d) oT[d] = oT[d] * f; } \
        float s_ = 0.f; \
        _Pragma("unroll") for (int r = 0; r < 16; ++r) { p0[r] = __builtin_amdgcn_exp2f(p0[r]); p1[r] = __builtin_amdgcn_exp2f(p1[r]); s_ += p0[r] + p1[r]; } \
        l += s_; \
        _Pragma("unroll") for (int k = 0; k < 2; ++k) { \
            pw[k]     = (u32x4){cvtpk(p0[8 * k], p0[8 * k + 1]), cvtpk(p0[8 * k + 2], p0[8 * k + 3]), cvtpk(p0[8 * k + 4], p0[8 * k + 5]), cvtpk(p0[8 * k + 6], p0[8 * k + 7])}; \
            pw[2 + k] = (u32x4){cvtpk(p1[8 * k], p1[8 * k + 1]), cvtpk(p1[8 * k + 2], p1[8 * k + 3]), cvtpk(p1[8 * k + 4], p1[8 * k + 5]), cvtpk(p1[8 * k + 6], p1[8 * k + 7])}; } \
        } while (0)
        DF_BARV();
        int so_p = 0, so_c = 0;
#define DF_ROT() do { so_p = so_c; so_c = (so_c == 65536) ? 0 : so_c + 32768; } while (0)
        bf16x8 fa[4], fb[4];
        if (mp == 0) {
            DF_DMA(1); DF_SEGM(false, true, 0, so_c); SBAR(); DF_PREV(so_c); DF_SEGV(0); SBAR(); DF_BARV(); SBAR();
            for (int t = 1; t < NT; ++t) { DF_ROT();
                DF_DMA(t + 1); DF_SEGM(true, true, so_p, so_c); SBAR(); DF_PREV(so_c); DF_SEGV(t); SBAR(); DF_BARV(); SBAR(); }
            DF_ROT();
            DF_SEGM(true, false, so_p, 0); SBAR(); DF_BARV(); SBAR();
        } else {
            DF_DMA(1); DF_SEGM(false, true, 0, so_c); SBAR(); DF_BARV(); SBAR();
            for (int t = 1; t < NT; ++t) { DF_ROT();
                DF_DMA(t + 1); DF_PREV(so_p); DF_SEGV(t - 1); SBAR(); DF_SEGM(true, true, so_p, so_c); SBAR(); DF_BARV(); SBAR(); }
            DF_ROT();
            DF_PREV(so_p); DF_SEGV(NT - 1); SBAR(); DF_SEGM(true, false, so_p, 0); SBAR(); DF_BARV(); SBAR();
        }
#undef DF_ROT
        l = hsum(l);
        const float il = 1.f / l;
        if (mp == 1) { const float sc = il * A.lam;
#pragma unroll
            for (int d = 0; d < 4; ++d)
#pragma unroll
                for (int q = 0; q < 16; ++q) xch[(d * 16 + q) * 64] = oT[d][q] * sc; }
        DF_BARV();
        if (mp == 0) {
            float ss = 0.f;
#pragma unroll
            for (int d = 0; d < 4; ++d)
#pragma unroll
                for (int q = 0; q < 16; ++q) { const float v = oT[d][q] * il - xch[(d * 16 + q) * 64]; oT[d][q] = v; ss += v * v; }
            ss = hsum(ss);
            const float rstd = rsqrtf(ss * (1.f / 128.f) + RMS_EPS) * A.omli;
            const size_t eo = (size_t)(qrow0 + r32) * DM + h * 128;
#pragma unroll
            for (int d = 0; d < 4; ++d)
#pragma unroll
                for (int g = 0; g < 4; ++g) { const f32x4 gg = *(const f32x4*)(A.subln_g + d * 32 + 8 * g + 4 * hi);
                    if (OUTPROJ_FP8) { const float r8 = rstd * Y_SCALE; int t = 0; t = __builtin_amdgcn_cvt_pk_fp8_f32(oT[d][4 * g] * r8 * gg[0], oT[d][4 * g + 1] * r8 * gg[1], t, false);
                        t = __builtin_amdgcn_cvt_pk_fp8_f32(oT[d][4 * g + 2] * r8 * gg[2], oT[d][4 * g + 3] * r8 * gg[3], t, true);
                        *(unsigned*)((unsigned char*)A.y + eo + d * 32 + 8 * g + 4 * hi) = (unsigned)t; }
                    else { u32x2 w; w.x = cvtpk(oT[d][4 * g] * rstd * gg[0], oT[d][4 * g + 1] * rstd * gg[1]); w.y = cvtpk(oT[d][4 * g + 2] * rstd * gg[2], oT[d][4 * g + 3] * rstd * gg[3]);
                        *(u32x2*)(A.y + eo + d * 32 + 8 * g + 4 * hi) = w; } }
        }
        DF_BAR();
#undef DF_DMA
#undef DF_SEGM
#undef DF_SEGV
#undef DF_PINIT
#undef DF_PREV
#undef DF_LOADV
#undef DF_PV4
#undef DF_LOADK
#undef DF_QK4
    }
}

#define D3_PIN(x) asm volatile("" : "+v"(x))
#define D3_EX(v) __builtin_amdgcn_exp2f(v)
__device__ __forceinline__ void diff_phase3(LAS unsigned char* lds, const DiffArgs A, int vcu, int G) {
    int tid = threadIdx.x; asm volatile("" : "+v"(tid));
    const int lane = tid & 63, r32 = lane & 31, hi = lane >> 5; const int wid = __builtin_amdgcn_readfirstlane(tid >> 6);
    constexpr int P = 3072;
    const unsigned lds0 = (unsigned)(uintptr_t)lds;
    const lds_cptr l3 = (lds_cptr)lds;
    const int mp = wid >> 2, qsub = wid & 3;
    const int nmain = NB * 8 * 32, nunits = nmain + (A.with_ctx ? NB * 8 * 2 : 0);
    for (int u = vcu; u < nunits; u += G) {
        int b, h, qrow0, NT; const bool ctxu = u >= nmain;
        if (!ctxu) { const int qb = u & 31; h = (u >> 5) & 7; b = u >> 8; qrow0 = b * SEQ + 128 * qb + 32 * qsub; NT = 4 + 64; }
        else { const int v = u - nmain; const int qb = v & 1; h = (v >> 1) & 7; b = v >> 4; qrow0 = MX + b * CTXL + 128 * qb + 32 * qsub; NT = 4; }
        const bf16_t* Kc = A.qkv + (size_t)(MX + b * CTXL) * P + 1024 + 128 * h;
        const bf16_t* Kx = A.qkv + (size_t)(b * SEQ) * P + 1024 + 128 * h;
        const int kra = 16 * qsub + (lane >> 3), krb = kra + 8; const int vr0 = 16 * qsub + (lane >> 4); const int vph = lane & 15;
        const unsigned d0 = mp ? (unsigned)vr0 * P + 1024 + ((((vph >> 2) ^ (vr0 & 3)) << 2) | (vph & 3)) * 8 : (unsigned)kra * P + (((lane & 7) ^ ((kra >> 1) & 7)) * 8);
        const unsigned d1 = mp ? d0 + 4 * P : (unsigned)krb * P + (((lane & 7) ^ ((krb >> 1) & 7)) * 8);
        const unsigned inc2 = mp ? 8 * P : 64;
        const unsigned e0 = lds0 + (mp ? 32768 + qsub * 4096 : qsub * 2048), e2 = e0 + (mp ? 2048 : 8192);
#define D3_DMA(t) do { const int t_ = (t); if (t_ < NT) { const bf16_t* base_ = (t_ < 4) ? Kc + (size_t)t_ * 64 * P : Kx + (size_t)(t_ - 4) * 64 * P; \
        const unsigned so_ = (mp ? (t_ & 3) : (t_ & 1)) * 16384; \
        glds16(base_ + d0,        (unsigned)__builtin_amdgcn_readfirstlane(e0 + so_)); \
        glds16(base_ + d1,        (unsigned)__builtin_amdgcn_readfirstlane(e0 + so_ + 1024)); \
        glds16(base_ + d0 + inc2, (unsigned)__builtin_amdgcn_readfirstlane(e2 + so_)); \
        glds16(base_ + d1 + inc2, (unsigned)__builtin_amdgcn_readfirstlane(e2 + so_ + 1024)); } } while (0)
#define D3_WAITBAR(T) do { if (mp == 0 || (T) + 1 >= NT) DF_BARV(); else asm volatile("s_waitcnt vmcnt(4) lgkmcnt(0)\n\ts_barrier" ::: "memory"); } while (0)
        D3_DMA(0);
        bf16x8 qr[4];
        { const bf16_t* Qw = A.q + ((size_t)(qrow0 >> 5) * 16 + 2 * h + mp) * 2048 + hi * 256 + r32 * 8;
#pragma unroll
          for (int d0 = 0; d0 < 4; ++d0) qr[d0] = *(const bf16x8*)(Qw + d0 * 512); }
        f32x16 oT[4]; oT[0] = f32x16{}; oT[1] = f32x16{}; oT[2] = f32x16{}; oT[3] = f32x16{};
        f32x16 negm;
        float m = 0.f, l = 0.f, rf = 1.f; bool resc = false;
        f32x16 pA0, pA1, pB0, pB1; u32x4 pw0, pw1, pw2, pw3;
        const int ksw = (r32 >> 1) & 7; const lds_cptr kp0 = l3 + mp * 8192 + r32 * 128 + ((hi ^ (ksw & 1)) << 4); const int ks2 = ksw >> 1;
        const int vq = (lane & 15) >> 2; const lds_cptr vp0 = l3 + 32768 + (4 * hi + vq) * 256 + ((lane >> 4) & 1) * 32 + (lane & 3) * 8;
#define D3_KF(kb_, g) (*(const LAS bf16x8*)((kb_) + (((((g) >> 1)) ^ ks2) << 5) + ((g) & 1) * 4096))
#define D3_VF(vp_, g) ({ const lds_cptr vd_ = (vp_) + (((((g) >> 2)) ^ vq) << 6) + ((g) & 3) * 4096; const s16x4 lo_ = vtr(vd_), hi_ = vtr(vd_ + 2048); (bf16x8){lo_[0], lo_[1], lo_[2], lo_[3], hi_[0], hi_[1], hi_[2], hi_[3]}; })
#define D3_PK(P, B) cvtpk(P[B], P[(B) + 1])
#define D3_KSEL(g) (((g) & 1) ? kf1 : kf0)
#define D3_GA(g, C0, C1, Q0, Q1, HASQK, HASVA, FIRST) do { \
        if (HASQK) { \
            if ((g) == 0) { if (FIRST) C0 = __builtin_amdgcn_mfma_f32_32x32x16_bf16(D3_KSEL(g), qr[0], f32x16{}, 0, 0, 0); else C0 = __builtin_amdgcn_mfma_f32_32x32x16_bf16(D3_KSEL(g), qr[0], negm, 0, 0, 0); } \
            else if ((g) == 1) { if (FIRST) C1 = __builtin_amdgcn_mfma_f32_32x32x16_bf16(D3_KSEL(g), qr[0], f32x16{}, 0, 0, 0); else C1 = __builtin_amdgcn_mfma_f32_32x32x16_bf16(D3_KSEL(g), qr[0], negm, 0, 0, 0); } \
            else if ((g) & 1) C1 = __builtin_amdgcn_mfma_f32_32x32x16_bf16(D3_KSEL(g), qr[(g) >> 1], C1, 0, 0, 0); else C0 = __builtin_amdgcn_mfma_f32_32x32x16_bf16(D3_KSEL(g), qr[(g) >> 1], C0, 0, 0, 0); \
            if ((g) + 2 < 8) { if ((g) & 1) kf1 = D3_KF(kb_, (g) + 2); else kf0 = D3_KF(kb_, (g) + 2); } } \
        if (HASVA) { if ((g) == 6) vf0 = D3_VF(vp_, 0); if ((g) == 7) vf1 = D3_VF(vp_, 1); } \
        if (HASVA) { if ((g) < 5) { Q1[5 + 2 * (g)] = D3_EX(Q1[5 + 2 * (g)]); Q1[6 + 2 * (g)] = D3_EX(Q1[6 + 2 * (g)]); } if ((g) == 5) { Q1[15] = D3_EX(Q1[15]); } \
            if ((g) == 0) { pw0[0] = D3_PK(Q0, 0); pw0[1] = D3_PK(Q0, 2); } if ((g) == 1) { pw0[2] = D3_PK(Q0, 4); pw0[3] = D3_PK(Q0, 6); D3_PIN(pw0); } \
            if ((g) == 2) { pw1[0] = D3_PK(Q0, 8); pw1[1] = D3_PK(Q0, 10); } if ((g) == 3) { pw1[2] = D3_PK(Q0, 12); pw1[3] = D3_PK(Q0, 14); D3_PIN(pw1); } \
            if ((g) == 4) { pw2[0] = D3_PK(Q1, 0); pw2[1] = D3_PK(Q1, 2); } if ((g) == 5) { pw2[2] = D3_PK(Q1, 4); pw2[3] = D3_PK(Q1, 6); D3_PIN(pw2); } \
            if ((g) == 6) { pw3[0] = D3_PK(Q1, 8); pw3[1] = D3_PK(Q1, 10); } if ((g) == 7) { pw3[2] = D3_PK(Q1, 12); pw3[3] = D3_PK(Q1, 14); D3_PIN(pw3); } \
            } \
        SBAR(); } while (0)
#define D3_PWSEL(g) (((g) & 3) == 0 ? pw0 : ((g) & 3) == 1 ? pw1 : ((g) & 3) == 2 ? pw2 : pw3)
#define D3_EXI(C0, C1, e) do { if ((e) < 16) C0[(e) & 15] = D3_EX(C0[(e) & 15]); else C1[(e) & 15] = D3_EX(C1[(e) & 15]); } while (0)
#define D3_GB(g, C0, C1, Q0, Q1, HASPV, HASVB, FIRST) do { \
        if (HASPV) { \
            oT[(g) >> 2] = __builtin_amdgcn_mfma_f32_32x32x16_bf16(((g) & 1) ? vf1 : vf0, __builtin_bit_cast(bf16x8, D3_PWSEL(g)), oT[(g) >> 2], 0, 0, 0); \
            if ((g) + 2 < 16) { if ((g) & 1) vf1 = D3_VF(vp_, (g) + 2); else vf0 = D3_VF(vp_, (g) + 2); } } \
        if (HASPV) { if ((g) < 4) { sacc += Q0[4 * ((g) & 3)]; sacc += Q0[4 * ((g) & 3) + 1]; sacc += Q0[4 * ((g) & 3) + 2]; sacc += Q0[4 * ((g) & 3) + 3]; D3_PIN(sacc); } \
            else if ((g) < 8) { sacc += Q1[4 * ((g) & 3)]; sacc += Q1[4 * ((g) & 3) + 1]; sacc += Q1[4 * ((g) & 3) + 2]; sacc += Q1[4 * ((g) & 3) + 3]; D3_PIN(sacc); } \
            else if ((g) == 8) { l += sacc; } } \
        if (HASVB) { if ((g) < 4) { rmx = fmaxf(fmaxf(rmx, C0[4 * ((g) & 3)]), C0[4 * ((g) & 3) + 1]); rmx = fmaxf(fmaxf(rmx, C0[4 * ((g) & 3) + 2]), C0[4 * ((g) & 3) + 3]); D3_PIN(rmx); } \
            else if ((g) < 8) { rmx = fmaxf(fmaxf(rmx, C1[4 * ((g) & 3)]), C1[4 * ((g) & 3) + 1]); rmx = fmaxf(fmaxf(rmx, C1[4 * ((g) & 3) + 2]), C1[4 * ((g) & 3) + 3]); D3_PIN(rmx); } \
            else if ((g) == 8) { rmx = hmax(rmx); resc = false; \
                if (FIRST || __any(rmx > DF_THR)) { const float dl = FIRST ? rmx : fmaxf(rmx, 0.f); m += dl; \
                    _Pragma("unroll") for (int r_ = 0; r_ < 16; ++r_) { C0[r_] -= dl; C1[r_] -= dl; negm[r_] = -m; } D3_PIN(negm); \
                    rf = D3_EX(-dl); l *= rf; resc = true; } } \
            else { const int e0_ = 3 * ((g) - 9);   \
                D3_EXI(C0, C1, e0_); D3_EXI(C0, C1, e0_ + 1); D3_EXI(C0, C1, e0_ + 2); if (e0_ + 2 < 16) D3_PIN(C0); else D3_PIN(C1); } } \
        SBAR(); } while (0)
#define D3_STEP(C0, C1, Q0, Q1, HASQK, HASPREV, FIRST, T) do { \
        const lds_cptr kb_ = kp0 + ((T) & 1) * 16384; const lds_cptr vp_ = vp0 + (((T) - 1) & 3) * 16384; bf16x8 kf0, kf1, vf0, vf1; float sacc = 0.f, rmx = -3.0e38f; \
        if (HASQK) D3_DMA((T) + 1); \
        SBAR(); if (HASQK) { kf0 = D3_KF(kb_, 0); kf1 = D3_KF(kb_, 1); } \
        D3_GA(0, C0, C1, Q0, Q1, HASQK, HASPREV, FIRST); D3_GA(1, C0, C1, Q0, Q1, HASQK, HASPREV, FIRST); D3_GA(2, C0, C1, Q0, Q1, HASQK, HASPREV, FIRST); D3_GA(3, C0, C1, Q0, Q1, HASQK, HASPREV, FIRST); \
        D3_GA(4, C0, C1, Q0, Q1, HASQK, HASPREV, FIRST); D3_GA(5, C0, C1, Q0, Q1, HASQK, HASPREV, FIRST); D3_GA(6, C0, C1, Q0, Q1, HASQK, HASPREV, FIRST); D3_GA(7, C0, C1, Q0, Q1, HASQK, HASPREV, FIRST); \
        if (HASQK) { if (mp == 1) D3_WAITBAR(T); } \
        D3_GB(0, C0, C1, Q0, Q1, HASPREV, HASQK, FIRST); D3_GB(1, C0, C1, Q0, Q1, HASPREV, HASQK, FIRST); D3_GB(2, C0, C1, Q0, Q1, HASPREV, HASQK, FIRST); D3_GB(3, C0, C1, Q0, Q1, HASPREV, HASQK, FIRST); \
        D3_GB(4, C0, C1, Q0, Q1, HASPREV, HASQK, FIRST); D3_GB(5, C0, C1, Q0, Q1, HASPREV, HASQK, FIRST); D3_GB(6, C0, C1, Q0, Q1, HASPREV, HASQK, FIRST); D3_GB(7, C0, C1, Q0, Q1, HASPREV, HASQK, FIRST); \
        D3_GB(8, C0, C1, Q0, Q1, HASPREV, HASQK, FIRST); D3_GB(9, C0, C1, Q0, Q1, HASPREV, HASQK, FIRST); D3_GB(10, C0, C1, Q0, Q1, HASPREV, HASQK, FIRST); D3_GB(11, C0, C1, Q0, Q1, HASPREV, HASQK, FIRST); \
        D3_GB(12, C0, C1, Q0, Q1, HASPREV, HASQK, FIRST); D3_GB(13, C0, C1, Q0, Q1, HASPREV, HASQK, FIRST); D3_GB(14, C0, C1, Q0, Q1, HASPREV, HASQK, FIRST); D3_GB(15, C0, C1, Q0, Q1, HASPREV, HASQK, FIRST); \
        if (HASQK && resc) { _Pragma("unroll") for (int d_ = 0; d_ < 4; ++d_) oT[d_] = oT[d_] * rf; } \
        if (HASQK) { if (mp == 0) D3_WAITBAR(T); } \
        } while (0)
        DF_BARV();
        D3_STEP(pA0, pA1, pB0, pB1, true, false, true, 0);
        int t = 1;
        for (; t + 1 < NT; t += 2) {
            D3_STEP(pB0, pB1, pA0, pA1, true, true, false, t);
            D3_STEP(pA0, pA1, pB0, pB1, true, true, false, t + 1);
        }
        D3_STEP(pB0, pB1, pA0, pA1, true, true, false, t);
        D3_STEP(pA0, pA1, pB0, pB1, false, true, false, NT);
        l = hsum(l);
        const float il = 1.f / l;
        DF_BAR();
        LAS float* xch = (LAS float*)lds + qsub * 4096 + lane;
        if (mp == 1) { const float sc = il * A.lam;
#pragma unroll
            for (int d = 0; d < 4; ++d)
#pragma unroll
                for (int q = 0; q < 16; ++q) xch[(d * 16 + q) * 64] = oT[d][q] * sc; }
        DF_BAR();
        if (mp == 0) {
            float ss = 0.f;
#pragma unroll
            for (int d = 0; d < 4; ++d)
#pragma unroll
                for (int q = 0; q < 16; ++q) { const float v = oT[d][q] * il - xch[(d * 16 + q) * 64]; oT[d][q] = v; ss += v * v; }
            ss = hsum(ss);
            const float rstd = rsqrtf(ss * (1.f / 128.f) + RMS_EPS) * A.omli;
            LAS unsigned char* stg = lds + qsub * 16384;
#pragma unroll
            for (int d = 0; d < 4; ++d)
#pragma unroll
                for (int g = 0; g < 4; ++g) { const f32x4 gg = *(const f32x4*)(A.subln_g + d * 32 + 8 * g + 4 * hi);
                    if (OUTPROJ_FP8) { const float r8 = rstd * Y_SCALE; int t = 0; t = __builtin_amdgcn_cvt_pk_fp8_f32(oT[d][4 * g] * r8 * gg[0], oT[d][4 * g + 1] * r8 * gg[1], t, false);
                        t = __builtin_amdgcn_cvt_pk_fp8_f32(oT[d][4 * g + 2] * r8 * gg[2], oT[d][4 * g + 3] * r8 * gg[3], t, true); *(LAS unsigned*)(stg + r32 * 144 + d * 32 + 8 * g + 4 * hi) = (unsigned)t; }
                    else { u32x2 w; w.x = cvtpk(oT[d][4 * g] * rstd * gg[0], oT[d][4 * g + 1] * rstd * gg[1]); w.y = cvtpk(oT[d][4 * g + 2] * rstd * gg[2], oT[d][4 * g + 3] * rstd * gg[3]);
                        *(LAS u32x2*)(stg + r32 * 272 + (d * 32 + 8 * g + 4 * hi) * 2) = w; } }
            if (OUTPROJ_FP8) stg_flush_bytes<128>(stg, (unsigned char*)A.y + (size_t)qrow0 * DM + h * 128, DM, lane);
            else stg_flush<4>(stg, A.y + (size_t)qrow0 * DM + h * 128, lane);
        }
        DF_BAR();
#undef D3_DMA
#undef D3_KF
#undef D3_KSEL
#undef D3_VF
#undef D3_PK
#undef D3_GA
#undef D3_GB
#undef D3_EXI
#undef D3_PWSEL
#undef D3_STEP
#undef D3_WAITBAR
    }
}

struct A2Args { const bf16_t* qkv; bf16_t* y; const float* aux; int with_ctx; const bf16_t* q; };
template <int MODE  >
__device__ __forceinline__ void att2_phase(LAS unsigned char* lds, const A2Args A, int vcu, int G) {
    int tid = threadIdx.x; asm volatile("" : "+v"(tid));
    const int lane = tid & 63, r32 = lane & 31, hi = lane >> 5; const int wid = __builtin_amdgcn_readfirstlane(tid >> 6);
    constexpr int P = MODE == 0 ? 1536 : 3072; constexpr int VOFF = MODE == 0 ? 256 : 1024;
    const unsigned lds0 = (unsigned)(uintptr_t)lds;
    const lds_cptr l3 = (lds_cptr)lds;
    const int grp = wid >> 2;
    LAS float* btab = (LAS float*)(lds + NA_BIAS_OFF + 1024);
    const int nmain = MODE == 0 ? NB * 4 * 32 * 2 : NB * 16 * 16;
    const int nunits = nmain + (A.with_ctx ? (MODE == 0 ? NB * 4 * 4 : NB * 16) : 0);
    for (int u = vcu; u < nunits; u += G) {
        int b, hk, hq, qrow0, nwin, k0win; const bool ctxu = u >= nmain; int qs = 0, r = 0, c = 0;
        if (MODE == 0) {
            if (!ctxu) { const int jj = u & 63; hk = (u >> 6) & 3; b = u >> 8; hq = 4 * hk + (wid >> 1); qs = 64 * jj + 32 * (wid & 1); qrow0 = b * SEQ + qs;
                const int ks = max(0, 64 * jj - 128), ke = min(SEQ, 64 * jj + 192); k0win = ks; nwin = (ke - ks) / 64; }
            else { const int v = u - nmain; hk = (v >> 2) & 3; hq = 4 * hk + (v & 3); b = v >> 4; qrow0 = MX + b * CTXL + 32 * wid; nwin = 0; k0win = 0; }
        } else {
            if (!ctxu) { const int uu = u & 15; hk = hq = (u >> 4) & 15; b = u >> 8; r = 4 * uu + (wid >> 1); c = 32 * (wid & 1) + r32; qrow0 = b * SEQ + r * 64 + 32 * (wid & 1);
                const int rs_lo = min(max(4 * uu - 4, 0), 56), rs_hi = min(max(4 * uu + 3 - 4, 0), 56); k0win = rs_lo * 64; nwin = rs_hi + 8 - rs_lo; }
            else { const int v = u - nmain; hk = hq = v & 15; b = v >> 4; qrow0 = MX + b * CTXL + 32 * wid; nwin = 0; k0win = 0; }
        }
        const int NT = 4 + nwin;
        const bf16_t* Kc = A.qkv + (size_t)(MX + b * CTXL) * P + 1024 + 64 * hk;
        const bf16_t* Kx = A.qkv + (size_t)(b * SEQ + k0win) * P + 1024 + 64 * hk;
        const int krow = 8 * wid + (lane >> 3); const size_t koff = (size_t)krow * P + (((lane & 7) ^ ((krow >> 1) & 7)) * 8), voff = (size_t)krow * P + VOFF + (((lane & 7) ^ (((krow >> 1) & 1) << 2)) * 8);
#define A2_DMA(t) do { if ((t) < NT) { const int slot_ = (t) % 3; const bf16_t* base_ = ((t) < 4) ? Kc + (size_t)(t) * 64 * P : Kx + (size_t)((t) - 4) * 64 * P; \
        glds16(base_ + koff, (unsigned)__builtin_amdgcn_readfirstlane(lds0 + slot_ * 16384 + wid * 1024)); \
        glds16(base_ + voff, (unsigned)__builtin_amdgcn_readfirstlane(lds0 + slot_ * 16384 + 8192 + wid * 1024)); } } while (0)
        A2_DMA(0);
        if (MODE == 1) { if (!ctxu && tid < 15 * 31) btab[tid] = A.aux[hq * 465 + tid] * LOG2E; }
        bf16x8 qr[4];
        { const bf16_t* Qw = A.q + ((size_t)(qrow0 >> 5) * 16 + hq) * 2048 + hi * 256 + r32 * 8;
#pragma unroll
          for (int d0 = 0; d0 < 4; ++d0) qr[d0] = *(const bf16x8*)(Qw + d0 * 512); }
        f32x16 oT[2]; oT[0] = f32x16{}; oT[1] = f32x16{};
        float m = 0.f, l = 0.f;
        f32x16 p0, p1; u32x4 pw[4];
        const int ksw = (r32 >> 1) & 7; const lds_cptr kp0 = l3 + r32 * 128 + ((hi ^ (ksw & 1)) << 4); const int ks2 = ksw >> 1;
        const int vq = (lane & 15) >> 2, vsq = (vq >> 1) & 1; const lds_cptr vp0 = l3 + 8192 + (4 * hi + vq) * 128 + ((lane >> 4) & 1) * 32 + (lane & 3) * 8;
        const int rs = min(max(r - 4, 0), 56), cs = min(max(c - 8, 0), 48);
#define A2_LOADV(dst, vp_, d) do { const lds_cptr vd_ = (vp_) + (((d) ^ vsq) << 6); _Pragma("unroll") for (int ks = 0; ks < 4; ++ks) { const s16x4 lo_ = vtr(vd_ + ks * 2048), hi_ = vtr(vd_ + ks * 2048 + 1024); \
            dst[ks] = (bf16x8){lo_[0], lo_[1], lo_[2], lo_[3], hi_[0], hi_[1], hi_[2], hi_[3]}; } } while (0)
#define A2_PV4(src, d) do { _Pragma("unroll") for (int ks = 0; ks < 4; ++ks) oT[d] = __builtin_amdgcn_mfma_f32_32x32x16_bf16(src[ks], __builtin_bit_cast(bf16x8, pw[ks]), oT[d], 0, 0, 0); } while (0)
#define A2_LOADK(dst, kb_, dd) do { dst[0] = *(const LAS bf16x8*)((kb_) + ((((dd)) ^ ks2) << 5)); dst[1] = *(const LAS bf16x8*)((kb_) + ((((dd)) ^ ks2) << 5) + 4096); \
            dst[2] = *(const LAS bf16x8*)((kb_) + ((((dd) + 1) ^ ks2) << 5)); dst[3] = *(const LAS bf16x8*)((kb_) + ((((dd) + 1) ^ ks2) << 5) + 4096); } while (0)
#define A2_QK4(src, dd) do { p0 = __builtin_amdgcn_mfma_f32_32x32x16_bf16(src[0], qr[dd], p0, 0, 0, 0); p1 = __builtin_amdgcn_mfma_f32_32x32x16_bf16(src[1], qr[dd], p1, 0, 0, 0); \
            p0 = __builtin_amdgcn_mfma_f32_32x32x16_bf16(src[2], qr[(dd) + 1], p0, 0, 0, 0); p1 = __builtin_amdgcn_mfma_f32_32x32x16_bf16(src[3], qr[(dd) + 1], p1, 0, 0, 0); } while (0)
#define A2_PREV(vso) do { const lds_cptr vq_ = vp0 + (vso); A2_LOADV(fa, vq_, 0); A2_LOADV(fb, vq_, 1); SBAR(); } while (0)
#define A2_PINIT() do { _Pragma("unroll") for (int q_ = 0; q_ < 16; ++q_) { p0[q_] = -m; p1[q_] = -m; } } while (0)
#define A2_SEGM(DO_PV, DO_QK, vso, kso) do { const lds_cptr kb_ = kp0 + (kso); SBAR(); __builtin_amdgcn_s_setprio(1); \
        if (DO_PV) { A2_PV4(fa, 0); if (DO_QK) { A2_PINIT(); } SBAR(); if (DO_QK) { A2_LOADK(fa, kb_, 0); } SBAR(); A2_PV4(fb, 1); SBAR(); if (DO_QK) { A2_LOADK(fb, kb_, 2); } SBAR(); } \
        else if (DO_QK) { A2_LOADK(fa, kb_, 0); A2_LOADK(fb, kb_, 2); A2_PINIT(); SBAR(); } \
        if (DO_QK) { A2_QK4(fa, 0); SBAR(); A2_QK4(fb, 2); SBAR(); } \
        __builtin_amdgcn_s_setprio(0); } while (0)
#define A2_SEGV(t) do { \
        if ((t) >= 4) { \
            if (MODE == 0) { const int kb0_ = k0win + 64 * ((t) - 4); if ((kb0_ + 63 > qs + 128) || (kb0_ < qs + 31 - 128)) { const int dq_ = kb0_ + 4 * hi - (qs + r32) + 128; \
                _Pragma("unroll") for (int q_ = 0; q_ < 16; ++q_) { const int kk_ = (q_ & 3) + 8 * (q_ >> 2); if ((unsigned)(dq_ + kk_) > 256u) p0[q_] = NEG_BIG; if ((unsigned)(dq_ + kk_ + 32) > 256u) p1[q_] = NEG_BIG; } } } \
            else { const int kr_ = (k0win >> 6) + (t) - 4; const bool rowok_ = (kr_ >= rs) && (kr_ < rs + 8); const int rel_ = rowok_ ? 4 * hi - cs : 1000; const LAS float* bp_ = btab + (rowok_ ? kr_ - r + 7 : 0) * 31 + 4 * hi - c + 15; \
                _Pragma("unroll") for (int q_ = 0; q_ < 16; ++q_) { const int kk_ = (q_ & 3) + 8 * (q_ >> 2); const float b0_ = bp_[kk_], b1_ = bp_[kk_ + 32]; \
                    p0[q_] = ((unsigned)(rel_ + kk_) < 16u) ? p0[q_] + b0_ : NEG_BIG; p1[q_] = ((unsigned)(rel_ + kk_ + 32) < 16u) ? p1[q_] + b1_ : NEG_BIG; } } } \
        float rm = p0[0]; \
        _Pragma("unroll") for (int q_ = 1; q_ < 16; ++q_) rm = fmaxf(rm, p0[q_]); \
        _Pragma("unroll") for (int q_ = 0; q_ < 16; ++q_) rm = fmaxf(rm, p1[q_]); \
        rm = hmax(rm); \
        if ((t) == 0 || __any(rm > DF_THR)) { const float dl = ((t) == 0) ? rm : fmaxf(rm, 0.f); m += dl; \
            _Pragma("unroll") for (int q_ = 0; q_ < 16; ++q_) { p0[q_] -= dl; p1[q_] -= dl; } \
            const float f = __builtin_amdgcn_exp2f(-dl); l *= f; oT[0] = oT[0] * f; oT[1] = oT[1] * f; } \
        float s_ = 0.f; \
        _Pragma("unroll") for (int q_ = 0; q_ < 16; ++q_) { p0[q_] = __builtin_amdgcn_exp2f(p0[q_]); p1[q_] = __builtin_amdgcn_exp2f(p1[q_]); s_ += p0[q_] + p1[q_]; } \
        l += s_; \
        _Pragma("unroll") for (int k = 0; k < 2; ++k) { \
            pw[k]     = (u32x4){cvtpk(p0[8 * k], p0[8 * k + 1]), cvtpk(p0[8 * k + 2], p0[8 * k + 3]), cvtpk(p0[8 * k + 4], p0[8 * k + 5]), cvtpk(p0[8 * k + 6], p0[8 * k + 7])}; \
            pw[2 + k] = (u32x4){cvtpk(p1[8 * k], p1[8 * k + 1]), cvtpk(p1[8 * k + 2], p1[8 * k + 3]), cvtpk(p1[8 * k + 4], p1[8 * k + 5]), cvtpk(p1[8 * k + 6], p1[8 * k + 7])}; } \
        } while (0)
        DF_BARV();
        int so_p = 0, so_c = 0;
#define A2_ROT() do { so_p = so_c; so_c = (so_c == 32768) ? 0 : so_c + 16384; } while (0)
        bf16x8 fa[4], fb[4];
        if (grp == 0) {
            A2_DMA(1); A2_SEGM(false, true, 0, so_c); SBAR(); A2_PREV(so_c); A2_SEGV(0); SBAR(); DF_BARV(); SBAR();
            for (int t = 1; t < NT; ++t) { A2_ROT();
                A2_DMA(t + 1); A2_SEGM(true, true, so_p, so_c); SBAR(); A2_PREV(so_c); A2_SEGV(t); SBAR(); DF_BARV(); SBAR(); }
            A2_ROT();
            A2_SEGM(true, false, so_p, 0); SBAR(); DF_BARV(); SBAR();
        } else {
            A2_DMA(1); A2_SEGM(false, true, 0, so_c); SBAR(); DF_BARV(); SBAR();
            for (int t = 1; t < NT; ++t) { A2_ROT();
                A2_DMA(t + 1); A2_PREV(so_p); A2_SEGV(t - 1); SBAR(); A2_SEGM(true, true, so_p, so_c); SBAR(); DF_BARV(); SBAR(); }
            A2_ROT();
            A2_PREV(so_p); A2_SEGV(NT - 1); SBAR(); A2_SEGM(true, false, so_p, 0); SBAR(); DF_BARV(); SBAR();
        }
        l = hsum(l);
        if (MODE == 0) l += __builtin_amdgcn_exp2f(A.aux[hq] * LOG2E - m);
        if (OUTPROJ_FP8) { LAS unsigned char* stg = lds + wid * 8192; const float sc8 = Y_SCALE / l;
#pragma unroll
            for (int d = 0; d < 2; ++d)
#pragma unroll
                for (int g = 0; g < 4; ++g) { int t = 0; t = __builtin_amdgcn_cvt_pk_fp8_f32(oT[d][4 * g] * sc8, oT[d][4 * g + 1] * sc8, t, false); t = __builtin_amdgcn_cvt_pk_fp8_f32(oT[d][4 * g + 2] * sc8, oT[d][4 * g + 3] * sc8, t, true);
                    *(LAS unsigned*)(stg + r32 * 80 + d * 32 + 8 * g + 4 * hi) = (unsigned)t; }
            stg_flush_bytes<64>(stg, (unsigned char*)A.y + (size_t)qrow0 * DM + hq * 64, DM, lane); }
        else { LAS unsigned char* stg = lds + wid * 8192; const float sc_ = 1.f / l;
#pragma unroll
            for (int d = 0; d < 2; ++d)
#pragma unroll
                for (int g = 0; g < 4; ++g) { u32x2 w; w.x = cvtpk(oT[d][4 * g] * sc_, oT[d][4 * g + 1] * sc_); w.y = cvtpk(oT[d][4 * g + 2] * sc_, oT[d][4 * g + 3] * sc_);
                    *(LAS u32x2*)(stg + r32 * 144 + (d * 32 + 8 * g + 4 * hi) * 2) = w; }
            stg_flush<2>(stg, A.y + (size_t)qrow0 * DM + hq * 64, lane); }
        DF_BAR();
#undef A2_DMA
#undef A2_LOADV
#undef A2_PV4
#undef A2_LOADK
#undef A2_QK4
#undef A2_SEGM
#undef A2_SEGV
#undef A2_PREV
#undef A2_PINIT
#undef A2_ROT
    }
}
#undef SBAR
}

struct Frame {
    LAS unsigned char* lds; volatile LAS unsigned* MISC; unsigned* ctl;
    int tid, lane, wave, vcu, G;
};

__device__ __forceinline__ void transpose_item(const float* W, int K, int N, bf16_t* WT, int k0, int n0, int drow0, LAS float* scr, int lane) {
    f32x4 v[16];
    const float* src = W + (size_t)(k0 + (lane >> 4)) * N + n0 + 4 * (lane & 15);
#pragma unroll
    for (int i = 0; i < 16; ++i) v[i] = *(const f32x4*)(src + (size_t)(4 * i) * N);
#pragma unroll
    for (int i = 0; i < 16; ++i) { LAS float* d = scr + (4 * i + (lane >> 4)) * 65 + 4 * (lane & 15); d[0] = v[i].x; d[1] = v[i].y; d[2] = v[i].z; d[3] = v[i].w; }
    LDS_WAIT(); asm volatile("" ::: "memory");
    const int c = lane & 7;
#pragma unroll
    for (int j = 0; j < 8; ++j) { const int n = (lane >> 3) + 8 * j; const LAS float* s = scr + (8 * c) * 65 + n;
        u32x4 o; o.x = cvtpk(s[0 * 65], s[1 * 65]); o.y = cvtpk(s[2 * 65], s[3 * 65]); o.z = cvtpk(s[4 * 65], s[5 * 65]); o.w = cvtpk(s[6 * 65], s[7 * 65]);
        *(u32x4*)(WT + (size_t)(drow0 + n) * K + k0 + 8 * c) = o; }
    LDS_WAIT(); asm volatile("" ::: "memory");
}

enum { KA_x, KA_c, KA_ctx, KA_c_ctx, KA_ada_w, KA_ada_b, KA_norm1_g, KA_norm2_g, KA_final_g, KA_win_w_in, KA_win_w_out, KA_win_sink, KA_diff_w_in, KA_diff_w_out, KA_diff_lambda, KA_diff_subln_g,
       KA_na_w_in, KA_na_w_out, KA_na_rpb, KA_router_w, KA_w_gate, KA_w_up, KA_w_down, KA_OUT, KA_WS };
__device__ __forceinline__ const float* karg(int i) { asm volatile("" : "+s"(i)); return (const float*)(GAS const float*)(((const unsigned long long __attribute__((address_space(4)))*)__builtin_amdgcn_kernarg_segment_ptr())[i]); }
__device__ __forceinline__ void t8_load(f32x4 (&v)[16], const float* W, int N, int k0, int n0, int lane) {
    const float* src = W + (size_t)(k0 + (lane >> 4)) * N + n0 + 4 * (lane & 15);
#pragma unroll
    for (int i = 0; i < 16; ++i) v[i] = *(const f32x4*)(src + (size_t)(4 * i) * N);
}
__device__ __forceinline__ void t8_finish(const f32x4 (&v)[16], int Kb, unsigned char* WT, int k0, int drow0, LAS float* scr, int lane) {
#pragma unroll
    for (int i = 0; i < 16; ++i) { LAS float* d = scr + (4 * i + (lane >> 4)) * 65 + 4 * (lane & 15); d[0] = v[i].x * W8_SCALE; d[1] = v[i].y * W8_SCALE; d[2] = v[i].z * W8_SCALE; d[3] = v[i].w * W8_SCALE; }
    LDS_WAIT(); asm volatile("" ::: "memory");
    const int c = lane & 3;
#pragma unroll
    for (int j = 0; j < 4; ++j) { const int n = (lane >> 2) + 16 * j; const LAS float* s = scr + (16 * c) * 65 + n;
        int w[4];
#pragma unroll
        for (int q = 0; q < 4; ++q) { int t = 0; t = __builtin_amdgcn_cvt_pk_fp8_f32(s[(4 * q) * 65], s[(4 * q + 1) * 65], t, false); t = __builtin_amdgcn_cvt_pk_fp8_f32(s[(4 * q + 2) * 65], s[(4 * q + 3) * 65], t, true); w[q] = t; }
        *(u32x4*)(WT + (size_t)(drow0 + n) * Kb + k0 + 16 * c) = (u32x4){(unsigned)w[0], (unsigned)w[1], (unsigned)w[2], (unsigned)w[3]}; }
    LDS_WAIT(); asm volatile("" ::: "memory");
}
__device__ __forceinline__ void transpose_item8(const float* W, int Kb, int N, unsigned char* WT, int k0, int n0, int drow0, LAS float* scr, int lane) {
    f32x4 v[16]; t8_load(v, W, N, k0, n0, lane); t8_finish(v, Kb, WT, k0, drow0, scr, lane);
}

struct In {
    const float *x, *c, *ctx, *c_ctx, *ada_w, *ada_b, *norm1_g, *norm2_g, *final_g, *win_w_in, *win_w_out, *win_sink, *diff_w_in, *diff_w_out, *diff_lambda, *diff_subln_g,
        *na_w_in, *na_w_out, *na_rpb, *router_w, *w_gate, *w_up, *w_down;
};

__device__ __forceinline__ void phase_prologue(Frame& F, unsigned char* ws) {
    int tid_ = threadIdx.x; asm volatile("" : "+v"(tid_)); const int lane_ = tid_ & 63; const int wave_ = __builtin_amdgcn_readfirstlane(tid_ >> 6);
    LAS float* scr = (LAS float*)(F.lds + wave_ * 16640);
    const int gw = F.vcu * NWAVES + wave_, NGW = F.G * NWAVES;
    if (F.vcu == 0) {
        float* tab = (float*)(ws + WS_TAB);
        for (int i = tid_; i < 1024; i += 512) { const int pos = i >> 4, f = i & 15; const float inv = 1.0f / powf(10000.0f, (float)(2 * f) / 32.0f); const float ang = (float)pos * inv;
            tab[TAB_COS + i] = cosf(ang); tab[TAB_SIN + i] = sinf(ang); }
        if (wave_ == 0) { const float* lp = karg(KA_diff_lambda); const float a = wave_sum(lp[lane_] * lp[64 + lane_]), b2 = wave_sum(lp[128 + lane_] * lp[192 + lane_]);
            const float li = 0.8f - 0.6f * expf(-0.3f * 1.0f); if (lane_ == 0) { tab[TAB_LAM] = expf(a) - expf(b2) + li; tab[TAB_LAM + 1] = 1.0f - li; } }
    }
    {
        bf16_t* pw = (bf16_t*)(ws + WS_PW);
        constexpr int IT_WI = 16 * 24, IT_O = 16 * 16, IT_3 = 16 * 48;
        constexpr int NIT = 2 * IT_WI + 2 * IT_O + IT_3 + IT_O + IT_3 + IT_O;
        for (int it = gw; it < NIT; it += NGW) {
            int r = it; const float* W; bf16_t* WT; int N;
            if (r < 2 * IT_WI) { const int s = r / IT_WI; r -= s * IT_WI; W = karg(KA_win_w_in) + (size_t)s * 1024 * 1536; WT = pw + (PW_WIN_IN / 2) + (size_t)s * 1536 * 1024; N = 1536; }
            else if ((r -= 2 * IT_WI) < 2 * IT_O) { const int s = r / IT_O; r -= s * IT_O; W = karg(KA_win_w_out) + (size_t)s * 1024 * 1024; WT = pw + (PW_WIN_OUT / 2) + (size_t)s * 1024 * 1024; N = 1024; }
            else if ((r -= 2 * IT_O) < IT_3) { W = karg(KA_diff_w_in); WT = pw + PW_DIFF_IN / 2; N = 3072; }
            else if ((r -= IT_3) < IT_O) { W = karg(KA_diff_w_out); WT = pw + PW_DIFF_OUT / 2; N = 1024; }
            else if ((r -= IT_O) < IT_3) { W = karg(KA_na_w_in); WT = pw + PW_NA_IN / 2; N = 3072; }
            else { r -= IT_3; W = karg(KA_na_w_out); WT = pw + PW_NA_OUT / 2; N = 1024; }
            const int nblk = N / 64, kb = r / nblk, nb = r % nblk;
            if ((INPROJ_FP8 && N != 1024) || (OUTPROJ_FP8 && N == 1024)) transpose_item8(W, 1024, N, (unsigned char*)WT, 64 * kb, 64 * nb, 64 * nb, scr, lane_);
            else transpose_item(W, 1024, N, WT, 64 * kb, 64 * nb, 64 * nb, scr, lane_);
        }
    }
    {
        const int NIT = 64 * 1536;
#define MW_DESC(it_, W_, N_, Kb_, WT_, k0_, n0_, dr_) do { const int le_ = (it_) / 1536; int r_ = (it_) % 1536; \
            unsigned char* W1t_ = ws + WS_MOEW + (size_t)le_ * MOEW_E; \
            if (r_ < 1024) { const bool up_ = r_ >= 512; r_ &= 511; W_ = (up_ ? karg(KA_w_up) : karg(KA_w_gate)) + (size_t)le_ * 1024 * 2048; N_ = 2048; Kb_ = 1024; WT_ = W1t_; \
                k0_ = 64 * (r_ / 32); n0_ = 64 * (r_ % 32); dr_ = (n0_ >> 7) * 256 + (up_ ? 128 : 0) + (n0_ & 127); } \
            else { r_ -= 1024; W_ = karg(KA_w_down) + (size_t)le_ * 2048 * 1024; N_ = 1024; Kb_ = 2048; WT_ = W1t_ + (size_t)4096 * 1024; k0_ = 64 * (r_ / 16); n0_ = 64 * (r_ % 16); dr_ = n0_; } } while (0)
        f32x4 va[16], vb[16];
        const float* Wc = nullptr; int Nc = 0, Kbc = 0, k0c = 0, n0c = 0, drc = 0; unsigned char* WTc = nullptr;
        int it = gw;
        if (it < NIT) { MW_DESC(it, Wc, Nc, Kbc, WTc, k0c, n0c, drc); t8_load(va, Wc, Nc, k0c, n0c, lane_); }
        while (it < NIT) {
            const int itn = it + NGW;
            const float* Wn = Wc; int Nn = Nc, Kbn = Kbc, k0n = k0c, n0n = n0c, drn = drc; unsigned char* WTn = WTc;
            if (itn < NIT) { MW_DESC(itn, Wn, Nn, Kbn, WTn, k0n, n0n, drn); t8_load(vb, Wn, Nn, k0n, n0n, lane_); }
            t8_finish(va, Kbc, WTc, k0c, drc, scr, lane_);
#pragma unroll
            for (int i = 0; i < 16; ++i) va[i] = vb[i];
            Wc = Wn; Nc = Nn; Kbc = Kbn; WTc = WTn; k0c = k0n; n0c = n0n; drc = drn; it = itn;
        }
#undef MW_DESC
    }
    __syncthreads();
    {
        LAS float* sc = (LAS float*)F.lds;
        LAS float* red = (LAS float*)(F.lds + 69632);
        for (int i = tid_; i < 17 * 1024; i += 512) { const float v = (i < 16384) ? karg(KA_c)[i] : karg(KA_c_ctx)[i - 16384]; sc[i] = siluf(v); }
        __syncthreads();
        float* mod = (float*)(ws + WS_MOD);
        for (int task = F.vcu; task < 4 * 192; task += F.G) {
            const int L = task / 192, cg = task % 192, col = cg * 32 + (lane_ & 31), kh = lane_ >> 5;
            const float* wp = karg(KA_ada_w) + (size_t)L * 1024 * 6144 + (size_t)(wave_ * 128 + kh * 64) * 6144 + col;
            const LAS float* scp = sc + wave_ * 128 + kh * 64;
            float acc[17];
#pragma unroll
            for (int r = 0; r < 17; ++r) acc[r] = 0.f;
            for (int k0 = 0; k0 < 64; k0 += 16) { float w[16];
#pragma unroll
                for (int kk = 0; kk < 16; ++kk) w[kk] = wp[(size_t)(k0 + kk) * 6144];
#pragma unroll
                for (int kk = 0; kk < 16; ++kk)
#pragma unroll
                    for (int r = 0; r < 17; ++r) acc[r] += scp[r * 1024 + k0 + kk] * w[kk]; }
#pragma unroll
            for (int r = 0; r < 17; ++r) { acc[r] += __shfl_xor(acc[r], 32); if (lane_ < 32) red[(wave_ * 17 + r) * 32 + lane_] = acc[r]; }
            __syncthreads();
            for (int i = tid_; i < 17 * 32; i += 512) { const int r = i >> 5, ln = i & 31; float sum = 0.f;
#pragma unroll
                for (int w = 0; w < 8; ++w) sum += red[(w * 17 + r) * 32 + ln];
                mod[((size_t)L * 17 + r) * 6144 + cg * 32 + ln] = sum + karg(KA_ada_b)[L * 6144 + cg * 32 + ln]; }
            __syncthreads();
        }
    }
}

__device__ __forceinline__ void load_row(const float* row, int lane, f32x4 (&v)[4]) {
    const f32x4* xr = (const f32x4*)row + lane;
#pragma unroll
    for (int j = 0; j < 4; ++j) v[j] = xr[64 * j];
}
__device__ __forceinline__ void load_row_bf16(const bf16_t* row, int lane, u32x2 (&w)[4]) {
    const u32x2* p = (const u32x2*)row + lane;
#pragma unroll
    for (int j = 0; j < 4; ++j) w[j] = p[64 * j];
}
__device__ __forceinline__ void cvt_row_bf16(f32x4 (&v)[4], const u32x2 (&w)[4]) {
#pragma unroll
    for (int j = 0; j < 4; ++j) { v[j].x = __builtin_bit_cast(float, w[j].x << 16); v[j].y = __builtin_bit_cast(float, w[j].x & 0xffff0000u);
        v[j].z = __builtin_bit_cast(float, w[j].y << 16); v[j].w = __builtin_bit_cast(float, w[j].y & 0xffff0000u); }
}
__device__ __forceinline__ void add_row_bf16(f32x4 (&v)[4], const u32x2 (&w)[4]) {
#pragma unroll
    for (int j = 0; j < 4; ++j) { v[j].x += __builtin_bit_cast(float, w[j].x << 16); v[j].y += __builtin_bit_cast(float, w[j].x & 0xffff0000u);
        v[j].z += __builtin_bit_cast(float, w[j].y << 16); v[j].w += __builtin_bit_cast(float, w[j].y & 0xffff0000u); }
}
__device__ __forceinline__ float row_rstd(const f32x4 (&v)[4]) {
    float s = 0.f;
#pragma unroll
    for (int j = 0; j < 4; ++j) s += (v[j].x * v[j].x + v[j].y * v[j].y) + (v[j].z * v[j].z + v[j].w * v[j].w);
    return rsqrtf(wave_sum_fast(s) * (1.f / DM) + RMS_EPS);
}
__device__ __forceinline__ void store_row_bf16(bf16_t* orow, int lane, const f32x4 (&v)[4]) {
    u32x2* o8 = (u32x2*)orow + lane;
#pragma unroll
    for (int j = 0; j < 4; ++j) { u32x2 w; w.x = cvtpk(v[j].x, v[j].y); w.y = cvtpk(v[j].z, v[j].w); o8[64 * j] = w; }
}
__device__ __forceinline__ void store_row_fp8(unsigned char* orow, int lane, const f32x4 (&v)[4], float scale) {
    unsigned* o4 = (unsigned*)orow + lane;
#pragma unroll
    for (int j = 0; j < 4; ++j) { int t = 0; t = __builtin_amdgcn_cvt_pk_fp8_f32(v[j].x * scale, v[j].y * scale, t, false); t = __builtin_amdgcn_cvt_pk_fp8_f32(v[j].z * scale, v[j].w * scale, t, true); o4[64 * j] = (unsigned)t; }
}
struct ModCache { f32x4 sc[4], sh[4]; int b; };
__device__ __forceinline__ void modcache_load(ModCache& M, int b, const float* g, const float* modL, int shift_chunk, int scale_chunk, int lane) {
    if (M.b == b) return; M.b = b;
    const float* mp = modL + (size_t)b * 6144;
#pragma unroll
    for (int j = 0; j < 4; ++j) { const f32x4 gg = ((const f32x4*)g)[lane + 64 * j], s = ((const f32x4*)(mp + scale_chunk * DM))[lane + 64 * j];
        M.sc[j] = gg * (1.f + s); M.sh[j] = ((const f32x4*)(mp + shift_chunk * DM))[lane + 64 * j]; }
}
__device__ __forceinline__ int row_batch(int m) { return m < MX ? (m >> 12) : 16; }

__device__ __forceinline__ void phase_norm1(Frame& F, const float* x, const float* ctx, const float* g1, const float* modL, bf16_t* H, bf16_t* XB) {
    int tid_ = threadIdx.x; asm volatile("" : "+v"(tid_)); const int lane_ = tid_ & 63; const int wave_ = __builtin_amdgcn_readfirstlane(tid_ >> 6);
    const int gw = F.vcu * NWAVES + wave_, NGW = F.G * NWAVES; const int per = (MT + NGW - 1) / NGW;
    ModCache M; M.b = -1;
    const int m0 = gw * per, m1 = min(MT, m0 + per);
    f32x4 nx[4];
    if (m0 < m1) load_row(m0 < MX ? x + (size_t)m0 * DM : ctx + (size_t)(m0 - MX) * DM, lane_, nx);
    for (int m = m0; m < m1; ++m) {
        f32x4 v[4];
#pragma unroll
        for (int j = 0; j < 4; ++j) v[j] = nx[j];
        if (m + 1 < m1) load_row((m + 1) < MX ? x + (size_t)(m + 1) * DM : ctx + (size_t)(m + 1 - MX) * DM, lane_, nx);
        modcache_load(M, row_batch(m), g1, modL, 0, 1, lane_);
        store_row_bf16(XB + (size_t)m * DM, lane_, v);
        const float rstd = row_rstd(v);
#pragma unroll
        for (int j = 0; j < 4; ++j) v[j] = v[j] * rstd * M.sc[j] + M.sh[j];
        if (INPROJ_FP8) store_row_fp8((unsigned char*)H + (size_t)m * DM, lane_, v, H2_SCALE); else store_row_bf16(H + (size_t)m * DM, lane_, v);
    }
}

__device__ __forceinline__ void phase_norm2_router(Frame& F, const bf16_t* XB, const float* g2, const float* modL, const float* rw, unsigned char* H8, float* aff, int nrows, const bf16_t* P, bool do_router = true) {
    int tid_ = threadIdx.x; asm volatile("" : "+v"(tid_)); const int lane = tid_ & 63; const int wave_ = __builtin_amdgcn_readfirstlane(tid_ >> 6);
    LAS float* rwT = (LAS float*)F.lds;
    for (int i = tid_; i < 16384; i += 512) { const int d = i >> 4, e = i & 15; rwT[e * 1024 + d] = rw[i]; }
    __syncthreads();
    const int gw = F.vcu * NWAVES + wave_, NGW = F.G * NWAVES; constexpr int NR2 = 1; const int ngroups = nrows / NR2; const int per = (ngroups + NGW - 1) / NGW;
    ModCache M; M.b = -1;
    const int g0 = gw * per, g1 = min(ngroups, g0 + per);
    constexpr int ND3 = 3;
    u32x2 nx[ND3][4];
#pragma unroll
    for (int k = 0; k < ND3; ++k) if (g0 + k < g1) { load_row_bf16(XB + (size_t)(g0 + k) * DM, lane, nx[k]); }
    for (int gb = g0; gb < g1; gb += ND3)
#pragma unroll
    for (int k = 0; k < ND3; ++k) {
        const int g = gb + k; if (g >= g1) break;
        const int m = NR2 * g;
        f32x4 v[NR2][4];
        cvt_row_bf16(v[0], nx[k]);
        if (g + ND3 < g1) { load_row_bf16(XB + (size_t)(g + ND3) * DM, lane, nx[k]); }
        modcache_load(M, row_batch(m), g2, modL, 3, 4, lane);
#pragma unroll
        for (int r = 0; r < NR2; ++r) { const float rstd = row_rstd(v[r]);
#pragma unroll
            for (int j = 0; j < 4; ++j) v[r][j] = v[r][j] * rstd * M.sc[j] + M.sh[j];
            store_row_fp8(H8 + (size_t)(m + r) * DM, lane, v[r], H2_SCALE); }
        if (!do_router) continue;
        float pe[NR2][16];
        int lo4 = 4 * lane; asm volatile("" : "+v"(lo4));
#pragma unroll
        for (int eb = 0; eb < 16; eb += 4) {
            f32x4 w[4][4];
#pragma unroll
            for (int e4 = 0; e4 < 4; ++e4)
#pragma unroll
                for (int j = 0; j < 4; ++j) w[e4][j] = *(const LAS f32x4*)(rwT + (eb + e4) * 1024 + lo4 + 256 * j);
            __builtin_amdgcn_sched_barrier(0);
#pragma unroll
            for (int e4 = 0; e4 < 4; ++e4) { f32x2 s2 = {0.f, 0.f};
#pragma unroll
                for (int j = 0; j < 4; ++j) { s2 = __builtin_elementwise_fma((f32x2){v[0][j].x, v[0][j].y}, (f32x2){w[e4][j].x, w[e4][j].y}, s2); s2 = __builtin_elementwise_fma((f32x2){v[0][j].z, v[0][j].w}, (f32x2){w[e4][j].z, w[e4][j].w}, s2); }
                pe[0][eb + e4] = s2.x + s2.y; }
            __builtin_amdgcn_sched_barrier(0);
        }
        {
            LAS float* red = (LAS float*)(F.lds + 65536) + wave_ * 1088;
#pragma unroll
            for (int e = 0; e < 16; ++e) red[lane * 17 + e] = pe[0][e];
            const LAS float* rp = red + (lane >> 4) * 272 + (lane & 15);
            float sacc = 0.f;
#pragma unroll
            for (int i = 0; i < 16; ++i) sacc += rp[i * 17];
            sacc += __shfl_xor(sacc, 16); sacc += __shfl_xor(sacc, 32);
            const float mx = row16_max(sacc);
            const float ex = expf(sacc - mx);
            const float sm = row16_sum(ex);
            if (lane < 16) aff[(size_t)m * 16 + lane] = ex / sm;
        }
    }
    __syncthreads();
}

#define N2_BAR() asm volatile("s_waitcnt lgkmcnt(0)\n\ts_barrier" ::: "memory")
__device__ __forceinline__ void phase_norm2_router_mfma(Frame& F, const bf16_t* XB, const float* g2, const float* modL, const float* rw, unsigned char* H8, float* aff, int nrows) {
    int tid_ = threadIdx.x; asm volatile("" : "+v"(tid_)); const int lane = tid_ & 63; const int wave_ = __builtin_amdgcn_readfirstlane(tid_ >> 6);
    constexpr int AST = 2064;
    LAS unsigned char* Ahi = F.lds; LAS unsigned char* Alo = F.lds + 16 * AST; LAS float* red = (LAS float*)(F.lds + 2 * 16 * AST);
    const int e_ = lane & 15, kg = lane >> 4;
    bf16x8 Bh[4], Bl[4];
#pragma unroll
    for (int s = 0; s < 4; ++s) { const float* wp = rw + (size_t)(128 * wave_ + 32 * s + 8 * kg) * 16 + e_;
        const float x0 = wp[0], x1 = wp[16], x2 = wp[32], x3 = wp[48], x4 = wp[64], x5 = wp[80], x6 = wp[96], x7 = wp[112];
        u32x4 h, l; h.x = cvtpk(x0, x1); h.y = cvtpk(x2, x3); h.z = cvtpk(x4, x5); h.w = cvtpk(x6, x7);
        l.x = cvtpk(x0 - __builtin_bit_cast(float, h.x << 16), x1 - __builtin_bit_cast(float, h.x & 0xffff0000u)); l.y = cvtpk(x2 - __builtin_bit_cast(float, h.y << 16), x3 - __builtin_bit_cast(float, h.y & 0xffff0000u));
        l.z = cvtpk(x4 - __builtin_bit_cast(float, h.z << 16), x5 - __builtin_bit_cast(float, h.z & 0xffff0000u)); l.w = cvtpk(x6 - __builtin_bit_cast(float, h.w << 16), x7 - __builtin_bit_cast(float, h.w & 0xffff0000u));
        Bh[s] = __builtin_bit_cast(bf16x8, h); Bl[s] = __builtin_bit_cast(bf16x8, l); }
    const int ngroups = nrows >> 4; const bool ilv = (F.G == 256); const int per = ilv ? (ngroups >> 8) : (ngroups + F.G - 1) / F.G; const int gg0 = ilv ? 0 : F.vcu * per, gg1 = ilv ? per : min(ngroups, gg0 + per);
#define N2_GROUP(i) (ilv ? ((i) < 16 ? 256 * (F.vcu >> 4) + (F.vcu & 15) + 16 * (i) : 4096 + F.vcu) : (i))
    ModCache M; M.b = -1;
    u32x2 nx[2][4];
    if (gg0 < gg1) { load_row_bf16(XB + (size_t)(N2_GROUP(gg0) * 16 + 2 * wave_) * DM, lane, nx[0]); load_row_bf16(XB + (size_t)(N2_GROUP(gg0) * 16 + 2 * wave_ + 1) * DM, lane, nx[1]); }
    for (int gg = gg0; gg < gg1; ++gg) {
        const int mbase = N2_GROUP(gg) * 16;
        f32x4 v[2][4];
        cvt_row_bf16(v[0], nx[0]); cvt_row_bf16(v[1], nx[1]);
        if (gg + 1 < gg1) { const int mn_ = N2_GROUP(gg + 1) * 16; load_row_bf16(XB + (size_t)(mn_ + 2 * wave_) * DM, lane, nx[0]); load_row_bf16(XB + (size_t)(mn_ + 2 * wave_ + 1) * DM, lane, nx[1]); }
#pragma unroll
        for (int r = 0; r < 2; ++r) { const int tok = 2 * wave_ + r, m = mbase + tok;
            modcache_load(M, row_batch(m), g2, modL, 3, 4, lane);
            const float rstd = row_rstd(v[r]);
#pragma unroll
            for (int j = 0; j < 4; ++j) v[r][j] = v[r][j] * rstd * M.sc[j] + M.sh[j];
            store_row_fp8(H8 + (size_t)m * DM, lane, v[r], H2_SCALE);
            LAS unsigned char* ah = Ahi + tok * AST + 8 * lane;
#pragma unroll
            for (int j = 0; j < 4; ++j) { const f32x4 x = v[r][j]; u32x2 h, l; h.x = cvtpk(x.x, x.y); h.y = cvtpk(x.z, x.w);
                l.x = cvtpk(x.x - __builtin_bit_cast(float, h.x << 16), x.y - __builtin_bit_cast(float, h.x & 0xffff0000u)); l.y = cvtpk(x.z - __builtin_bit_cast(float, h.y << 16), x.w - __builtin_bit_cast(float, h.y & 0xffff0000u));
                *(LAS u32x2*)(ah + 512 * j) = h; *(LAS u32x2*)(ah + 16 * AST + 512 * j) = l; } }
        N2_BAR();
        f32x4 acc = {0.f, 0.f, 0.f, 0.f};
#pragma unroll
        for (int s = 0; s < 4; ++s) { const LAS unsigned char* ap = Ahi + e_ * AST + 256 * wave_ + 64 * s + 16 * kg;
            const bf16x8 a_h = *(const LAS bf16x8*)ap, a_l = *(const LAS bf16x8*)(ap + 16 * AST);
            acc = __builtin_amdgcn_mfma_f32_16x16x32_bf16(a_h, Bh[s], acc, 0, 0, 0); acc = __builtin_amdgcn_mfma_f32_16x16x32_bf16(a_h, Bl[s], acc, 0, 0, 0); acc = __builtin_amdgcn_mfma_f32_16x16x32_bf16(a_l, Bh[s], acc, 0, 0, 0); }
#pragma unroll
        for (int r = 0; r < 4; ++r) red[wave_ * 256 + (4 * kg + r) * 16 + e_] = acc[r];
        N2_BAR();
        if (tid_ < 256) { float sacc = 0.f;
#pragma unroll
            for (int w = 0; w < 8; ++w) sacc += red[w * 256 + tid_];
            const float mx = row16_max(sacc);
            const float ex = expf(sacc - mx);
            const float sm = row16_sum(ex);
            aff[(size_t)(mbase + (tid_ >> 4)) * 16 + (tid_ & 15)] = ex / sm; }
    }
    __syncthreads();
#undef N2_GROUP
}

template <int NPT>
__device__ __forceinline__ void topk_task(Frame& F, const float* aff, int rowbase, int n, int cap, int e, int slot_base, unsigned* rowsrc_e, short* slot) {
    int tid_ = threadIdx.x; asm volatile("" : "+v"(tid_)); const int lane_ = tid_ & 63; const int wave_ = __builtin_amdgcn_readfirstlane(tid_ >> 6);
    LAS unsigned* cnt = (LAS unsigned*)F.lds;
    const int tid = tid_, lane = lane_, wave = wave_;
    const bool act = tid * NPT < n;
    unsigned v[NPT];
#pragma unroll
    for (int j = 0; j < NPT; ++j) v[j] = act ? __float_as_uint(aff[(size_t)(rowbase + tid * NPT + j) * 16 + e]) : 0u;
    unsigned T = 0u;
    for (int bit = 30; bit >= 0; --bit) {
        const unsigned cand = T | (1u << bit);
        unsigned c = 0;
#pragma unroll
        for (int j = 0; j < NPT; ++j) c += (act && v[j] >= cand) ? 1u : 0u;
        c = (unsigned)wave_sum((float)c);
        LAS unsigned* cb = cnt + (bit & 1) * 8;
        if (lane == 0) cb[wave] = c;
        __syncthreads();
        unsigned tot = 0;
#pragma unroll
        for (int w = 0; w < 8; ++w) tot += cb[w];
        if (tot >= (unsigned)cap) T = cand;
    }
    unsigned ngt = 0, neq = 0;
#pragma unroll
    for (int j = 0; j < NPT; ++j) { ngt += (act && v[j] > T) ? 1u : 0u; neq += (act && v[j] == T) ? 1u : 0u; }
    unsigned pk = ngt | (neq << 16), inc = pk;
#pragma unroll
    for (int o = 1; o < 64; o <<= 1) { const unsigned t = __shfl_up(inc, o); if (lane >= o) inc += t; }
    LAS unsigned* wtot = cnt + 32;
    __syncthreads();
    if (lane == 63) wtot[wave] = inc;
    __syncthreads();
    unsigned wpre = 0, total = 0;
#pragma unroll
    for (int w = 0; w < 8; ++w) { const unsigned t = wtot[w]; if (w < wave) wpre += t; total += t; }
    const unsigned exc = wpre + inc - pk;
    const unsigned tot_gt = total & 0xffffu;
    const unsigned need_eq = (unsigned)cap - tot_gt;
    unsigned gt_before = exc & 0xffffu, eq_before = exc >> 16;
    if (act) {
#pragma unroll
        for (int j = 0; j < NPT; ++j) {
            const bool g = v[j] > T, q = v[j] == T;
            const bool sel = g || (q && eq_before < need_eq);
            const int tok = tid * NPT + j;
            short sv = -1;
            if (sel) { const unsigned pos = gt_before + min(eq_before, need_eq); sv = (short)(slot_base + pos); rowsrc_e[slot_base + pos] = (unsigned)(rowbase + tok); }
            slot[(size_t)(rowbase + tok) * 16 + e] = sv;
            gt_before += g ? 1u : 0u; eq_before += q ? 1u : 0u;
        }
    }
    __syncthreads();
}
__device__ __forceinline__ void phase_topk(Frame& F, const float* aff, unsigned* rowsrc, short* slot, int nMe, bool with_ctx) {
    const int ntask = NB * NE * (with_ctx ? 2 : 1);
    for (int t = F.vcu; t < ntask; t += F.G) {
        const bool cx = t >= NB * NE; const int tt = cx ? t - NB * NE : t; const int b = tt >> 4, e = tt & 15;
        unsigned* rs_e = rowsrc + (size_t)e * nMe * 256;
        if (!cx) topk_task<8>(F, aff, b * SEQ, SEQ, CAPX, e, b * CAPX, rs_e, slot);
        else topk_task<1>(F, aff, MX + b * CTXL, CTXL, CAPC, e, NB * CAPX + b * CAPC, rs_e, slot);
    }
}

__device__ __forceinline__ void phase_combine(Frame& F, bf16_t* XB, const bf16_t* P, float* xout, const float* modL, const float* aff, const short* slot, const bf16_t* ybuf, int nMe,
                                              int nrows, bool last, const float* gnext, const float* modN, bf16_t* H, const float* final_g, float* dump = nullptr) {
    int tid_ = threadIdx.x; asm volatile("" : "+v"(tid_)); const int lane = tid_ & 63; const int wave_ = __builtin_amdgcn_readfirstlane(tid_ >> 6);
    const int gw = F.vcu * NWAVES + wave_, NGW = F.G * NWAVES; const int per = (nrows + NGW - 1) / NGW;
    ModCache M; M.b = -1;
    f32x4 g2v[4]; int gb = -1;
    const int m0 = gw * per, m1 = min(nrows, m0 + per);
    const size_t estride = (size_t)nMe * 256 * DM;
#define CB_META(m, sv, av) do { sv = (int)slot[(size_t)(m) * 16 + (lane & 15)]; av = aff[(size_t)(m) * 16 + (lane & 15)]; } while (0)
#define CB_ISSUE(m, sv, av, X, Y, AK, REST) do { load_row_bf16(XB + (size_t)(m) * DM, lane, X); \
        unsigned mk_ = (unsigned)__ballot(sv >= 0) & 0xffffu; \
        _Pragma("unroll") for (int k = 0; k < 4; ++k) { \
            if (mk_) { const int e_ = __builtin_ctz(mk_); mk_ &= mk_ - 1u; const int s_ = __builtin_amdgcn_readlane(sv, e_); AK[k] = __builtin_bit_cast(float, __builtin_amdgcn_readlane(__builtin_bit_cast(int, av), e_)); \
                const u32x2* yr_ = (const u32x2*)(ybuf + (size_t)e_ * estride + (size_t)s_ * DM) + lane; \
                _Pragma("unroll") for (int j = 0; j < 4; ++j) Y[k][j] = yr_[64 * j]; } \
            else { AK[k] = 0.f; _Pragma("unroll") for (int j = 0; j < 4; ++j) Y[k][j] = (u32x2){0u, 0u}; } } \
        REST = mk_; } while (0)
    int sv1 = -1, sv2 = -1; float av1 = 0.f, av2 = 0.f;
    u32x2 X[4], Xn[4]; u32x2 Y[4][4], Yn[4][4]; float AK[4], AKn[4]; unsigned rest = 0, restn = 0; int svc = -1, svn = -1; float avc = 0.f, avn = 0.f;
    if (m0 < m1) { CB_META(m0, sv1, av1); CB_ISSUE(m0, sv1, av1, X, Y, AK, rest); svc = sv1; avc = av1; }
    if (m0 + 1 < m1) CB_META(m0 + 1, sv1, av1);
    for (int m = m0; m < m1; ++m) {
        if (m + 1 < m1) { CB_ISSUE(m + 1, sv1, av1, Xn, Yn, AKn, restn); svn = sv1; avn = av1; }
        if (m + 2 < m1) CB_META(m + 2, sv1, av1);
        const int b = row_batch(m);
        if (gb != b) { gb = b;
#pragma unroll
            for (int j = 0; j < 4; ++j) g2v[j] = ((const f32x4*)(modL + (size_t)b * 6144 + 5 * DM))[lane + 64 * j]; }
        f32x4 acc[4];
#pragma unroll
        for (int j = 0; j < 4; ++j) acc[j] = (f32x4){0.f, 0.f, 0.f, 0.f};
#pragma unroll
        for (int k = 0; k < 4; ++k) { const float a = AK[k];
#pragma unroll
            for (int j = 0; j < 4; ++j) { const u32x2 w = Y[k][j];
                acc[j].x += a * __builtin_bit_cast(float, w.x << 16); acc[j].y += a * __builtin_bit_cast(float, w.x & 0xffff0000u);
                acc[j].z += a * __builtin_bit_cast(float, w.y << 16); acc[j].w += a * __builtin_bit_cast(float, w.y & 0xffff0000u); } }
        while (rest) { const int e_ = __builtin_ctz(rest); rest &= rest - 1u; const int s_ = __builtin_amdgcn_readlane(svc, e_); const float a = __builtin_bit_cast(float, __builtin_amdgcn_readlane(__builtin_bit_cast(int, avc), e_));
            const u32x2* yr = (const u32x2*)(ybuf + (size_t)e_ * estride + (size_t)s_ * DM) + lane;
#pragma unroll
            for (int j = 0; j < 4; ++j) { const u32x2 w = yr[64 * j];
                acc[j].x += a * __builtin_bit_cast(float, w.x << 16); acc[j].y += a * __builtin_bit_cast(float, w.x & 0xffff0000u);
                acc[j].z += a * __builtin_bit_cast(float, w.y << 16); acc[j].w += a * __builtin_bit_cast(float, w.y & 0xffff0000u); } }
        f32x4 v[4];
        cvt_row_bf16(v, X);
#pragma unroll
        for (int j = 0; j < 4; ++j) v[j] = v[j] + g2v[j] * acc[j];
        const float rstd = row_rstd(v);
        if (!last) {
            store_row_bf16((dump ? (bf16_t*)dump : XB) + (size_t)m * DM, lane, v);
            modcache_load(M, b, gnext, modN, 0, 1, lane);
#pragma unroll
            for (int j = 0; j < 4; ++j) v[j] = v[j] * rstd * M.sc[j] + M.sh[j];
            if (INPROJ_FP8) store_row_fp8((unsigned char*)H + (size_t)m * DM, lane, v, H2_SCALE); else store_row_bf16(H + (size_t)m * DM, lane, v);
        } else {
            f32x4* o = (f32x4*)((dump ? dump : xout) + (size_t)m * DM) + lane;
#pragma unroll
            for (int j = 0; j < 4; ++j) o[64 * j] = v[j] * rstd * ((const f32x4*)final_g)[lane + 64 * j];
        }
#pragma unroll
        for (int j = 0; j < 4; ++j) { X[j] = Xn[j];
#pragma unroll
            for (int k = 0; k < 4; ++k) Y[k][j] = Yn[k][j]; }
#pragma unroll
        for (int k = 0; k < 4; ++k) AK[k] = AKn[k];
        rest = restn; svc = svn; avc = avn;
    }
#undef CB_META
#undef CB_ISSUE
}

struct Args { In in; float* out; unsigned char* ws; int ph_lo, ph_hi; };
#define WSP(off) ((unsigned char*)karg(KA_WS) + (off))
__global__ void __launch_bounds__(NWAVES * 64, 2) fwd(Args args) {
    extern __shared__ __attribute__((aligned(16))) unsigned char lds_raw[];
    Frame F;
    F.lds = (LAS unsigned char*)lds_raw;
    F.MISC = (volatile LAS unsigned*)(F.lds + MISC_OFF);
    F.tid = threadIdx.x; F.lane = F.tid & 63; F.wave = __builtin_amdgcn_readfirstlane(F.tid >> 6);
    F.G = gridDim.x; { const int bx = blockIdx.x; F.vcu = (F.G % 8 == 0) ? (bx % 8) * (F.G / 8) + bx / 8 : bx; }
    F.ctl = nullptr;
    if (F.tid < 64) ((LAS unsigned*)(F.lds + MISC_OFF))[F.tid] = 0u;
    __syncthreads();
    const int lo = args.ph_lo, hi = args.ph_hi;
    if (hi - lo > 1) (void)xcd_barrier_post((unsigned*)WSP(WS_CTL) + 1024, F.MISC + 8);
#ifndef DBG_ONLY
#define DBG_ONLY -1
#endif
#define PHEN(k) (DBG_ONLY < 0 || ((k) < 2 ? (k) : 2 + (((k) - 2) & 7)) == DBG_ONLY)
#define IN(k) (PHEN(k) && lo <= (k) && (k) < hi)
#ifndef ROUTER_MFMA
#define ROUTER_MFMA 1
#endif
#ifndef DUP_PH
#define DUP_PH -1
#endif
#ifndef DUP_LMASK
#define DUP_LMASK 0xF
#endif
#define NREP(k, L) ((DUP_PH == (k) && ((DUP_LMASK >> (L)) & 1)) ? 2 : 1)
#define SEAM(k) do { if (IN(k) && IN((k) + 1)) { XcdBarrier bar_; bar_.bar = (unsigned*)WSP(WS_CTL) + 1024; bar_.x = xb_xcc_id(); bar_.st = F.MISC + 8; xcd_barrier(bar_); } } while (0)

    if (IN(0)) { for (int rep_ = 0; rep_ < NREP(0, 0); ++rep_) phase_prologue(F, WSP(0)); } SEAM(0);
    if (IN(1)) { phase_norm1(F, karg(KA_x), karg(KA_ctx), karg(KA_norm1_g), (const float*)WSP(WS_MOD), (bf16_t*)WSP(WS_H), (bf16_t*)WSP(WS_XB)); } SEAM(1);

#pragma unroll 1
    for (int L = 0; L < DEPTH; ++L) {
        const int pb = 2 + 8 * L;
        if (hi <= pb || lo >= pb + 8) continue;
        if (IN(pb + 0)) for (int rep_ = 0; rep_ < NREP(2, L); ++rep_) {
            const int kind = L % 3, slot = L / 3; const int Nin = (kind == 0) ? 1536 : 3072;
            const bf16_t* Wt = (const bf16_t*)WSP(WS_PW) + (kind == 0 ? PW_WIN_IN / 2 + (size_t)slot * 1536 * 1024 : kind == 1 ? PW_DIFF_IN / 2 : PW_NA_IN / 2);
            pg8::Gemm g{(const char*)WSP(WS_H), (const char*)Wt, INPROJ_FP8 ? DM : DM * 2, 1 << 20, 0, nullptr};
            pg8::StaticOrder S; S.init(MT / 256, Nin / 256, F.G, (int)blockIdx.x);
            pg8::EpiInProj E{(bf16_t*)WSP(WS_QKV), Nin, 4, kind == 0 ? 5 : (kind == 1 ? 8 : 0), (const float*)WSP(WS_TAB), INPROJ_FP8 ? 1.f / (H2_SCALE * W8_SCALE) : 1.f, kind == 0 ? 5 : 8, (bf16_t*)WSP(WS_P)};
            pg8::gemm_phase<pg8::EpiInProj, false, true, INPROJ_FP8 != 0>(F.lds, g, S, E);
        }
        SEAM(pb + 0);
        if (IN(pb + 1)) for (int rep_ = 0; rep_ < NREP(3, L); ++rep_) {
            const int kind = L % 3, slot = L / 3; const int with_ctx = L < DEPTH - 1 ? 1 : 0;
            if (kind == 0) { att::A2Args A{(const bf16_t*)WSP(WS_QKV), (bf16_t*)WSP(WS_H), karg(KA_win_sink) + slot * 16, with_ctx, (const bf16_t*)WSP(WS_P)}; att::att2_phase<0>(F.lds, A, F.vcu, F.G); }
            else if (kind == 1) { const float* TAB = (const float*)WSP(WS_TAB); att::DiffArgs A{(const bf16_t*)WSP(WS_QKV), (bf16_t*)WSP(WS_H), karg(KA_diff_subln_g), TAB[TAB_LAM], TAB[TAB_LAM + 1], with_ctx, (const bf16_t*)WSP(WS_P)}; att::diff_phase3(F.lds, A, F.vcu, F.G); }
            else { att::A2Args A{(const bf16_t*)WSP(WS_QKV), (bf16_t*)WSP(WS_H), karg(KA_na_rpb), with_ctx, (const bf16_t*)WSP(WS_P)}; att::att2_phase<1>(F.lds, A, F.vcu, F.G); }
        }
        SEAM(pb + 1);
        if (IN(pb + 2)) {
            const int kind = L % 3, slot = L / 3; const bool with_ctx = L < DEPTH - 1;
            const bf16_t* Wt = (const bf16_t*)WSP(WS_PW) + (kind == 0 ? PW_WIN_OUT / 2 + (size_t)slot * 1024 * 1024 : kind == 1 ? PW_DIFF_OUT / 2 : PW_NA_OUT / 2);
            pg8::Gemm g{(const char*)WSP(WS_H), (const char*)Wt, OUTPROJ_FP8 ? DM : DM * 2, 1 << 20, 0, nullptr};
            pg8::StaticOrder S; S.init((with_ctx ? MT : MX) / 256, 4, F.G, (int)blockIdx.x);
            pg8::EpiOutProj E{(bf16_t*)WSP(WS_XB), (const float*)WSP(WS_MOD) + (size_t)L * 17 * 6144, OUTPROJ_FP8 ? 1.f / (Y_SCALE * W8_SCALE) : 1.f};
            pg8::gemm_phase<pg8::EpiOutProj, false, true, OUTPROJ_FP8 != 0>(F.lds, g, S, E);
        }
        SEAM(pb + 2);
        if (IN(pb + 3)) for (int rep_ = 0; rep_ < NREP(5, L); ++rep_) { const bool with_ctx = L < DEPTH - 1;
            if (ROUTER_MFMA && rep_ == 0) phase_norm2_router_mfma(F, (const bf16_t*)WSP(WS_XB), karg(KA_norm2_g) + L * DM, (const float*)WSP(WS_MOD) + (size_t)L * 17 * 6144, karg(KA_router_w) + (size_t)L * DM * NE,
                               (unsigned char*)WSP(WS_H), (float*)WSP(WS_AFF), with_ctx ? MT : MX);
            else phase_norm2_router(F, (const bf16_t*)WSP(WS_XB), karg(KA_norm2_g) + L * DM, (const float*)WSP(WS_MOD) + (size_t)L * 17 * 6144, karg(KA_router_w) + (size_t)L * DM * NE,
                               (unsigned char*)WSP(WS_H), (float*)WSP(WS_AFF), with_ctx ? MT : MX, (const bf16_t*)WSP(WS_P), rep_ == 0); }
        SEAM(pb + 3);
        if (IN(pb + 4)) for (int rep_ = 0; rep_ < NREP(6, L); ++rep_) { const bool with_ctx = L < DEPTH - 1; phase_topk(F, (const float*)WSP(WS_AFF), (unsigned*)WSP(WS_ROWSRC), (short*)WSP(WS_SLOT), with_ctx ? NME_FULL : NME_LAST, with_ctx); }
        SEAM(pb + 4);
        if (IN(pb + 5)) for (int rep_ = 0; rep_ < NREP(7, L); ++rep_) {
            const int nMe = (L < DEPTH - 1) ? NME_FULL : NME_LAST;
            pg8::Gemm g{(const char*)WSP(WS_H), (const char*)WSP(WS_MOEW + (size_t)L * 16 * MOEW_E), DM, nMe, MOEW_E, (const unsigned*)WSP(WS_ROWSRC)};
            pg8::StaticOrder S; S.init(16 * nMe, 16, F.G, (int)blockIdx.x);
            if (DUP_PH == 7 && rep_ == 1) { pg8::EpiSwiglu<true> E{(unsigned char*)WSP(WS_QKV), 1.f / (H2_SCALE * W8_SCALE), HID_SCALE};
                pg8::gemm_phase<pg8::EpiSwiglu<true>, true, true, true>(F.lds, g, S, E); }
            else { pg8::EpiSwiglu<false> E{(unsigned char*)WSP(WS_QKV), 1.f / (H2_SCALE * W8_SCALE), HID_SCALE};
                pg8::gemm_phase<pg8::EpiSwiglu<false>, true, true, true>(F.lds, g, S, E); }
        }
        SEAM(pb + 5);
        if (IN(pb + 6)) for (int rep_ = 0; rep_ < NREP(8, L); ++rep_) {
            const int nMe = (L < DEPTH - 1) ? NME_FULL : NME_LAST;
            pg8::Gemm g{(const char*)WSP(WS_QKV), (const char*)WSP(WS_MOEW + (size_t)L * 16 * MOEW_E + (size_t)4096 * 1024), FF, nMe, MOEW_E, nullptr};
            pg8::StaticOrder S; S.init(16 * nMe, 4, F.G, (int)blockIdx.x);
            pg8::EpiBf16 E{(bf16_t*)WSP(WS_YBUF), DM, 1.f / (HID_SCALE * W8_SCALE)};
            pg8::gemm_phase<pg8::EpiBf16, false, true, true, true>(F.lds, g, S, E);
        }
        SEAM(pb + 6);
        if (IN(pb + 7)) for (int rep_ = NREP(9, L) - 1; rep_ >= 0; --rep_) {
            const bool last = (L == DEPTH - 1); const bool with_ctx = !last;
            phase_combine(F, (bf16_t*)WSP(WS_XB), (const bf16_t*)WSP(WS_P), (float*)karg(KA_OUT), (const float*)WSP(WS_MOD) + (size_t)L * 17 * 6144, (const float*)WSP(WS_AFF), (const short*)WSP(WS_SLOT), (const bf16_t*)WSP(WS_YBUF),
                          with_ctx ? NME_FULL : NME_LAST, with_ctx ? MT : MX, last, karg(KA_norm1_g) + (last ? 0 : (L + 1) * DM), (const float*)WSP(WS_MOD) + (size_t)(last ? 0 : L + 1) * 17 * 6144,
                          rep_ ? (bf16_t*)WSP(WS_QKV + 300 * MiB) : (bf16_t*)WSP(WS_H), karg(KA_final_g), rep_ ? (float*)WSP(WS_QKV) : nullptr);
        }
        SEAM(pb + 7);
    }
#undef IN
#undef SEAM
}

extern "C" void kernel_launch(void* const* d_in, const int* in_sizes, int n_in, void* d_out, int out_size, void* d_ws, size_t ws_size, hipStream_t stream) {
    static int grid = 0;
    if (grid == 0) {
        if (n_in != 23 || out_size != MX * DM || ws_size < WS_END) { fprintf(stderr, "kernel_launch: unexpected shapes: n_in %d out %d ws %zu (need %zu)\n", n_in, out_size, ws_size, (size_t)WS_END); grid = -1; return; }
        int dev = 0, cus = 0, per_cu = 0;
        if (hipGetDevice(&dev) != hipSuccess || hipDeviceGetAttribute(&cus, hipDeviceAttributeMultiprocessorCount, dev) != hipSuccess) { grid = -1; return; }
        if (hipFuncSetAttribute((const void*)fwd, hipFuncAttributeMaxDynamicSharedMemorySize, LDS_BYTES) != hipSuccess) { fprintf(stderr, "kernel_launch: hipFuncSetAttribute failed\n"); grid = -1; return; }
        if (hipOccupancyMaxActiveBlocksPerMultiprocessor(&per_cu, (const void*)fwd, NWAVES * 64, LDS_BYTES) != hipSuccess || per_cu < 1) fprintf(stderr, "kernel_launch: occupancy query says %d\n", per_cu);
        (void)hipGetLastError();
        grid = cus;
    }
    if (grid < 0) return;
    (void)hipMemsetAsync((char*)d_ws + WS_CTL, 0, CTL_ZERO_BYTES, stream);
    Args a{};
    const float** ip = (const float**)&a.in;
    for (int i = 0; i < 23; ++i) ip[i] = (const float*)d_in[i];
    a.out = (float*)d_out; a.ws = (unsigned char*)d_ws;
    if (MK_N_LAUNCHES == 1) { a.ph_lo = 0; a.ph_hi = NPHASES; hipLaunchKernelGGL(fwd, dim3(grid), dim3(NWAVES * 64), LDS_BYTES, stream, a); }
    else for (int p = 0; p < NPHASES; ++p) { a.ph_lo = p; a.ph_hi = p + 1; hipLaunchKernelGGL(fwd, dim3(grid), dim3(NWAVES * 64), LDS_BYTES, stream, a); }
}
```

```cpp
#include <hip/hip_runtime.h>
#include <cstdio>
#include <cstdint>

#ifndef MK_N_LAUNCHES
#define MK_N_LAUNCHES 1
#endif

#define GAS __attribute__((address_space(1)))
#define LAS __attribute__((address_space(3)))
typedef unsigned short bf16_t;
typedef short bf16x8 __attribute__((ext_vector_type(8)));
typedef short s16x4 __attribute__((ext_vector_type(4)));
typedef float f32x4 __attribute__((ext_vector_type(4)));
typedef float f32x2 __attribute__((ext_vector_type(2)));
typedef float f32x16 __attribute__((ext_vector_type(16)));
typedef unsigned u32x4 __attribute__((ext_vector_type(4)));
typedef unsigned u32x2 __attribute__((ext_vector_type(2)));
typedef __bf16 bf16x2_t __attribute__((ext_vector_type(2)));
typedef GAS unsigned gu32;

constexpr int DM = 1024, NB = 16, SEQ = 4096, DEPTH = 4, CTXL = 256, NE = 16, FF = 2048;
constexpr int MX = NB * SEQ;
constexpr int MC = NB * CTXL;
constexpr int MT = MX + MC;
constexpr int CAPX = 512, CAPC = 32;
constexpr int NME_FULL = 34, NME_LAST = 32;
constexpr float C2 = 0.125f * 1.4426950408889634f;
constexpr float LOG2E = 1.4426950408889634f;
constexpr float RMS_EPS = 1e-6f;
constexpr float NEG_BIG = -1e30f;
constexpr int NWAVES = 8;
constexpr int NPHASES = 2 + 8 * DEPTH;

constexpr size_t MiB = 1u << 20;
constexpr size_t WS_CTL = 0, CTL_ZERO_BYTES = 64 * 1024;
constexpr size_t WS_MOD = 1 * MiB;
constexpr size_t WS_TAB = 3 * MiB;
constexpr size_t WS_AFF = 4 * MiB;
constexpr size_t WS_SLOT = 9 * MiB;
constexpr size_t WS_ROWSRC = 12 * MiB;
constexpr size_t WS_CTXRES = 13 * MiB;
constexpr size_t WS_PW = 29 * MiB;
constexpr size_t PW_WIN_IN = 0, PW_WIN_OUT = 6 * MiB, PW_DIFF_IN = 10 * MiB, PW_DIFF_OUT = 16 * MiB, PW_NA_IN = 18 * MiB, PW_NA_OUT = 24 * MiB;
constexpr size_t WS_H = 56 * MiB;
constexpr size_t WS_QKV = 192 * MiB;
constexpr size_t WS_YBUF = 736 * MiB;
constexpr size_t WS_MOEW = 1008 * MiB;
constexpr size_t MOEW_E = (size_t)(4096 * 1024 + 1024 * 2048);
#ifndef INPROJ_FP8
#define INPROJ_FP8 1
#endif
#ifndef OUTPROJ_FP8
#define OUTPROJ_FP8 1
#endif
constexpr float Y_SCALE = 8.f;
constexpr float H2_SCALE = 4.f, HID_SCALE = 2.f, W8_SCALE = 32.f;
constexpr size_t WS_XB = 1536 * MiB;
constexpr size_t WS_END = 1672 * MiB;
constexpr size_t WS_P = 1400 * MiB;
constexpr int TAB_COS = 0, TAB_SIN = 1024, TAB_LAM = 2048;

constexpr int RING_BYTES = 131072;
constexpr int MISC_OFF = 135168;
constexpr int LDS_BYTES = 147456;

#define LDS_WAIT() asm volatile("s_waitcnt lgkmcnt(0)" ::: "memory")
#define VM_WAIT() asm volatile("s_waitcnt vmcnt(0)" ::: "memory")

__device__ __forceinline__ unsigned cvtpk(float lo, float hi) { f32x2 v = {lo, hi}; bf16x2_t b = __builtin_convertvector(v, bf16x2_t); return __builtin_bit_cast(unsigned, b); }
__device__ __forceinline__ float bf2f(unsigned short u) { return __builtin_bit_cast(float, (unsigned)u << 16); }
__device__ __forceinline__ float wave_sum(float v) {
#pragma unroll
    for (int o = 1; o < 64; o <<= 1) v += __shfl_xor(v, o);
    return v;
}
template <int CTRL> __device__ __forceinline__ float dppf(float v) { return __builtin_bit_cast(float, __builtin_amdgcn_update_dpp(0, __builtin_bit_cast(int, v), CTRL, 0xF, 0xF, true)); }
__device__ __forceinline__ float row16_sum(float v) { v += dppf<0xB1>(v); v += dppf<0x4E>(v); v += dppf<0x141>(v); v += dppf<0x140>(v); return v; }
__device__ __forceinline__ float row16_max(float v) { v = fmaxf(v, dppf<0xB1>(v)); v = fmaxf(v, dppf<0x4E>(v)); v = fmaxf(v, dppf<0x141>(v)); v = fmaxf(v, dppf<0x140>(v)); return v; }
__device__ __forceinline__ float rdlane(float v, int l) { return __builtin_bit_cast(float, __builtin_amdgcn_readlane(__builtin_bit_cast(int, v), l)); }
__device__ __forceinline__ float wave_sum_fast(float v) { v = row16_sum(v); return (rdlane(v, 0) + rdlane(v, 16)) + (rdlane(v, 32) + rdlane(v, 48)); }
__device__ __forceinline__ float siluf(float v) { return v / (1.f + __expf(-v)); }

#define XB_TMO      128
#define XB_XCNT(j)  (256  + 64 * (j))
#define XB_XSUB(j)  (1280 + 64 * (j))
#define XB_XGEN(j)  (2304 + 64 * (j))
#define XB_TOP      3328
#define XB_TOPGEN   3392
#define XCD_BAR_WORDS 3456
#define XB_SPIN_CAP (1u << 18)
__device__ __forceinline__ unsigned xb_ld(unsigned* p)              { return __hip_atomic_load(p, __ATOMIC_RELAXED, __HIP_MEMORY_SCOPE_AGENT); }
__device__ __forceinline__ unsigned xb_add(unsigned* p, unsigned v) { return __hip_atomic_fetch_add(p, v, __ATOMIC_RELAXED, __HIP_MEMORY_SCOPE_AGENT); }
__device__ __forceinline__ unsigned xb_xcc_id() { return (unsigned)__builtin_amdgcn_s_getreg((3 << 11) | 20) & 0xFu; }
#define XB_SPIN(cond, bar) do { unsigned _sp = 0; while (cond) { __builtin_amdgcn_s_sleep(1); \
    if ((++_sp & 255u) == 0u) { if (xb_ld(&(bar)[XB_TMO])) break; if (_sp > XB_SPIN_CAP) { atomicAdd(&(bar)[XB_TMO], 1u); break; } } } } while (0)
struct XcdBarrier { unsigned* bar; unsigned x; volatile LAS unsigned* st; };
__device__ __forceinline__ XcdBarrier xcd_barrier_post(unsigned* bar, volatile LAS unsigned* st) {
    XcdBarrier b; b.bar = bar; b.x = xb_xcc_id(); b.st = st;
    if (threadIdx.x == 0) (void)xb_add(&bar[XB_XCNT(b.x)], 1u);
    return b;
}
__device__ __forceinline__ void xcd_barrier_complete(unsigned* bar, unsigned x, unsigned& nloc, unsigned& nx) {
    const unsigned G = gridDim.x * gridDim.y * gridDim.z;
    unsigned sum, cnt, mine, sp = 0u;
    for (;;) {
        sum = 0u; cnt = 0u; mine = 0u;
#pragma unroll
        for (unsigned j = 0; j < 16; ++j) { const unsigned c = xb_ld(&bar[XB_XCNT(j)]); sum += c; cnt += (c > 0u) ? 1u : 0u; mine = (j == x) ? c : mine; }
        if (sum == G) break;
        __builtin_amdgcn_s_sleep(1);
        if ((++sp & 255u) == 0u) { if (xb_ld(&bar[XB_TMO])) break; if (sp > XB_SPIN_CAP) { atomicAdd(&bar[XB_TMO], 1u); break; } }
    }
    nloc = mine > 0u ? mine : 1u; nx = cnt > 0u ? cnt : 1u;
}
__device__ __forceinline__ void xcd_barrier(const XcdBarrier& b) {
    asm volatile("s_waitcnt vmcnt(0)" ::: "memory");
    __syncthreads();
    if (threadIdx.x == 0) {
        unsigned* bar = b.bar;
        __builtin_amdgcn_s_waitcnt(0);
        unsigned nloc = b.st[0], nx = b.st[1];
        if (nloc == 0u) { xcd_barrier_complete(bar, b.x, nloc, nx); b.st[0] = nloc; b.st[1] = nx; }
        const unsigned old = xb_add(&bar[XB_XSUB(b.x)], 1u);
        const unsigned gen = old / nloc;
        if (old + 1u == (gen + 1u) * nloc) {
            __builtin_amdgcn_fence(__ATOMIC_RELEASE, "agent");
            asm volatile("s_waitcnt vmcnt(0)" ::: "memory");
            const unsigned og = xb_add(&bar[XB_TOP], 1u);
            const unsigned tg = og / nx;
            if (og + 1u == (tg + 1u) * nx) xb_add(&bar[XB_TOPGEN], 1u);
            else XB_SPIN(xb_ld(&bar[XB_TOPGEN]) == tg, bar);
            __builtin_amdgcn_fence(__ATOMIC_ACQUIRE, "agent");
            xb_add(&bar[XB_XGEN(b.x)], 1u);
            asm volatile("s_waitcnt vmcnt(0)" ::: "memory");
        } else {
            XB_SPIN(xb_ld(&bar[XB_XGEN(b.x)]) == gen, bar);
            __builtin_amdgcn_fence(__ATOMIC_ACQUIRE, "agent");
            asm volatile("s_waitcnt vmcnt(0)" ::: "memory");
        }
    }
    __syncthreads();
}

namespace pg8 {
constexpr int BM = 256, BK = 64, HALF = 128, HTB = HALF * BK * 2, NXCD = 8, WGM = 4;
typedef int v4i __attribute__((ext_vector_type(4)));
typedef int v8i __attribute__((ext_vector_type(8)));
__host__ __device__ __forceinline__ int lds_byte(int r, int c) { const int st = (r >> 4) * 2 + (c >> 5), rr = r & 15, cc = c & 31, ob = rr * 64 + cc * 2; return st * 1024 + (ob ^ (((ob >> 9) & 1) << 5)); }
__host__ __device__ __forceinline__ void stage_rc(int b, int& R, int& C) { const int st = b / 1024, sb = b % 1024, swz = sb ^ (((sb >> 9) & 1) << 5); R = (st >> 1) * 16 + swz / 64; C = (st & 1) * 32 + (swz % 64) / 2; }
__host__ __device__ __forceinline__ int perm32(int rho) { const int n = rho >> 4, i = rho & 15; return 8 * (i >> 2) + 4 * n + (i & 3); }

struct Unit { int pm, pn; };
struct Gemm { const char* A; const char* Bt; int Kb; int nMe; size_t b_estride; const unsigned* rowsrc; };

struct StaticOrder {
    int nM, nN, nwg, G, c;
    __device__ void init(int nM_, int nN_, int G_, int c_) { nM = nM_; nN = nN_; nwg = nM * nN; G = G_; c = c_; }
    __device__ bool next(int i, Unit& u) const {
        const long L = (long)i * G + c; if (L >= nwg) return false;
        int wgid = (int)L; { const int q = nwg / NXCD, r = nwg % NXCD, xcd = wgid % NXCD, off = wgid / NXCD; wgid = (xcd < r ? xcd * (q + 1) : r * (q + 1) + (xcd - r) * q) + off; }
        const int nig = WGM * nN, gid = wgid / nig, fm = gid * WGM, gsz = (nM - fm) < WGM ? (nM - fm) : WGM;
        u.pm = fm + ((wgid % nig) % gsz); u.pn = (wgid % nig) / gsz; return true;
    }
};

template <class Epi, bool GATHER, bool ALIGN_EPI, bool FP8 = false, bool ABLK = false>
__device__ __forceinline__ void gemm_phase(LAS unsigned char* lds, const Gemm g, const StaticOrder& S, const Epi& E) {
    int tid = threadIdx.x; asm volatile("" : "+v"(tid));
    const int wid = __builtin_amdgcn_readfirstlane(tid >> 6), lane = tid & 63, wr = wid >> 2, wc = wid & 3, fr = lane & 15, fq = lane >> 4;
    const int Kb = g.Kb, nt = Kb / (BK * 2);
    int Rr[2], Cc[2]; unsigned voffB[2];
#pragma unroll
    for (int i = 0; i < 2; ++i) { int R, C; stage_rc(tid * 16 + i * 8192, R, C); const int Rb = Epi::PERM ? ((R & ~31) + perm32(R & 31)) : R;
        Rr[i] = R; Cc[i] = C; voffB[i] = (unsigned)(Rb * Kb + C * 2); }
    const size_t kstep = (size_t)(BK * 2);
    const size_t kstepA = ABLK ? (size_t)32768 : kstep;
    const size_t hstep = (size_t)HALF * Kb;
    const size_t tstep = 2 * hstep;
    const unsigned ldsw = (unsigned)wid * 1024u;
    const int aoff = lds_byte(wr * 64 + fr, fq * 8), boff = lds_byte(wc * 32 + fr, fq * 8);
#define PG8_SA(b, h) (((b) * 2 + (h)) * HTB)
#define PG8_SB(b, h) ((4 + (b) * 2 + (h)) * HTB)
#define PG8_STAGE(bufoff, gbase, voff) do { _Pragma("unroll") for (int _i = 0; _i < 2; ++_i) \
        __builtin_amdgcn_global_load_lds((const unsigned*)((const char*)(gbase) + (voff)[_i]), (LAS unsigned*)(lds + (bufoff) + ldsw + _i * 8192), 16, 0, 0); } while (0)
#define PG8_LDA(dst, b, h) do { _Pragma("unroll") for (int m = 0; m < 4; ++m) _Pragma("unroll") for (int k = 0; k < 2; ++k) dst[m][k] = *(const LAS bf16x8*)(lds + PG8_SA(b, h) + aoff + m * 2048 + k * 1024); } while (0)
#define PG8_LDB(dst, b, h) do { _Pragma("unroll") for (int n = 0; n < 2; ++n) _Pragma("unroll") for (int k = 0; k < 2; ++k) dst[n][k] = *(const LAS bf16x8*)(lds + PG8_SB(b, h) + boff + n * 2048 + k * 1024); } while (0)
#define PG8_MMA(ai, bj, At, Bt, Z) do { __builtin_amdgcn_s_setprio(1); \
        if constexpr (FP8) { if (Epi::ZEROC && (Z)) { _Pragma("unroll") for (int m = 0; m < 4; ++m) _Pragma("unroll") for (int n = 0; n < 2; ++n) { \
            const v8i b8_ = __builtin_shufflevector(__builtin_bit_cast(v4i, Bt[n][0]), __builtin_bit_cast(v4i, Bt[n][1]), 0, 1, 2, 3, 4, 5, 6, 7); \
            const v8i a8_ = __builtin_shufflevector(__builtin_bit_cast(v4i, At[m][0]), __builtin_bit_cast(v4i, At[m][1]), 0, 1, 2, 3, 4, 5, 6, 7); \
            asm volatile("v_mfma_f32_16x16x128_f8f6f4 %0, %1, %2, 0" : "+v"(acc[ai][bj][m][n]) : "v"(b8_), "v"(a8_)); } }   \
          else { _Pragma("unroll") for (int m = 0; m < 4; ++m) _Pragma("unroll") for (int n = 0; n < 2; ++n) { \
            const v8i b8_ = __builtin_shufflevector(__builtin_bit_cast(v4i, Bt[n][0]), __builtin_bit_cast(v4i, Bt[n][1]), 0, 1, 2, 3, 4, 5, 6, 7); \
            const v8i a8_ = __builtin_shufflevector(__builtin_bit_cast(v4i, At[m][0]), __builtin_bit_cast(v4i, At[m][1]), 0, 1, 2, 3, 4, 5, 6, 7); \
            asm volatile("v_mfma_f32_16x16x128_f8f6f4 %0, %1, %2, %0" : "+v"(acc[ai][bj][m][n]) : "v"(b8_), "v"(a8_)); } } } \
        else { _Pragma("unroll") for (int m = 0; m < 4; ++m) _Pragma("unroll") for (int n = 0; n < 2; ++n) _Pragma("unroll") for (int k = 0; k < 2; ++k) \
            acc[ai][bj][m][n] = __builtin_amdgcn_mfma_f32_16x16x32_bf16(Bt[n][k], At[m][k], acc[ai][bj][m][n], 0, 0, 0); } \
        __builtin_amdgcn_s_setprio(0); } while (0)
#define PG8_WAIT_V(n) asm volatile("s_waitcnt vmcnt(" #n ")" ::: "memory")
#define PG8_WAIT_L(n) asm volatile("s_waitcnt lgkmcnt(" #n ")" ::: "memory")
#define PG8_BAR __builtin_amdgcn_s_barrier()
#define PG8_SCHED __builtin_amdgcn_sched_barrier(0)
#define PG8_CALC_VG(VG, U) do { _Pragma("unroll") for (int _h = 0; _h < 2; ++_h) _Pragma("unroll") for (int _i = 0; _i < 2; ++_i) { \
        const unsigned _row = (unsigned)((U).pm * BM + _h * HALF + Rr[_i]); const unsigned _src = GATHER ? g.rowsrc[_row] : _row; \
        if constexpr (ABLK) { const unsigned _r = (unsigned)(_h * HALF + Rr[_i]), _c = (unsigned)Cc[_i] >> 3; \
            VG[_h][_i] = (unsigned)(U).pm * (unsigned)(Kb * BM) + (_r >> 4) * 2048u + (_c >> 1) * 512u + (_r & 15u) * 32u + (_c & 1u) * 16u; } \
        else VG[_h][_i] = _src * (unsigned)Kb + (unsigned)Cc[_i] * 2u; } } while (0)
    Unit cur, nxt; int ui = 0;
    if (!S.next(0, cur)) return;
    f32x4 acc[2][2][4][2];
    if constexpr (!(FP8 && Epi::ZEROC)) {
#pragma unroll
    for (int a = 0; a < 2; ++a)
#pragma unroll
        for (int b = 0; b < 2; ++b)
#pragma unroll
            for (int m = 0; m < 4; ++m)
#pragma unroll
                for (int n = 0; n < 2; ++n) acc[a][b][m][n] = (f32x4){0.f, 0.f, 0.f, 0.f};
    }
    bf16x8 At[4][2], B0[2][2], B1[2][2];
    unsigned vg[2][2], vgn[2][2];
    PG8_CALC_VG(vg, cur);
    const char* const gA = g.A;
    const char* cB = g.Bt + (size_t)(cur.pm / g.nMe) * g.b_estride + (size_t)cur.pn * tstep;
    PG8_STAGE(PG8_SB(0, 0), cB, voffB); PG8_STAGE(PG8_SB(0, 1), cB + hstep, voffB); PG8_STAGE(PG8_SA(0, 0), gA, vg[0]); PG8_STAGE(PG8_SA(0, 1), gA, vg[1]);
    if (wr == 1) PG8_BAR;
    PG8_WAIT_V(2); PG8_BAR;
    PG8_STAGE(PG8_SB(1, 0), cB + kstep, voffB); PG8_STAGE(PG8_SA(1, 0), gA + kstepA, vg[0]); PG8_STAGE(PG8_SB(1, 1), cB + hstep + kstep, voffB);
    PG8_WAIT_V(6); PG8_BAR;
    for (;;) {
        const bool has_next = S.next(ui + 1, nxt);
        LAS unsigned char* const rsb = lds + 131072 + ((ui + 1) & 1) * 1024;
        if (has_next) {
            if constexpr (GATHER) { if (wid == 0) __builtin_amdgcn_global_load_lds((const unsigned*)(g.rowsrc + (size_t)nxt.pm * BM) + lane * 4, (LAS unsigned*)rsb, 16, 0, 0); }
            else { PG8_CALC_VG(vgn, nxt); } }
        else {
#pragma unroll
            for (int _h = 0; _h < 2; ++_h)
#pragma unroll
                for (int _i = 0; _i < 2; ++_i) vgn[_h][_i] = vg[_h][_i]; }
        const char* nB = has_next ? g.Bt + (size_t)(nxt.pm / g.nMe) * g.b_estride + (size_t)nxt.pn * tstep : cB;
        for (int t = 0; t < nt; t += 2) {
            const bool last = (t == nt - 2);
            const char* a1 = gA + (size_t)(t + 1) * kstepA;
            const char* a2 = last ? gA : gA + (size_t)(t + 2) * kstepA; const char* b2 = last ? nB : cB + (size_t)(t + 2) * kstep;
            const char* a3 = a2 + kstepA; const char* b3 = b2 + kstep;
            if constexpr (GATHER) { if (last && has_next) {
#pragma unroll
                for (int _h = 0; _h < 2; ++_h)
#pragma unroll
                    for (int _i = 0; _i < 2; ++_i) vgn[_h][_i] = *(const LAS unsigned*)(rsb + (_h * HALF + Rr[_i]) * 4) * (unsigned)Kb + (unsigned)Cc[_i] * 2u; } }
            unsigned w0[2], w1[2];
#pragma unroll
            for (int _i = 0; _i < 2; ++_i) { w0[_i] = last ? vgn[0][_i] : vg[0][_i]; w1[_i] = last ? vgn[1][_i] : vg[1][_i]; }
            PG8_LDB(B0, 0, 0); PG8_LDB(B1, 0, 1); PG8_SCHED; PG8_LDA(At, 0, 0); PG8_STAGE(PG8_SA(1, 1), a1, vg[1]);
            PG8_WAIT_V(8); PG8_WAIT_L(0); PG8_BAR; PG8_MMA(0, 0, At, B0, t == 0); PG8_MMA(0, 1, At, B1, t == 0); PG8_BAR; PG8_SCHED;
            PG8_LDA(At, 0, 1); PG8_STAGE(PG8_SB(0, 0), b2, voffB); PG8_STAGE(PG8_SB(0, 1), b2 + hstep, voffB); PG8_STAGE(PG8_SA(0, 0), a2, w0);
            PG8_WAIT_V(8); PG8_WAIT_L(0); PG8_BAR; PG8_MMA(1, 0, At, B0, t == 0); PG8_MMA(1, 1, At, B1, t == 0); PG8_BAR; PG8_SCHED;
            PG8_LDB(B0, 1, 0); PG8_LDB(B1, 1, 1); PG8_SCHED; PG8_LDA(At, 1, 0); PG8_STAGE(PG8_SA(0, 1), a2, w1);
            PG8_WAIT_V(8); PG8_WAIT_L(0); PG8_BAR; PG8_MMA(0, 0, At, B0, false); PG8_MMA(0, 1, At, B1, false); PG8_BAR; PG8_SCHED;
            PG8_LDA(At, 1, 1); PG8_STAGE(PG8_SB(1, 0), b3, voffB); PG8_STAGE(PG8_SB(1, 1), b3 + hstep, voffB); PG8_STAGE(PG8_SA(1, 0), a3, w0);
            PG8_WAIT_V(8); PG8_WAIT_L(0); PG8_BAR; PG8_MMA(1, 0, At, B0, false); PG8_MMA(1, 1, At, B1, false); PG8_BAR; PG8_SCHED;
        }
        if constexpr (ALIGN_EPI) { if (wr == 0) PG8_BAR; }
        if constexpr (FP8) asm volatile("s_nop 15\n\ts_nop 15" ::: "memory");
        E(acc, cur, wr, wc, fr, fq);
        if (!has_next) break;
        if constexpr (!(FP8 && Epi::ZEROC)) {
#pragma unroll
        for (int a = 0; a < 2; ++a)
#pragma unroll
            for (int b = 0; b < 2; ++b)
#pragma unroll
                for (int m = 0; m < 4; ++m)
#pragma unroll
                    for (int n = 0; n < 2; ++n) acc[a][b][m][n] = (f32x4){0.f, 0.f, 0.f, 0.f};
        }
        cur = nxt; cB = nB; ++ui;
#pragma unroll
        for (int _h = 0; _h < 2; ++_h)
#pragma unroll
            for (int _i = 0; _i < 2; ++_i) vg[_h][_i] = vgn[_h][_i];
        if constexpr (ALIGN_EPI) { if (wr == 1) PG8_BAR; }
    }
    PG8_WAIT_V(0);
    if constexpr (!ALIGN_EPI) { if (wr == 0) PG8_BAR; }
    PG8_BAR;
#undef PG8_SA
#undef PG8_SB
#undef PG8_STAGE
#undef PG8_LDA
#undef PG8_LDB
#undef PG8_MMA
#undef PG8_WAIT_V
#undef PG8_WAIT_L
#undef PG8_BAR
#undef PG8_SCHED
#undef PG8_CALC_VG
}

struct EpiInProj {
    static constexpr bool PERM = false; static constexpr bool ZEROC = false;
    bf16_t* O; int ldc; int q_tiles; int rope_tiles; const float* tab; float osc; int v_tile0; bf16_t* Q;
    __device__ __forceinline__ void operator()(const f32x4 (&acc)[2][2][4][2], const Unit& u, int wr, int wc, int fr, int fq) const {
        const int row0 = u.pm * BM + wr * 64 + fr, col0 = u.pn * BM + wc * 32 + 4 * fq;
        const float sc = ((u.pn < q_tiles) ? C2 : 1.f) * osc;
        const bool rope = (u.pn < rope_tiles) && (u.pm < MX / BM);
        const int axis = wc & 1; const bool isv = u.pn >= v_tile0;
#pragma unroll
        for (int ai = 0; ai < 2; ++ai)
#pragma unroll
            for (int m = 0; m < 4; ++m) {
                const int row = row0 + ai * HALF + m * 16;
                f32x4 cs = {1.f, 1.f, 1.f, 1.f}, sn = {0.f, 0.f, 0.f, 0.f};
                if (rope) { const int t = row & (SEQ - 1); const int pos = axis ? (t & 63) : (t >> 6); cs = *(const f32x4*)(tab + TAB_COS + pos * 16 + 4 * fq); sn = *(const f32x4*)(tab + TAB_SIN + pos * 16 + 4 * fq); }
                bf16_t* rowp = O + (size_t)row * ldc + col0;
                bf16_t* rowq = (u.pn < q_tiles) ? Q + ((size_t)(row >> 5) * 16 + 4 * u.pn + (wc >> 1)) * 2048 + (2 * (wc & 1) + (fq >> 1)) * 512 + (fq & 1) * 256 + (row & 31) * 8
                                                : O + (size_t)row * ldc + u.pn * BM + wc * 32 + 8 * fq;
                const int qstep = (u.pn < q_tiles) ? 2 * 2048 : HALF;
#pragma unroll
                for (int bj = 0; bj < 2; ++bj) {
                    const f32x4 x1 = acc[ai][bj][m][0] * sc, x2 = acc[ai][bj][m][1] * sc;
                    const f32x4 o1 = x1 * cs - x2 * sn, o2 = x2 * cs + x1 * sn;
                    u32x2 w1, w2; w1.x = cvtpk(o1[0], o1[1]); w1.y = cvtpk(o1[2], o1[3]); w2.x = cvtpk(o2[0], o2[1]); w2.y = cvtpk(o2[2], o2[3]);
                    if (isv) { *(u32x2*)(rowp + bj * HALF) = w1; *(u32x2*)(rowp + bj * HALF + 16) = w2; }
                    else *(u32x4*)(rowq + bj * qstep) = (u32x4){w1.x, w1.y, w2.x, w2.y}; }
            }
    }
};
struct EpiOutProj {
    static constexpr bool PERM = true; static constexpr bool ZEROC = false;
    bf16_t* P; const float* mod; float osc;
    __device__ __forceinline__ void operator()(const f32x4 (&acc)[2][2][4][2], const Unit& u, int wr, int wc, int fr, int fq) const {
        const int b = (u.pm < MX / BM) ? ((u.pm * BM) >> 12) : 16;
        const int row0 = u.pm * BM + wr * 64 + fr, col0 = u.pn * BM + wc * 32 + 8 * fq;
        const float* gp = mod + (size_t)b * 6144 + 2 * DM + col0;
        f32x4 gv[2][2];
#pragma unroll
        for (int bj = 0; bj < 2; ++bj)
#pragma unroll
            for (int n = 0; n < 2; ++n) gv[bj][n] = *(const f32x4*)(gp + bj * HALF + 4 * n) * osc;
        u32x4 xa[2][4][2];
#pragma unroll
        for (int ai = 0; ai < 2; ++ai)
#pragma unroll
            for (int m = 0; m < 4; ++m) { const bf16_t* rowp = P + (size_t)(row0 + ai * HALF + m * 16) * DM + col0; xa[ai][m][0] = *(const u32x4*)rowp; xa[ai][m][1] = *(const u32x4*)(rowp + HALF); }
#pragma unroll
        for (int ai = 0; ai < 2; ++ai)
#pragma unroll
            for (int m = 0; m < 4; ++m) { bf16_t* rowp = P + (size_t)(row0 + ai * HALF + m * 16) * DM + col0;
#pragma unroll
                for (int bj = 0; bj < 2; ++bj) { const f32x4 v0 = acc[ai][bj][m][0] * gv[bj][0], v1 = acc[ai][bj][m][1] * gv[bj][1]; const u32x4 x = xa[ai][m][bj];
                    u32x4 w; w.x = cvtpk(v0[0] + __builtin_bit_cast(float, x.x << 16), v0[1] + __builtin_bit_cast(float, x.x & 0xffff0000u));
                    w.y = cvtpk(v0[2] + __builtin_bit_cast(float, x.y << 16), v0[3] + __builtin_bit_cast(float, x.y & 0xffff0000u));
                    w.z = cvtpk(v1[0] + __builtin_bit_cast(float, x.z << 16), v1[1] + __builtin_bit_cast(float, x.z & 0xffff0000u));
                    w.w = cvtpk(v1[2] + __builtin_bit_cast(float, x.w << 16), v1[3] + __builtin_bit_cast(float, x.w & 0xffff0000u));
                    *(u32x4*)(rowp + bj * HALF) = w; } }
    }
};
template <bool NOSTORE = false> struct EpiSwiglu {
    static constexpr bool PERM = true; static constexpr bool ZEROC = true;
    unsigned char* O; float in_scale; float out_scale;
    __device__ __forceinline__ void operator()(const f32x4 (&acc)[2][2][4][2], const Unit& u, int wr, int wc, int fr, int fq) const {
        const int row0 = u.pm * BM + wr * 64 + fr, col0 = u.pn * HALF + wc * 32 + 8 * fq;
#pragma unroll
        for (int ai = 0; ai < 2; ++ai)
#pragma unroll
            for (int m = 0; m < 4; ++m) { unsigned char* rowp = O + ((size_t)u.pm * 16 + u.pn) * 32768 + (8 * ai + 4 * wr + m) * 2048 + wc * 512 + fr * 32 + fq * 8;
                float h[8];
                const float c1 = -LOG2E * in_scale, c2i = 1.f / (in_scale * in_scale * out_scale);
#pragma unroll
                for (int n = 0; n < 2; ++n)
#pragma unroll
                    for (int j = 0; j < 4; j += 2) { const f32x2 ag = {acc[ai][0][m][n][j], acc[ai][0][m][n][j + 1]}, au = {acc[ai][1][m][n][j], acc[ai][1][m][n][j + 1]};
                        const f32x2 ea = ag * c1; f32x2 t; t.x = __builtin_amdgcn_exp2f(ea.x); t.y = __builtin_amdgcn_exp2f(ea.y);
                        const f32x2 d = __builtin_elementwise_fma(t, (f32x2){c2i, c2i}, (f32x2){c2i, c2i}); f32x2 r; r.x = __builtin_amdgcn_rcpf(d.x); r.y = __builtin_amdgcn_rcpf(d.y);
                        const f32x2 hv = (ag * au) * r; h[n * 4 + j] = hv.x; h[n * 4 + j + 1] = hv.y; }
                int w0 = 0, w1 = 0;
                w0 = __builtin_amdgcn_cvt_pk_fp8_f32(h[0], h[1], w0, false); w0 = __builtin_amdgcn_cvt_pk_fp8_f32(h[2], h[3], w0, true);
                w1 = __builtin_amdgcn_cvt_pk_fp8_f32(h[4], h[5], w1, false); w1 = __builtin_amdgcn_cvt_pk_fp8_f32(h[6], h[7], w1, true);
                if (NOSTORE) asm volatile("" :: "v"(w0), "v"(w1)); else *(u32x2*)rowp = (u32x2){(unsigned)w0, (unsigned)w1}; }
    }
};
struct EpiBf16 {
    static constexpr bool PERM = true; static constexpr bool ZEROC = true;
    bf16_t* O; int ldc; float sc;
    __device__ __forceinline__ void operator()(const f32x4 (&acc)[2][2][4][2], const Unit& u, int wr, int wc, int fr, int fq) const {
        const int row0 = u.pm * BM + wr * 64 + fr, col0 = u.pn * BM + wc * 32 + 8 * fq;
#pragma unroll
        for (int ai = 0; ai < 2; ++ai)
#pragma unroll
            for (int m = 0; m < 4; ++m) { bf16_t* rowp = O + (size_t)(row0 + ai * HALF + m * 16) * ldc + col0;
#pragma unroll
                for (int bj = 0; bj < 2; ++bj) { const f32x4 v0 = acc[ai][bj][m][0] * sc, v1 = acc[ai][bj][m][1] * sc;
                    u32x4 w; w.x = cvtpk(v0[0], v0[1]); w.y = cvtpk(v0[2], v0[3]); w.z = cvtpk(v1[0], v1[1]); w.w = cvtpk(v1[2], v1[3]);
                    *(u32x4*)(rowp + bj * HALF) = w; } }
    }
};
}

namespace att {
#define SBAR() __builtin_amdgcn_sched_barrier(0)
__device__ __forceinline__ int crow(int r, int hi) { return (r & 3) + 8 * (r >> 2) + 4 * hi; }
__device__ __forceinline__ void glds16(const void* gsrc, unsigned lds_dst) { unsigned keep;
    asm volatile("s_mov_b32 %0, m0\n\ts_mov_b32 m0, %2\n\ts_nop 0\n\tglobal_load_lds_dwordx4 %1, off\n\ts_mov_b32 m0, %0" : "=&s"(keep) : "v"(gsrc), "s"(lds_dst) : "memory"); }
#define WAIT_BAR0() asm volatile("s_waitcnt vmcnt(0) lgkmcnt(0)\n\ts_barrier" ::: "memory")
typedef LAS const char* lds_cptr;
typedef short v4i16_t __attribute__((ext_vector_type(4)));
__device__ __forceinline__ s16x4 vtr(lds_cptr p) { return __builtin_bit_cast(s16x4, __builtin_amdgcn_ds_read_tr16_b64_v4i16((LAS v4i16_t*)p)); }
__device__ __forceinline__ float hmax(float m) { auto rr = __builtin_amdgcn_permlane32_swap(__float_as_uint(m), __float_as_uint(m), false, false); return fmaxf(__uint_as_float(rr[0]), __uint_as_float(rr[1])); }
__device__ __forceinline__ float hsum(float m) { auto rr = __builtin_amdgcn_permlane32_swap(__float_as_uint(m), __float_as_uint(m), false, false); return __uint_as_float(rr[0]) + __uint_as_float(rr[1]); }

__device__ __forceinline__ void qkt(f32x16& p0, f32x16& p1, lds_cptr kb, const bf16x8 (&qr)[4]) {
    p0 = f32x16{}; p1 = f32x16{};
#pragma unroll
    for (int d0 = 0; d0 < 4; ++d0) {
        const bf16x8 b0 = *(const LAS bf16x8*)(kb + d0 * 2048), b1 = *(const LAS bf16x8*)(kb + d0 * 2048 + 512);
        p0 = __builtin_amdgcn_mfma_f32_32x32x16_bf16(b0, qr[d0], p0, 0, 0, 0);
        p1 = __builtin_amdgcn_mfma_f32_32x32x16_bf16(b1, qr[d0], p1, 0, 0, 0); }
}
template <int ND>
__device__ __forceinline__ void softmax_pv(f32x16& p0, f32x16& p1, f32x16 (&oT)[ND], float& m, float& l, lds_cptr vp) {
    float rm = p0[0];
#pragma unroll
    for (int r = 1; r < 16; ++r) rm = fmaxf(rm, p0[r]);
#pragma unroll
    for (int r = 0; r < 16; ++r) rm = fmaxf(rm, p1[r]);
    rm = hmax(rm);
    const float mn = fmaxf(m, rm);
    const float alpha = __builtin_amdgcn_exp2f(m - mn);
    m = mn;
    float s = 0.f;
#pragma unroll
    for (int r = 0; r < 16; ++r) { p0[r] = __builtin_amdgcn_exp2f(p0[r] - mn); p1[r] = __builtin_amdgcn_exp2f(p1[r] - mn); s += p0[r] + p1[r]; }
    l = l * alpha + s;
#pragma unroll
    for (int d = 0; d < ND; ++d) oT[d] = oT[d] * alpha;
    u32x4 pw[4];
#pragma unroll
    for (int k = 0; k < 2; ++k) {
        pw[k]     = (u32x4){cvtpk(p0[8 * k], p0[8 * k + 1]), cvtpk(p0[8 * k + 2], p0[8 * k + 3]), cvtpk(p0[8 * k + 4], p0[8 * k + 5]), cvtpk(p0[8 * k + 6], p0[8 * k + 7])};
        pw[2 + k] = (u32x4){cvtpk(p1[8 * k], p1[8 * k + 1]), cvtpk(p1[8 * k + 2], p1[8 * k + 3]), cvtpk(p1[8 * k + 4], p1[8 * k + 5]), cvtpk(p1[8 * k + 6], p1[8 * k + 7])}; }
#pragma unroll
    for (int d = 0; d < ND; ++d)
#pragma unroll
        for (int ks = 0; ks < 4; ++ks) {
            const s16x4 lo = vtr(vp + d * 4096 + ks * 1024), hi = vtr(vp + d * 4096 + ks * 1024 + 512);
            const bf16x8 vf = (bf16x8){lo[0], lo[1], lo[2], lo[3], hi[0], hi[1], hi[2], hi[3]};
            oT[d] = __builtin_amdgcn_mfma_f32_32x32x16_bf16(vf, __builtin_bit_cast(bf16x8, pw[ks]), oT[d], 0, 0, 0); }
}
template <int ND>
__device__ __forceinline__ void stg_flush(const LAS unsigned char* stg, bf16_t* ybase, int lane) {
    constexpr int RB = ND * 64 + 16, CPR = ND * 4;
#pragma unroll
    for (int i = 0; i < 32 * CPR / 64; ++i) { const int idx = i * 64 + lane, row = idx / CPR, ch = idx % CPR;
        const u32x4 v = *(const LAS u32x4*)(stg + row * RB + ch * 16); *(u32x4*)(ybase + (size_t)row * DM + ch * 8) = v; }
}
template <int ROWB>
__device__ __forceinline__ void stg_flush_bytes(const LAS unsigned char* stg, unsigned char* ybase, size_t ystride, int lane) {
    constexpr int RB = ROWB + 16, CPR = ROWB / 16;
#pragma unroll
    for (int i = 0; i < 32 * CPR / 64; ++i) { const int idx = i * 64 + lane, row = idx / CPR, ch = idx % CPR;
        const u32x4 v = *(const LAS u32x4*)(stg + row * RB + ch * 16); *(u32x4*)(ybase + (size_t)row * ystride + ch * 16) = v; }
}
template <int ND>
__device__ __forceinline__ void store_oT(const f32x16 (&oT)[ND], float scale, bf16_t* ybase, size_t elem_off, int hi) {
    if (OUTPROJ_FP8) { unsigned char* orow = (unsigned char*)ybase + elem_off; const float sc8 = scale * Y_SCALE;
#pragma unroll
        for (int d = 0; d < ND; ++d)
#pragma unroll
            for (int g = 0; g < 4; ++g) { int t = 0; t = __builtin_amdgcn_cvt_pk_fp8_f32(oT[d][4 * g] * sc8, oT[d][4 * g + 1] * sc8, t, false); t = __builtin_amdgcn_cvt_pk_fp8_f32(oT[d][4 * g + 2] * sc8, oT[d][4 * g + 3] * sc8, t, true);
                *(unsigned*)(orow + d * 32 + 8 * g + 4 * hi) = (unsigned)t; } }
    else { bf16_t* orow = ybase + elem_off;
#pragma unroll
        for (int d = 0; d < ND; ++d)
#pragma unroll
            for (int g = 0; g < 4; ++g) { u32x2 w; w.x = cvtpk(oT[d][4 * g] * scale, oT[d][4 * g + 1] * scale); w.y = cvtpk(oT[d][4 * g + 2] * scale, oT[d][4 * g + 3] * scale);
                *(u32x2*)(orow + d * 32 + 8 * g + 4 * hi) = w; } }
}
constexpr int NA_BIAS_OFF = 65536;
struct DiffArgs { const bf16_t* qkv; bf16_t* y; const float* subln_g; float lam; float omli; int with_ctx; const bf16_t* q; };

#define DF_THR 8.0f
#define DF_BAR()   asm volatile("s_waitcnt lgkmcnt(0)\n\ts_barrier" ::: "memory")
#define DF_BARV()  asm volatile("s_waitcnt vmcnt(0) lgkmcnt(0)\n\ts_barrier" ::: "memory")
__device__ __forceinline__ void diff_phase2(LAS unsigned char* lds, const DiffArgs A, int vcu, int G) {
    int tid = threadIdx.x; asm volatile("" : "+v"(tid));
    const int lane = tid & 63, r32 = lane & 31, hi = lane >> 5; const int wid = __builtin_amdgcn_readfirstlane(tid >> 6);
    constexpr int P = 3072;
    const unsigned lds0 = (unsigned)(uintptr_t)lds;
    const lds_cptr l3 = (lds_cptr)lds;
    const int mp = wid >> 2, qsub = wid & 3;
    LAS float* xch = (LAS float*)lds + qsub * 4096 + lane;
    const int nmain = NB * 8 * 32, nunits = nmain + (A.with_ctx ? NB * 8 * 2 : 0);
    for (int u = vcu; u < nunits; u += G) {
        int b, h, qrow0, NT; const bool ctxu = u >= nmain;
        if (!ctxu) { const int qb = u & 31; h = (u >> 5) & 7; b = u >> 8; qrow0 = b * SEQ + 128 * qb + 32 * qsub; NT = 4 + 64; }
        else { const int v = u - nmain; const int qb = v & 1; h = (v >> 1) & 7; b = v >> 4; qrow0 = MX + b * CTXL + 128 * qb + 32 * qsub; NT = 4; }
        const bf16_t* Kc = A.qkv + (size_t)(MX + b * CTXL) * P + 1024 + 128 * h;
        const bf16_t* Kx = A.qkv + (size_t)(b * SEQ) * P + 1024 + 128 * h;
        const int krow = 8 * wid + (lane >> 3); const size_t koff = (size_t)krow * P + (((lane & 7) ^ ((krow >> 1) & 7)) * 8);
        const int pv0 = 2 * wid, pv1 = 2 * wid + 1;
        const int vra = 4 * pv0 + (lane >> 4), vrb = 4 * pv1 + (lane >> 4); const int vph = lane & 15;
        const size_t voffa = (size_t)vra * P + 1024 + ((((vph >> 2) ^ (vra & 3)) << 2) | (vph & 3)) * 8;
        const size_t voffb = (size_t)vrb * P + 1024 + ((((vph >> 2) ^ (vrb & 3)) << 2) | (vph & 3)) * 8;
#define DF_DMA(t) do { if ((t) < NT) { const int slot_ = (t) % 3; const bf16_t* base_ = ((t) < 4) ? Kc + (size_t)(t) * 64 * P : Kx + (size_t)((t) - 4) * 64 * P; \
        glds16(base_ + koff,      (unsigned)__builtin_amdgcn_readfirstlane(lds0 + slot_ * 32768 + wid * 1024)); \
        glds16(base_ + koff + 64, (unsigned)__builtin_amdgcn_readfirstlane(lds0 + slot_ * 32768 + 8192 + wid * 1024)); \
        glds16(base_ + voffa,     (unsigned)__builtin_amdgcn_readfirstlane(lds0 + slot_ * 32768 + 16384 + pv0 * 1024)); \
        glds16(base_ + voffb,     (unsigned)__builtin_amdgcn_readfirstlane(lds0 + slot_ * 32768 + 16384 + pv1 * 1024)); } } while (0)
        DF_DMA(0);
        bf16x8 qr[4];
        { const bf16_t* Qw = A.qkv + (size_t)(qrow0 + r32) * P + h * 128 + mp * 64;
#pragma unroll
          for (int d0 = 0; d0 < 4; ++d0) qr[d0] = *(const bf16x8*)(Qw + d0 * 16 + hi * 8); }
        f32x16 oT[4]; oT[0] = f32x16{}; oT[1] = f32x16{}; oT[2] = f32x16{}; oT[3] = f32x16{};
        float m = 0.f, l = 0.f;
        f32x16 p0, p1; u32x4 pw[4];
        const int ksw = (r32 >> 1) & 7; const lds_cptr kp0 = l3 + mp * 8192 + r32 * 128 + ((hi ^ (ksw & 1)) << 4); const int ks2 = ksw >> 1;
        const int vq = (lane & 15) >> 2; const lds_cptr vp0 = l3 + 16384 + (4 * hi + vq) * 256 + ((lane >> 4) & 1) * 32 + (lane & 3) * 8;
#define DF_LOADV(dst, vp_, d) do { const lds_cptr vd_ = (vp_) + (((d) ^ vq) << 6); _Pragma("unroll") for (int ks = 0; ks < 4; ++ks) { const s16x4 lo_ = vtr(vd_ + ks * 4096), hi_ = vtr(vd_ + ks * 4096 + 2048); \
            dst[ks] = (bf16x8){lo_[0], lo_[1], lo_[2], lo_[3], hi_[0], hi_[1], hi_[2], hi_[3]}; } } while (0)
#define DF_PV4(src, d) do { _Pragma("unroll") for (int ks = 0; ks < 4; ++ks) oT[d] = __builtin_amdgcn_mfma_f32_32x32x16_bf16(src[ks], __builtin_bit_cast(bf16x8, pw[ks]), oT[d], 0, 0, 0); } while (0)
#define DF_LOADK(dst, kb_, dd) do { dst[0] = *(const LAS bf16x8*)((kb_) + ((((dd)) ^ ks2) << 5)); dst[1] = *(const LAS bf16x8*)((kb_) + ((((dd)) ^ ks2) << 5) + 4096); \
            dst[2] = *(const LAS bf16x8*)((kb_) + ((((dd) + 1) ^ ks2) << 5)); dst[3] = *(const LAS bf16x8*)((kb_) + ((((dd) + 1) ^ ks2) << 5) + 4096); } while (0)
#define DF_QK4(src, dd) do { p0 = __builtin_amdgcn_mfma_f32_32x32x16_bf16(src[0], qr[dd], p0, 0, 0, 0); p1 = __builtin_amdgcn_mfma_f32_32x32x16_bf16(src[1], qr[dd], p1, 0, 0, 0); \
            p0 = __builtin_amdgcn_mfma_f32_32x32x16_bf16(src[2], qr[(dd) + 1], p0, 0, 0, 0); p1 = __builtin_amdgcn_mfma_f32_32x32x16_bf16(src[3], qr[(dd) + 1], p1, 0, 0, 0); } while (0)
#define DF_PREV(vso) do { const lds_cptr vq_ = vp0 + (vso); DF_LOADV(fa, vq_, 0); DF_LOADV(fb, vq_, 1); SBAR(); } while (0)
#define DF_PINIT() do { _Pragma("unroll") for (int r = 0; r < 16; ++r) { p0[r] = -m; p1[r] = -m; } } while (0)
#define DF_SEGM(DO_PV, DO_QK, vso, kso) do { const lds_cptr vp_ = vp0 + (vso); const lds_cptr kb_ = kp0 + (kso); SBAR(); __builtin_amdgcn_s_setprio(1); \
        if (DO_PV) { DF_PV4(fa, 0); SBAR(); DF_LOADV(fa, vp_, 2); SBAR(); \
            DF_PV4(fb, 1); SBAR(); DF_LOADV(fb, vp_, 3); if (DO_QK) { DF_PINIT(); } SBAR(); \
            DF_PV4(fa, 2); SBAR(); if (DO_QK) { DF_LOADK(fa, kb_, 0); } SBAR(); \
            DF_PV4(fb, 3); SBAR(); if (DO_QK) { DF_LOADK(fb, kb_, 2); } SBAR(); } \
        else if (DO_QK) { DF_LOADK(fa, kb_, 0); DF_LOADK(fb, kb_, 2); DF_PINIT(); SBAR(); } \
        if (DO_QK) { DF_QK4(fa, 0); SBAR(); DF_QK4(fb, 2); SBAR(); } \
        __builtin_amdgcn_s_setprio(0); } while (0)
#define DF_SEGV(t) do { \
        float rm = p0[0]; \
        _Pragma("unroll") for (int r = 1; r < 16; ++r) rm = fmaxf(rm, p0[r]); \
        _Pragma("unroll") for (int r = 0; r < 16; ++r) rm = fmaxf(rm, p1[r]); \
        rm = hmax(rm); \
        if ((t) == 0 || __any(rm > DF_THR)) { const float dl = ((t) == 0) ? rm : fmaxf(rm, 0.f); m += dl; \
            _Pragma("unroll") for (int r = 0; r < 16; ++r) { p0[r] -= dl; p1[r] -= dl; } \
            const float f = __builtin_amdgcn_exp2f(-dl); l *= f; \
            _Pragma("unroll") for (int d = 0; d < 4; ++d) oT[d] = oT[d] * f; } \
        float s_ = 0.f; \
        _Pragma("unroll") for (int r = 0; r < 16; ++r) { p0[r] = __builtin_amdgcn_exp2f(p0[r]); p1[r] = __builtin_amdgcn_exp2f(p1[r]); s_ += p0[r] + p1[r]; } \
        l += s_; \
        _Pragma("unroll") for (int k = 0; k < 2; ++k) { \
            pw[k]     = (u32x4){cvtpk(p0[8 * k], p0[8 * k + 1]), cvtpk(p0[8 * k + 2], p0[8 * k + 3]), cvtpk(p0[8 * k + 4], p0[8 * k + 5]), cvtpk(p0[8 * k + 6], p0[8 * k + 7])}; \
            pw[2 + k] = (u32x4){cvtpk(p1[8 * k], p1[8 * k + 1]), cvtpk(p1[8 * k + 2], p1[8 * k + 3]), cvtpk(p1[8 * k + 4], p1[8 * k + 5]), cvtpk(p1[8 * k + 6], p1[8 * k + 7])}; } \
        } while (0)
        DF_BARV();
        int so_p = 0, so_c = 0;
#define DF_ROT() do { so_p = so_c; so_c = (so_c == 65536) ? 0 : so_c + 32768; } while (0)
        bf16x8 fa[4], fb[4];
        if (mp == 0) {
            DF_DMA(1); DF_SEGM(false, true, 0, so_c); SBAR(); DF_PREV(so_c); DF_SEGV(0); SBAR(); DF_BARV(); SBAR();
            for (int t = 1; t < NT; ++t) { DF_ROT();
                DF_DMA(t + 1); DF_SEGM(true, true, so_p, so_c); SBAR(); DF_PREV(so_c); DF_SEGV(t); SBAR(); DF_BARV(); SBAR(); }
            DF_ROT();
            DF_SEGM(true, false, so_p, 0); SBAR(); DF_BARV(); SBAR();
        } else {
            DF_DMA(1); DF_SEGM(false, true, 0, so_c); SBAR(); DF_BARV(); SBAR();
            for (int t = 1; t < NT; ++t) { DF_ROT();
                DF_DMA(t + 1); DF_PREV(so_p); DF_SEGV(t - 1); SBAR(); DF_SEGM(true, true, so_p, so_c); SBAR(); DF_BARV(); SBAR(); }
            DF_ROT();
            DF_PREV(so_p); DF_SEGV(NT - 1); SBAR(); DF_SEGM(true, false, so_p, 0); SBAR(); DF_BARV(); SBAR();
        }
#undef DF_ROT
        l = hsum(l);
        const float il = 1.f / l;
        if (mp == 1) { const float sc = il * A.lam;
#pragma unroll
            for (int d = 0; d < 4; ++d)
#pragma unroll
                for (int q = 0; q < 16; ++q) xch[(d * 16 + q) * 64] = oT[d][q] * sc; }
        DF_BARV();
        if (mp == 0) {
            float ss = 0.f;
#pragma unroll
            for (int d = 0; d < 4; ++d)
#pragma unroll
                for (int q = 0; q < 16; ++q) { const float v = oT[d][q] * il - xch[(d * 16 + q) * 64]; oT[d][q] = v; ss += v * v; }
            ss = hsum(ss);
            const float rstd = rsqrtf(ss * (1.f / 128.f) + RMS_EPS) * A.omli;
            const size_t eo = (size_t)(qrow0 + r32) * DM + h * 128;
#pragma unroll
            for (int d = 0; d < 4; ++d)
#pragma unroll
                for (int g = 0; g < 4; ++g) { const f32x4 gg = *(const f32x4*)(A.subln_g + d * 32 + 8 * g + 4 * hi);
                    if (OUTPROJ_FP8) { const float r8 = rstd * Y_SCALE; int t = 0; t = __builtin_amdgcn_cvt_pk_fp8_f32(oT[d][4 * g] * r8 * gg[0], oT[d][4 * g + 1] * r8 * gg[1], t, false);
                        t = __builtin_amdgcn_cvt_pk_fp8_f32(oT[d][4 * g + 2] * r8 * gg[2], oT[d][4 * g + 3] * r8 * gg[3], t, true);
                        *(unsigned*)((unsigned char*)A.y + eo + d * 32 + 8 * g + 4 * hi) = (unsigned)t; }
                    else { u32x2 w; w.x = cvtpk(oT[d][4 * g] * rstd * gg[0], oT[d][4 * g + 1] * rstd * gg[1]); w.y = cvtpk(oT[d][4 * g + 2] * rstd * gg[2], oT[d][4 * g + 3] * rstd * gg[3]);
                        *(u32x2*)(A.y + eo + d * 32 + 8 * g + 4 * hi) = w; } }
        }
        DF_BAR();
#undef DF_DMA
#undef DF_SEGM
#undef DF_SEGV
#undef DF_PINIT
#undef DF_PREV
#undef DF_LOADV
#undef DF_PV4
#undef DF_LOADK
#undef DF_QK4
    }
}

#define D3_PIN(x) asm volatile("" : "+v"(x))
#define D3_EX(v) __builtin_amdgcn_exp2f(v)
__device__ __forceinline__ void diff_phase3(LAS unsigned char* lds, const DiffArgs A, int vcu, int G) {
    int tid = threadIdx.x; asm volatile("" : "+v"(tid));
    const int lane = tid & 63, r32 = lane & 31, hi = lane >> 5; const int wid = __builtin_amdgcn_readfirstlane(tid >> 6);
    constexpr int P = 3072;
    const unsigned lds0 = (unsigned)(uintptr_t)lds;
    const lds_cptr l3 = (lds_cptr)lds;
    const int mp = wid >> 2, qsub = wid & 3;
    const int nmain = NB * 8 * 32, nunits = nmain + (A.with_ctx ? NB * 8 * 2 : 0);
    for (int u = vcu; u < nunits; u += G) {
        int b, h, qrow0, NT; const bool ctxu = u >= nmain;
        if (!ctxu) { const int qb = u & 31; h = (u >> 5) & 7; b = u >> 8; qrow0 = b * SEQ + 128 * qb + 32 * qsub; NT = 4 + 64; }
        else { const int v = u - nmain; const int qb = v & 1; h = (v >> 1) & 7; b = v >> 4; qrow0 = MX + b * CTXL + 128 * qb + 32 * qsub; NT = 4; }
        const bf16_t* Kc = A.qkv + (size_t)(MX + b * CTXL) * P + 1024 + 128 * h;
        const bf16_t* Kx = A.qkv + (size_t)(b * SEQ) * P + 1024 + 128 * h;
        const int kra = 16 * qsub + (lane >> 3), krb = kra + 8; const int vr0 = 16 * qsub + (lane >> 4); const int vph = lane & 15;
        const unsigned d0 = mp ? (unsigned)vr0 * P + 1024 + ((((vph >> 2) ^ (vr0 & 3)) << 2) | (vph & 3)) * 8 : (unsigned)kra * P + (((lane & 7) ^ ((kra >> 1) & 7)) * 8);
        const unsigned d1 = mp ? d0 + 4 * P : (unsigned)krb * P + (((lane & 7) ^ ((krb >> 1) & 7)) * 8);
        const unsigned inc2 = mp ? 8 * P : 64;
        const unsigned e0 = lds0 + (mp ? 32768 + qsub * 4096 : qsub * 2048), e2 = e0 + (mp ? 2048 : 8192);
#define D3_DMA(t) do { const int t_ = (t); if (t_ < NT) { const bf16_t* base_ = (t_ < 4) ? Kc + (size_t)t_ * 64 * P : Kx + (size_t)(t_ - 4) * 64 * P; \
        const unsigned so_ = (mp ? (t_ & 3) : (t_ & 1)) * 16384; \
        glds16(base_ + d0,        (unsigned)__builtin_amdgcn_readfirstlane(e0 + so_)); \
        glds16(base_ + d1,        (unsigned)__builtin_amdgcn_readfirstlane(e0 + so_ + 1024)); \
        glds16(base_ + d0 + inc2, (unsigned)__builtin_amdgcn_readfirstlane(e2 + so_)); \
        glds16(base_ + d1 + inc2, (unsigned)__builtin_amdgcn_readfirstlane(e2 + so_ + 1024)); } } while (0)
#define D3_WAITBAR(T) do { if (mp == 0 || (T) + 1 >= NT) DF_BARV(); else asm volatile("s_waitcnt vmcnt(4) lgkmcnt(0)\n\ts_barrier" ::: "memory"); } while (0)
        D3_DMA(0);
        bf16x8 qr[4];
        { const bf16_t* Qw = A.q + ((size_t)(qrow0 >> 5) * 16 + 2 * h + mp) * 2048 + hi * 256 + r32 * 8;
#pragma unroll
          for (int d0 = 0; d0 < 4; ++d0) qr[d0] = *(const bf16x8*)(Qw + d0 * 512); }
        f32x16 oT[4]; oT[0] = f32x16{}; oT[1] = f32x16{}; oT[2] = f32x16{}; oT[3] = f32x16{};
        f32x16 negm;
        float m = 0.f, l = 0.f, rf = 1.f; bool resc = false;
        f32x16 pA0, pA1, pB0, pB1; u32x4 pw0, pw1, pw2, pw3;
        const int ksw = (r32 >> 1) & 7; const lds_cptr kp0 = l3 + mp * 8192 + r32 * 128 + ((hi ^ (ksw & 1)) << 4); const int ks2 = ksw >> 1;
        const int vq = (lane & 15) >> 2; const lds_cptr vp0 = l3 + 32768 + (4 * hi + vq) * 256 + ((lane >> 4) & 1) * 32 + (lane & 3) * 8;
#define D3_KF(kb_, g) (*(const LAS bf16x8*)((kb_) + (((((g) >> 1)) ^ ks2) << 5) + ((g) & 1) * 4096))
#define D3_VF(vp_, g) ({ const lds_cptr vd_ = (vp_) + (((((g) >> 2)) ^ vq) << 6) + ((g) & 3) * 4096; const s16x4 lo_ = vtr(vd_), hi_ = vtr(vd_ + 2048); (bf16x8){lo_[0], lo_[1], lo_[2], lo_[3], hi_[0], hi_[1], hi_[2], hi_[3]}; })
#define D3_PK(P, B) cvtpk(P[B], P[(B) + 1])
#define D3_KSEL(g) (((g) & 1) ? kf1 : kf0)
#define D3_GA(g, C0, C1, Q0, Q1, HASQK, HASVA, FIRST) do { \
        if (HASQK) { \
            if ((g) == 0) { if (FIRST) C0 = __builtin_amdgcn_mfma_f32_32x32x16_bf16(D3_KSEL(g), qr[0], f32x16{}, 0, 0, 0); else C0 = __builtin_amdgcn_mfma_f32_32x32x16_bf16(D3_KSEL(g), qr[0], negm, 0, 0, 0); } \
            else if ((g) == 1) { if (FIRST) C1 = __builtin_amdgcn_mfma_f32_32x32x16_bf16(D3_KSEL(g), qr[0], f32x16{}, 0, 0, 0); else C1 = __builtin_amdgcn_mfma_f32_32x32x16_bf16(D3_KSEL(g), qr[0], negm, 0, 0, 0); } \
            else if ((g) & 1) C1 = __builtin_amdgcn_mfma_f32_32x32x16_bf16(D3_KSEL(g), qr[(g) >> 1], C1, 0, 0, 0); else C0 = __builtin_amdgcn_mfma_f32_32x32x16_bf16(D3_KSEL(g), qr[(g) >> 1], C0, 0, 0, 0); \
            if ((g) + 2 < 8) { if ((g) & 1) kf1 = D3_KF(kb_, (g) + 2); else kf0 = D3_KF(kb_, (g) + 2); } } \
        if (HASVA) { if ((g) == 6) vf0 = D3_VF(vp_, 0); if ((g) == 7) vf1 = D3_VF(vp_, 1); } \
        if (HASVA) { if ((g) < 5) { Q1[5 + 2 * (g)] = D3_EX(Q1[5 + 2 * (g)]); Q1[6 + 2 * (g)] = D3_EX(Q1[6 + 2 * (g)]); } if ((g) == 5) { Q1[15] = D3_EX(Q1[15]); } \
            if ((g) == 0) { pw0[0] = D3_PK(Q0, 0); pw0[1] = D3_PK(Q0, 2); } if ((g) == 1) { pw0[2] = D3_PK(Q0, 4); pw0[3] = D3_PK(Q0, 6); D3_PIN(pw0); } \
            if ((g) == 2) { pw1[0] = D3_PK(Q0, 8); pw1[1] = D3_PK(Q0, 10); } if ((g) == 3) { pw1[2] = D3_PK(Q0, 12); pw1[3] = D3_PK(Q0, 14); D3_PIN(pw1); } \
            if ((g) == 4) { pw2[0] = D3_PK(Q1, 0); pw2[1] = D3_PK(Q1, 2); } if ((g) == 5) { pw2[2] = D3_PK(Q1, 4); pw2[3] = D3_PK(Q1, 6); D3_PIN(pw2); } \
            if ((g) == 6) { pw3[0] = D3_PK(Q1, 8); pw3[1] = D3_PK(Q1, 10); } if ((g) == 7) { pw3[2] = D3_PK(Q1, 12); pw3[3] = D3_PK(Q1, 14); D3_PIN(pw3); } \
            } \
        SBAR(); } while (0)
#define D3_PWSEL(g) (((g) & 3) == 0 ? pw0 : ((g) & 3) == 1 ? pw1 : ((g) & 3) == 2 ? pw2 : pw3)
#define D3_EXI(C0, C1, e) do { if ((e) < 16) C0[(e) & 15] = D3_EX(C0[(e) & 15]); else C1[(e) & 15] = D3_EX(C1[(e) & 15]); } while (0)
#define D3_GB(g, C0, C1, Q0, Q1, HASPV, HASVB, FIRST) do { \
        if (HASPV) { \
            oT[(g) >> 2] = __builtin_amdgcn_mfma_f32_32x32x16_bf16(((g) & 1) ? vf1 : vf0, __builtin_bit_cast(bf16x8, D3_PWSEL(g)), oT[(g) >> 2], 0, 0, 0); \
            if ((g) + 2 < 16) { if ((g) & 1) vf1 = D3_VF(vp_, (g) + 2); else vf0 = D3_VF(vp_, (g) + 2); } } \
        if (HASPV) { if ((g) < 4) { sacc += Q0[4 * ((g) & 3)]; sacc += Q0[4 * ((g) & 3) + 1]; sacc += Q0[4 * ((g) & 3) + 2]; sacc += Q0[4 * ((g) & 3) + 3]; D3_PIN(sacc); } \
            else if ((g) < 8) { sacc += Q1[4 * ((g) & 3)]; sacc += Q1[4 * ((g) & 3) + 1]; sacc += Q1[4 * ((g) & 3) + 2]; sacc += Q1[4 * ((g) & 3) + 3]; D3_PIN(sacc); } \
            else if ((g) == 8) { l += sacc; } } \
        if (HASVB) { if ((g) < 4) { rmx = fmaxf(fmaxf(rmx, C0[4 * ((g) & 3)]), C0[4 * ((g) & 3) + 1]); rmx = fmaxf(fmaxf(rmx, C0[4 * ((g) & 3) + 2]), C0[4 * ((g) & 3) + 3]); D3_PIN(rmx); } \
            else if ((g) < 8) { rmx = fmaxf(fmaxf(rmx, C1[4 * ((g) & 3)]), C1[4 * ((g) & 3) + 1]); rmx = fmaxf(fmaxf(rmx, C1[4 * ((g) & 3) + 2]), C1[4 * ((g) & 3) + 3]); D3_PIN(rmx); } \
            else if ((g) == 8) { rmx = hmax(rmx); resc = false; \
                if (FIRST || __any(rmx > DF_THR)) { const float dl = FIRST ? rmx : fmaxf(rmx, 0.f); m += dl; \
                    _Pragma("unroll") for (int r_ = 0; r_ < 16; ++r_) { C0[r_] -= dl; C1[r_] -= dl; negm[r_] = -m; } D3_PIN(negm); \
                    rf = D3_EX(-dl); l *= rf; resc = true; } } \
            else { const int e0_ = 3 * ((g) - 9);   \
                D3_EXI(C0, C1, e0_); D3_EXI(C0, C1, e0_ + 1); D3_EXI(C0, C1, e0_ + 2); if (e0_ + 2 < 16) D3_PIN(C0); else D3_PIN(C1); } } \
        SBAR(); } while (0)
#define D3_STEP(C0, C1, Q0, Q1, HASQK, HASPREV, FIRST, T) do { \
        const lds_cptr kb_ = kp0 + ((T) & 1) * 16384; const lds_cptr vp_ = vp0 + (((T) - 1) & 3) * 16384; bf16x8 kf0, kf1, vf0, vf1; float sacc = 0.f, rmx = -3.0e38f; \
        if (HASQK) D3_DMA((T) + 1); \
        SBAR(); if (HASQK) { kf0 = D3_KF(kb_, 0); kf1 = D3_KF(kb_, 1); } \
        D3_GA(0, C0, C1, Q0, Q1, HASQK, HASPREV, FIRST); D3_GA(1, C0, C1, Q0, Q1, HASQK, HASPREV, FIRST); D3_GA(2, C0, C1, Q0, Q1, HASQK, HASPREV, FIRST); D3_GA(3, C0, C1, Q0, Q1, HASQK, HASPREV, FIRST); \
        D3_GA(4, C0, C1, Q0, Q1, HASQK, HASPREV, FIRST); D3_GA(5, C0, C1, Q0, Q1, HASQK, HASPREV, FIRST); D3_GA(6, C0, C1, Q0, Q1, HASQK, HASPREV, FIRST); D3_GA(7, C0, C1, Q0, Q1, HASQK, HASPREV, FIRST); \
        if (HASQK) { if (mp == 1) D3_WAITBAR(T); } \
        D3_GB(0, C0, C1, Q0, Q1, HASPREV, HASQK, FIRST); D3_GB(1, C0, C1, Q0, Q1, HASPREV, HASQK, FIRST); D3_GB(2, C0, C1, Q0, Q1, HASPREV, HASQK, FIRST); D3_GB(3, C0, C1, Q0, Q1, HASPREV, HASQK, FIRST); \
        D3_GB(4, C0, C1, Q0, Q1, HASPREV, HASQK, FIRST); D3_GB(5, C0, C1, Q0, Q1, HASPREV, HASQK, FIRST); D3_GB(6, C0, C1, Q0, Q1, HASPREV, HASQK, FIRST); D3_GB(7, C0, C1, Q0, Q1, HASPREV, HASQK, FIRST); \
        D3_GB(8, C0, C1, Q0, Q1, HASPREV, HASQK, FIRST); D3_GB(9, C0, C1, Q0, Q1, HASPREV, HASQK, FIRST); D3_GB(10, C0, C1, Q0, Q1, HASPREV, HASQK, FIRST); D3_GB(11, C0, C1, Q0, Q1, HASPREV, HASQK, FIRST); \
        D3_GB(12, C0, C1, Q0, Q1, HASPREV, HASQK, FIRST); D3_GB(13, C0, C1, Q0, Q1, HASPREV, HASQK, FIRST); D3_GB(14, C0, C1, Q0, Q1, HASPREV, HASQK, FIRST); D3_GB(15, C0, C1, Q0, Q1, HASPREV, HASQK, FIRST); \
        if (HASQK && resc) { _Pragma("unroll") for (int d_ = 0; d_ < 4; ++d_) oT[d_] = oT[d_] * rf; } \
        if (HASQK) { if (mp == 0) D3_WAITBAR(T); } \
        } while (0)
        DF_BARV();
        D3_STEP(pA0, pA1, pB0, pB1, true, false, true, 0);
        int t = 1;
        for (; t + 1 < NT; t += 2) {
            D3_STEP(pB0, pB1, pA0, pA1, true, true, false, t);
            D3_STEP(pA0, pA1, pB0, pB1, true, true, false, t + 1);
        }
        D3_STEP(pB0, pB1, pA0, pA1, true, true, false, t);
        D3_STEP(pA0, pA1, pB0, pB1, false, true, false, NT);
        l = hsum(l);
        const float il = 1.f / l;
        DF_BAR();
        LAS float* xch = (LAS float*)lds + qsub * 4096 + lane;
        if (mp == 1) { const float sc = il * A.lam;
#pragma unroll
            for (int d = 0; d < 4; ++d)
#pragma unroll
                for (int q = 0; q < 16; ++q) xch[(d * 16 + q) * 64] = oT[d][q] * sc; }
        DF_BAR();
        if (mp == 0) {
            float ss = 0.f;
#pragma unroll
            for (int d = 0; d < 4; ++d)
#pragma unroll
                for (int q = 0; q < 16; ++q) { const float v = oT[d][q] * il - xch[(d * 16 + q) * 64]; oT[d][q] = v; ss += v * v; }
            ss = hsum(ss);
            const float rstd = rsqrtf(ss * (1.f / 128.f) + RMS_EPS) * A.omli;
            LAS unsigned char* stg = lds + qsub * 16384;
#pragma unroll
            for (int d = 0; d < 4; ++d)
#pragma unroll
                for (int g = 0; g < 4; ++g) { const f32x4 gg = *(const f32x4*)(A.subln_g + d * 32 + 8 * g + 4 * hi);
                    if (OUTPROJ_FP8) { const float r8 = rstd * Y_SCALE; int t = 0; t = __builtin_amdgcn_cvt_pk_fp8_f32(oT[d][4 * g] * r8 * gg[0], oT[d][4 * g + 1] * r8 * gg[1], t, false);
                        t = __builtin_amdgcn_cvt_pk_fp8_f32(oT[d][4 * g + 2] * r8 * gg[2], oT[d][4 * g + 3] * r8 * gg[3], t, true); *(LAS unsigned*)(stg + r32 * 144 + d * 32 + 8 * g + 4 * hi) = (unsigned)t; }
                    else { u32x2 w; w.x = cvtpk(oT[d][4 * g] * rstd * gg[0], oT[d][4 * g + 1] * rstd * gg[1]); w.y = cvtpk(oT[d][4 * g + 2] * rstd * gg[2], oT[d][4 * g + 3] * rstd * gg[3]);
                        *(LAS u32x2*)(stg + r32 * 272 + (d * 32 + 8 * g + 4 * hi) * 2) = w; } }
            if (OUTPROJ_FP8) stg_flush_bytes<128>(stg, (unsigned char*)A.y + (size_t)qrow0 * DM + h * 128, DM, lane);
            else stg_flush<4>(stg, A.y + (size_t)qrow0 * DM + h * 128, lane);
        }
        DF_BAR();
#undef D3_DMA
#undef D3_KF
#undef D3_KSEL
#undef D3_VF
#undef D3_PK
#undef D3_GA
#undef D3_GB
#undef D3_EXI
#undef D3_PWSEL
#undef D3_STEP
#undef D3_WAITBAR
    }
}

struct A2Args { const bf16_t* qkv; bf16_t* y; const float* aux; int with_ctx; const bf16_t* q; };
template <int MODE  >
__device__ __forceinline__ void att2_phase(LAS unsigned char* lds, const A2Args A, int vcu, int G) {
    int tid = threadIdx.x; asm volatile("" : "+v"(tid));
    const int lane = tid & 63, r32 = lane & 31, hi = lane >> 5; const int wid = __builtin_amdgcn_readfirstlane(tid >> 6);
    constexpr int P = MODE == 0 ? 1536 : 3072; constexpr int VOFF = MODE == 0 ? 256 : 1024;
    const unsigned lds0 = (unsigned)(uintptr_t)lds;
    const lds_cptr l3 = (lds_cptr)lds;
    const int grp = wid >> 2;
    LAS float* btab = (LAS float*)(lds + NA_BIAS_OFF + 1024);
    const int nmain = MODE == 0 ? NB * 4 * 32 * 2 : NB * 16 * 16;
    const int nunits = nmain + (A.with_ctx ? (MODE == 0 ? NB * 4 * 4 : NB * 16) : 0);
    for (int u = vcu; u < nunits; u += G) {
        int b, hk, hq, qrow0, nwin, k0win; const bool ctxu = u >= nmain; int qs = 0, r = 0, c = 0;
        if (MODE == 0) {
            if (!ctxu) { const int jj = u & 63; hk = (u >> 6) & 3; b = u >> 8; hq = 4 * hk + (wid >> 1); qs = 64 * jj + 32 * (wid & 1); qrow0 = b * SEQ + qs;
                const int ks = max(0, 64 * jj - 128), ke = min(SEQ, 64 * jj + 192); k0win = ks; nwin = (ke - ks) / 64; }
            else { const int v = u - nmain; hk = (v >> 2) & 3; hq = 4 * hk + (v & 3); b = v >> 4; qrow0 = MX + b * CTXL + 32 * wid; nwin = 0; k0win = 0; }
        } else {
            if (!ctxu) { const int uu = u & 15; hk = hq = (u >> 4) & 15; b = u >> 8; r = 4 * uu + (wid >> 1); c = 32 * (wid & 1) + r32; qrow0 = b * SEQ + r * 64 + 32 * (wid & 1);
                const int rs_lo = min(max(4 * uu - 4, 0), 56), rs_hi = min(max(4 * uu + 3 - 4, 0), 56); k0win = rs_lo * 64; nwin = rs_hi + 8 - rs_lo; }
            else { const int v = u - nmain; hk = hq = v & 15; b = v >> 4; qrow0 = MX + b * CTXL + 32 * wid; nwin = 0; k0win = 0; }
        }
        const int NT = 4 + nwin;
        const bf16_t* Kc = A.qkv + (size_t)(MX + b * CTXL) * P + 1024 + 64 * hk;
        const bf16_t* Kx = A.qkv + (size_t)(b * SEQ + k0win) * P + 1024 + 64 * hk;
        const int krow = 8 * wid + (lane >> 3); const size_t koff = (size_t)krow * P + (((lane & 7) ^ ((krow >> 1) & 7)) * 8), voff = (size_t)krow * P + VOFF + (((lane & 7) ^ (((krow >> 1) & 1) << 2)) * 8);
#define A2_DMA(t) do { if ((t) < NT) { const int slot_ = (t) % 3; const bf16_t* base_ = ((t) < 4) ? Kc + (size_t)(t) * 64 * P : Kx + (size_t)((t) - 4) * 64 * P; \
        glds16(base_ + koff, (unsigned)__builtin_amdgcn_readfirstlane(lds0 + slot_ * 16384 + wid * 1024)); \
        glds16(base_ + voff, (unsigned)__builtin_amdgcn_readfirstlane(lds0 + slot_ * 16384 + 8192 + wid * 1024)); } } while (0)
        A2_DMA(0);
        if (MODE == 1) { if (!ctxu && tid < 15 * 31) btab[tid] = A.aux[hq * 465 + tid] * LOG2E; }
        bf16x8 qr[4];
        { const bf16_t* Qw = A.q + ((size_t)(qrow0 >> 5) * 16 + hq) * 2048 + hi * 256 + r32 * 8;
#pragma unroll
          for (int d0 = 0; d0 < 4; ++d0) qr[d0] = *(const bf16x8*)(Qw + d0 * 512); }
        f32x16 oT[2]; oT[0] = f32x16{}; oT[1] = f32x16{};
        float m = 0.f, l = 0.f;
        f32x16 p0, p1; u32x4 pw[4];
        const int ksw = (r32 >> 1) & 7; const lds_cptr kp0 = l3 + r32 * 128 + ((hi ^ (ksw & 1)) << 4); const int ks2 = ksw >> 1;
        const int vq = (lane & 15) >> 2, vsq = (vq >> 1) & 1; const lds_cptr vp0 = l3 + 8192 + (4 * hi + vq) * 128 + ((lane >> 4) & 1) * 32 + (lane & 3) * 8;
        const int rs = min(max(r - 4, 0), 56), cs = min(max(c - 8, 0), 48);
#define A2_LOADV(dst, vp_, d) do { const lds_cptr vd_ = (vp_) + (((d) ^ vsq) << 6); _Pragma("unroll") for (int ks = 0; ks < 4; ++ks) { const s16x4 lo_ = vtr(vd_ + ks * 2048), hi_ = vtr(vd_ + ks * 2048 + 1024); \
            dst[ks] = (bf16x8){lo_[0], lo_[1], lo_[2], lo_[3], hi_[0], hi_[1], hi_[2], hi_[3]}; } } while (0)
#define A2_PV4(src, d) do { _Pragma("unroll") for (int ks = 0; ks < 4; ++ks) oT[d] = __builtin_amdgcn_mfma_f32_32x32x16_bf16(src[ks], __builtin_bit_cast(bf16x8, pw[ks]), oT[d], 0, 0, 0); } while (0)
#define A2_LOADK(dst, kb_, dd) do { dst[0] = *(const LAS bf16x8*)((kb_) + ((((dd)) ^ ks2) << 5)); dst[1] = *(const LAS bf16x8*)((kb_) + ((((dd)) ^ ks2) << 5) + 4096); \
            dst[2] = *(const LAS bf16x8*)((kb_) + ((((dd) + 1) ^ ks2) << 5)); dst[3] = *(const LAS bf16x8*)((kb_) + ((((dd) + 1) ^ ks2) << 5) + 4096); } while (0)
#define A2_QK4(src, dd) do { p0 = __builtin_amdgcn_mfma_f32_32x32x16_bf16(src[0], qr[dd], p0, 0, 0, 0); p1 = __builtin_amdgcn_mfma_f32_32x32x16_bf16(src[1], qr[dd], p1, 0, 0, 0); \
            p0 = __builtin_amdgcn_mfma_f32_32x32x16_bf16(src[2], qr[(dd) + 1], p0, 0, 0, 0); p1 = __builtin_amdgcn_mfma_f32_32x32x16_bf16(src[3], qr[(dd) + 1], p1, 0, 0, 0); } while (0)
#define A2_PREV(vso) do { const lds_cptr vq_ = vp0 + (vso); A2_LOADV(fa, vq_, 0); A2_LOADV(fb, vq_, 1); SBAR(); } while (0)
#define A2_PINIT() do { _Pragma("unroll") for (int q_ = 0; q_ < 16; ++q_) { p0[q_] = -m; p1[q_] = -m; } } while (0)
#define A2_SEGM(DO_PV, DO_QK, vso, kso) do { const lds_cptr kb_ = kp0 + (kso); SBAR(); __builtin_amdgcn_s_setprio(1); \
        if (DO_PV) { A2_PV4(fa, 0); if (DO_QK) { A2_PINIT(); } SBAR(); if (DO_QK) { A2_LOADK(fa, kb_, 0); } SBAR(); A2_PV4(fb, 1); SBAR(); if (DO_QK) { A2_LOADK(fb, kb_, 2); } SBAR(); } \
        else if (DO_QK) { A2_LOADK(fa, kb_, 0); A2_LOADK(fb, kb_, 2); A2_PINIT(); SBAR(); } \
        if (DO_QK) { A2_QK4(fa, 0); SBAR(); A2_QK4(fb, 2); SBAR(); } \
        __builtin_amdgcn_s_setprio(0); } while (0)
#define A2_SEGV(t) do { \
        if ((t) >= 4) { \
            if (MODE == 0) { const int kb0_ = k0win + 64 * ((t) - 4); if ((kb0_ + 63 > qs + 128) || (kb0_ < qs + 31 - 128)) { const int dq_ = kb0_ + 4 * hi - (qs + r32) + 128; \
                _Pragma("unroll") for (int q_ = 0; q_ < 16; ++q_) { const int kk_ = (q_ & 3) + 8 * (q_ >> 2); if ((unsigned)(dq_ + kk_) > 256u) p0[q_] = NEG_BIG; if ((unsigned)(dq_ + kk_ + 32) > 256u) p1[q_] = NEG_BIG; } } } \
            else { const int kr_ = (k0win >> 6) + (t) - 4; const bool rowok_ = (kr_ >= rs) && (kr_ < rs + 8); const int rel_ = rowok_ ? 4 * hi - cs : 1000; const LAS float* bp_ = btab + (rowok_ ? kr_ - r + 7 : 0) * 31 + 4 * hi - c + 15; \
                _Pragma("unroll") for (int q_ = 0; q_ < 16; ++q_) { const int kk_ = (q_ & 3) + 8 * (q_ >> 2); const float b0_ = bp_[kk_], b1_ = bp_[kk_ + 32]; \
                    p0[q_] = ((unsigned)(rel_ + kk_) < 16u) ? p0[q_] + b0_ : NEG_BIG; p1[q_] = ((unsigned)(rel_ + kk_ + 32) < 16u) ? p1[q_] + b1_ : NEG_BIG; } } } \
        float rm = p0[0]; \
        _Pragma("unroll") for (int q_ = 1; q_ < 16; ++q_) rm = fmaxf(rm, p0[q_]); \
        _Pragma("unroll") for (int q_ = 0; q_ < 16; ++q_) rm = fmaxf(rm, p1[q_]); \
        rm = hmax(rm); \
        if ((t) == 0 || __any(rm > DF_THR)) { const float dl = ((t) == 0) ? rm : fmaxf(rm, 0.f); m += dl; \
            _Pragma("unroll") for (int q_ = 0; q_ < 16; ++q_) { p0[q_] -= dl; p1[q_] -= dl; } \
            const float f = __builtin_amdgcn_exp2f(-dl); l *= f; oT[0] = oT[0] * f; oT[1] = oT[1] * f; } \
        float s_ = 0.f; \
        _Pragma("unroll") for (int q_ = 0; q_ < 16; ++q_) { p0[q_] = __builtin_amdgcn_exp2f(p0[q_]); p1[q_] = __builtin_amdgcn_exp2f(p1[q_]); s_ += p0[q_] + p1[q_]; } \
        l += s_; \
        _Pragma("unroll") for (int k = 0; k < 2; ++k) { \
            pw[k]     = (u32x4){cvtpk(p0[8 * k], p0[8 * k + 1]), cvtpk(p0[8 * k + 2], p0[8 * k + 3]), cvtpk(p0[8 * k + 4], p0[8 * k + 5]), cvtpk(p0[8 * k + 6], p0[8 * k + 7])}; \
            pw[2 + k] = (u32x4){cvtpk(p1[8 * k], p1[8 * k + 1]), cvtpk(p1[8 * k + 2], p1[8 * k + 3]), cvtpk(p1[8 * k + 4], p1[8 * k + 5]), cvtpk(p1[8 * k + 6], p1[8 * k + 7])}; } \
        } while (0)
        DF_BARV();
        int so_p = 0, so_c = 0;
#define A2_ROT() do { so_p = so_c; so_c = (so_c == 32768) ? 0 : so_c + 16384; } while (0)
        bf16x8 fa[4], fb[4];
        if (grp == 0) {
            A2_DMA(1); A2_SEGM(false, true, 0, so_c); SBAR(); A2_PREV(so_c); A2_SEGV(0); SBAR(); DF_BARV(); SBAR();
            for (int t = 1; t < NT; ++t) { A2_ROT();
                A2_DMA(t + 1); A2_SEGM(true, true, so_p, so_c); SBAR(); A2_PREV(so_c); A2_SEGV(t); SBAR(); DF_BARV(); SBAR(); }
            A2_ROT();
            A2_SEGM(true, false, so_p, 0); SBAR(); DF_BARV(); SBAR();
        } else {
            A2_DMA(1); A2_SEGM(false, true, 0, so_c); SBAR(); DF_BARV(); SBAR();
            for (int t = 1; t < NT; ++t) { A2_ROT();
                A2_DMA(t + 1); A2_PREV(so_p); A2_SEGV(t - 1); SBAR(); A2_SEGM(true, true, so_p, so_c); SBAR(); DF_BARV(); SBAR(); }
            A2_ROT();
            A2_PREV(so_p); A2_SEGV(NT - 1); SBAR(); A2_SEGM(true, false, so_p, 0); SBAR(); DF_BARV(); SBAR();
        }
        l = hsum(l);
        if (MODE == 0) l += __builtin_amdgcn_exp2f(A.aux[hq] * LOG2E - m);
        if (OUTPROJ_FP8) { LAS unsigned char* stg = lds + wid * 8192; const float sc8 = Y_SCALE / l;
#pragma unroll
            for (int d = 0; d < 2; ++d)
#pragma unroll
                for (int g = 0; g < 4; ++g) { int t = 0; t = __builtin_amdgcn_cvt_pk_fp8_f32(oT[d][4 * g] * sc8, oT[d][4 * g + 1] * sc8, t, false); t = __builtin_amdgcn_cvt_pk_fp8_f32(oT[d][4 * g + 2] * sc8, oT[d][4 * g + 3] * sc8, t, true);
                    *(LAS unsigned*)(stg + r32 * 80 + d * 32 + 8 * g + 4 * hi) = (unsigned)t; }
            stg_flush_bytes<64>(stg, (unsigned char*)A.y + (size_t)qrow0 * DM + hq * 64, DM, lane); }
        else { LAS unsigned char* stg = lds + wid * 8192; const float sc_ = 1.f / l;
#pragma unroll
            for (int d = 0; d < 2; ++d)
#pragma unroll
                for (int g = 0; g < 4; ++g) { u32x2 w; w.x = cvtpk(oT[d][4 * g] * sc_, oT[d][4 * g + 1] * sc_); w.y = cvtpk(oT[d][4 * g + 2] * sc_, oT[d][4 * g + 3] * sc_);
                    *(LAS u32x2*)(stg + r32 * 144 + (d * 32 + 8 * g + 4 * hi) * 2) = w; }
            stg_flush<2>(stg, A.y + (size_t)qrow0 * DM + hq * 64, lane); }
        DF_BAR();
#undef A2_DMA
#undef A2_LOADV
#undef A2_PV4
#undef A2_LOADK
#undef A2_QK4
#undef A2_SEGM
#undef A2_SEGV
#undef A2_PREV
#undef A2_PINIT
#undef A2_ROT
    }
}
#undef SBAR
}

struct Frame {
    LAS unsigned char* lds; volatile LAS unsigned* MISC; unsigned* ctl;
    int tid, lane, wave, vcu, G;
};

__device__ __forceinline__ void transpose_item(const float* W, int K, int N, bf16_t* WT, int k0, int n0, int drow0, LAS float* scr, int lane) {
    f32x4 v[16];
    const float* src = W + (size_t)(k0 + (lane >> 4)) * N + n0 + 4 * (lane & 15);
#pragma unroll
    for (int i = 0; i < 16; ++i) v[i] = *(const f32x4*)(src + (size_t)(4 * i) * N);
#pragma unroll
    for (int i = 0; i < 16; ++i) { LAS float* d = scr + (4 * i + (lane >> 4)) * 65 + 4 * (lane & 15); d[0] = v[i].x; d[1] = v[i].y; d[2] = v[i].z; d[3] = v[i].w; }
    LDS_WAIT(); asm volatile("" ::: "memory");
    const int c = lane & 7;
#pragma unroll
    for (int j = 0; j < 8; ++j) { const int n = (lane >> 3) + 8 * j; const LAS float* s = scr + (8 * c) * 65 + n;
        u32x4 o; o.x = cvtpk(s[0 * 65], s[1 * 65]); o.y = cvtpk(s[2 * 65], s[3 * 65]); o.z = cvtpk(s[4 * 65], s[5 * 65]); o.w = cvtpk(s[6 * 65], s[7 * 65]);
        *(u32x4*)(WT + (size_t)(drow0 + n) * K + k0 + 8 * c) = o; }
    LDS_WAIT(); asm volatile("" ::: "memory");
}

enum { KA_x, KA_c, KA_ctx, KA_c_ctx, KA_ada_w, KA_ada_b, KA_norm1_g, KA_norm2_g, KA_final_g, KA_win_w_in, KA_win_w_out, KA_win_sink, KA_diff_w_in, KA_diff_w_out, KA_diff_lambda, KA_diff_subln_g,
       KA_na_w_in, KA_na_w_out, KA_na_rpb, KA_router_w, KA_w_gate, KA_w_up, KA_w_down, KA_OUT, KA_WS };
__device__ __forceinline__ const float* karg(int i) { asm volatile("" : "+s"(i)); return (const float*)(GAS const float*)(((const unsigned long long __attribute__((address_space(4)))*)__builtin_amdgcn_kernarg_segment_ptr())[i]); }
__device__ __forceinline__ void t8_load(f32x4 (&v)[16], const float* W, int N, int k0, int n0, int lane) {
    const float* src = W + (size_t)(k0 + (lane >> 4)) * N + n0 + 4 * (lane & 15);
#pragma unroll
    for (int i = 0; i < 16; ++i) v[i] = *(const f32x4*)(src + (size_t)(4 * i) * N);
}
__device__ __forceinline__ void t8_finish(const f32x4 (&v)[16], int Kb, unsigned char* WT, int k0, int drow0, LAS float* scr, int lane) {
#pragma unroll
    for (int i = 0; i < 16; ++i) { LAS float* d = scr + (4 * i + (lane >> 4)) * 65 + 4 * (lane & 15); d[0] = v[i].x * W8_SCALE; d[1] = v[i].y * W8_SCALE; d[2] = v[i].z * W8_SCALE; d[3] = v[i].w * W8_SCALE; }
    LDS_WAIT(); asm volatile("" ::: "memory");
    const int c = lane & 3;
#pragma unroll
    for (int j = 0; j < 4; ++j) { const int n = (lane >> 2) + 16 * j; const LAS float* s = scr + (16 * c) * 65 + n;
        int w[4];
#pragma unroll
        for (int q = 0; q < 4; ++q) { int t = 0; t = __builtin_amdgcn_cvt_pk_fp8_f32(s[(4 * q) * 65], s[(4 * q + 1) * 65], t, false); t = __builtin_amdgcn_cvt_pk_fp8_f32(s[(4 * q + 2) * 65], s[(4 * q + 3) * 65], t, true); w[q] = t; }
        *(u32x4*)(WT + (size_t)(drow0 + n) * Kb + k0 + 16 * c) = (u32x4){(unsigned)w[0], (unsigned)w[1], (unsigned)w[2], (unsigned)w[3]}; }
    LDS_WAIT(); asm volatile("" ::: "memory");
}
__device__ __forceinline__ void transpose_item8(const float* W, int Kb, int N, unsigned char* WT, int k0, int n0, int drow0, LAS float* scr, int lane) {
    f32x4 v[16]; t8_load(v, W, N, k0, n0, lane); t8_finish(v, Kb, WT, k0, drow0, scr, lane);
}

struct In {
    const float *x, *c, *ctx, *c_ctx, *ada_w, *ada_b, *norm1_g, *norm2_g, *final_g, *win_w_in, *win_w_out, *win_sink, *diff_w_in, *diff_w_out, *diff_lambda, *diff_subln_g,
        *na_w_in, *na_w_out, *na_rpb, *router_w, *w_gate, *w_up, *w_down;
};

__device__ __forceinline__ void phase_prologue(Frame& F, unsigned char* ws) {
    int tid_ = threadIdx.x; asm volatile("" : "+v"(tid_)); const int lane_ = tid_ & 63; const int wave_ = __builtin_amdgcn_readfirstlane(tid_ >> 6);
    LAS float* scr = (LAS float*)(F.lds + wave_ * 16640);
    const int gw = F.vcu * NWAVES + wave_, NGW = F.G * NWAVES;
    if (F.vcu == 0) {
        float* tab = (float*)(ws + WS_TAB);
        for (int i = tid_; i < 1024; i += 512) { const int pos = i >> 4, f = i & 15; const float inv = 1.0f / powf(10000.0f, (float)(2 * f) / 32.0f); const float ang = (float)pos * inv;
            tab[TAB_COS + i] = cosf(ang); tab[TAB_SIN + i] = sinf(ang); }
        if (wave_ == 0) { const float* lp = karg(KA_diff_lambda); const float a = wave_sum(lp[lane_] * lp[64 + lane_]), b2 = wave_sum(lp[128 + lane_] * lp[192 + lane_]);
            const float li = 0.8f - 0.6f * expf(-0.3f * 1.0f); if (lane_ == 0) { tab[TAB_LAM] = expf(a) - expf(b2) + li; tab[TAB_LAM + 1] = 1.0f - li; } }
    }
    {
        bf16_t* pw = (bf16_t*)(ws + WS_PW);
        constexpr int IT_WI = 16 * 24, IT_O = 16 * 16, IT_3 = 16 * 48;
        constexpr int NIT = 2 * IT_WI + 2 * IT_O + IT_3 + IT_O + IT_3 + IT_O;
        for (int it = gw; it < NIT; it += NGW) {
            int r = it; const float* W; bf16_t* WT; int N;
            if (r < 2 * IT_WI) { const int s = r / IT_WI; r -= s * IT_WI; W = karg(KA_win_w_in) + (size_t)s * 1024 * 1536; WT = pw + (PW_WIN_IN / 2) + (size_t)s * 1536 * 1024; N = 1536; }
            else if ((r -= 2 * IT_WI) < 2 * IT_O) { const int s = r / IT_O; r -= s * IT_O; W = karg(KA_win_w_out) + (size_t)s * 1024 * 1024; WT = pw + (PW_WIN_OUT / 2) + (size_t)s * 1024 * 1024; N = 1024; }
            else if ((r -= 2 * IT_O) < IT_3) { W = karg(KA_diff_w_in); WT = pw + PW_DIFF_IN / 2; N = 3072; }
            else if ((r -= IT_3) < IT_O) { W = karg(KA_diff_w_out); WT = pw + PW_DIFF_OUT / 2; N = 1024; }
            else if ((r -= IT_O) < IT_3) { W = karg(KA_na_w_in); WT = pw + PW_NA_IN / 2; N = 3072; }
            else { r -= IT_3; W = karg(KA_na_w_out); WT = pw + PW_NA_OUT / 2; N = 1024; }
            const int nblk = N / 64, kb = r / nblk, nb = r % nblk;
            if ((INPROJ_FP8 && N != 1024) || (OUTPROJ_FP8 && N == 1024)) transpose_item8(W, 1024, N, (unsigned char*)WT, 64 * kb, 64 * nb, 64 * nb, scr, lane_);
            else transpose_item(W, 1024, N, WT, 64 * kb, 64 * nb, 64 * nb, scr, lane_);
        }
    }
    {
        const int NIT = 64 * 1536;
#define MW_DESC(it_, W_, N_, Kb_, WT_, k0_, n0_, dr_) do { const int le_ = (it_) / 1536; int r_ = (it_) % 1536; \
            unsigned char* W1t_ = ws + WS_MOEW + (size_t)le_ * MOEW_E; \
            if (r_ < 1024) { const bool up_ = r_ >= 512; r_ &= 511; W_ = (up_ ? karg(KA_w_up) : karg(KA_w_gate)) + (size_t)le_ * 1024 * 2048; N_ = 2048; Kb_ = 1024; WT_ = W1t_; \
                k0_ = 64 * (r_ / 32); n0_ = 64 * (r_ % 32); dr_ = (n0_ >> 7) * 256 + (up_ ? 128 : 0) + (n0_ & 127); } \
            else { r_ -= 1024; W_ = karg(KA_w_down) + (size_t)le_ * 2048 * 1024; N_ = 1024; Kb_ = 2048; WT_ = W1t_ + (size_t)4096 * 1024; k0_ = 64 * (r_ / 16); n0_ = 64 * (r_ % 16); dr_ = n0_; } } while (0)
        f32x4 va[16], vb[16];
        const float* Wc = nullptr; int Nc = 0, Kbc = 0, k0c = 0, n0c = 0, drc = 0; unsigned char* WTc = nullptr;
        int it = gw;
        if (it < NIT) { MW_DESC(it, Wc, Nc, Kbc, WTc, k0c, n0c, drc); t8_load(va, Wc, Nc, k0c, n0c, lane_); }
        while (it < NIT) {
            const int itn = it + NGW;
            const float* Wn = Wc; int Nn = Nc, Kbn = Kbc, k0n = k0c, n0n = n0c, drn = drc; unsigned char* WTn = WTc;
            if (itn < NIT) { MW_DESC(itn, Wn, Nn, Kbn, WTn, k0n, n0n, drn); t8_load(vb, Wn, Nn, k0n, n0n, lane_); }
            t8_finish(va, Kbc, WTc, k0c, drc, scr, lane_);
#pragma unroll
            for (int i = 0; i < 16; ++i) va[i] = vb[i];
            Wc = Wn; Nc = Nn; Kbc = Kbn; WTc = WTn; k0c = k0n; n0c = n0n; drc = drn; it = itn;
        }
#undef MW_DESC
    }
    __syncthreads();
    {
        LAS float* sc = (LAS float*)F.lds;
        LAS float* red = (LAS float*)(F.lds + 69632);
        for (int i = tid_; i < 17 * 1024; i += 512) { const float v = (i < 16384) ? karg(KA_c)[i] : karg(KA_c_ctx)[i - 16384]; sc[i] = siluf(v); }
        __syncthreads();
        float* mod = (float*)(ws + WS_MOD);
        for (int task = F.vcu; task < 4 * 192; task += F.G) {
            const int L = task / 192, cg = task % 192, col = cg * 32 + (lane_ & 31), kh = lane_ >> 5;
            const float* wp = karg(KA_ada_w) + (size_t)L * 1024 * 6144 + (size_t)(wave_ * 128 + kh * 64) * 6144 + col;
            const LAS float* scp = sc + wave_ * 128 + kh * 64;
            float acc[17];
#pragma unroll
            for (int r = 0; r < 17; ++r) acc[r] = 0.f;
            for (int k0 = 0; k0 < 64; k0 += 16) { float w[16];
#pragma unroll
                for (int kk = 0; kk < 16; ++kk) w[kk] = wp[(size_t)(k0 + kk) * 6144];
#pragma unroll
                for (int kk = 0; kk < 16; ++kk)
#pragma unroll
                    for (int r = 0; r < 17; ++r) acc[r] += scp[r * 1024 + k0 + kk] * w[kk]; }
#pragma unroll
            for (int r = 0; r < 17; ++r) { acc[r] += __shfl_xor(acc[r], 32); if (lane_ < 32) red[(wave_ * 17 + r) * 32 + lane_] = acc[r]; }
            __syncthreads();
            for (int i = tid_; i < 17 * 32; i += 512) { const int r = i >> 5, ln = i & 31; float sum = 0.f;
#pragma unroll
                for (int w = 0; w < 8; ++w) sum += red[(w * 17 + r) * 32 + ln];
                mod[((size_t)L * 17 + r) * 6144 + cg * 32 + ln] = sum + karg(KA_ada_b)[L * 6144 + cg * 32 + ln]; }
            __syncthreads();
        }
    }
}

__device__ __forceinline__ void load_row(const float* row, int lane, f32x4 (&v)[4]) {
    const f32x4* xr = (const f32x4*)row + lane;
#pragma unroll
    for (int j = 0; j < 4; ++j) v[j] = xr[64 * j];
}
__device__ __forceinline__ void load_row_bf16(const bf16_t* row, int lane, u32x2 (&w)[4]) {
    const u32x2* p = (const u32x2*)row + lane;
#pragma unroll
    for (int j = 0; j < 4; ++j) w[j] = p[64 * j];
}
__device__ __forceinline__ void cvt_row_bf16(f32x4 (&v)[4], const u32x2 (&w)[4]) {
#pragma unroll
    for (int j = 0; j < 4; ++j) { v[j].x = __builtin_bit_cast(float, w[j].x << 16); v[j].y = __builtin_bit_cast(float, w[j].x & 0xffff0000u);
        v[j].z = __builtin_bit_cast(float, w[j].y << 16); v[j].w = __builtin_bit_cast(float, w[j].y & 0xffff0000u); }
}
__device__ __forceinline__ void add_row_bf16(f32x4 (&v)[4], const u32x2 (&w)[4]) {
#pragma unroll
    for (int j = 0; j < 4; ++j) { v[j].x += __builtin_bit_cast(float, w[j].x << 16); v[j].y += __builtin_bit_cast(float, w[j].x & 0xffff0000u);
        v[j].z += __builtin_bit_cast(float, w[j].y << 16); v[j].w += __builtin_bit_cast(float, w[j].y & 0xffff0000u); }
}
__device__ __forceinline__ float row_rstd(const f32x4 (&v)[4]) {
    float s = 0.f;
#pragma unroll
    for (int j = 0; j < 4; ++j) s += (v[j].x * v[j].x + v[j].y * v[j].y) + (v[j].z * v[j].z + v[j].w * v[j].w);
    return rsqrtf(wave_sum_fast(s) * (1.f / DM) + RMS_EPS);
}
__device__ __forceinline__ void store_row_bf16(bf16_t* orow, int lane, const f32x4 (&v)[4]) {
    u32x2* o8 = (u32x2*)orow + lane;
#pragma unroll
    for (int j = 0; j < 4; ++j) { u32x2 w; w.x = cvtpk(v[j].x, v[j].y); w.y = cvtpk(v[j].z, v[j].w); o8[64 * j] = w; }
}
__device__ __forceinline__ void store_row_fp8(unsigned char* orow, int lane, const f32x4 (&v)[4], float scale) {
    unsigned* o4 = (unsigned*)orow + lane;
#pragma unroll
    for (int j = 0; j < 4; ++j) { int t = 0; t = __builtin_amdgcn_cvt_pk_fp8_f32(v[j].x * scale, v[j].y * scale, t, false); t = __builtin_amdgcn_cvt_pk_fp8_f32(v[j].z * scale, v[j].w * scale, t, true); o4[64 * j] = (unsigned)t; }
}
struct ModCache { f32x4 sc[4], sh[4]; int b; };
__device__ __forceinline__ void modcache_load(ModCache& M, int b, const float* g, const float* modL, int shift_chunk, int scale_chunk, int lane) {
    if (M.b == b) return; M.b = b;
    const float* mp = modL + (size_t)b * 6144;
#pragma unroll
    for (int j = 0; j < 4; ++j) { const f32x4 gg = ((const f32x4*)g)[lane + 64 * j], s = ((const f32x4*)(mp + scale_chunk * DM))[lane + 64 * j];
        M.sc[j] = gg * (1.f + s); M.sh[j] = ((const f32x4*)(mp + shift_chunk * DM))[lane + 64 * j]; }
}
__device__ __forceinline__ int row_batch(int m) { return m < MX ? (m >> 12) : 16; }

__device__ __forceinline__ void phase_norm1(Frame& F, const float* x, const float* ctx, const float* g1, const float* modL, bf16_t* H, bf16_t* XB) {
    int tid_ = threadIdx.x; asm volatile("" : "+v"(tid_)); const int lane_ = tid_ & 63; const int wave_ = __builtin_amdgcn_readfirstlane(tid_ >> 6);
    const int gw = F.vcu * NWAVES + wave_, NGW = F.G * NWAVES; const int per = (MT + NGW - 1) / NGW;
    ModCache M; M.b = -1;
    const int m0 = gw * per, m1 = min(MT, m0 + per);
    f32x4 nx[4];
    if (m0 < m1) load_row(m0 < MX ? x + (size_t)m0 * DM : ctx + (size_t)(m0 - MX) * DM, lane_, nx);
    for (int m = m0; m < m1; ++m) {
        f32x4 v[4];
#pragma unroll
        for (int j = 0; j < 4; ++j) v[j] = nx[j];
        if (m + 1 < m1) load_row((m + 1) < MX ? x + (size_t)(m + 1) * DM : ctx + (size_t)(m + 1 - MX) * DM, lane_, nx);
        modcache_load(M, row_batch(m), g1, modL, 0, 1, lane_);
        store_row_bf16(XB + (size_t)m * DM, lane_, v);
        const float rstd = row_rstd(v);
#pragma unroll
        for (int j = 0; j < 4; ++j) v[j] = v[j] * rstd * M.sc[j] + M.sh[j];
        if (INPROJ_FP8) store_row_fp8((unsigned char*)H + (size_t)m * DM, lane_, v, H2_SCALE); else store_row_bf16(H + (size_t)m * DM, lane_, v);
    }
}

__device__ __forceinline__ void phase_norm2_router(Frame& F, const bf16_t* XB, const float* g2, const float* modL, const float* rw, unsigned char* H8, float* aff, int nrows, const bf16_t* P, bool do_router = true) {
    int tid_ = threadIdx.x; asm volatile("" : "+v"(tid_)); const int lane = tid_ & 63; const int wave_ = __builtin_amdgcn_readfirstlane(tid_ >> 6);
    LAS float* rwT = (LAS float*)F.lds;
    for (int i = tid_; i < 16384; i += 512) { const int d = i >> 4, e = i & 15; rwT[e * 1024 + d] = rw[i]; }
    __syncthreads();
    const int gw = F.vcu * NWAVES + wave_, NGW = F.G * NWAVES; constexpr int NR2 = 1; const int ngroups = nrows / NR2; const int per = (ngroups + NGW - 1) / NGW;
    ModCache M; M.b = -1;
    const int g0 = gw * per, g1 = min(ngroups, g0 + per);
    constexpr int ND3 = 3;
    u32x2 nx[ND3][4];
#pragma unroll
    for (int k = 0; k < ND3; ++k) if (g0 + k < g1) { load_row_bf16(XB + (size_t)(g0 + k) * DM, lane, nx[k]); }
    for (int gb = g0; gb < g1; gb += ND3)
#pragma unroll
    for (int k = 0; k < ND3; ++k) {
        const int g = gb + k; if (g >= g1) break;
        const int m = NR2 * g;
        f32x4 v[NR2][4];
        cvt_row_bf16(v[0], nx[k]);
        if (g + ND3 < g1) { load_row_bf16(XB + (size_t)(g + ND3) * DM, lane, nx[k]); }
        modcache_load(M, row_batch(m), g2, modL, 3, 4, lane);
#pragma unroll
        for (int r = 0; r < NR2; ++r) { const float rstd = row_rstd(v[r]);
#pragma unroll
            for (int j = 0; j < 4; ++j) v[r][j] = v[r][j] * rstd * M.sc[j] + M.sh[j];
            store_row_fp8(H8 + (size_t)(m + r) * DM, lane, v[r], H2_SCALE); }
        if (!do_router) continue;
        float pe[NR2][16];
        int lo4 = 4 * lane; asm volatile("" : "+v"(lo4));
#pragma unroll
        for (int eb = 0; eb < 16; eb += 4) {
            f32x4 w[4][4];
#pragma unroll
            for (int e4 = 0; e4 < 4; ++e4)
#pragma unroll
                for (int j = 0; j < 4; ++j) w[e4][j] = *(const LAS f32x4*)(rwT + (eb + e4) * 1024 + lo4 + 256 * j);
            __builtin_amdgcn_sched_barrier(0);
#pragma unroll
            for (int e4 = 0; e4 < 4; ++e4) { f32x2 s2 = {0.f, 0.f};
#pragma unroll
                for (int j = 0; j < 4; ++j) { s2 = __builtin_elementwise_fma((f32x2){v[0][j].x, v[0][j].y}, (f32x2){w[e4][j].x, w[e4][j].y}, s2); s2 = __builtin_elementwise_fma((f32x2){v[0][j].z, v[0][j].w}, (f32x2){w[e4][j].z, w[e4][j].w}, s2); }
                pe[0][eb + e4] = s2.x + s2.y; }
            __builtin_amdgcn_sched_barrier(0);
        }
        {
            LAS float* red = (LAS float*)(F.lds + 65536) + wave_ * 1088;
#pragma unroll
            for (int e = 0; e < 16; ++e) red[lane * 17 + e] = pe[0][e];
            const LAS float* rp = red + (lane >> 4) * 272 + (lane & 15);
            float sacc = 0.f;
#pragma unroll
            for (int i = 0; i < 16; ++i) sacc += rp[i * 17];
            sacc += __shfl_xor(sacc, 16); sacc += __shfl_xor(sacc, 32);
            const float mx = row16_max(sacc);
            const float ex = expf(sacc - mx);
            const float sm = row16_sum(ex);
            if (lane < 16) aff[(size_t)m * 16 + lane] = ex / sm;
        }
    }
    __syncthreads();
}

#define N2_BAR() asm volatile("s_waitcnt lgkmcnt(0)\n\ts_barrier" ::: "memory")
__device__ __forceinline__ void phase_norm2_router_mfma(Frame& F, const bf16_t* XB, const float* g2, const float* modL, const float* rw, unsigned char* H8, float* aff, int nrows) {
    int tid_ = threadIdx.x; asm volatile("" : "+v"(tid_)); const int lane = tid_ & 63; const int wave_ = __builtin_amdgcn_readfirstlane(tid_ >> 6);
    constexpr int AST = 2064;
    LAS unsigned char* Ahi = F.lds; LAS unsigned char* Alo = F.lds + 16 * AST; LAS float* red = (LAS float*)(F.lds + 2 * 16 * AST);
    const int e_ = lane & 15, kg = lane >> 4;
    bf16x8 Bh[4], Bl[4];
#pragma unroll
    for (int s = 0; s < 4; ++s) { const float* wp = rw + (size_t)(128 * wave_ + 32 * s + 8 * kg) * 16 + e_;
        const float x0 = wp[0], x1 = wp[16], x2 = wp[32], x3 = wp[48], x4 = wp[64], x5 = wp[80], x6 = wp[96], x7 = wp[112];
        u32x4 h, l; h.x = cvtpk(x0, x1); h.y = cvtpk(x2, x3); h.z = cvtpk(x4, x5); h.w = cvtpk(x6, x7);
        l.x = cvtpk(x0 - __builtin_bit_cast(float, h.x << 16), x1 - __builtin_bit_cast(float, h.x & 0xffff0000u)); l.y = cvtpk(x2 - __builtin_bit_cast(float, h.y << 16), x3 - __builtin_bit_cast(float, h.y & 0xffff0000u));
        l.z = cvtpk(x4 - __builtin_bit_cast(float, h.z << 16), x5 - __builtin_bit_cast(float, h.z & 0xffff0000u)); l.w = cvtpk(x6 - __builtin_bit_cast(float, h.w << 16), x7 - __builtin_bit_cast(float, h.w & 0xffff0000u));
        Bh[s] = __builtin_bit_cast(bf16x8, h); Bl[s] = __builtin_bit_cast(bf16x8, l); }
    const int ngroups = nrows >> 4; const bool ilv = (F.G == 256); const int per = ilv ? (ngroups >> 8) : (ngroups + F.G - 1) / F.G; const int gg0 = ilv ? 0 : F.vcu * per, gg1 = ilv ? per : min(ngroups, gg0 + per);
#define N2_GROUP(i) (ilv ? ((i) < 16 ? 256 * (F.vcu >> 4) + (F.vcu & 15) + 16 * (i) : 4096 + F.vcu) : (i))
    ModCache M; M.b = -1;
    u32x2 nx[2][4];
    if (gg0 < gg1) { load_row_bf16(XB + (size_t)(N2_GROUP(gg0) * 16 + 2 * wave_) * DM, lane, nx[0]); load_row_bf16(XB + (size_t)(N2_GROUP(gg0) * 16 + 2 * wave_ + 1) * DM, lane, nx[1]); }
    for (int gg = gg0; gg < gg1; ++gg) {
        const int mbase = N2_GROUP(gg) * 16;
        f32x4 v[2][4];
        cvt_row_bf16(v[0], nx[0]); cvt_row_bf16(v[1], nx[1]);
        if (gg + 1 < gg1) { const int mn_ = N2_GROUP(gg + 1) * 16; load_row_bf16(XB + (size_t)(mn_ + 2 * wave_) * DM, lane, nx[0]); load_row_bf16(XB + (size_t)(mn_ + 2 * wave_ + 1) * DM, lane, nx[1]); }
#pragma unroll
        for (int r = 0; r < 2; ++r) { const int tok = 2 * wave_ + r, m = mbase + tok;
            modcache_load(M, row_batch(m), g2, modL, 3, 4, lane);
            const float rstd = row_rstd(v[r]);
#pragma unroll
            for (int j = 0; j < 4; ++j) v[r][j] = v[r][j] * rstd * M.sc[j] + M.sh[j];
            store_row_fp8(H8 + (size_t)m * DM, lane, v[r], H2_SCALE);
            LAS unsigned char* ah = Ahi + tok * AST + 8 * lane;
#pragma unroll
            for (int j = 0; j < 4; ++j) { const f32x4 x = v[r][j]; u32x2 h, l; h.x = cvtpk(x.x, x.y); h.y = cvtpk(x.z, x.w);
                l.x = cvtpk(x.x - __builtin_bit_cast(float, h.x << 16), x.y - __builtin_bit_cast(float, h.x & 0xffff0000u)); l.y = cvtpk(x.z - __builtin_bit_cast(float, h.y << 16), x.w - __builtin_bit_cast(float, h.y & 0xffff0000u));
                *(LAS u32x2*)(ah + 512 * j) = h; *(LAS u32x2*)(ah + 16 * AST + 512 * j) = l; } }
        N2_BAR();
        f32x4 acc = {0.f, 0.f, 0.f, 0.f};
#pragma unroll
        for (int s = 0; s < 4; ++s) { const LAS unsigned char* ap = Ahi + e_ * AST + 256 * wave_ + 64 * s + 16 * kg;
            const bf16x8 a_h = *(const LAS bf16x8*)ap, a_l = *(const LAS bf16x8*)(ap + 16 * AST);
            acc = __builtin_amdgcn_mfma_f32_16x16x32_bf16(a_h, Bh[s], acc, 0, 0, 0); acc = __builtin_amdgcn_mfma_f32_16x16x32_bf16(a_h, Bl[s], acc, 0, 0, 0); acc = __builtin_amdgcn_mfma_f32_16x16x32_bf16(a_l, Bh[s], acc, 0, 0, 0); }
#pragma unroll
        for (int r = 0; r < 4; ++r) red[wave_ * 256 + (4 * kg + r) * 16 + e_] = acc[r];
        N2_BAR();
        if (tid_ < 256) { float sacc = 0.f;
#pragma unroll
            for (int w = 0; w < 8; ++w) sacc += red[w * 256 + tid_];
            const float mx = row16_max(sacc);
            const float ex = expf(sacc - mx);
            const float sm = row16_sum(ex);
            aff[(size_t)(mbase + (tid_ >> 4)) * 16 + (tid_ & 15)] = ex / sm; }
    }
    __syncthreads();
#undef N2_GROUP
}

template <int NPT>
__device__ __forceinline__ void topk_task(Frame& F, const float* aff, int rowbase, int n, int cap, int e, int slot_base, unsigned* rowsrc_e, short* slot) {
    int tid_ = threadIdx.x; asm volatile("" : "+v"(tid_)); const int lane_ = tid_ & 63; const int wave_ = __builtin_amdgcn_readfirstlane(tid_ >> 6);
    LAS unsigned* cnt = (LAS unsigned*)F.lds;
    const int tid = tid_, lane = lane_, wave = wave_;
    const bool act = tid * NPT < n;
    unsigned v[NPT];
#pragma unroll
    for (int j = 0; j < NPT; ++j) v[j] = act ? __float_as_uint(aff[(size_t)(rowbase + tid * NPT + j) * 16 + e]) : 0u;
    unsigned T = 0u;
    for (int bit = 30; bit >= 0; --bit) {
        const unsigned cand = T | (1u << bit);
        unsigned c = 0;
#pragma unroll
        for (int j = 0; j < NPT; ++j) c += (act && v[j] >= cand) ? 1u : 0u;
        c = (unsigned)wave_sum((float)c);
        LAS unsigned* cb = cnt + (bit & 1) * 8;
        if (lane == 0) cb[wave] = c;
        __syncthreads();
        unsigned tot = 0;
#pragma unroll
        for (int w = 0; w < 8; ++w) tot += cb[w];
        if (tot >= (unsigned)cap) T = cand;
    }
    unsigned ngt = 0, neq = 0;
#pragma unroll
    for (int j = 0; j < NPT; ++j) { ngt += (act && v[j] > T) ? 1u : 0u; neq += (act && v[j] == T) ? 1u : 0u; }
    unsigned pk = ngt | (neq << 16), inc = pk;
#pragma unroll
    for (int o = 1; o < 64; o <<= 1) { const unsigned t = __shfl_up(inc, o); if (lane >= o) inc += t; }
    LAS unsigned* wtot = cnt + 32;
    __syncthreads();
    if (lane == 63) wtot[wave] = inc;
    __syncthreads();
    unsigned wpre = 0, total = 0;
#pragma unroll
    for (int w = 0; w < 8; ++w) { const unsigned t = wtot[w]; if (w < wave) wpre += t; total += t; }
    const unsigned exc = wpre + inc - pk;
    const unsigned tot_gt = total & 0xffffu;
    const unsigned need_eq = (unsigned)cap - tot_gt;
    unsigned gt_before = exc & 0xffffu, eq_before = exc >> 16;
    if (act) {
#pragma unroll
        for (int j = 0; j < NPT; ++j) {
            const bool g = v[j] > T, q = v[j] == T;
            const bool sel = g || (q && eq_before < need_eq);
            const int tok = tid * NPT + j;
            short sv = -1;
            if (sel) { const unsigned pos = gt_before + min(eq_before, need_eq); sv = (short)(slot_base + pos); rowsrc_e[slot_base + pos] = (unsigned)(rowbase + tok); }
            slot[(size_t)(rowbase + tok) * 16 + e] = sv;
            gt_before += g ? 1u : 0u; eq_before += q ? 1u : 0u;
        }
    }
    __syncthreads();
}
__device__ __forceinline__ void phase_topk(Frame& F, const float* aff, unsigned* rowsrc, short* slot, int nMe, bool with_ctx) {
    const int ntask = NB * NE * (with_ctx ? 2 : 1);
    for (int t = F.vcu; t < ntask; t += F.G) {
        const bool cx = t >= NB * NE; const int tt = cx ? t - NB * NE : t; const int b = tt >> 4, e = tt & 15;
        unsigned* rs_e = rowsrc + (size_t)e * nMe * 256;
        if (!cx) topk_task<8>(F, aff, b * SEQ, SEQ, CAPX, e, b * CAPX, rs_e, slot);
        else topk_task<1>(F, aff, MX + b * CTXL, CTXL, CAPC, e, NB * CAPX + b * CAPC, rs_e, slot);
    }
}

__device__ __forceinline__ void phase_combine(Frame& F, bf16_t* XB, const bf16_t* P, float* xout, const float* modL, const float* aff, const short* slot, const bf16_t* ybuf, int nMe,
                                              int nrows, bool last, const float* gnext, const float* modN, bf16_t* H, const float* final_g, float* dump = nullptr) {
    int tid_ = threadIdx.x; asm volatile("" : "+v"(tid_)); const int lane = tid_ & 63; const int wave_ = __builtin_amdgcn_readfirstlane(tid_ >> 6);
    const int gw = F.vcu * NWAVES + wave_, NGW = F.G * NWAVES; const int per = (nrows + NGW - 1) / NGW;
    ModCache M; M.b = -1;
    f32x4 g2v[4]; int gb = -1;
    const int m0 = gw * per, m1 = min(nrows, m0 + per);
    const size_t estride = (size_t)nMe * 256 * DM;
#define CB_META(m, sv, av) do { sv = (int)slot[(size_t)(m) * 16 + (lane & 15)]; av = aff[(size_t)(m) * 16 + (lane & 15)]; } while (0)
#define CB_ISSUE(m, sv, av, X, Y, AK, REST) do { load_row_bf16(XB + (size_t)(m) * DM, lane, X); \
        unsigned mk_ = (unsigned)__ballot(sv >= 0) & 0xffffu; \
        _Pragma("unroll") for (int k = 0; k < 4; ++k) { \
            if (mk_) { const int e_ = __builtin_ctz(mk_); mk_ &= mk_ - 1u; const int s_ = __builtin_amdgcn_readlane(sv, e_); AK[k] = __builtin_bit_cast(float, __builtin_amdgcn_readlane(__builtin_bit_cast(int, av), e_)); \
                const u32x2* yr_ = (const u32x2*)(ybuf + (size_t)e_ * estride + (size_t)s_ * DM) + lane; \
                _Pragma("unroll") for (int j = 0; j < 4; ++j) Y[k][j] = yr_[64 * j]; } \
            else { AK[k] = 0.f; _Pragma("unroll") for (int j = 0; j < 4; ++j) Y[k][j] = (u32x2){0u, 0u}; } } \
        REST = mk_; } while (0)
    int sv1 = -1, sv2 = -1; float av1 = 0.f, av2 = 0.f;
    u32x2 X[4], Xn[4]; u32x2 Y[4][4], Yn[4][4]; float AK[4], AKn[4]; unsigned rest = 0, restn = 0; int svc = -1, svn = -1; float avc = 0.f, avn = 0.f;
    if (m0 < m1) { CB_META(m0, sv1, av1); CB_ISSUE(m0, sv1, av1, X, Y, AK, rest); svc = sv1; avc = av1; }
    if (m0 + 1 < m1) CB_META(m0 + 1, sv1, av1);
    for (int m = m0; m < m1; ++m) {
        if (m + 1 < m1) { CB_ISSUE(m + 1, sv1, av1, Xn, Yn, AKn, restn); svn = sv1; avn = av1; }
        if (m + 2 < m1) CB_META(m + 2, sv1, av1);
        const int b = row_batch(m);
        if (gb != b) { gb = b;
#pragma unroll
            for (int j = 0; j < 4; ++j) g2v[j] = ((const f32x4*)(modL + (size_t)b * 6144 + 5 * DM))[lane + 64 * j]; }
        f32x4 acc[4];
#pragma unroll
        for (int j = 0; j < 4; ++j) acc[j] = (f32x4){0.f, 0.f, 0.f, 0.f};
#pragma unroll
        for (int k = 0; k < 4; ++k) { const float a = AK[k];
#pragma unroll
            for (int j = 0; j < 4; ++j) { const u32x2 w = Y[k][j];
                acc[j].x += a * __builtin_bit_cast(float, w.x << 16); acc[j].y += a * __builtin_bit_cast(float, w.x & 0xffff0000u);
                acc[j].z += a * __builtin_bit_cast(float, w.y << 16); acc[j].w += a * __builtin_bit_cast(float, w.y & 0xffff0000u); } }
        while (rest) { const int e_ = __builtin_ctz(rest); rest &= rest - 1u; const int s_ = __builtin_amdgcn_readlane(svc, e_); const float a = __builtin_bit_cast(float, __builtin_amdgcn_readlane(__builtin_bit_cast(int, avc), e_));
            const u32x2* yr = (const u32x2*)(ybuf + (size_t)e_ * estride + (size_t)s_ * DM) + lane;
#pragma unroll
            for (int j = 0; j < 4; ++j) { const u32x2 w = yr[64 * j];
                acc[j].x += a * __builtin_bit_cast(float, w.x << 16); acc[j].y += a * __builtin_bit_cast(float, w.x & 0xffff0000u);
                acc[j].z += a * __builtin_bit_cast(float, w.y << 16); acc[j].w += a * __builtin_bit_cast(float, w.y & 0xffff0000u); } }
        f32x4 v[4];
        cvt_row_bf16(v, X);
#pragma unroll
        for (int j = 0; j < 4; ++j) v[j] = v[j] + g2v[j] * acc[j];
        const float rstd = row_rstd(v);
        if (!last) {
            store_row_bf16((dump ? (bf16_t*)dump : XB) + (size_t)m * DM, lane, v);
            modcache_load(M, b, gnext, modN, 0, 1, lane);
#pragma unroll
            for (int j = 0; j < 4; ++j) v[j] = v[j] * rstd * M.sc[j] + M.sh[j];
            if (INPROJ_FP8) store_row_fp8((unsigned char*)H + (size_t)m * DM, lane, v, H2_SCALE); else store_row_bf16(H + (size_t)m * DM, lane, v);
        } else {
            f32x4* o = (f32x4*)((dump ? dump : xout) + (size_t)m * DM) + lane;
#pragma unroll
            for (int j = 0; j < 4; ++j) o[64 * j] = v[j] * rstd * ((const f32x4*)final_g)[lane + 64 * j];
        }
#pragma unroll
        for (int j = 0; j < 4; ++j) { X[j] = Xn[j];
#pragma unroll
            for (int k = 0; k < 4; ++k) Y[k][j] = Yn[k][j]; }
#pragma unroll
        for (int k = 0; k < 4; ++k) AK[k] = AKn[k];
        rest = restn; svc = svn; avc = avn;
    }
#undef CB_META
#undef CB_ISSUE
}

struct Args { In in; float* out; unsigned char* ws; int ph_lo, ph_hi; };
#define WSP(off) ((unsigned char*)karg(KA_WS) + (off))
__global__ void __launch_bounds__(NWAVES * 64, 2) fwd(Args args) {
    extern __shared__ __attribute__((aligned(16))) unsigned char lds_raw[];
    Frame F;
    F.lds = (LAS unsigned char*)lds_raw;
    F.MISC = (volatile LAS unsigned*)(F.lds + MISC_OFF);
    F.tid = threadIdx.x; F.lane = F.tid & 63; F.wave = __builtin_amdgcn_readfirstlane(F.tid >> 6);
    F.G = gridDim.x; { const int bx = blockIdx.x; F.vcu = (F.G % 8 == 0) ? (bx % 8) * (F.G / 8) + bx / 8 : bx; }
    F.ctl = nullptr;
    if (F.tid < 64) ((LAS unsigned*)(F.lds + MISC_OFF))[F.tid] = 0u;
    __syncthreads();
    const int lo = args.ph_lo, hi = args.ph_hi;
    if (hi - lo > 1) (void)xcd_barrier_post((unsigned*)WSP(WS_CTL) + 1024, F.MISC + 8);
#ifndef DBG_ONLY
#define DBG_ONLY -1
#endif
#define PHEN(k) (DBG_ONLY < 0 || ((k) < 2 ? (k) : 2 + (((k) - 2) & 7)) == DBG_ONLY)
#define IN(k) (PHEN(k) && lo <= (k) && (k) < hi)
#ifndef ROUTER_MFMA
#define ROUTER_MFMA 1
#endif
#ifndef DUP_PH
#define DUP_PH -1
#endif
#ifndef DUP_LMASK
#define DUP_LMASK 0xF
#endif
#define NREP(k, L) ((DUP_PH == (k) && ((DUP_LMASK >> (L)) & 1)) ? 2 : 1)
#define SEAM(k) do { if (IN(k) && IN((k) + 1)) { XcdBarrier bar_; bar_.bar = (unsigned*)WSP(WS_CTL) + 1024; bar_.x = xb_xcc_id(); bar_.st = F.MISC + 8; xcd_barrier(bar_); } } while (0)

    if (IN(0)) { for (int rep_ = 0; rep_ < NREP(0, 0); ++rep_) phase_prologue(F, WSP(0)); } SEAM(0);
    if (IN(1)) { phase_norm1(F, karg(KA_x), karg(KA_ctx), karg(KA_norm1_g), (const float*)WSP(WS_MOD), (bf16_t*)WSP(WS_H), (bf16_t*)WSP(WS_XB)); } SEAM(1);

#pragma unroll 1
    for (int L = 0; L < DEPTH; ++L) {
        const int pb = 2 + 8 * L;
        if (hi <= pb || lo >= pb + 8) continue;
        if (IN(pb + 0)) for (int rep_ = 0; rep_ < NREP(2, L); ++rep_) {
            const int kind = L % 3, slot = L / 3; const int Nin = (kind == 0) ? 1536 : 3072;
            const bf16_t* Wt = (const bf16_t*)WSP(WS_PW) + (kind == 0 ? PW_WIN_IN / 2 + (size_t)slot * 1536 * 1024 : kind == 1 ? PW_DIFF_IN / 2 : PW_NA_IN / 2);
            pg8::Gemm g{(const char*)WSP(WS_H), (const char*)Wt, INPROJ_FP8 ? DM : DM * 2, 1 << 20, 0, nullptr};
            pg8::StaticOrder S; S.init(MT / 256, Nin / 256, F.G, (int)blockIdx.x);
            pg8::EpiInProj E{(bf16_t*)WSP(WS_QKV), Nin, 4, kind == 0 ? 5 : (kind == 1 ? 8 : 0), (const float*)WSP(WS_TAB), INPROJ_FP8 ? 1.f / (H2_SCALE * W8_SCALE) : 1.f, kind == 0 ? 5 : 8, (bf16_t*)WSP(WS_P)};
            pg8::gemm_phase<pg8::EpiInProj, false, true, INPROJ_FP8 != 0>(F.lds, g, S, E);
        }
        SEAM(pb + 0);
        if (IN(pb + 1)) for (int rep_ = 0; rep_ < NREP(3, L); ++rep_) {
            const int kind = L % 3, slot = L / 3; const int with_ctx = L < DEPTH - 1 ? 1 : 0;
            if (kind == 0) { att::A2Args A{(const bf16_t*)WSP(WS_QKV), (bf16_t*)WSP(WS_H), karg(KA_win_sink) + slot * 16, with_ctx, (const bf16_t*)WSP(WS_P)}; att::att2_phase<0>(F.lds, A, F.vcu, F.G); }
            else if (kind == 1) { const float* TAB = (const float*)WSP(WS_TAB); att::DiffArgs A{(const bf16_t*)WSP(WS_QKV), (bf16_t*)WSP(WS_H), karg(KA_diff_subln_g), TAB[TAB_LAM], TAB[TAB_LAM + 1], with_ctx, (const bf16_t*)WSP(WS_P)}; att::diff_phase3(F.lds, A, F.vcu, F.G); }
            else { att::A2Args A{(const bf16_t*)WSP(WS_QKV), (bf16_t*)WSP(WS_H), karg(KA_na_rpb), with_ctx, (const bf16_t*)WSP(WS_P)}; att::att2_phase<1>(F.lds, A, F.vcu, F.G); }
        }
        SEAM(pb + 1);
        if (IN(pb + 2)) {
            const int kind = L % 3, slot = L / 3; const bool with_ctx = L < DEPTH - 1;
            const bf16_t* Wt = (const bf16_t*)WSP(WS_PW) + (kind == 0 ? PW_WIN_OUT / 2 + (size_t)slot * 1024 * 1024 : kind == 1 ? PW_DIFF_OUT / 2 : PW_NA_OUT / 2);
            pg8::Gemm g{(const char*)WSP(WS_H), (const char*)Wt, OUTPROJ_FP8 ? DM : DM * 2, 1 << 20, 0, nullptr};
            pg8::StaticOrder S; S.init((with_ctx ? MT : MX) / 256, 4, F.G, (int)blockIdx.x);
            pg8::EpiOutProj E{(bf16_t*)WSP(WS_XB), (const float*)WSP(WS_MOD) + (size_t)L * 17 * 6144, OUTPROJ_FP8 ? 1.f / (Y_SCALE * W8_SCALE) : 1.f};
            pg8::gemm_phase<pg8::EpiOutProj, false, true, OUTPROJ_FP8 != 0>(F.lds, g, S, E);
        }
        SEAM(pb + 2);
        if (IN(pb + 3)) for (int rep_ = 0; rep_ < NREP(5, L); ++rep_) { const bool with_ctx = L < DEPTH - 1;
            if (ROUTER_MFMA && rep_ == 0) phase_norm2_router_mfma(F, (const bf16_t*)WSP(WS_XB), karg(KA_norm2_g) + L * DM, (const float*)WSP(WS_MOD) + (size_t)L * 17 * 6144, karg(KA_router_w) + (size_t)L * DM * NE,
                               (unsigned char*)WSP(WS_H), (float*)WSP(WS_AFF), with_ctx ? MT : MX);
            else phase_norm2_router(F, (const bf16_t*)WSP(WS_XB), karg(KA_norm2_g) + L * DM, (const float*)WSP(WS_MOD) + (size_t)L * 17 * 6144, karg(KA_router_w) + (size_t)L * DM * NE,
                               (unsigned char*)WSP(WS_H), (float*)WSP(WS_AFF), with_ctx ? MT : MX, (const bf16_t*)WSP(WS_P), rep_ == 0); }
        SEAM(pb + 3);
        if (IN(pb + 4)) for (int rep_ = 0; rep_ < NREP(6, L); ++rep_) { const bool with_ctx = L < DEPTH - 1; phase_topk(F, (const float*)WSP(WS_AFF), (unsigned*)WSP(WS_ROWSRC), (short*)WSP(WS_SLOT), with_ctx ? NME_FULL : NME_LAST, with_ctx); }
        SEAM(pb + 4);
        if (IN(pb + 5)) for (int rep_ = 0; rep_ < NREP(7, L); ++rep_) {
            const int nMe = (L < DEPTH - 1) ? NME_FULL : NME_LAST;
            pg8::Gemm g{(const char*)WSP(WS_H), (const char*)WSP(WS_MOEW + (size_t)L * 16 * MOEW_E), DM, nMe, MOEW_E, (const unsigned*)WSP(WS_ROWSRC)};
            pg8::StaticOrder S; S.init(16 * nMe, 16, F.G, (int)blockIdx.x);
            if (DUP_PH == 7 && rep_ == 1) { pg8::EpiSwiglu<true> E{(unsigned char*)WSP(WS_QKV), 1.f / (H2_SCALE * W8_SCALE), HID_SCALE};
                pg8::gemm_phase<pg8::EpiSwiglu<true>, true, true, true>(F.lds, g, S, E); }
            else { pg8::EpiSwiglu<false> E{(unsigned char*)WSP(WS_QKV), 1.f / (H2_SCALE * W8_SCALE), HID_SCALE};
                pg8::gemm_phase<pg8::EpiSwiglu<false>, true, true, true>(F.lds, g, S, E); }
        }
        SEAM(pb + 5);
        if (IN(pb + 6)) for (int rep_ = 0; rep_ < NREP(8, L); ++rep_) {
            const int nMe = (L < DEPTH - 1) ? NME_FULL : NME_LAST;
            pg8::Gemm g{(const char*)WSP(WS_QKV), (const char*)WSP(WS_MOEW + (size_t)L * 16 * MOEW_E + (size_t)4096 * 1024), FF, nMe, MOEW_E, nullptr};
            pg8::StaticOrder S; S.init(16 * nMe, 4, F.G, (int)blockIdx.x);
            pg8::EpiBf16 E{(bf16_t*)WSP(WS_YBUF), DM, 1.f / (HID_SCALE * W8_SCALE)};
            pg8::gemm_phase<pg8::EpiBf16, false, true, true, true>(F.lds, g, S, E);
        }
        SEAM(pb + 6);
        if (IN(pb + 7)) for (int rep_ = NREP(9, L) - 1; rep_ >= 0; --rep_) {
            const bool last = (L == DEPTH - 1); const bool with_ctx = !last;
            phase_combine(F, (bf16_t*)WSP(WS_XB), (const bf16_t*)WSP(WS_P), (float*)karg(KA_OUT), (const float*)WSP(WS_MOD) + (size_t)L * 17 * 6144, (const float*)WSP(WS_AFF), (const short*)WSP(WS_SLOT), (const bf16_t*)WSP(WS_YBUF),
                          with_ctx ? NME_FULL : NME_LAST, with_ctx ? MT : MX, last, karg(KA_norm1_g) + (last ? 0 : (L + 1) * DM), (const float*)WSP(WS_MOD) + (size_t)(last ? 0 : L + 1) * 17 * 6144,
                          rep_ ? (bf16_t*)WSP(WS_QKV + 300 * MiB) : (bf16_t*)WSP(WS_H), karg(KA_final_g), rep_ ? (float*)WSP(WS_QKV) : nullptr);
        }
        SEAM(pb + 7);
    }
#undef IN
#undef SEAM
}

extern "C" void kernel_launch(void* const* d_in, const int* in_sizes, int n_in, void* d_out, int out_size, void* d_ws, size_t ws_size, hipStream_t stream) {
    static int grid = 0;
    if (grid == 0) {
        if (n_in != 23 || out_size != MX * DM || ws_size < WS_END) { fprintf(stderr, "kernel_launch: unexpected shapes: n_in %d out %d ws %zu (need %zu)\n", n_in, out_size, ws_size, (size_t)WS_END); grid = -1; return; }
        int dev = 0, cus = 0, per_cu = 0;
        if (hipGetDevice(&dev) != hipSuccess || hipDeviceGetAttribute(&cus, hipDeviceAttributeMultiprocessorCount, dev) != hipSuccess) { grid = -1; return; }
        if (hipFuncSetAttribute((const void*)fwd, hipFuncAttributeMaxDynamicSharedMemorySize, LDS_BYTES) != hipSuccess) { fprintf(stderr, "kernel_launch: hipFuncSetAttribute failed\n"); grid = -1; return; }
        if (hipOccupancyMaxActiveBlocksPerMultiprocessor(&per_cu, (const void*)fwd, NWAVES * 64, LDS_BYTES) != hipSuccess || per_cu < 1) fprintf(stderr, "kernel_launch: occupancy query says %d\n", per_cu);
        (void)hipGetLastError();
        grid = cus;
    }
    if (grid < 0) return;
    (void)hipMemsetAsync((char*)d_ws + WS_CTL, 0, CTL_ZERO_BYTES, stream);
    Args a{};
    const float** ip = (const float**)&a.in;
    for (int i = 0; i < 23; ++i) ip[i] = (const float*)d_in[i];
    a.out = (float*)d_out; a.ws = (unsigned char*)d_ws;
    if (MK_N_LAUNCHES == 1) { a.ph_lo = 0; a.ph_hi = NPHASES; hipLaunchKernelGGL(fwd, dim3(grid), dim3(NWAVES * 64), LDS_BYTES, stream, a); }
    else for (int p = 0; p < NPHASES; ++p) { a.ph_lo = p; a.ph_hi = p + 1; hipLaunchKernelGGL(fwd, dim3(grid), dim3(NWAVES * 64), LDS_BYTES, stream, a); }
}
```
